# Optimizing an MI355X kernel written in HIP

```python
import jax
import jax.numpy as jnp
from jax import lax
import numpy as np

D_MODEL = 1024
BATCH = 4
SEQ = 8192
DEPTH = 4

D_MIX = D_MODEL
GROUP_WIDTH = D_MIX // 4
MLA_V_DIM = 64
MLA_HEADS = GROUP_WIDTH // MLA_V_DIM
MLA_NOPE_DIM = 64
MLA_ROPE_DIM = 32
MLA_QK_DIM = MLA_NOPE_DIM + MLA_ROPE_DIM
MLA_Q_LORA = 3 * D_MODEL // 16
MLA_KV_LORA = D_MODEL // 8
ROPE_THETA = 10000.0
ATTN_BLOCK = 128
POOL_WINDOWS = (2, 4, 8, 16)
POOL_GROUP = GROUP_WIDTH // len(POOL_WINDOWS)
HGRN_DK = 64
HGRN_DV = 64
HGRN_HEADS = GROUP_WIDTH // HGRN_DV
HGRN_CHUNK = 128
CONV_CH = GROUP_WIDTH
CONV_K = 31
N_EXPERT_GROUPS = 4
EXPERTS_PER_GROUP = 8
N_EXPERTS = N_EXPERT_GROUPS * EXPERTS_PER_GROUP
TOP_K = 2
D_EXPERT = D_MODEL // 2
MOE_BLOCK = 128
EPS = 1e-6
IN_SIZES = (MLA_Q_LORA, MLA_KV_LORA, MLA_ROPE_DIM, GROUP_WIDTH,
            HGRN_HEADS * HGRN_DK, HGRN_HEADS * HGRN_DK, HGRN_HEADS * HGRN_DV, HGRN_HEADS * HGRN_DV,
            2 * CONV_CH)
IN_COLS = sum(IN_SIZES)
IN_OFFSETS = tuple(int(v) for v in np.cumsum(IN_SIZES)[:-1])

kernel_name = 'hybrid_parallel_heads_hmoe'


def rms_norm(x, g):
    xf = x.astype(jnp.float32)
    y = xf * lax.rsqrt(jnp.mean(xf * xf, axis=-1, keepdims=True) + EPS)
    return (y * g.astype(jnp.float32)).astype(x.dtype)


def layer_norm(x, g, b):
    xf = x.astype(jnp.float32)
    mu = jnp.mean(xf, axis=-1, keepdims=True)
    var = jnp.mean(jnp.square(xf - mu), axis=-1, keepdims=True)
    y = (xf - mu) * lax.rsqrt(var + EPS)
    return (y * g.astype(jnp.float32) + b.astype(jnp.float32)).astype(x.dtype)


def rope_tables(positions):
    half = MLA_ROPE_DIM // 2
    inv_freq = ROPE_THETA ** (-jnp.arange(half, dtype=jnp.float32) / half)
    ang = positions.astype(jnp.float32)[..., None] * inv_freq
    return jnp.cos(ang)[:, :, None, :], jnp.sin(ang)[:, :, None, :]


def apply_rope(x, cos, sin):
    x1, x2 = jnp.split(x, 2, axis=-1)
    cos = cos.astype(x.dtype)
    sin = sin.astype(x.dtype)
    return jnp.concatenate([x1 * cos - x2 * sin, x1 * sin + x2 * cos], axis=-1)


def causal_attention(q, k, v):
    B, S, H, Dq = q.shape
    nb = S // ATTN_BLOCK
    qb = q.reshape(B, nb, ATTN_BLOCK, H, Dq).transpose(1, 0, 2, 3, 4)
    starts = jnp.arange(nb, dtype=jnp.int32) * ATTN_BLOCK
    kpos = jnp.arange(S, dtype=jnp.int32)
    scale = MLA_QK_DIM ** -0.5

    def block(args):
        qi, st = args
        s = jnp.einsum('bqhd,bkhd->bhqk', qi, k).astype(jnp.float32) * scale
        qpos = st + jnp.arange(ATTN_BLOCK, dtype=jnp.int32)
        s = jnp.where(kpos[None, :] <= qpos[:, None], s, -1e30)
        p = jax.nn.softmax(s, axis=-1).astype(v.dtype)
        return jnp.einsum('bhqk,bkhd->bqhd', p, v)

    o = lax.map(block, (qb, starts))
    return o.transpose(1, 0, 2, 3, 4).reshape(B, S, H, v.shape[-1])


def mla_mixer(cq, ckv, krope, cos, sin, q_a_g, w_uq, kv_a_g, w_ukv, q_g, k_g):
    B, S, _ = cq.shape
    q = (rms_norm(cq, q_a_g) @ w_uq).reshape(B, S, MLA_HEADS, MLA_QK_DIM)
    kv = (rms_norm(ckv, kv_a_g) @ w_ukv).reshape(B, S, MLA_HEADS, MLA_NOPE_DIM + MLA_V_DIM)
    k_nope, v = jnp.split(kv, [MLA_NOPE_DIM], axis=-1)
    k_rope = jnp.broadcast_to(krope[:, :, None, :], (B, S, MLA_HEADS, MLA_ROPE_DIM))
    k = jnp.concatenate([k_nope, k_rope], axis=-1)
    q = rms_norm(q, q_g)
    k = rms_norm(k, k_g)
    q = jnp.concatenate([q[..., :MLA_NOPE_DIM], apply_rope(q[..., MLA_NOPE_DIM:], cos, sin)], axis=-1)
    k = jnp.concatenate([k[..., :MLA_NOPE_DIM], apply_rope(k[..., MLA_NOPE_DIM:], cos, sin)], axis=-1)
    o = causal_attention(q, k, v)
    return o.reshape(B, S, MLA_HEADS * MLA_V_DIM)


def pool_mixer(u, w_pool, scale):
    B, S, _ = u.shape
    uf = u.astype(jnp.float32).reshape(B, S, len(POOL_WINDOWS), POOL_GROUP)
    cs = jnp.cumsum(uf, axis=1)
    t1 = jnp.arange(1, S + 1, dtype=jnp.float32)
    outs = []
    for gi, w in enumerate(POOL_WINDOWS):
        csg = cs[:, :, gi]
        lag = jnp.pad(csg, ((0, 0), (w, 0), (0, 0)))[:, :S]
        mean = (csg - lag) / jnp.minimum(t1, w)[None, :, None]
        outs.append(mean - uf[:, :, gi])
    pooled = jnp.stack(outs, axis=2).astype(u.dtype)
    y = jnp.einsum('bsgc,gcd->bsgd', pooled, w_pool)
    return y.reshape(B, S, GROUP_WIDTH) * scale


def gated_recurrence_chunked(q, k, v, logf):
    B, S, H, DK = q.shape
    DV = v.shape[-1]
    nc = S // HGRN_CHUNK

    def to_chunks(a):
        return a.reshape(B, nc, HGRN_CHUNK, H, a.shape[-1]).transpose(1, 0, 3, 2, 4)

    causal = jnp.tril(jnp.ones((HGRN_CHUNK, HGRN_CHUNK), dtype=bool))

    def step(state, inp):
        qc, kc, vc, lc = inp
        b = jnp.cumsum(lc, axis=2)
        o_inter = jnp.einsum('bhtd,bhdv->bhtv', qc * jnp.exp(b), state)
        diff = b[:, :, :, None, :] - b[:, :, None, :, :]
        decay = jnp.exp(jnp.where(causal[:, :, None], diff, -jnp.inf))
        a = jnp.einsum('bhtd,bhtsd,bhsd->bhts', qc, decay, kc)
        o_intra = jnp.einsum('bhts,bhsv->bhtv', a, vc)
        b_last = b[:, :, -1:, :]
        new_state = jnp.exp(b_last[:, :, 0, :])[..., None] * state + \
            jnp.einsum('bhsd,bhsv->bhdv', kc * jnp.exp(b_last - b), vc)
        return new_state, o_inter + o_intra

    state0 = jnp.zeros((B, H, DK, DV), jnp.float32)
    _, o = lax.scan(step, state0, (to_chunks(q), to_chunks(k), to_chunks(v), to_chunks(logf)))
    return o.transpose(1, 0, 3, 2, 4).reshape(B, S, H, DV)


def hgrn2_mixer(hq, hf, hi, hg, lb, out_g):
    B, S, _ = hq.shape
    q = jax.nn.silu(hq.astype(jnp.float32)).reshape(B, S, HGRN_HEADS, HGRN_DK)
    zf = hf.astype(jnp.float32).reshape(B, S, HGRN_HEADS, HGRN_DK)
    lbh = lb.reshape(HGRN_HEADS, HGRN_DK)
    logf = jnp.logaddexp(jnp.log(lbh), jnp.log1p(-lbh) + jax.nn.log_sigmoid(zf))
    k = -jnp.expm1(logf)
    v = hi.astype(jnp.float32).reshape(B, S, HGRN_HEADS, HGRN_DV)
    o = gated_recurrence_chunked(q, k, v, logf)
    g = hg.astype(jnp.float32).reshape(B, S, HGRN_HEADS, HGRN_DV)
    o = rms_norm(o, out_g) * jax.nn.silu(g)
    return o.reshape(B, S, GROUP_WIDTH).astype(hq.dtype)


def conformer_conv_mixer(u2, dw_w, dw_b, ln_g, ln_b):
    a, gate = jnp.split(u2, 2, axis=-1)
    u = a * jax.nn.sigmoid(gate)
    u = lax.conv_general_dilated(
        u, dw_w[:, None, :].astype(u.dtype), window_strides=(1,), padding=[(CONV_K - 1, 0)],
        dimension_numbers=('NWC', 'WIO', 'NWC'), feature_group_count=CONV_CH) + dw_b
    u = layer_norm(u, ln_g, ln_b)
    return jax.nn.silu(u)


def token_mixer(h, cos, sin, lb, w_in, q_a_g, w_uq, kv_a_g, w_ukv, q_g, k_g, w_pool, pool_scale,
                hgrn_out_g, dw_w, dw_b, ln_g, ln_b, w_out):
    z = h @ w_in
    cq, ckv, krope, u_pool, hq, hf, hi, hg, u_conv = jnp.split(z, list(IN_OFFSETS), axis=-1)
    y_mla = mla_mixer(cq, ckv, krope, cos, sin, q_a_g, w_uq, kv_a_g, w_ukv, q_g, k_g)
    y_pool = pool_mixer(u_pool, w_pool, pool_scale)
    y_hgrn = hgrn2_mixer(hq, hf, hi, hg, lb, hgrn_out_g)
    y_conv = conformer_conv_mixer(u_conv, dw_w, dw_b, ln_g, ln_b)
    y = jnp.concatenate([y_mla, y_pool, y_hgrn, y_conv], axis=-1)
    return y @ w_out


def hierarchical_moe(h, rg_w, rg_b, re_w, re_b, w1, w3, w2):
    B, S, D = h.shape
    N = B * S
    xf = h.reshape(N, D)
    g_logits = (xf @ rg_w).astype(jnp.float32) + rg_b
    g_prob = jax.nn.softmax(g_logits, axis=-1)
    g_idx = jnp.argmax(g_logits, axis=-1).astype(jnp.int32)
    g_w = jnp.take_along_axis(g_prob, g_idx[:, None], axis=-1)
    e_logits = ((xf @ re_w).astype(jnp.float32) + re_b).reshape(N, N_EXPERT_GROUPS, EXPERTS_PER_GROUP)
    e_logits = jnp.take_along_axis(e_logits, g_idx[:, None, None], axis=1)[:, 0]
    top_l, top_i = lax.top_k(e_logits, TOP_K)
    e_w = jax.nn.softmax(top_l, axis=-1) * g_w
    expert_id = (g_idx[:, None] * EXPERTS_PER_GROUP + top_i).reshape(-1).astype(jnp.int32)
    weight = e_w.reshape(-1)
    token = jnp.repeat(jnp.arange(N, dtype=jnp.int32), TOP_K)
    A = N * TOP_K
    order = jnp.argsort(expert_id)
    e_sorted = expert_id[order]
    tok_sorted = token[order]
    w_sorted = weight[order]
    counts = jax.ops.segment_sum(jnp.ones((A,), jnp.int32), expert_id, num_segments=N_EXPERTS)
    start = jnp.cumsum(counts) - counts
    padded = (counts + MOE_BLOCK - 1) // MOE_BLOCK * MOE_BLOCK
    padded_end = jnp.cumsum(padded)
    padded_start = padded_end - padded
    dest = padded_start[e_sorted] + jnp.arange(A, dtype=jnp.int32) - start[e_sorted]
    n_rows = (-(-A // MOE_BLOCK) + N_EXPERTS) * MOE_BLOCK
    n_blocks = n_rows // MOE_BLOCK
    row_tok = jnp.full((n_rows,), N, jnp.int32).at[dest].set(tok_sorted)
    row_w = jnp.zeros((n_rows,), jnp.float32).at[dest].set(w_sorted)
    blk_start = jnp.arange(n_blocks, dtype=jnp.int32) * MOE_BLOCK
    blk_expert = jnp.minimum(jnp.searchsorted(padded_end, blk_start, side='right'), N_EXPERTS - 1)
    x_pad = jnp.concatenate([xf, jnp.zeros((1, D), xf.dtype)], axis=0)

    def run_block(args):
        toks, wts, e = args
        xb = x_pad[toks]
        hb = jax.nn.silu(xb @ w1[e]) * (xb @ w3[e])
        return (hb @ w2[e]) * wts[:, None].astype(xb.dtype)

    yb = lax.map(run_block, (row_tok.reshape(n_blocks, MOE_BLOCK), row_w.reshape(n_blocks, MOE_BLOCK), blk_expert))
    y = jnp.zeros((N + 1, D), h.dtype).at[row_tok].add(yb.reshape(n_rows, D).astype(h.dtype))
    return y[:N].reshape(B, S, D)


def setup_inputs(seed: int = 0) -> dict:
    key = jax.random.key(seed)
    ks = jax.random.split(key, 32)
    f32 = jnp.float32
    L, D = DEPTH, D_MODEL

    def nrm(k, shape, scale):
        return jax.random.normal(k, shape, f32) * scale

    def gain(k, shape):
        return 1.0 + 0.02 * jax.random.normal(k, shape, f32)

    return {
        'x': nrm(ks[0], (BATCH, SEQ, D), 1.0),
        'c': nrm(ks[1], (BATCH, D), 1.0),
        'positions': jnp.arange(SEQ, dtype=jnp.int32)[None, :] + jax.random.randint(ks[2], (BATCH, 1), 0, 4096, dtype=jnp.int32),
        'w_ada': nrm(ks[3], (L, D, 6 * D), 0.5 * D ** -0.5),
        'b_ada': nrm(ks[4], (L, 6 * D), 0.02),
        'norm1_g': gain(ks[5], (L, D)),
        'norm2_g': gain(ks[6], (L, D)),
        'w_in': nrm(ks[7], (L, D, IN_COLS), D ** -0.5),
        'q_a_norm_g': gain(ks[8], (L, MLA_Q_LORA)),
        'w_uq': nrm(ks[9], (L, MLA_Q_LORA, MLA_HEADS * MLA_QK_DIM), MLA_Q_LORA ** -0.5),
        'kv_a_norm_g': gain(ks[10], (L, MLA_KV_LORA)),
        'w_ukv': nrm(ks[11], (L, MLA_KV_LORA, MLA_HEADS * (MLA_NOPE_DIM + MLA_V_DIM)), MLA_KV_LORA ** -0.5),
        'q_norm_g': gain(ks[12], (L, MLA_QK_DIM)),
        'k_norm_g': gain(ks[13], (L, MLA_QK_DIM)),
        'w_pool': nrm(ks[14], (L, len(POOL_WINDOWS), POOL_GROUP, POOL_GROUP), POOL_GROUP ** -0.5),
        'pool_scale': 1.0 + 0.1 * jax.random.normal(ks[15], (L, GROUP_WIDTH), f32),
        'hgrn_lb_logits': nrm(ks[16], (DEPTH, HGRN_HEADS * HGRN_DK), 1.0),
        'hgrn_out_norm_g': gain(ks[17], (L, HGRN_DV)),
        'conv_dw_w': nrm(ks[18], (L, CONV_K, CONV_CH), CONV_K ** -0.5),
        'conv_dw_b': nrm(ks[19], (L, CONV_CH), 0.02),
        'conv_ln_g': gain(ks[20], (L, CONV_CH)),
        'conv_ln_b': nrm(ks[21], (L, CONV_CH), 0.02),
        'w_out': nrm(ks[22], (L, D_MIX, D), D_MIX ** -0.5),
        'router_group_w': nrm(ks[23], (L, D, N_EXPERT_GROUPS), D ** -0.5),
        'router_group_b': nrm(ks[24], (L, N_EXPERT_GROUPS), 0.01),
        'router_expert_w': nrm(ks[25], (L, D, N_EXPERTS), D ** -0.5),
        'router_expert_b': nrm(ks[26], (L, N_EXPERTS), 0.01),
        'w1': nrm(ks[27], (L, N_EXPERTS, D, D_EXPERT), D ** -0.5),
        'w3': nrm(ks[28], (L, N_EXPERTS, D, D_EXPERT), D ** -0.5),
        'w2': nrm(ks[29], (L, N_EXPERTS, D_EXPERT, D), D_EXPERT ** -0.5),
    }


def reference(x, c, positions, w_ada, b_ada, norm1_g, norm2_g, w_in, q_a_norm_g, w_uq, kv_a_norm_g, w_ukv,
              q_norm_g, k_norm_g, w_pool, pool_scale, hgrn_lb_logits, hgrn_out_norm_g, conv_dw_w, conv_dw_b,
              conv_ln_g, conv_ln_b, w_out, router_group_w, router_group_b, router_expert_w, router_expert_b,
              w1, w3, w2):
    cos, sin = rope_tables(positions)
    lb_cum = jnp.cumsum(jax.nn.softmax(hgrn_lb_logits.astype(jnp.float32), axis=0), axis=0)
    lower_bounds = lb_cum - lb_cum[0:1]
    c_act = jax.nn.silu(c)
    for l in range(DEPTH):
        mod = (c_act @ w_ada[l] + b_ada[l])[:, None, :]
        sh1, sc1, g1, sh2, sc2, g2 = jnp.split(mod, 6, axis=-1)
        h = rms_norm(x, norm1_g[l]) * (1 + sc1) + sh1
        x = x + g1 * token_mixer(h, cos, sin, lower_bounds[l], w_in[l], q_a_norm_g[l], w_uq[l], kv_a_norm_g[l],
                                 w_ukv[l], q_norm_g[l], k_norm_g[l], w_pool[l], pool_scale[l], hgrn_out_norm_g[l],
                                 conv_dw_w[l], conv_dw_b[l], conv_ln_g[l], conv_ln_b[l], w_out[l])
        h = rms_norm(x, norm2_g[l]) * (1 + sc2) + sh2
        x = x + g2 * hierarchical_moe(h, router_group_w[l], router_group_b[l], router_expert_w[l],
                                      router_expert_b[l], w1[l], w3[l], w2[l])
    return x
```

```cpp
#include <hip/hip_runtime.h>
#include <cstdio>
#include <cstdint>

#ifndef CFG_B
#define CFG_B 4
#endif
#ifndef CFG_S
#define CFG_S 8192
#endif
#ifndef CFG_L
#define CFG_L 4
#endif
#ifndef MK_SPLIT
#define MK_SPLIT 0
#endif

#ifdef EMU
#define ASMV(...) ((void)0)
#define LAS
#define LAUNDER_V(x) ((void)0)
#define LAUNDER_S(x) ((void)0)
#else
#define ASMV(...) asm volatile(__VA_ARGS__)
#define LAS __attribute__((address_space(3)))
#define LAUNDER_V(x) asm volatile("" : "+v"(x))
#define LAUNDER_S(x) asm volatile("" : "+s"(x))
#endif

typedef unsigned short bf16_t;
typedef short bf16x8 __attribute__((ext_vector_type(8)));
typedef short s16x4 __attribute__((ext_vector_type(4)));
typedef float f32x4 __attribute__((ext_vector_type(4)));
typedef float f32x16 __attribute__((ext_vector_type(16)));
typedef unsigned u32x4 __attribute__((ext_vector_type(4)));
typedef unsigned u32x2 __attribute__((ext_vector_type(2)));

__device__ __forceinline__ float bf2f(bf16_t h) { return __builtin_bit_cast(float, (unsigned)h << 16); }
__device__ __forceinline__ float bflo(unsigned w) { return __builtin_bit_cast(float, w << 16); }
__device__ __forceinline__ float bfhi(unsigned w) { return __builtin_bit_cast(float, w & 0xffff0000u); }
__device__ __forceinline__ unsigned f2bf_bits(float f) { unsigned u = __builtin_bit_cast(unsigned, f); u += 0x7fffu + ((u >> 16) & 1u); return u >> 16; }
#ifdef EMU
__device__ __forceinline__ unsigned cvt_pk_bf16(float lo, float hi) { return f2bf_bits(lo) | (f2bf_bits(hi) << 16); }
#else
__device__ __forceinline__ unsigned cvt_pk_bf16(float lo, float hi) { unsigned r; asm volatile("v_cvt_pk_bf16_f32 %0, %1, %2" : "=v"(r) : "v"(lo), "v"(hi)); return r; }
#endif
__device__ __forceinline__ float fast_exp(float x) { return __builtin_amdgcn_exp2f(x * 1.44269504089f); }
__device__ __forceinline__ float fsigmoid(float x) { return __builtin_amdgcn_rcpf(1.0f + fast_exp(-x)); }
__device__ __forceinline__ float fsilu(float x) { return x * fsigmoid(x); }
__device__ __forceinline__ float frsqrt(float x) { return __builtin_amdgcn_rsqf(x); }
__device__ __forceinline__ float wave_sum(float v) {
#pragma unroll
    for (int m = 32; m >= 1; m >>= 1) v += __shfl_xor(v, m);
    return v;
}

namespace pg8 {
#define PG8_LAS LAS
constexpr int BM = 256, BK = 64, HALF = 128, HTB = HALF * BK * 2  , STAGE_BYTES = 8 * HTB, NXCD = 8, WGM = 8;

__host__ __device__ __forceinline__ int lds_byte(int r, int c) { const int st = (r >> 4) * 2 + (c >> 5), rr = r & 15, cc = c & 31, ob = rr * 64 + cc * 2; return st * 1024 + (ob ^ (((ob >> 9) & 1) << 5)); }
__host__ __device__ __forceinline__ void stage_rc(int b, int& R, int& C) { const int st = b / 1024, sb = b % 1024, swz = sb ^ (((sb >> 9) & 1) << 5); R = (st >> 1) * 16 + swz / 64; C = (st & 1) * 32 + (swz % 64) / 2; }
__host__ __device__ __forceinline__ int perm32(int rho) { const int n = rho >> 4, i = rho & 15; return 8 * (i >> 2) + 4 * n + (i & 3); }

struct Unit { int pm, pn; };
struct Gemm { const bf16_t* A; const bf16_t* Bt; int M, N, K; };

struct StaticOrder {
    int nM, nN, nwg, G, c;
    __host__ __device__ void init(int M, int N, int G_, int c_) { nM = M / BM; nN = N / BM; nwg = nM * nN; G = G_; c = c_; }
    __host__ __device__ bool next(int i, Unit& u) const {
        const long L = (long)i * G + c; if (L >= nwg) return false;
        int wgid = (int)L; { const int q = nwg / NXCD, r = nwg % NXCD, xcd = wgid % NXCD, off = wgid / NXCD; wgid = (xcd < r ? xcd * (q + 1) : r * (q + 1) + (xcd - r) * q) + off; }
        const int nig = WGM * nN, gid = wgid / nig, fm = gid * WGM, gsz = (nM - fm) < WGM ? (nM - fm) : WGM;
        u.pm = fm + ((wgid % nig) % gsz); u.pn = (wgid % nig) / gsz; return true;
    }
    __device__ __forceinline__ void a_ready(const Unit&) const {}
    __device__ __forceinline__ void done(const Unit&) const {}
};
template <class Epi, class Sched, bool ALIGN_EPI = false, bool SP2 = false>
__device__ __forceinline__ void gemm_phase(PG8_LAS unsigned char* lds, const Gemm g, const Sched& S, const Epi& E) {
    int tid = threadIdx.x; LAUNDER_V(tid); const int wid = __builtin_amdgcn_readfirstlane(tid >> 6), lane = tid & 63, wr = wid >> 2, wc = wid & 3, fr = lane & 15, fq = lane >> 4;
    const int K = g.K, nt = K / BK;
    unsigned voffA[2], voffB[2];
#pragma unroll
    for (int i = 0; i < 2; ++i) { int R, C; stage_rc(tid * 16 + i * 8192, R, C); const int Rb = Epi::PERM ? ((R & ~31) + perm32(R & 31)) : R;
        voffA[i] = (unsigned)(R * K + C) * 2u; voffB[i] = (unsigned)(Rb * K + C) * 2u; }
    const size_t kstep = (size_t)(BK * 2);
    const size_t hstep = (size_t)HALF * K * 2;
    const size_t tstep = 2 * hstep;
    const unsigned ldsw = (unsigned)wid * 1024u;
    const int aoff = lds_byte(wr * 64 + fr, fq * 8), boff = lds_byte(wc * 32 + fr, fq * 8);
#define PG8_SA(b, h) (((b) * 2 + (h)) * HTB)
#define PG8_SB(b, h) ((4 + (b) * 2 + (h)) * HTB)
#define PG8_STAGE(bufoff, gbase, voff) do { _Pragma("unroll") for (int _i = 0; _i < 2; ++_i) \
        __builtin_amdgcn_global_load_lds((const unsigned*)((const char*)(gbase) + (voff)[_i]), (PG8_LAS unsigned*)(lds + (bufoff) + ldsw + _i * 8192), 16, 0, 0); } while (0)
#define PG8_LDA(dst, b, h) do { _Pragma("unroll") for (int m = 0; m < 4; ++m) _Pragma("unroll") for (int k = 0; k < 2; ++k) dst[m][k] = *(const PG8_LAS bf16x8*)(lds + PG8_SA(b, h) + aoff + m * 2048 + k * 1024); } while (0)
#define PG8_LDB(dst, b, h) do { _Pragma("unroll") for (int n = 0; n < 2; ++n) _Pragma("unroll") for (int k = 0; k < 2; ++k) dst[n][k] = *(const PG8_LAS bf16x8*)(lds + PG8_SB(b, h) + boff + n * 2048 + k * 1024); } while (0)
#define PG8_MMA(ai, bj, At, Bt) do { __builtin_amdgcn_s_setprio(1); _Pragma("unroll") for (int m = 0; m < 4; ++m) _Pragma("unroll") for (int n = 0; n < 2; ++n) _Pragma("unroll") for (int k = 0; k < 2; ++k) \
        acc[ai][bj][m][n] = __builtin_amdgcn_mfma_f32_16x16x32_bf16(Bt[n][k], At[m][k], acc[ai][bj][m][n], 0, 0, 0); __builtin_amdgcn_s_setprio(0); } while (0)
#define PG8_WAIT_V(n) ASMV("s_waitcnt vmcnt(" #n ")" ::: "memory")
#define PG8_WAIT_L(n) ASMV("s_waitcnt lgkmcnt(" #n ")" ::: "memory")
#define PG8_BAR __builtin_amdgcn_s_barrier()
#define PG8_SCHED __builtin_amdgcn_sched_barrier(0)
    Unit cur, nxt; int ui = 0;
    if (!S.next(0, cur)) return;
    f32x4 acc[2][2][4][2];
#pragma unroll
    for (int a = 0; a < 2; ++a)
#pragma unroll
        for (int b = 0; b < 2; ++b)
#pragma unroll
            for (int m = 0; m < 4; ++m)
#pragma unroll
                for (int n = 0; n < 2; ++n) acc[a][b][m][n] = (f32x4){0.f, 0.f, 0.f, 0.f};
    bf16x8 At[4][2], B0[2][2], B1[2][2];
    const char* cA = (const char*)g.A + (size_t)cur.pm * tstep; const char* cB = (const char*)g.Bt + (size_t)cur.pn * tstep;
    S.a_ready(cur);
    if constexpr (SP2) {
        PG8_STAGE(PG8_SB(0, 0), cB, voffB); PG8_STAGE(PG8_SB(0, 1), cB + hstep, voffB); PG8_STAGE(PG8_SA(0, 0), cA, voffA); PG8_STAGE(PG8_SA(0, 1), cA + hstep, voffA);
        if (wr == 1) PG8_BAR;
        PG8_WAIT_V(2); PG8_BAR;
        PG8_STAGE(PG8_SB(1, 0), cB + kstep, voffB); PG8_STAGE(PG8_SA(1, 0), cA + kstep, voffA); PG8_STAGE(PG8_SB(1, 1), cB + hstep + kstep, voffB);
        PG8_WAIT_V(6); PG8_BAR;
    } else {
        PG8_STAGE(PG8_SB(0, 0), cB, voffB); PG8_STAGE(PG8_SA(0, 0), cA, voffA); PG8_STAGE(PG8_SB(0, 1), cB + hstep, voffB); PG8_STAGE(PG8_SA(0, 1), cA + hstep, voffA);
        if (wr == 1) PG8_BAR;
        PG8_WAIT_V(4); PG8_BAR;
        PG8_STAGE(PG8_SB(1, 0), cB + kstep, voffB); PG8_STAGE(PG8_SA(1, 0), cA + kstep, voffA); PG8_STAGE(PG8_SB(1, 1), cB + hstep + kstep, voffB);
        PG8_WAIT_V(6); PG8_BAR;
    }
    for (;;) {
        const bool has_next = S.next(ui + 1, nxt);
        const char* nA = has_next ? (const char*)g.A + (size_t)nxt.pm * tstep : cA; const char* nB = has_next ? (const char*)g.Bt + (size_t)nxt.pn * tstep : cB;
        for (int t = 0; t < nt; t += 2) {
            const bool last = (t == nt - 2);
            const char* a1 = cA + (size_t)(t + 1) * kstep;
            const char* a2 = last ? nA : cA + (size_t)(t + 2) * kstep; const char* b2 = last ? nB : cB + (size_t)(t + 2) * kstep;
            const char* a3 = a2 + kstep; const char* b3 = b2 + kstep;
            if (last && has_next) S.a_ready(nxt);
            if constexpr (SP2) {
            PG8_LDB(B0, 0, 0); PG8_LDB(B1, 0, 1); PG8_SCHED; PG8_LDA(At, 0, 0); PG8_STAGE(PG8_SA(1, 1), a1 + hstep, voffA);
            PG8_WAIT_V(8); PG8_WAIT_L(0); PG8_BAR; PG8_MMA(0, 0, At, B0); PG8_MMA(0, 1, At, B1); PG8_BAR; PG8_SCHED;
            PG8_LDA(At, 0, 1); PG8_STAGE(PG8_SB(0, 0), b2, voffB); PG8_STAGE(PG8_SB(0, 1), b2 + hstep, voffB); PG8_STAGE(PG8_SA(0, 0), a2, voffA);
            PG8_WAIT_V(8); PG8_WAIT_L(0); PG8_BAR; PG8_MMA(1, 0, At, B0); PG8_MMA(1, 1, At, B1); PG8_BAR; PG8_SCHED;
            PG8_LDB(B0, 1, 0); PG8_LDB(B1, 1, 1); PG8_SCHED; PG8_LDA(At, 1, 0); PG8_STAGE(PG8_SA(0, 1), a2 + hstep, voffA);
            PG8_WAIT_V(8); PG8_WAIT_L(0); PG8_BAR; PG8_MMA(0, 0, At, B0); PG8_MMA(0, 1, At, B1); PG8_BAR; PG8_SCHED;
            PG8_LDA(At, 1, 1); PG8_STAGE(PG8_SB(1, 0), b3, voffB); PG8_STAGE(PG8_SB(1, 1), b3 + hstep, voffB); PG8_STAGE(PG8_SA(1, 0), a3, voffA);
            PG8_WAIT_V(8); PG8_WAIT_L(0); PG8_BAR; PG8_MMA(1, 0, At, B0); PG8_MMA(1, 1, At, B1); PG8_BAR; PG8_SCHED;
            } else {
            PG8_LDB(B0, 0, 0); PG8_SCHED; PG8_LDA(At, 0, 0); PG8_STAGE(PG8_SA(1, 1), a1 + hstep, voffA);
            PG8_WAIT_L(8); PG8_BAR; PG8_WAIT_L(0); PG8_MMA(0, 0, At, B0); PG8_BAR; PG8_SCHED;
            PG8_LDB(B1, 0, 1); PG8_STAGE(PG8_SB(0, 0), b2, voffB);
            PG8_BAR; PG8_WAIT_L(0); PG8_MMA(0, 1, At, B1); PG8_BAR;
            PG8_LDA(At, 0, 1); PG8_STAGE(PG8_SA(0, 0), a2, voffA);
            PG8_BAR; PG8_WAIT_L(0); PG8_MMA(1, 0, At, B0); PG8_BAR; PG8_SCHED;
            PG8_STAGE(PG8_SB(0, 1), b2 + hstep, voffB);
            PG8_WAIT_V(6); PG8_BAR; PG8_MMA(1, 1, At, B1); PG8_BAR;
            PG8_LDB(B0, 1, 0); PG8_SCHED; PG8_LDA(At, 1, 0); PG8_STAGE(PG8_SA(0, 1), a2 + hstep, voffA);
            PG8_WAIT_L(8); PG8_BAR; PG8_WAIT_L(0); PG8_MMA(0, 0, At, B0); PG8_BAR; PG8_SCHED;
            PG8_LDB(B1, 1, 1); PG8_STAGE(PG8_SB(1, 0), b3, voffB);
            PG8_BAR; PG8_WAIT_L(0); PG8_MMA(0, 1, At, B1); PG8_BAR;
            PG8_LDA(At, 1, 1); PG8_STAGE(PG8_SA(1, 0), a3, voffA);
            PG8_BAR; PG8_WAIT_L(0); PG8_MMA(1, 0, At, B0); PG8_BAR; PG8_SCHED;
            PG8_STAGE(PG8_SB(1, 1), b3 + hstep, voffB);
            PG8_WAIT_V(6); PG8_BAR; PG8_MMA(1, 1, At, B1); PG8_BAR;
            }
        }
        if constexpr (ALIGN_EPI) { if (wr == 0) PG8_BAR; }
        if constexpr (!Epi::AFTER_DRAIN) { E(acc, cur, wr, wc, fr, fq); S.done(cur); }
        if (!has_next) break;
#pragma unroll
        for (int a = 0; a < 2; ++a)
#pragma unroll
            for (int b = 0; b < 2; ++b)
#pragma unroll
                for (int m = 0; m < 4; ++m)
#pragma unroll
                    for (int n = 0; n < 2; ++n) acc[a][b][m][n] = (f32x4){0.f, 0.f, 0.f, 0.f};
        cur = nxt; cA = nA; cB = nB; ++ui;
        if constexpr (ALIGN_EPI) { if (wr == 1) PG8_BAR; }
    }
    PG8_WAIT_V(0);
    if constexpr (!ALIGN_EPI) { if (wr == 0) PG8_BAR; }
    PG8_BAR;
    if constexpr (Epi::AFTER_DRAIN) { E.fused(acc, cur, wr, wc, fr, fq, lds, wid, lane); S.done(cur); }
#undef PG8_SA
#undef PG8_SB
#undef PG8_STAGE
#undef PG8_LDA
#undef PG8_LDB
#undef PG8_MMA
#undef PG8_WAIT_V
#undef PG8_WAIT_L
#undef PG8_BAR
#undef PG8_SCHED
}

struct EpiBf16 {
    static constexpr bool PERM = true, AFTER_DRAIN = false;
    bf16_t* O; int ldc;
    __device__ __forceinline__ void operator()(const f32x4 (&acc)[2][2][4][2], const Unit& u, int wr, int wc, int fr, int fq) const {
        const int row0 = u.pm * BM + wr * 64 + fr, col0 = u.pn * BM + wc * 32 + 8 * fq;
#pragma unroll
        for (int ai = 0; ai < 2; ++ai)
#pragma unroll
            for (int m = 0; m < 4; ++m) { bf16_t* rowp = O + (size_t)(row0 + ai * HALF + m * 16) * ldc + col0;
#pragma unroll
                for (int bj = 0; bj < 2; ++bj) { const f32x4 v0 = acc[ai][bj][m][0], v1 = acc[ai][bj][m][1];
                    u32x4 w; w.x = cvt_pk_bf16(v0[0], v0[1]); w.y = cvt_pk_bf16(v0[2], v0[3]); w.z = cvt_pk_bf16(v1[0], v1[1]); w.w = cvt_pk_bf16(v1[2], v1[3]);
                    *(u32x4*)(rowp + bj * HALF) = w; } }
    }
};
struct EpiResid {
    static constexpr bool PERM = true, AFTER_DRAIN = false;
    const float* xin; float* xout; const float* gate; int gstride; int seq;
    __device__ __forceinline__ void operator()(const f32x4 (&acc)[2][2][4][2], const Unit& u, int wr, int wc, int fr, int fq) const {
        const int row0 = u.pm * BM + wr * 64 + fr, col0 = u.pn * BM + wc * 32 + 8 * fq;
#pragma unroll
        for (int ai = 0; ai < 2; ++ai)
#pragma unroll
            for (int m = 0; m < 4; ++m) { const int row = row0 + ai * HALF + m * 16; const float* gp = gate + (size_t)(row / seq) * gstride;
#pragma unroll
                for (int bj = 0; bj < 2; ++bj) { const int c = col0 + bj * HALF; const size_t o = (size_t)row * 1024 + c;
                    const f32x4 g0 = *(const f32x4*)(gp + c), g1 = *(const f32x4*)(gp + c + 4);
                    const f32x4 x0 = *(const f32x4*)(xin + o), x1 = *(const f32x4*)(xin + o + 4);
                    *(f32x4*)(xout + o) = x0 + g0 * acc[ai][bj][m][0]; *(f32x4*)(xout + o + 4) = x1 + g1 * acc[ai][bj][m][1]; } }
    }
};
struct EpiSwiglu {
    static constexpr bool PERM = true, AFTER_DRAIN = false;
    bf16_t* HB;
    __device__ __forceinline__ void operator()(const f32x4 (&acc)[2][2][4][2], const Unit& u, int wr, int wc, int fr, int fq) const {
        const int row0 = u.pm * BM + wr * 64 + fr, col0 = (u.pn & 3) * 128 + wc * 32 + 8 * fq;
#pragma unroll
        for (int ai = 0; ai < 2; ++ai)
#pragma unroll
            for (int m = 0; m < 4; ++m) { bf16_t* p = HB + (size_t)(row0 + ai * HALF + m * 16) * 512 + col0;
                float h[8];
#pragma unroll
                for (int n = 0; n < 2; ++n)
#pragma unroll
                    for (int k = 0; k < 4; ++k) h[n * 4 + k] = fsilu(acc[ai][0][m][n][k]) * acc[ai][1][m][n][k];
                u32x4 w; w.x = cvt_pk_bf16(h[0], h[1]); w.y = cvt_pk_bf16(h[2], h[3]); w.z = cvt_pk_bf16(h[4], h[5]); w.w = cvt_pk_bf16(h[6], h[7]);
                *(u32x4*)p = w; }
    }
};
struct EpiDown {
    static constexpr bool PERM = true, AFTER_DRAIN = false;
    const int* row_tok; const float* row_w; float* x; bf16_t* y1; const float* gate; int gstride; int seq;
    __device__ __forceinline__ void operator()(const f32x4 (&acc)[2][2][4][2], const Unit& u, int wr, int wc, int fr, int fq) const {
        const int row0 = u.pm * BM + wr * 64 + fr, col0 = (u.pn & 3) * BM + wc * 32 + 8 * fq;
#pragma unroll
        for (int ai = 0; ai < 2; ++ai)
#pragma unroll
            for (int m = 0; m < 4; ++m) { const int row = row0 + ai * HALF + m * 16; const int ts = row_tok[row];
                if (ts >= 0) { const int tok = ts >> 1; const float w = row_w[row]; const float* gp = gate + (size_t)(tok / seq) * gstride;
#pragma unroll
                    for (int bj = 0; bj < 2; ++bj) { const int c = col0 + bj * HALF; const size_t o = (size_t)tok * 1024 + c;
                        const f32x4 v0 = acc[ai][bj][m][0] * (*(const f32x4*)(gp + c)) * w, v1 = acc[ai][bj][m][1] * (*(const f32x4*)(gp + c + 4)) * w;
                        if (ts & 1) { u32x4 q; q.x = cvt_pk_bf16(v0[0], v0[1]); q.y = cvt_pk_bf16(v0[2], v0[3]); q.z = cvt_pk_bf16(v1[0], v1[1]); q.w = cvt_pk_bf16(v1[2], v1[3]); *(u32x4*)(y1 + o) = q; }
                        else { *(f32x4*)(x + o) = *(const f32x4*)(x + o) + v0; *(f32x4*)(x + o + 4) = *(const f32x4*)(x + o + 4) + v1; } } } }
    }
};
struct MoeOrder {
    const int* tile; int G, c;
    __device__ __forceinline__ bool next(int i, Unit& u) const { const int L = i * G + c, nt = tile[0]; if (L >= nt * 4) return false; u.pm = L >> 2; u.pn = tile[1 + (L >> 2)] * 4 + (L & 3); return true; }
    __device__ __forceinline__ void a_ready(const Unit&) const {}
    __device__ __forceinline__ void done(const Unit&) const {}
};
}

constexpr int NB = CFG_B, SEQ = CFG_S, NL = CFG_L, NTOK = NB * SEQ, DM = 1024, ZP = 2304;
constexpr int NBH = NB * 4, NCH = SEQ / 128, NQT = SEQ / 256;
constexpr int NR = 2 * NTOK + 32 * 256;
constexpr int Z_CQ = 0, Z_CKV = 192, Z_KR = 320, Z_POOL = 352, Z_HQ = 608, Z_HF = 864, Z_HI = 1120, Z_HG = 1376, Z_CA = 1632, Z_CG = 1888;
constexpr float EPS = 1e-6f;
static_assert(SEQ % 256 == 0 && NTOK % 256 == 0 && (NQT % 2) == 0, "shape");
constexpr size_t al256(size_t x) { return (x + 255) & ~(size_t)255; }
constexpr size_t cmax(size_t a, size_t b) { return a > b ? a : b; }
constexpr size_t WS_CTL = 0, CTL_BYTES = 65536;
constexpr size_t CTL_CNT = 16384;
constexpr size_t WS_MODP = WS_CTL + CTL_BYTES;
constexpr size_t WS_MOD = WS_MODP + al256((size_t)16 * NL * NB * 6144 * 4);
constexpr size_t WS_LB = WS_MOD + al256((size_t)NL * NB * 6144 * 4);
constexpr size_t WS_ROPE = WS_LB + al256((size_t)NL * 256 * 4);
constexpr size_t WS_WIN = WS_ROPE + al256((size_t)NTOK * 32 * 4);
constexpr size_t WS_WOUT = WS_WIN + (size_t)ZP * 1024 * 2;
constexpr size_t WS_WUQ = WS_WOUT + (size_t)1024 * 1024 * 2;
constexpr size_t WS_WUKV = WS_WUQ + al256((size_t)384 * 192 * 2);
constexpr size_t WS_WPOOL = WS_WUKV + al256((size_t)512 * 128 * 2);
constexpr size_t WS_WUP = WS_WPOOL + al256((size_t)4 * 64 * 64 * 2);
constexpr size_t WS_WDN = WS_WUP + (size_t)32 * 1024 * 1024 * 2;
constexpr size_t WS_HA = WS_WDN + (size_t)32 * 1024 * 512 * 2;
constexpr size_t WS_Z = WS_HA + (size_t)NTOK * 1024 * 2;
constexpr size_t Z_BYTES = cmax((size_t)NTOK * ZP * 2, (size_t)NR * 1024 * 2);
constexpr size_t WS_Q = WS_Z + Z_BYTES;
constexpr size_t WS_K = WS_Q + (size_t)NTOK * 4 * 96 * 2;
constexpr size_t WS_VT = WS_K + (size_t)NTOK * 4 * 96 * 2;
constexpr size_t WS_YB = WS_VT + (size_t)NTOK * 4 * 64 * 2;
constexpr size_t R2_BYTES = cmax(WS_YB + (size_t)NTOK * 1024 * 2 - WS_Q, (size_t)NR * 512 * 2);
constexpr size_t WS_Y1 = WS_Q + R2_BYTES;
constexpr size_t WS_SC = WS_Y1 + (size_t)NTOK * 1024 * 2;
constexpr size_t WS_PC = WS_SC + (size_t)NBH * NCH * 4096 * 4;
constexpr size_t WS_ASGE = WS_PC + al256((size_t)NBH * NCH * 64 * 4);
constexpr size_t WS_ASGR = WS_ASGE + (size_t)NTOK * 8;
constexpr size_t WS_ASGW = WS_ASGR + (size_t)NTOK * 8;
constexpr size_t WS_ROWTOK = WS_ASGW + (size_t)NTOK * 8;
constexpr size_t WS_ROWW = WS_ROWTOK + al256((size_t)NR * 4);
constexpr size_t WS_TILE = WS_ROWW + al256((size_t)NR * 4);
constexpr size_t WS_END = WS_TILE + al256((size_t)(NR / 256 + 16) * 4);
constexpr int LDS_BYTES = 160 * 1024;
constexpr int LDS_XB = LDS_BYTES - 16;

#define XB_TMO      128
#define XB_XCNT(j)  (256  + 64 * (j))
#define XB_XSUB(j)  (1280 + 64 * (j))
#define XB_XGEN(j)  (2304 + 64 * (j))
#define XB_TOP      3328
#define XB_TOPGEN   3392
#define XCD_BAR_WORDS 3456
#define XB_SPIN_CAP (1u << 18)
__device__ __forceinline__ unsigned xb_ld(unsigned* p)              { return __hip_atomic_load(p, __ATOMIC_RELAXED, __HIP_MEMORY_SCOPE_AGENT); }
__device__ __forceinline__ unsigned xb_add(unsigned* p, unsigned v) { return __hip_atomic_fetch_add(p, v, __ATOMIC_RELAXED, __HIP_MEMORY_SCOPE_AGENT); }
__device__ __forceinline__ unsigned xb_xcc_id() { return (unsigned)__builtin_amdgcn_s_getreg((3 << 11) | 20) & 0xFu; }
#define XB_SPIN(cond, bar) do { unsigned _sp = 0; while (cond) { __builtin_amdgcn_s_sleep(1); \
    if ((++_sp & 255u) == 0u) { if (xb_ld(&(bar)[XB_TMO])) break; if (_sp > XB_SPIN_CAP) { atomicAdd(&(bar)[XB_TMO], 1u); break; } } } } while (0)
struct XcdBarrier { unsigned* bar; unsigned x; volatile LAS unsigned* st; };
__device__ __forceinline__ XcdBarrier xcd_barrier_post(unsigned* bar, volatile LAS unsigned* st) {
    XcdBarrier b; b.bar = bar; b.x = xb_xcc_id(); b.st = st;
    if (threadIdx.x == 0) (void)xb_add(&bar[XB_XCNT(b.x)], 1u);
    return b;
}
__device__ __forceinline__ void xcd_barrier_complete(unsigned* bar, unsigned x, unsigned& nloc, unsigned& nx) {
    const unsigned G = gridDim.x * gridDim.y * gridDim.z;
    unsigned sum, cnt, mine, sp = 0u;
    for (;;) {
        sum = 0u; cnt = 0u; mine = 0u;
#pragma unroll
        for (unsigned j = 0; j < 16; ++j) { const unsigned c = xb_ld(&bar[XB_XCNT(j)]); sum += c; cnt += (c > 0u) ? 1u : 0u; mine = (j == x) ? c : mine; }
        if (sum == G) break;
        __builtin_amdgcn_s_sleep(1);
        if ((++sp & 255u) == 0u) { if (xb_ld(&bar[XB_TMO])) break; if (sp > XB_SPIN_CAP) { atomicAdd(&bar[XB_TMO], 1u); break; } }
    }
    nloc = mine > 0u ? mine : 1u; nx = cnt > 0u ? cnt : 1u;
}
__device__ __forceinline__ void xcd_barrier(const XcdBarrier& b) {
    ASMV("s_waitcnt vmcnt(0)" ::: "memory");
    __syncthreads();
    if (threadIdx.x == 0) {
        unsigned* bar = b.bar;
        __builtin_amdgcn_s_waitcnt(0);
        unsigned nloc = b.st[0], nx = b.st[1];
        if (nloc == 0u) { xcd_barrier_complete(bar, b.x, nloc, nx); b.st[0] = nloc; b.st[1] = nx; }
        const unsigned old = xb_add(&bar[XB_XSUB(b.x)], 1u);
        const unsigned gen = old / nloc;
        if (old + 1u == (gen + 1u) * nloc) {
            __builtin_amdgcn_fence(__ATOMIC_RELEASE, "agent");
            ASMV("s_waitcnt vmcnt(0)" ::: "memory");
            const unsigned og = xb_add(&bar[XB_TOP], 1u);
            const unsigned tg = og / nx;
            if (og + 1u == (tg + 1u) * nx) xb_add(&bar[XB_TOPGEN], 1u);
            else XB_SPIN(xb_ld(&bar[XB_TOPGEN]) == tg, bar);
            __builtin_amdgcn_fence(__ATOMIC_ACQUIRE, "agent");
            xb_add(&bar[XB_XGEN(b.x)], 1u);
            ASMV("s_waitcnt vmcnt(0)" ::: "memory");
        } else {
            XB_SPIN(xb_ld(&bar[XB_XGEN(b.x)]) == gen, bar);
            __builtin_amdgcn_fence(__ATOMIC_ACQUIRE, "agent");
            ASMV("s_waitcnt vmcnt(0)" ::: "memory");
        }
    }
    __syncthreads();
}

struct Args { const void* in[30]; float* out; unsigned char* ws; int ph_lo, ph_hi; };
enum { I_X = 0, I_C, I_POS, I_WADA, I_BADA, I_N1G, I_N2G, I_WIN, I_QAG, I_WUQ, I_KVAG, I_WUKV, I_QG, I_KG, I_WPOOL, I_PSCALE, I_LBL, I_HOG, I_DWW, I_DWB, I_LNG, I_LNB,
       I_WOUT, I_RGW, I_RGB, I_REW, I_REB, I_W1, I_W3, I_W2 };
struct Ctx {
    const Args* a; unsigned char* ws; unsigned char* lds; int tid, wid, lane, G, blk;
    __device__ __forceinline__ const float* inf(int i) const { return (const float*)a->in[i]; }
    template <class T> __device__ __forceinline__ T* w(size_t off) const { return (T*)(ws + off); }
};

__device__ __forceinline__ Ctx fresh(const Ctx& c0) { Ctx c = c0; LAUNDER_V(c.tid); LAUNDER_V(c.lane); LAUNDER_S(c.wid); LAUNDER_S(c.ws); return c; }
__device__ __forceinline__ void ph_prologue0(const Ctx& c_) { const Ctx c = fresh(c_);
    const float* cc = c.inf(I_C); const float* wada = c.inf(I_WADA); float* modp = c.w<float>(WS_MODP);
    for (int u = c.blk; u < NL * 16 * 12; u += c.G) {
        const int l = u / 192, r = u % 192, ic = r / 12, jb = r % 12, j = jb * 512 + c.tid;
        float acc[NB];
#pragma unroll
        for (int b = 0; b < NB; ++b) acc[b] = 0.f;
        const float* wp = wada + ((size_t)l * 1024 + ic * 64) * 6144 + j;
        for (int i = 0; i < 64; ++i) { const float wv = wp[(size_t)i * 6144];
#pragma unroll
            for (int b = 0; b < NB; ++b) acc[b] += fsilu(cc[b * 1024 + ic * 64 + i]) * wv; }
#pragma unroll
        for (int b = 0; b < NB; ++b) modp[(((size_t)ic * NL + l) * NB + b) * 6144 + j] = acc[b];
    }
    const int* pos = (const int*)c.a->in[I_POS]; float* rc = c.w<float>(WS_ROPE); float* rs = rc + (size_t)NTOK * 16;
    for (int e = c.blk * 512 + c.tid; e < NTOK * 16; e += c.G * 512) { const int t = e >> 4, i = e & 15;
        const float inv = exp2f(-(float)i * (13.287712379549449f / 16.0f));
        const float ang = (float)pos[t] * inv; rc[e] = cosf(ang); rs[e] = sinf(ang); }
    if (c.blk == 0 && c.tid < 256) { const float* lg = c.inf(I_LBL); float* lb = c.w<float>(WS_LB); float mx = -1e30f;
        for (int l = 0; l < NL; ++l) mx = fmaxf(mx, lg[l * 256 + c.tid]);
        float den = 0.f; for (int l = 0; l < NL; ++l) den += expf(lg[l * 256 + c.tid] - mx);
        float cum = 0.f, first = 0.f; for (int l = 0; l < NL; ++l) { cum += expf(lg[l * 256 + c.tid] - mx) / den; if (l == 0) first = cum; lb[l * 256 + c.tid] = cum - first; } }
}
__device__ __forceinline__ void ph_prologue1(const Ctx& c_) { const Ctx c = fresh(c_);
    const float* modp = c.w<float>(WS_MODP); float* mod = c.w<float>(WS_MOD); const float* bada = c.inf(I_BADA);
    for (int e = c.blk * 512 + c.tid; e < NL * NB * 6144; e += c.G * 512) { const int j = e % 6144, l = e / (NB * 6144);
        float s = bada[l * 6144 + j];
#pragma unroll
        for (int ic = 0; ic < 16; ++ic) s += modp[(size_t)ic * NL * NB * 6144 + e];
        mod[e] = s; }
}

__device__ __forceinline__ void cvt_tile(const Ctx& c, const float* src, int ldn, int nlim, int k0, int n0, bf16_t* dst, int ldk, int drow0) {
    float* T = (float*)c.lds;
#pragma unroll
    for (int i = 0; i < 8; ++i) { const int e = c.tid + 512 * i, kk = e >> 6, nn = e & 63; T[kk * 65 + nn] = (n0 + nn < nlim) ? src[(size_t)(k0 + kk) * ldn + n0 + nn] : 0.f; }
    __syncthreads();
#pragma unroll
    for (int i = 0; i < 4; ++i) { const int e = c.tid + 512 * i, nn = e >> 5, k2 = e & 31;
        *(unsigned*)(dst + (size_t)(drow0 + nn) * ldk + k0 + 2 * k2) = cvt_pk_bf16(T[(2 * k2) * 65 + nn], T[(2 * k2 + 1) * 65 + nn]); }
    __syncthreads();
}
constexpr int CT_IN = 16 * 36, CT_OUT = 16 * 16, CT_UQ = 3 * 6, CT_UKV = 2 * 8, CT_POOL = 4, CT_W13 = 32 * 16 * 8, CT_W2 = 32 * 8 * 16;
constexpr int CT_TOTAL = CT_IN + CT_OUT + CT_UQ + CT_UKV + CT_POOL + 2 * CT_W13 + CT_W2;
__device__ __forceinline__ void ph_norm1(const Ctx& c_, int l) { const Ctx c = fresh(c_);
    for (int t = c.blk; t < CT_TOTAL; t += c.G) {
        int r = t;
        if (r < CT_IN) { const int kt = r / 36, nt = r % 36; cvt_tile(c, c.inf(I_WIN) + (size_t)l * 1024 * 2144, 2144, 2144, kt * 64, nt * 64, c.w<bf16_t>(WS_WIN), 1024, nt * 64); continue; } r -= CT_IN;
        if (r < CT_OUT) { const int kt = r / 16, nt = r % 16; cvt_tile(c, c.inf(I_WOUT) + (size_t)l * 1024 * 1024, 1024, 1024, kt * 64, nt * 64, c.w<bf16_t>(WS_WOUT), 1024, nt * 64); continue; } r -= CT_OUT;
        if (r < CT_UQ) { const int kt = r / 6, nt = r % 6; cvt_tile(c, c.inf(I_WUQ) + (size_t)l * 192 * 384, 384, 384, kt * 64, nt * 64, c.w<bf16_t>(WS_WUQ), 192, nt * 64); continue; } r -= CT_UQ;
        if (r < CT_UKV) { const int kt = r / 8, nt = r % 8; cvt_tile(c, c.inf(I_WUKV) + (size_t)l * 128 * 512, 512, 512, kt * 64, nt * 64, c.w<bf16_t>(WS_WUKV), 128, nt * 64); continue; } r -= CT_UKV;
        if (r < CT_POOL) { cvt_tile(c, c.inf(I_WPOOL) + ((size_t)l * 4 + r) * 4096, 64, 64, 0, 0, c.w<bf16_t>(WS_WPOOL) + r * 4096, 64, 0); continue; } r -= CT_POOL;
        if (r < 2 * CT_W13) { const int which = r / CT_W13; r %= CT_W13; const int e = r / 128, kt = (r % 128) / 8, nt = r % 8;
            const float* src = c.inf(which ? I_W3 : I_W1) + ((size_t)l * 32 + e) * 1024 * 512;
            cvt_tile(c, src, 512, 512, kt * 64, nt * 64, c.w<bf16_t>(WS_WUP) + (size_t)e * 1024 * 1024, 1024, (nt >> 1) * 256 + which * 128 + (nt & 1) * 64); continue; } r -= 2 * CT_W13;
        { const int e = r / 128, kt = (r % 128) / 16, nt = r % 16;
            cvt_tile(c, c.inf(I_W2) + ((size_t)l * 32 + e) * 512 * 1024, 1024, 1024, kt * 64, nt * 64, c.w<bf16_t>(WS_WDN) + (size_t)e * 1024 * 512, 512, nt * 64); }
    }
    const float* xin = (l == 0) ? c.inf(I_X) : c.a->out; float* xout = c.a->out; const bf16_t* y1 = c.w<bf16_t>(WS_Y1);
    const float* gn = c.inf(I_N1G) + l * 1024; const float* mod = c.w<float>(WS_MOD) + (size_t)l * NB * 6144; bf16_t* ha = c.w<bf16_t>(WS_HA);
    for (int row = c.blk * 8 + c.wid; row < NTOK; row += c.G * 8) {
        const int b = row / SEQ; const float* sh = mod + b * 6144; const float* sc = sh + 1024;
        f32x4 v[4]; float ss = 0.f;
#pragma unroll
        for (int i = 0; i < 4; ++i) { const int col = i * 256 + c.lane * 4; v[i] = *(const f32x4*)(xin + (size_t)row * 1024 + col);
            if (l > 0) { const u32x2 y = *(const u32x2*)(y1 + (size_t)row * 1024 + col); v[i] += (f32x4){bflo(y.x), bfhi(y.x), bflo(y.y), bfhi(y.y)}; *(f32x4*)(xout + (size_t)row * 1024 + col) = v[i]; }
            ss += v[i][0] * v[i][0] + v[i][1] * v[i][1] + v[i][2] * v[i][2] + v[i][3] * v[i][3]; }
        ss = wave_sum(ss); const float rinv = frsqrt(ss * (1.0f / 1024.0f) + EPS);
#pragma unroll
        for (int i = 0; i < 4; ++i) { const int col = i * 256 + c.lane * 4; const f32x4 g = *(const f32x4*)(gn + col), s1 = *(const f32x4*)(sc + col), s0 = *(const f32x4*)(sh + col);
            const f32x4 h = v[i] * rinv * g * (s1 + 1.0f) + s0; u32x2 o; o.x = cvt_pk_bf16(h[0], h[1]); o.y = cvt_pk_bf16(h[2], h[3]); *(u32x2*)(ha + (size_t)row * 1024 + col) = o; }
    }
}

__device__ __forceinline__ void ld8bf(const bf16_t* p, float (&o)[8]) { const u32x4 v = *(const u32x4*)p; o[0] = bflo(v.x); o[1] = bfhi(v.x); o[2] = bflo(v.y); o[3] = bfhi(v.y); o[4] = bflo(v.z); o[5] = bfhi(v.z); o[6] = bflo(v.w); o[7] = bfhi(v.w); }
__device__ __forceinline__ u32x4 pk8(const float (&o)[8]) { u32x4 w; w.x = cvt_pk_bf16(o[0], o[1]); w.y = cvt_pk_bf16(o[2], o[3]); w.z = cvt_pk_bf16(o[4], o[5]); w.w = cvt_pk_bf16(o[6], o[7]); return w; }
#define MFMA16(a, b, c) __builtin_amdgcn_mfma_f32_16x16x32_bf16((a), (b), (c), 0, 0, 0)
#define MFMA32(a, b, c) __builtin_amdgcn_mfma_f32_32x32x16_bf16((a), (b), (c), 0, 0, 0)

__device__ __forceinline__ void mix_mla(const Ctx& c_, int l, int r0) { const Ctx c = fresh(c_);
    const bf16_t* Z = c.w<bf16_t>(WS_Z); bf16_t* Aq = (bf16_t*)c.lds; bf16_t* Akv = (bf16_t*)(c.lds + 12800); float* Lkr = (float*)(c.lds + 21504);
    {
        const int t = c.tid >> 4, sub = c.tid & 15; const bf16_t* zr = Z + (size_t)(r0 + t) * ZP;
        const float* qag = c.inf(I_QAG) + l * 192; const float* kvag = c.inf(I_KVAG) + l * 128;
        float a0[8], a1[8], k0[8]; float ssq = 0.f, ssk = 0.f;
        ld8bf(zr + Z_CQ + sub * 8, a0);
#pragma unroll
        for (int j = 0; j < 8; ++j) ssq += a0[j] * a0[j];
        if (sub < 8) { ld8bf(zr + Z_CQ + 128 + sub * 8, a1);
#pragma unroll
            for (int j = 0; j < 8; ++j) ssq += a1[j] * a1[j]; }
        ld8bf(zr + Z_CKV + sub * 8, k0);
#pragma unroll
        for (int j = 0; j < 8; ++j) ssk += k0[j] * k0[j];
#pragma unroll
        for (int m = 1; m < 16; m <<= 1) { ssq += __shfl_xor(ssq, m); ssk += __shfl_xor(ssk, m); }
        const float rq = frsqrt(ssq * (1.0f / 192.0f) + EPS), rk = frsqrt(ssk * (1.0f / 128.0f) + EPS);
#pragma unroll
        for (int j = 0; j < 8; ++j) a0[j] *= rq * qag[sub * 8 + j];
        *(u32x4*)(Aq + t * 200 + sub * 8) = pk8(a0);
        if (sub < 8) {
#pragma unroll
            for (int j = 0; j < 8; ++j) a1[j] *= rq * qag[128 + sub * 8 + j];
            *(u32x4*)(Aq + t * 200 + 128 + sub * 8) = pk8(a1); }
#pragma unroll
        for (int j = 0; j < 8; ++j) k0[j] *= rk * kvag[sub * 8 + j];
        *(u32x4*)(Akv + t * 136 + sub * 8) = pk8(k0);
        if (sub < 4) { float kr[8]; ld8bf(zr + Z_KR + sub * 8, kr);
#pragma unroll
            for (int j = 0; j < 8; ++j) Lkr[t * 32 + sub * 8 + j] = kr[j]; }
    }
    __syncthreads();
    const int fr = c.lane & 15, fq = c.lane >> 4; const int b = r0 / SEQ, s0 = r0 % SEQ;
    const float* rcos = c.w<float>(WS_ROPE); const float* rsin = rcos + (size_t)NTOK * 16;
    if (c.wid < 4) {
        const int h = c.wid; const bf16_t* W = c.w<bf16_t>(WS_WUQ) + (size_t)(96 * h) * 192; const float* qg = c.inf(I_QG) + l * 96;
        f32x4 acc[6][2];
#pragma unroll
        for (int nf = 0; nf < 6; ++nf) { acc[nf][0] = (f32x4){0.f, 0.f, 0.f, 0.f}; acc[nf][1] = acc[nf][0]; }
#pragma unroll 1
        for (int ks = 0; ks < 6; ++ks) { bf16x8 af[2];
#pragma unroll
            for (int mf = 0; mf < 2; ++mf) af[mf] = *(const bf16x8*)(Aq + (mf * 16 + fr) * 200 + ks * 32 + fq * 8);
#pragma unroll
            for (int nf = 0; nf < 6; ++nf) { const bf16x8 bfr = *(const bf16x8*)(W + (size_t)(16 * nf + fr) * 192 + ks * 32 + fq * 8);
                acc[nf][0] = MFMA16(bfr, af[0], acc[nf][0]); acc[nf][1] = MFMA16(bfr, af[1], acc[nf][1]); } }
#pragma unroll
        for (int mf = 0; mf < 2; ++mf) { float ss = 0.f;
#pragma unroll
            for (int nf = 0; nf < 6; ++nf)
#pragma unroll
                for (int j = 0; j < 4; ++j) ss += acc[nf][mf][j] * acc[nf][mf][j];
            ss += __shfl_xor(ss, 16); ss += __shfl_xor(ss, 32);
            const float rinv = frsqrt(ss * (1.0f / 96.0f) + EPS) * (0.10206207261596575f * 1.44269504089f);
            const int tok = r0 + mf * 16 + fr; bf16_t* qo = c.w<bf16_t>(WS_Q) + ((size_t)(b * 4 + h) * SEQ + s0 + mf * 16 + fr) * 96;
            float v[6][4];
#pragma unroll
            for (int nf = 0; nf < 6; ++nf)
#pragma unroll
                for (int j = 0; j < 4; ++j) v[nf][j] = acc[nf][mf][j] * rinv * qg[16 * nf + 4 * fq + j];
#pragma unroll
            for (int j = 0; j < 4; ++j) { const float cs = rcos[(size_t)tok * 16 + 4 * fq + j], sn = rsin[(size_t)tok * 16 + 4 * fq + j]; const float x1 = v[4][j], x2 = v[5][j]; v[4][j] = x1 * cs - x2 * sn; v[5][j] = x1 * sn + x2 * cs; }
#pragma unroll
            for (int nf = 0; nf < 6; ++nf) { u32x2 o; o.x = cvt_pk_bf16(v[nf][0], v[nf][1]); o.y = cvt_pk_bf16(v[nf][2], v[nf][3]); *(u32x2*)(qo + 16 * nf + 4 * fq) = o; } }
    } else {
        const int h = c.wid - 4; const bf16_t* W = c.w<bf16_t>(WS_WUKV) + (size_t)(128 * h) * 128; const float* kg = c.inf(I_KG) + l * 96;
        f32x4 ak[4][2], av[4][2];
#pragma unroll
        for (int nf = 0; nf < 4; ++nf) { ak[nf][0] = (f32x4){0.f, 0.f, 0.f, 0.f}; ak[nf][1] = ak[nf][0]; av[nf][0] = ak[nf][0]; av[nf][1] = ak[nf][0]; }
#pragma unroll 1
        for (int ks = 0; ks < 4; ++ks) { bf16x8 af[2];
#pragma unroll
            for (int mf = 0; mf < 2; ++mf) af[mf] = *(const bf16x8*)(Akv + (mf * 16 + fr) * 136 + ks * 32 + fq * 8);
#pragma unroll
            for (int nf = 0; nf < 4; ++nf) { const bf16x8 bk = *(const bf16x8*)(W + (size_t)(16 * nf + fr) * 128 + ks * 32 + fq * 8), bv = *(const bf16x8*)(W + (size_t)(64 + 16 * nf + fr) * 128 + ks * 32 + fq * 8);
                ak[nf][0] = MFMA16(bk, af[0], ak[nf][0]); ak[nf][1] = MFMA16(bk, af[1], ak[nf][1]);
                av[nf][0] = MFMA16(af[0], bv, av[nf][0]); av[nf][1] = MFMA16(af[1], bv, av[nf][1]); } }
#pragma unroll
        for (int mf = 0; mf < 2; ++mf) { const int tl = mf * 16 + fr; float ss = 0.f;
#pragma unroll
            for (int nf = 0; nf < 4; ++nf)
#pragma unroll
                for (int j = 0; j < 4; ++j) ss += ak[nf][mf][j] * ak[nf][mf][j];
#pragma unroll
            for (int j = 0; j < 8; ++j) { const float kr = Lkr[tl * 32 + fq * 8 + j]; ss += kr * kr; }
            ss += __shfl_xor(ss, 16); ss += __shfl_xor(ss, 32);
            const float rinv = frsqrt(ss * (1.0f / 96.0f) + EPS);
            const int tok = r0 + tl; bf16_t* ko = c.w<bf16_t>(WS_K) + ((size_t)(b * 4 + h) * SEQ + s0 + tl) * 96;
#pragma unroll
            for (int nf = 0; nf < 4; ++nf) { u32x2 o; o.x = cvt_pk_bf16(ak[nf][mf][0] * rinv * kg[16 * nf + 4 * fq], ak[nf][mf][1] * rinv * kg[16 * nf + 4 * fq + 1]);
                o.y = cvt_pk_bf16(ak[nf][mf][2] * rinv * kg[16 * nf + 4 * fq + 2], ak[nf][mf][3] * rinv * kg[16 * nf + 4 * fq + 3]); *(u32x2*)(ko + 16 * nf + 4 * fq) = o; }
            float o1[4], o2[4];
#pragma unroll
            for (int j = 0; j < 4; ++j) { const int i = 4 * fq + j; const float x1 = Lkr[tl * 32 + i] * rinv * kg[64 + i], x2 = Lkr[tl * 32 + 16 + i] * rinv * kg[80 + i];
                const float cs = rcos[(size_t)tok * 16 + i], sn = rsin[(size_t)tok * 16 + i]; o1[j] = x1 * cs - x2 * sn; o2[j] = x1 * sn + x2 * cs; }
            { u32x2 o; o.x = cvt_pk_bf16(o1[0], o1[1]); o.y = cvt_pk_bf16(o1[2], o1[3]); *(u32x2*)(ko + 64 + 4 * fq) = o; o.x = cvt_pk_bf16(o2[0], o2[1]); o.y = cvt_pk_bf16(o2[2], o2[3]); *(u32x2*)(ko + 80 + 4 * fq) = o; }
            bf16_t* vo = c.w<bf16_t>(WS_VT) + (size_t)(b * 4 + h) * 64 * SEQ + s0 + mf * 16 + 4 * fq;
#pragma unroll
            for (int nf = 0; nf < 4; ++nf) { u32x2 o; o.x = cvt_pk_bf16(av[nf][mf][0], av[nf][mf][1]); o.y = cvt_pk_bf16(av[nf][mf][2], av[nf][mf][3]); *(u32x2*)(vo + (size_t)(16 * nf + fr) * SEQ) = o; } }
    }
    __syncthreads();
}
__device__ __forceinline__ void mix_pool(const Ctx& c_, int l, int r0) { const Ctx c = fresh(c_);
    const bf16_t* Z = c.w<bf16_t>(WS_Z); float* Lu = (float*)c.lds; bf16_t* Lp = (bf16_t*)(c.lds + 48128); const int s0 = r0 % SEQ;
    for (int ch = c.tid; ch < 47 * 32; ch += 512) { const int row = ch >> 5, c8 = ch & 31, s = s0 - 15 + row; float v[8];
        if (s >= 0) ld8bf(Z + (size_t)(r0 - 15 + row) * ZP + Z_POOL + c8 * 8, v); else {
#pragma unroll
            for (int j = 0; j < 8; ++j) v[j] = 0.f; }
        *(f32x4*)(Lu + row * 256 + c8 * 8) = (f32x4){v[0], v[1], v[2], v[3]}; *(f32x4*)(Lu + row * 256 + c8 * 8 + 4) = (f32x4){v[4], v[5], v[6], v[7]}; }
    __syncthreads();
    { const int t = c.tid >> 4, sub = c.tid & 15, g = sub >> 2, w = 2 << g, s = s0 + t; const float inv = 1.0f / (float)((s + 1 < w) ? (s + 1) : w);
#pragma unroll
        for (int k = 0; k < 2; ++k) { const int col = sub * 16 + k * 8; float sum[8];
#pragma unroll
            for (int j = 0; j < 8; ++j) sum[j] = 0.f;
            for (int d = 0; d < w; ++d) { const float* p = Lu + (t + 15 - d) * 256 + col;
#pragma unroll
                for (int j = 0; j < 8; ++j) sum[j] += p[j]; }
            const float* p0 = Lu + (t + 15) * 256 + col;
#pragma unroll
            for (int j = 0; j < 8; ++j) sum[j] = sum[j] * inv - p0[j];
            *(u32x4*)(Lp + t * 264 + col) = pk8(sum); } }
    __syncthreads();
    { const int fr = c.lane & 15, fq = c.lane >> 4, g = c.wid >> 1, mf = c.wid & 1; const bf16_t* W = c.w<bf16_t>(WS_WPOOL) + g * 4096; const float* ps = c.inf(I_PSCALE) + l * 256 + g * 64;
        f32x4 acc[4];
#pragma unroll
        for (int nf = 0; nf < 4; ++nf) acc[nf] = (f32x4){0.f, 0.f, 0.f, 0.f};
#pragma unroll
        for (int ks = 0; ks < 2; ++ks) { const bf16x8 af = *(const bf16x8*)(Lp + (mf * 16 + fr) * 264 + g * 64 + ks * 32 + fq * 8);
#pragma unroll
            for (int nf = 0; nf < 4; ++nf) { const bf16x8 bfr = *(const bf16x8*)(W + (16 * nf + fr) * 64 + ks * 32 + fq * 8); acc[nf] = MFMA16(bfr, af, acc[nf]); } }
        bf16_t* yo = c.w<bf16_t>(WS_YB) + (size_t)(r0 + mf * 16 + fr) * 1024 + 256 + g * 64;
#pragma unroll
        for (int nf = 0; nf < 4; ++nf) { const int d = 16 * nf + 4 * fq; u32x2 o; o.x = cvt_pk_bf16(acc[nf][0] * ps[d], acc[nf][1] * ps[d + 1]); o.y = cvt_pk_bf16(acc[nf][2] * ps[d + 2], acc[nf][3] * ps[d + 3]); *(u32x2*)(yo + d) = o; } }
    __syncthreads();
}
__device__ __forceinline__ void mix_conv(const Ctx& c_, int l, int r0) { const Ctx c = fresh(c_);
    const bf16_t* Z = c.w<bf16_t>(WS_Z); float* Lcu = (float*)c.lds; float* Lco = (float*)(c.lds + 63488); const int s0 = r0 % SEQ;
    for (int ch = c.tid; ch < 62 * 32; ch += 512) { const int row = ch >> 5, c8 = ch & 31, s = s0 - 30 + row; float a[8], g[8];
        if (s >= 0) { ld8bf(Z + (size_t)(r0 - 30 + row) * ZP + Z_CA + c8 * 8, a); ld8bf(Z + (size_t)(r0 - 30 + row) * ZP + Z_CG + c8 * 8, g);
#pragma unroll
            for (int j = 0; j < 8; ++j) a[j] *= fsigmoid(g[j]); } else {
#pragma unroll
            for (int j = 0; j < 8; ++j) a[j] = 0.f; }
        *(f32x4*)(Lcu + row * 256 + c8 * 8) = (f32x4){a[0], a[1], a[2], a[3]}; *(f32x4*)(Lcu + row * 256 + c8 * 8 + 4) = (f32x4){a[4], a[5], a[6], a[7]}; }
    __syncthreads();
    { const int chn = c.tid & 255, half = c.tid >> 8; const float* dw = c.inf(I_DWW) + (size_t)l * 31 * 256 + chn; const float bias = c.inf(I_DWB)[l * 256 + chn];
        float wv[31];
#pragma unroll
        for (int j = 0; j < 31; ++j) wv[j] = dw[j * 256];
        for (int tt = 0; tt < 16; ++tt) { const int t = half * 16 + tt; float acc = bias;
#pragma unroll
            for (int j = 0; j < 31; ++j) acc += wv[j] * Lcu[(t + j) * 256 + chn];
            Lco[t * 256 + chn] = acc; } }
    __syncthreads();
    { const float* lg = c.inf(I_LNG) + l * 256 + c.lane * 4; const float* lb = c.inf(I_LNB) + l * 256 + c.lane * 4;
        for (int k = 0; k < 4; ++k) { const int t = c.wid * 4 + k; const f32x4 v = *(const f32x4*)(Lco + t * 256 + c.lane * 4);
            const float mean = wave_sum(v[0] + v[1] + v[2] + v[3]) * (1.0f / 256.0f); const f32x4 d = v - mean;
            const float var = wave_sum(d[0] * d[0] + d[1] * d[1] + d[2] * d[2] + d[3] * d[3]) * (1.0f / 256.0f); const float rs = frsqrt(var + EPS);
            float y[4];
#pragma unroll
            for (int j = 0; j < 4; ++j) y[j] = fsilu(d[j] * rs * lg[j] + lb[j]);
            u32x2 o; o.x = cvt_pk_bf16(y[0], y[1]); o.y = cvt_pk_bf16(y[2], y[3]); *(u32x2*)(c.w<bf16_t>(WS_YB) + (size_t)(r0 + t) * 1024 + 768 + c.lane * 4) = o; } }
    __syncthreads();
}
template <bool OUT> __device__ __forceinline__ void hgrn_scan(const Ctx& c_, int l, int bu) { const Ctx c = fresh(c_);
    const int us = c.wid >> 1, dh = c.wid & 1, cu = bu * 4 + us, bh = cu / NCH, chunk = cu % NCH, b = bh >> 2, h = bh & 3, tok0 = b * SEQ + chunk * 128;
    const bf16_t* Z = c.w<bf16_t>(WS_Z); const float* lbv = c.w<float>(WS_LB) + l * 256 + h * 64;
    float* Lf = (float*)(c.lds + us * 20480); float* Lq = Lf + 1024; float* Lv = Lq + 1024; float* Lo = Lv + 1024;
    float* SC = c.w<float>(WS_SC); float* PC = c.w<float>(WS_PC);
    float S[32];
#pragma unroll
    for (int d = 0; d < 32; ++d) S[d] = 0.f;
    float P = 1.0f;
    if (OUT) { for (int j = 0; j < chunk; ++j) { const float* sc = SC + ((size_t)(bh * NCH + j) * 64 + dh * 32) * 64 + c.lane; const float* pc = PC + (size_t)(bh * NCH + j) * 64 + dh * 32;
#pragma unroll
            for (int d = 0; d < 32; ++d) S[d] = pc[d] * S[d] + sc[d * 64]; } }
    const int tl = dh * 64 + c.lane; const float og = OUT ? c.inf(I_HOG)[l * 64 + c.lane] : 0.f;
    for (int sb = 0; sb < 8; ++sb) {
#pragma unroll
        for (int i = 0; i < 8; ++i) { const int idx = tl + 128 * i, t = idx >> 6, d = idx & 63; const bf16_t* zr = Z + (size_t)(tok0 + sb * 16 + t) * ZP + h * 64 + d;
            const float lb = lbv[d]; Lf[idx] = lb + (1.0f - lb) * fsigmoid(bf2f(zr[Z_HF])); Lv[idx] = bf2f(zr[Z_HI]); if (OUT) Lq[idx] = fsilu(bf2f(zr[Z_HQ])); }
        __syncthreads();
        for (int t = 0; t < 16; ++t) { const float v = Lv[t * 64 + c.lane]; float o = 0.f;
#pragma unroll
            for (int d4 = 0; d4 < 8; ++d4) { const f32x4 f = *(const f32x4*)(Lf + t * 64 + dh * 32 + d4 * 4); f32x4 q; if (OUT) q = *(const f32x4*)(Lq + t * 64 + dh * 32 + d4 * 4);
#pragma unroll
                for (int k = 0; k < 4; ++k) { const int d = d4 * 4 + k; S[d] = v + f[k] * (S[d] - v); if (OUT) o += S[d] * q[k]; } }
            if (OUT) Lo[(dh * 16 + t) * 64 + c.lane] = o; else P *= Lf[t * 64 + dh * 32 + (c.lane & 31)]; }
        __syncthreads();
        if (OUT) { for (int k = 0; k < 8; ++k) { const int t = dh * 8 + k, tok = tok0 + sb * 16 + t; const float o = Lo[t * 64 + c.lane] + Lo[(16 + t) * 64 + c.lane];
                const float ss = wave_sum(o * o); const float g = bf2f(Z[(size_t)tok * ZP + Z_HG + h * 64 + c.lane]);
                c.w<bf16_t>(WS_YB)[(size_t)tok * 1024 + 512 + h * 64 + c.lane] = (bf16_t)f2bf_bits(o * frsqrt(ss * (1.0f / 64.0f) + EPS) * og * fsilu(g)); } }
    }
    if (!OUT) { float* sc = SC + ((size_t)(bh * NCH + chunk) * 64 + dh * 32) * 64 + c.lane;
#pragma unroll
        for (int d = 0; d < 32; ++d) sc[d * 64] = S[d];
        if (c.lane < 32) PC[(size_t)(bh * NCH + chunk) * 64 + dh * 32 + c.lane] = P; }
    __syncthreads();
}
__device__ __forceinline__ void ph_mixers(const Ctx& c, int l) {
    for (int u = c.blk; u < NTOK / 32; u += c.G) { mix_mla(c, l, u * 32); mix_pool(c, l, u * 32); mix_conv(c, l, u * 32); }
    for (int bu = c.blk; bu < NBH * NCH / 4; bu += c.G) hgrn_scan<false>(c, l, bu);
}

__device__ __forceinline__ void attn_unit(const Ctx& c_, int bh, int qt) { const Ctx c = fresh(c_);
    const bf16_t* Qg = c.w<bf16_t>(WS_Q) + (size_t)bh * SEQ * 96; const bf16_t* Kg = c.w<bf16_t>(WS_K) + (size_t)bh * SEQ * 96; const bf16_t* Vg = c.w<bf16_t>(WS_VT) + (size_t)bh * 64 * SEQ;
    constexpr int KROW = 104, VROW = 72, KB = 64 * KROW * 2, VB = 64 * VROW * 2;
    const int l31 = c.lane & 31, hi = c.lane >> 5, qrow = qt * 256 + c.wid * 32 + l31;
    bf16x8 qf[6];
#pragma unroll
    for (int ks = 0; ks < 6; ++ks) qf[ks] = *(const bf16x8*)(Qg + (size_t)qrow * 96 + ks * 16 + hi * 8);
    f32x16 o0, o1;
#pragma unroll
    for (int r = 0; r < 16; ++r) { o0[r] = 0.f; o1[r] = 0.f; }
    float mrun = -INFINITY, lsum = 0.f;
    const int nkt = 4 * (qt + 1), mylast = 4 * qt + (c.wid >> 1);
    const int kr0 = c.tid / 12, kc0 = c.tid % 12, kr1 = (c.tid + 512) / 12, kc1 = (c.tid + 512) % 12, vr = c.tid >> 3, vc = c.tid & 7;
    u32x4 sk0, sk1, sv;
    auto gload = [&](int kt) { sk0 = *(const u32x4*)(Kg + (size_t)(kt * 64 + kr0) * 96 + kc0 * 8); if (c.tid < 256) sk1 = *(const u32x4*)(Kg + (size_t)(kt * 64 + kr1) * 96 + kc1 * 8);
                               sv = *(const u32x4*)(Vg + (size_t)vr * SEQ + kt * 64 + vc * 8); };
    auto lstore = [&](int buf) { unsigned char* kb = c.lds + buf * (KB + VB); unsigned char* vb = kb + KB;
                                 *(u32x4*)(kb + (kr0 * KROW + kc0 * 8) * 2) = sk0; if (c.tid < 256) *(u32x4*)(kb + (kr1 * KROW + kc1 * 8) * 2) = sk1; *(u32x4*)(vb + (vr * VROW + vc * 8) * 2) = sv; };
    gload(0); lstore(0); __syncthreads();
    for (int kt = 0; kt < nkt; ++kt) {
        if (kt + 1 < nkt) gload(kt + 1);
        if (kt <= mylast) {
            const bf16_t* kb = (const bf16_t*)(c.lds + (kt & 1) * (KB + VB)); const bf16_t* vb = (const bf16_t*)(c.lds + (kt & 1) * (KB + VB) + KB);
            f32x16 s0, s1;
#pragma unroll
            for (int r = 0; r < 16; ++r) { s0[r] = 0.f; s1[r] = 0.f; }
#pragma unroll
            for (int ks = 0; ks < 6; ++ks) { const bf16x8 k0 = *(const bf16x8*)(kb + l31 * KROW + ks * 16 + hi * 8), k1 = *(const bf16x8*)(kb + (32 + l31) * KROW + ks * 16 + hi * 8);
                s0 = MFMA32(k0, qf[ks], s0); s1 = MFMA32(k1, qf[ks], s1); }
            if (kt == mylast) {
#pragma unroll
                for (int r = 0; r < 16; ++r) { const int key = kt * 64 + (r & 3) + 8 * (r >> 2) + 4 * hi; if (key > qrow) s0[r] = -INFINITY; if (key + 32 > qrow) s1[r] = -INFINITY; } }
            float mx = s0[0];
#pragma unroll
            for (int r = 1; r < 16; ++r) mx = fmaxf(mx, s0[r]);
#pragma unroll
            for (int r = 0; r < 16; ++r) mx = fmaxf(mx, s1[r]);
            mx = fmaxf(mx, __shfl_xor(mx, 32));
            const float mnew = fmaxf(mrun, mx), alpha = __builtin_amdgcn_exp2f(mrun - mnew); mrun = mnew;
            float ps = 0.f;
#pragma unroll
            for (int r = 0; r < 16; ++r) { s0[r] = __builtin_amdgcn_exp2f(s0[r] - mnew); s1[r] = __builtin_amdgcn_exp2f(s1[r] - mnew); ps += s0[r] + s1[r]; }
            lsum = lsum * alpha + ps;
#pragma unroll
            for (int r = 0; r < 16; ++r) { o0[r] *= alpha; o1[r] *= alpha; }
#pragma unroll
            for (int kf = 0; kf < 2; ++kf)
#pragma unroll
                for (int s = 0; s < 2; ++s) { const f32x16& sx = kf ? s1 : s0; u32x4 pw; pw.x = cvt_pk_bf16(sx[8 * s], sx[8 * s + 1]); pw.y = cvt_pk_bf16(sx[8 * s + 2], sx[8 * s + 3]); pw.z = cvt_pk_bf16(sx[8 * s + 4], sx[8 * s + 5]); pw.w = cvt_pk_bf16(sx[8 * s + 6], sx[8 * s + 7]);
                    const bf16x8 pf = __builtin_bit_cast(bf16x8, pw); const int kcol = kf * 32 + 16 * s + 4 * hi;
                    const s16x4 a0 = *(const s16x4*)(vb + l31 * VROW + kcol), a1 = *(const s16x4*)(vb + l31 * VROW + kcol + 8), b0 = *(const s16x4*)(vb + (32 + l31) * VROW + kcol), b1 = *(const s16x4*)(vb + (32 + l31) * VROW + kcol + 8);
                    const bf16x8 v0 = (bf16x8){a0[0], a0[1], a0[2], a0[3], a1[0], a1[1], a1[2], a1[3]}, v1 = (bf16x8){b0[0], b0[1], b0[2], b0[3], b1[0], b1[1], b1[2], b1[3]};
                    o0 = MFMA32(v0, pf, o0); o1 = MFMA32(v1, pf, o1); }
        }
        if (kt + 1 < nkt) lstore((kt + 1) & 1);
        __syncthreads();
    }
    lsum += __shfl_xor(lsum, 32); const float rl = 1.0f / lsum;
    const int b = bh >> 2, h = bh & 3; bf16_t* yo = c.w<bf16_t>(WS_YB) + (size_t)(b * SEQ + qrow) * 1024 + h * 64;
#pragma unroll
    for (int g = 0; g < 4; ++g) { const int dv = 8 * g + 4 * hi; u32x2 w0, w1;
        w0.x = cvt_pk_bf16(o0[4 * g] * rl, o0[4 * g + 1] * rl); w0.y = cvt_pk_bf16(o0[4 * g + 2] * rl, o0[4 * g + 3] * rl); *(u32x2*)(yo + dv) = w0;
        w1.x = cvt_pk_bf16(o1[4 * g] * rl, o1[4 * g + 1] * rl); w1.y = cvt_pk_bf16(o1[4 * g + 2] * rl, o1[4 * g + 3] * rl); *(u32x2*)(yo + 32 + dv) = w1; }
    __syncthreads();
}
__device__ __forceinline__ void ph_attn(const Ctx& c, int l) {
    for (int pu = c.blk; pu < NBH * (NQT / 2); pu += c.G) { const int bh = pu / (NQT / 2), p = pu % (NQT / 2); attn_unit(c, bh, NQT - 1 - p); attn_unit(c, bh, p); }
    for (int bu = c.blk; bu < NBH * NCH / 4; bu += c.G) hgrn_scan<true>(c, l, bu);
}

__device__ __forceinline__ void ph_router(const Ctx& c_, int l) { const Ctx c = fresh(c_);
    float* RW = (float*)c.lds;
    int* Le = (int*)(c.lds + 147456); float* Lw = (float*)(c.lds + 147456 + 1024); int* Lr = (int*)(c.lds + 147456 + 2048); int* Lcnt = (int*)(c.lds + 147456 + 3072); int* Lbase = Lcnt + 32;
    const float* rgw = c.inf(I_RGW) + (size_t)l * 1024 * 4; const float* rew = c.inf(I_REW) + (size_t)l * 1024 * 32;
    for (int e = c.tid; e < 1024 * 4; e += 512) RW[(e & 3) * 1024 + (e >> 2)] = rgw[e];
    for (int e = c.tid; e < 1024 * 32; e += 512) RW[(4 + (e & 31)) * 1024 + (e >> 5)] = rew[e];
    const float* rgb = c.inf(I_RGB) + l * 4; const float* reb = c.inf(I_REB) + l * 32;
    const float* x = c.a->out; const float* gn = c.inf(I_N2G) + l * 1024; const float* mod = c.w<float>(WS_MOD) + (size_t)l * NB * 6144; bf16_t* ha = c.w<bf16_t>(WS_HA);
    unsigned* cnt = (unsigned*)(c.ws + WS_CTL + CTL_CNT) + l * 32;
    int* asge = c.w<int>(WS_ASGE); int* asgr = c.w<int>(WS_ASGR); float* asgw = c.w<float>(WS_ASGW);
    __syncthreads();
    for (int u = c.blk; u < NTOK / 128; u += c.G) {
        if (c.tid < 32) Lcnt[c.tid] = 0;
        __syncthreads();
        for (int k = 0; k < 16; ++k) { const int rl = c.wid * 16 + k, row = u * 128 + rl, b = row / SEQ; const float* sh = mod + b * 6144 + 3072; const float* sc = sh + 1024;
            f32x4 v[4]; float ss = 0.f;
#pragma unroll
            for (int i = 0; i < 4; ++i) { v[i] = *(const f32x4*)(x + (size_t)row * 1024 + i * 256 + c.lane * 4); ss += v[i][0] * v[i][0] + v[i][1] * v[i][1] + v[i][2] * v[i][2] + v[i][3] * v[i][3]; }
            ss = wave_sum(ss); const float rinv = frsqrt(ss * (1.0f / 1024.0f) + EPS);
#pragma unroll
            for (int i = 0; i < 4; ++i) { const int col = i * 256 + c.lane * 4; v[i] = v[i] * rinv * (*(const f32x4*)(gn + col)) * (*(const f32x4*)(sc + col) + 1.0f) + *(const f32x4*)(sh + col);
                u32x2 o; o.x = cvt_pk_bf16(v[i][0], v[i][1]); o.y = cvt_pk_bf16(v[i][2], v[i][3]); *(u32x2*)(ha + (size_t)row * 1024 + col) = o; }
            float lg[36];
#pragma unroll
            for (int g = 0; g < 36; ++g) { float s = 0.f;
#pragma unroll
                for (int i = 0; i < 4; ++i) { const f32x4 w = *(const f32x4*)(RW + g * 1024 + i * 256 + c.lane * 4); s += v[i][0] * w[0] + v[i][1] * w[1] + v[i][2] * w[2] + v[i][3] * w[3]; }
                lg[g] = wave_sum(s); }
            int gi = 0; float gm = lg[0] + rgb[0];
#pragma unroll
            for (int g = 1; g < 4; ++g) { const float t = lg[g] + rgb[g]; if (t > gm) { gm = t; gi = g; } }
            float den = 0.f;
#pragma unroll
            for (int g = 0; g < 4; ++g) den += expf(lg[g] + rgb[g] - gm);
            const float gw = 1.0f / den;
            float e1 = -INFINITY, e2 = -INFINITY; int i1 = 0, i2 = 0;
#pragma unroll
            for (int g = 0; g < 4; ++g) if (g == gi) {
#pragma unroll
                for (int j = 0; j < 8; ++j) { const float t = lg[4 + g * 8 + j] + reb[g * 8 + j]; if (t > e1) { e2 = e1; i2 = i1; e1 = t; i1 = j; } else if (t > e2) { e2 = t; i2 = j; } } }
            const float p2 = expf(e2 - e1), w1 = gw / (1.0f + p2), w2 = gw * p2 / (1.0f + p2);
            if (c.lane == 0) { const int ea = gi * 8 + i1, eb = gi * 8 + i2; Le[rl * 2] = ea; Le[rl * 2 + 1] = eb; Lw[rl * 2] = w1; Lw[rl * 2 + 1] = w2;
                Lr[rl * 2] = atomicAdd(&Lcnt[ea], 1); Lr[rl * 2 + 1] = atomicAdd(&Lcnt[eb], 1); }
        }
        __syncthreads();
        if (c.tid < 32) Lbase[c.tid] = (int)__hip_atomic_fetch_add(&cnt[c.tid], (unsigned)Lcnt[c.tid], __ATOMIC_RELAXED, __HIP_MEMORY_SCOPE_AGENT);
        __syncthreads();
        if (c.tid < 256) { const int a = u * 256 + c.tid, e = Le[c.tid]; asge[a] = e; asgr[a] = Lbase[e] + Lr[c.tid]; asgw[a] = Lw[c.tid]; }
        __syncthreads();
    }
}
__device__ __forceinline__ void ph_gather(const Ctx& c_, int l) { const Ctx c = fresh(c_);
    int* Lps = (int*)c.lds; int* Lcn = Lps + 40;
    unsigned* cnt = (unsigned*)(c.ws + WS_CTL + CTL_CNT) + l * 32;
    if (c.tid == 0) { int acc = 0; for (int e = 0; e < 32; ++e) { const int n = (int)__hip_atomic_load(&cnt[e], __ATOMIC_RELAXED, __HIP_MEMORY_SCOPE_AGENT); Lcn[e] = n; Lps[e] = acc; acc += (n + 255) / 256 * 256; } Lps[32] = acc; }
    __syncthreads();
    int* rowtok = c.w<int>(WS_ROWTOK); float* roww = c.w<float>(WS_ROWW);
    if (c.blk == 0) { int* tile = c.w<int>(WS_TILE); if (c.tid == 0) tile[0] = Lps[32] / 256;
        for (int e = c.tid; e < 32; e += 512) for (int t = Lps[e] / 256; t < Lps[e + 1] / 256; ++t) tile[1 + t] = e; }
    for (int e = c.blk; e < 32; e += c.G) for (int r = Lps[e] + Lcn[e] + c.tid; r < Lps[e + 1]; r += 512) rowtok[r] = -1;
    const int* asge = c.w<int>(WS_ASGE); const int* asgr = c.w<int>(WS_ASGR); const float* asgw = c.w<float>(WS_ASGW);
    const bf16_t* ha = c.w<bf16_t>(WS_HA); bf16_t* xg = c.w<bf16_t>(WS_Z);
    for (int a = c.blk * 8 + c.wid; a < NTOK * 2; a += c.G * 8) { const int tok = a >> 1, dest = Lps[asge[a]] + asgr[a];
        if (c.lane == 0) { rowtok[dest] = a; roww[dest] = asgw[a]; }
        const u32x4* s = (const u32x4*)(ha + (size_t)tok * 1024); u32x4* d = (u32x4*)(xg + (size_t)dest * 1024); d[c.lane] = s[c.lane]; d[64 + c.lane] = s[64 + c.lane]; }
}
__device__ __forceinline__ void ph_final(const Ctx& c_) { const Ctx c = fresh(c_);
    float* out = c.a->out; const bf16_t* y1 = c.w<bf16_t>(WS_Y1);
    for (size_t e = (size_t)c.blk * 512 + c.tid; e < (size_t)NTOK * 256; e += (size_t)c.G * 512) { const u32x2 y = *(const u32x2*)(y1 + e * 4); f32x4 v = *(const f32x4*)(out + e * 4);
        v += (f32x4){bflo(y.x), bfhi(y.x), bflo(y.y), bfhi(y.y)}; *(f32x4*)(out + e * 4) = v; }
}

constexpr int PH_PER_LAYER = 9, N_PHASES = 2 + PH_PER_LAYER * NL + 1;
__global__ void __launch_bounds__(512, 2) mk_fwd(Args args) {
#ifdef EMU
    unsigned char* lds = emu_lds();
#else
    extern __shared__ __attribute__((aligned(16))) unsigned char lds[];
#endif
    Ctx c; c.a = &args; c.ws = args.ws; c.lds = lds; c.tid = threadIdx.x; c.wid = __builtin_amdgcn_readfirstlane(c.tid >> 6); c.lane = c.tid & 63; c.G = gridDim.x; c.blk = blockIdx.x;
    if (c.tid == 0) *(uint4*)(lds + LDS_XB) = make_uint4(0u, 0u, 0u, 0u);
    __syncthreads();
    XcdBarrier bar; bar.bar = (unsigned*)(args.ws + WS_CTL); bar.x = 0; bar.st = (volatile LAS unsigned*)(lds + LDS_XB);
    if (args.ph_hi - args.ph_lo > 1) bar = xcd_barrier_post((unsigned*)(args.ws + WS_CTL), (volatile LAS unsigned*)(lds + LDS_XB));
    int ph = 0;
#ifndef PHMASK
#define PHMASK 0xFFFFF
#endif
#define PHASE(K, ...) do { if (ph >= args.ph_lo && ph < args.ph_hi) { if constexpr ((PHMASK >> K) & 1) { __VA_ARGS__; } if (ph + 1 < args.ph_hi) xcd_barrier(bar); } ++ph; } while (0)
    PHASE(0, ph_prologue0(c));
    PHASE(1, ph_prologue1(c));
    for (int l = 0; l < NL; ++l) {
        PHASE(2, ph_norm1(c, l));
        PHASE(3, { pg8::Gemm g{c.w<bf16_t>(WS_HA), c.w<bf16_t>(WS_WIN), NTOK, ZP, 1024}; pg8::StaticOrder S; S.init(NTOK, ZP, c.G, c.blk); pg8::EpiBf16 E{c.w<bf16_t>(WS_Z), ZP};
                pg8::gemm_phase<pg8::EpiBf16, pg8::StaticOrder, true, true>((LAS unsigned char*)lds, g, S, E); });
        PHASE(4, ph_mixers(c, l));
        PHASE(5, ph_attn(c, l));
        PHASE(6, { pg8::Gemm g{c.w<bf16_t>(WS_YB), c.w<bf16_t>(WS_WOUT), NTOK, 1024, 1024}; pg8::StaticOrder S; S.init(NTOK, 1024, c.G, c.blk);
                pg8::EpiResid E{(l == 0) ? c.inf(I_X) : args.out, args.out, c.w<float>(WS_MOD) + (size_t)l * NB * 6144 + 2048, 6144, SEQ};
                pg8::gemm_phase<pg8::EpiResid, pg8::StaticOrder, true, true>((LAS unsigned char*)lds, g, S, E); });
        PHASE(7, ph_router(c, l));
        PHASE(8, ph_gather(c, l));
        PHASE(9, { pg8::Gemm g{c.w<bf16_t>(WS_Z), c.w<bf16_t>(WS_WUP), NR, 32 * 1024, 1024}; pg8::MoeOrder S{c.w<int>(WS_TILE), c.G, c.blk}; pg8::EpiSwiglu E{c.w<bf16_t>(WS_Q)};
                pg8::gemm_phase<pg8::EpiSwiglu, pg8::MoeOrder, true, true>((LAS unsigned char*)lds, g, S, E); });
        PHASE(10, { pg8::Gemm g{c.w<bf16_t>(WS_Q), c.w<bf16_t>(WS_WDN), NR, 32 * 1024, 512}; pg8::MoeOrder S{c.w<int>(WS_TILE), c.G, c.blk};
                pg8::EpiDown E{c.w<int>(WS_ROWTOK), c.w<float>(WS_ROWW), args.out, c.w<bf16_t>(WS_Y1), c.w<float>(WS_MOD) + (size_t)l * NB * 6144 + 5120, 6144, SEQ};
                pg8::gemm_phase<pg8::EpiDown, pg8::MoeOrder, true, true>((LAS unsigned char*)lds, g, S, E); });
    }
    PHASE(11, ph_final(c));
#undef PHASE
}

extern "C" void kernel_launch(void* const* d_in, const int* in_sizes, int n_in, void* d_out, int out_size, void* d_ws, size_t ws_size, hipStream_t stream) {
    static int grid = 0;
    if (grid == 0) {
        if (n_in != 30 || out_size != NTOK * 1024 || ws_size < WS_END) { fprintf(stderr, "kernel_launch: shape/workspace mismatch (n_in %d out %d ws %zu need %zu)\n", n_in, out_size, ws_size, (size_t)WS_END); grid = -1; return; }
        int dev = 0, cus = 0;
        if (hipGetDevice(&dev) != hipSuccess || hipDeviceGetAttribute(&cus, hipDeviceAttributeMultiprocessorCount, dev) != hipSuccess) { grid = -1; return; }
        if (hipFuncSetAttribute((const void*)mk_fwd, hipFuncAttributeMaxDynamicSharedMemorySize, LDS_BYTES) != hipSuccess) { fprintf(stderr, "kernel_launch: hipFuncSetAttribute failed\n"); grid = -1; return; }
        int per_cu = 0; (void)hipOccupancyMaxActiveBlocksPerMultiprocessor(&per_cu, (const void*)mk_fwd, 512, LDS_BYTES);
        if (per_cu < 1) fprintf(stderr, "kernel_launch: occupancy query says %d blocks per CU\n", per_cu);
        grid = cus;
    }
    if (grid < 0) return;
    (void)hipMemsetAsync((char*)d_ws + WS_CTL, 0, CTL_BYTES, stream);
    Args a{};
    for (int i = 0; i < 30; ++i) a.in[i] = d_in[i];
    a.out = (float*)d_out; a.ws = (unsigned char*)d_ws;
#if MK_SPLIT
    for (int p = 0; p < N_PHASES; ++p) { a.ph_lo = p; a.ph_hi = p + 1;
#else
    { a.ph_lo = 0; a.ph_hi = N_PHASES;
#endif
#ifdef EMU
        EMU_LAUNCH(mk_fwd, grid, 512, LDS_BYTES, stream, a);
#else
        hipLaunchKernelGGL(mk_fwd, dim3(grid), dim3(512), LDS_BYTES, stream, a);
#endif
    }
}
```

```cpp
#include <hip/hip_runtime.h>
#include <cstdio>
#include <cstdint>

#ifndef CFG_B
#define CFG_B 4
#endif
#ifndef CFG_S
#define CFG_S 8192
#endif
#ifndef CFG_L
#define CFG_L 4
#endif
#ifndef MK_SPLIT
#define MK_SPLIT 0
#endif

#ifdef EMU
#define ASMV(...) ((void)0)
#define LAS
#define LAUNDER_V(x) ((void)0)
#define LAUNDER_S(x) ((void)0)
#else
#define ASMV(...) asm volatile(__VA_ARGS__)
#define LAS __attribute__((address_space(3)))
#define LAUNDER_V(x) asm volatile("" : "+v"(x))
#define LAUNDER_S(x) asm volatile("" : "+s"(x))
#endif

typedef unsigned short bf16_t;
typedef short bf16x8 __attribute__((ext_vector_type(8)));
typedef short s16x4 __attribute__((ext_vector_type(4)));
typedef float f32x4 __attribute__((ext_vector_type(4)));
typedef float f32x16 __attribute__((ext_vector_type(16)));
typedef unsigned u32x4 __attribute__((ext_vector_type(4)));
typedef unsigned u32x2 __attribute__((ext_vector_type(2)));

__device__ __forceinline__ float bf2f(bf16_t h) { return __builtin_bit_cast(float, (unsigned)h << 16); }
__device__ __forceinline__ float bflo(unsigned w) { return __builtin_bit_cast(float, w << 16); }
__device__ __forceinline__ float bfhi(unsigned w) { return __builtin_bit_cast(float, w & 0xffff0000u); }
__device__ __forceinline__ unsigned f2bf_bits(float f) { unsigned u = __builtin_bit_cast(unsigned, f); u += 0x7fffu + ((u >> 16) & 1u); return u >> 16; }
#ifdef EMU
__device__ __forceinline__ unsigned cvt_pk_bf16(float lo, float hi) { return f2bf_bits(lo) | (f2bf_bits(hi) << 16); }
#else
__device__ __forceinline__ unsigned cvt_pk_bf16(float lo, float hi) { unsigned r; asm volatile("v_cvt_pk_bf16_f32 %0, %1, %2" : "=v"(r) : "v"(lo), "v"(hi)); return r; }
#endif
__device__ __forceinline__ float fast_exp(float x) { return __builtin_amdgcn_exp2f(x * 1.44269504089f); }
__device__ __forceinline__ float fsigmoid(float x) { return __builtin_amdgcn_rcpf(1.0f + fast_exp(-x)); }
__device__ __forceinline__ float fsilu(float x) { return x * fsigmoid(x); }
__device__ __forceinline__ float frsqrt(float x) { return __builtin_amdgcn_rsqf(x); }
#ifdef EMU
__device__ __forceinline__ float wave_sum(float v) {
#pragma unroll
    for (int m = 32; m >= 1; m >>= 1) v += __shfl_xor(v, m);
    return v;
}
#else
template <int CTRL, int ROW_MASK> __device__ __forceinline__ float dpp_t(float v) { return __builtin_bit_cast(float, __builtin_amdgcn_update_dpp(0, __builtin_bit_cast(int, v), CTRL, ROW_MASK, 0xF, false)); }
#define dpp_f(v, ctrl, rm) dpp_t<ctrl, rm>(v)
__device__ __forceinline__ float wave_sum(float v) {
    v += dpp_f(v, 0xB1, 0xF);
    v += dpp_f(v, 0x4E, 0xF);
    v += dpp_f(v, 0x141, 0xF);
    v += dpp_f(v, 0x140, 0xF);
    v += dpp_f(v, 0x142, 0xA);
    v += dpp_f(v, 0x143, 0xC);
    return __builtin_bit_cast(float, __builtin_amdgcn_readlane(__builtin_bit_cast(int, v), 63));
}
#endif

namespace pg8 {
#define PG8_LAS LAS
constexpr int BM = 256, BK = 64, HALF = 128, HTB = HALF * BK * 2  , STAGE_BYTES = 8 * HTB, NXCD = 8, WGM = 8;

__host__ __device__ __forceinline__ int lds_byte(int r, int c) { const int st = (r >> 4) * 2 + (c >> 5), rr = r & 15, cc = c & 31, ob = rr * 64 + cc * 2; return st * 1024 + (ob ^ (((ob >> 9) & 1) << 5)); }
__host__ __device__ __forceinline__ void stage_rc(int b, int& R, int& C) { const int st = b / 1024, sb = b % 1024, swz = sb ^ (((sb >> 9) & 1) << 5); R = (st >> 1) * 16 + swz / 64; C = (st & 1) * 32 + (swz % 64) / 2; }
__host__ __device__ __forceinline__ int perm32(int rho) { const int n = rho >> 4, i = rho & 15; return 8 * (i >> 2) + 4 * n + (i & 3); }

struct Unit { int pm, pn; };
struct Gemm { const bf16_t* A; const bf16_t* Bt; int M, N, K; };

struct StaticOrder {
    int nM, nN, nwg, G, c;
    __host__ __device__ void init(int M, int N, int G_, int c_) { nM = M / BM; nN = N / BM; nwg = nM * nN; G = G_; c = c_; }
    __host__ __device__ bool next(int i, Unit& u) const {
        const long L = (long)i * G + c; if (L >= nwg) return false;
        int wgid = (int)L; { const int q = nwg / NXCD, r = nwg % NXCD, xcd = wgid % NXCD, off = wgid / NXCD; wgid = (xcd < r ? xcd * (q + 1) : r * (q + 1) + (xcd - r) * q) + off; }
        const int nig = WGM * nN, gid = wgid / nig, fm = gid * WGM, gsz = (nM - fm) < WGM ? (nM - fm) : WGM;
        u.pm = fm + ((wgid % nig) % gsz); u.pn = (wgid % nig) / gsz; return true;
    }
    __device__ __forceinline__ void a_ready(const Unit&) const {}
    __device__ __forceinline__ void done(const Unit&) const {}
};
template <class Epi, class Sched, bool ALIGN_EPI = false, bool SP2 = false, bool GATHER = false>
__device__ __forceinline__ void gemm_phase(PG8_LAS unsigned char* lds, const Gemm g, const Sched& S, const Epi& E, const int* rowmap = nullptr) {
    int tid = threadIdx.x; LAUNDER_V(tid); const int wid = __builtin_amdgcn_readfirstlane(tid >> 6), lane = tid & 63, wr = wid >> 2, wc = wid & 3, fr = lane & 15, fq = lane >> 4;
    const int K = g.K, nt = K / BK;
    unsigned voffA[2], voffB[2]; int RA[2], CA[2];
#pragma unroll
    for (int i = 0; i < 2; ++i) { int R, C; stage_rc(tid * 16 + i * 8192, R, C); const int Rb = Epi::PERM ? ((R & ~31) + perm32(R & 31)) : R;
        voffA[i] = (unsigned)(R * K + C) * 2u; voffB[i] = (unsigned)(Rb * K + C) * 2u; RA[i] = R; CA[i] = C; }
    const size_t kstep = (size_t)(BK * 2);
    const size_t hstep = (size_t)HALF * K * 2;
    const size_t tstep = 2 * hstep;
    const size_t hA = GATHER ? (size_t)0 : hstep;
    unsigned vA0[2], vA1[2], nA0[2], nA1[2];
    auto rows_of = [&](const Unit& u, unsigned (&o0)[2], unsigned (&o1)[2]) {
#pragma unroll
        for (int i = 0; i < 2; ++i) { if constexpr (GATHER) { int t0 = rowmap[u.pm * BM + RA[i]], t1 = rowmap[u.pm * BM + HALF + RA[i]]; t0 = t0 < 0 ? 0 : (t0 >> 1); t1 = t1 < 0 ? 0 : (t1 >> 1);
                o0[i] = (unsigned)(t0 * K + CA[i]) * 2u; o1[i] = (unsigned)(t1 * K + CA[i]) * 2u; } else { o0[i] = voffA[i]; o1[i] = voffA[i]; } } };
    const unsigned ldsw = (unsigned)wid * 1024u;
    const int aoff = lds_byte(wr * 64 + fr, fq * 8), boff = lds_byte(wc * 32 + fr, fq * 8);
#define PG8_SA(b, h) (((b) * 2 + (h)) * HTB)
#define PG8_SB(b, h) ((4 + (b) * 2 + (h)) * HTB)
#define PG8_STAGE(bufoff, gbase, voff) do { _Pragma("unroll") for (int _i = 0; _i < 2; ++_i) \
        __builtin_amdgcn_global_load_lds((const unsigned*)((const char*)(gbase) + (voff)[_i]), (PG8_LAS unsigned*)(lds + (bufoff) + ldsw + _i * 8192), 16, 0, 0); } while (0)
#define PG8_LDA(dst, b, h) do { _Pragma("unroll") for (int m = 0; m < 4; ++m) _Pragma("unroll") for (int k = 0; k < 2; ++k) dst[m][k] = *(const PG8_LAS bf16x8*)(lds + PG8_SA(b, h) + aoff + m * 2048 + k * 1024); } while (0)
#define PG8_LDB(dst, b, h) do { _Pragma("unroll") for (int n = 0; n < 2; ++n) _Pragma("unroll") for (int k = 0; k < 2; ++k) dst[n][k] = *(const PG8_LAS bf16x8*)(lds + PG8_SB(b, h) + boff + n * 2048 + k * 1024); } while (0)
#define PG8_MMA(ai, bj, At, Bt) do { __builtin_amdgcn_s_setprio(1); _Pragma("unroll") for (int m = 0; m < 4; ++m) _Pragma("unroll") for (int n = 0; n < 2; ++n) _Pragma("unroll") for (int k = 0; k < 2; ++k) \
        acc[ai][bj][m][n] = __builtin_amdgcn_mfma_f32_16x16x32_bf16(Bt[n][k], At[m][k], acc[ai][bj][m][n], 0, 0, 0); __builtin_amdgcn_s_setprio(0); } while (0)
#define PG8_WAIT_V(n) ASMV("s_waitcnt vmcnt(" #n ")" ::: "memory")
#define PG8_WAIT_L(n) ASMV("s_waitcnt lgkmcnt(" #n ")" ::: "memory")
#define PG8_BAR __builtin_amdgcn_s_barrier()
#define PG8_SCHED __builtin_amdgcn_sched_barrier(0)
    Unit cur, nxt; int ui = 0;
    if (!S.next(0, cur)) return;
    f32x4 acc[2][2][4][2];
#pragma unroll
    for (int a = 0; a < 2; ++a)
#pragma unroll
        for (int b = 0; b < 2; ++b)
#pragma unroll
            for (int m = 0; m < 4; ++m)
#pragma unroll
                for (int n = 0; n < 2; ++n) acc[a][b][m][n] = (f32x4){0.f, 0.f, 0.f, 0.f};
    bf16x8 At[4][2], B0[2][2], B1[2][2];
    const char* cA = GATHER ? (const char*)g.A : (const char*)g.A + (size_t)cur.pm * tstep; rows_of(cur, vA0, vA1); const char* cB = (const char*)g.Bt + (size_t)cur.pn * tstep;
    S.a_ready(cur);
    if constexpr (SP2) {
        PG8_STAGE(PG8_SB(0, 0), cB, voffB); PG8_STAGE(PG8_SB(0, 1), cB + hstep, voffB); PG8_STAGE(PG8_SA(0, 0), cA, vA0); PG8_STAGE(PG8_SA(0, 1), cA + hA, vA1);
        if (wr == 1) PG8_BAR;
        PG8_WAIT_V(2); PG8_BAR;
        PG8_STAGE(PG8_SB(1, 0), cB + kstep, voffB); PG8_STAGE(PG8_SA(1, 0), cA + kstep, vA0); PG8_STAGE(PG8_SB(1, 1), cB + hstep + kstep, voffB);
        PG8_WAIT_V(6); PG8_BAR;
    } else {
        PG8_STAGE(PG8_SB(0, 0), cB, voffB); PG8_STAGE(PG8_SA(0, 0), cA, vA0); PG8_STAGE(PG8_SB(0, 1), cB + hstep, voffB); PG8_STAGE(PG8_SA(0, 1), cA + hA, vA1);
        if (wr == 1) PG8_BAR;
        PG8_WAIT_V(4); PG8_BAR;
        PG8_STAGE(PG8_SB(1, 0), cB + kstep, voffB); PG8_STAGE(PG8_SA(1, 0), cA + kstep, vA0); PG8_STAGE(PG8_SB(1, 1), cB + hstep + kstep, voffB);
        PG8_WAIT_V(6); PG8_BAR;
    }
    for (;;) {
        const bool has_next = S.next(ui + 1, nxt);
        const char* nA = GATHER ? (const char*)g.A : (has_next ? (const char*)g.A + (size_t)nxt.pm * tstep : cA);
        if (has_next) rows_of(nxt, nA0, nA1); else { nA0[0] = vA0[0]; nA0[1] = vA0[1]; nA1[0] = vA1[0]; nA1[1] = vA1[1]; } const char* nB = has_next ? (const char*)g.Bt + (size_t)nxt.pn * tstep : cB;
        for (int t = 0; t < nt; t += 2) {
            const bool last = (t == nt - 2);
            unsigned sA0[2], sA1[2];
#pragma unroll
            for (int i = 0; i < 2; ++i) { sA0[i] = last ? nA0[i] : vA0[i]; sA1[i] = last ? nA1[i] : vA1[i]; }
            const char* a1 = cA + (size_t)(t + 1) * kstep;
            const char* a2 = last ? nA : cA + (size_t)(t + 2) * kstep; const char* b2 = last ? nB : cB + (size_t)(t + 2) * kstep;
            const char* a3 = a2 + kstep; const char* b3 = b2 + kstep;
            if (last && has_next) S.a_ready(nxt);
            if constexpr (SP2) {
            PG8_LDB(B0, 0, 0); PG8_LDB(B1, 0, 1); PG8_SCHED; PG8_LDA(At, 0, 0); PG8_STAGE(PG8_SA(1, 1), a1 + hA, vA1);
            PG8_WAIT_V(8); PG8_WAIT_L(0); PG8_BAR; PG8_MMA(0, 0, At, B0); PG8_MMA(0, 1, At, B1); PG8_BAR; PG8_SCHED;
            PG8_LDA(At, 0, 1); PG8_STAGE(PG8_SB(0, 0), b2, voffB); PG8_STAGE(PG8_SB(0, 1), b2 + hstep, voffB); PG8_STAGE(PG8_SA(0, 0), a2, sA0);
            PG8_WAIT_V(8); PG8_WAIT_L(0); PG8_BAR; PG8_MMA(1, 0, At, B0); PG8_MMA(1, 1, At, B1); PG8_BAR; PG8_SCHED;
            PG8_LDB(B0, 1, 0); PG8_LDB(B1, 1, 1); PG8_SCHED; PG8_LDA(At, 1, 0); PG8_STAGE(PG8_SA(0, 1), a2 + hA, sA1);
            PG8_WAIT_V(8); PG8_WAIT_L(0); PG8_BAR; PG8_MMA(0, 0, At, B0); PG8_MMA(0, 1, At, B1); PG8_BAR; PG8_SCHED;
            PG8_LDA(At, 1, 1); PG8_STAGE(PG8_SB(1, 0), b3, voffB); PG8_STAGE(PG8_SB(1, 1), b3 + hstep, voffB); PG8_STAGE(PG8_SA(1, 0), a3, sA0);
            PG8_WAIT_V(8); PG8_WAIT_L(0); PG8_BAR; PG8_MMA(1, 0, At, B0); PG8_MMA(1, 1, At, B1); PG8_BAR; PG8_SCHED;
            } else {
            PG8_LDB(B0, 0, 0); PG8_SCHED; PG8_LDA(At, 0, 0); PG8_STAGE(PG8_SA(1, 1), a1 + hA, vA1);
            PG8_WAIT_L(8); PG8_BAR; PG8_WAIT_L(0); PG8_MMA(0, 0, At, B0); PG8_BAR; PG8_SCHED;
            PG8_LDB(B1, 0, 1); PG8_STAGE(PG8_SB(0, 0), b2, voffB);
            PG8_BAR; PG8_WAIT_L(0); PG8_MMA(0, 1, At, B1); PG8_BAR;
            PG8_LDA(At, 0, 1); PG8_STAGE(PG8_SA(0, 0), a2, sA0);
            PG8_BAR; PG8_WAIT_L(0); PG8_MMA(1, 0, At, B0); PG8_BAR; PG8_SCHED;
            PG8_STAGE(PG8_SB(0, 1), b2 + hstep, voffB);
            PG8_WAIT_V(6); PG8_BAR; PG8_MMA(1, 1, At, B1); PG8_BAR;
            PG8_LDB(B0, 1, 0); PG8_SCHED; PG8_LDA(At, 1, 0); PG8_STAGE(PG8_SA(0, 1), a2 + hA, sA1);
            PG8_WAIT_L(8); PG8_BAR; PG8_WAIT_L(0); PG8_MMA(0, 0, At, B0); PG8_BAR; PG8_SCHED;
            PG8_LDB(B1, 1, 1); PG8_STAGE(PG8_SB(1, 0), b3, voffB);
            PG8_BAR; PG8_WAIT_L(0); PG8_MMA(0, 1, At, B1); PG8_BAR;
            PG8_LDA(At, 1, 1); PG8_STAGE(PG8_SA(1, 0), a3, sA0);
            PG8_BAR; PG8_WAIT_L(0); PG8_MMA(1, 0, At, B0); PG8_BAR; PG8_SCHED;
            PG8_STAGE(PG8_SB(1, 1), b3 + hstep, voffB);
            PG8_WAIT_V(6); PG8_BAR; PG8_MMA(1, 1, At, B1); PG8_BAR;
            }
        }
        if constexpr (ALIGN_EPI) { if (wr == 0) PG8_BAR; }
        if constexpr (!Epi::AFTER_DRAIN) { E(acc, cur, wr, wc, fr, fq); S.done(cur); }
        if (!has_next) break;
#pragma unroll
        for (int a = 0; a < 2; ++a)
#pragma unroll
            for (int b = 0; b < 2; ++b)
#pragma unroll
                for (int m = 0; m < 4; ++m)
#pragma unroll
                    for (int n = 0; n < 2; ++n) acc[a][b][m][n] = (f32x4){0.f, 0.f, 0.f, 0.f};
        cur = nxt; cA = nA; cB = nB; ++ui; vA0[0] = nA0[0]; vA0[1] = nA0[1]; vA1[0] = nA1[0]; vA1[1] = nA1[1];
        if constexpr (ALIGN_EPI) { if (wr == 1) PG8_BAR; }
    }
    PG8_WAIT_V(0);
    if constexpr (!ALIGN_EPI) { if (wr == 0) PG8_BAR; }
    PG8_BAR;
    if constexpr (Epi::AFTER_DRAIN) { E.fused(acc, cur, wr, wc, fr, fq, lds, wid, lane); S.done(cur); }
#undef PG8_SA
#undef PG8_SB
#undef PG8_STAGE
#undef PG8_LDA
#undef PG8_LDB
#undef PG8_MMA
#undef PG8_WAIT_V
#undef PG8_WAIT_L
#undef PG8_BAR
#undef PG8_SCHED
}

struct EpiBf16 {
    static constexpr bool PERM = true, AFTER_DRAIN = false;
    bf16_t* O; int ldc;
    __device__ __forceinline__ void operator()(const f32x4 (&acc)[2][2][4][2], const Unit& u, int wr, int wc, int fr, int fq) const {
        const int row0 = u.pm * BM + wr * 64 + fr, col0 = u.pn * BM + wc * 32 + 8 * fq;
#pragma unroll
        for (int ai = 0; ai < 2; ++ai)
#pragma unroll
            for (int m = 0; m < 4; ++m) { bf16_t* rowp = O + (size_t)(row0 + ai * HALF + m * 16) * ldc + col0;
#pragma unroll
                for (int bj = 0; bj < 2; ++bj) { const f32x4 v0 = acc[ai][bj][m][0], v1 = acc[ai][bj][m][1];
                    u32x4 w; w.x = cvt_pk_bf16(v0[0], v0[1]); w.y = cvt_pk_bf16(v0[2], v0[3]); w.z = cvt_pk_bf16(v1[0], v1[1]); w.w = cvt_pk_bf16(v1[2], v1[3]);
                    *(u32x4*)(rowp + bj * HALF) = w; } }
    }
};
struct EpiResid {
    static constexpr bool PERM = true, AFTER_DRAIN = false;
    const float* xin; float* xout; const float* gate; int gstride; int seq; const bf16_t* y1;
    __device__ __forceinline__ void operator()(const f32x4 (&acc)[2][2][4][2], const Unit& u, int wr, int wc, int fr, int fq) const {
        const int row0 = u.pm * BM + wr * 64 + fr, col0 = u.pn * BM + wc * 32 + 8 * fq;
#pragma unroll
        for (int ai = 0; ai < 2; ++ai)
#pragma unroll
            for (int m = 0; m < 4; ++m) { const int row = row0 + ai * HALF + m * 16; const float* gp = gate + (size_t)(row / seq) * gstride;
#pragma unroll
                for (int bj = 0; bj < 2; ++bj) { const int c = col0 + bj * HALF; const size_t o = (size_t)row * 1024 + c;
                    const f32x4 g0 = *(const f32x4*)(gp + c), g1 = *(const f32x4*)(gp + c + 4);
                    f32x4 x0 = *(const f32x4*)(xin + o), x1 = *(const f32x4*)(xin + o + 4);
                    if (y1) { const u32x4 y = *(const u32x4*)(y1 + o); x0 += (f32x4){bflo(y.x), bfhi(y.x), bflo(y.y), bfhi(y.y)}; x1 += (f32x4){bflo(y.z), bfhi(y.z), bflo(y.w), bfhi(y.w)}; }
                    *(f32x4*)(xout + o) = x0 + g0 * acc[ai][bj][m][0]; *(f32x4*)(xout + o + 4) = x1 + g1 * acc[ai][bj][m][1]; } }
    }
};
struct EpiSwiglu {
    static constexpr bool PERM = true, AFTER_DRAIN = false;
    bf16_t* HB;
    __device__ __forceinline__ void operator()(const f32x4 (&acc)[2][2][4][2], const Unit& u, int wr, int wc, int fr, int fq) const {
        const int row0 = u.pm * BM + wr * 64 + fr, col0 = (u.pn & 3) * 128 + wc * 32 + 8 * fq;
#pragma unroll
        for (int ai = 0; ai < 2; ++ai)
#pragma unroll
            for (int m = 0; m < 4; ++m) { bf16_t* p = HB + (size_t)(row0 + ai * HALF + m * 16) * 512 + col0;
                float h[8];
#pragma unroll
                for (int n = 0; n < 2; ++n)
#pragma unroll
                    for (int k = 0; k < 4; ++k) h[n * 4 + k] = fsilu(acc[ai][0][m][n][k]) * acc[ai][1][m][n][k];
                u32x4 w; w.x = cvt_pk_bf16(h[0], h[1]); w.y = cvt_pk_bf16(h[2], h[3]); w.z = cvt_pk_bf16(h[4], h[5]); w.w = cvt_pk_bf16(h[6], h[7]);
                *(u32x4*)p = w; }
    }
};
struct EpiDown {
    static constexpr bool PERM = true, AFTER_DRAIN = false;
    const int* row_tok; const float* row_w; float* x; bf16_t* y1; const float* gate; int gstride; int seq;
    __device__ __forceinline__ void operator()(const f32x4 (&acc)[2][2][4][2], const Unit& u, int wr, int wc, int fr, int fq) const {
        const int row0 = u.pm * BM + wr * 64 + fr, col0 = (u.pn & 3) * BM + wc * 32 + 8 * fq;
#pragma unroll
        for (int ai = 0; ai < 2; ++ai)
#pragma unroll
            for (int m = 0; m < 4; ++m) { const int row = row0 + ai * HALF + m * 16; const int ts = row_tok[row];
                if (ts >= 0) { const int tok = ts >> 1; const float w = row_w[row]; const float* gp = gate + (size_t)(tok / seq) * gstride;
#pragma unroll
                    for (int bj = 0; bj < 2; ++bj) { const int c = col0 + bj * HALF; const size_t o = (size_t)tok * 1024 + c;
                        const f32x4 v0 = acc[ai][bj][m][0] * (*(const f32x4*)(gp + c)) * w, v1 = acc[ai][bj][m][1] * (*(const f32x4*)(gp + c + 4)) * w;
                        if (ts & 1) { u32x4 q; q.x = cvt_pk_bf16(v0[0], v0[1]); q.y = cvt_pk_bf16(v0[2], v0[3]); q.z = cvt_pk_bf16(v1[0], v1[1]); q.w = cvt_pk_bf16(v1[2], v1[3]); *(u32x4*)(y1 + o) = q; }
                        else { *(f32x4*)(x + o) = *(const f32x4*)(x + o) + v0; *(f32x4*)(x + o + 4) = *(const f32x4*)(x + o + 4) + v1; } } } }
    }
};
struct MoeOrder {
    const int* tile; int G, c;
    __device__ __forceinline__ bool next(int i, Unit& u) const { const int v = ((G & 7) == 0) ? (c & 7) * (G >> 3) + (c >> 3) : c; const int L = i * G + v, nt = tile[0]; if (L >= nt * 4) return false; u.pm = L >> 2; u.pn = tile[1 + (L >> 2)] * 4 + (L & 3); return true; }
    __device__ __forceinline__ void a_ready(const Unit&) const {}
    __device__ __forceinline__ void done(const Unit&) const {}
};
}

constexpr int NB = CFG_B, SEQ = CFG_S, NL = CFG_L, NTOK = NB * SEQ, DM = 1024, ZP = 2304;
constexpr int NBH = NB * 4, NCH = SEQ / 128, NQT = SEQ / 256;
constexpr int NR = 2 * NTOK + 32 * 256;
constexpr int Z_CQ = 0, Z_CKV = 192, Z_KR = 320, Z_POOL = 352, Z_HQ = 608, Z_HF = 864, Z_HI = 1120, Z_HG = 1376, Z_CA = 1632, Z_CG = 1888;
constexpr float EPS = 1e-6f;
static_assert(SEQ % 256 == 0 && NTOK % 256 == 0 && (NQT % 2) == 0, "shape");
constexpr size_t al256(size_t x) { return (x + 255) & ~(size_t)255; }
constexpr size_t cmax(size_t a, size_t b) { return a > b ? a : b; }
constexpr size_t WS_CTL = 0, CTL_BYTES = 65536;
constexpr size_t CTL_CNT = 16384;
constexpr size_t CTL_HG = 32768;
constexpr size_t WS_MODP = WS_CTL + CTL_BYTES;
constexpr size_t WS_MOD = WS_MODP + al256((size_t)16 * NL * NB * 6144 * 4);
constexpr size_t WS_LB = WS_MOD + al256((size_t)NL * NB * 6144 * 4);
constexpr size_t WS_ROPE = WS_LB + al256((size_t)NL * 256 * 4);
constexpr size_t WS_WIN = WS_ROPE + al256((size_t)NTOK * 32 * 4);
constexpr size_t WS_WOUT = WS_WIN + (size_t)ZP * 1024 * 2;
constexpr size_t WS_WUQ = WS_WOUT + (size_t)1024 * 1024 * 2;
constexpr size_t WS_WUKV = WS_WUQ + al256((size_t)384 * 192 * 2);
constexpr size_t WS_WPOOL = WS_WUKV + al256((size_t)512 * 128 * 2);
constexpr size_t WS_WUP = WS_WPOOL + al256((size_t)4 * 64 * 64 * 2);
constexpr size_t WS_WDN = WS_WUP + (size_t)32 * 1024 * 1024 * 2;
constexpr size_t WS_RWT = WS_WDN + (size_t)32 * 1024 * 512 * 2;
constexpr size_t WSET = WS_RWT + 36 * 1024 * 4 - WS_WIN;
constexpr size_t WS_HA = WS_WIN + 2 * WSET;
constexpr size_t WS_Z = WS_HA + (size_t)NTOK * 1024 * 2;
constexpr size_t Z_BYTES = cmax((size_t)NTOK * ZP * 2, (size_t)NR * 1024 * 2);
constexpr size_t WS_Q = WS_Z + Z_BYTES;
constexpr size_t WS_K = WS_Q + (size_t)NTOK * 4 * 96 * 2;
constexpr size_t WS_VT = WS_K + (size_t)NTOK * 4 * 96 * 2;
constexpr size_t WS_YB = WS_VT + (size_t)NTOK * 4 * 64 * 2;
constexpr size_t R2_BYTES = cmax(WS_YB + (size_t)NTOK * 1024 * 2 - WS_Q, (size_t)NR * 512 * 2);
constexpr size_t WS_Y1 = WS_Q + R2_BYTES;
constexpr size_t WS_SC = WS_Y1 + (size_t)NTOK * 1024 * 2;
constexpr size_t WS_PC = WS_SC + (size_t)NBH * NCH * 4096 * 4;
constexpr size_t WS_S0 = WS_PC + al256((size_t)NBH * NCH * 64 * 4);
constexpr size_t WS_ASGE = WS_S0 + (size_t)NBH * NCH * 4096 * 4;
constexpr size_t WS_ASGR = WS_ASGE + (size_t)NTOK * 8;
constexpr size_t WS_ASGW = WS_ASGR + (size_t)NTOK * 8;
constexpr size_t WS_ROWTOK = WS_ASGW + (size_t)NTOK * 8;
constexpr size_t WS_ROWW = WS_ROWTOK + al256((size_t)NR * 4);
constexpr size_t WS_TILE = WS_ROWW + al256((size_t)NR * 4);
constexpr size_t WS_END = WS_TILE + al256((size_t)(NR / 256 + 16) * 4);
constexpr int LDS_BYTES = 160 * 1024;
constexpr int LDS_XB = LDS_BYTES - 16;

#define XB_TMO      128
#define XB_XCNT(j)  (256  + 64 * (j))
#define XB_XSUB(j)  (1280 + 64 * (j))
#define XB_XGEN(j)  (2304 + 64 * (j))
#define XB_TOP      3328
#define XB_TOPGEN   3392
#define XCD_BAR_WORDS 3456
#define XB_SPIN_CAP (1u << 18)
__device__ __forceinline__ unsigned xb_ld(unsigned* p)              { return __hip_atomic_load(p, __ATOMIC_RELAXED, __HIP_MEMORY_SCOPE_AGENT); }
__device__ __forceinline__ unsigned xb_add(unsigned* p, unsigned v) { return __hip_atomic_fetch_add(p, v, __ATOMIC_RELAXED, __HIP_MEMORY_SCOPE_AGENT); }
__device__ __forceinline__ unsigned xb_xcc_id() { return (unsigned)__builtin_amdgcn_s_getreg((3 << 11) | 20) & 0xFu; }
#define XB_SPIN(cond, bar) do { unsigned _sp = 0; while (cond) { __builtin_amdgcn_s_sleep(1); \
    if ((++_sp & 255u) == 0u) { if (xb_ld(&(bar)[XB_TMO])) break; if (_sp > XB_SPIN_CAP) { atomicAdd(&(bar)[XB_TMO], 1u); break; } } } } while (0)
struct XcdBarrier { unsigned* bar; unsigned x; volatile LAS unsigned* st; };
__device__ __forceinline__ XcdBarrier xcd_barrier_post(unsigned* bar, volatile LAS unsigned* st) {
    XcdBarrier b; b.bar = bar; b.x = xb_xcc_id(); b.st = st;
    if (threadIdx.x == 0) (void)xb_add(&bar[XB_XCNT(b.x)], 1u);
    return b;
}
__device__ __forceinline__ void xcd_barrier_complete(unsigned* bar, unsigned x, unsigned& nloc, unsigned& nx) {
    const unsigned G = gridDim.x * gridDim.y * gridDim.z;
    unsigned sum, cnt, mine, sp = 0u;
    for (;;) {
        sum = 0u; cnt = 0u; mine = 0u;
#pragma unroll
        for (unsigned j = 0; j < 16; ++j) { const unsigned c = xb_ld(&bar[XB_XCNT(j)]); sum += c; cnt += (c > 0u) ? 1u : 0u; mine = (j == x) ? c : mine; }
        if (sum == G) break;
        __builtin_amdgcn_s_sleep(1);
        if ((++sp & 255u) == 0u) { if (xb_ld(&bar[XB_TMO])) break; if (sp > XB_SPIN_CAP) { atomicAdd(&bar[XB_TMO], 1u); break; } }
    }
    nloc = mine > 0u ? mine : 1u; nx = cnt > 0u ? cnt : 1u;
}
__device__ __forceinline__ void xcd_barrier(const XcdBarrier& b) {
    ASMV("s_waitcnt vmcnt(0)" ::: "memory");
    __syncthreads();
    if (threadIdx.x == 0) {
        unsigned* bar = b.bar;
        __builtin_amdgcn_s_waitcnt(0);
        unsigned nloc = b.st[0], nx = b.st[1];
        if (nloc == 0u) { xcd_barrier_complete(bar, b.x, nloc, nx); b.st[0] = nloc; b.st[1] = nx; }
        const unsigned old = xb_add(&bar[XB_XSUB(b.x)], 1u);
        const unsigned gen = old / nloc;
        if (old + 1u == (gen + 1u) * nloc) {
            __builtin_amdgcn_fence(__ATOMIC_RELEASE, "agent");
            ASMV("s_waitcnt vmcnt(0)" ::: "memory");
            const unsigned og = xb_add(&bar[XB_TOP], 1u);
            const unsigned tg = og / nx;
            if (og + 1u == (tg + 1u) * nx) xb_add(&bar[XB_TOPGEN], 1u);
            else XB_SPIN(xb_ld(&bar[XB_TOPGEN]) == tg, bar);
            __builtin_amdgcn_fence(__ATOMIC_ACQUIRE, "agent");
            xb_add(&bar[XB_XGEN(b.x)], 1u);
            ASMV("s_waitcnt vmcnt(0)" ::: "memory");
        } else {
            XB_SPIN(xb_ld(&bar[XB_XGEN(b.x)]) == gen, bar);
            __builtin_amdgcn_fence(__ATOMIC_ACQUIRE, "agent");
            ASMV("s_waitcnt vmcnt(0)" ::: "memory");
        }
    }
    __syncthreads();
}

struct Args { const void* in[30]; float* out; unsigned char* ws; int ph_lo, ph_hi; };
enum { I_X = 0, I_C, I_POS, I_WADA, I_BADA, I_N1G, I_N2G, I_WIN, I_QAG, I_WUQ, I_KVAG, I_WUKV, I_QG, I_KG, I_WPOOL, I_PSCALE, I_LBL, I_HOG, I_DWW, I_DWB, I_LNG, I_LNB,
       I_WOUT, I_RGW, I_RGB, I_REW, I_REB, I_W1, I_W3, I_W2 };
struct Ctx {
    const Args* a; unsigned char* ws; unsigned char* lds; int tid, wid, lane, G, blk;
    __device__ __forceinline__ const float* inf(int i) const { return (const float*)a->in[i]; }
    template <class T> __device__ __forceinline__ T* w(size_t off) const { return (T*)(ws + off); }
};

__device__ __forceinline__ Ctx fresh(const Ctx& c0) { Ctx c = c0; LAUNDER_V(c.tid); LAUNDER_V(c.lane); LAUNDER_S(c.wid); return c; }
__device__ __forceinline__ void ph_prologue0(const Ctx& c_) { const Ctx c = fresh(c_);
    const float* cc = c.inf(I_C); const float* wada = c.inf(I_WADA); float* modp = c.w<float>(WS_MODP);
    for (int u = c.blk; u < NL * 16 * 12; u += c.G) {
        const int l = u / 192, r = u % 192, ic = r / 12, jb = r % 12, j = jb * 512 + c.tid;
        float* Ls = (float*)c.lds;
        __syncthreads();
        if (c.tid < NB * 64) Ls[c.tid] = fsilu(cc[(c.tid >> 6) * 1024 + ic * 64 + (c.tid & 63)]);
        __syncthreads();
        float acc[NB];
#pragma unroll
        for (int b = 0; b < NB; ++b) acc[b] = 0.f;
        const float* wp = wada + ((size_t)l * 1024 + ic * 64) * 6144 + j;
#pragma unroll
        for (int i0 = 0; i0 < 64; i0 += 16) { float wv[16];
#pragma unroll
            for (int i = 0; i < 16; ++i) wv[i] = wp[(size_t)(i0 + i) * 6144];
#pragma unroll
            for (int i = 0; i < 16; ++i)
#pragma unroll
                for (int b = 0; b < NB; ++b) acc[b] += Ls[b * 64 + i0 + i] * wv[i]; }
#pragma unroll
        for (int b = 0; b < NB; ++b) modp[(((size_t)ic * NL + l) * NB + b) * 6144 + j] = acc[b];
    }
    const int* pos = (const int*)c.a->in[I_POS]; float* rc = c.w<float>(WS_ROPE); float* rs = rc + (size_t)NTOK * 16;
    for (int e = c.blk * 512 + c.tid; e < NTOK * 16; e += c.G * 512) { const int t = e >> 4, i = e & 15;
        const float inv = exp2f(-(float)i * (13.287712379549449f / 16.0f));
        const float ang = (float)pos[t] * inv; rc[e] = cosf(ang); rs[e] = sinf(ang); }
    if (c.blk == 0 && c.tid < 256) { const float* lg = c.inf(I_LBL); float* lb = c.w<float>(WS_LB); float mx = -1e30f;
        for (int l = 0; l < NL; ++l) mx = fmaxf(mx, lg[l * 256 + c.tid]);
        float den = 0.f; for (int l = 0; l < NL; ++l) den += expf(lg[l * 256 + c.tid] - mx);
        float cum = 0.f, first = 0.f; for (int l = 0; l < NL; ++l) { cum += expf(lg[l * 256 + c.tid] - mx) / den; if (l == 0) first = cum; lb[l * 256 + c.tid] = cum - first; } }
}
__device__ __forceinline__ void ph_prologue1(const Ctx& c_) { const Ctx c = fresh(c_);
    const float* modp = c.w<float>(WS_MODP); float* mod = c.w<float>(WS_MOD); const float* bada = c.inf(I_BADA);
    for (int e = c.blk * 512 + c.tid; e < NL * NB * 6144; e += c.G * 512) { const int j = e % 6144, l = e / (NB * 6144);
        float s = bada[l * 6144 + j];
#pragma unroll
        for (int ic = 0; ic < 16; ++ic) s += modp[(size_t)ic * NL * NB * 6144 + e];
        mod[e] = s; }
}

__device__ __forceinline__ void ld8bf(const bf16_t* p, float (&o)[8]) { const u32x4 v = *(const u32x4*)p; o[0] = bflo(v.x); o[1] = bfhi(v.x); o[2] = bflo(v.y); o[3] = bfhi(v.y); o[4] = bflo(v.z); o[5] = bfhi(v.z); o[6] = bflo(v.w); o[7] = bfhi(v.w); }
__device__ __forceinline__ u32x4 pk8(const float (&o)[8]) { u32x4 w; w.x = cvt_pk_bf16(o[0], o[1]); w.y = cvt_pk_bf16(o[2], o[3]); w.z = cvt_pk_bf16(o[4], o[5]); w.w = cvt_pk_bf16(o[6], o[7]); return w; }
__device__ __forceinline__ void cvt_tile(const Ctx& c, const float* src, int ldn, int nlim, int k0, int n0, bf16_t* dst, int ldk, int drow0) {
    float* T = (float*)c.lds;
#pragma unroll
    for (int i = 0; i < 8; ++i) { const int e = c.tid + 512 * i, kk = e >> 6, nn = e & 63; T[kk * 65 + nn] = (n0 + nn < nlim) ? src[(size_t)(k0 + kk) * ldn + n0 + nn] : 0.f; }
    __syncthreads();
#pragma unroll
    for (int i = 0; i < 4; ++i) { const int e = c.tid + 512 * i, nn = e >> 5, k2 = e & 31;
        *(unsigned*)(dst + (size_t)(drow0 + nn) * ldk + k0 + 2 * k2) = cvt_pk_bf16(T[(2 * k2) * 65 + nn], T[(2 * k2 + 1) * 65 + nn]); }
    __syncthreads();
}
__device__ __forceinline__ void cvt_big(const Ctx& c, const float* src, int ldn, int nlim, int k0, int n0, bf16_t* dst, int ldk, int mode) {
    float* T = (float*)c.lds;
    f32x4 v[8];
#pragma unroll
    for (int i = 0; i < 8; ++i) { const int e4 = c.tid + 512 * i, kk = e4 >> 6, n4 = e4 & 63; v[i] = (n0 + n4 * 4 < nlim) ? *(const f32x4*)(src + (size_t)(k0 + kk) * ldn + n0 + n4 * 4) : (f32x4){0.f, 0.f, 0.f, 0.f}; }
#pragma unroll
    for (int i = 0; i < 8; ++i) { const int e4 = c.tid + 512 * i, kk = e4 >> 6, n4 = e4 & 63; float* p = T + kk * 261 + n4 * 4; p[0] = v[i][0]; p[1] = v[i][1]; p[2] = v[i][2]; p[3] = v[i][3]; }
    __syncthreads();
#pragma unroll
    for (int i = 0; i < 4; ++i) { const int e = c.tid + 512 * i, k8 = e & 7, nn = e >> 3, n = n0 + nn; float o[8];
#pragma unroll
        for (int j = 0; j < 8; ++j) o[j] = T[(8 * k8 + j) * 261 + nn];
        const int row = (mode == 0) ? n : ((n >> 7) * 256 + (mode - 1) * 128 + (n & 127));
        *(u32x4*)(dst + (size_t)row * ldk + k0 + 8 * k8) = pk8(o); }
    __syncthreads();
}
constexpr int CT_IN = 16 * 9, CT_OUT = 16 * 4, CT_W13 = 32 * 16 * 2, CT_W2 = 32 * 8 * 4, CT_UQ = 3 * 6, CT_UKV = 2 * 8, CT_POOL = 4;
constexpr int CT_TOTAL = CT_IN + CT_OUT + 2 * CT_W13 + CT_W2 + CT_UQ + CT_UKV + CT_POOL;
__device__ __forceinline__ void ph_cvt(const Ctx& c_, int l) { const Ctx c = fresh(c_);
    { const float* rgw = c.inf(I_RGW) + (size_t)l * 1024 * 4; const float* rew = c.inf(I_REW) + (size_t)l * 1024 * 32; float* rwt = c.w<float>(WS_RWT + (size_t)(l & 1) * WSET);
        for (int e = c.blk * 512 + c.tid; e < 36 * 1024; e += c.G * 512) { const int g = e >> 10, k = e & 1023; rwt[e] = (g < 4) ? rgw[k * 4 + g] : rew[k * 32 + g - 4]; } }
    for (int t = c.blk; t < CT_TOTAL; t += c.G) {
        int r = t;
        if (r < 2 * CT_W13) { const int which = r / CT_W13; r %= CT_W13; const int e = r / 32, kt = (r % 32) / 2, nt = r % 2;
            cvt_big(c, c.inf(which ? I_W3 : I_W1) + ((size_t)l * 32 + e) * 1024 * 512, 512, 512, kt * 64, nt * 256, c.w<bf16_t>(WS_WUP + (size_t)(l & 1) * WSET) + (size_t)e * 1024 * 1024, 1024, 1 + which); continue; } r -= 2 * CT_W13;
        if (r < CT_W2) { const int e = r / 32, kt = (r % 32) / 4, nt = r % 4;
            cvt_big(c, c.inf(I_W2) + ((size_t)l * 32 + e) * 512 * 1024, 1024, 1024, kt * 64, nt * 256, c.w<bf16_t>(WS_WDN + (size_t)(l & 1) * WSET) + (size_t)e * 1024 * 512, 512, 0); continue; } r -= CT_W2;
        if (r < CT_IN) { const int kt = r / 9, nt = r % 9; cvt_big(c, c.inf(I_WIN) + (size_t)l * 1024 * 2144, 2144, 2144, kt * 64, nt * 256, c.w<bf16_t>(WS_WIN + (size_t)(l & 1) * WSET), 1024, 0); continue; } r -= CT_IN;
        if (r < CT_OUT) { const int kt = r / 4, nt = r % 4; cvt_big(c, c.inf(I_WOUT) + (size_t)l * 1024 * 1024, 1024, 1024, kt * 64, nt * 256, c.w<bf16_t>(WS_WOUT + (size_t)(l & 1) * WSET), 1024, 0); continue; } r -= CT_OUT;
        if (r < CT_UQ) { const int kt = r / 6, nt = r % 6; cvt_tile(c, c.inf(I_WUQ) + (size_t)l * 192 * 384, 384, 384, kt * 64, nt * 64, c.w<bf16_t>(WS_WUQ + (size_t)(l & 1) * WSET), 192, nt * 64); continue; } r -= CT_UQ;
        if (r < CT_UKV) { const int kt = r / 8, nt = r % 8; cvt_tile(c, c.inf(I_WUKV) + (size_t)l * 128 * 512, 512, 512, kt * 64, nt * 64, c.w<bf16_t>(WS_WUKV + (size_t)(l & 1) * WSET), 128, nt * 64); continue; } r -= CT_UKV;
        cvt_tile(c, c.inf(I_WPOOL) + ((size_t)l * 4 + r) * 4096, 64, 64, 0, 0, c.w<bf16_t>(WS_WPOOL + (size_t)(l & 1) * WSET) + r * 4096, 64, 0);
    }
}
__device__ __forceinline__ void ph_normrows(const Ctx& c_, int l) { const Ctx c = fresh(c_);
    const float* xin = (l == 0) ? c.inf(I_X) : c.a->out; float* xout = c.a->out; const bf16_t* y1 = c.w<bf16_t>(WS_Y1);
    const float* gn = c.inf(I_N1G) + l * 1024; const float* mod = c.w<float>(WS_MOD) + (size_t)l * NB * 6144; bf16_t* ha = c.w<bf16_t>(WS_HA);
    for (int row0 = c.blk * 8 + c.wid; row0 < NTOK; row0 += c.G * 16) {
        f32x4 v[2][4]; float ss[2];
#pragma unroll
        for (int q = 0; q < 2; ++q) { const int row = row0 + q * c.G * 8; ss[q] = 0.f;
            if (row < NTOK) {
#pragma unroll
                for (int i = 0; i < 4; ++i) { const int col = i * 256 + c.lane * 4; v[q][i] = *(const f32x4*)(xin + (size_t)row * 1024 + col);
                    if (l > 0) { const u32x2 y = *(const u32x2*)(y1 + (size_t)row * 1024 + col); v[q][i] += (f32x4){bflo(y.x), bfhi(y.x), bflo(y.y), bfhi(y.y)}; } } } }
#pragma unroll
        for (int q = 0; q < 2; ++q) { const int row = row0 + q * c.G * 8;
            if (row < NTOK) {
#pragma unroll
                for (int i = 0; i < 4; ++i) {
                    ss[q] += v[q][i][0] * v[q][i][0] + v[q][i][1] * v[q][i][1] + v[q][i][2] * v[q][i][2] + v[q][i][3] * v[q][i][3]; } } }
        ss[0] = wave_sum(ss[0]); ss[1] = wave_sum(ss[1]);
#pragma unroll
        for (int q = 0; q < 2; ++q) { const int row = row0 + q * c.G * 8;
            if (row < NTOK) { const int b = row / SEQ; const float* sh = mod + b * 6144; const float* sc = sh + 1024; const float rinv = frsqrt(ss[q] * (1.0f / 1024.0f) + EPS);
#pragma unroll
                for (int i = 0; i < 4; ++i) { const int col = i * 256 + c.lane * 4; const f32x4 g = *(const f32x4*)(gn + col), s1 = *(const f32x4*)(sc + col), s0 = *(const f32x4*)(sh + col);
                    const f32x4 h = v[q][i] * rinv * g * (s1 + 1.0f) + s0; u32x2 o; o.x = cvt_pk_bf16(h[0], h[1]); o.y = cvt_pk_bf16(h[2], h[3]); *(u32x2*)(ha + (size_t)row * 1024 + col) = o; } } }
    }
}

#define MFMA16(a, b, c) __builtin_amdgcn_mfma_f32_16x16x32_bf16((a), (b), (c), 0, 0, 0)
#define MFMA32(a, b, c) __builtin_amdgcn_mfma_f32_32x32x16_bf16((a), (b), (c), 0, 0, 0)

__device__ __forceinline__ void mix_unit(const Ctx& c_, int l, int r0) { const Ctx c = fresh(c_);
    const bf16_t* Z = c.w<bf16_t>(WS_Z); bf16_t* Aq = (bf16_t*)c.lds; bf16_t* Akv = (bf16_t*)(c.lds + 12800); float* Lkr = (float*)(c.lds + 21504);
    float* Lu = (float*)(c.lds + 25600); bf16_t* Lp = (bf16_t*)(c.lds + 73728); float* Lcu = (float*)(c.lds + 90624); float* Lco = (float*)c.lds;
    const int s0 = r0 % SEQ, b = r0 / SEQ, fr = c.lane & 15, fq = c.lane >> 4;
    {   const int t = c.tid >> 4, sub = c.tid & 15; const bf16_t* zr = Z + (size_t)(r0 + t) * ZP;
        const u32x4 zero4 = {0u, 0u, 0u, 0u};
        const u32x4 ra0 = *(const u32x4*)(zr + Z_CQ + sub * 8), ra1 = (sub < 8) ? *(const u32x4*)(zr + Z_CQ + 128 + sub * 8) : zero4, rk0 = *(const u32x4*)(zr + Z_CKV + sub * 8), rkr = (sub < 4) ? *(const u32x4*)(zr + Z_KR + sub * 8) : zero4;
        u32x4 rp[3], rca[4], rcg[4];
#pragma unroll
        for (int i = 0; i < 3; ++i) { const int ch = c.tid + 512 * i, row = ch >> 5, c8 = ch & 31; rp[i] = (ch < 47 * 32 && s0 - 15 + row >= 0) ? *(const u32x4*)(Z + (size_t)(r0 - 15 + row) * ZP + Z_POOL + c8 * 8) : zero4; }
#pragma unroll
        for (int i = 0; i < 4; ++i) { const int ch = c.tid + 512 * i, row = ch >> 5, c8 = ch & 31; const bool ok = (ch < 62 * 32 && s0 - 30 + row >= 0);
            rca[i] = ok ? *(const u32x4*)(Z + (size_t)(r0 - 30 + row) * ZP + Z_CA + c8 * 8) : zero4; rcg[i] = ok ? *(const u32x4*)(Z + (size_t)(r0 - 30 + row) * ZP + Z_CG + c8 * 8) : zero4; }
        auto un8 = [](const u32x4 v, float (&o)[8]) { o[0] = bflo(v.x); o[1] = bfhi(v.x); o[2] = bflo(v.y); o[3] = bfhi(v.y); o[4] = bflo(v.z); o[5] = bfhi(v.z); o[6] = bflo(v.w); o[7] = bfhi(v.w); };
        const float* qag = c.inf(I_QAG) + l * 192; const float* kvag = c.inf(I_KVAG) + l * 128;
        float a0[8], a1[8], k0[8]; float ssq = 0.f, ssk = 0.f; un8(ra0, a0); un8(ra1, a1); un8(rk0, k0);
#pragma unroll
        for (int j = 0; j < 8; ++j) { ssq += a0[j] * a0[j] + a1[j] * a1[j]; ssk += k0[j] * k0[j]; }
#pragma unroll
        for (int m = 1; m < 16; m <<= 1) { ssq += __shfl_xor(ssq, m); ssk += __shfl_xor(ssk, m); }
        const float rq = frsqrt(ssq * (1.0f / 192.0f) + EPS), rk = frsqrt(ssk * (1.0f / 128.0f) + EPS);
#pragma unroll
        for (int j = 0; j < 8; ++j) a0[j] *= rq * qag[sub * 8 + j];
        *(u32x4*)(Aq + t * 200 + sub * 8) = pk8(a0);
        if (sub < 8) {
#pragma unroll
            for (int j = 0; j < 8; ++j) a1[j] *= rq * qag[128 + sub * 8 + j];
            *(u32x4*)(Aq + t * 200 + 128 + sub * 8) = pk8(a1); }
#pragma unroll
        for (int j = 0; j < 8; ++j) k0[j] *= rk * kvag[sub * 8 + j];
        *(u32x4*)(Akv + t * 136 + sub * 8) = pk8(k0);
        if (sub < 4) { float kr[8]; un8(rkr, kr);
#pragma unroll
            for (int j = 0; j < 8; ++j) Lkr[t * 32 + sub * 8 + j] = kr[j]; }
#pragma unroll
        for (int i = 0; i < 3; ++i) { const int ch = c.tid + 512 * i, row = ch >> 5, c8 = ch & 31; if (ch < 47 * 32) { float v[8]; un8(rp[i], v);
            *(f32x4*)(Lu + row * 256 + c8 * 8) = (f32x4){v[0], v[1], v[2], v[3]}; *(f32x4*)(Lu + row * 256 + c8 * 8 + 4) = (f32x4){v[4], v[5], v[6], v[7]}; } }
#pragma unroll
        for (int i = 0; i < 4; ++i) { const int ch = c.tid + 512 * i, row = ch >> 5, c8 = ch & 31; if (ch < 62 * 32) { float a[8], g[8]; un8(rca[i], a); un8(rcg[i], g);
#pragma unroll
            for (int j = 0; j < 8; ++j) a[j] *= fsigmoid(g[j]);
            *(f32x4*)(Lcu + row * 256 + c8 * 8) = (f32x4){a[0], a[1], a[2], a[3]}; *(f32x4*)(Lcu + row * 256 + c8 * 8 + 4) = (f32x4){a[4], a[5], a[6], a[7]}; } }
    }
    __syncthreads();
    const float* rcos = c.w<float>(WS_ROPE); const float* rsin = rcos + (size_t)NTOK * 16;
    if (c.wid < 4) {
        const int h = c.wid; const bf16_t* W = c.w<bf16_t>(WS_WUQ + (size_t)(l & 1) * WSET) + (size_t)(96 * h) * 192; const float* qg = c.inf(I_QG) + l * 96;
        f32x4 acc[6][2];
#pragma unroll
        for (int nf = 0; nf < 6; ++nf) { acc[nf][0] = (f32x4){0.f, 0.f, 0.f, 0.f}; acc[nf][1] = acc[nf][0]; }
#pragma unroll 3
        for (int ks = 0; ks < 6; ++ks) { bf16x8 af[2];
#pragma unroll
            for (int mf = 0; mf < 2; ++mf) af[mf] = *(const bf16x8*)(Aq + (mf * 16 + fr) * 200 + ks * 32 + fq * 8);
#pragma unroll
            for (int nf = 0; nf < 6; ++nf) { const bf16x8 bfr = *(const bf16x8*)(W + (size_t)(16 * nf + fr) * 192 + ks * 32 + fq * 8);
                acc[nf][0] = MFMA16(bfr, af[0], acc[nf][0]); acc[nf][1] = MFMA16(bfr, af[1], acc[nf][1]); } }
#pragma unroll
        for (int mf = 0; mf < 2; ++mf) { float ss = 0.f;
#pragma unroll
            for (int nf = 0; nf < 6; ++nf)
#pragma unroll
                for (int j = 0; j < 4; ++j) ss += acc[nf][mf][j] * acc[nf][mf][j];
            ss += __shfl_xor(ss, 16); ss += __shfl_xor(ss, 32);
            const float rinv = frsqrt(ss * (1.0f / 96.0f) + EPS) * (0.10206207261596575f * 1.44269504089f);
            const int tok = r0 + mf * 16 + fr; bf16_t* qo = c.w<bf16_t>(WS_Q) + ((size_t)(b * 4 + h) * SEQ + s0 + mf * 16 + fr) * 96;
            float v[6][4];
#pragma unroll
            for (int nf = 0; nf < 6; ++nf)
#pragma unroll
                for (int j = 0; j < 4; ++j) v[nf][j] = acc[nf][mf][j] * rinv * qg[16 * nf + 4 * fq + j];
            const f32x4 cs4 = *(const f32x4*)(rcos + (size_t)tok * 16 + 4 * fq), sn4 = *(const f32x4*)(rsin + (size_t)tok * 16 + 4 * fq);
#pragma unroll
            for (int j = 0; j < 4; ++j) { const float x1 = v[4][j], x2 = v[5][j]; v[4][j] = x1 * cs4[j] - x2 * sn4[j]; v[5][j] = x1 * sn4[j] + x2 * cs4[j]; }
#pragma unroll
            for (int nf = 0; nf < 6; ++nf) { u32x2 o; o.x = cvt_pk_bf16(v[nf][0], v[nf][1]); o.y = cvt_pk_bf16(v[nf][2], v[nf][3]); *(u32x2*)(qo + 16 * nf + 4 * fq) = o; } }
    } else {
        const int h = c.wid - 4; const bf16_t* W = c.w<bf16_t>(WS_WUKV + (size_t)(l & 1) * WSET) + (size_t)(128 * h) * 128; const float* kg = c.inf(I_KG) + l * 96;
        f32x4 ak[4][2], av[4][2];
#pragma unroll
        for (int nf = 0; nf < 4; ++nf) { ak[nf][0] = (f32x4){0.f, 0.f, 0.f, 0.f}; ak[nf][1] = ak[nf][0]; av[nf][0] = ak[nf][0]; av[nf][1] = ak[nf][0]; }
#pragma unroll 2
        for (int ks = 0; ks < 4; ++ks) { bf16x8 af[2];
#pragma unroll
            for (int mf = 0; mf < 2; ++mf) af[mf] = *(const bf16x8*)(Akv + (mf * 16 + fr) * 136 + ks * 32 + fq * 8);
#pragma unroll
            for (int nf = 0; nf < 4; ++nf) { const bf16x8 bk = *(const bf16x8*)(W + (size_t)(16 * nf + fr) * 128 + ks * 32 + fq * 8), bv = *(const bf16x8*)(W + (size_t)(64 + 16 * nf + fr) * 128 + ks * 32 + fq * 8);
                ak[nf][0] = MFMA16(bk, af[0], ak[nf][0]); ak[nf][1] = MFMA16(bk, af[1], ak[nf][1]);
                av[nf][0] = MFMA16(af[0], bv, av[nf][0]); av[nf][1] = MFMA16(af[1], bv, av[nf][1]); } }
#pragma unroll
        for (int mf = 0; mf < 2; ++mf) { const int tl = mf * 16 + fr; float ss = 0.f;
#pragma unroll
            for (int nf = 0; nf < 4; ++nf)
#pragma unroll
                for (int j = 0; j < 4; ++j) ss += ak[nf][mf][j] * ak[nf][mf][j];
#pragma unroll
            for (int j = 0; j < 8; ++j) { const float kr = Lkr[tl * 32 + fq * 8 + j]; ss += kr * kr; }
            ss += __shfl_xor(ss, 16); ss += __shfl_xor(ss, 32);
            const float rinv = frsqrt(ss * (1.0f / 96.0f) + EPS);
            const int tok = r0 + tl; bf16_t* ko = c.w<bf16_t>(WS_K) + ((size_t)(b * 4 + h) * SEQ + s0 + tl) * 96;
#pragma unroll
            for (int nf = 0; nf < 4; ++nf) { u32x2 o; o.x = cvt_pk_bf16(ak[nf][mf][0] * rinv * kg[16 * nf + 4 * fq], ak[nf][mf][1] * rinv * kg[16 * nf + 4 * fq + 1]);
                o.y = cvt_pk_bf16(ak[nf][mf][2] * rinv * kg[16 * nf + 4 * fq + 2], ak[nf][mf][3] * rinv * kg[16 * nf + 4 * fq + 3]); *(u32x2*)(ko + 16 * nf + 4 * fq) = o; }
            const f32x4 cs4 = *(const f32x4*)(rcos + (size_t)tok * 16 + 4 * fq), sn4 = *(const f32x4*)(rsin + (size_t)tok * 16 + 4 * fq);
            float o1[4], o2[4];
#pragma unroll
            for (int j = 0; j < 4; ++j) { const int i = 4 * fq + j; const float x1 = Lkr[tl * 32 + i] * rinv * kg[64 + i], x2 = Lkr[tl * 32 + 16 + i] * rinv * kg[80 + i];
                o1[j] = x1 * cs4[j] - x2 * sn4[j]; o2[j] = x1 * sn4[j] + x2 * cs4[j]; }
            { u32x2 o; o.x = cvt_pk_bf16(o1[0], o1[1]); o.y = cvt_pk_bf16(o1[2], o1[3]); *(u32x2*)(ko + 64 + 4 * fq) = o; o.x = cvt_pk_bf16(o2[0], o2[1]); o.y = cvt_pk_bf16(o2[2], o2[3]); *(u32x2*)(ko + 80 + 4 * fq) = o; }
            bf16_t* vo = c.w<bf16_t>(WS_VT) + (size_t)(b * 4 + h) * 64 * SEQ + s0 + mf * 16 + 4 * fq;
#pragma unroll
            for (int nf = 0; nf < 4; ++nf) { u32x2 o; o.x = cvt_pk_bf16(av[nf][mf][0], av[nf][mf][1]); o.y = cvt_pk_bf16(av[nf][mf][2], av[nf][mf][3]); *(u32x2*)(vo + (size_t)(16 * nf + fr) * SEQ) = o; } }
    }
    { const int t = c.tid >> 4, sub = c.tid & 15, g = sub >> 2, w = 2 << g, s = s0 + t; const float inv = 1.0f / (float)((s + 1 < w) ? (s + 1) : w);
#pragma unroll
        for (int k = 0; k < 2; ++k) { const int col = sub * 16 + k * 8; float sum[8];
#pragma unroll
            for (int j = 0; j < 8; ++j) sum[j] = 0.f;
            for (int d = 0; d < w; ++d) { const float* p = Lu + (t + 15 - d) * 256 + col;
#pragma unroll
                for (int j = 0; j < 8; ++j) sum[j] += p[j]; }
            const float* p0 = Lu + (t + 15) * 256 + col;
#pragma unroll
            for (int j = 0; j < 8; ++j) sum[j] = sum[j] * inv - p0[j];
            *(u32x4*)(Lp + t * 264 + col) = pk8(sum); } }
    float cres[16];
    { const int chn = c.tid & 255, half = c.tid >> 8; const float* dw = c.inf(I_DWW) + (size_t)l * 31 * 256 + chn; const float bias = c.inf(I_DWB)[l * 256 + chn];
        float wv[31];
#pragma unroll
        for (int j = 0; j < 31; ++j) wv[j] = dw[j * 256];
#pragma unroll
        for (int tt = 0; tt < 16; ++tt) cres[tt] = bias;
#pragma unroll
        for (int r = 0; r < 46; ++r) { const float u = Lcu[(half * 16 + r) * 256 + chn];
#pragma unroll
            for (int tt = 0; tt < 16; ++tt) { const int j = r - tt; if (j >= 0 && j < 31) cres[tt] += wv[j] * u; } } }
    __syncthreads();
    { const int g = c.wid >> 1, mf = c.wid & 1; const bf16_t* W = c.w<bf16_t>(WS_WPOOL + (size_t)(l & 1) * WSET) + g * 4096; const float* ps = c.inf(I_PSCALE) + l * 256 + g * 64;
        f32x4 acc[4];
#pragma unroll
        for (int nf = 0; nf < 4; ++nf) acc[nf] = (f32x4){0.f, 0.f, 0.f, 0.f};
#pragma unroll
        for (int ks = 0; ks < 2; ++ks) { const bf16x8 af = *(const bf16x8*)(Lp + (mf * 16 + fr) * 264 + g * 64 + ks * 32 + fq * 8);
#pragma unroll
            for (int nf = 0; nf < 4; ++nf) { const bf16x8 bfr = *(const bf16x8*)(W + (16 * nf + fr) * 64 + ks * 32 + fq * 8); acc[nf] = MFMA16(bfr, af, acc[nf]); } }
        bf16_t* yo = c.w<bf16_t>(WS_YB) + (size_t)(r0 + mf * 16 + fr) * 1024 + 256 + g * 64;
#pragma unroll
        for (int nf = 0; nf < 4; ++nf) { const int d = 16 * nf + 4 * fq; u32x2 o; o.x = cvt_pk_bf16(acc[nf][0] * ps[d], acc[nf][1] * ps[d + 1]); o.y = cvt_pk_bf16(acc[nf][2] * ps[d + 2], acc[nf][3] * ps[d + 3]); *(u32x2*)(yo + d) = o; } }
    { const int chn = c.tid & 255, half = c.tid >> 8;
#pragma unroll
        for (int tt = 0; tt < 16; ++tt) Lco[(half * 16 + tt) * 256 + chn] = cres[tt]; }
    __syncthreads();
    { const float* lg = c.inf(I_LNG) + l * 256 + c.lane * 4; const float* lb = c.inf(I_LNB) + l * 256 + c.lane * 4;
#pragma unroll
        for (int k = 0; k < 4; ++k) { const int t = c.wid * 4 + k; const f32x4 v = *(const f32x4*)(Lco + t * 256 + c.lane * 4);
            const float mean = wave_sum(v[0] + v[1] + v[2] + v[3]) * (1.0f / 256.0f); const f32x4 d = v - mean;
            const float var = wave_sum(d[0] * d[0] + d[1] * d[1] + d[2] * d[2] + d[3] * d[3]) * (1.0f / 256.0f); const float rs = frsqrt(var + EPS);
            float y[4];
#pragma unroll
            for (int j = 0; j < 4; ++j) y[j] = fsilu(d[j] * rs * lg[j] + lb[j]);
            u32x2 o; o.x = cvt_pk_bf16(y[0], y[1]); o.y = cvt_pk_bf16(y[2], y[3]); *(u32x2*)(c.w<bf16_t>(WS_YB) + (size_t)(r0 + t) * 1024 + 768 + c.lane * 4) = o; } }
    __syncthreads();
}

constexpr int CW_W13 = 32 * 16 * 16, CW_W2 = 32 * 8 * 32, CW_IN = 16 * 72, CW_OUT = 16 * 32, CW_UQ = 3 * 12, CW_UKV = 2 * 16, CW_POOL = 4 * 2;
constexpr int CW_TOTAL = 2 * CW_W13 + CW_W2 + CW_IN + CW_OUT + CW_UQ + CW_UKV + CW_POOL;
struct CvtTile { const float* src; bf16_t* dst; int ldn, ldk; };
__device__ __forceinline__ void cvt_decode(const Ctx& c, int l, int t, CvtTile& d) {
    const size_t wso = (size_t)(l & 1) * WSET; int r = t;
    if (r < 2 * CW_W13) { const int which = r / CW_W13; r %= CW_W13; const int e = r >> 8, kt = (r >> 4) & 15, nt = r & 15, n0 = nt * 32;
        d.src = c.inf(which ? I_W3 : I_W1) + ((size_t)l * 32 + e) * 1024 * 512 + (size_t)kt * 64 * 512 + n0; d.ldn = 512; d.ldk = 1024;
        d.dst = c.w<bf16_t>(WS_WUP + wso) + (size_t)e * 1024 * 1024 + (size_t)((n0 >> 7) * 256 + which * 128 + (n0 & 127)) * 1024 + kt * 64; return; } r -= 2 * CW_W13;
    if (r < CW_W2) { const int e = r >> 8, kt = (r >> 5) & 7, nt = r & 31;
        d.src = c.inf(I_W2) + ((size_t)l * 32 + e) * 512 * 1024 + (size_t)kt * 64 * 1024 + nt * 32; d.ldn = 1024; d.ldk = 512;
        d.dst = c.w<bf16_t>(WS_WDN + wso) + (size_t)e * 1024 * 512 + (size_t)(nt * 32) * 512 + kt * 64; return; } r -= CW_W2;
    if (r < CW_IN) { const int kt = r / 72, nt = r % 72; d.src = (nt < 67) ? c.inf(I_WIN) + (size_t)l * 1024 * 2144 + (size_t)kt * 64 * 2144 + nt * 32 : nullptr; d.ldn = 2144; d.ldk = 1024;
        d.dst = c.w<bf16_t>(WS_WIN + wso) + (size_t)(nt * 32) * 1024 + kt * 64; return; } r -= CW_IN;
    if (r < CW_OUT) { const int kt = r >> 5, nt = r & 31; d.src = c.inf(I_WOUT) + (size_t)l * 1024 * 1024 + (size_t)kt * 64 * 1024 + nt * 32; d.ldn = 1024; d.ldk = 1024;
        d.dst = c.w<bf16_t>(WS_WOUT + wso) + (size_t)(nt * 32) * 1024 + kt * 64; return; } r -= CW_OUT;
    if (r < CW_UQ) { const int kt = r / 12, nt = r % 12; d.src = c.inf(I_WUQ) + (size_t)l * 192 * 384 + (size_t)kt * 64 * 384 + nt * 32; d.ldn = 384; d.ldk = 192;
        d.dst = c.w<bf16_t>(WS_WUQ + wso) + (size_t)(nt * 32) * 192 + kt * 64; return; } r -= CW_UQ;
    if (r < CW_UKV) { const int kt = r >> 4, nt = r & 15; d.src = c.inf(I_WUKV) + (size_t)l * 128 * 512 + (size_t)kt * 64 * 512 + nt * 32; d.ldn = 512; d.ldk = 128;
        d.dst = c.w<bf16_t>(WS_WUKV + wso) + (size_t)(nt * 32) * 128 + kt * 64; return; } r -= CW_UKV;
    { const int g = r >> 1, nt = r & 1; d.src = c.inf(I_WPOOL) + ((size_t)l * 4 + g) * 4096 + nt * 32; d.ldn = 64; d.ldk = 64; d.dst = c.w<bf16_t>(WS_WPOOL + wso) + g * 4096 + (size_t)(nt * 32) * 64; }
}
__device__ __forceinline__ void cvt_wave(const Ctx& c, int l, int wrank, int nwaves, float* T) {
    { const float* rgw = c.inf(I_RGW) + (size_t)l * 1024 * 4; const float* rew = c.inf(I_REW) + (size_t)l * 1024 * 32; float* rwt = c.w<float>(WS_RWT + (size_t)(l & 1) * WSET);
        for (int e = wrank * 64 + c.lane; e < 36 * 1024; e += nwaves * 64) { const int g = e >> 10, k = e & 1023; rwt[e] = (g < 4) ? rgw[k * 4 + g] : rew[k * 32 + g - 4]; } }
    f32x4 v[8]; CvtTile cur; cur.src = nullptr; cur.dst = nullptr; cur.ldn = 0; cur.ldk = 0;
    auto issue = [&](const CvtTile& d) {
#pragma unroll
        for (int i = 0; i < 8; ++i) { const int e4 = c.lane + 64 * i, kk = e4 >> 3, n4 = e4 & 7; v[i] = d.src ? *(const f32x4*)(d.src + (size_t)kk * d.ldn + n4 * 4) : (f32x4){0.f, 0.f, 0.f, 0.f}; } };
    int t = wrank;
    if (t < CW_TOTAL) { cvt_decode(c, l, t, cur); issue(cur); }
    while (t < CW_TOTAL) {
#pragma unroll
        for (int i = 0; i < 8; ++i) { const int e4 = c.lane + 64 * i, kk = e4 >> 3, n4 = e4 & 7; float* p = T + kk * 33 + n4 * 4; p[0] = v[i][0]; p[1] = v[i][1]; p[2] = v[i][2]; p[3] = v[i][3]; }
        const int tn = t + nwaves; CvtTile nxt = cur; if (tn < CW_TOTAL) { cvt_decode(c, l, tn, nxt); issue(nxt); }
        __builtin_amdgcn_wave_barrier();
        { const int n = c.lane & 31, kh = c.lane >> 5; bf16_t* drow = cur.dst + (size_t)n * cur.ldk + kh * 32;
#pragma unroll
            for (int q = 0; q < 4; ++q) { float o[8];
#pragma unroll
                for (int j = 0; j < 8; ++j) o[j] = T[(kh * 32 + q * 8 + j) * 33 + n];
                *(u32x4*)(drow + q * 8) = pk8(o); } }
        __builtin_amdgcn_wave_barrier();
        t = tn; cur = nxt;
    }
}

#ifdef EMU
static inline float __builtin_amdgcn_logf(float x) { return log2f(x); }
#endif
constexpr int HGP = 68, HGV = 40;
constexpr int HG_LG = 0, HG_LK = 8704, HG_LQ = 17408, HG_LVT = 26112, HG_LEG = 31232, HG_LGG = 31488, HG_BYTES = 31744;
template <bool OUT> __device__ __forceinline__ void hgrn_mfma(const Ctx& c_, int l, int bu, int cvt_layer = NL) { const Ctx c = fresh(c_);
    if (c.wid < 4) {
        const int cu = bu * 4 + c.wid, bh = cu / NCH, chunk = cu % NCH, b = bh >> 2, h = bh & 3, tok0 = b * SEQ + chunk * 128;
        const bf16_t* Z = c.w<bf16_t>(WS_Z); const float lbd = c.w<float>(WS_LB)[l * 256 + h * 64 + c.lane];
        unsigned char* L = c.lds + c.wid * HG_BYTES; float* Lg = (float*)(L + HG_LG); float* Lk = (float*)(L + HG_LK); float* Lq = (float*)(L + HG_LQ); bf16_t* Lvt = (bf16_t*)(L + HG_LVT); float* LeG = (float*)(L + HG_LEG); float* LG = (float*)(L + HG_LGG);
        const int l31 = c.lane & 31, hi = c.lane >> 5;
        f32x16 S[2][2];
        if (OUT) { const float* s0 = c.w<float>(WS_S0) + (size_t)(bh * NCH + chunk) * 4096;
#pragma unroll
            for (int mf = 0; mf < 2; ++mf)
#pragma unroll
                for (int nf = 0; nf < 2; ++nf)
#pragma unroll
                    for (int r = 0; r < 16; ++r) S[mf][nf][r] = s0[(32 * mf + (r & 3) + 8 * (r >> 2) + 4 * hi) * 64 + 32 * nf + l31]; }
        else {
#pragma unroll
            for (int mf = 0; mf < 2; ++mf)
#pragma unroll
                for (int nf = 0; nf < 2; ++nf)
#pragma unroll
                    for (int r = 0; r < 16; ++r) S[mf][nf][r] = 0.f; }
        float gtot = 0.f; const float og0 = OUT ? c.inf(I_HOG)[l * 64 + l31] : 0.f, og1 = OUT ? c.inf(I_HOG)[l * 64 + 32 + l31] : 0.f;
        u32x4 rf[4], rq[4], rv[4];
        { const bf16_t* zn = Z + (size_t)(tok0 + (c.lane >> 3)) * ZP + h * 64 + (c.lane & 7) * 8;
#pragma unroll
            for (int i = 0; i < 4; ++i) { rf[i] = *(const u32x4*)(zn + (size_t)i * 8 * ZP + Z_HF); rv[i] = *(const u32x4*)(zn + (size_t)i * 8 * ZP + Z_HI); if (OUT) rq[i] = *(const u32x4*)(zn + (size_t)i * 8 * ZP + Z_HQ); else rq[i] = (u32x4){0u, 0u, 0u, 0u}; } }
#pragma unroll 1
        for (int sc = 0; sc < 4; ++sc) { const int tokb = tok0 + sc * 32;
            {
                const int rr = c.lane >> 3, c8 = (c.lane & 7) * 8;
#pragma unroll
                for (int i = 0; i < 4; ++i) { const int tr = i * 8 + rr; float x[8];
                    { const u32x4 v = rf[i]; x[0] = bflo(v.x); x[1] = bfhi(v.x); x[2] = bflo(v.y); x[3] = bfhi(v.y); x[4] = bflo(v.z); x[5] = bfhi(v.z); x[6] = bflo(v.w); x[7] = bfhi(v.w); }
                    *(f32x4*)(Lg + tr * HGP + c8) = (f32x4){x[0], x[1], x[2], x[3]}; *(f32x4*)(Lg + tr * HGP + c8 + 4) = (f32x4){x[4], x[5], x[6], x[7]};
                    if (OUT) { const u32x4 v = rq[i]; x[0] = fsilu(bflo(v.x)); x[1] = fsilu(bfhi(v.x)); x[2] = fsilu(bflo(v.y)); x[3] = fsilu(bfhi(v.y)); x[4] = fsilu(bflo(v.z)); x[5] = fsilu(bfhi(v.z)); x[6] = fsilu(bflo(v.w)); x[7] = fsilu(bfhi(v.w));
                        *(f32x4*)(Lq + tr * HGP + c8) = (f32x4){x[0], x[1], x[2], x[3]}; *(f32x4*)(Lq + tr * HGP + c8 + 4) = (f32x4){x[4], x[5], x[6], x[7]}; }
                    { const u32x4 v = rv[i]; const unsigned w4[4] = {v.x, v.y, v.z, v.w};
#pragma unroll
                        for (int k = 0; k < 4; ++k) { Lvt[(c8 + 2 * k) * HGV + tr] = (bf16_t)(w4[k] & 0xffffu); Lvt[(c8 + 2 * k + 1) * HGV + tr] = (bf16_t)(w4[k] >> 16); } } }
                if (sc < 3) { const bf16_t* zn = Z + (size_t)(tokb + 32 + rr) * ZP + h * 64 + c8;
#pragma unroll
                    for (int i = 0; i < 4; ++i) { rf[i] = *(const u32x4*)(zn + (size_t)i * 8 * ZP + Z_HF); rv[i] = *(const u32x4*)(zn + (size_t)i * 8 * ZP + Z_HI); if (OUT) rq[i] = *(const u32x4*)(zn + (size_t)i * 8 * ZP + Z_HQ); } }
                __builtin_amdgcn_wave_barrier();
                float run = 0.f;
#pragma unroll
                for (int t = 0; t < 32; ++t) { const float f = lbd + (1.0f - lbd) * fsigmoid(Lg[t * HGP + c.lane]); run += __builtin_amdgcn_logf(f); Lg[t * HGP + c.lane] = run; Lk[t * HGP + c.lane] = 1.0f - f; }
                LG[c.lane] = run; LeG[c.lane] = __builtin_amdgcn_exp2f(run); gtot += run;
            }
            __builtin_amdgcn_wave_barrier();
            bf16x8 vt[2][2];
#pragma unroll
            for (int nf = 0; nf < 2; ++nf)
#pragma unroll
                for (int ks = 0; ks < 2; ++ks) vt[nf][ks] = *(const bf16x8*)(Lvt + (32 * nf + l31) * HGV + 16 * ks + 8 * hi);
            f32x16 O[2];
            if (OUT) {
#pragma unroll
                for (int r = 0; r < 16; ++r) { O[0][r] = 0.f; O[1][r] = 0.f; }
                float acc[16];
#pragma unroll
                for (int m = 0; m < 16; ++m) acc[m] = 0.f;
#pragma unroll 1
                for (int d4 = 0; d4 < 16; ++d4) { const f32x4 qt = *(const f32x4*)(Lq + l31 * HGP + 4 * d4), gt = *(const f32x4*)(Lg + l31 * HGP + 4 * d4);
#pragma unroll
                    for (int m = 0; m < 16; ++m) { const int s = 16 * (m >> 3) + 8 * hi + (m & 7); const f32x4 k4 = *(const f32x4*)(Lk + s * HGP + 4 * d4), g4 = *(const f32x4*)(Lg + s * HGP + 4 * d4);
#pragma unroll
                        for (int e = 0; e < 4; ++e) acc[m] += qt[e] * k4[e] * __builtin_amdgcn_exp2f(gt[e] - g4[e]); } }
                bf16x8 af[2];
#pragma unroll
                for (int ks = 0; ks < 2; ++ks) { float a8[8];
#pragma unroll
                    for (int j = 0; j < 8; ++j) { const int s = 16 * ks + 8 * hi + j; a8[j] = (s <= l31) ? acc[ks * 8 + j] : 0.f; }
                    af[ks] = __builtin_bit_cast(bf16x8, pk8(a8)); }
#pragma unroll
                for (int mf = 0; mf < 2; ++mf)
#pragma unroll
                    for (int s = 0; s < 2; ++s) { const int d0 = 32 * mf + 16 * s + 4 * hi;
                        const f32x4 qa = *(const f32x4*)(Lq + l31 * HGP + d0), qb = *(const f32x4*)(Lq + l31 * HGP + d0 + 8), ga = *(const f32x4*)(Lg + l31 * HGP + d0), gb = *(const f32x4*)(Lg + l31 * HGP + d0 + 8);
                        float q8[8];
#pragma unroll
                        for (int j = 0; j < 4; ++j) { q8[j] = qa[j] * __builtin_amdgcn_exp2f(ga[j]); q8[4 + j] = qb[j] * __builtin_amdgcn_exp2f(gb[j]); }
                        const bf16x8 qf = __builtin_bit_cast(bf16x8, pk8(q8));
#pragma unroll
                        for (int nf = 0; nf < 2; ++nf) { float s8[8];
#pragma unroll
                            for (int j = 0; j < 8; ++j) s8[j] = S[mf][nf][8 * s + j];
                            O[nf] = MFMA32(qf, __builtin_bit_cast(bf16x8, pk8(s8)), O[nf]); } }
#pragma unroll
                for (int nf = 0; nf < 2; ++nf)
#pragma unroll
                    for (int ks = 0; ks < 2; ++ks) O[nf] = MFMA32(af[ks], vt[nf][ks], O[nf]);
            }
#pragma unroll
            for (int mf = 0; mf < 2; ++mf) {
#pragma unroll
                for (int q = 0; q < 4; ++q) { const f32x4 e4 = *(const f32x4*)(LeG + 32 * mf + 8 * q + 4 * hi);
#pragma unroll
                    for (int e = 0; e < 4; ++e) { S[mf][0][4 * q + e] *= e4[e]; S[mf][1][4 * q + e] *= e4[e]; } }
                const int d = 32 * mf + l31; const float Gd = LG[d];
#pragma unroll
                for (int ks = 0; ks < 2; ++ks) { float k8[8];
#pragma unroll
                    for (int j = 0; j < 8; ++j) { const int s = 16 * ks + 8 * hi + j; k8[j] = Lk[s * HGP + d] * __builtin_amdgcn_exp2f(Gd - Lg[s * HGP + d]); }
                    const bf16x8 kf = __builtin_bit_cast(bf16x8, pk8(k8));
                    S[mf][0] = MFMA32(kf, vt[0][ks], S[mf][0]); S[mf][1] = MFMA32(kf, vt[1][ks], S[mf][1]); } }
            if (OUT) {
#pragma unroll
                for (int r = 0; r < 16; ++r) { const int tl = (r & 3) + 8 * (r >> 2) + 4 * hi; float ss = O[0][r] * O[0][r] + O[1][r] * O[1][r];
#pragma unroll
                    for (int m = 1; m < 32; m <<= 1) ss += __shfl_xor(ss, m);
                    const float rinv = frsqrt(ss * (1.0f / 64.0f) + EPS); const size_t tok = (size_t)(tokb + tl);
                    const float g0 = bf2f(Z[tok * ZP + Z_HG + h * 64 + l31]), g1 = bf2f(Z[tok * ZP + Z_HG + h * 64 + 32 + l31]);
                    bf16_t* yo = c.w<bf16_t>(WS_YB) + tok * 1024 + 512 + h * 64;
                    yo[l31] = (bf16_t)f2bf_bits(O[0][r] * rinv * og0 * fsilu(g0)); yo[32 + l31] = (bf16_t)f2bf_bits(O[1][r] * rinv * og1 * fsilu(g1)); } }
            __builtin_amdgcn_wave_barrier();
        }
        if (!OUT) { float* sc = c.w<float>(WS_SC) + (size_t)(bh * NCH + chunk) * 4096;
#pragma unroll
            for (int mf = 0; mf < 2; ++mf)
#pragma unroll
                for (int nf = 0; nf < 2; ++nf)
#pragma unroll
                    for (int r = 0; r < 16; ++r) sc[(32 * mf + (r & 3) + 8 * (r >> 2) + 4 * hi) * 64 + 32 * nf + l31] = S[mf][nf][r];
            c.w<float>(WS_PC)[(size_t)(bh * NCH + chunk) * 64 + c.lane] = __builtin_amdgcn_exp2f(gtot); }
    } else if (OUT && cvt_layer < NL) {
        cvt_wave(c, cvt_layer, bu * 4 + (c.wid - 4), NBH * NCH, (float*)(c.lds + 4 * HG_BYTES + (c.wid - 4) * 8448));
    }
    __syncthreads();
}
__device__ __forceinline__ void hgrn_carry(const Ctx& c_, int l) { const Ctx c = fresh(c_);
    const float* SC = c.w<float>(WS_SC); const float* PC = c.w<float>(WS_PC); float* S0 = c.w<float>(WS_S0);
    for (int e = c.blk * 512 + c.tid; e < NBH * 4096; e += c.G * 512) { const int bh = e >> 12, dv = e & 4095, d = dv >> 6; float s = 0.f;
#pragma unroll 8
        for (int ch = 0; ch < NCH; ++ch) { const size_t o = (size_t)(bh * NCH + ch) * 4096 + dv; S0[o] = s; s = PC[(size_t)(bh * NCH + ch) * 64 + d] * s + SC[o]; } }
    ASMV("s_waitcnt vmcnt(0)" ::: "memory");
    __syncthreads();
    if (c.tid == 0) { __builtin_amdgcn_fence(__ATOMIC_RELEASE, "agent"); ASMV("s_waitcnt vmcnt(0)" ::: "memory");
        (void)__hip_atomic_fetch_add((unsigned*)(c.ws + WS_CTL + CTL_HG) + l * 64, 1u, __ATOMIC_RELAXED, __HIP_MEMORY_SCOPE_AGENT); }
}
__device__ __forceinline__ void hgrn_wait_carry(const Ctx& c, int l) {
    if (c.tid == 0) { unsigned* p = (unsigned*)(c.ws + WS_CTL + CTL_HG) + l * 64; unsigned sp = 0;
        while (__hip_atomic_load(p, __ATOMIC_RELAXED, __HIP_MEMORY_SCOPE_AGENT) < (unsigned)c.G) { __builtin_amdgcn_s_sleep(1); if (++sp > (1u << 22)) break; }
        __builtin_amdgcn_fence(__ATOMIC_ACQUIRE, "agent"); ASMV("s_waitcnt vmcnt(0)" ::: "memory"); }
    __syncthreads();
}
__device__ __forceinline__ void ph_mixers(const Ctx& c, int l) {
    if (c.blk & 1) for (int bu = c.blk; bu < NBH * NCH / 4; bu += c.G) hgrn_mfma<false>(c, l, bu);
    for (int u = c.blk; u < NTOK / 32; u += c.G) mix_unit(c, l, u * 32);
    if (!(c.blk & 1)) for (int bu = c.blk; bu < NBH * NCH / 4; bu += c.G) hgrn_mfma<false>(c, l, bu);
}

__device__ __forceinline__ void attn_unit(const Ctx& c_, int bh, int qt) { const Ctx c = fresh(c_);
    const bf16_t* Qg = c.w<bf16_t>(WS_Q) + (size_t)bh * SEQ * 96; const bf16_t* Kg = c.w<bf16_t>(WS_K) + (size_t)bh * SEQ * 96; const bf16_t* Vg = c.w<bf16_t>(WS_VT) + (size_t)bh * 64 * SEQ;
    constexpr int KROW = 104, VROW = 72, KB = 64 * KROW * 2, VB = 64 * VROW * 2;
    const int l31 = c.lane & 31, hi = c.lane >> 5, qrow = qt * 256 + c.wid * 32 + l31;
    bf16x8 qf[6];
#pragma unroll
    for (int ks = 0; ks < 6; ++ks) qf[ks] = *(const bf16x8*)(Qg + (size_t)qrow * 96 + ks * 16 + hi * 8);
    f32x16 o0, o1;
#pragma unroll
    for (int r = 0; r < 16; ++r) { o0[r] = 0.f; o1[r] = 0.f; }
    float mrun = -INFINITY, lsum = 0.f;
    const int nkt = 4 * (qt + 1), mylast = 4 * qt + (c.wid >> 1);
    const int kr0 = c.tid / 12, kc0 = c.tid % 12, kr1 = (c.tid + 512) / 12, kc1 = (c.tid + 512) % 12, vr = c.tid >> 3, vc = c.tid & 7;
    u32x4 sk0, sk1, sv;
    auto gload = [&](int kt) { sk0 = *(const u32x4*)(Kg + (size_t)(kt * 64 + kr0) * 96 + kc0 * 8); if (c.tid < 256) sk1 = *(const u32x4*)(Kg + (size_t)(kt * 64 + kr1) * 96 + kc1 * 8);
                               sv = *(const u32x4*)(Vg + (size_t)vr * SEQ + kt * 64 + vc * 8); };
    auto lstore = [&](int buf) { unsigned char* kb = c.lds + buf * (KB + VB); unsigned char* vb = kb + KB;
                                 *(u32x4*)(kb + (kr0 * KROW + kc0 * 8) * 2) = sk0; if (c.tid < 256) *(u32x4*)(kb + (kr1 * KROW + kc1 * 8) * 2) = sk1; *(u32x4*)(vb + (vr * VROW + vc * 8) * 2) = sv; };
    gload(0); lstore(0); __syncthreads();
    for (int kt = 0; kt < nkt; ++kt) {
        if (kt + 1 < nkt) gload(kt + 1);
        if (kt <= mylast) {
            const bf16_t* kb = (const bf16_t*)(c.lds + (kt & 1) * (KB + VB)); const bf16_t* vb = (const bf16_t*)(c.lds + (kt & 1) * (KB + VB) + KB);
            f32x16 s0, s1;
#pragma unroll
            for (int r = 0; r < 16; ++r) { s0[r] = 0.f; s1[r] = 0.f; }
#pragma unroll
            for (int ks = 0; ks < 6; ++ks) { const bf16x8 k0 = *(const bf16x8*)(kb + l31 * KROW + ks * 16 + hi * 8), k1 = *(const bf16x8*)(kb + (32 + l31) * KROW + ks * 16 + hi * 8);
                s0 = MFMA32(k0, qf[ks], s0); s1 = MFMA32(k1, qf[ks], s1); }
            if (kt == mylast) {
#pragma unroll
                for (int r = 0; r < 16; ++r) { const int key = kt * 64 + (r & 3) + 8 * (r >> 2) + 4 * hi; if (key > qrow) s0[r] = -INFINITY; if (key + 32 > qrow) s1[r] = -INFINITY; } }
            float mx = s0[0];
#pragma unroll
            for (int r = 1; r < 16; ++r) mx = fmaxf(mx, s0[r]);
#pragma unroll
            for (int r = 0; r < 16; ++r) mx = fmaxf(mx, s1[r]);
            mx = fmaxf(mx, __shfl_xor(mx, 32));
            const float mnew = fmaxf(mrun, mx), alpha = __builtin_amdgcn_exp2f(mrun - mnew); mrun = mnew;
            float ps = 0.f;
#pragma unroll
            for (int r = 0; r < 16; ++r) { s0[r] = __builtin_amdgcn_exp2f(s0[r] - mnew); s1[r] = __builtin_amdgcn_exp2f(s1[r] - mnew); ps += s0[r] + s1[r]; }
            lsum = lsum * alpha + ps;
#pragma unroll
            for (int r = 0; r < 16; ++r) { o0[r] *= alpha; o1[r] *= alpha; }
#pragma unroll
            for (int kf = 0; kf < 2; ++kf)
#pragma unroll
                for (int s = 0; s < 2; ++s) { const f32x16& sx = kf ? s1 : s0; u32x4 pw; pw.x = cvt_pk_bf16(sx[8 * s], sx[8 * s + 1]); pw.y = cvt_pk_bf16(sx[8 * s + 2], sx[8 * s + 3]); pw.z = cvt_pk_bf16(sx[8 * s + 4], sx[8 * s + 5]); pw.w = cvt_pk_bf16(sx[8 * s + 6], sx[8 * s + 7]);
                    const bf16x8 pf = __builtin_bit_cast(bf16x8, pw); const int kcol = kf * 32 + 16 * s + 4 * hi;
                    const s16x4 a0 = *(const s16x4*)(vb + l31 * VROW + kcol), a1 = *(const s16x4*)(vb + l31 * VROW + kcol + 8), b0 = *(const s16x4*)(vb + (32 + l31) * VROW + kcol), b1 = *(const s16x4*)(vb + (32 + l31) * VROW + kcol + 8);
                    const bf16x8 v0 = (bf16x8){a0[0], a0[1], a0[2], a0[3], a1[0], a1[1], a1[2], a1[3]}, v1 = (bf16x8){b0[0], b0[1], b0[2], b0[3], b1[0], b1[1], b1[2], b1[3]};
                    o0 = MFMA32(v0, pf, o0); o1 = MFMA32(v1, pf, o1); }
        }
        if (kt + 1 < nkt) lstore((kt + 1) & 1);
        __syncthreads();
    }
    lsum += __shfl_xor(lsum, 32); const float rl = 1.0f / lsum;
    const int b = bh >> 2, h = bh & 3; bf16_t* yo = c.w<bf16_t>(WS_YB) + (size_t)(b * SEQ + qrow) * 1024 + h * 64;
#pragma unroll
    for (int g = 0; g < 4; ++g) { const int dv = 8 * g + 4 * hi; u32x2 w0, w1;
        w0.x = cvt_pk_bf16(o0[4 * g] * rl, o0[4 * g + 1] * rl); w0.y = cvt_pk_bf16(o0[4 * g + 2] * rl, o0[4 * g + 3] * rl); *(u32x2*)(yo + dv) = w0;
        w1.x = cvt_pk_bf16(o1[4 * g] * rl, o1[4 * g + 1] * rl); w1.y = cvt_pk_bf16(o1[4 * g + 2] * rl, o1[4 * g + 3] * rl); *(u32x2*)(yo + 32 + dv) = w1; }
    __syncthreads();
}
__device__ __forceinline__ void ph_attn(const Ctx& c, int l) {
    hgrn_carry(c, l);
    { const int NU = NBH * (NQT / 2);
      if ((c.G & 7) == 0) { const int per = (NU + 7) / 8, x = c.blk & 7, G8 = c.G >> 3;
          for (int j = c.blk >> 3; j < per; j += G8) { const int pu = x * per + j; if (pu < NU) { const int bh = pu / (NQT / 2), p = pu % (NQT / 2); attn_unit(c, bh, NQT - 1 - p); attn_unit(c, bh, p); } } }
      else for (int pu = c.blk; pu < NU; pu += c.G) { const int bh = pu / (NQT / 2), p = pu % (NQT / 2); attn_unit(c, bh, NQT - 1 - p); attn_unit(c, bh, p); } }
    hgrn_wait_carry(c, l);
    for (int bu = c.blk; bu < NBH * NCH / 4; bu += c.G) hgrn_mfma<true>(c, l, bu, l + 1);
}

__device__ __forceinline__ void ph_router(const Ctx& c_, int l, int cnt_off = 0) { const Ctx c = fresh(c_);
    float* RW = (float*)c.lds;
    int* Le = (int*)(c.lds + 147456); float* Lw = (float*)(c.lds + 147456 + 1024); int* Lr = (int*)(c.lds + 147456 + 2048); int* Lcnt = (int*)(c.lds + 147456 + 3072); int* Lbase = Lcnt + 32;
    { const float* rwt = c.w<float>(WS_RWT + (size_t)(l & 1) * WSET);
        for (int e = c.tid * 4; e < 36 * 1024; e += 2048) *(f32x4*)(RW + e) = *(const f32x4*)(rwt + e); }
    const float* rgb = c.inf(I_RGB) + l * 4; const float* reb = c.inf(I_REB) + l * 32;
    const float* x = c.a->out; const float* gn = c.inf(I_N2G) + l * 1024; const float* mod = c.w<float>(WS_MOD) + (size_t)l * NB * 6144; bf16_t* ha = c.w<bf16_t>(WS_HA);
    unsigned* cnt = (unsigned*)(c.ws + WS_CTL + CTL_CNT) + l * 32 + cnt_off;
    int* asge = c.w<int>(WS_ASGE); int* asgr = c.w<int>(WS_ASGR); float* asgw = c.w<float>(WS_ASGW);
    __syncthreads();
    auto decide = [&](int rl, const float (&lg)[36]) {
        int gi = 0; float gm = lg[0] + rgb[0];
#pragma unroll
        for (int g = 1; g < 4; ++g) { const float t = lg[g] + rgb[g]; if (t > gm) { gm = t; gi = g; } }
        float den = 0.f;
#pragma unroll
        for (int g = 0; g < 4; ++g) den += expf(lg[g] + rgb[g] - gm);
        const float gw = 1.0f / den;
        float e1 = -INFINITY, e2 = -INFINITY; int i1 = 0, i2 = 0;
#pragma unroll
        for (int g = 0; g < 4; ++g) if (g == gi) {
#pragma unroll
            for (int j = 0; j < 8; ++j) { const float t = lg[4 + g * 8 + j] + reb[g * 8 + j]; if (t > e1) { e2 = e1; i2 = i1; e1 = t; i1 = j; } else if (t > e2) { e2 = t; i2 = j; } } }
        const float p2 = expf(e2 - e1), w1 = gw / (1.0f + p2), w2 = gw * p2 / (1.0f + p2);
        if (c.lane == 0) { const int ea = gi * 8 + i1, eb = gi * 8 + i2; Le[rl * 2] = ea; Le[rl * 2 + 1] = eb; Lw[rl * 2] = w1; Lw[rl * 2 + 1] = w2;
            Lr[rl * 2] = atomicAdd(&Lcnt[ea], 1); Lr[rl * 2 + 1] = atomicAdd(&Lcnt[eb], 1); } };
    for (int u = c.blk; u < NTOK / 128; u += c.G) {
        if (c.tid < 32) Lcnt[c.tid] = 0;
        __syncthreads();
        const int rowb = u * 128 + c.wid * 16, b = rowb / SEQ; const float* sh = mod + b * 6144 + 3072; const float* sc = sh + 1024;
        f32x4 nv[2][4];
#pragma unroll
        for (int q = 0; q < 2; ++q)
#pragma unroll
            for (int i = 0; i < 4; ++i) nv[q][i] = *(const f32x4*)(x + (size_t)(rowb + q) * 1024 + i * 256 + c.lane * 4);
#pragma unroll 1
        for (int kp = 0; kp < 8; ++kp) {
            f32x4 v[2][4];
#pragma unroll
            for (int q = 0; q < 2; ++q)
#pragma unroll
                for (int i = 0; i < 4; ++i) v[q][i] = nv[q][i];
            if (kp < 7) {
#pragma unroll
                for (int q = 0; q < 2; ++q)
#pragma unroll
                    for (int i = 0; i < 4; ++i) nv[q][i] = *(const f32x4*)(x + (size_t)(rowb + 2 * kp + 2 + q) * 1024 + i * 256 + c.lane * 4); }
            float ss0 = 0.f, ss1 = 0.f;
#pragma unroll
            for (int i = 0; i < 4; ++i) { ss0 += v[0][i][0] * v[0][i][0] + v[0][i][1] * v[0][i][1] + v[0][i][2] * v[0][i][2] + v[0][i][3] * v[0][i][3]; ss1 += v[1][i][0] * v[1][i][0] + v[1][i][1] * v[1][i][1] + v[1][i][2] * v[1][i][2] + v[1][i][3] * v[1][i][3]; }
            ss0 = wave_sum(ss0); ss1 = wave_sum(ss1); const float ri0 = frsqrt(ss0 * (1.0f / 1024.0f) + EPS), ri1 = frsqrt(ss1 * (1.0f / 1024.0f) + EPS);
#pragma unroll
            for (int i = 0; i < 4; ++i) { const int col = i * 256 + c.lane * 4; const f32x4 gs = (*(const f32x4*)(gn + col)) * (*(const f32x4*)(sc + col) + 1.0f), s0 = *(const f32x4*)(sh + col);
                v[0][i] = v[0][i] * ri0 * gs + s0; v[1][i] = v[1][i] * ri1 * gs + s0;
                u32x2 o; o.x = cvt_pk_bf16(v[0][i][0], v[0][i][1]); o.y = cvt_pk_bf16(v[0][i][2], v[0][i][3]); *(u32x2*)(ha + (size_t)(rowb + 2 * kp) * 1024 + col) = o;
                o.x = cvt_pk_bf16(v[1][i][0], v[1][i][1]); o.y = cvt_pk_bf16(v[1][i][2], v[1][i][3]); *(u32x2*)(ha + (size_t)(rowb + 2 * kp + 1) * 1024 + col) = o; }
            float lg0[36], lg1[36];
#pragma unroll
            for (int g = 0; g < 36; ++g) { float s0 = 0.f, s1 = 0.f;
#pragma unroll
                for (int i = 0; i < 4; ++i) { const f32x4 w = *(const f32x4*)(RW + g * 1024 + i * 256 + c.lane * 4);
                    s0 += v[0][i][0] * w[0] + v[0][i][1] * w[1] + v[0][i][2] * w[2] + v[0][i][3] * w[3]; s1 += v[1][i][0] * w[0] + v[1][i][1] * w[1] + v[1][i][2] * w[2] + v[1][i][3] * w[3]; }
                lg0[g] = wave_sum(s0); lg1[g] = wave_sum(s1); }
            decide(c.wid * 16 + 2 * kp, lg0); decide(c.wid * 16 + 2 * kp + 1, lg1);
        }
        __syncthreads();
        if (c.tid < 32) Lbase[c.tid] = (int)__hip_atomic_fetch_add(&cnt[c.tid], (unsigned)Lcnt[c.tid], __ATOMIC_RELAXED, __HIP_MEMORY_SCOPE_AGENT);
        __syncthreads();
        if (c.tid < 256) { const int a = u * 256 + c.tid, e = Le[c.tid]; asge[a] = e; asgr[a] = Lbase[e] + Lr[c.tid]; asgw[a] = Lw[c.tid]; }
        __syncthreads();
    }
}
__device__ __forceinline__ void ph_gather(const Ctx& c_, int l) { const Ctx c = fresh(c_);
    int* Lps = (int*)c.lds; int* Lcn = Lps + 40;
    unsigned* cnt = (unsigned*)(c.ws + WS_CTL + CTL_CNT) + l * 32;
    if (c.tid == 0) { int acc = 0; for (int e = 0; e < 32; ++e) { const int n = (int)__hip_atomic_load(&cnt[e], __ATOMIC_RELAXED, __HIP_MEMORY_SCOPE_AGENT); Lcn[e] = n; Lps[e] = acc; acc += (n + 255) / 256 * 256; } Lps[32] = acc; }
    __syncthreads();
    int* rowtok = c.w<int>(WS_ROWTOK); float* roww = c.w<float>(WS_ROWW);
    if (c.blk == 0) { int* tile = c.w<int>(WS_TILE); if (c.tid == 0) tile[0] = Lps[32] / 256;
        for (int e = c.tid; e < 32; e += 512) for (int t = Lps[e] / 256; t < Lps[e + 1] / 256; ++t) tile[1 + t] = e; }
    for (int e = c.blk; e < 32; e += c.G) for (int r = Lps[e] + Lcn[e] + c.tid; r < Lps[e + 1]; r += 512) rowtok[r] = -1;
    const int* asge = c.w<int>(WS_ASGE); const int* asgr = c.w<int>(WS_ASGR); const float* asgw = c.w<float>(WS_ASGW);
    for (int a = c.blk * 512 + c.tid; a < NTOK * 2; a += c.G * 512) { const int dest = Lps[asge[a]] + asgr[a]; rowtok[dest] = a; roww[dest] = asgw[a]; }
}
__device__ __forceinline__ void ph_final(const Ctx& c_) { const Ctx c = fresh(c_);
    float* out = c.a->out; const bf16_t* y1 = c.w<bf16_t>(WS_Y1);
    for (size_t e = (size_t)c.blk * 512 + c.tid; e < (size_t)NTOK * 256; e += (size_t)c.G * 512) { const u32x2 y = *(const u32x2*)(y1 + e * 4); f32x4 v = *(const f32x4*)(out + e * 4);
        v += (f32x4){bflo(y.x), bfhi(y.x), bflo(y.y), bfhi(y.y)}; *(f32x4*)(out + e * 4) = v; }
}

constexpr int PH_PER_LAYER = 9, N_PHASES = 2 + PH_PER_LAYER * NL + 1;
__global__ void __launch_bounds__(512, 2) mk_fwd(Args args) {
#ifdef EMU
    unsigned char* lds = emu_lds();
#else
    extern __shared__ __attribute__((aligned(16))) unsigned char lds[];
#endif
    Ctx c; c.a = &args; c.ws = args.ws; c.lds = lds; c.tid = threadIdx.x; c.wid = __builtin_amdgcn_readfirstlane(c.tid >> 6); c.lane = c.tid & 63; c.G = gridDim.x; c.blk = blockIdx.x;
    if (c.tid == 0) *(uint4*)(lds + LDS_XB) = make_uint4(0u, 0u, 0u, 0u);
    __syncthreads();
    XcdBarrier bar; bar.bar = (unsigned*)(args.ws + WS_CTL); bar.x = 0; bar.st = (volatile LAS unsigned*)(lds + LDS_XB);
    if (args.ph_hi - args.ph_lo > 1) bar = xcd_barrier_post((unsigned*)(args.ws + WS_CTL), (volatile LAS unsigned*)(lds + LDS_XB));
    int ph = 0;
#ifndef PHMASK
#define PHMASK 0xFFFFF
#endif
#define PHASE(K, ...) do { if (ph >= args.ph_lo && ph < args.ph_hi) { if constexpr ((PHMASK >> K) & 1) { __VA_ARGS__; } if (ph + 1 < args.ph_hi) xcd_barrier(bar); } ++ph; } while (0)
    PHASE(0, ph_prologue0(c));
    PHASE(1, ph_prologue1(c));
    for (int l = 0; l < NL; ++l) {
        PHASE(2, if (l == 0) ph_cvt(c, 0); ph_normrows(c, l));
        PHASE(3, { pg8::Gemm g{c.w<bf16_t>(WS_HA), c.w<bf16_t>(WS_WIN + (size_t)(l & 1) * WSET), NTOK, ZP, 1024}; pg8::StaticOrder S; S.init(NTOK, ZP, c.G, c.blk); pg8::EpiBf16 E{c.w<bf16_t>(WS_Z), ZP};
                pg8::gemm_phase<pg8::EpiBf16, pg8::StaticOrder, true, true>((LAS unsigned char*)lds, g, S, E); });
        PHASE(4, ph_mixers(c, l));
        PHASE(5, ph_attn(c, l));
        PHASE(6, { pg8::Gemm g{c.w<bf16_t>(WS_YB), c.w<bf16_t>(WS_WOUT + (size_t)(l & 1) * WSET), NTOK, 1024, 1024}; pg8::StaticOrder S; S.init(NTOK, 1024, c.G, c.blk);
                pg8::EpiResid E{(l == 0) ? c.inf(I_X) : args.out, args.out, c.w<float>(WS_MOD) + (size_t)l * NB * 6144 + 2048, 6144, SEQ, (l == 0) ? (const bf16_t*)nullptr : c.w<bf16_t>(WS_Y1)};
                pg8::gemm_phase<pg8::EpiResid, pg8::StaticOrder, true, true>((LAS unsigned char*)lds, g, S, E); });
        PHASE(7, ph_router(c, l));
        PHASE(8, ph_gather(c, l));
        PHASE(9, { pg8::Gemm g{c.w<bf16_t>(WS_HA), c.w<bf16_t>(WS_WUP + (size_t)(l & 1) * WSET), NR, 32 * 1024, 1024}; pg8::MoeOrder S{c.w<int>(WS_TILE), c.G, c.blk}; pg8::EpiSwiglu E{c.w<bf16_t>(WS_Q)};
                pg8::gemm_phase<pg8::EpiSwiglu, pg8::MoeOrder, true, true, true>((LAS unsigned char*)lds, g, S, E, c.w<int>(WS_ROWTOK)); });
        PHASE(10, { pg8::Gemm g{c.w<bf16_t>(WS_Q), c.w<bf16_t>(WS_WDN + (size_t)(l & 1) * WSET), NR, 32 * 1024, 512}; pg8::MoeOrder S{c.w<int>(WS_TILE), c.G, c.blk};
                pg8::EpiDown E{c.w<int>(WS_ROWTOK), c.w<float>(WS_ROWW), args.out, c.w<bf16_t>(WS_Y1), c.w<float>(WS_MOD) + (size_t)l * NB * 6144 + 5120, 6144, SEQ};
                pg8::gemm_phase<pg8::EpiDown, pg8::MoeOrder, true, true>((LAS unsigned char*)lds, g, S, E); });
    }
    PHASE(11, ph_final(c));
#undef PHASE
}

extern "C" void kernel_launch(void* const* d_in, const int* in_sizes, int n_in, void* d_out, int out_size, void* d_ws, size_t ws_size, hipStream_t stream) {
    static int grid = 0;
    if (grid == 0) {
        if (n_in != 30 || out_size != NTOK * 1024 || ws_size < WS_END) { fprintf(stderr, "kernel_launch: shape/workspace mismatch (n_in %d out %d ws %zu need %zu)\n", n_in, out_size, ws_size, (size_t)WS_END); grid = -1; return; }
        int dev = 0, cus = 0;
        if (hipGetDevice(&dev) != hipSuccess || hipDeviceGetAttribute(&cus, hipDeviceAttributeMultiprocessorCount, dev) != hipSuccess) { grid = -1; return; }
        if (hipFuncSetAttribute((const void*)mk_fwd, hipFuncAttributeMaxDynamicSharedMemorySize, LDS_BYTES) != hipSuccess) { fprintf(stderr, "kernel_launch: hipFuncSetAttribute failed\n"); grid = -1; return; }
        int per_cu = 0; (void)hipOccupancyMaxActiveBlocksPerMultiprocessor(&per_cu, (const void*)mk_fwd, 512, LDS_BYTES);
        if (per_cu < 1) fprintf(stderr, "kernel_launch: occupancy query says %d blocks per CU\n", per_cu);
        grid = cus;
    }
    if (grid < 0) return;
    (void)hipMemsetAsync((char*)d_ws + WS_CTL, 0, CTL_BYTES, stream);
    Args a{};
    for (int i = 0; i < 30; ++i) a.in[i] = d_in[i];
    a.out = (float*)d_out; a.ws = (unsigned char*)d_ws;
#if MK_SPLIT
    for (int p = 0; p < N_PHASES; ++p) { a.ph_lo = p; a.ph_hi = p + 1;
#else
    { a.ph_lo = 0; a.ph_hi = N_PHASES;
#endif
#ifdef EMU
        EMU_LAUNCH(mk_fwd, grid, 512, LDS_BYTES, stream, a);
#else
        hipLaunchKernelGGL(mk_fwd, dim3(grid), dim3(512), LDS_BYTES, stream, a);
#endif
    }
}
```

```cpp
#include <hip/hip_runtime.h>
#include <cstdio>
#include <cstdint>

#ifndef CFG_B
#define CFG_B 4
#endif
#ifndef CFG_S
#define CFG_S 8192
#endif
#ifndef CFG_L
#define CFG_L 4
#endif
#ifndef MK_SPLIT
#define MK_SPLIT 0
#endif

#ifdef EMU
#define ASMV(...) ((void)0)
#define LAS
#define LAUNDER_V(x) ((void)0)
#define LAUNDER_S(x) ((void)0)
#else
#define ASMV(...) asm volatile(__VA_ARGS__)
#define LAS __attribute__((address_space(3)))
#define LAUNDER_V(x) asm volatile("" : "+v"(x))
#define LAUNDER_S(x) asm volatile("" : "+s"(x))
#endif

typedef unsigned short bf16_t;
typedef short bf16x8 __attribute__((ext_vector_type(8)));
typedef short s16x4 __attribute__((ext_vector_type(4)));
typedef float f32x4 __attribute__((ext_vector_type(4)));
typedef float f32x16 __attribute__((ext_vector_type(16)));
typedef unsigned u32x4 __attribute__((ext_vector_type(4)));
typedef unsigned u32x2 __attribute__((ext_vector_type(2)));

__device__ __forceinline__ float bf2f(bf16_t h) { return __builtin_bit_cast(float, (unsigned)h << 16); }
__device__ __forceinline__ float bflo(unsigned w) { return __builtin_bit_cast(float, w << 16); }
__device__ __forceinline__ float bfhi(unsigned w) { return __builtin_bit_cast(float, w & 0xffff0000u); }
__device__ __forceinline__ unsigned f2bf_bits(float f) { unsigned u = __builtin_bit_cast(unsigned, f); u += 0x7fffu + ((u >> 16) & 1u); return u >> 16; }
#ifdef EMU
__device__ __forceinline__ unsigned cvt_pk_bf16(float lo, float hi) { return f2bf_bits(lo) | (f2bf_bits(hi) << 16); }
#else
__device__ __forceinline__ unsigned cvt_pk_bf16(float lo, float hi) { unsigned r; asm volatile("v_cvt_pk_bf16_f32 %0, %1, %2" : "=v"(r) : "v"(lo), "v"(hi)); return r; }
#endif
__device__ __forceinline__ float fast_exp(float x) { return __builtin_amdgcn_exp2f(x * 1.44269504089f); }
__device__ __forceinline__ float fsigmoid(float x) { return __builtin_amdgcn_rcpf(1.0f + fast_exp(-x)); }
__device__ __forceinline__ float fsilu(float x) { return x * fsigmoid(x); }
__device__ __forceinline__ float frsqrt(float x) { return __builtin_amdgcn_rsqf(x); }
#ifdef EMU
__device__ __forceinline__ float wave_sum(float v) {
#pragma unroll
    for (int m = 32; m >= 1; m >>= 1) v += __shfl_xor(v, m);
    return v;
}
#else
template <int CTRL, int ROW_MASK> __device__ __forceinline__ float dpp_t(float v) { return __builtin_bit_cast(float, __builtin_amdgcn_update_dpp(0, __builtin_bit_cast(int, v), CTRL, ROW_MASK, 0xF, false)); }
#define dpp_f(v, ctrl, rm) dpp_t<ctrl, rm>(v)
__device__ __forceinline__ float wave_sum(float v) {
    v += dpp_f(v, 0xB1, 0xF);
    v += dpp_f(v, 0x4E, 0xF);
    v += dpp_f(v, 0x141, 0xF);
    v += dpp_f(v, 0x140, 0xF);
    v += dpp_f(v, 0x142, 0xA);
    v += dpp_f(v, 0x143, 0xC);
    return __builtin_bit_cast(float, __builtin_amdgcn_readlane(__builtin_bit_cast(int, v), 63));
}
__device__ __forceinline__ float half_sum(float v, int hi) {
    v += dpp_f(v, 0xB1, 0xF); v += dpp_f(v, 0x4E, 0xF); v += dpp_f(v, 0x141, 0xF); v += dpp_f(v, 0x140, 0xF);
    v += dpp_f(v, 0x142, 0xA);
    const float a = __builtin_bit_cast(float, __builtin_amdgcn_readlane(__builtin_bit_cast(int, v), 31)), b = __builtin_bit_cast(float, __builtin_amdgcn_readlane(__builtin_bit_cast(int, v), 63));
    return hi ? b : a;
}
#endif
#ifdef EMU
__device__ __forceinline__ float half_sum(float v, int) {
#pragma unroll
    for (int m = 1; m < 32; m <<= 1) v += __shfl_xor(v, m);
    return v;
}
#endif

namespace pg8 {
#define PG8_LAS LAS
constexpr int BM = 256, BK = 64, HALF = 128, HTB = HALF * BK * 2  , STAGE_BYTES = 8 * HTB, NXCD = 8, WGM = 8;

__host__ __device__ __forceinline__ int lds_byte(int r, int c) { const int st = (r >> 4) * 2 + (c >> 5), rr = r & 15, cc = c & 31, ob = rr * 64 + cc * 2; return st * 1024 + (ob ^ (((ob >> 9) & 1) << 5)); }
__host__ __device__ __forceinline__ void stage_rc(int b, int& R, int& C) { const int st = b / 1024, sb = b % 1024, swz = sb ^ (((sb >> 9) & 1) << 5); R = (st >> 1) * 16 + swz / 64; C = (st & 1) * 32 + (swz % 64) / 2; }
__host__ __device__ __forceinline__ int perm32(int rho) { const int n = rho >> 4, i = rho & 15; return 8 * (i >> 2) + 4 * n + (i & 3); }

struct Unit { int pm, pn; };
struct Gemm { const bf16_t* A; const bf16_t* Bt; int M, N, K; };

struct StaticOrder {
    int nM, nN, nwg, G, c;
    __host__ __device__ void init(int M, int N, int G_, int c_) { nM = M / BM; nN = N / BM; nwg = nM * nN; G = G_; c = c_; }
    __host__ __device__ bool next(int i, Unit& u) const {
        const long L = (long)i * G + c; if (L >= nwg) return false;
        int wgid = (int)L; { const int q = nwg / NXCD, r = nwg % NXCD, xcd = wgid % NXCD, off = wgid / NXCD; wgid = (xcd < r ? xcd * (q + 1) : r * (q + 1) + (xcd - r) * q) + off; }
        const int nig = WGM * nN, gid = wgid / nig, fm = gid * WGM, gsz = (nM - fm) < WGM ? (nM - fm) : WGM;
        u.pm = fm + ((wgid % nig) % gsz); u.pn = (wgid % nig) / gsz; return true;
    }
    __device__ __forceinline__ void a_ready(const Unit&) const {}
    __device__ __forceinline__ void done(const Unit&) const {}
};
template <class Epi, class Sched, bool ALIGN_EPI = false, bool SP2 = false, bool GATHER = false>
__device__ __forceinline__ void gemm_phase(PG8_LAS unsigned char* lds, const Gemm g, const Sched& S, const Epi& E, const int* rowmap = nullptr) {
    int tid = threadIdx.x; LAUNDER_V(tid); const int wid = __builtin_amdgcn_readfirstlane(tid >> 6), lane = tid & 63, wr = wid >> 2, wc = wid & 3, fr = lane & 15, fq = lane >> 4;
    const int K = g.K, nt = K / BK;
    unsigned voffA[2], voffB[2]; int RA[2], CA[2];
#pragma unroll
    for (int i = 0; i < 2; ++i) { int R, C; stage_rc(tid * 16 + i * 8192, R, C); const int Rb = Epi::PERM ? ((R & ~31) + perm32(R & 31)) : R;
        voffA[i] = (unsigned)(R * K + C) * 2u; voffB[i] = (unsigned)(Rb * K + C) * 2u; RA[i] = R; CA[i] = C; }
    const size_t kstep = (size_t)(BK * 2);
    const size_t hstep = (size_t)HALF * K * 2;
    const size_t tstep = 2 * hstep;
    const size_t hA = GATHER ? (size_t)0 : hstep;
    unsigned vA0[2], vA1[2], nA0[2], nA1[2];
    auto rows_of = [&](const Unit& u, unsigned (&o0)[2], unsigned (&o1)[2]) {
#pragma unroll
        for (int i = 0; i < 2; ++i) { if constexpr (GATHER) { int t0 = rowmap[u.pm * BM + RA[i]], t1 = rowmap[u.pm * BM + HALF + RA[i]]; t0 = t0 < 0 ? 0 : (t0 >> 1); t1 = t1 < 0 ? 0 : (t1 >> 1);
                o0[i] = (unsigned)(t0 * K + CA[i]) * 2u; o1[i] = (unsigned)(t1 * K + CA[i]) * 2u; } else { o0[i] = voffA[i]; o1[i] = voffA[i]; } } };
    const unsigned ldsw = (unsigned)wid * 1024u;
    const int aoff = lds_byte(wr * 64 + fr, fq * 8), boff = lds_byte(wc * 32 + fr, fq * 8);
#define PG8_SA(b, h) (((b) * 2 + (h)) * HTB)
#define PG8_SB(b, h) ((4 + (b) * 2 + (h)) * HTB)
#define PG8_STAGE(bufoff, gbase, voff) do { _Pragma("unroll") for (int _i = 0; _i < 2; ++_i) \
        __builtin_amdgcn_global_load_lds((const unsigned*)((const char*)(gbase) + (voff)[_i]), (PG8_LAS unsigned*)(lds + (bufoff) + ldsw + _i * 8192), 16, 0, 0); } while (0)
#define PG8_LDA(dst, b, h) do { _Pragma("unroll") for (int m = 0; m < 4; ++m) _Pragma("unroll") for (int k = 0; k < 2; ++k) dst[m][k] = *(const PG8_LAS bf16x8*)(lds + PG8_SA(b, h) + aoff + m * 2048 + k * 1024); } while (0)
#define PG8_LDB(dst, b, h) do { _Pragma("unroll") for (int n = 0; n < 2; ++n) _Pragma("unroll") for (int k = 0; k < 2; ++k) dst[n][k] = *(const PG8_LAS bf16x8*)(lds + PG8_SB(b, h) + boff + n * 2048 + k * 1024); } while (0)
#define PG8_MMA(ai, bj, At, Bt) do { __builtin_amdgcn_s_setprio(1); _Pragma("unroll") for (int m = 0; m < 4; ++m) _Pragma("unroll") for (int n = 0; n < 2; ++n) _Pragma("unroll") for (int k = 0; k < 2; ++k) \
        acc[ai][bj][m][n] = __builtin_amdgcn_mfma_f32_16x16x32_bf16(Bt[n][k], At[m][k], acc[ai][bj][m][n], 0, 0, 0); __builtin_amdgcn_s_setprio(0); } while (0)
#define PG8_WAIT_V(n) ASMV("s_waitcnt vmcnt(" #n ")" ::: "memory")
#define PG8_WAIT_L(n) ASMV("s_waitcnt lgkmcnt(" #n ")" ::: "memory")
#define PG8_BAR __builtin_amdgcn_s_barrier()
#define PG8_SCHED __builtin_amdgcn_sched_barrier(0)
    Unit cur, nxt; int ui = 0;
    if (!S.next(0, cur)) return;
    f32x4 acc[2][2][4][2];
#pragma unroll
    for (int a = 0; a < 2; ++a)
#pragma unroll
        for (int b = 0; b < 2; ++b)
#pragma unroll
            for (int m = 0; m < 4; ++m)
#pragma unroll
                for (int n = 0; n < 2; ++n) acc[a][b][m][n] = (f32x4){0.f, 0.f, 0.f, 0.f};
    bf16x8 At[4][2], B0[2][2], B1[2][2];
    const char* cA = GATHER ? (const char*)g.A : (const char*)g.A + (size_t)cur.pm * tstep; rows_of(cur, vA0, vA1); const char* cB = (const char*)g.Bt + (size_t)cur.pn * tstep;
    S.a_ready(cur);
    if constexpr (SP2) {
        PG8_STAGE(PG8_SB(0, 0), cB, voffB); PG8_STAGE(PG8_SB(0, 1), cB + hstep, voffB); PG8_STAGE(PG8_SA(0, 0), cA, vA0); PG8_STAGE(PG8_SA(0, 1), cA + hA, vA1);
        if (wr == 1) PG8_BAR;
        PG8_WAIT_V(2); PG8_BAR;
        PG8_STAGE(PG8_SB(1, 0), cB + kstep, voffB); PG8_STAGE(PG8_SA(1, 0), cA + kstep, vA0); PG8_STAGE(PG8_SB(1, 1), cB + hstep + kstep, voffB);
        PG8_WAIT_V(6); PG8_BAR;
    } else {
        PG8_STAGE(PG8_SB(0, 0), cB, voffB); PG8_STAGE(PG8_SA(0, 0), cA, vA0); PG8_STAGE(PG8_SB(0, 1), cB + hstep, voffB); PG8_STAGE(PG8_SA(0, 1), cA + hA, vA1);
        if (wr == 1) PG8_BAR;
        PG8_WAIT_V(4); PG8_BAR;
        PG8_STAGE(PG8_SB(1, 0), cB + kstep, voffB); PG8_STAGE(PG8_SA(1, 0), cA + kstep, vA0); PG8_STAGE(PG8_SB(1, 1), cB + hstep + kstep, voffB);
        PG8_WAIT_V(6); PG8_BAR;
    }
    for (;;) {
        const bool has_next = S.next(ui + 1, nxt);
        const char* nA = GATHER ? (const char*)g.A : (has_next ? (const char*)g.A + (size_t)nxt.pm * tstep : cA);
        if (has_next) rows_of(nxt, nA0, nA1); else { nA0[0] = vA0[0]; nA0[1] = vA0[1]; nA1[0] = vA1[0]; nA1[1] = vA1[1]; } const char* nB = has_next ? (const char*)g.Bt + (size_t)nxt.pn * tstep : cB;
        for (int t = 0; t < nt; t += 2) {
            const bool last = (t == nt - 2);
            unsigned sA0[2], sA1[2];
#pragma unroll
            for (int i = 0; i < 2; ++i) { sA0[i] = last ? nA0[i] : vA0[i]; sA1[i] = last ? nA1[i] : vA1[i]; }
            const char* a1 = cA + (size_t)(t + 1) * kstep;
            const char* a2 = last ? nA : cA + (size_t)(t + 2) * kstep; const char* b2 = last ? nB : cB + (size_t)(t + 2) * kstep;
            const char* a3 = a2 + kstep; const char* b3 = b2 + kstep;
            if (last && has_next) S.a_ready(nxt);
            if constexpr (SP2) {
            PG8_LDB(B0, 0, 0); PG8_LDB(B1, 0, 1); PG8_SCHED; PG8_LDA(At, 0, 0); PG8_STAGE(PG8_SA(1, 1), a1 + hA, vA1);
            PG8_WAIT_V(8); PG8_WAIT_L(0); PG8_BAR; PG8_MMA(0, 0, At, B0); PG8_MMA(0, 1, At, B1); PG8_BAR; PG8_SCHED;
            PG8_LDA(At, 0, 1); PG8_STAGE(PG8_SB(0, 0), b2, voffB); PG8_STAGE(PG8_SB(0, 1), b2 + hstep, voffB); PG8_STAGE(PG8_SA(0, 0), a2, sA0);
            PG8_WAIT_V(8); PG8_WAIT_L(0); PG8_BAR; PG8_MMA(1, 0, At, B0); PG8_MMA(1, 1, At, B1); PG8_BAR; PG8_SCHED;
            PG8_LDB(B0, 1, 0); PG8_LDB(B1, 1, 1); PG8_SCHED; PG8_LDA(At, 1, 0); PG8_STAGE(PG8_SA(0, 1), a2 + hA, sA1);
            PG8_WAIT_V(8); PG8_WAIT_L(0); PG8_BAR; PG8_MMA(0, 0, At, B0); PG8_MMA(0, 1, At, B1); PG8_BAR; PG8_SCHED;
            PG8_LDA(At, 1, 1); PG8_STAGE(PG8_SB(1, 0), b3, voffB); PG8_STAGE(PG8_SB(1, 1), b3 + hstep, voffB); PG8_STAGE(PG8_SA(1, 0), a3, sA0);
            PG8_WAIT_V(8); PG8_WAIT_L(0); PG8_BAR; PG8_MMA(1, 0, At, B0); PG8_MMA(1, 1, At, B1); PG8_BAR; PG8_SCHED;
            } else {
            PG8_LDB(B0, 0, 0); PG8_SCHED; PG8_LDA(At, 0, 0); PG8_STAGE(PG8_SA(1, 1), a1 + hA, vA1);
            PG8_WAIT_L(8); PG8_BAR; PG8_WAIT_L(0); PG8_MMA(0, 0, At, B0); PG8_BAR; PG8_SCHED;
            PG8_LDB(B1, 0, 1); PG8_STAGE(PG8_SB(0, 0), b2, voffB);
            PG8_BAR; PG8_WAIT_L(0); PG8_MMA(0, 1, At, B1); PG8_BAR;
            PG8_LDA(At, 0, 1); PG8_STAGE(PG8_SA(0, 0), a2, sA0);
            PG8_BAR; PG8_WAIT_L(0); PG8_MMA(1, 0, At, B0); PG8_BAR; PG8_SCHED;
            PG8_STAGE(PG8_SB(0, 1), b2 + hstep, voffB);
            PG8_WAIT_V(6); PG8_BAR; PG8_MMA(1, 1, At, B1); PG8_BAR;
            PG8_LDB(B0, 1, 0); PG8_SCHED; PG8_LDA(At, 1, 0); PG8_STAGE(PG8_SA(0, 1), a2 + hA, sA1);
            PG8_WAIT_L(8); PG8_BAR; PG8_WAIT_L(0); PG8_MMA(0, 0, At, B0); PG8_BAR; PG8_SCHED;
            PG8_LDB(B1, 1, 1); PG8_STAGE(PG8_SB(1, 0), b3, voffB);
            PG8_BAR; PG8_WAIT_L(0); PG8_MMA(0, 1, At, B1); PG8_BAR;
            PG8_LDA(At, 1, 1); PG8_STAGE(PG8_SA(1, 0), a3, sA0);
            PG8_BAR; PG8_WAIT_L(0); PG8_MMA(1, 0, At, B0); PG8_BAR; PG8_SCHED;
            PG8_STAGE(PG8_SB(1, 1), b3 + hstep, voffB);
            PG8_WAIT_V(6); PG8_BAR; PG8_MMA(1, 1, At, B1); PG8_BAR;
            }
        }
        if constexpr (ALIGN_EPI) { if (wr == 0) PG8_BAR; }
        if constexpr (!Epi::AFTER_DRAIN) { E(acc, cur, wr, wc, fr, fq); S.done(cur); }
        if (!has_next) break;
#pragma unroll
        for (int a = 0; a < 2; ++a)
#pragma unroll
            for (int b = 0; b < 2; ++b)
#pragma unroll
                for (int m = 0; m < 4; ++m)
#pragma unroll
                    for (int n = 0; n < 2; ++n) acc[a][b][m][n] = (f32x4){0.f, 0.f, 0.f, 0.f};
        cur = nxt; cA = nA; cB = nB; ++ui; vA0[0] = nA0[0]; vA0[1] = nA0[1]; vA1[0] = nA1[0]; vA1[1] = nA1[1];
        if constexpr (ALIGN_EPI) { if (wr == 1) PG8_BAR; }
    }
    PG8_WAIT_V(0);
    if constexpr (!ALIGN_EPI) { if (wr == 0) PG8_BAR; }
    PG8_BAR;
    if constexpr (Epi::AFTER_DRAIN) { E.fused(acc, cur, wr, wc, fr, fq, lds, wid, lane); S.done(cur); }
#undef PG8_SA
#undef PG8_SB
#undef PG8_STAGE
#undef PG8_LDA
#undef PG8_LDB
#undef PG8_MMA
#undef PG8_WAIT_V
#undef PG8_WAIT_L
#undef PG8_BAR
#undef PG8_SCHED
}

struct EpiBf16 {
    static constexpr bool PERM = true, AFTER_DRAIN = false;
    bf16_t* O; int ldc;
    __device__ __forceinline__ void operator()(const f32x4 (&acc)[2][2][4][2], const Unit& u, int wr, int wc, int fr, int fq) const {
        const int row0 = u.pm * BM + wr * 64 + fr, col0 = u.pn * BM + wc * 32 + 8 * fq;
#pragma unroll
        for (int ai = 0; ai < 2; ++ai)
#pragma unroll
            for (int m = 0; m < 4; ++m) { bf16_t* rowp = O + (size_t)(row0 + ai * HALF + m * 16) * ldc + col0;
#pragma unroll
                for (int bj = 0; bj < 2; ++bj) { const f32x4 v0 = acc[ai][bj][m][0], v1 = acc[ai][bj][m][1];
                    u32x4 w; w.x = cvt_pk_bf16(v0[0], v0[1]); w.y = cvt_pk_bf16(v0[2], v0[3]); w.z = cvt_pk_bf16(v1[0], v1[1]); w.w = cvt_pk_bf16(v1[2], v1[3]);
                    *(u32x4*)(rowp + bj * HALF) = w; } }
    }
};
struct EpiResid {
    static constexpr bool PERM = true, AFTER_DRAIN = false;
    const float* xin; float* xout; const float* gate; int gstride; int seq; const bf16_t* y1;
    __device__ __forceinline__ void operator()(const f32x4 (&acc)[2][2][4][2], const Unit& u, int wr, int wc, int fr, int fq) const {
        const int row0 = u.pm * BM + wr * 64 + fr, col0 = u.pn * BM + wc * 32 + 8 * fq;
#pragma unroll
        for (int ai = 0; ai < 2; ++ai)
#pragma unroll
            for (int m = 0; m < 4; ++m) { const int row = row0 + ai * HALF + m * 16; const float* gp = gate + (size_t)(row / seq) * gstride;
#pragma unroll
                for (int bj = 0; bj < 2; ++bj) { const int c = col0 + bj * HALF; const size_t o = (size_t)row * 1024 + c;
                    const f32x4 g0 = *(const f32x4*)(gp + c), g1 = *(const f32x4*)(gp + c + 4);
                    f32x4 x0 = *(const f32x4*)(xin + o), x1 = *(const f32x4*)(xin + o + 4);
                    if (y1) { const u32x4 y = *(const u32x4*)(y1 + o); x0 += (f32x4){bflo(y.x), bfhi(y.x), bflo(y.y), bfhi(y.y)}; x1 += (f32x4){bflo(y.z), bfhi(y.z), bflo(y.w), bfhi(y.w)}; }
                    *(f32x4*)(xout + o) = x0 + g0 * acc[ai][bj][m][0]; *(f32x4*)(xout + o + 4) = x1 + g1 * acc[ai][bj][m][1]; } }
    }
};
struct EpiSwiglu {
    static constexpr bool PERM = true, AFTER_DRAIN = false;
    bf16_t* HB;
    __device__ __forceinline__ void operator()(const f32x4 (&acc)[2][2][4][2], const Unit& u, int wr, int wc, int fr, int fq) const {
        const int row0 = u.pm * BM + wr * 64 + fr, col0 = (u.pn & 3) * 128 + wc * 32 + 8 * fq;
#pragma unroll
        for (int ai = 0; ai < 2; ++ai)
#pragma unroll
            for (int m = 0; m < 4; ++m) { bf16_t* p = HB + (size_t)(row0 + ai * HALF + m * 16) * 512 + col0;
                float h[8];
#pragma unroll
                for (int n = 0; n < 2; ++n)
#pragma unroll
                    for (int k = 0; k < 4; ++k) h[n * 4 + k] = fsilu(acc[ai][0][m][n][k]) * acc[ai][1][m][n][k];
                u32x4 w; w.x = cvt_pk_bf16(h[0], h[1]); w.y = cvt_pk_bf16(h[2], h[3]); w.z = cvt_pk_bf16(h[4], h[5]); w.w = cvt_pk_bf16(h[6], h[7]);
                *(u32x4*)p = w; }
    }
};
struct EpiDown {
    static constexpr bool PERM = true, AFTER_DRAIN = false;
    const int* row_tok; const float* row_w; float* x; bf16_t* y1; const float* gate; int gstride; int seq;
    __device__ __forceinline__ void operator()(const f32x4 (&acc)[2][2][4][2], const Unit& u, int wr, int wc, int fr, int fq) const {
        const int row0 = u.pm * BM + wr * 64 + fr, col0 = (u.pn & 3) * BM + wc * 32 + 8 * fq;
#pragma unroll
        for (int ai = 0; ai < 2; ++ai)
#pragma unroll
            for (int m = 0; m < 4; ++m) { const int row = row0 + ai * HALF + m * 16; const int ts = row_tok[row];
                if (ts >= 0) { const int tok = ts >> 1; const float w = row_w[row]; const float* gp = gate + (size_t)(tok / seq) * gstride;
#pragma unroll
                    for (int bj = 0; bj < 2; ++bj) { const int c = col0 + bj * HALF; const size_t o = (size_t)tok * 1024 + c;
                        const f32x4 v0 = acc[ai][bj][m][0] * (*(const f32x4*)(gp + c)) * w, v1 = acc[ai][bj][m][1] * (*(const f32x4*)(gp + c + 4)) * w;
                        if (ts & 1) { u32x4 q; q.x = cvt_pk_bf16(v0[0], v0[1]); q.y = cvt_pk_bf16(v0[2], v0[3]); q.z = cvt_pk_bf16(v1[0], v1[1]); q.w = cvt_pk_bf16(v1[2], v1[3]); *(u32x4*)(y1 + o) = q; }
                        else { *(f32x4*)(x + o) = *(const f32x4*)(x + o) + v0; *(f32x4*)(x + o + 4) = *(const f32x4*)(x + o + 4) + v1; } } } }
    }
};
struct MoeOrder {
    const int* tile; int G, c;
    __device__ __forceinline__ bool next(int i, Unit& u) const { const int v = ((G & 7) == 0) ? (c & 7) * (G >> 3) + (c >> 3) : c; const int L = i * G + v, nt = tile[0]; if (L >= nt * 4) return false; u.pm = L >> 2; u.pn = tile[1 + (L >> 2)] * 4 + (L & 3); return true; }
    __device__ __forceinline__ void a_ready(const Unit&) const {}
    __device__ __forceinline__ void done(const Unit&) const {}
};
}

constexpr int NB = CFG_B, SEQ = CFG_S, NL = CFG_L, NTOK = NB * SEQ, DM = 1024, ZP = 2304;
constexpr int NBH = NB * 4, NCH = SEQ / 128, NQT = SEQ / 256;
constexpr int NR = 2 * NTOK + 32 * 256;
constexpr int Z_CQ = 0, Z_CKV = 192, Z_KR = 320, Z_POOL = 352, Z_HQ = 608, Z_HF = 864, Z_HI = 1120, Z_HG = 1376, Z_CA = 1632, Z_CG = 1888;
constexpr float EPS = 1e-6f;
static_assert(SEQ % 256 == 0 && NTOK % 256 == 0 && (NQT % 2) == 0, "shape");
constexpr size_t al256(size_t x) { return (x + 255) & ~(size_t)255; }
constexpr size_t cmax(size_t a, size_t b) { return a > b ? a : b; }
constexpr size_t WS_CTL = 0, CTL_BYTES = 65536;
constexpr size_t CTL_CNT = 16384;
constexpr size_t CTL_HG = 32768;
constexpr size_t WS_MODP = WS_CTL + CTL_BYTES;
constexpr size_t WS_MOD = WS_MODP + al256((size_t)16 * NL * NB * 6144 * 4);
constexpr size_t WS_LB = WS_MOD + al256((size_t)NL * NB * 6144 * 4);
constexpr size_t WS_ROPE = WS_LB + al256((size_t)NL * 256 * 4);
constexpr size_t WS_WIN = WS_ROPE + al256((size_t)NTOK * 32 * 4);
constexpr size_t WS_WOUT = WS_WIN + (size_t)ZP * 1024 * 2;
constexpr size_t WS_WUQ = WS_WOUT + (size_t)1024 * 1024 * 2;
constexpr size_t WS_WUKV = WS_WUQ + al256((size_t)384 * 192 * 2);
constexpr size_t WS_WPOOL = WS_WUKV + al256((size_t)512 * 128 * 2);
constexpr size_t WS_WUP = WS_WPOOL + al256((size_t)4 * 64 * 64 * 2);
constexpr size_t WS_WDN = WS_WUP + (size_t)32 * 1024 * 1024 * 2;
constexpr size_t WS_RWT = WS_WDN + (size_t)32 * 1024 * 512 * 2;
constexpr size_t WSET = WS_RWT + 36 * 1024 * 4 - WS_WIN;
constexpr size_t WS_HA = WS_WIN + 2 * WSET;
constexpr size_t WS_Z = WS_HA + (size_t)NTOK * 1024 * 2;
constexpr size_t Z_BYTES = cmax((size_t)NTOK * ZP * 2, (size_t)NR * 1024 * 2);
constexpr size_t WS_Q = WS_Z + Z_BYTES;
constexpr size_t WS_K = WS_Q + (size_t)NTOK * 4 * 96 * 2;
constexpr size_t WS_VT = WS_K + (size_t)NTOK * 4 * 96 * 2;
constexpr size_t WS_YB = WS_VT + (size_t)NTOK * 4 * 64 * 2;
constexpr size_t R2_BYTES = cmax(WS_YB + (size_t)NTOK * 1024 * 2 - WS_Q, (size_t)NR * 512 * 2);
constexpr size_t WS_Y1 = WS_Q + R2_BYTES;
constexpr size_t WS_SC = WS_Y1 + (size_t)NTOK * 1024 * 2;
constexpr size_t WS_PC = WS_SC + (size_t)NBH * NCH * 4096 * 4;
constexpr size_t WS_S0 = WS_PC + al256((size_t)NBH * NCH * 64 * 4);
constexpr size_t WS_ASGE = WS_S0 + (size_t)NBH * NCH * 4096 * 4;
constexpr size_t WS_ASGR = WS_ASGE + (size_t)NTOK * 8;
constexpr size_t WS_ASGW = WS_ASGR + (size_t)NTOK * 8;
constexpr size_t WS_ROWTOK = WS_ASGW + (size_t)NTOK * 8;
constexpr size_t WS_ROWW = WS_ROWTOK + al256((size_t)NR * 4);
constexpr size_t WS_TILE = WS_ROWW + al256((size_t)NR * 4);
constexpr size_t WS_END = WS_TILE + al256((size_t)(NR / 256 + 16) * 4);
constexpr int LDS_BYTES = 160 * 1024;
constexpr int LDS_XB = LDS_BYTES - 16;

#define XB_TMO      128
#define XB_XCNT(j)  (256  + 64 * (j))
#define XB_XSUB(j)  (1280 + 64 * (j))
#define XB_XGEN(j)  (2304 + 64 * (j))
#define XB_TOP      3328
#define XB_TOPGEN   3392
#define XCD_BAR_WORDS 3456
#define XB_SPIN_CAP (1u << 18)
__device__ __forceinline__ unsigned xb_ld(unsigned* p)              { return __hip_atomic_load(p, __ATOMIC_RELAXED, __HIP_MEMORY_SCOPE_AGENT); }
__device__ __forceinline__ unsigned xb_add(unsigned* p, unsigned v) { return __hip_atomic_fetch_add(p, v, __ATOMIC_RELAXED, __HIP_MEMORY_SCOPE_AGENT); }
__device__ __forceinline__ unsigned xb_xcc_id() { return (unsigned)__builtin_amdgcn_s_getreg((3 << 11) | 20) & 0xFu; }
#define XB_SPIN(cond, bar) do { unsigned _sp = 0; while (cond) { __builtin_amdgcn_s_sleep(1); \
    if ((++_sp & 255u) == 0u) { if (xb_ld(&(bar)[XB_TMO])) break; if (_sp > XB_SPIN_CAP) { atomicAdd(&(bar)[XB_TMO], 1u); break; } } } } while (0)
struct XcdBarrier { unsigned* bar; unsigned x; volatile LAS unsigned* st; };
__device__ __forceinline__ XcdBarrier xcd_barrier_post(unsigned* bar, volatile LAS unsigned* st) {
    XcdBarrier b; b.bar = bar; b.x = xb_xcc_id(); b.st = st;
    if (threadIdx.x == 0) (void)xb_add(&bar[XB_XCNT(b.x)], 1u);
    return b;
}
__device__ __forceinline__ void xcd_barrier_complete(unsigned* bar, unsigned x, unsigned& nloc, unsigned& nx) {
    const unsigned G = gridDim.x * gridDim.y * gridDim.z;
    unsigned sum, cnt, mine, sp = 0u;
    for (;;) {
        sum = 0u; cnt = 0u; mine = 0u;
#pragma unroll
        for (unsigned j = 0; j < 16; ++j) { const unsigned c = xb_ld(&bar[XB_XCNT(j)]); sum += c; cnt += (c > 0u) ? 1u : 0u; mine = (j == x) ? c : mine; }
        if (sum == G) break;
        __builtin_amdgcn_s_sleep(1);
        if ((++sp & 255u) == 0u) { if (xb_ld(&bar[XB_TMO])) break; if (sp > XB_SPIN_CAP) { atomicAdd(&bar[XB_TMO], 1u); break; } }
    }
    nloc = mine > 0u ? mine : 1u; nx = cnt > 0u ? cnt : 1u;
}
__device__ __forceinline__ void xcd_barrier(const XcdBarrier& b) {
    ASMV("s_waitcnt vmcnt(0)" ::: "memory");
    __syncthreads();
    if (threadIdx.x == 0) {
        unsigned* bar = b.bar;
        __builtin_amdgcn_s_waitcnt(0);
        unsigned nloc = b.st[0], nx = b.st[1];
        if (nloc == 0u) { xcd_barrier_complete(bar, b.x, nloc, nx); b.st[0] = nloc; b.st[1] = nx; }
        const unsigned old = xb_add(&bar[XB_XSUB(b.x)], 1u);
        const unsigned gen = old / nloc;
        if (old + 1u == (gen + 1u) * nloc) {
            __builtin_amdgcn_fence(__ATOMIC_RELEASE, "agent");
            ASMV("s_waitcnt vmcnt(0)" ::: "memory");
            const unsigned og = xb_add(&bar[XB_TOP], 1u);
            const unsigned tg = og / nx;
            if (og + 1u == (tg + 1u) * nx) xb_add(&bar[XB_TOPGEN], 1u);
            else XB_SPIN(xb_ld(&bar[XB_TOPGEN]) == tg, bar);
            __builtin_amdgcn_fence(__ATOMIC_ACQUIRE, "agent");
            xb_add(&bar[XB_XGEN(b.x)], 1u);
            ASMV("s_waitcnt vmcnt(0)" ::: "memory");
        } else {
            XB_SPIN(xb_ld(&bar[XB_XGEN(b.x)]) == gen, bar);
            __builtin_amdgcn_fence(__ATOMIC_ACQUIRE, "agent");
            ASMV("s_waitcnt vmcnt(0)" ::: "memory");
        }
    }
    __syncthreads();
}

struct Args { const void* in[30]; float* out; unsigned char* ws; int ph_lo, ph_hi; };
enum { I_X = 0, I_C, I_POS, I_WADA, I_BADA, I_N1G, I_N2G, I_WIN, I_QAG, I_WUQ, I_KVAG, I_WUKV, I_QG, I_KG, I_WPOOL, I_PSCALE, I_LBL, I_HOG, I_DWW, I_DWB, I_LNG, I_LNB,
       I_WOUT, I_RGW, I_RGB, I_REW, I_REB, I_W1, I_W3, I_W2 };
struct Ctx {
    const Args* a; unsigned char* ws; unsigned char* lds; int tid, wid, lane, G, blk;
    __device__ __forceinline__ const float* inf(int i) const { return (const float*)a->in[i]; }
    template <class T> __device__ __forceinline__ T* w(size_t off) const { return (T*)(ws + off); }
};

__device__ __forceinline__ Ctx fresh(const Ctx& c0) { Ctx c = c0; LAUNDER_V(c.tid); LAUNDER_V(c.lane); LAUNDER_S(c.wid); return c; }
__device__ __forceinline__ void ph_prologue0(const Ctx& c_) { const Ctx c = fresh(c_);
    const float* cc = c.inf(I_C); const float* wada = c.inf(I_WADA); float* modp = c.w<float>(WS_MODP);
    for (int u = c.blk; u < NL * 16 * 12; u += c.G) {
        const int l = u / 192, r = u % 192, ic = r / 12, jb = r % 12, j = jb * 512 + c.tid;
        float* Ls = (float*)c.lds;
        __syncthreads();
        if (c.tid < NB * 64) Ls[c.tid] = fsilu(cc[(c.tid >> 6) * 1024 + ic * 64 + (c.tid & 63)]);
        __syncthreads();
        float acc[NB];
#pragma unroll
        for (int b = 0; b < NB; ++b) acc[b] = 0.f;
        const float* wp = wada + ((size_t)l * 1024 + ic * 64) * 6144 + j;
#pragma unroll
        for (int i0 = 0; i0 < 64; i0 += 16) { float wv[16];
#pragma unroll
            for (int i = 0; i < 16; ++i) wv[i] = wp[(size_t)(i0 + i) * 6144];
#pragma unroll
            for (int i = 0; i < 16; ++i)
#pragma unroll
                for (int b = 0; b < NB; ++b) acc[b] += Ls[b * 64 + i0 + i] * wv[i]; }
#pragma unroll
        for (int b = 0; b < NB; ++b) modp[(((size_t)ic * NL + l) * NB + b) * 6144 + j] = acc[b];
    }
    const int* pos = (const int*)c.a->in[I_POS]; float* rc = c.w<float>(WS_ROPE); float* rs = rc + (size_t)NTOK * 16;
    for (int e = c.blk * 512 + c.tid; e < NTOK * 16; e += c.G * 512) { const int t = e >> 4, i = e & 15;
        const float inv = exp2f(-(float)i * (13.287712379549449f / 16.0f));
        const float ang = (float)pos[t] * inv; rc[e] = cosf(ang); rs[e] = sinf(ang); }
    if (c.blk == 0 && c.tid < 256) { const float* lg = c.inf(I_LBL); float* lb = c.w<float>(WS_LB); float mx = -1e30f;
        for (int l = 0; l < NL; ++l) mx = fmaxf(mx, lg[l * 256 + c.tid]);
        float den = 0.f; for (int l = 0; l < NL; ++l) den += expf(lg[l * 256 + c.tid] - mx);
        float cum = 0.f, first = 0.f; for (int l = 0; l < NL; ++l) { cum += expf(lg[l * 256 + c.tid] - mx) / den; if (l == 0) first = cum; lb[l * 256 + c.tid] = cum - first; } }
}
__device__ __forceinline__ void ph_prologue1(const Ctx& c_) { const Ctx c = fresh(c_);
    const float* modp = c.w<float>(WS_MODP); float* mod = c.w<float>(WS_MOD); const float* bada = c.inf(I_BADA);
    for (int e = c.blk * 512 + c.tid; e < NL * NB * 6144; e += c.G * 512) { const int j = e % 6144, l = e / (NB * 6144);
        float s = bada[l * 6144 + j];
#pragma unroll
        for (int ic = 0; ic < 16; ++ic) s += modp[(size_t)ic * NL * NB * 6144 + e];
        mod[e] = s; }
}

__device__ __forceinline__ void ld8bf(const bf16_t* p, float (&o)[8]) { const u32x4 v = *(const u32x4*)p; o[0] = bflo(v.x); o[1] = bfhi(v.x); o[2] = bflo(v.y); o[3] = bfhi(v.y); o[4] = bflo(v.z); o[5] = bfhi(v.z); o[6] = bflo(v.w); o[7] = bfhi(v.w); }
__device__ __forceinline__ u32x4 pk8(const float (&o)[8]) { u32x4 w; w.x = cvt_pk_bf16(o[0], o[1]); w.y = cvt_pk_bf16(o[2], o[3]); w.z = cvt_pk_bf16(o[4], o[5]); w.w = cvt_pk_bf16(o[6], o[7]); return w; }
__device__ __forceinline__ void cvt_tile(const Ctx& c, const float* src, int ldn, int nlim, int k0, int n0, bf16_t* dst, int ldk, int drow0) {
    float* T = (float*)c.lds;
#pragma unroll
    for (int i = 0; i < 8; ++i) { const int e = c.tid + 512 * i, kk = e >> 6, nn = e & 63; T[kk * 65 + nn] = (n0 + nn < nlim) ? src[(size_t)(k0 + kk) * ldn + n0 + nn] : 0.f; }
    __syncthreads();
#pragma unroll
    for (int i = 0; i < 4; ++i) { const int e = c.tid + 512 * i, nn = e >> 5, k2 = e & 31;
        *(unsigned*)(dst + (size_t)(drow0 + nn) * ldk + k0 + 2 * k2) = cvt_pk_bf16(T[(2 * k2) * 65 + nn], T[(2 * k2 + 1) * 65 + nn]); }
    __syncthreads();
}
__device__ __forceinline__ void cvt_big(const Ctx& c, const float* src, int ldn, int nlim, int k0, int n0, bf16_t* dst, int ldk, int mode) {
    float* T = (float*)c.lds;
    f32x4 v[8];
#pragma unroll
    for (int i = 0; i < 8; ++i) { const int e4 = c.tid + 512 * i, kk = e4 >> 6, n4 = e4 & 63; v[i] = (n0 + n4 * 4 < nlim) ? *(const f32x4*)(src + (size_t)(k0 + kk) * ldn + n0 + n4 * 4) : (f32x4){0.f, 0.f, 0.f, 0.f}; }
#pragma unroll
    for (int i = 0; i < 8; ++i) { const int e4 = c.tid + 512 * i, kk = e4 >> 6, n4 = e4 & 63; float* p = T + kk * 261 + n4 * 4; p[0] = v[i][0]; p[1] = v[i][1]; p[2] = v[i][2]; p[3] = v[i][3]; }
    __syncthreads();
#pragma unroll
    for (int i = 0; i < 4; ++i) { const int e = c.tid + 512 * i, k8 = e & 7, nn = e >> 3, n = n0 + nn; float o[8];
#pragma unroll
        for (int j = 0; j < 8; ++j) o[j] = T[(8 * k8 + j) * 261 + nn];
        const int row = (mode == 0) ? n : ((n >> 7) * 256 + (mode - 1) * 128 + (n & 127));
        *(u32x4*)(dst + (size_t)row * ldk + k0 + 8 * k8) = pk8(o); }
    __syncthreads();
}
constexpr int CT_IN = 16 * 9, CT_OUT = 16 * 4, CT_W13 = 32 * 16 * 2, CT_W2 = 32 * 8 * 4, CT_UQ = 3 * 6, CT_UKV = 2 * 8, CT_POOL = 4;
constexpr int CT_TOTAL = CT_IN + CT_OUT + 2 * CT_W13 + CT_W2 + CT_UQ + CT_UKV + CT_POOL;
__device__ __forceinline__ void ph_cvt(const Ctx& c_, int l) { const Ctx c = fresh(c_);
    { const float* rgw = c.inf(I_RGW) + (size_t)l * 1024 * 4; const float* rew = c.inf(I_REW) + (size_t)l * 1024 * 32; float* rwt = c.w<float>(WS_RWT + (size_t)(l & 1) * WSET);
        for (int e = c.blk * 512 + c.tid; e < 36 * 1024; e += c.G * 512) { const int g = e >> 10, k = e & 1023; rwt[e] = (g < 4) ? rgw[k * 4 + g] : rew[k * 32 + g - 4]; } }
    for (int t = c.blk; t < CT_TOTAL; t += c.G) {
        int r = t;
        if (r < 2 * CT_W13) { const int which = r / CT_W13; r %= CT_W13; const int e = r / 32, kt = (r % 32) / 2, nt = r % 2;
            cvt_big(c, c.inf(which ? I_W3 : I_W1) + ((size_t)l * 32 + e) * 1024 * 512, 512, 512, kt * 64, nt * 256, c.w<bf16_t>(WS_WUP + (size_t)(l & 1) * WSET) + (size_t)e * 1024 * 1024, 1024, 1 + which); continue; } r -= 2 * CT_W13;
        if (r < CT_W2) { const int e = r / 32, kt = (r % 32) / 4, nt = r % 4;
            cvt_big(c, c.inf(I_W2) + ((size_t)l * 32 + e) * 512 * 1024, 1024, 1024, kt * 64, nt * 256, c.w<bf16_t>(WS_WDN + (size_t)(l & 1) * WSET) + (size_t)e * 1024 * 512, 512, 0); continue; } r -= CT_W2;
        if (r < CT_IN) { const int kt = r / 9, nt = r % 9; cvt_big(c, c.inf(I_WIN) + (size_t)l * 1024 * 2144, 2144, 2144, kt * 64, nt * 256, c.w<bf16_t>(WS_WIN + (size_t)(l & 1) * WSET), 1024, 0); continue; } r -= CT_IN;
        if (r < CT_OUT) { const int kt = r / 4, nt = r % 4; cvt_big(c, c.inf(I_WOUT) + (size_t)l * 1024 * 1024, 1024, 1024, kt * 64, nt * 256, c.w<bf16_t>(WS_WOUT + (size_t)(l & 1) * WSET), 1024, 0); continue; } r -= CT_OUT;
        if (r < CT_UQ) { const int kt = r / 6, nt = r % 6; cvt_tile(c, c.inf(I_WUQ) + (size_t)l * 192 * 384, 384, 384, kt * 64, nt * 64, c.w<bf16_t>(WS_WUQ + (size_t)(l & 1) * WSET), 192, nt * 64); continue; } r -= CT_UQ;
        if (r < CT_UKV) { const int kt = r / 8, nt = r % 8; cvt_tile(c, c.inf(I_WUKV) + (size_t)l * 128 * 512, 512, 512, kt * 64, nt * 64, c.w<bf16_t>(WS_WUKV + (size_t)(l & 1) * WSET), 128, nt * 64); continue; } r -= CT_UKV;
        cvt_tile(c, c.inf(I_WPOOL) + ((size_t)l * 4 + r) * 4096, 64, 64, 0, 0, c.w<bf16_t>(WS_WPOOL + (size_t)(l & 1) * WSET) + r * 4096, 64, 0);
    }
}
__device__ __forceinline__ void ph_normrows(const Ctx& c_, int l) { const Ctx c = fresh(c_);
    const float* xin = (l == 0) ? c.inf(I_X) : c.a->out; float* xout = c.a->out; const bf16_t* y1 = c.w<bf16_t>(WS_Y1);
    const float* gn = c.inf(I_N1G) + l * 1024; const float* mod = c.w<float>(WS_MOD) + (size_t)l * NB * 6144; bf16_t* ha = c.w<bf16_t>(WS_HA);
    for (int row0 = c.blk * 8 + c.wid; row0 < NTOK; row0 += c.G * 16) {
        f32x4 v[2][4]; float ss[2];
#pragma unroll
        for (int q = 0; q < 2; ++q) { const int row = row0 + q * c.G * 8; ss[q] = 0.f;
            if (row < NTOK) {
#pragma unroll
                for (int i = 0; i < 4; ++i) { const int col = i * 256 + c.lane * 4; v[q][i] = *(const f32x4*)(xin + (size_t)row * 1024 + col);
                    if (l > 0) { const u32x2 y = *(const u32x2*)(y1 + (size_t)row * 1024 + col); v[q][i] += (f32x4){bflo(y.x), bfhi(y.x), bflo(y.y), bfhi(y.y)}; } } } }
#pragma unroll
        for (int q = 0; q < 2; ++q) { const int row = row0 + q * c.G * 8;
            if (row < NTOK) {
#pragma unroll
                for (int i = 0; i < 4; ++i) {
                    ss[q] += v[q][i][0] * v[q][i][0] + v[q][i][1] * v[q][i][1] + v[q][i][2] * v[q][i][2] + v[q][i][3] * v[q][i][3]; } } }
        ss[0] = wave_sum(ss[0]); ss[1] = wave_sum(ss[1]);
#pragma unroll
        for (int q = 0; q < 2; ++q) { const int row = row0 + q * c.G * 8;
            if (row < NTOK) { const int b = row / SEQ; const float* sh = mod + b * 6144; const float* sc = sh + 1024; const float rinv = frsqrt(ss[q] * (1.0f / 1024.0f) + EPS);
#pragma unroll
                for (int i = 0; i < 4; ++i) { const int col = i * 256 + c.lane * 4; const f32x4 g = *(const f32x4*)(gn + col), s1 = *(const f32x4*)(sc + col), s0 = *(const f32x4*)(sh + col);
                    const f32x4 h = v[q][i] * rinv * g * (s1 + 1.0f) + s0; u32x2 o; o.x = cvt_pk_bf16(h[0], h[1]); o.y = cvt_pk_bf16(h[2], h[3]); *(u32x2*)(ha + (size_t)row * 1024 + col) = o; } } }
    }
}

#define MFMA16(a, b, c) __builtin_amdgcn_mfma_f32_16x16x32_bf16((a), (b), (c), 0, 0, 0)
#define MFMA32(a, b, c) __builtin_amdgcn_mfma_f32_32x32x16_bf16((a), (b), (c), 0, 0, 0)

__device__ __forceinline__ void mix_unit(const Ctx& c_, int l, int r0) { const Ctx c = fresh(c_);
    const bf16_t* Z = c.w<bf16_t>(WS_Z); bf16_t* Aq = (bf16_t*)c.lds; bf16_t* Akv = (bf16_t*)(c.lds + 12800); float* Lkr = (float*)(c.lds + 21504);
    float* Lu = (float*)(c.lds + 25600); bf16_t* Lp = (bf16_t*)(c.lds + 73728); float* Lcu = (float*)(c.lds + 90624); float* Lco = (float*)c.lds;
    const int s0 = r0 % SEQ, b = r0 / SEQ, fr = c.lane & 15, fq = c.lane >> 4;
    {   const int t = c.tid >> 4, sub = c.tid & 15; const bf16_t* zr = Z + (size_t)(r0 + t) * ZP;
        const u32x4 zero4 = {0u, 0u, 0u, 0u};
        const u32x4 ra0 = *(const u32x4*)(zr + Z_CQ + sub * 8), ra1 = (sub < 8) ? *(const u32x4*)(zr + Z_CQ + 128 + sub * 8) : zero4, rk0 = *(const u32x4*)(zr + Z_CKV + sub * 8), rkr = (sub < 4) ? *(const u32x4*)(zr + Z_KR + sub * 8) : zero4;
        u32x4 rp[3], rca[4], rcg[4];
#pragma unroll
        for (int i = 0; i < 3; ++i) { const int ch = c.tid + 512 * i, row = ch >> 5, c8 = ch & 31; rp[i] = (ch < 47 * 32 && s0 - 15 + row >= 0) ? *(const u32x4*)(Z + (size_t)(r0 - 15 + row) * ZP + Z_POOL + c8 * 8) : zero4; }
#pragma unroll
        for (int i = 0; i < 4; ++i) { const int ch = c.tid + 512 * i, row = ch >> 5, c8 = ch & 31; const bool ok = (ch < 62 * 32 && s0 - 30 + row >= 0);
            rca[i] = ok ? *(const u32x4*)(Z + (size_t)(r0 - 30 + row) * ZP + Z_CA + c8 * 8) : zero4; rcg[i] = ok ? *(const u32x4*)(Z + (size_t)(r0 - 30 + row) * ZP + Z_CG + c8 * 8) : zero4; }
        auto un8 = [](const u32x4 v, float (&o)[8]) { o[0] = bflo(v.x); o[1] = bfhi(v.x); o[2] = bflo(v.y); o[3] = bfhi(v.y); o[4] = bflo(v.z); o[5] = bfhi(v.z); o[6] = bflo(v.w); o[7] = bfhi(v.w); };
        const float* qag = c.inf(I_QAG) + l * 192; const float* kvag = c.inf(I_KVAG) + l * 128;
        float a0[8], a1[8], k0[8]; float ssq = 0.f, ssk = 0.f; un8(ra0, a0); un8(ra1, a1); un8(rk0, k0);
#pragma unroll
        for (int j = 0; j < 8; ++j) { ssq += a0[j] * a0[j] + a1[j] * a1[j]; ssk += k0[j] * k0[j]; }
#pragma unroll
        for (int m = 1; m < 16; m <<= 1) { ssq += __shfl_xor(ssq, m); ssk += __shfl_xor(ssk, m); }
        const float rq = frsqrt(ssq * (1.0f / 192.0f) + EPS), rk = frsqrt(ssk * (1.0f / 128.0f) + EPS);
#pragma unroll
        for (int j = 0; j < 8; ++j) a0[j] *= rq * qag[sub * 8 + j];
        *(u32x4*)(Aq + t * 200 + sub * 8) = pk8(a0);
        if (sub < 8) {
#pragma unroll
            for (int j = 0; j < 8; ++j) a1[j] *= rq * qag[128 + sub * 8 + j];
            *(u32x4*)(Aq + t * 200 + 128 + sub * 8) = pk8(a1); }
#pragma unroll
        for (int j = 0; j < 8; ++j) k0[j] *= rk * kvag[sub * 8 + j];
        *(u32x4*)(Akv + t * 136 + sub * 8) = pk8(k0);
        if (sub < 4) { float kr[8]; un8(rkr, kr);
#pragma unroll
            for (int j = 0; j < 8; ++j) Lkr[t * 32 + sub * 8 + j] = kr[j]; }
#pragma unroll
        for (int i = 0; i < 3; ++i) { const int ch = c.tid + 512 * i, row = ch >> 5, c8 = ch & 31; if (ch < 47 * 32) { float v[8]; un8(rp[i], v);
            *(f32x4*)(Lu + row * 256 + c8 * 8) = (f32x4){v[0], v[1], v[2], v[3]}; *(f32x4*)(Lu + row * 256 + c8 * 8 + 4) = (f32x4){v[4], v[5], v[6], v[7]}; } }
#pragma unroll
        for (int i = 0; i < 4; ++i) { const int ch = c.tid + 512 * i, row = ch >> 5, c8 = ch & 31; if (ch < 62 * 32) { float a[8], g[8]; un8(rca[i], a); un8(rcg[i], g);
#pragma unroll
            for (int j = 0; j < 8; ++j) a[j] *= fsigmoid(g[j]);
            *(f32x4*)(Lcu + row * 256 + c8 * 8) = (f32x4){a[0], a[1], a[2], a[3]}; *(f32x4*)(Lcu + row * 256 + c8 * 8 + 4) = (f32x4){a[4], a[5], a[6], a[7]}; } }
    }
    __syncthreads();
    const float* rcos = c.w<float>(WS_ROPE); const float* rsin = rcos + (size_t)NTOK * 16;
    if (c.wid < 4) {
        const int h = c.wid; const bf16_t* W = c.w<bf16_t>(WS_WUQ + (size_t)(l & 1) * WSET) + (size_t)(96 * h) * 192; const float* qg = c.inf(I_QG) + l * 96;
        f32x4 acc[6][2];
#pragma unroll
        for (int nf = 0; nf < 6; ++nf) { acc[nf][0] = (f32x4){0.f, 0.f, 0.f, 0.f}; acc[nf][1] = acc[nf][0]; }
#pragma unroll 3
        for (int ks = 0; ks < 6; ++ks) { bf16x8 af[2];
#pragma unroll
            for (int mf = 0; mf < 2; ++mf) af[mf] = *(const bf16x8*)(Aq + (mf * 16 + fr) * 200 + ks * 32 + fq * 8);
#pragma unroll
            for (int nf = 0; nf < 6; ++nf) { const bf16x8 bfr = *(const bf16x8*)(W + (size_t)(16 * nf + fr) * 192 + ks * 32 + fq * 8);
                acc[nf][0] = MFMA16(bfr, af[0], acc[nf][0]); acc[nf][1] = MFMA16(bfr, af[1], acc[nf][1]); } }
#pragma unroll
        for (int mf = 0; mf < 2; ++mf) { float ss = 0.f;
#pragma unroll
            for (int nf = 0; nf < 6; ++nf)
#pragma unroll
                for (int j = 0; j < 4; ++j) ss += acc[nf][mf][j] * acc[nf][mf][j];
            ss += __shfl_xor(ss, 16); ss += __shfl_xor(ss, 32);
            const float rinv = frsqrt(ss * (1.0f / 96.0f) + EPS) * (0.10206207261596575f * 1.44269504089f);
            const int tok = r0 + mf * 16 + fr; bf16_t* qo = c.w<bf16_t>(WS_Q) + ((size_t)(b * 4 + h) * SEQ + s0 + mf * 16 + fr) * 96;
            float v[6][4];
#pragma unroll
            for (int nf = 0; nf < 6; ++nf)
#pragma unroll
                for (int j = 0; j < 4; ++j) v[nf][j] = acc[nf][mf][j] * rinv * qg[16 * nf + 4 * fq + j];
            const f32x4 cs4 = *(const f32x4*)(rcos + (size_t)tok * 16 + 4 * fq), sn4 = *(const f32x4*)(rsin + (size_t)tok * 16 + 4 * fq);
#pragma unroll
            for (int j = 0; j < 4; ++j) { const float x1 = v[4][j], x2 = v[5][j]; v[4][j] = x1 * cs4[j] - x2 * sn4[j]; v[5][j] = x1 * sn4[j] + x2 * cs4[j]; }
#pragma unroll
            for (int nf = 0; nf < 6; ++nf) { u32x2 o; o.x = cvt_pk_bf16(v[nf][0], v[nf][1]); o.y = cvt_pk_bf16(v[nf][2], v[nf][3]); *(u32x2*)(qo + 16 * nf + 4 * fq) = o; } }
    } else {
        const int h = c.wid - 4; const bf16_t* W = c.w<bf16_t>(WS_WUKV + (size_t)(l & 1) * WSET) + (size_t)(128 * h) * 128; const float* kg = c.inf(I_KG) + l * 96;
        f32x4 ak[4][2], av[4][2];
#pragma unroll
        for (int nf = 0; nf < 4; ++nf) { ak[nf][0] = (f32x4){0.f, 0.f, 0.f, 0.f}; ak[nf][1] = ak[nf][0]; av[nf][0] = ak[nf][0]; av[nf][1] = ak[nf][0]; }
#pragma unroll 2
        for (int ks = 0; ks < 4; ++ks) { bf16x8 af[2];
#pragma unroll
            for (int mf = 0; mf < 2; ++mf) af[mf] = *(const bf16x8*)(Akv + (mf * 16 + fr) * 136 + ks * 32 + fq * 8);
#pragma unroll
            for (int nf = 0; nf < 4; ++nf) { const bf16x8 bk = *(const bf16x8*)(W + (size_t)(16 * nf + fr) * 128 + ks * 32 + fq * 8), bv = *(const bf16x8*)(W + (size_t)(64 + 16 * nf + fr) * 128 + ks * 32 + fq * 8);
                ak[nf][0] = MFMA16(bk, af[0], ak[nf][0]); ak[nf][1] = MFMA16(bk, af[1], ak[nf][1]);
                av[nf][0] = MFMA16(af[0], bv, av[nf][0]); av[nf][1] = MFMA16(af[1], bv, av[nf][1]); } }
#pragma unroll
        for (int mf = 0; mf < 2; ++mf) { const int tl = mf * 16 + fr; float ss = 0.f;
#pragma unroll
            for (int nf = 0; nf < 4; ++nf)
#pragma unroll
                for (int j = 0; j < 4; ++j) ss += ak[nf][mf][j] * ak[nf][mf][j];
#pragma unroll
            for (int j = 0; j < 8; ++j) { const float kr = Lkr[tl * 32 + fq * 8 + j]; ss += kr * kr; }
            ss += __shfl_xor(ss, 16); ss += __shfl_xor(ss, 32);
            const float rinv = frsqrt(ss * (1.0f / 96.0f) + EPS);
            const int tok = r0 + tl; bf16_t* ko = c.w<bf16_t>(WS_K) + ((size_t)(b * 4 + h) * SEQ + s0 + tl) * 96;
#pragma unroll
            for (int nf = 0; nf < 4; ++nf) { u32x2 o; o.x = cvt_pk_bf16(ak[nf][mf][0] * rinv * kg[16 * nf + 4 * fq], ak[nf][mf][1] * rinv * kg[16 * nf + 4 * fq + 1]);
                o.y = cvt_pk_bf16(ak[nf][mf][2] * rinv * kg[16 * nf + 4 * fq + 2], ak[nf][mf][3] * rinv * kg[16 * nf + 4 * fq + 3]); *(u32x2*)(ko + 16 * nf + 4 * fq) = o; }
            const f32x4 cs4 = *(const f32x4*)(rcos + (size_t)tok * 16 + 4 * fq), sn4 = *(const f32x4*)(rsin + (size_t)tok * 16 + 4 * fq);
            float o1[4], o2[4];
#pragma unroll
            for (int j = 0; j < 4; ++j) { const int i = 4 * fq + j; const float x1 = Lkr[tl * 32 + i] * rinv * kg[64 + i], x2 = Lkr[tl * 32 + 16 + i] * rinv * kg[80 + i];
                o1[j] = x1 * cs4[j] - x2 * sn4[j]; o2[j] = x1 * sn4[j] + x2 * cs4[j]; }
            { u32x2 o; o.x = cvt_pk_bf16(o1[0], o1[1]); o.y = cvt_pk_bf16(o1[2], o1[3]); *(u32x2*)(ko + 64 + 4 * fq) = o; o.x = cvt_pk_bf16(o2[0], o2[1]); o.y = cvt_pk_bf16(o2[2], o2[3]); *(u32x2*)(ko + 80 + 4 * fq) = o; }
            bf16_t* vo = c.w<bf16_t>(WS_VT) + (size_t)(b * 4 + h) * 64 * SEQ + s0 + mf * 16 + 4 * fq;
#pragma unroll
            for (int nf = 0; nf < 4; ++nf) { u32x2 o; o.x = cvt_pk_bf16(av[nf][mf][0], av[nf][mf][1]); o.y = cvt_pk_bf16(av[nf][mf][2], av[nf][mf][3]); *(u32x2*)(vo + (size_t)(16 * nf + fr) * SEQ) = o; } }
    }
    { const int t = c.tid >> 4, sub = c.tid & 15, g = sub >> 2, w = 2 << g, s = s0 + t; const float inv = 1.0f / (float)((s + 1 < w) ? (s + 1) : w);
#pragma unroll
        for (int k = 0; k < 2; ++k) { const int col = sub * 16 + k * 8; float sum[8];
#pragma unroll
            for (int j = 0; j < 8; ++j) sum[j] = 0.f;
            for (int d = 0; d < w; ++d) { const float* p = Lu + (t + 15 - d) * 256 + col;
#pragma unroll
                for (int j = 0; j < 8; ++j) sum[j] += p[j]; }
            const float* p0 = Lu + (t + 15) * 256 + col;
#pragma unroll
            for (int j = 0; j < 8; ++j) sum[j] = sum[j] * inv - p0[j];
            *(u32x4*)(Lp + t * 264 + col) = pk8(sum); } }
    float cres[16];
    { const int chn = c.tid & 255, half = c.tid >> 8; const float* dw = c.inf(I_DWW) + (size_t)l * 31 * 256 + chn; const float bias = c.inf(I_DWB)[l * 256 + chn];
        float wv[31];
#pragma unroll
        for (int j = 0; j < 31; ++j) wv[j] = dw[j * 256];
#pragma unroll
        for (int tt = 0; tt < 16; ++tt) cres[tt] = bias;
#pragma unroll
        for (int r = 0; r < 46; ++r) { const float u = Lcu[(half * 16 + r) * 256 + chn];
#pragma unroll
            for (int tt = 0; tt < 16; ++tt) { const int j = r - tt; if (j >= 0 && j < 31) cres[tt] += wv[j] * u; } } }
    __syncthreads();
    { const int g = c.wid >> 1, mf = c.wid & 1; const bf16_t* W = c.w<bf16_t>(WS_WPOOL + (size_t)(l & 1) * WSET) + g * 4096; const float* ps = c.inf(I_PSCALE) + l * 256 + g * 64;
        f32x4 acc[4];
#pragma unroll
        for (int nf = 0; nf < 4; ++nf) acc[nf] = (f32x4){0.f, 0.f, 0.f, 0.f};
#pragma unroll
        for (int ks = 0; ks < 2; ++ks) { const bf16x8 af = *(const bf16x8*)(Lp + (mf * 16 + fr) * 264 + g * 64 + ks * 32 + fq * 8);
#pragma unroll
            for (int nf = 0; nf < 4; ++nf) { const bf16x8 bfr = *(const bf16x8*)(W + (16 * nf + fr) * 64 + ks * 32 + fq * 8); acc[nf] = MFMA16(bfr, af, acc[nf]); } }
        bf16_t* yo = c.w<bf16_t>(WS_YB) + (size_t)(r0 + mf * 16 + fr) * 1024 + 256 + g * 64;
#pragma unroll
        for (int nf = 0; nf < 4; ++nf) { const int d = 16 * nf + 4 * fq; u32x2 o; o.x = cvt_pk_bf16(acc[nf][0] * ps[d], acc[nf][1] * ps[d + 1]); o.y = cvt_pk_bf16(acc[nf][2] * ps[d + 2], acc[nf][3] * ps[d + 3]); *(u32x2*)(yo + d) = o; } }
    { const int chn = c.tid & 255, half = c.tid >> 8;
#pragma unroll
        for (int tt = 0; tt < 16; ++tt) Lco[(half * 16 + tt) * 256 + chn] = cres[tt]; }
    __syncthreads();
    { const float* lg = c.inf(I_LNG) + l * 256 + c.lane * 4; const float* lb = c.inf(I_LNB) + l * 256 + c.lane * 4;
#pragma unroll
        for (int k = 0; k < 4; ++k) { const int t = c.wid * 4 + k; const f32x4 v = *(const f32x4*)(Lco + t * 256 + c.lane * 4);
            const float mean = wave_sum(v[0] + v[1] + v[2] + v[3]) * (1.0f / 256.0f); const f32x4 d = v - mean;
            const float var = wave_sum(d[0] * d[0] + d[1] * d[1] + d[2] * d[2] + d[3] * d[3]) * (1.0f / 256.0f); const float rs = frsqrt(var + EPS);
            float y[4];
#pragma unroll
            for (int j = 0; j < 4; ++j) y[j] = fsilu(d[j] * rs * lg[j] + lb[j]);
            u32x2 o; o.x = cvt_pk_bf16(y[0], y[1]); o.y = cvt_pk_bf16(y[2], y[3]); *(u32x2*)(c.w<bf16_t>(WS_YB) + (size_t)(r0 + t) * 1024 + 768 + c.lane * 4) = o; } }
    __syncthreads();
}

constexpr int CW_W13 = 32 * 16 * 16, CW_W2 = 32 * 8 * 32, CW_IN = 16 * 72, CW_OUT = 16 * 32, CW_UQ = 3 * 12, CW_UKV = 2 * 16, CW_POOL = 4 * 2;
constexpr int CW_TOTAL = 2 * CW_W13 + CW_W2 + CW_IN + CW_OUT + CW_UQ + CW_UKV + CW_POOL;
struct CvtTile { const float* src; bf16_t* dst; int ldn, ldk; };
__device__ __forceinline__ void cvt_decode(const Ctx& c, int l, int t, CvtTile& d) {
    const size_t wso = (size_t)(l & 1) * WSET; int r = t;
    if (r < 2 * CW_W13) { const int which = r / CW_W13; r %= CW_W13; const int e = r >> 8, kt = (r >> 4) & 15, nt = r & 15, n0 = nt * 32;
        d.src = c.inf(which ? I_W3 : I_W1) + ((size_t)l * 32 + e) * 1024 * 512 + (size_t)kt * 64 * 512 + n0; d.ldn = 512; d.ldk = 1024;
        d.dst = c.w<bf16_t>(WS_WUP + wso) + (size_t)e * 1024 * 1024 + (size_t)((n0 >> 7) * 256 + which * 128 + (n0 & 127)) * 1024 + kt * 64; return; } r -= 2 * CW_W13;
    if (r < CW_W2) { const int e = r >> 8, kt = (r >> 5) & 7, nt = r & 31;
        d.src = c.inf(I_W2) + ((size_t)l * 32 + e) * 512 * 1024 + (size_t)kt * 64 * 1024 + nt * 32; d.ldn = 1024; d.ldk = 512;
        d.dst = c.w<bf16_t>(WS_WDN + wso) + (size_t)e * 1024 * 512 + (size_t)(nt * 32) * 512 + kt * 64; return; } r -= CW_W2;
    if (r < CW_IN) { const int kt = r / 72, nt = r % 72; d.src = (nt < 67) ? c.inf(I_WIN) + (size_t)l * 1024 * 2144 + (size_t)kt * 64 * 2144 + nt * 32 : nullptr; d.ldn = 2144; d.ldk = 1024;
        d.dst = c.w<bf16_t>(WS_WIN + wso) + (size_t)(nt * 32) * 1024 + kt * 64; return; } r -= CW_IN;
    if (r < CW_OUT) { const int kt = r >> 5, nt = r & 31; d.src = c.inf(I_WOUT) + (size_t)l * 1024 * 1024 + (size_t)kt * 64 * 1024 + nt * 32; d.ldn = 1024; d.ldk = 1024;
        d.dst = c.w<bf16_t>(WS_WOUT + wso) + (size_t)(nt * 32) * 1024 + kt * 64; return; } r -= CW_OUT;
    if (r < CW_UQ) { const int kt = r / 12, nt = r % 12; d.src = c.inf(I_WUQ) + (size_t)l * 192 * 384 + (size_t)kt * 64 * 384 + nt * 32; d.ldn = 384; d.ldk = 192;
        d.dst = c.w<bf16_t>(WS_WUQ + wso) + (size_t)(nt * 32) * 192 + kt * 64; return; } r -= CW_UQ;
    if (r < CW_UKV) { const int kt = r >> 4, nt = r & 15; d.src = c.inf(I_WUKV) + (size_t)l * 128 * 512 + (size_t)kt * 64 * 512 + nt * 32; d.ldn = 512; d.ldk = 128;
        d.dst = c.w<bf16_t>(WS_WUKV + wso) + (size_t)(nt * 32) * 128 + kt * 64; return; } r -= CW_UKV;
    { const int g = r >> 1, nt = r & 1; d.src = c.inf(I_WPOOL) + ((size_t)l * 4 + g) * 4096 + nt * 32; d.ldn = 64; d.ldk = 64; d.dst = c.w<bf16_t>(WS_WPOOL + wso) + g * 4096 + (size_t)(nt * 32) * 64; }
}
__device__ __forceinline__ void cvt_wave(const Ctx& c, int l, int wrank, int nwaves, float* T) {
    { const float* rgw = c.inf(I_RGW) + (size_t)l * 1024 * 4; const float* rew = c.inf(I_REW) + (size_t)l * 1024 * 32; float* rwt = c.w<float>(WS_RWT + (size_t)(l & 1) * WSET);
        for (int e = wrank * 64 + c.lane; e < 36 * 1024; e += nwaves * 64) { const int g = e >> 10, k = e & 1023; rwt[e] = (g < 4) ? rgw[k * 4 + g] : rew[k * 32 + g - 4]; } }
    f32x4 v[8]; CvtTile cur; cur.src = nullptr; cur.dst = nullptr; cur.ldn = 0; cur.ldk = 0;
    auto issue = [&](const CvtTile& d) {
#pragma unroll
        for (int i = 0; i < 8; ++i) { const int e4 = c.lane + 64 * i, kk = e4 >> 3, n4 = e4 & 7; v[i] = d.src ? *(const f32x4*)(d.src + (size_t)kk * d.ldn + n4 * 4) : (f32x4){0.f, 0.f, 0.f, 0.f}; } };
    int t = wrank;
    if (t < CW_TOTAL) { cvt_decode(c, l, t, cur); issue(cur); }
    while (t < CW_TOTAL) {
#pragma unroll
        for (int i = 0; i < 8; ++i) { const int e4 = c.lane + 64 * i, kk = e4 >> 3, n4 = e4 & 7; float* p = T + kk * 33 + n4 * 4; p[0] = v[i][0]; p[1] = v[i][1]; p[2] = v[i][2]; p[3] = v[i][3]; }
        const int tn = t + nwaves; CvtTile nxt = cur; if (tn < CW_TOTAL) { cvt_decode(c, l, tn, nxt); issue(nxt); }
        __builtin_amdgcn_wave_barrier();
        { const int n = c.lane & 31, kh = c.lane >> 5; bf16_t* drow = cur.dst + (size_t)n * cur.ldk + kh * 32;
#pragma unroll
            for (int q = 0; q < 4; ++q) { float o[8];
#pragma unroll
                for (int j = 0; j < 8; ++j) o[j] = T[(kh * 32 + q * 8 + j) * 33 + n];
                *(u32x4*)(drow + q * 8) = pk8(o); } }
        __builtin_amdgcn_wave_barrier();
        t = tn; cur = nxt;
    }
}

#ifdef EMU
static inline float __builtin_amdgcn_logf(float x) { return log2f(x); }
#endif
constexpr int HGP = 68, HGV = 40;
constexpr int HG_LG = 0, HG_LK = 8704, HG_LQ = 17408, HG_LVT = 26112, HG_LEG = 31232, HG_LGG = 31488, HG_BYTES = 31744;
template <bool OUT> __device__ __forceinline__ void hgrn_mfma(const Ctx& c_, int l, int bu, int cvt_layer = NL) { const Ctx c = fresh(c_);
    if (c.wid < 4) {
        const int cu = bu * 4 + c.wid, bh = cu / NCH, chunk = cu % NCH, b = bh >> 2, h = bh & 3, tok0 = b * SEQ + chunk * 128;
        const bf16_t* Z = c.w<bf16_t>(WS_Z); const float lbd = c.w<float>(WS_LB)[l * 256 + h * 64 + c.lane];
        unsigned char* L = c.lds + c.wid * HG_BYTES; float* Lg = (float*)(L + HG_LG); float* Lk = (float*)(L + HG_LK); float* Lq = (float*)(L + HG_LQ); bf16_t* Lvt = (bf16_t*)(L + HG_LVT); float* LeG = (float*)(L + HG_LEG); float* LG = (float*)(L + HG_LGG);
        const int l31 = c.lane & 31, hi = c.lane >> 5;
        f32x16 S[2][2];
        if (OUT) { const float* s0 = c.w<float>(WS_S0) + (size_t)(bh * NCH + chunk) * 4096;
#pragma unroll
            for (int mf = 0; mf < 2; ++mf)
#pragma unroll
                for (int nf = 0; nf < 2; ++nf)
#pragma unroll
                    for (int r = 0; r < 16; ++r) S[mf][nf][r] = s0[(32 * mf + (r & 3) + 8 * (r >> 2) + 4 * hi) * 64 + 32 * nf + l31]; }
        else {
#pragma unroll
            for (int mf = 0; mf < 2; ++mf)
#pragma unroll
                for (int nf = 0; nf < 2; ++nf)
#pragma unroll
                    for (int r = 0; r < 16; ++r) S[mf][nf][r] = 0.f; }
        float gtot = 0.f; const float og0 = OUT ? c.inf(I_HOG)[l * 64 + l31] : 0.f, og1 = OUT ? c.inf(I_HOG)[l * 64 + 32 + l31] : 0.f;
        u32x4 rf[4], rq[4], rv[4];
        { const bf16_t* zn = Z + (size_t)(tok0 + (c.lane >> 3)) * ZP + h * 64 + (c.lane & 7) * 8;
#pragma unroll
            for (int i = 0; i < 4; ++i) { rf[i] = *(const u32x4*)(zn + (size_t)i * 8 * ZP + Z_HF); rv[i] = *(const u32x4*)(zn + (size_t)i * 8 * ZP + Z_HI); if (OUT) rq[i] = *(const u32x4*)(zn + (size_t)i * 8 * ZP + Z_HQ); else rq[i] = (u32x4){0u, 0u, 0u, 0u}; } }
#pragma unroll 1
        for (int sc = 0; sc < 4; ++sc) { const int tokb = tok0 + sc * 32;
            {
                const int rr = c.lane >> 3, c8 = (c.lane & 7) * 8;
#pragma unroll
                for (int i = 0; i < 4; ++i) { const int tr = i * 8 + rr; float x[8];
                    { const u32x4 v = rf[i]; x[0] = bflo(v.x); x[1] = bfhi(v.x); x[2] = bflo(v.y); x[3] = bfhi(v.y); x[4] = bflo(v.z); x[5] = bfhi(v.z); x[6] = bflo(v.w); x[7] = bfhi(v.w); }
                    *(f32x4*)(Lg + tr * HGP + c8) = (f32x4){x[0], x[1], x[2], x[3]}; *(f32x4*)(Lg + tr * HGP + c8 + 4) = (f32x4){x[4], x[5], x[6], x[7]};
                    if (OUT) { const u32x4 v = rq[i]; x[0] = fsilu(bflo(v.x)); x[1] = fsilu(bfhi(v.x)); x[2] = fsilu(bflo(v.y)); x[3] = fsilu(bfhi(v.y)); x[4] = fsilu(bflo(v.z)); x[5] = fsilu(bfhi(v.z)); x[6] = fsilu(bflo(v.w)); x[7] = fsilu(bfhi(v.w));
                        *(f32x4*)(Lq + tr * HGP + c8) = (f32x4){x[0], x[1], x[2], x[3]}; *(f32x4*)(Lq + tr * HGP + c8 + 4) = (f32x4){x[4], x[5], x[6], x[7]}; }
                    { const u32x4 v = rv[i]; const unsigned w4[4] = {v.x, v.y, v.z, v.w};
#pragma unroll
                        for (int k = 0; k < 4; ++k) { Lvt[(c8 + 2 * k) * HGV + tr] = (bf16_t)(w4[k] & 0xffffu); Lvt[(c8 + 2 * k + 1) * HGV + tr] = (bf16_t)(w4[k] >> 16); } } }
                if (sc < 3) { const bf16_t* zn = Z + (size_t)(tokb + 32 + rr) * ZP + h * 64 + c8;
#pragma unroll
                    for (int i = 0; i < 4; ++i) { rf[i] = *(const u32x4*)(zn + (size_t)i * 8 * ZP + Z_HF); rv[i] = *(const u32x4*)(zn + (size_t)i * 8 * ZP + Z_HI); if (OUT) rq[i] = *(const u32x4*)(zn + (size_t)i * 8 * ZP + Z_HQ); } }
                __builtin_amdgcn_wave_barrier();
                float run = 0.f;
#pragma unroll
                for (int t = 0; t < 32; ++t) { const float f = lbd + (1.0f - lbd) * fsigmoid(Lg[t * HGP + c.lane]); run += __builtin_amdgcn_logf(f); Lg[t * HGP + c.lane] = run; Lk[t * HGP + c.lane] = 1.0f - f; }
                LG[c.lane] = run; LeG[c.lane] = __builtin_amdgcn_exp2f(run); gtot += run;
            }
            __builtin_amdgcn_wave_barrier();
            bf16x8 vt[2][2];
#pragma unroll
            for (int nf = 0; nf < 2; ++nf)
#pragma unroll
                for (int ks = 0; ks < 2; ++ks) vt[nf][ks] = *(const bf16x8*)(Lvt + (32 * nf + l31) * HGV + 16 * ks + 8 * hi);
            f32x16 O[2];
            if (OUT) {
#pragma unroll
                for (int r = 0; r < 16; ++r) { O[0][r] = 0.f; O[1][r] = 0.f; }
                float acc[16];
#pragma unroll
                for (int m = 0; m < 16; ++m) acc[m] = 0.f;
#pragma unroll 1
                for (int d4 = 0; d4 < 16; ++d4) { const f32x4 qt = *(const f32x4*)(Lq + l31 * HGP + 4 * d4), gt = *(const f32x4*)(Lg + l31 * HGP + 4 * d4);
#pragma unroll
                    for (int mg = 0; mg < 8; ++mg) {
                        f32x4 k4[2], g4[2];
#pragma unroll
                        for (int j = 0; j < 2; ++j) { const int s = 16 * (mg >> 2) + 8 * hi + 2 * (mg & 3) + j; k4[j] = *(const f32x4*)(Lk + s * HGP + 4 * d4); g4[j] = *(const f32x4*)(Lg + s * HGP + 4 * d4); }
                        __builtin_amdgcn_sched_barrier(0);
#pragma unroll
                        for (int j = 0; j < 2; ++j)
#pragma unroll
                            for (int e = 0; e < 4; ++e) acc[mg * 2 + j] += qt[e] * k4[j][e] * __builtin_amdgcn_exp2f(gt[e] - g4[j][e]);
                        __builtin_amdgcn_sched_barrier(0); } }
                bf16x8 af[2];
#pragma unroll
                for (int ks = 0; ks < 2; ++ks) { float a8[8];
#pragma unroll
                    for (int j = 0; j < 8; ++j) { const int s = 16 * ks + 8 * hi + j; a8[j] = (s <= l31) ? acc[ks * 8 + j] : 0.f; }
                    af[ks] = __builtin_bit_cast(bf16x8, pk8(a8)); }
#pragma unroll
                for (int mf = 0; mf < 2; ++mf)
#pragma unroll
                    for (int s = 0; s < 2; ++s) { const int d0 = 32 * mf + 16 * s + 4 * hi;
                        const f32x4 qa = *(const f32x4*)(Lq + l31 * HGP + d0), qb = *(const f32x4*)(Lq + l31 * HGP + d0 + 8), ga = *(const f32x4*)(Lg + l31 * HGP + d0), gb = *(const f32x4*)(Lg + l31 * HGP + d0 + 8);
                        float q8[8];
#pragma unroll
                        for (int j = 0; j < 4; ++j) { q8[j] = qa[j] * __builtin_amdgcn_exp2f(ga[j]); q8[4 + j] = qb[j] * __builtin_amdgcn_exp2f(gb[j]); }
                        const bf16x8 qf = __builtin_bit_cast(bf16x8, pk8(q8));
#pragma unroll
                        for (int nf = 0; nf < 2; ++nf) { float s8[8];
#pragma unroll
                            for (int j = 0; j < 8; ++j) s8[j] = S[mf][nf][8 * s + j];
                            O[nf] = MFMA32(qf, __builtin_bit_cast(bf16x8, pk8(s8)), O[nf]); } }
#pragma unroll
                for (int nf = 0; nf < 2; ++nf)
#pragma unroll
                    for (int ks = 0; ks < 2; ++ks) O[nf] = MFMA32(af[ks], vt[nf][ks], O[nf]);
            }
#pragma unroll
            for (int mf = 0; mf < 2; ++mf) {
#pragma unroll
                for (int q = 0; q < 4; ++q) { const f32x4 e4 = *(const f32x4*)(LeG + 32 * mf + 8 * q + 4 * hi);
#pragma unroll
                    for (int e = 0; e < 4; ++e) { S[mf][0][4 * q + e] *= e4[e]; S[mf][1][4 * q + e] *= e4[e]; } }
                const int d = 32 * mf + l31; const float Gd = LG[d];
#pragma unroll
                for (int ks = 0; ks < 2; ++ks) { float k8[8];
#pragma unroll
                    for (int j = 0; j < 8; ++j) { const int s = 16 * ks + 8 * hi + j; k8[j] = Lk[s * HGP + d] * __builtin_amdgcn_exp2f(Gd - Lg[s * HGP + d]); }
                    const bf16x8 kf = __builtin_bit_cast(bf16x8, pk8(k8));
                    S[mf][0] = MFMA32(kf, vt[0][ks], S[mf][0]); S[mf][1] = MFMA32(kf, vt[1][ks], S[mf][1]); } }
            if (OUT) {
                {
                    const int rr = c.lane >> 3, c8 = (c.lane & 7) * 8; const bf16_t* zg = Z + (size_t)(tokb + rr) * ZP + Z_HG + h * 64 + c8; u32x2 gv[4];
#pragma unroll
                    for (int hf = 0; hf < 2; ++hf) {
#pragma unroll
                    for (int i = 0; i < 4; ++i) gv[i] = *(const u32x2*)(zg + (size_t)i * 8 * ZP + 4 * hf);
#pragma unroll
                    for (int i = 0; i < 4; ++i) { const u32x2 v = gv[i]; *(f32x4*)(Lq + (i * 8 + rr) * HGP + c8 + 4 * hf) = (f32x4){fsilu(bflo(v.x)), fsilu(bfhi(v.x)), fsilu(bflo(v.y)), fsilu(bfhi(v.y))}; } }
                }
                __builtin_amdgcn_wave_barrier();
#pragma unroll
                for (int r = 0; r < 16; ++r) { const int tl = (r & 3) + 8 * (r >> 2) + 4 * hi; float ss = O[0][r] * O[0][r] + O[1][r] * O[1][r];
                    ss = half_sum(ss, hi);
                    const float rinv = frsqrt(ss * (1.0f / 64.0f) + EPS); const size_t tok = (size_t)(tokb + tl);
                    const float g0 = Lq[tl * HGP + l31], g1 = Lq[tl * HGP + 32 + l31];
                    bf16_t* yo = c.w<bf16_t>(WS_YB) + tok * 1024 + 512 + h * 64;
                    yo[l31] = (bf16_t)f2bf_bits(O[0][r] * rinv * og0 * g0); yo[32 + l31] = (bf16_t)f2bf_bits(O[1][r] * rinv * og1 * g1); } }
            __builtin_amdgcn_wave_barrier();
        }
        if (!OUT) { float* sc = c.w<float>(WS_SC) + (size_t)(bh * NCH + chunk) * 4096;
#pragma unroll
            for (int mf = 0; mf < 2; ++mf)
#pragma unroll
                for (int nf = 0; nf < 2; ++nf)
#pragma unroll
                    for (int r = 0; r < 16; ++r) sc[(32 * mf + (r & 3) + 8 * (r >> 2) + 4 * hi) * 64 + 32 * nf + l31] = S[mf][nf][r];
            c.w<float>(WS_PC)[(size_t)(bh * NCH + chunk) * 64 + c.lane] = __builtin_amdgcn_exp2f(gtot); }
    } else if (OUT && cvt_layer < NL) {
        cvt_wave(c, cvt_layer, bu * 4 + (c.wid - 4), NBH * NCH, (float*)(c.lds + 4 * HG_BYTES + (c.wid - 4) * 8448));
    }
    __syncthreads();
}
__device__ __forceinline__ void hgrn_carry(const Ctx& c_, int l) { const Ctx c = fresh(c_);
    const float* SC = c.w<float>(WS_SC); const float* PC = c.w<float>(WS_PC); float* S0 = c.w<float>(WS_S0);
    for (int e = c.blk * 512 + c.tid; e < NBH * 4096; e += c.G * 512) { const int bh = e >> 12, dv = e & 4095, d = dv >> 6; float s = 0.f;
#pragma unroll 8
        for (int ch = 0; ch < NCH; ++ch) { const size_t o = (size_t)(bh * NCH + ch) * 4096 + dv; S0[o] = s; s = PC[(size_t)(bh * NCH + ch) * 64 + d] * s + SC[o]; } }
    ASMV("s_waitcnt vmcnt(0)" ::: "memory");
    __syncthreads();
    if (c.tid == 0) { __builtin_amdgcn_fence(__ATOMIC_RELEASE, "agent"); ASMV("s_waitcnt vmcnt(0)" ::: "memory");
        (void)__hip_atomic_fetch_add((unsigned*)(c.ws + WS_CTL + CTL_HG) + l * 64, 1u, __ATOMIC_RELAXED, __HIP_MEMORY_SCOPE_AGENT); }
}
__device__ __forceinline__ void hgrn_wait_carry(const Ctx& c, int l) {
    if (c.tid == 0) { unsigned* p = (unsigned*)(c.ws + WS_CTL + CTL_HG) + l * 64; unsigned sp = 0;
        while (__hip_atomic_load(p, __ATOMIC_RELAXED, __HIP_MEMORY_SCOPE_AGENT) < (unsigned)c.G) { __builtin_amdgcn_s_sleep(1); if (++sp > (1u << 22)) break; }
        __builtin_amdgcn_fence(__ATOMIC_ACQUIRE, "agent"); ASMV("s_waitcnt vmcnt(0)" ::: "memory"); }
    __syncthreads();
}
__device__ __forceinline__ void ph_mixers(const Ctx& c, int l) {
    if (c.blk & 1) for (int bu = c.blk; bu < NBH * NCH / 4; bu += c.G) hgrn_mfma<false>(c, l, bu);
    for (int u = c.blk; u < NTOK / 32; u += c.G) mix_unit(c, l, u * 32);
    if (!(c.blk & 1)) for (int bu = c.blk; bu < NBH * NCH / 4; bu += c.G) hgrn_mfma<false>(c, l, bu);
}

__device__ __forceinline__ void attn_unit(const Ctx& c_, int bh, int qt) { const Ctx c = fresh(c_);
    const bf16_t* Qg = c.w<bf16_t>(WS_Q) + (size_t)bh * SEQ * 96; const bf16_t* Kg = c.w<bf16_t>(WS_K) + (size_t)bh * SEQ * 96; const bf16_t* Vg = c.w<bf16_t>(WS_VT) + (size_t)bh * 64 * SEQ;
    constexpr int KROW = 104, VROW = 72, KB = 64 * KROW * 2, VB = 64 * VROW * 2;
    const int l31 = c.lane & 31, hi = c.lane >> 5, qrow = qt * 256 + c.wid * 32 + l31;
    bf16x8 qf[6];
#pragma unroll
    for (int ks = 0; ks < 6; ++ks) qf[ks] = *(const bf16x8*)(Qg + (size_t)qrow * 96 + ks * 16 + hi * 8);
    f32x16 o0, o1;
#pragma unroll
    for (int r = 0; r < 16; ++r) { o0[r] = 0.f; o1[r] = 0.f; }
    float mrun = -INFINITY, lsum = 0.f;
    const int nkt = 4 * (qt + 1), mylast = 4 * qt + (c.wid >> 1);
    const int kr0 = c.tid / 12, kc0 = c.tid % 12, kr1 = (c.tid + 512) / 12, kc1 = (c.tid + 512) % 12, vr = c.tid >> 3, vc = c.tid & 7;
    u32x4 sk0, sk1, sv;
    auto gload = [&](int kt) { sk0 = *(const u32x4*)(Kg + (size_t)(kt * 64 + kr0) * 96 + kc0 * 8); if (c.tid < 256) sk1 = *(const u32x4*)(Kg + (size_t)(kt * 64 + kr1) * 96 + kc1 * 8);
                               sv = *(const u32x4*)(Vg + (size_t)vr * SEQ + kt * 64 + vc * 8); };
    auto lstore = [&](int buf) { unsigned char* kb = c.lds + buf * (KB + VB); unsigned char* vb = kb + KB;
                                 *(u32x4*)(kb + (kr0 * KROW + kc0 * 8) * 2) = sk0; if (c.tid < 256) *(u32x4*)(kb + (kr1 * KROW + kc1 * 8) * 2) = sk1; *(u32x4*)(vb + (vr * VROW + vc * 8) * 2) = sv; };
    gload(0); lstore(0); __syncthreads();
    for (int kt = 0; kt < nkt; ++kt) {
        if (kt + 1 < nkt) gload(kt + 1);
        if (kt <= mylast) {
            const bf16_t* kb = (const bf16_t*)(c.lds + (kt & 1) * (KB + VB)); const bf16_t* vb = (const bf16_t*)(c.lds + (kt & 1) * (KB + VB) + KB);
            f32x16 s0, s1;
#pragma unroll
            for (int r = 0; r < 16; ++r) { s0[r] = 0.f; s1[r] = 0.f; }
#pragma unroll
            for (int ks = 0; ks < 6; ++ks) { const bf16x8 k0 = *(const bf16x8*)(kb + l31 * KROW + ks * 16 + hi * 8), k1 = *(const bf16x8*)(kb + (32 + l31) * KROW + ks * 16 + hi * 8);
                s0 = MFMA32(k0, qf[ks], s0); s1 = MFMA32(k1, qf[ks], s1); }
            if (kt == mylast) {
#pragma unroll
                for (int r = 0; r < 16; ++r) { const int key = kt * 64 + (r & 3) + 8 * (r >> 2) + 4 * hi; if (key > qrow) s0[r] = -INFINITY; if (key + 32 > qrow) s1[r] = -INFINITY; } }
            float mx = s0[0];
#pragma unroll
            for (int r = 1; r < 16; ++r) mx = fmaxf(mx, s0[r]);
#pragma unroll
            for (int r = 0; r < 16; ++r) mx = fmaxf(mx, s1[r]);
            mx = fmaxf(mx, __shfl_xor(mx, 32));
            const float mnew = fmaxf(mrun, mx), alpha = __builtin_amdgcn_exp2f(mrun - mnew); mrun = mnew;
            float ps = 0.f;
#pragma unroll
            for (int r = 0; r < 16; ++r) { s0[r] = __builtin_amdgcn_exp2f(s0[r] - mnew); s1[r] = __builtin_amdgcn_exp2f(s1[r] - mnew); ps += s0[r] + s1[r]; }
            lsum = lsum * alpha + ps;
#pragma unroll
            for (int r = 0; r < 16; ++r) { o0[r] *= alpha; o1[r] *= alpha; }
#pragma unroll
            for (int kf = 0; kf < 2; ++kf)
#pragma unroll
                for (int s = 0; s < 2; ++s) { const f32x16& sx = kf ? s1 : s0; u32x4 pw; pw.x = cvt_pk_bf16(sx[8 * s], sx[8 * s + 1]); pw.y = cvt_pk_bf16(sx[8 * s + 2], sx[8 * s + 3]); pw.z = cvt_pk_bf16(sx[8 * s + 4], sx[8 * s + 5]); pw.w = cvt_pk_bf16(sx[8 * s + 6], sx[8 * s + 7]);
                    const bf16x8 pf = __builtin_bit_cast(bf16x8, pw); const int kcol = kf * 32 + 16 * s + 4 * hi;
                    const s16x4 a0 = *(const s16x4*)(vb + l31 * VROW + kcol), a1 = *(const s16x4*)(vb + l31 * VROW + kcol + 8), b0 = *(const s16x4*)(vb + (32 + l31) * VROW + kcol), b1 = *(const s16x4*)(vb + (32 + l31) * VROW + kcol + 8);
                    const bf16x8 v0 = (bf16x8){a0[0], a0[1], a0[2], a0[3], a1[0], a1[1], a1[2], a1[3]}, v1 = (bf16x8){b0[0], b0[1], b0[2], b0[3], b1[0], b1[1], b1[2], b1[3]};
                    o0 = MFMA32(v0, pf, o0); o1 = MFMA32(v1, pf, o1); }
        }
        if (kt + 1 < nkt) lstore((kt + 1) & 1);
        __syncthreads();
    }
    lsum += __shfl_xor(lsum, 32); const float rl = 1.0f / lsum;
    const int b = bh >> 2, h = bh & 3; bf16_t* yo = c.w<bf16_t>(WS_YB) + (size_t)(b * SEQ + qrow) * 1024 + h * 64;
#pragma unroll
    for (int g = 0; g < 4; ++g) { const int dv = 8 * g + 4 * hi; u32x2 w0, w1;
        w0.x = cvt_pk_bf16(o0[4 * g] * rl, o0[4 * g + 1] * rl); w0.y = cvt_pk_bf16(o0[4 * g + 2] * rl, o0[4 * g + 3] * rl); *(u32x2*)(yo + dv) = w0;
        w1.x = cvt_pk_bf16(o1[4 * g] * rl, o1[4 * g + 1] * rl); w1.y = cvt_pk_bf16(o1[4 * g + 2] * rl, o1[4 * g + 3] * rl); *(u32x2*)(yo + 32 + dv) = w1; }
    __syncthreads();
}
__device__ __forceinline__ void ph_attn(const Ctx& c, int l) {
    hgrn_carry(c, l);
    { const int NU = NBH * (NQT / 2);
      if ((c.G & 7) == 0) { const int per = (NU + 7) / 8, x = c.blk & 7, G8 = c.G >> 3;
          for (int j = c.blk >> 3; j < per; j += G8) { const int pu = x * per + j; if (pu < NU) { const int bh = pu / (NQT / 2), p = pu % (NQT / 2); attn_unit(c, bh, NQT - 1 - p); attn_unit(c, bh, p); } } }
      else for (int pu = c.blk; pu < NU; pu += c.G) { const int bh = pu / (NQT / 2), p = pu % (NQT / 2); attn_unit(c, bh, NQT - 1 - p); attn_unit(c, bh, p); } }
    hgrn_wait_carry(c, l);
    for (int bu = c.blk; bu < NBH * NCH / 4; bu += c.G) hgrn_mfma<true>(c, l, bu, l + 1);
}

__device__ __forceinline__ void ph_router(const Ctx& c_, int l, int cnt_off = 0) { const Ctx c = fresh(c_);
    bf16_t* Whi = (bf16_t*)c.lds; bf16_t* Wlo = (bf16_t*)(c.lds + 73728); float* Llog = (float*)(c.lds + 147456) + c.wid * 288; float* Lcb = (float*)(c.lds + 156672);
    int* Le = (int*)(c.lds + 156672 + 256); float* Lw = (float*)(c.lds + 156672 + 256 + 1024); int* Lr = (int*)(c.lds + 156672 + 256 + 2048); int* Lcnt = (int*)(c.lds + 156672 + 256 + 3072); int* Lbase = Lcnt + 32;
    const float* rwt = c.w<float>(WS_RWT + (size_t)(l & 1) * WSET);
    const float* rgb = c.inf(I_RGB) + l * 4; const float* reb = c.inf(I_REB) + l * 32;
    const float* x = c.a->out; const float* gn = c.inf(I_N2G) + l * 1024; const float* mod = c.w<float>(WS_MOD) + (size_t)l * NB * 6144; bf16_t* ha = c.w<bf16_t>(WS_HA);
    unsigned* cnt = (unsigned*)(c.ws + WS_CTL + CTL_CNT) + l * 32 + cnt_off;
    int* asge = c.w<int>(WS_ASGE); int* asgr = c.w<int>(WS_ASGR); float* asgw = c.w<float>(WS_ASGW);
    const int fr = c.lane & 15, fq = c.lane >> 4;
    int staged_b = -1;
    for (int u = c.blk; u < NTOK / 128; u += c.G) {
        const int b = (u * 128) / SEQ; const float* sh = mod + b * 6144 + 3072; const float* sc = sh + 1024;
        __syncthreads();
        if (b != staged_b) { staged_b = b;
            for (int q = c.tid; q < 36 * 128; q += 512) { const int n = q >> 7, ch = q & 127, k0 = ch * 8; float hi8[8], lo8[8];
#pragma unroll
                for (int j = 0; j < 8; ++j) { const float w = rwt[n * 1024 + k0 + j] * gn[k0 + j] * (1.0f + sc[k0 + j]); const float h = bf2f((bf16_t)f2bf_bits(w)); hi8[j] = h; lo8[j] = w - h; }
                const int pc = (ch ^ (n & 15)) * 8; *(u32x4*)(Whi + n * 1024 + pc) = pk8(hi8); *(u32x4*)(Wlo + n * 1024 + pc) = pk8(lo8); }
            for (int g = c.wid; g < 36; g += 8) { float s = 0.f;
#pragma unroll
                for (int i = 0; i < 4; ++i) { const f32x4 w = *(const f32x4*)(rwt + g * 1024 + i * 256 + c.lane * 4), s4 = *(const f32x4*)(sh + i * 256 + c.lane * 4); s += w[0] * s4[0] + w[1] * s4[1] + w[2] * s4[2] + w[3] * s4[3]; }
                s = wave_sum(s); if (c.lane == 0) Lcb[g] = s + (g < 4 ? rgb[g] : reb[g - 4]); } }
        if (c.tid < 32) Lcnt[c.tid] = 0;
        __syncthreads();
        const int rowb = u * 128 + c.wid * 16; const float* xr = x + (size_t)(rowb + fr) * 1024 + 8 * fq;
        f32x4 acc[3] = {{0.f, 0.f, 0.f, 0.f}, {0.f, 0.f, 0.f, 0.f}, {0.f, 0.f, 0.f, 0.f}}; float ssp = 0.f;
#pragma unroll 4
        for (int ks = 0; ks < 32; ++ks) { const f32x4 xa = *(const f32x4*)(xr + 32 * ks), xb = *(const f32x4*)(xr + 32 * ks + 4);
            float xv[8] = {xa[0], xa[1], xa[2], xa[3], xb[0], xb[1], xb[2], xb[3]}, lo8[8];
            u32x4 hw; hw.x = cvt_pk_bf16(xv[0], xv[1]); hw.y = cvt_pk_bf16(xv[2], xv[3]); hw.z = cvt_pk_bf16(xv[4], xv[5]); hw.w = cvt_pk_bf16(xv[6], xv[7]);
            const unsigned hws[4] = {hw.x, hw.y, hw.z, hw.w};
#pragma unroll
            for (int j = 0; j < 8; ++j) { ssp += xv[j] * xv[j]; lo8[j] = xv[j] - ((j & 1) ? bfhi(hws[j >> 1]) : bflo(hws[j >> 1])); }
            const bf16x8 ah = __builtin_bit_cast(bf16x8, hw), al = __builtin_bit_cast(bf16x8, pk8(lo8));
            const int ch = 4 * ks + fq;
#pragma unroll
            for (int nf = 0; nf < 3; ++nf) { const int n = 16 * nf + fr; bf16x8 bh = {0, 0, 0, 0, 0, 0, 0, 0}, bl = bh;
                if (nf < 2 || fr < 4) { const int pc = (ch ^ (n & 15)) * 8; bh = *(const bf16x8*)(Whi + n * 1024 + pc); bl = *(const bf16x8*)(Wlo + n * 1024 + pc); }
                acc[nf] = MFMA16(ah, bh, acc[nf]); acc[nf] = MFMA16(ah, bl, acc[nf]); acc[nf] = MFMA16(al, bh, acc[nf]); } }
        ssp += __shfl_xor(ssp, 16); ssp += __shfl_xor(ssp, 32);
        const float rinv = frsqrt(ssp * (1.0f / 1024.0f) + EPS);
        float rj[4];
#pragma unroll
        for (int j = 0; j < 4; ++j) rj[j] = __shfl(rinv, fq * 4 + j);
#pragma unroll
        for (int half = 0; half < 2; ++half) {
            if ((fq >> 1) == half) {
#pragma unroll
                for (int nf = 0; nf < 3; ++nf) { const int col = 16 * nf + fr; if (col < 36) {
#pragma unroll
                    for (int j = 0; j < 4; ++j) Llog[((fq & 1) * 4 + j) * 36 + col] = acc[nf][j] * rj[j] + Lcb[col]; } } }
            __builtin_amdgcn_wave_barrier();
            if (c.lane < 8) { const float* lg = Llog + c.lane * 36; const int rl = c.wid * 16 + half * 8 + c.lane;
                int gi = 0; float gm = lg[0];
#pragma unroll
                for (int g = 1; g < 4; ++g) { const float t = lg[g]; if (t > gm) { gm = t; gi = g; } }
                float den = 0.f;
#pragma unroll
                for (int g = 0; g < 4; ++g) den += expf(lg[g] - gm);
                const float gw = 1.0f / den;
                float e1 = -INFINITY, e2 = -INFINITY; int i1 = 0, i2 = 0;
#pragma unroll
                for (int j = 0; j < 8; ++j) { const float t = lg[4 + gi * 8 + j]; if (t > e1) { e2 = e1; i2 = i1; e1 = t; i1 = j; } else if (t > e2) { e2 = t; i2 = j; } }
                const float p2 = expf(e2 - e1), w1 = gw / (1.0f + p2), w2 = gw * p2 / (1.0f + p2);
                const int ea = gi * 8 + i1, eb = gi * 8 + i2; Le[rl * 2] = ea; Le[rl * 2 + 1] = eb; Lw[rl * 2] = w1; Lw[rl * 2 + 1] = w2;
                Lr[rl * 2] = atomicAdd(&Lcnt[ea], 1); Lr[rl * 2 + 1] = atomicAdd(&Lcnt[eb], 1); }
            __builtin_amdgcn_wave_barrier();
        }
#pragma unroll 4
        for (int ks = 0; ks < 32; ++ks) { const int k0 = 32 * ks + 8 * fq; const f32x4 xa = *(const f32x4*)(xr + 32 * ks), xb = *(const f32x4*)(xr + 32 * ks + 4);
            const f32x4 ga = *(const f32x4*)(gn + k0) * (*(const f32x4*)(sc + k0) + 1.0f), gb = *(const f32x4*)(gn + k0 + 4) * (*(const f32x4*)(sc + k0 + 4) + 1.0f);
            const f32x4 ha4 = xa * rinv * ga + *(const f32x4*)(sh + k0), hb4 = xb * rinv * gb + *(const f32x4*)(sh + k0 + 4);
            u32x4 o; o.x = cvt_pk_bf16(ha4[0], ha4[1]); o.y = cvt_pk_bf16(ha4[2], ha4[3]); o.z = cvt_pk_bf16(hb4[0], hb4[1]); o.w = cvt_pk_bf16(hb4[2], hb4[3]);
            *(u32x4*)(ha + (size_t)(rowb + fr) * 1024 + k0) = o; }
        __syncthreads();
        if (c.tid < 32) Lbase[c.tid] = (int)__hip_atomic_fetch_add(&cnt[c.tid], (unsigned)Lcnt[c.tid], __ATOMIC_RELAXED, __HIP_MEMORY_SCOPE_AGENT);
        __syncthreads();
        if (c.tid < 256) { const int a = u * 256 + c.tid, e = Le[c.tid]; asge[a] = e; asgr[a] = Lbase[e] + Lr[c.tid]; asgw[a] = Lw[c.tid]; }
    }
    __syncthreads();
}
__device__ __forceinline__ void ph_gather(const Ctx& c_, int l) { const Ctx c = fresh(c_);
    int* Lps = (int*)c.lds; int* Lcn = Lps + 40;
    unsigned* cnt = (unsigned*)(c.ws + WS_CTL + CTL_CNT) + l * 32;
    if (c.tid < 32) Lcn[c.tid] = (int)__hip_atomic_load(&cnt[c.tid], __ATOMIC_RELAXED, __HIP_MEMORY_SCOPE_AGENT);
    __syncthreads();
    if (c.tid == 0) { int acc = 0; for (int e = 0; e < 32; ++e) { Lps[e] = acc; acc += (Lcn[e] + 255) / 256 * 256; } Lps[32] = acc; }
    __syncthreads();
    int* rowtok = c.w<int>(WS_ROWTOK); float* roww = c.w<float>(WS_ROWW);
    if (c.blk == 0) { int* tile = c.w<int>(WS_TILE); if (c.tid == 0) tile[0] = Lps[32] / 256;
        for (int e = c.tid; e < 32; e += 512) for (int t = Lps[e] / 256; t < Lps[e + 1] / 256; ++t) tile[1 + t] = e; }
    for (int e = c.blk; e < 32; e += c.G) for (int r = Lps[e] + Lcn[e] + c.tid; r < Lps[e + 1]; r += 512) rowtok[r] = -1;
    const int* asge = c.w<int>(WS_ASGE); const int* asgr = c.w<int>(WS_ASGR); const float* asgw = c.w<float>(WS_ASGW);
    for (int a = c.blk * 512 + c.tid; a < NTOK * 2; a += c.G * 512) { const int dest = Lps[asge[a]] + asgr[a]; rowtok[dest] = a; roww[dest] = asgw[a]; }
}
__device__ __forceinline__ void ph_final(const Ctx& c_) { const Ctx c = fresh(c_);
    float* out = c.a->out; const bf16_t* y1 = c.w<bf16_t>(WS_Y1);
    for (size_t e = (size_t)c.blk * 512 + c.tid; e < (size_t)NTOK * 256; e += (size_t)c.G * 512) { const u32x2 y = *(const u32x2*)(y1 + e * 4); f32x4 v = *(const f32x4*)(out + e * 4);
        v += (f32x4){bflo(y.x), bfhi(y.x), bflo(y.y), bfhi(y.y)}; *(f32x4*)(out + e * 4) = v; }
}

constexpr int PH_PER_LAYER = 9, N_PHASES = 2 + PH_PER_LAYER * NL + 1;
__global__ void __launch_bounds__(512, 2) mk_fwd(Args args) {
#ifdef EMU
    unsigned char* lds = emu_lds();
#else
    extern __shared__ __attribute__((aligned(16))) unsigned char lds[];
#endif
    Ctx c; c.a = &args; c.ws = args.ws; c.lds = lds; c.tid = threadIdx.x; c.wid = __builtin_amdgcn_readfirstlane(c.tid >> 6); c.lane = c.tid & 63; c.G = gridDim.x; c.blk = blockIdx.x;
    if (c.tid == 0) *(uint4*)(lds + LDS_XB) = make_uint4(0u, 0u, 0u, 0u);
    __syncthreads();
    XcdBarrier bar; bar.bar = (unsigned*)(args.ws + WS_CTL); bar.x = 0; bar.st = (volatile LAS unsigned*)(lds + LDS_XB);
    if (args.ph_hi - args.ph_lo > 1) bar = xcd_barrier_post((unsigned*)(args.ws + WS_CTL), (volatile LAS unsigned*)(lds + LDS_XB));
    int ph = 0;
#ifndef PHMASK
#define PHMASK 0xFFFFF
#endif
#define PHASE(K, ...) do { if (ph >= args.ph_lo && ph < args.ph_hi) { if constexpr ((PHMASK >> K) & 1) { __VA_ARGS__; } if (ph + 1 < args.ph_hi) xcd_barrier(bar); } ++ph; } while (0)
    PHASE(0, ph_prologue0(c));
    PHASE(1, ph_prologue1(c));
    for (int l = 0; l < NL; ++l) {
        PHASE(2, if (l == 0) ph_cvt(c, 0); ph_normrows(c, l));
        PHASE(3, { pg8::Gemm g{c.w<bf16_t>(WS_HA), c.w<bf16_t>(WS_WIN + (size_t)(l & 1) * WSET), NTOK, ZP, 1024}; pg8::StaticOrder S; S.init(NTOK, ZP, c.G, c.blk); pg8::EpiBf16 E{c.w<bf16_t>(WS_Z), ZP};
                pg8::gemm_phase<pg8::EpiBf16, pg8::StaticOrder, true, true>((LAS unsigned char*)lds, g, S, E); });
        PHASE(4, ph_mixers(c, l));
        PHASE(5, ph_attn(c, l));
        PHASE(6, { pg8::Gemm g{c.w<bf16_t>(WS_YB), c.w<bf16_t>(WS_WOUT + (size_t)(l & 1) * WSET), NTOK, 1024, 1024}; pg8::StaticOrder S; S.init(NTOK, 1024, c.G, c.blk);
                pg8::EpiResid E{(l == 0) ? c.inf(I_X) : args.out, args.out, c.w<float>(WS_MOD) + (size_t)l * NB * 6144 + 2048, 6144, SEQ, (l == 0) ? (const bf16_t*)nullptr : c.w<bf16_t>(WS_Y1)};
                pg8::gemm_phase<pg8::EpiResid, pg8::StaticOrder, true, true>((LAS unsigned char*)lds, g, S, E); });
        PHASE(7, ph_router(c, l));
        PHASE(8, ph_gather(c, l));
        PHASE(9, { pg8::Gemm g{c.w<bf16_t>(WS_HA), c.w<bf16_t>(WS_WUP + (size_t)(l & 1) * WSET), NR, 32 * 1024, 1024}; pg8::MoeOrder S{c.w<int>(WS_TILE), c.G, c.blk}; pg8::EpiSwiglu E{c.w<bf16_t>(WS_Q)};
                pg8::gemm_phase<pg8::EpiSwiglu, pg8::MoeOrder, true, true, true>((LAS unsigned char*)lds, g, S, E, c.w<int>(WS_ROWTOK)); });
        PHASE(10, { pg8::Gemm g{c.w<bf16_t>(WS_Q), c.w<bf16_t>(WS_WDN + (size_t)(l & 1) * WSET), NR, 32 * 1024, 512}; pg8::MoeOrder S{c.w<int>(WS_TILE), c.G, c.blk};
                pg8::EpiDown E{c.w<int>(WS_ROWTOK), c.w<float>(WS_ROWW), args.out, c.w<bf16_t>(WS_Y1), c.w<float>(WS_MOD) + (size_t)l * NB * 6144 + 5120, 6144, SEQ};
                pg8::gemm_phase<pg8::EpiDown, pg8::MoeOrder, true, true>((LAS unsigned char*)lds, g, S, E); });
    }
    PHASE(11, ph_final(c));
#undef PHASE
}

extern "C" void kernel_launch(void* const* d_in, const int* in_sizes, int n_in, void* d_out, int out_size, void* d_ws, size_t ws_size, hipStream_t stream) {
    static int grid = 0;
    if (grid == 0) {
        if (n_in != 30 || out_size != NTOK * 1024 || ws_size < WS_END) { fprintf(stderr, "kernel_launch: shape/workspace mismatch (n_in %d out %d ws %zu need %zu)\n", n_in, out_size, ws_size, (size_t)WS_END); grid = -1; return; }
        int dev = 0, cus = 0;
        if (hipGetDevice(&dev) != hipSuccess || hipDeviceGetAttribute(&cus, hipDeviceAttributeMultiprocessorCount, dev) != hipSuccess) { grid = -1; return; }
        if (hipFuncSetAttribute((const void*)mk_fwd, hipFuncAttributeMaxDynamicSharedMemorySize, LDS_BYTES) != hipSuccess) { fprintf(stderr, "kernel_launch: hipFuncSetAttribute failed\n"); grid = -1; return; }
        int per_cu = 0; (void)hipOccupancyMaxActiveBlocksPerMultiprocessor(&per_cu, (const void*)mk_fwd, 512, LDS_BYTES);
        if (per_cu < 1) fprintf(stderr, "kernel_launch: occupancy query says %d blocks per CU\n", per_cu);
        grid = cus;
    }
    if (grid < 0) return;
    (void)hipMemsetAsync((char*)d_ws + WS_CTL, 0, CTL_BYTES, stream);
    Args a{};
    for (int i = 0; i < 30; ++i) a.in[i] = d_in[i];
    a.out = (float*)d_out; a.ws = (unsigned char*)d_ws;
#if MK_SPLIT
    for (int p = 0; p < N_PHASES; ++p) { a.ph_lo = p; a.ph_hi = p + 1;
#else
    { a.ph_lo = 0; a.ph_hi = N_PHASES;
#endif
#ifdef EMU
        EMU_LAUNCH(mk_fwd, grid, 512, LDS_BYTES, stream, a);
#else
        hipLaunchKernelGGL(mk_fwd, dim3(grid), dim3(512), LDS_BYTES, stream, a);
#endif
    }
}
```

```cpp
#include <hip/hip_runtime.h>
#include <cstdio>
#include <cstdint>

#ifndef CFG_B
#define CFG_B 4
#endif
#ifndef CFG_S
#define CFG_S 8192
#endif
#ifndef CFG_L
#define CFG_L 4
#endif
#ifndef MK_SPLIT
#define MK_SPLIT 0
#endif

#ifdef EMU
#define ASMV(...) ((void)0)
#define LAS
#define LAUNDER_V(x) ((void)0)
#define LAUNDER_S(x) ((void)0)
#else
#define ASMV(...) asm volatile(__VA_ARGS__)
#define LAS __attribute__((address_space(3)))
#define LAUNDER_V(x) asm volatile("" : "+v"(x))
#define LAUNDER_S(x) asm volatile("" : "+s"(x))
#endif

typedef unsigned short bf16_t;
typedef short bf16x8 __attribute__((ext_vector_type(8)));
typedef short s16x4 __attribute__((ext_vector_type(4)));
typedef float f32x4 __attribute__((ext_vector_type(4)));
typedef float f32x16 __attribute__((ext_vector_type(16)));
typedef unsigned u32x4 __attribute__((ext_vector_type(4)));
typedef unsigned u32x2 __attribute__((ext_vector_type(2)));

__device__ __forceinline__ float bf2f(bf16_t h) { return __builtin_bit_cast(float, (unsigned)h << 16); }
__device__ __forceinline__ float bflo(unsigned w) { return __builtin_bit_cast(float, w << 16); }
__device__ __forceinline__ float bfhi(unsigned w) { return __builtin_bit_cast(float, w & 0xffff0000u); }
__device__ __forceinline__ unsigned f2bf_bits(float f) { unsigned u = __builtin_bit_cast(unsigned, f); u += 0x7fffu + ((u >> 16) & 1u); return u >> 16; }
#ifdef EMU
__device__ __forceinline__ unsigned cvt_pk_bf16(float lo, float hi) { return f2bf_bits(lo) | (f2bf_bits(hi) << 16); }
__device__ __forceinline__ unsigned cvt_pk_bf16_pinned(float lo, float hi) { return f2bf_bits(lo) | (f2bf_bits(hi) << 16); }
#else
typedef __bf16 bf16v2_t __attribute__((ext_vector_type(2)));
typedef float f32v2_t __attribute__((ext_vector_type(2)));
__device__ __forceinline__ unsigned cvt_pk_bf16(float lo, float hi) { const bf16v2_t r = __builtin_convertvector((f32v2_t){lo, hi}, bf16v2_t); return __builtin_bit_cast(unsigned, r); }
__device__ __forceinline__ unsigned cvt_pk_bf16_pinned(float lo, float hi) { unsigned r; asm volatile("v_cvt_pk_bf16_f32 %0, %1, %2\n\ts_nop 1" : "=v"(r) : "v"(lo), "v"(hi)); return r; }
#endif
__device__ __forceinline__ float fast_exp(float x) { return __builtin_amdgcn_exp2f(x * 1.44269504089f); }
__device__ __forceinline__ float fsigmoid(float x) { return __builtin_amdgcn_rcpf(1.0f + fast_exp(-x)); }
__device__ __forceinline__ float fsilu(float x) { return x * fsigmoid(x); }
__device__ __forceinline__ float frsqrt(float x) { return __builtin_amdgcn_rsqf(x); }
#ifdef EMU
__device__ __forceinline__ float wave_sum(float v) {
#pragma unroll
    for (int m = 32; m >= 1; m >>= 1) v += __shfl_xor(v, m);
    return v;
}
#else
template <int CTRL, int ROW_MASK> __device__ __forceinline__ float dpp_t(float v) { return __builtin_bit_cast(float, __builtin_amdgcn_update_dpp(0, __builtin_bit_cast(int, v), CTRL, ROW_MASK, 0xF, false)); }
#define dpp_f(v, ctrl, rm) dpp_t<ctrl, rm>(v)
__device__ __forceinline__ float wave_sum(float v) {
    v += dpp_f(v, 0xB1, 0xF);
    v += dpp_f(v, 0x4E, 0xF);
    v += dpp_f(v, 0x141, 0xF);
    v += dpp_f(v, 0x140, 0xF);
    v += dpp_f(v, 0x142, 0xA);
    v += dpp_f(v, 0x143, 0xC);
    return __builtin_bit_cast(float, __builtin_amdgcn_readlane(__builtin_bit_cast(int, v), 63));
}
__device__ __forceinline__ float half_sum(float v, int hi) {
    v += dpp_f(v, 0xB1, 0xF); v += dpp_f(v, 0x4E, 0xF); v += dpp_f(v, 0x141, 0xF); v += dpp_f(v, 0x140, 0xF);
    v += dpp_f(v, 0x142, 0xA);
    const float a = __builtin_bit_cast(float, __builtin_amdgcn_readlane(__builtin_bit_cast(int, v), 31)), b = __builtin_bit_cast(float, __builtin_amdgcn_readlane(__builtin_bit_cast(int, v), 63));
    return hi ? b : a;
}
#endif
#ifdef EMU
__device__ __forceinline__ float half_sum(float v, int) {
#pragma unroll
    for (int m = 1; m < 32; m <<= 1) v += __shfl_xor(v, m);
    return v;
}
#endif

namespace pg8 {
#define PG8_LAS LAS
constexpr int BM = 256, BK = 64, HALF = 128, HTB = HALF * BK * 2  , STAGE_BYTES = 8 * HTB, NXCD = 8, WGM = 8;

__host__ __device__ __forceinline__ int lds_byte(int r, int c) { const int st = (r >> 4) * 2 + (c >> 5), rr = r & 15, cc = c & 31, ob = rr * 64 + cc * 2; return st * 1024 + (ob ^ (((ob >> 9) & 1) << 5)); }
__host__ __device__ __forceinline__ void stage_rc(int b, int& R, int& C) { const int st = b / 1024, sb = b % 1024, swz = sb ^ (((sb >> 9) & 1) << 5); R = (st >> 1) * 16 + swz / 64; C = (st & 1) * 32 + (swz % 64) / 2; }
__host__ __device__ __forceinline__ int perm32(int rho) { const int n = rho >> 4, i = rho & 15; return 8 * (i >> 2) + 4 * n + (i & 3); }

struct Unit { int pm, pn; };
struct Gemm { const bf16_t* A; const bf16_t* Bt; int M, N, K; };

struct StaticOrder {
    int nM, nN, nwg, G, c;
    __host__ __device__ void init(int M, int N, int G_, int c_) { nM = M / BM; nN = N / BM; nwg = nM * nN; G = G_; c = c_; }
    __host__ __device__ bool next(int i, Unit& u) const {
        const long L = (long)i * G + c; if (L >= nwg) return false;
        int wgid = (int)L; { const int q = nwg / NXCD, r = nwg % NXCD, xcd = wgid % NXCD, off = wgid / NXCD; wgid = (xcd < r ? xcd * (q + 1) : r * (q + 1) + (xcd - r) * q) + off; }
        const int nig = WGM * nN, gid = wgid / nig, fm = gid * WGM, gsz = (nM - fm) < WGM ? (nM - fm) : WGM;
        u.pm = fm + ((wgid % nig) % gsz); u.pn = (wgid % nig) / gsz; return true;
    }
    __device__ __forceinline__ void a_ready(const Unit&) const {}
    __device__ __forceinline__ void done(const Unit&) const {}
};
template <class Epi, class Sched, bool ALIGN_EPI = false, bool SP2 = false, bool GATHER = false>
__device__ __forceinline__ void gemm_phase(PG8_LAS unsigned char* lds, const Gemm g, const Sched& S, const Epi& E, const int* rowmap = nullptr) {
    int tid = threadIdx.x; LAUNDER_V(tid); const int wid = __builtin_amdgcn_readfirstlane(tid >> 6), lane = tid & 63, wr = wid >> 2, wc = wid & 3, fr = lane & 15, fq = lane >> 4;
    const int K = g.K, nt = K / BK;
    unsigned voffA[2], voffB[2]; int RA[2], CA[2];
#pragma unroll
    for (int i = 0; i < 2; ++i) { int R, C; stage_rc(tid * 16 + i * 8192, R, C); const int Rb = Epi::PERM ? ((R & ~31) + perm32(R & 31)) : R;
        voffA[i] = (unsigned)(R * K + C) * 2u; voffB[i] = (unsigned)(Rb * K + C) * 2u; RA[i] = R; CA[i] = C; }
    const size_t kstep = (size_t)(BK * 2);
    const size_t hstep = (size_t)HALF * K * 2;
    const size_t tstep = 2 * hstep;
    const size_t hA = GATHER ? (size_t)0 : hstep;
    unsigned vA0[2], vA1[2], nA0[2], nA1[2];
    auto rows_of = [&](const Unit& u, unsigned (&o0)[2], unsigned (&o1)[2]) {
#pragma unroll
        for (int i = 0; i < 2; ++i) { if constexpr (GATHER) { int t0 = rowmap[u.pm * BM + RA[i]], t1 = rowmap[u.pm * BM + HALF + RA[i]]; t0 = t0 < 0 ? 0 : (t0 >> 1); t1 = t1 < 0 ? 0 : (t1 >> 1);
                o0[i] = (unsigned)(t0 * K + CA[i]) * 2u; o1[i] = (unsigned)(t1 * K + CA[i]) * 2u; } else { o0[i] = voffA[i]; o1[i] = voffA[i]; } } };
    const unsigned ldsw = (unsigned)wid * 1024u;
    const int aoff = lds_byte(wr * 64 + fr, fq * 8), boff = lds_byte(wc * 32 + fr, fq * 8);
#define PG8_SA(b, h) (((b) * 2 + (h)) * HTB)
#define PG8_SB(b, h) ((4 + (b) * 2 + (h)) * HTB)
#define PG8_STAGE(bufoff, gbase, voff) do { _Pragma("unroll") for (int _i = 0; _i < 2; ++_i) \
        __builtin_amdgcn_global_load_lds((const unsigned*)((const char*)(gbase) + (voff)[_i]), (PG8_LAS unsigned*)(lds + (bufoff) + ldsw + _i * 8192), 16, 0, 0); } while (0)
#define PG8_LDA(dst, b, h) do { _Pragma("unroll") for (int m = 0; m < 4; ++m) _Pragma("unroll") for (int k = 0; k < 2; ++k) dst[m][k] = *(const PG8_LAS bf16x8*)(lds + PG8_SA(b, h) + aoff + m * 2048 + k * 1024); } while (0)
#define PG8_LDB(dst, b, h) do { _Pragma("unroll") for (int n = 0; n < 2; ++n) _Pragma("unroll") for (int k = 0; k < 2; ++k) dst[n][k] = *(const PG8_LAS bf16x8*)(lds + PG8_SB(b, h) + boff + n * 2048 + k * 1024); } while (0)
#define PG8_MMA(ai, bj, At, Bt) do { __builtin_amdgcn_s_setprio(1); _Pragma("unroll") for (int m = 0; m < 4; ++m) _Pragma("unroll") for (int n = 0; n < 2; ++n) _Pragma("unroll") for (int k = 0; k < 2; ++k) \
        acc[ai][bj][m][n] = __builtin_amdgcn_mfma_f32_16x16x32_bf16(Bt[n][k], At[m][k], acc[ai][bj][m][n], 0, 0, 0); __builtin_amdgcn_s_setprio(0); } while (0)
#define PG8_WAIT_V(n) ASMV("s_waitcnt vmcnt(" #n ")" ::: "memory")
#define PG8_WAIT_L(n) ASMV("s_waitcnt lgkmcnt(" #n ")" ::: "memory")
#define PG8_BAR __builtin_amdgcn_s_barrier()
#define PG8_SCHED __builtin_amdgcn_sched_barrier(0)
    Unit cur, nxt; int ui = 0;
    if (!S.next(0, cur)) return;
    f32x4 acc[2][2][4][2];
#pragma unroll
    for (int a = 0; a < 2; ++a)
#pragma unroll
        for (int b = 0; b < 2; ++b)
#pragma unroll
            for (int m = 0; m < 4; ++m)
#pragma unroll
                for (int n = 0; n < 2; ++n) acc[a][b][m][n] = (f32x4){0.f, 0.f, 0.f, 0.f};
    bf16x8 At[4][2], B0[2][2], B1[2][2];
    const char* cA = GATHER ? (const char*)g.A : (const char*)g.A + (size_t)cur.pm * tstep; rows_of(cur, vA0, vA1); const char* cB = (const char*)g.Bt + (size_t)cur.pn * tstep;
    S.a_ready(cur);
    if constexpr (SP2) {
        PG8_STAGE(PG8_SB(0, 0), cB, voffB); PG8_STAGE(PG8_SB(0, 1), cB + hstep, voffB); PG8_STAGE(PG8_SA(0, 0), cA, vA0); PG8_STAGE(PG8_SA(0, 1), cA + hA, vA1);
        if (wr == 1) PG8_BAR;
        PG8_WAIT_V(2); PG8_BAR;
        PG8_STAGE(PG8_SB(1, 0), cB + kstep, voffB); PG8_STAGE(PG8_SA(1, 0), cA + kstep, vA0); PG8_STAGE(PG8_SB(1, 1), cB + hstep + kstep, voffB);
        PG8_WAIT_V(6); PG8_BAR;
    } else {
        PG8_STAGE(PG8_SB(0, 0), cB, voffB); PG8_STAGE(PG8_SA(0, 0), cA, vA0); PG8_STAGE(PG8_SB(0, 1), cB + hstep, voffB); PG8_STAGE(PG8_SA(0, 1), cA + hA, vA1);
        if (wr == 1) PG8_BAR;
        PG8_WAIT_V(4); PG8_BAR;
        PG8_STAGE(PG8_SB(1, 0), cB + kstep, voffB); PG8_STAGE(PG8_SA(1, 0), cA + kstep, vA0); PG8_STAGE(PG8_SB(1, 1), cB + hstep + kstep, voffB);
        PG8_WAIT_V(6); PG8_BAR;
    }
    for (;;) {
        const bool has_next = S.next(ui + 1, nxt);
        const char* nA = GATHER ? (const char*)g.A : (has_next ? (const char*)g.A + (size_t)nxt.pm * tstep : cA);
        if (has_next) rows_of(nxt, nA0, nA1); else { nA0[0] = vA0[0]; nA0[1] = vA0[1]; nA1[0] = vA1[0]; nA1[1] = vA1[1]; } const char* nB = has_next ? (const char*)g.Bt + (size_t)nxt.pn * tstep : cB;
        for (int t = 0; t < nt; t += 2) {
            const bool last = (t == nt - 2);
            unsigned sA0[2], sA1[2];
#pragma unroll
            for (int i = 0; i < 2; ++i) { sA0[i] = last ? nA0[i] : vA0[i]; sA1[i] = last ? nA1[i] : vA1[i]; }
            const char* a1 = cA + (size_t)(t + 1) * kstep;
            const char* a2 = last ? nA : cA + (size_t)(t + 2) * kstep; const char* b2 = last ? nB : cB + (size_t)(t + 2) * kstep;
            const char* a3 = a2 + kstep; const char* b3 = b2 + kstep;
            if (last && has_next) S.a_ready(nxt);
            if constexpr (SP2) {
            PG8_LDB(B0, 0, 0); PG8_LDB(B1, 0, 1); PG8_SCHED; PG8_LDA(At, 0, 0); PG8_STAGE(PG8_SA(1, 1), a1 + hA, vA1);
            PG8_WAIT_V(8); PG8_WAIT_L(0); PG8_BAR; PG8_MMA(0, 0, At, B0); PG8_MMA(0, 1, At, B1); PG8_BAR; PG8_SCHED;
            PG8_LDA(At, 0, 1); PG8_STAGE(PG8_SB(0, 0), b2, voffB); PG8_STAGE(PG8_SB(0, 1), b2 + hstep, voffB); PG8_STAGE(PG8_SA(0, 0), a2, sA0);
            PG8_WAIT_V(8); PG8_WAIT_L(0); PG8_BAR; PG8_MMA(1, 0, At, B0); PG8_MMA(1, 1, At, B1); PG8_BAR; PG8_SCHED;
            PG8_LDB(B0, 1, 0); PG8_LDB(B1, 1, 1); PG8_SCHED; PG8_LDA(At, 1, 0); PG8_STAGE(PG8_SA(0, 1), a2 + hA, sA1);
            PG8_WAIT_V(8); PG8_WAIT_L(0); PG8_BAR; PG8_MMA(0, 0, At, B0); PG8_MMA(0, 1, At, B1); PG8_BAR; PG8_SCHED;
            PG8_LDA(At, 1, 1); PG8_STAGE(PG8_SB(1, 0), b3, voffB); PG8_STAGE(PG8_SB(1, 1), b3 + hstep, voffB); PG8_STAGE(PG8_SA(1, 0), a3, sA0);
            PG8_WAIT_V(8); PG8_WAIT_L(0); PG8_BAR; PG8_MMA(1, 0, At, B0); PG8_MMA(1, 1, At, B1); PG8_BAR; PG8_SCHED;
            } else {
            PG8_LDB(B0, 0, 0); PG8_SCHED; PG8_LDA(At, 0, 0); PG8_STAGE(PG8_SA(1, 1), a1 + hA, vA1);
            PG8_WAIT_L(8); PG8_BAR; PG8_WAIT_L(0); PG8_MMA(0, 0, At, B0); PG8_BAR; PG8_SCHED;
            PG8_LDB(B1, 0, 1); PG8_STAGE(PG8_SB(0, 0), b2, voffB);
            PG8_BAR; PG8_WAIT_L(0); PG8_MMA(0, 1, At, B1); PG8_BAR;
            PG8_LDA(At, 0, 1); PG8_STAGE(PG8_SA(0, 0), a2, sA0);
            PG8_BAR; PG8_WAIT_L(0); PG8_MMA(1, 0, At, B0); PG8_BAR; PG8_SCHED;
            PG8_STAGE(PG8_SB(0, 1), b2 + hstep, voffB);
            PG8_WAIT_V(6); PG8_BAR; PG8_MMA(1, 1, At, B1); PG8_BAR;
            PG8_LDB(B0, 1, 0); PG8_SCHED; PG8_LDA(At, 1, 0); PG8_STAGE(PG8_SA(0, 1), a2 + hA, sA1);
            PG8_WAIT_L(8); PG8_BAR; PG8_WAIT_L(0); PG8_MMA(0, 0, At, B0); PG8_BAR; PG8_SCHED;
            PG8_LDB(B1, 1, 1); PG8_STAGE(PG8_SB(1, 0), b3, voffB);
            PG8_BAR; PG8_WAIT_L(0); PG8_MMA(0, 1, At, B1); PG8_BAR;
            PG8_LDA(At, 1, 1); PG8_STAGE(PG8_SA(1, 0), a3, sA0);
            PG8_BAR; PG8_WAIT_L(0); PG8_MMA(1, 0, At, B0); PG8_BAR; PG8_SCHED;
            PG8_STAGE(PG8_SB(1, 1), b3 + hstep, voffB);
            PG8_WAIT_V(6); PG8_BAR; PG8_MMA(1, 1, At, B1); PG8_BAR;
            }
        }
        if constexpr (ALIGN_EPI) { if (wr == 0) PG8_BAR; }
        if constexpr (!Epi::AFTER_DRAIN) { E(acc, cur, wr, wc, fr, fq); S.done(cur); }
        if (!has_next) break;
#pragma unroll
        for (int a = 0; a < 2; ++a)
#pragma unroll
            for (int b = 0; b < 2; ++b)
#pragma unroll
                for (int m = 0; m < 4; ++m)
#pragma unroll
                    for (int n = 0; n < 2; ++n) acc[a][b][m][n] = (f32x4){0.f, 0.f, 0.f, 0.f};
        cur = nxt; cA = nA; cB = nB; ++ui; vA0[0] = nA0[0]; vA0[1] = nA0[1]; vA1[0] = nA1[0]; vA1[1] = nA1[1];
        if constexpr (ALIGN_EPI) { if (wr == 1) PG8_BAR; }
    }
    PG8_WAIT_V(0);
    if constexpr (!ALIGN_EPI) { if (wr == 0) PG8_BAR; }
    PG8_BAR;
    if constexpr (Epi::AFTER_DRAIN) { E.fused(acc, cur, wr, wc, fr, fq, lds, wid, lane); S.done(cur); }
#undef PG8_SA
#undef PG8_SB
#undef PG8_STAGE
#undef PG8_LDA
#undef PG8_LDB
#undef PG8_MMA
#undef PG8_WAIT_V
#undef PG8_WAIT_L
#undef PG8_BAR
#undef PG8_SCHED
}

struct EpiBf16 {
    static constexpr bool PERM = true, AFTER_DRAIN = false;
    bf16_t* O; int ldc;
    __device__ __forceinline__ void operator()(const f32x4 (&acc)[2][2][4][2], const Unit& u, int wr, int wc, int fr, int fq) const {
        const int row0 = u.pm * BM + wr * 64 + fr, col0 = u.pn * BM + wc * 32 + 8 * fq;
#pragma unroll
        for (int ai = 0; ai < 2; ++ai)
#pragma unroll
            for (int m = 0; m < 4; ++m) { bf16_t* rowp = O + (size_t)(row0 + ai * HALF + m * 16) * ldc + col0;
#pragma unroll
                for (int bj = 0; bj < 2; ++bj) { const f32x4 v0 = acc[ai][bj][m][0], v1 = acc[ai][bj][m][1];
                    u32x4 w; w.x = cvt_pk_bf16(v0[0], v0[1]); w.y = cvt_pk_bf16(v0[2], v0[3]); w.z = cvt_pk_bf16(v1[0], v1[1]); w.w = cvt_pk_bf16(v1[2], v1[3]);
                    *(u32x4*)(rowp + bj * HALF) = w; } }
    }
};
struct EpiResid {
    static constexpr bool PERM = true, AFTER_DRAIN = false;
    const float* xin; float* xout; const float* gate; int gstride; int seq; const bf16_t* y1;
    __device__ __forceinline__ void operator()(const f32x4 (&acc)[2][2][4][2], const Unit& u, int wr, int wc, int fr, int fq) const {
        const int row0 = u.pm * BM + wr * 64 + fr, col0 = u.pn * BM + wc * 32 + 8 * fq;
#pragma unroll
        for (int ai = 0; ai < 2; ++ai)
#pragma unroll
            for (int m = 0; m < 4; ++m) { const int row = row0 + ai * HALF + m * 16; const float* gp = gate + (size_t)(row / seq) * gstride;
#pragma unroll
                for (int bj = 0; bj < 2; ++bj) { const int c = col0 + bj * HALF; const size_t o = (size_t)row * 1024 + c;
                    const f32x4 g0 = *(const f32x4*)(gp + c), g1 = *(const f32x4*)(gp + c + 4);
                    f32x4 x0 = *(const f32x4*)(xin + o), x1 = *(const f32x4*)(xin + o + 4);
                    if (y1) { const u32x4 y = *(const u32x4*)(y1 + o); x0 += (f32x4){bflo(y.x), bfhi(y.x), bflo(y.y), bfhi(y.y)}; x1 += (f32x4){bflo(y.z), bfhi(y.z), bflo(y.w), bfhi(y.w)}; }
                    *(f32x4*)(xout + o) = x0 + g0 * acc[ai][bj][m][0]; *(f32x4*)(xout + o + 4) = x1 + g1 * acc[ai][bj][m][1]; } }
    }
};
struct EpiSwiglu {
    static constexpr bool PERM = true, AFTER_DRAIN = false;
    bf16_t* HB;
    __device__ __forceinline__ void operator()(const f32x4 (&acc)[2][2][4][2], const Unit& u, int wr, int wc, int fr, int fq) const {
        const int row0 = u.pm * BM + wr * 64 + fr, col0 = (u.pn & 3) * 128 + wc * 32 + 8 * fq;
#pragma unroll
        for (int ai = 0; ai < 2; ++ai)
#pragma unroll
            for (int m = 0; m < 4; ++m) { bf16_t* p = HB + (size_t)(row0 + ai * HALF + m * 16) * 512 + col0;
                float h[8];
#pragma unroll
                for (int n = 0; n < 2; ++n)
#pragma unroll
                    for (int k = 0; k < 4; ++k) h[n * 4 + k] = fsilu(acc[ai][0][m][n][k]) * acc[ai][1][m][n][k];
                u32x4 w; w.x = cvt_pk_bf16(h[0], h[1]); w.y = cvt_pk_bf16(h[2], h[3]); w.z = cvt_pk_bf16(h[4], h[5]); w.w = cvt_pk_bf16(h[6], h[7]);
                *(u32x4*)p = w; }
    }
};
struct EpiDown {
    static constexpr bool PERM = true, AFTER_DRAIN = false;
    const int* row_tok; const float* row_w; float* x; bf16_t* y1; const float* gate; int gstride; int seq;
    __device__ __forceinline__ void operator()(const f32x4 (&acc)[2][2][4][2], const Unit& u, int wr, int wc, int fr, int fq) const {
        const int row0 = u.pm * BM + wr * 64 + fr, col0 = (u.pn & 3) * BM + wc * 32 + 8 * fq;
#pragma unroll
        for (int ai = 0; ai < 2; ++ai)
#pragma unroll
            for (int m = 0; m < 4; ++m) { const int row = row0 + ai * HALF + m * 16; const int ts = row_tok[row];
                if (ts >= 0) { const int tok = ts >> 1; const float w = row_w[row]; const float* gp = gate + (size_t)(tok / seq) * gstride;
#pragma unroll
                    for (int bj = 0; bj < 2; ++bj) { const int c = col0 + bj * HALF; const size_t o = (size_t)tok * 1024 + c;
                        const f32x4 v0 = acc[ai][bj][m][0] * (*(const f32x4*)(gp + c)) * w, v1 = acc[ai][bj][m][1] * (*(const f32x4*)(gp + c + 4)) * w;
                        if (ts & 1) { u32x4 q; q.x = cvt_pk_bf16(v0[0], v0[1]); q.y = cvt_pk_bf16(v0[2], v0[3]); q.z = cvt_pk_bf16(v1[0], v1[1]); q.w = cvt_pk_bf16(v1[2], v1[3]); *(u32x4*)(y1 + o) = q; }
                        else { *(f32x4*)(x + o) = *(const f32x4*)(x + o) + v0; *(f32x4*)(x + o + 4) = *(const f32x4*)(x + o + 4) + v1; } } } }
    }
};
struct MoeOrder {
    const int* tile; int G, c;
    __device__ __forceinline__ bool next(int i, Unit& u) const { const int v = ((G & 7) == 0) ? (c & 7) * (G >> 3) + (c >> 3) : c; const int L = i * G + v, nt = tile[0]; if (L >= nt * 4) return false; u.pm = L >> 2; u.pn = tile[1 + (L >> 2)] * 4 + (L & 3); return true; }
    __device__ __forceinline__ void a_ready(const Unit&) const {}
    __device__ __forceinline__ void done(const Unit&) const {}
};
}

constexpr int NB = CFG_B, SEQ = CFG_S, NL = CFG_L, NTOK = NB * SEQ, DM = 1024, ZP = 2304;
constexpr int NBH = NB * 4, NCH = SEQ / 128, NQT = SEQ / 256;
constexpr int NR = 2 * NTOK + 32 * 256;
constexpr int Z_CQ = 0, Z_CKV = 192, Z_KR = 320, Z_POOL = 352, Z_HQ = 608, Z_HF = 864, Z_HI = 1120, Z_HG = 1376, Z_CA = 1632, Z_CG = 1888;
constexpr float EPS = 1e-6f;
static_assert(SEQ % 256 == 0 && NTOK % 256 == 0 && (NQT % 2) == 0, "shape");
constexpr size_t al256(size_t x) { return (x + 255) & ~(size_t)255; }
constexpr size_t cmax(size_t a, size_t b) { return a > b ? a : b; }
constexpr size_t WS_CTL = 0, CTL_BYTES = 65536;
constexpr size_t CTL_CNT = 16384;
constexpr size_t CTL_HG = 32768;
constexpr size_t WS_MODP = WS_CTL + CTL_BYTES;
constexpr size_t WS_MOD = WS_MODP + al256((size_t)16 * NL * NB * 6144 * 4);
constexpr size_t WS_LB = WS_MOD + al256((size_t)NL * NB * 6144 * 4);
constexpr size_t WS_ROPE = WS_LB + al256((size_t)NL * 256 * 4);
constexpr size_t WS_WIN = WS_ROPE + al256((size_t)NTOK * 32 * 4);
constexpr size_t WS_WOUT = WS_WIN + (size_t)ZP * 1024 * 2;
constexpr size_t WS_WUQ = WS_WOUT + (size_t)1024 * 1024 * 2;
constexpr size_t WS_WUKV = WS_WUQ + al256((size_t)384 * 192 * 2);
constexpr size_t WS_WPOOL = WS_WUKV + al256((size_t)512 * 128 * 2);
constexpr size_t WS_WUP = WS_WPOOL + al256((size_t)4 * 64 * 64 * 2);
constexpr size_t WS_WDN = WS_WUP + (size_t)32 * 1024 * 1024 * 2;
constexpr size_t WS_RWT = WS_WDN + (size_t)32 * 1024 * 512 * 2;
constexpr size_t WSET = WS_RWT + 36 * 1024 * 4 - WS_WIN;
constexpr size_t WS_HA = WS_WIN + 2 * WSET;
constexpr size_t WS_Z = WS_HA + (size_t)NTOK * 1024 * 2;
constexpr size_t Z_BYTES = cmax((size_t)NTOK * ZP * 2, (size_t)NR * 1024 * 2);
constexpr size_t WS_Q = WS_Z + Z_BYTES;
constexpr size_t WS_K = WS_Q + (size_t)NTOK * 4 * 96 * 2;
constexpr size_t WS_VT = WS_K + (size_t)NTOK * 4 * 96 * 2;
constexpr size_t WS_YB = WS_VT + (size_t)NTOK * 4 * 64 * 2;
constexpr size_t R2_BYTES = cmax(WS_YB + (size_t)NTOK * 1024 * 2 - WS_Q, (size_t)NR * 512 * 2);
constexpr size_t WS_Y1 = WS_Q + R2_BYTES;
constexpr size_t WS_SC = WS_Y1 + (size_t)NTOK * 1024 * 2;
constexpr size_t WS_PC = WS_SC + (size_t)NBH * NCH * 4096 * 4;
constexpr size_t WS_S0 = WS_PC + al256((size_t)NBH * NCH * 64 * 4);
constexpr size_t WS_ASGE = WS_S0 + (size_t)NBH * NCH * 4096 * 4;
constexpr size_t WS_ASGR = WS_ASGE + (size_t)NTOK * 8;
constexpr size_t WS_ASGW = WS_ASGR + (size_t)NTOK * 8;
constexpr size_t WS_ROWTOK = WS_ASGW + (size_t)NTOK * 8;
constexpr size_t WS_ROWW = WS_ROWTOK + al256((size_t)NR * 4);
constexpr size_t WS_TILE = WS_ROWW + al256((size_t)NR * 4);
constexpr size_t WS_END = WS_TILE + al256((size_t)(NR / 256 + 16) * 4);
constexpr int LDS_BYTES = 160 * 1024;
constexpr int LDS_XB = LDS_BYTES - 16;

#define XB_TMO      128
#define XB_XCNT(j)  (256  + 64 * (j))
#define XB_XSUB(j)  (1280 + 64 * (j))
#define XB_XGEN(j)  (2304 + 64 * (j))
#define XB_TOP      3328
#define XB_TOPGEN   3392
#define XCD_BAR_WORDS 3456
#define XB_SPIN_CAP (1u << 18)
__device__ __forceinline__ unsigned xb_ld(unsigned* p)              { return __hip_atomic_load(p, __ATOMIC_RELAXED, __HIP_MEMORY_SCOPE_AGENT); }
__device__ __forceinline__ unsigned xb_add(unsigned* p, unsigned v) { return __hip_atomic_fetch_add(p, v, __ATOMIC_RELAXED, __HIP_MEMORY_SCOPE_AGENT); }
__device__ __forceinline__ unsigned xb_xcc_id() { return (unsigned)__builtin_amdgcn_s_getreg((3 << 11) | 20) & 0xFu; }
#define XB_SPIN(cond, bar) do { unsigned _sp = 0; while (cond) { __builtin_amdgcn_s_sleep(1); \
    if ((++_sp & 255u) == 0u) { if (xb_ld(&(bar)[XB_TMO])) break; if (_sp > XB_SPIN_CAP) { atomicAdd(&(bar)[XB_TMO], 1u); break; } } } } while (0)
struct XcdBarrier { unsigned* bar; unsigned x; volatile LAS unsigned* st; };
__device__ __forceinline__ XcdBarrier xcd_barrier_post(unsigned* bar, volatile LAS unsigned* st) {
    XcdBarrier b; b.bar = bar; b.x = xb_xcc_id(); b.st = st;
    if (threadIdx.x == 0) (void)xb_add(&bar[XB_XCNT(b.x)], 1u);
    return b;
}
__device__ __forceinline__ void xcd_barrier_complete(unsigned* bar, unsigned x, unsigned& nloc, unsigned& nx) {
    const unsigned G = gridDim.x * gridDim.y * gridDim.z;
    unsigned sum, cnt, mine, sp = 0u;
    for (;;) {
        sum = 0u; cnt = 0u; mine = 0u;
#pragma unroll
        for (unsigned j = 0; j < 16; ++j) { const unsigned c = xb_ld(&bar[XB_XCNT(j)]); sum += c; cnt += (c > 0u) ? 1u : 0u; mine = (j == x) ? c : mine; }
        if (sum == G) break;
        __builtin_amdgcn_s_sleep(1);
        if ((++sp & 255u) == 0u) { if (xb_ld(&bar[XB_TMO])) break; if (sp > XB_SPIN_CAP) { atomicAdd(&bar[XB_TMO], 1u); break; } }
    }
    nloc = mine > 0u ? mine : 1u; nx = cnt > 0u ? cnt : 1u;
}
__device__ __forceinline__ void xcd_barrier(const XcdBarrier& b) {
    ASMV("s_waitcnt vmcnt(0)" ::: "memory");
    __syncthreads();
    if (threadIdx.x == 0) {
        unsigned* bar = b.bar;
        __builtin_amdgcn_s_waitcnt(0);
        unsigned nloc = b.st[0], nx = b.st[1];
        if (nloc == 0u) { xcd_barrier_complete(bar, b.x, nloc, nx); b.st[0] = nloc; b.st[1] = nx; }
        const unsigned old = xb_add(&bar[XB_XSUB(b.x)], 1u);
        const unsigned gen = old / nloc;
        if (old + 1u == (gen + 1u) * nloc) {
            __builtin_amdgcn_fence(__ATOMIC_RELEASE, "agent");
            ASMV("s_waitcnt vmcnt(0)" ::: "memory");
            const unsigned og = xb_add(&bar[XB_TOP], 1u);
            const unsigned tg = og / nx;
            if (og + 1u == (tg + 1u) * nx) xb_add(&bar[XB_TOPGEN], 1u);
            else XB_SPIN(xb_ld(&bar[XB_TOPGEN]) == tg, bar);
            __builtin_amdgcn_fence(__ATOMIC_ACQUIRE, "agent");
            xb_add(&bar[XB_XGEN(b.x)], 1u);
            ASMV("s_waitcnt vmcnt(0)" ::: "memory");
        } else {
            XB_SPIN(xb_ld(&bar[XB_XGEN(b.x)]) == gen, bar);
            __builtin_amdgcn_fence(__ATOMIC_ACQUIRE, "agent");
            ASMV("s_waitcnt vmcnt(0)" ::: "memory");
        }
    }
    __syncthreads();
}

struct Args { const void* in[30]; float* out; unsigned char* ws; int ph_lo, ph_hi; };
enum { I_X = 0, I_C, I_POS, I_WADA, I_BADA, I_N1G, I_N2G, I_WIN, I_QAG, I_WUQ, I_KVAG, I_WUKV, I_QG, I_KG, I_WPOOL, I_PSCALE, I_LBL, I_HOG, I_DWW, I_DWB, I_LNG, I_LNB,
       I_WOUT, I_RGW, I_RGB, I_REW, I_REB, I_W1, I_W3, I_W2 };
struct Ctx {
    const Args* a; unsigned char* ws; unsigned char* lds; int tid, wid, lane, G, blk;
    __device__ __forceinline__ const float* inf(int i) const { return (const float*)a->in[i]; }
    template <class T> __device__ __forceinline__ T* w(size_t off) const { return (T*)(ws + off); }
};

__device__ __forceinline__ Ctx fresh(const Ctx& c0) { Ctx c = c0; LAUNDER_V(c.tid); LAUNDER_V(c.lane); LAUNDER_S(c.wid); return c; }
__device__ __forceinline__ void ph_prologue0(const Ctx& c_) { const Ctx c = fresh(c_);
    const float* cc = c.inf(I_C); const float* wada = c.inf(I_WADA); float* modp = c.w<float>(WS_MODP);
    for (int u = c.blk; u < NL * 16 * 12; u += c.G) {
        const int l = u / 192, r = u % 192, ic = r / 12, jb = r % 12, j = jb * 512 + c.tid;
        float* Ls = (float*)c.lds;
        __syncthreads();
        if (c.tid < NB * 64) Ls[c.tid] = fsilu(cc[(c.tid >> 6) * 1024 + ic * 64 + (c.tid & 63)]);
        __syncthreads();
        float acc[NB];
#pragma unroll
        for (int b = 0; b < NB; ++b) acc[b] = 0.f;
        const float* wp = wada + ((size_t)l * 1024 + ic * 64) * 6144 + j;
#pragma unroll
        for (int i0 = 0; i0 < 64; i0 += 16) { float wv[16];
#pragma unroll
            for (int i = 0; i < 16; ++i) wv[i] = wp[(size_t)(i0 + i) * 6144];
#pragma unroll
            for (int i = 0; i < 16; ++i)
#pragma unroll
                for (int b = 0; b < NB; ++b) acc[b] += Ls[b * 64 + i0 + i] * wv[i]; }
#pragma unroll
        for (int b = 0; b < NB; ++b) modp[(((size_t)ic * NL + l) * NB + b) * 6144 + j] = acc[b];
    }
    const int* pos = (const int*)c.a->in[I_POS]; float* rc = c.w<float>(WS_ROPE); float* rs = rc + (size_t)NTOK * 16;
    for (int e = c.blk * 512 + c.tid; e < NTOK * 16; e += c.G * 512) { const int t = e >> 4, i = e & 15;
        const float inv = exp2f(-(float)i * (13.287712379549449f / 16.0f));
        const float ang = (float)pos[t] * inv; rc[e] = cosf(ang); rs[e] = sinf(ang); }
    if (c.blk == 0 && c.tid < 256) { const float* lg = c.inf(I_LBL); float* lb = c.w<float>(WS_LB); float mx = -1e30f;
        for (int l = 0; l < NL; ++l) mx = fmaxf(mx, lg[l * 256 + c.tid]);
        float den = 0.f; for (int l = 0; l < NL; ++l) den += expf(lg[l * 256 + c.tid] - mx);
        float cum = 0.f, first = 0.f; for (int l = 0; l < NL; ++l) { cum += expf(lg[l * 256 + c.tid] - mx) / den; if (l == 0) first = cum; lb[l * 256 + c.tid] = cum - first; } }
}
__device__ __forceinline__ void ph_prologue1(const Ctx& c_) { const Ctx c = fresh(c_);
    const float* modp = c.w<float>(WS_MODP); float* mod = c.w<float>(WS_MOD); const float* bada = c.inf(I_BADA);
    for (int e = c.blk * 512 + c.tid; e < NL * NB * 6144; e += c.G * 512) { const int j = e % 6144, l = e / (NB * 6144);
        float s = bada[l * 6144 + j];
#pragma unroll
        for (int ic = 0; ic < 16; ++ic) s += modp[(size_t)ic * NL * NB * 6144 + e];
        mod[e] = s; }
}

__device__ __forceinline__ void ld8bf(const bf16_t* p, float (&o)[8]) { const u32x4 v = *(const u32x4*)p; o[0] = bflo(v.x); o[1] = bfhi(v.x); o[2] = bflo(v.y); o[3] = bfhi(v.y); o[4] = bflo(v.z); o[5] = bfhi(v.z); o[6] = bflo(v.w); o[7] = bfhi(v.w); }
__device__ __forceinline__ u32x4 pk8(const float (&o)[8]) { u32x4 w; w.x = cvt_pk_bf16(o[0], o[1]); w.y = cvt_pk_bf16(o[2], o[3]); w.z = cvt_pk_bf16(o[4], o[5]); w.w = cvt_pk_bf16(o[6], o[7]); return w; }
__device__ __forceinline__ u32x4 pk8p(const float (&o)[8]) { u32x4 w; w.x = cvt_pk_bf16_pinned(o[0], o[1]); w.y = cvt_pk_bf16_pinned(o[2], o[3]); w.z = cvt_pk_bf16_pinned(o[4], o[5]); w.w = cvt_pk_bf16_pinned(o[6], o[7]); return w; }
__device__ __forceinline__ void cvt_tile(const Ctx& c, const float* src, int ldn, int nlim, int k0, int n0, bf16_t* dst, int ldk, int drow0) {
    float* T = (float*)c.lds;
#pragma unroll
    for (int i = 0; i < 8; ++i) { const int e = c.tid + 512 * i, kk = e >> 6, nn = e & 63; T[kk * 65 + nn] = (n0 + nn < nlim) ? src[(size_t)(k0 + kk) * ldn + n0 + nn] : 0.f; }
    __syncthreads();
#pragma unroll
    for (int i = 0; i < 4; ++i) { const int e = c.tid + 512 * i, nn = e >> 5, k2 = e & 31;
        *(unsigned*)(dst + (size_t)(drow0 + nn) * ldk + k0 + 2 * k2) = cvt_pk_bf16(T[(2 * k2) * 65 + nn], T[(2 * k2 + 1) * 65 + nn]); }
    __syncthreads();
}
__device__ __forceinline__ void cvt_big(const Ctx& c, const float* src, int ldn, int nlim, int k0, int n0, bf16_t* dst, int ldk, int mode) {
    float* T = (float*)c.lds;
    f32x4 v[8];
#pragma unroll
    for (int i = 0; i < 8; ++i) { const int e4 = c.tid + 512 * i, kk = e4 >> 6, n4 = e4 & 63; v[i] = (n0 + n4 * 4 < nlim) ? *(const f32x4*)(src + (size_t)(k0 + kk) * ldn + n0 + n4 * 4) : (f32x4){0.f, 0.f, 0.f, 0.f}; }
#pragma unroll
    for (int i = 0; i < 8; ++i) { const int e4 = c.tid + 512 * i, kk = e4 >> 6, n4 = e4 & 63; float* p = T + kk * 261 + n4 * 4; p[0] = v[i][0]; p[1] = v[i][1]; p[2] = v[i][2]; p[3] = v[i][3]; }
    __syncthreads();
#pragma unroll
    for (int i = 0; i < 4; ++i) { const int e = c.tid + 512 * i, k8 = e & 7, nn = e >> 3, n = n0 + nn; float o[8];
#pragma unroll
        for (int j = 0; j < 8; ++j) o[j] = T[(8 * k8 + j) * 261 + nn];
        const int row = (mode == 0) ? n : ((n >> 7) * 256 + (mode - 1) * 128 + (n & 127));
        *(u32x4*)(dst + (size_t)row * ldk + k0 + 8 * k8) = pk8(o); }
    __syncthreads();
}
constexpr int CT_IN = 16 * 9, CT_OUT = 16 * 4, CT_W13 = 32 * 16 * 2, CT_W2 = 32 * 8 * 4, CT_UQ = 3 * 6, CT_UKV = 2 * 8, CT_POOL = 4;
constexpr int CT_TOTAL = CT_IN + CT_OUT + 2 * CT_W13 + CT_W2 + CT_UQ + CT_UKV + CT_POOL;
__device__ __forceinline__ void ph_cvt(const Ctx& c_, int l) { const Ctx c = fresh(c_);
    { const float* rgw = c.inf(I_RGW) + (size_t)l * 1024 * 4; const float* rew = c.inf(I_REW) + (size_t)l * 1024 * 32; float* rwt = c.w<float>(WS_RWT + (size_t)(l & 1) * WSET);
        for (int e = c.blk * 512 + c.tid; e < 36 * 1024; e += c.G * 512) { const int g = e >> 10, k = e & 1023; rwt[e] = (g < 4) ? rgw[k * 4 + g] : rew[k * 32 + g - 4]; } }
    for (int t = c.blk; t < CT_TOTAL; t += c.G) {
        int r = t;
        if (r < 2 * CT_W13) { const int which = r / CT_W13; r %= CT_W13; const int e = r / 32, kt = (r % 32) / 2, nt = r % 2;
            cvt_big(c, c.inf(which ? I_W3 : I_W1) + ((size_t)l * 32 + e) * 1024 * 512, 512, 512, kt * 64, nt * 256, c.w<bf16_t>(WS_WUP + (size_t)(l & 1) * WSET) + (size_t)e * 1024 * 1024, 1024, 1 + which); continue; } r -= 2 * CT_W13;
        if (r < CT_W2) { const int e = r / 32, kt = (r % 32) / 4, nt = r % 4;
            cvt_big(c, c.inf(I_W2) + ((size_t)l * 32 + e) * 512 * 1024, 1024, 1024, kt * 64, nt * 256, c.w<bf16_t>(WS_WDN + (size_t)(l & 1) * WSET) + (size_t)e * 1024 * 512, 512, 0); continue; } r -= CT_W2;
        if (r < CT_IN) { const int kt = r / 9, nt = r % 9; cvt_big(c, c.inf(I_WIN) + (size_t)l * 1024 * 2144, 2144, 2144, kt * 64, nt * 256, c.w<bf16_t>(WS_WIN + (size_t)(l & 1) * WSET), 1024, 0); continue; } r -= CT_IN;
        if (r < CT_OUT) { const int kt = r / 4, nt = r % 4; cvt_big(c, c.inf(I_WOUT) + (size_t)l * 1024 * 1024, 1024, 1024, kt * 64, nt * 256, c.w<bf16_t>(WS_WOUT + (size_t)(l & 1) * WSET), 1024, 0); continue; } r -= CT_OUT;
        if (r < CT_UQ) { const int kt = r / 6, nt = r % 6; cvt_tile(c, c.inf(I_WUQ) + (size_t)l * 192 * 384, 384, 384, kt * 64, nt * 64, c.w<bf16_t>(WS_WUQ + (size_t)(l & 1) * WSET), 192, nt * 64); continue; } r -= CT_UQ;
        if (r < CT_UKV) { const int kt = r / 8, nt = r % 8; cvt_tile(c, c.inf(I_WUKV) + (size_t)l * 128 * 512, 512, 512, kt * 64, nt * 64, c.w<bf16_t>(WS_WUKV + (size_t)(l & 1) * WSET), 128, nt * 64); continue; } r -= CT_UKV;
        cvt_tile(c, c.inf(I_WPOOL) + ((size_t)l * 4 + r) * 4096, 64, 64, 0, 0, c.w<bf16_t>(WS_WPOOL + (size_t)(l & 1) * WSET) + r * 4096, 64, 0);
    }
}
__device__ __forceinline__ void ph_normrows(const Ctx& c_, int l) { const Ctx c = fresh(c_);
    const float* xin = (l == 0) ? c.inf(I_X) : c.a->out; float* xout = c.a->out; const bf16_t* y1 = c.w<bf16_t>(WS_Y1);
    const float* gn = c.inf(I_N1G) + l * 1024; const float* mod = c.w<float>(WS_MOD) + (size_t)l * NB * 6144; bf16_t* ha = c.w<bf16_t>(WS_HA);
    for (int row0 = c.blk * 8 + c.wid; row0 < NTOK; row0 += c.G * 16) {
        f32x4 v[2][4]; float ss[2];
#pragma unroll
        for (int q = 0; q < 2; ++q) { const int row = row0 + q * c.G * 8; ss[q] = 0.f;
            if (row < NTOK) {
#pragma unroll
                for (int i = 0; i < 4; ++i) { const int col = i * 256 + c.lane * 4; v[q][i] = *(const f32x4*)(xin + (size_t)row * 1024 + col);
                    if (l > 0) { const u32x2 y = *(const u32x2*)(y1 + (size_t)row * 1024 + col); v[q][i] += (f32x4){bflo(y.x), bfhi(y.x), bflo(y.y), bfhi(y.y)}; } } } }
#pragma unroll
        for (int q = 0; q < 2; ++q) { const int row = row0 + q * c.G * 8;
            if (row < NTOK) {
#pragma unroll
                for (int i = 0; i < 4; ++i) {
                    ss[q] += v[q][i][0] * v[q][i][0] + v[q][i][1] * v[q][i][1] + v[q][i][2] * v[q][i][2] + v[q][i][3] * v[q][i][3]; } } }
        ss[0] = wave_sum(ss[0]); ss[1] = wave_sum(ss[1]);
#pragma unroll
        for (int q = 0; q < 2; ++q) { const int row = row0 + q * c.G * 8;
            if (row < NTOK) { const int b = row / SEQ; const float* sh = mod + b * 6144; const float* sc = sh + 1024; const float rinv = frsqrt(ss[q] * (1.0f / 1024.0f) + EPS);
#pragma unroll
                for (int i = 0; i < 4; ++i) { const int col = i * 256 + c.lane * 4; const f32x4 g = *(const f32x4*)(gn + col), s1 = *(const f32x4*)(sc + col), s0 = *(const f32x4*)(sh + col);
                    const f32x4 h = v[q][i] * rinv * g * (s1 + 1.0f) + s0; u32x2 o; o.x = cvt_pk_bf16(h[0], h[1]); o.y = cvt_pk_bf16(h[2], h[3]); *(u32x2*)(ha + (size_t)row * 1024 + col) = o; } } }
    }
}

#define MFMA16(a, b, c) __builtin_amdgcn_mfma_f32_16x16x32_bf16((a), (b), (c), 0, 0, 0)
#define MFMA32(a, b, c) __builtin_amdgcn_mfma_f32_32x32x16_bf16((a), (b), (c), 0, 0, 0)

__device__ __forceinline__ void mix_unit(const Ctx& c_, int l, int r0) { const Ctx c = fresh(c_);
    const bf16_t* Z = c.w<bf16_t>(WS_Z); bf16_t* Aq = (bf16_t*)c.lds; bf16_t* Akv = (bf16_t*)(c.lds + 12800); float* Lkr = (float*)(c.lds + 21504);
    float* Lu = (float*)(c.lds + 25600); bf16_t* Lp = (bf16_t*)(c.lds + 73728); float* Lcu = (float*)(c.lds + 90624); float* Lco = (float*)c.lds;
    const int s0 = r0 % SEQ, b = r0 / SEQ, fr = c.lane & 15, fq = c.lane >> 4;
    {   const int t = c.tid >> 4, sub = c.tid & 15; const bf16_t* zr = Z + (size_t)(r0 + t) * ZP;
        const u32x4 zero4 = {0u, 0u, 0u, 0u};
        const u32x4 ra0 = *(const u32x4*)(zr + Z_CQ + sub * 8), ra1 = (sub < 8) ? *(const u32x4*)(zr + Z_CQ + 128 + sub * 8) : zero4, rk0 = *(const u32x4*)(zr + Z_CKV + sub * 8), rkr = (sub < 4) ? *(const u32x4*)(zr + Z_KR + sub * 8) : zero4;
        u32x4 rp[3], rca[4], rcg[4];
#pragma unroll
        for (int i = 0; i < 3; ++i) { const int ch = c.tid + 512 * i, row = ch >> 5, c8 = ch & 31; rp[i] = (ch < 47 * 32 && s0 - 15 + row >= 0) ? *(const u32x4*)(Z + (size_t)(r0 - 15 + row) * ZP + Z_POOL + c8 * 8) : zero4; }
#pragma unroll
        for (int i = 0; i < 4; ++i) { const int ch = c.tid + 512 * i, row = ch >> 5, c8 = ch & 31; const bool ok = (ch < 62 * 32 && s0 - 30 + row >= 0);
            rca[i] = ok ? *(const u32x4*)(Z + (size_t)(r0 - 30 + row) * ZP + Z_CA + c8 * 8) : zero4; rcg[i] = ok ? *(const u32x4*)(Z + (size_t)(r0 - 30 + row) * ZP + Z_CG + c8 * 8) : zero4; }
        auto un8 = [](const u32x4 v, float (&o)[8]) { o[0] = bflo(v.x); o[1] = bfhi(v.x); o[2] = bflo(v.y); o[3] = bfhi(v.y); o[4] = bflo(v.z); o[5] = bfhi(v.z); o[6] = bflo(v.w); o[7] = bfhi(v.w); };
        const float* qag = c.inf(I_QAG) + l * 192; const float* kvag = c.inf(I_KVAG) + l * 128;
        float a0[8], a1[8], k0[8]; float ssq = 0.f, ssk = 0.f; un8(ra0, a0); un8(ra1, a1); un8(rk0, k0);
#pragma unroll
        for (int j = 0; j < 8; ++j) { ssq += a0[j] * a0[j] + a1[j] * a1[j]; ssk += k0[j] * k0[j]; }
#pragma unroll
        for (int m = 1; m < 16; m <<= 1) { ssq += __shfl_xor(ssq, m); ssk += __shfl_xor(ssk, m); }
        const float rq = frsqrt(ssq * (1.0f / 192.0f) + EPS), rk = frsqrt(ssk * (1.0f / 128.0f) + EPS);
#pragma unroll
        for (int j = 0; j < 8; ++j) a0[j] *= rq * qag[sub * 8 + j];
        *(u32x4*)(Aq + t * 200 + sub * 8) = pk8(a0);
        if (sub < 8) {
#pragma unroll
            for (int j = 0; j < 8; ++j) a1[j] *= rq * qag[128 + sub * 8 + j];
            *(u32x4*)(Aq + t * 200 + 128 + sub * 8) = pk8(a1); }
#pragma unroll
        for (int j = 0; j < 8; ++j) k0[j] *= rk * kvag[sub * 8 + j];
        *(u32x4*)(Akv + t * 136 + sub * 8) = pk8(k0);
        if (sub < 4) { float kr[8]; un8(rkr, kr);
#pragma unroll
            for (int j = 0; j < 8; ++j) Lkr[t * 32 + sub * 8 + j] = kr[j]; }
#pragma unroll
        for (int i = 0; i < 3; ++i) { const int ch = c.tid + 512 * i, row = ch >> 5, c8 = ch & 31; if (ch < 47 * 32) { float v[8]; un8(rp[i], v);
            *(f32x4*)(Lu + row * 256 + c8 * 8) = (f32x4){v[0], v[1], v[2], v[3]}; *(f32x4*)(Lu + row * 256 + c8 * 8 + 4) = (f32x4){v[4], v[5], v[6], v[7]}; } }
#pragma unroll
        for (int i = 0; i < 4; ++i) { const int ch = c.tid + 512 * i, row = ch >> 5, c8 = ch & 31; if (ch < 62 * 32) { float a[8], g[8]; un8(rca[i], a); un8(rcg[i], g);
#pragma unroll
            for (int j = 0; j < 8; ++j) a[j] *= fsigmoid(g[j]);
            *(f32x4*)(Lcu + row * 256 + c8 * 8) = (f32x4){a[0], a[1], a[2], a[3]}; *(f32x4*)(Lcu + row * 256 + c8 * 8 + 4) = (f32x4){a[4], a[5], a[6], a[7]}; } }
    }
    __syncthreads();
    const float* rcos = c.w<float>(WS_ROPE); const float* rsin = rcos + (size_t)NTOK * 16;
    if (c.wid < 4) {
        const int h = c.wid; const bf16_t* W = c.w<bf16_t>(WS_WUQ + (size_t)(l & 1) * WSET) + (size_t)(96 * h) * 192; const float* qg = c.inf(I_QG) + l * 96;
        f32x4 acc[6][2];
#pragma unroll
        for (int nf = 0; nf < 6; ++nf) { acc[nf][0] = (f32x4){0.f, 0.f, 0.f, 0.f}; acc[nf][1] = acc[nf][0]; }
#pragma unroll 3
        for (int ks = 0; ks < 6; ++ks) { bf16x8 af[2];
#pragma unroll
            for (int mf = 0; mf < 2; ++mf) af[mf] = *(const bf16x8*)(Aq + (mf * 16 + fr) * 200 + ks * 32 + fq * 8);
#pragma unroll
            for (int nf = 0; nf < 6; ++nf) { const bf16x8 bfr = *(const bf16x8*)(W + (size_t)(16 * nf + fr) * 192 + ks * 32 + fq * 8);
                acc[nf][0] = MFMA16(bfr, af[0], acc[nf][0]); acc[nf][1] = MFMA16(bfr, af[1], acc[nf][1]); } }
#pragma unroll
        for (int mf = 0; mf < 2; ++mf) { float ss = 0.f;
#pragma unroll
            for (int nf = 0; nf < 6; ++nf)
#pragma unroll
                for (int j = 0; j < 4; ++j) ss += acc[nf][mf][j] * acc[nf][mf][j];
            ss += __shfl_xor(ss, 16); ss += __shfl_xor(ss, 32);
            const float rinv = frsqrt(ss * (1.0f / 96.0f) + EPS) * (0.10206207261596575f * 1.44269504089f);
            const int tok = r0 + mf * 16 + fr; bf16_t* qo = c.w<bf16_t>(WS_Q) + ((size_t)(b * 4 + h) * SEQ + s0 + mf * 16 + fr) * 96;
            float v[6][4];
#pragma unroll
            for (int nf = 0; nf < 6; ++nf)
#pragma unroll
                for (int j = 0; j < 4; ++j) v[nf][j] = acc[nf][mf][j] * rinv * qg[16 * nf + 4 * fq + j];
            const f32x4 cs4 = *(const f32x4*)(rcos + (size_t)tok * 16 + 4 * fq), sn4 = *(const f32x4*)(rsin + (size_t)tok * 16 + 4 * fq);
#pragma unroll
            for (int j = 0; j < 4; ++j) { const float x1 = v[4][j], x2 = v[5][j]; v[4][j] = x1 * cs4[j] - x2 * sn4[j]; v[5][j] = x1 * sn4[j] + x2 * cs4[j]; }
#pragma unroll
            for (int nf = 0; nf < 6; ++nf) { u32x2 o; o.x = cvt_pk_bf16(v[nf][0], v[nf][1]); o.y = cvt_pk_bf16(v[nf][2], v[nf][3]); *(u32x2*)(qo + 16 * nf + 4 * fq) = o; } }
    } else {
        const int h = c.wid - 4; const bf16_t* W = c.w<bf16_t>(WS_WUKV + (size_t)(l & 1) * WSET) + (size_t)(128 * h) * 128; const float* kg = c.inf(I_KG) + l * 96;
        f32x4 ak[4][2], av[4][2];
#pragma unroll
        for (int nf = 0; nf < 4; ++nf) { ak[nf][0] = (f32x4){0.f, 0.f, 0.f, 0.f}; ak[nf][1] = ak[nf][0]; av[nf][0] = ak[nf][0]; av[nf][1] = ak[nf][0]; }
#pragma unroll 2
        for (int ks = 0; ks < 4; ++ks) { bf16x8 af[2];
#pragma unroll
            for (int mf = 0; mf < 2; ++mf) af[mf] = *(const bf16x8*)(Akv + (mf * 16 + fr) * 136 + ks * 32 + fq * 8);
#pragma unroll
            for (int nf = 0; nf < 4; ++nf) { const bf16x8 bk = *(const bf16x8*)(W + (size_t)(16 * nf + fr) * 128 + ks * 32 + fq * 8), bv = *(const bf16x8*)(W + (size_t)(64 + 16 * nf + fr) * 128 + ks * 32 + fq * 8);
                ak[nf][0] = MFMA16(bk, af[0], ak[nf][0]); ak[nf][1] = MFMA16(bk, af[1], ak[nf][1]);
                av[nf][0] = MFMA16(af[0], bv, av[nf][0]); av[nf][1] = MFMA16(af[1], bv, av[nf][1]); } }
#pragma unroll
        for (int mf = 0; mf < 2; ++mf) { const int tl = mf * 16 + fr; float ss = 0.f;
#pragma unroll
            for (int nf = 0; nf < 4; ++nf)
#pragma unroll
                for (int j = 0; j < 4; ++j) ss += ak[nf][mf][j] * ak[nf][mf][j];
#pragma unroll
            for (int j = 0; j < 8; ++j) { const float kr = Lkr[tl * 32 + fq * 8 + j]; ss += kr * kr; }
            ss += __shfl_xor(ss, 16); ss += __shfl_xor(ss, 32);
            const float rinv = frsqrt(ss * (1.0f / 96.0f) + EPS);
            const int tok = r0 + tl; bf16_t* ko = c.w<bf16_t>(WS_K) + ((size_t)(b * 4 + h) * SEQ + s0 + tl) * 96;
#pragma unroll
            for (int nf = 0; nf < 4; ++nf) { u32x2 o; o.x = cvt_pk_bf16(ak[nf][mf][0] * rinv * kg[16 * nf + 4 * fq], ak[nf][mf][1] * rinv * kg[16 * nf + 4 * fq + 1]);
                o.y = cvt_pk_bf16(ak[nf][mf][2] * rinv * kg[16 * nf + 4 * fq + 2], ak[nf][mf][3] * rinv * kg[16 * nf + 4 * fq + 3]); *(u32x2*)(ko + 16 * nf + 4 * fq) = o; }
            const f32x4 cs4 = *(const f32x4*)(rcos + (size_t)tok * 16 + 4 * fq), sn4 = *(const f32x4*)(rsin + (size_t)tok * 16 + 4 * fq);
            float o1[4], o2[4];
#pragma unroll
            for (int j = 0; j < 4; ++j) { const int i = 4 * fq + j; const float x1 = Lkr[tl * 32 + i] * rinv * kg[64 + i], x2 = Lkr[tl * 32 + 16 + i] * rinv * kg[80 + i];
                o1[j] = x1 * cs4[j] - x2 * sn4[j]; o2[j] = x1 * sn4[j] + x2 * cs4[j]; }
            { u32x2 o; o.x = cvt_pk_bf16(o1[0], o1[1]); o.y = cvt_pk_bf16(o1[2], o1[3]); *(u32x2*)(ko + 64 + 4 * fq) = o; o.x = cvt_pk_bf16(o2[0], o2[1]); o.y = cvt_pk_bf16(o2[2], o2[3]); *(u32x2*)(ko + 80 + 4 * fq) = o; }
            bf16_t* vo = c.w<bf16_t>(WS_VT) + (size_t)(b * 4 + h) * 64 * SEQ + s0 + mf * 16 + 4 * fq;
#pragma unroll
            for (int nf = 0; nf < 4; ++nf) { u32x2 o; o.x = cvt_pk_bf16(av[nf][mf][0], av[nf][mf][1]); o.y = cvt_pk_bf16(av[nf][mf][2], av[nf][mf][3]); *(u32x2*)(vo + (size_t)(16 * nf + fr) * SEQ) = o; } }
    }
    { const int t = c.tid >> 4, sub = c.tid & 15, g = sub >> 2, w = 2 << g, s = s0 + t; const float inv = 1.0f / (float)((s + 1 < w) ? (s + 1) : w);
#pragma unroll
        for (int k = 0; k < 2; ++k) { const int col = sub * 16 + k * 8; float sum[8];
#pragma unroll
            for (int j = 0; j < 8; ++j) sum[j] = 0.f;
            for (int d = 0; d < w; ++d) { const float* p = Lu + (t + 15 - d) * 256 + col;
#pragma unroll
                for (int j = 0; j < 8; ++j) sum[j] += p[j]; }
            const float* p0 = Lu + (t + 15) * 256 + col;
#pragma unroll
            for (int j = 0; j < 8; ++j) sum[j] = sum[j] * inv - p0[j];
            *(u32x4*)(Lp + t * 264 + col) = pk8(sum); } }
    float cres[16];
    { const int chn = c.tid & 255, half = c.tid >> 8; const float* dw = c.inf(I_DWW) + (size_t)l * 31 * 256 + chn; const float bias = c.inf(I_DWB)[l * 256 + chn];
        float wv[31];
#pragma unroll
        for (int j = 0; j < 31; ++j) wv[j] = dw[j * 256];
#pragma unroll
        for (int tt = 0; tt < 16; ++tt) cres[tt] = bias;
#pragma unroll
        for (int r = 0; r < 46; ++r) { const float u = Lcu[(half * 16 + r) * 256 + chn];
#pragma unroll
            for (int tt = 0; tt < 16; ++tt) { const int j = r - tt; if (j >= 0 && j < 31) cres[tt] += wv[j] * u; } } }
    __syncthreads();
    { const int g = c.wid >> 1, mf = c.wid & 1; const bf16_t* W = c.w<bf16_t>(WS_WPOOL + (size_t)(l & 1) * WSET) + g * 4096; const float* ps = c.inf(I_PSCALE) + l * 256 + g * 64;
        f32x4 acc[4];
#pragma unroll
        for (int nf = 0; nf < 4; ++nf) acc[nf] = (f32x4){0.f, 0.f, 0.f, 0.f};
#pragma unroll
        for (int ks = 0; ks < 2; ++ks) { const bf16x8 af = *(const bf16x8*)(Lp + (mf * 16 + fr) * 264 + g * 64 + ks * 32 + fq * 8);
#pragma unroll
            for (int nf = 0; nf < 4; ++nf) { const bf16x8 bfr = *(const bf16x8*)(W + (16 * nf + fr) * 64 + ks * 32 + fq * 8); acc[nf] = MFMA16(bfr, af, acc[nf]); } }
        bf16_t* yo = c.w<bf16_t>(WS_YB) + (size_t)(r0 + mf * 16 + fr) * 1024 + 256 + g * 64;
#pragma unroll
        for (int nf = 0; nf < 4; ++nf) { const int d = 16 * nf + 4 * fq; u32x2 o; o.x = cvt_pk_bf16(acc[nf][0] * ps[d], acc[nf][1] * ps[d + 1]); o.y = cvt_pk_bf16(acc[nf][2] * ps[d + 2], acc[nf][3] * ps[d + 3]); *(u32x2*)(yo + d) = o; } }
    { const int chn = c.tid & 255, half = c.tid >> 8;
#pragma unroll
        for (int tt = 0; tt < 16; ++tt) Lco[(half * 16 + tt) * 256 + chn] = cres[tt]; }
    __syncthreads();
    { const float* lg = c.inf(I_LNG) + l * 256 + c.lane * 4; const float* lb = c.inf(I_LNB) + l * 256 + c.lane * 4;
#pragma unroll
        for (int k = 0; k < 4; ++k) { const int t = c.wid * 4 + k; const f32x4 v = *(const f32x4*)(Lco + t * 256 + c.lane * 4);
            const float mean = wave_sum(v[0] + v[1] + v[2] + v[3]) * (1.0f / 256.0f); const f32x4 d = v - mean;
            const float var = wave_sum(d[0] * d[0] + d[1] * d[1] + d[2] * d[2] + d[3] * d[3]) * (1.0f / 256.0f); const float rs = frsqrt(var + EPS);
            float y[4];
#pragma unroll
            for (int j = 0; j < 4; ++j) y[j] = fsilu(d[j] * rs * lg[j] + lb[j]);
            u32x2 o; o.x = cvt_pk_bf16(y[0], y[1]); o.y = cvt_pk_bf16(y[2], y[3]); *(u32x2*)(c.w<bf16_t>(WS_YB) + (size_t)(r0 + t) * 1024 + 768 + c.lane * 4) = o; } }
    __syncthreads();
}

constexpr int CW_W13 = 32 * 16 * 16, CW_W2 = 32 * 8 * 32, CW_IN = 16 * 72, CW_OUT = 16 * 32, CW_UQ = 3 * 12, CW_UKV = 2 * 16, CW_POOL = 4 * 2;
constexpr int CW_TOTAL = 2 * CW_W13 + CW_W2 + CW_IN + CW_OUT + CW_UQ + CW_UKV + CW_POOL;
struct CvtTile { const float* src; bf16_t* dst; int ldn, ldk; };
__device__ __forceinline__ void cvt_decode(const Ctx& c, int l, int t, CvtTile& d) {
    const size_t wso = (size_t)(l & 1) * WSET; int r = t;
    if (r < 2 * CW_W13) { const int which = r / CW_W13; r %= CW_W13; const int e = r >> 8, kt = (r >> 4) & 15, nt = r & 15, n0 = nt * 32;
        d.src = c.inf(which ? I_W3 : I_W1) + ((size_t)l * 32 + e) * 1024 * 512 + (size_t)kt * 64 * 512 + n0; d.ldn = 512; d.ldk = 1024;
        d.dst = c.w<bf16_t>(WS_WUP + wso) + (size_t)e * 1024 * 1024 + (size_t)((n0 >> 7) * 256 + which * 128 + (n0 & 127)) * 1024 + kt * 64; return; } r -= 2 * CW_W13;
    if (r < CW_W2) { const int e = r >> 8, kt = (r >> 5) & 7, nt = r & 31;
        d.src = c.inf(I_W2) + ((size_t)l * 32 + e) * 512 * 1024 + (size_t)kt * 64 * 1024 + nt * 32; d.ldn = 1024; d.ldk = 512;
        d.dst = c.w<bf16_t>(WS_WDN + wso) + (size_t)e * 1024 * 512 + (size_t)(nt * 32) * 512 + kt * 64; return; } r -= CW_W2;
    if (r < CW_IN) { const int kt = r / 72, nt = r % 72; d.src = (nt < 67) ? c.inf(I_WIN) + (size_t)l * 1024 * 2144 + (size_t)kt * 64 * 2144 + nt * 32 : nullptr; d.ldn = 2144; d.ldk = 1024;
        d.dst = c.w<bf16_t>(WS_WIN + wso) + (size_t)(nt * 32) * 1024 + kt * 64; return; } r -= CW_IN;
    if (r < CW_OUT) { const int kt = r >> 5, nt = r & 31; d.src = c.inf(I_WOUT) + (size_t)l * 1024 * 1024 + (size_t)kt * 64 * 1024 + nt * 32; d.ldn = 1024; d.ldk = 1024;
        d.dst = c.w<bf16_t>(WS_WOUT + wso) + (size_t)(nt * 32) * 1024 + kt * 64; return; } r -= CW_OUT;
    if (r < CW_UQ) { const int kt = r / 12, nt = r % 12; d.src = c.inf(I_WUQ) + (size_t)l * 192 * 384 + (size_t)kt * 64 * 384 + nt * 32; d.ldn = 384; d.ldk = 192;
        d.dst = c.w<bf16_t>(WS_WUQ + wso) + (size_t)(nt * 32) * 192 + kt * 64; return; } r -= CW_UQ;
    if (r < CW_UKV) { const int kt = r >> 4, nt = r & 15; d.src = c.inf(I_WUKV) + (size_t)l * 128 * 512 + (size_t)kt * 64 * 512 + nt * 32; d.ldn = 512; d.ldk = 128;
        d.dst = c.w<bf16_t>(WS_WUKV + wso) + (size_t)(nt * 32) * 128 + kt * 64; return; } r -= CW_UKV;
    { const int g = r >> 1, nt = r & 1; d.src = c.inf(I_WPOOL) + ((size_t)l * 4 + g) * 4096 + nt * 32; d.ldn = 64; d.ldk = 64; d.dst = c.w<bf16_t>(WS_WPOOL + wso) + g * 4096 + (size_t)(nt * 32) * 64; }
}
__device__ __forceinline__ void cvt_wave(const Ctx& c, int l, int wrank, int nwaves, float* T) {
    { const float* rgw = c.inf(I_RGW) + (size_t)l * 1024 * 4; const float* rew = c.inf(I_REW) + (size_t)l * 1024 * 32; float* rwt = c.w<float>(WS_RWT + (size_t)(l & 1) * WSET);
        for (int e = wrank * 64 + c.lane; e < 36 * 1024; e += nwaves * 64) { const int g = e >> 10, k = e & 1023; rwt[e] = (g < 4) ? rgw[k * 4 + g] : rew[k * 32 + g - 4]; } }
    f32x4 v[8]; CvtTile cur; cur.src = nullptr; cur.dst = nullptr; cur.ldn = 0; cur.ldk = 0;
    auto issue = [&](const CvtTile& d) {
#pragma unroll
        for (int i = 0; i < 8; ++i) { const int e4 = c.lane + 64 * i, kk = e4 >> 3, n4 = e4 & 7; v[i] = d.src ? *(const f32x4*)(d.src + (size_t)kk * d.ldn + n4 * 4) : (f32x4){0.f, 0.f, 0.f, 0.f}; } };
    int t = wrank;
    if (t < CW_TOTAL) { cvt_decode(c, l, t, cur); issue(cur); }
    while (t < CW_TOTAL) {
#pragma unroll
        for (int i = 0; i < 8; ++i) { const int e4 = c.lane + 64 * i, kk = e4 >> 3, n4 = e4 & 7; float* p = T + kk * 33 + n4 * 4; p[0] = v[i][0]; p[1] = v[i][1]; p[2] = v[i][2]; p[3] = v[i][3]; }
        const int tn = t + nwaves; CvtTile nxt = cur; if (tn < CW_TOTAL) { cvt_decode(c, l, tn, nxt); issue(nxt); }
        __builtin_amdgcn_wave_barrier();
        { const int n = c.lane & 31, kh = c.lane >> 5; bf16_t* drow = cur.dst + (size_t)n * cur.ldk + kh * 32;
#pragma unroll
            for (int q = 0; q < 4; ++q) { float o[8];
#pragma unroll
                for (int j = 0; j < 8; ++j) o[j] = T[(kh * 32 + q * 8 + j) * 33 + n];
                *(u32x4*)(drow + q * 8) = pk8(o); } }
        __builtin_amdgcn_wave_barrier();
        t = tn; cur = nxt;
    }
}

#ifdef EMU
static inline float __builtin_amdgcn_logf(float x) { return log2f(x); }
#endif
constexpr int HGP = 68, HGV = 40;
constexpr int HG_LG = 0, HG_LK = 8704, HG_LQ = 17408, HG_LVT = 26112, HG_LEG = 31232, HG_LGG = 31488, HG_BYTES = 31744;
template <bool OUT> __device__ __forceinline__ void hgrn_mfma(const Ctx& c_, int l, int bu, int cvt_layer = NL) { const Ctx c = fresh(c_);
    if (c.wid < 4) {
        const int cu = bu * 4 + c.wid, bh = cu / NCH, chunk = cu % NCH, b = bh >> 2, h = bh & 3, tok0 = b * SEQ + chunk * 128;
        const bf16_t* Z = c.w<bf16_t>(WS_Z); const float lbd = c.w<float>(WS_LB)[l * 256 + h * 64 + c.lane];
        unsigned char* L = c.lds + c.wid * HG_BYTES; float* Lg = (float*)(L + HG_LG); float* Lk = (float*)(L + HG_LK); float* Lq = (float*)(L + HG_LQ); bf16_t* Lvt = (bf16_t*)(L + HG_LVT); float* LeG = (float*)(L + HG_LEG); float* LG = (float*)(L + HG_LGG);
        const int l31 = c.lane & 31, hi = c.lane >> 5;
        f32x16 S[2][2];
        if (OUT) { const float* s0 = c.w<float>(WS_S0) + (size_t)(bh * NCH + chunk) * 4096;
#pragma unroll
            for (int mf = 0; mf < 2; ++mf)
#pragma unroll
                for (int nf = 0; nf < 2; ++nf)
#pragma unroll
                    for (int r = 0; r < 16; ++r) S[mf][nf][r] = s0[(32 * mf + (r & 3) + 8 * (r >> 2) + 4 * hi) * 64 + 32 * nf + l31]; }
        else {
#pragma unroll
            for (int mf = 0; mf < 2; ++mf)
#pragma unroll
                for (int nf = 0; nf < 2; ++nf)
#pragma unroll
                    for (int r = 0; r < 16; ++r) S[mf][nf][r] = 0.f; }
        float gtot = 0.f; const float og0 = OUT ? c.inf(I_HOG)[l * 64 + l31] : 0.f, og1 = OUT ? c.inf(I_HOG)[l * 64 + 32 + l31] : 0.f;
        u32x4 rf[4], rq[4], rv[4];
        { const bf16_t* zn = Z + (size_t)(tok0 + (c.lane >> 3)) * ZP + h * 64 + (c.lane & 7) * 8;
#pragma unroll
            for (int i = 0; i < 4; ++i) { rf[i] = *(const u32x4*)(zn + (size_t)i * 8 * ZP + Z_HF); rv[i] = *(const u32x4*)(zn + (size_t)i * 8 * ZP + Z_HI); if (OUT) rq[i] = *(const u32x4*)(zn + (size_t)i * 8 * ZP + Z_HQ); else rq[i] = (u32x4){0u, 0u, 0u, 0u}; } }
#pragma unroll 1
        for (int sc = 0; sc < 4; ++sc) { const int tokb = tok0 + sc * 32;
            {
                const int rr = c.lane >> 3, c8 = (c.lane & 7) * 8;
#pragma unroll
                for (int i = 0; i < 4; ++i) { const int tr = i * 8 + rr; float x[8];
                    { const u32x4 v = rf[i]; x[0] = bflo(v.x); x[1] = bfhi(v.x); x[2] = bflo(v.y); x[3] = bfhi(v.y); x[4] = bflo(v.z); x[5] = bfhi(v.z); x[6] = bflo(v.w); x[7] = bfhi(v.w); }
                    *(f32x4*)(Lg + tr * HGP + c8) = (f32x4){x[0], x[1], x[2], x[3]}; *(f32x4*)(Lg + tr * HGP + c8 + 4) = (f32x4){x[4], x[5], x[6], x[7]};
                    if (OUT) { const u32x4 v = rq[i]; x[0] = fsilu(bflo(v.x)); x[1] = fsilu(bfhi(v.x)); x[2] = fsilu(bflo(v.y)); x[3] = fsilu(bfhi(v.y)); x[4] = fsilu(bflo(v.z)); x[5] = fsilu(bfhi(v.z)); x[6] = fsilu(bflo(v.w)); x[7] = fsilu(bfhi(v.w));
                        *(f32x4*)(Lq + tr * HGP + c8) = (f32x4){x[0], x[1], x[2], x[3]}; *(f32x4*)(Lq + tr * HGP + c8 + 4) = (f32x4){x[4], x[5], x[6], x[7]}; }
                    { const u32x4 v = rv[i]; const unsigned w4[4] = {v.x, v.y, v.z, v.w};
#pragma unroll
                        for (int k = 0; k < 4; ++k) { Lvt[(c8 + 2 * k) * HGV + tr] = (bf16_t)(w4[k] & 0xffffu); Lvt[(c8 + 2 * k + 1) * HGV + tr] = (bf16_t)(w4[k] >> 16); } } }
                if (sc < 3) { const bf16_t* zn = Z + (size_t)(tokb + 32 + rr) * ZP + h * 64 + c8;
#pragma unroll
                    for (int i = 0; i < 4; ++i) { rf[i] = *(const u32x4*)(zn + (size_t)i * 8 * ZP + Z_HF); rv[i] = *(const u32x4*)(zn + (size_t)i * 8 * ZP + Z_HI); if (OUT) rq[i] = *(const u32x4*)(zn + (size_t)i * 8 * ZP + Z_HQ); } }
                __builtin_amdgcn_wave_barrier();
                float run = 0.f;
#pragma unroll
                for (int t = 0; t < 32; ++t) { const float f = lbd + (1.0f - lbd) * fsigmoid(Lg[t * HGP + c.lane]); run += __builtin_amdgcn_logf(f); Lg[t * HGP + c.lane] = run; Lk[t * HGP + c.lane] = 1.0f - f; }
                LG[c.lane] = run; LeG[c.lane] = __builtin_amdgcn_exp2f(run); gtot += run;
            }
            __builtin_amdgcn_wave_barrier();
            bf16x8 vt[2][2];
#pragma unroll
            for (int nf = 0; nf < 2; ++nf)
#pragma unroll
                for (int ks = 0; ks < 2; ++ks) vt[nf][ks] = *(const bf16x8*)(Lvt + (32 * nf + l31) * HGV + 16 * ks + 8 * hi);
            f32x16 O[2];
            if (OUT) {
#pragma unroll
                for (int r = 0; r < 16; ++r) { O[0][r] = 0.f; O[1][r] = 0.f; }
                float acc[8];
#pragma unroll
                for (int m = 0; m < 8; ++m) acc[m] = 0.f;
                const int sb = (l31 & 16) + 8 * hi;
#pragma unroll 1
                for (int d4 = 0; d4 < 16; ++d4) { const f32x4 qt = *(const f32x4*)(Lq + l31 * HGP + 4 * d4), gt = *(const f32x4*)(Lg + l31 * HGP + 4 * d4);
#pragma unroll
                    for (int mg = 0; mg < 4; ++mg) {
                        f32x4 k4[2], g4[2];
#pragma unroll
                        for (int j = 0; j < 2; ++j) { const int s = sb + 2 * mg + j; k4[j] = *(const f32x4*)(Lk + s * HGP + 4 * d4); g4[j] = *(const f32x4*)(Lg + s * HGP + 4 * d4); }
                        __builtin_amdgcn_sched_barrier(0);
#pragma unroll
                        for (int j = 0; j < 2; ++j)
#pragma unroll
                            for (int e = 0; e < 4; ++e) acc[mg * 2 + j] += qt[e] * k4[j][e] * __builtin_amdgcn_exp2f(gt[e] - g4[j][e]);
                        __builtin_amdgcn_sched_barrier(0); } }
                bf16x8 af[2], afx;
                { float a8[8];
#pragma unroll
                    for (int j = 0; j < 8; ++j) a8[j] = (sb + j <= l31) ? acc[j] : 0.f;
                    const bf16x8 ad = __builtin_bit_cast(bf16x8, pk8p(a8)), az = (bf16x8){0, 0, 0, 0, 0, 0, 0, 0};
                    af[0] = (l31 < 16) ? ad : az; af[1] = (l31 < 16) ? az : ad; }
                {
                    f32x16 dx;
#pragma unroll
                    for (int r = 0; r < 16; ++r) dx[r] = 0.f;
                    const bool lowr = l31 < 16; const float* Lx = lowr ? Lk : Lq;
#pragma unroll
                    for (int kk = 0; kk < 4; ++kk) { const int d0 = 16 * kk + 8 * hi;
                        const f32x4 xa = *(const f32x4*)(Lx + l31 * HGP + d0), xb = *(const f32x4*)(Lx + l31 * HGP + d0 + 4), ga = *(const f32x4*)(Lg + l31 * HGP + d0), gb = *(const f32x4*)(Lg + l31 * HGP + d0 + 4),
                                    ma = *(const f32x4*)(Lg + 15 * HGP + d0), mb = *(const f32x4*)(Lg + 15 * HGP + d0 + 4);
                        float v8[8];
#pragma unroll
                        for (int j = 0; j < 4; ++j) { const float da = ga[j] - ma[j], db = gb[j] - mb[j];
                            v8[j] = xa[j] * __builtin_amdgcn_exp2f(lowr ? -da : da); v8[4 + j] = xb[j] * __builtin_amdgcn_exp2f(lowr ? -db : db); }
                        const bf16x8 vv = __builtin_bit_cast(bf16x8, pk8p(v8)), zz = (bf16x8){0, 0, 0, 0, 0, 0, 0, 0};
                        dx = MFMA32(lowr ? vv : zz, lowr ? zz : vv, dx); }
                    float x8[8];
#pragma unroll
                    for (int j = 0; j < 8; ++j) x8[j] = dx[j];
                    afx = __builtin_bit_cast(bf16x8, pk8(x8)); }
#pragma unroll
                for (int mf = 0; mf < 2; ++mf)
#pragma unroll
                    for (int s = 0; s < 2; ++s) { const int d0 = 32 * mf + 16 * s + 4 * hi;
                        const f32x4 qa = *(const f32x4*)(Lq + l31 * HGP + d0), qb = *(const f32x4*)(Lq + l31 * HGP + d0 + 8), ga = *(const f32x4*)(Lg + l31 * HGP + d0), gb = *(const f32x4*)(Lg + l31 * HGP + d0 + 8);
                        float q8[8];
#pragma unroll
                        for (int j = 0; j < 4; ++j) { q8[j] = qa[j] * __builtin_amdgcn_exp2f(ga[j]); q8[4 + j] = qb[j] * __builtin_amdgcn_exp2f(gb[j]); }
                        const bf16x8 qf = __builtin_bit_cast(bf16x8, pk8p(q8));
#pragma unroll
                        for (int nf = 0; nf < 2; ++nf) { float s8[8];
#pragma unroll
                            for (int j = 0; j < 8; ++j) s8[j] = S[mf][nf][8 * s + j];
                            O[nf] = MFMA32(qf, __builtin_bit_cast(bf16x8, pk8p(s8)), O[nf]); } }
#pragma unroll
                for (int nf = 0; nf < 2; ++nf) {
#pragma unroll
                    for (int ks = 0; ks < 2; ++ks) O[nf] = MFMA32(af[ks], vt[nf][ks], O[nf]);
                    const s16x4 p0 = *(const s16x4*)(Lvt + (32 * nf + l31) * HGV + 4 * hi), p1 = *(const s16x4*)(Lvt + (32 * nf + l31) * HGV + 8 + 4 * hi);
                    O[nf] = MFMA32(afx, ((bf16x8){p0[0], p0[1], p0[2], p0[3], p1[0], p1[1], p1[2], p1[3]}), O[nf]); }
            }
#pragma unroll
            for (int mf = 0; mf < 2; ++mf) {
#pragma unroll
                for (int q = 0; q < 4; ++q) { const f32x4 e4 = *(const f32x4*)(LeG + 32 * mf + 8 * q + 4 * hi);
#pragma unroll
                    for (int e = 0; e < 4; ++e) { S[mf][0][4 * q + e] *= e4[e]; S[mf][1][4 * q + e] *= e4[e]; } }
                const int d = 32 * mf + l31; const float Gd = LG[d];
#pragma unroll
                for (int ks = 0; ks < 2; ++ks) { float k8[8];
#pragma unroll
                    for (int j = 0; j < 8; ++j) { const int s = 16 * ks + 8 * hi + j; k8[j] = Lk[s * HGP + d] * __builtin_amdgcn_exp2f(Gd - Lg[s * HGP + d]); }
                    const bf16x8 kf = __builtin_bit_cast(bf16x8, pk8p(k8));
                    S[mf][0] = MFMA32(kf, vt[0][ks], S[mf][0]); S[mf][1] = MFMA32(kf, vt[1][ks], S[mf][1]); } }
            if (OUT) {
                {
                    const int rr = c.lane >> 3, c8 = (c.lane & 7) * 8; const bf16_t* zg = Z + (size_t)(tokb + rr) * ZP + Z_HG + h * 64 + c8; u32x2 gv[4];
#pragma unroll
                    for (int hf = 0; hf < 2; ++hf) {
#pragma unroll
                    for (int i = 0; i < 4; ++i) gv[i] = *(const u32x2*)(zg + (size_t)i * 8 * ZP + 4 * hf);
#pragma unroll
                    for (int i = 0; i < 4; ++i) { const u32x2 v = gv[i]; *(f32x4*)(Lq + (i * 8 + rr) * HGP + c8 + 4 * hf) = (f32x4){fsilu(bflo(v.x)), fsilu(bfhi(v.x)), fsilu(bflo(v.y)), fsilu(bfhi(v.y))}; } }
                }
                __builtin_amdgcn_wave_barrier();
#pragma unroll
                for (int r = 0; r < 16; ++r) { const int tl = (r & 3) + 8 * (r >> 2) + 4 * hi; float ss = O[0][r] * O[0][r] + O[1][r] * O[1][r];
                    ss = half_sum(ss, hi);
                    const float rinv = frsqrt(ss * (1.0f / 64.0f) + EPS); const size_t tok = (size_t)(tokb + tl);
                    const float g0 = Lq[tl * HGP + l31], g1 = Lq[tl * HGP + 32 + l31];
                    bf16_t* yo = c.w<bf16_t>(WS_YB) + tok * 1024 + 512 + h * 64;
                    yo[l31] = (bf16_t)f2bf_bits(O[0][r] * rinv * og0 * g0); yo[32 + l31] = (bf16_t)f2bf_bits(O[1][r] * rinv * og1 * g1); } }
            __builtin_amdgcn_wave_barrier();
        }
        if (!OUT) { float* sc = c.w<float>(WS_SC) + (size_t)(bh * NCH + chunk) * 4096;
#pragma unroll
            for (int mf = 0; mf < 2; ++mf)
#pragma unroll
                for (int nf = 0; nf < 2; ++nf)
#pragma unroll
                    for (int r = 0; r < 16; ++r) sc[(32 * mf + (r & 3) + 8 * (r >> 2) + 4 * hi) * 64 + 32 * nf + l31] = S[mf][nf][r];
            c.w<float>(WS_PC)[(size_t)(bh * NCH + chunk) * 64 + c.lane] = __builtin_amdgcn_exp2f(gtot); }
    } else if (OUT && cvt_layer < NL) {
        cvt_wave(c, cvt_layer, bu * 4 + (c.wid - 4), NBH * NCH, (float*)(c.lds + 4 * HG_BYTES + (c.wid - 4) * 8448));
    }
    __syncthreads();
}
__device__ __forceinline__ void hgrn_carry(const Ctx& c_, int l) { const Ctx c = fresh(c_);
    const float* SC = c.w<float>(WS_SC); const float* PC = c.w<float>(WS_PC); float* S0 = c.w<float>(WS_S0);
    for (int e = c.blk * 512 + c.tid; e < NBH * 4096; e += c.G * 512) { const int bh = e >> 12, dv = e & 4095, d = dv >> 6; float s = 0.f;
#pragma unroll 8
        for (int ch = 0; ch < NCH; ++ch) { const size_t o = (size_t)(bh * NCH + ch) * 4096 + dv; S0[o] = s; s = PC[(size_t)(bh * NCH + ch) * 64 + d] * s + SC[o]; } }
    ASMV("s_waitcnt vmcnt(0)" ::: "memory");
    __syncthreads();
    if (c.tid == 0) { __builtin_amdgcn_fence(__ATOMIC_RELEASE, "agent"); ASMV("s_waitcnt vmcnt(0)" ::: "memory");
        (void)__hip_atomic_fetch_add((unsigned*)(c.ws + WS_CTL + CTL_HG) + l * 64, 1u, __ATOMIC_RELAXED, __HIP_MEMORY_SCOPE_AGENT); }
}
__device__ __forceinline__ void hgrn_wait_carry(const Ctx& c, int l) {
    if (c.tid == 0) { unsigned* p = (unsigned*)(c.ws + WS_CTL + CTL_HG) + l * 64; unsigned sp = 0;
        while (__hip_atomic_load(p, __ATOMIC_RELAXED, __HIP_MEMORY_SCOPE_AGENT) < (unsigned)c.G) { __builtin_amdgcn_s_sleep(1); if (++sp > (1u << 22)) break; }
        __builtin_amdgcn_fence(__ATOMIC_ACQUIRE, "agent"); ASMV("s_waitcnt vmcnt(0)" ::: "memory"); }
    __syncthreads();
}
__device__ __forceinline__ void ph_mixers(const Ctx& c, int l) {
    if (c.blk & 1) for (int bu = c.blk; bu < NBH * NCH / 4; bu += c.G) hgrn_mfma<false>(c, l, bu);
    for (int u = c.blk; u < NTOK / 32; u += c.G) mix_unit(c, l, u * 32);
    if (!(c.blk & 1)) for (int bu = c.blk; bu < NBH * NCH / 4; bu += c.G) hgrn_mfma<false>(c, l, bu);
}

__device__ __forceinline__ void attn_unit(const Ctx& c_, int bh, int qt) { const Ctx c = fresh(c_);
    const bf16_t* Qg = c.w<bf16_t>(WS_Q) + (size_t)bh * SEQ * 96; const bf16_t* Kg = c.w<bf16_t>(WS_K) + (size_t)bh * SEQ * 96; const bf16_t* Vg = c.w<bf16_t>(WS_VT) + (size_t)bh * 64 * SEQ;
    constexpr int KROW = 104, VROW = 72, KB = 64 * KROW * 2, VB = 64 * VROW * 2;
    const int l31 = c.lane & 31, hi = c.lane >> 5, qrow = qt * 256 + c.wid * 32 + l31;
    bf16x8 qf[6];
#pragma unroll
    for (int ks = 0; ks < 6; ++ks) qf[ks] = *(const bf16x8*)(Qg + (size_t)qrow * 96 + ks * 16 + hi * 8);
    f32x16 o0, o1;
#pragma unroll
    for (int r = 0; r < 16; ++r) { o0[r] = 0.f; o1[r] = 0.f; }
    float mrun = -INFINITY, lsum = 0.f;
    const int nkt = 4 * (qt + 1), mylast = 4 * qt + (c.wid >> 1);
    const int kr0 = c.tid / 12, kc0 = c.tid % 12, kr1 = (c.tid + 512) / 12, kc1 = (c.tid + 512) % 12, vr = c.tid >> 3, vc = c.tid & 7;
    u32x4 sk0, sk1, sv;
    auto gload = [&](int kt) { sk0 = *(const u32x4*)(Kg + (size_t)(kt * 64 + kr0) * 96 + kc0 * 8); if (c.tid < 256) sk1 = *(const u32x4*)(Kg + (size_t)(kt * 64 + kr1) * 96 + kc1 * 8);
                               sv = *(const u32x4*)(Vg + (size_t)vr * SEQ + kt * 64 + vc * 8); };
    auto lstore = [&](int buf) { unsigned char* kb = c.lds + buf * (KB + VB); unsigned char* vb = kb + KB;
                                 *(u32x4*)(kb + (kr0 * KROW + kc0 * 8) * 2) = sk0; if (c.tid < 256) *(u32x4*)(kb + (kr1 * KROW + kc1 * 8) * 2) = sk1; *(u32x4*)(vb + (vr * VROW + vc * 8) * 2) = sv; };
    gload(0); lstore(0); __syncthreads();
    for (int kt = 0; kt < nkt; ++kt) {
        if (kt + 1 < nkt) gload(kt + 1);
        if (kt <= mylast) {
            const bf16_t* kb = (const bf16_t*)(c.lds + (kt & 1) * (KB + VB)); const bf16_t* vb = (const bf16_t*)(c.lds + (kt & 1) * (KB + VB) + KB);
            f32x16 s0, s1;
#pragma unroll
            for (int r = 0; r < 16; ++r) { s0[r] = 0.f; s1[r] = 0.f; }
#pragma unroll
            for (int ks = 0; ks < 6; ++ks) { const bf16x8 k0 = *(const bf16x8*)(kb + l31 * KROW + ks * 16 + hi * 8), k1 = *(const bf16x8*)(kb + (32 + l31) * KROW + ks * 16 + hi * 8);
                s0 = MFMA32(k0, qf[ks], s0); s1 = MFMA32(k1, qf[ks], s1); }
            if (kt == mylast) {
#pragma unroll
                for (int r = 0; r < 16; ++r) { const int key = kt * 64 + (r & 3) + 8 * (r >> 2) + 4 * hi; if (key > qrow) s0[r] = -INFINITY; if (key + 32 > qrow) s1[r] = -INFINITY; } }
            float mx = s0[0];
#pragma unroll
            for (int r = 1; r < 16; ++r) mx = fmaxf(mx, s0[r]);
#pragma unroll
            for (int r = 0; r < 16; ++r) mx = fmaxf(mx, s1[r]);
            mx = fmaxf(mx, __shfl_xor(mx, 32));
            const float mnew = fmaxf(mrun, mx), alpha = __builtin_amdgcn_exp2f(mrun - mnew); mrun = mnew;
            float ps = 0.f;
#pragma unroll
            for (int r = 0; r < 16; ++r) { s0[r] = __builtin_amdgcn_exp2f(s0[r] - mnew); s1[r] = __builtin_amdgcn_exp2f(s1[r] - mnew); ps += s0[r] + s1[r]; }
            lsum = lsum * alpha + ps;
#pragma unroll
            for (int r = 0; r < 16; ++r) { o0[r] *= alpha; o1[r] *= alpha; }
#pragma unroll
            for (int kf = 0; kf < 2; ++kf)
#pragma unroll
                for (int s = 0; s < 2; ++s) { const f32x16& sx = kf ? s1 : s0; u32x4 pw; pw.x = cvt_pk_bf16(sx[8 * s], sx[8 * s + 1]); pw.y = cvt_pk_bf16(sx[8 * s + 2], sx[8 * s + 3]); pw.z = cvt_pk_bf16(sx[8 * s + 4], sx[8 * s + 5]); pw.w = cvt_pk_bf16(sx[8 * s + 6], sx[8 * s + 7]);
                    const bf16x8 pf = __builtin_bit_cast(bf16x8, pw); const int kcol = kf * 32 + 16 * s + 4 * hi;
                    const s16x4 a0 = *(const s16x4*)(vb + l31 * VROW + kcol), a1 = *(const s16x4*)(vb + l31 * VROW + kcol + 8), b0 = *(const s16x4*)(vb + (32 + l31) * VROW + kcol), b1 = *(const s16x4*)(vb + (32 + l31) * VROW + kcol + 8);
                    const bf16x8 v0 = (bf16x8){a0[0], a0[1], a0[2], a0[3], a1[0], a1[1], a1[2], a1[3]}, v1 = (bf16x8){b0[0], b0[1], b0[2], b0[3], b1[0], b1[1], b1[2], b1[3]};
                    o0 = MFMA32(v0, pf, o0); o1 = MFMA32(v1, pf, o1); }
        }
        if (kt + 1 < nkt) lstore((kt + 1) & 1);
        __syncthreads();
    }
    lsum += __shfl_xor(lsum, 32); const float rl = 1.0f / lsum;
    const int b = bh >> 2, h = bh & 3; bf16_t* yo = c.w<bf16_t>(WS_YB) + (size_t)(b * SEQ + qrow) * 1024 + h * 64;
#pragma unroll
    for (int g = 0; g < 4; ++g) { const int dv = 8 * g + 4 * hi; u32x2 w0, w1;
        w0.x = cvt_pk_bf16(o0[4 * g] * rl, o0[4 * g + 1] * rl); w0.y = cvt_pk_bf16(o0[4 * g + 2] * rl, o0[4 * g + 3] * rl); *(u32x2*)(yo + dv) = w0;
        w1.x = cvt_pk_bf16(o1[4 * g] * rl, o1[4 * g + 1] * rl); w1.y = cvt_pk_bf16(o1[4 * g + 2] * rl, o1[4 * g + 3] * rl); *(u32x2*)(yo + 32 + dv) = w1; }
    __syncthreads();
}
__device__ __forceinline__ void ph_attn(const Ctx& c, int l) {
    hgrn_carry(c, l);
    { const int NU = NBH * (NQT / 2);
      if ((c.G & 7) == 0) { const int per = (NU + 7) / 8, x = c.blk & 7, G8 = c.G >> 3;
          for (int j = c.blk >> 3; j < per; j += G8) { const int pu = x * per + j; if (pu < NU) { const int bh = pu / (NQT / 2), p = pu % (NQT / 2); attn_unit(c, bh, NQT - 1 - p); attn_unit(c, bh, p); } } }
      else for (int pu = c.blk; pu < NU; pu += c.G) { const int bh = pu / (NQT / 2), p = pu % (NQT / 2); attn_unit(c, bh, NQT - 1 - p); attn_unit(c, bh, p); } }
    hgrn_wait_carry(c, l);
    for (int bu = c.blk; bu < NBH * NCH / 4; bu += c.G) hgrn_mfma<true>(c, l, bu, l + 1);
}

__device__ __forceinline__ void ph_router(const Ctx& c_, int l, int cnt_off = 0) { const Ctx c = fresh(c_);
    bf16_t* Whi = (bf16_t*)c.lds; bf16_t* Wlo = (bf16_t*)(c.lds + 73728); float* Llog = (float*)(c.lds + 147456) + c.wid * 288; float* Lcb = (float*)(c.lds + 156672);
    int* Le = (int*)(c.lds + 156672 + 256); float* Lw = (float*)(c.lds + 156672 + 256 + 1024); int* Lr = (int*)(c.lds + 156672 + 256 + 2048); int* Lcnt = (int*)(c.lds + 156672 + 256 + 3072); int* Lbase = Lcnt + 32;
    const float* rwt = c.w<float>(WS_RWT + (size_t)(l & 1) * WSET);
    const float* rgb = c.inf(I_RGB) + l * 4; const float* reb = c.inf(I_REB) + l * 32;
    const float* x = c.a->out; const float* gn = c.inf(I_N2G) + l * 1024; const float* mod = c.w<float>(WS_MOD) + (size_t)l * NB * 6144; bf16_t* ha = c.w<bf16_t>(WS_HA);
    unsigned* cnt = (unsigned*)(c.ws + WS_CTL + CTL_CNT) + l * 32 + cnt_off;
    int* asge = c.w<int>(WS_ASGE); int* asgr = c.w<int>(WS_ASGR); float* asgw = c.w<float>(WS_ASGW);
    const int fr = c.lane & 15, fq = c.lane >> 4;
    int staged_b = -1;
    for (int u = c.blk; u < NTOK / 128; u += c.G) {
        const int b = (u * 128) / SEQ; const float* sh = mod + b * 6144 + 3072; const float* sc = sh + 1024;
        __syncthreads();
        if (b != staged_b) { staged_b = b;
            for (int q = c.tid; q < 36 * 128; q += 512) { const int n = q >> 7, ch = q & 127, k0 = ch * 8; float hi8[8], lo8[8];
#pragma unroll
                for (int j = 0; j < 8; ++j) { const float w = rwt[n * 1024 + k0 + j] * gn[k0 + j] * (1.0f + sc[k0 + j]); const float h = bf2f((bf16_t)f2bf_bits(w)); hi8[j] = h; lo8[j] = w - h; }
                const int pc = (ch ^ (n & 15)) * 8; *(u32x4*)(Whi + n * 1024 + pc) = pk8(hi8); *(u32x4*)(Wlo + n * 1024 + pc) = pk8(lo8); }
            for (int g = c.wid; g < 36; g += 8) { float s = 0.f;
#pragma unroll
                for (int i = 0; i < 4; ++i) { const f32x4 w = *(const f32x4*)(rwt + g * 1024 + i * 256 + c.lane * 4), s4 = *(const f32x4*)(sh + i * 256 + c.lane * 4); s += w[0] * s4[0] + w[1] * s4[1] + w[2] * s4[2] + w[3] * s4[3]; }
                s = wave_sum(s); if (c.lane == 0) Lcb[g] = s + (g < 4 ? rgb[g] : reb[g - 4]); } }
        if (c.tid < 32) Lcnt[c.tid] = 0;
        __syncthreads();
        const int rowb = u * 128 + c.wid * 16; const float* xr = x + (size_t)(rowb + fr) * 1024 + 8 * fq;
        f32x4 acc[3] = {{0.f, 0.f, 0.f, 0.f}, {0.f, 0.f, 0.f, 0.f}, {0.f, 0.f, 0.f, 0.f}}; float ssp = 0.f;
#pragma unroll 4
        for (int ks = 0; ks < 32; ++ks) { const f32x4 xa = *(const f32x4*)(xr + 32 * ks), xb = *(const f32x4*)(xr + 32 * ks + 4);
            float xv[8] = {xa[0], xa[1], xa[2], xa[3], xb[0], xb[1], xb[2], xb[3]}, lo8[8];
            u32x4 hw; hw.x = cvt_pk_bf16(xv[0], xv[1]); hw.y = cvt_pk_bf16(xv[2], xv[3]); hw.z = cvt_pk_bf16(xv[4], xv[5]); hw.w = cvt_pk_bf16(xv[6], xv[7]);
            const unsigned hws[4] = {hw.x, hw.y, hw.z, hw.w};
#pragma unroll
            for (int j = 0; j < 8; ++j) { ssp += xv[j] * xv[j]; lo8[j] = xv[j] - ((j & 1) ? bfhi(hws[j >> 1]) : bflo(hws[j >> 1])); }
            const bf16x8 ah = __builtin_bit_cast(bf16x8, hw), al = __builtin_bit_cast(bf16x8, pk8(lo8));
            const int ch = 4 * ks + fq;
#pragma unroll
            for (int nf = 0; nf < 3; ++nf) { const int n = 16 * nf + fr; bf16x8 bh = {0, 0, 0, 0, 0, 0, 0, 0}, bl = bh;
                if (nf < 2 || fr < 4) { const int pc = (ch ^ (n & 15)) * 8; bh = *(const bf16x8*)(Whi + n * 1024 + pc); bl = *(const bf16x8*)(Wlo + n * 1024 + pc); }
                acc[nf] = MFMA16(ah, bh, acc[nf]); acc[nf] = MFMA16(ah, bl, acc[nf]); acc[nf] = MFMA16(al, bh, acc[nf]); } }
        ssp += __shfl_xor(ssp, 16); ssp += __shfl_xor(ssp, 32);
        const float rinv = frsqrt(ssp * (1.0f / 1024.0f) + EPS);
        float rj[4];
#pragma unroll
        for (int j = 0; j < 4; ++j) rj[j] = __shfl(rinv, fq * 4 + j);
#pragma unroll
        for (int half = 0; half < 2; ++half) {
            if ((fq >> 1) == half) {
#pragma unroll
                for (int nf = 0; nf < 3; ++nf) { const int col = 16 * nf + fr; if (col < 36) {
#pragma unroll
                    for (int j = 0; j < 4; ++j) Llog[((fq & 1) * 4 + j) * 36 + col] = acc[nf][j] * rj[j] + Lcb[col]; } } }
            __builtin_amdgcn_wave_barrier();
            if (c.lane < 8) { const float* lg = Llog + c.lane * 36; const int rl = c.wid * 16 + half * 8 + c.lane;
                int gi = 0; float gm = lg[0];
#pragma unroll
                for (int g = 1; g < 4; ++g) { const float t = lg[g]; if (t > gm) { gm = t; gi = g; } }
                float den = 0.f;
#pragma unroll
                for (int g = 0; g < 4; ++g) den += expf(lg[g] - gm);
                const float gw = 1.0f / den;
                float e1 = -INFINITY, e2 = -INFINITY; int i1 = 0, i2 = 0;
#pragma unroll
                for (int j = 0; j < 8; ++j) { const float t = lg[4 + gi * 8 + j]; if (t > e1) { e2 = e1; i2 = i1; e1 = t; i1 = j; } else if (t > e2) { e2 = t; i2 = j; } }
                const float p2 = expf(e2 - e1), w1 = gw / (1.0f + p2), w2 = gw * p2 / (1.0f + p2);
                const int ea = gi * 8 + i1, eb = gi * 8 + i2; Le[rl * 2] = ea; Le[rl * 2 + 1] = eb; Lw[rl * 2] = w1; Lw[rl * 2 + 1] = w2;
                Lr[rl * 2] = atomicAdd(&Lcnt[ea], 1); Lr[rl * 2 + 1] = atomicAdd(&Lcnt[eb], 1); }
            __builtin_amdgcn_wave_barrier();
        }
#pragma unroll 4
        for (int ks = 0; ks < 32; ++ks) { const int k0 = 32 * ks + 8 * fq; const f32x4 xa = *(const f32x4*)(xr + 32 * ks), xb = *(const f32x4*)(xr + 32 * ks + 4);
            const f32x4 ga = *(const f32x4*)(gn + k0) * (*(const f32x4*)(sc + k0) + 1.0f), gb = *(const f32x4*)(gn + k0 + 4) * (*(const f32x4*)(sc + k0 + 4) + 1.0f);
            const f32x4 ha4 = xa * rinv * ga + *(const f32x4*)(sh + k0), hb4 = xb * rinv * gb + *(const f32x4*)(sh + k0 + 4);
            u32x4 o; o.x = cvt_pk_bf16(ha4[0], ha4[1]); o.y = cvt_pk_bf16(ha4[2], ha4[3]); o.z = cvt_pk_bf16(hb4[0], hb4[1]); o.w = cvt_pk_bf16(hb4[2], hb4[3]);
            *(u32x4*)(ha + (size_t)(rowb + fr) * 1024 + k0) = o; }
        __syncthreads();
        if (c.tid < 32) Lbase[c.tid] = (int)__hip_atomic_fetch_add(&cnt[c.tid], (unsigned)Lcnt[c.tid], __ATOMIC_RELAXED, __HIP_MEMORY_SCOPE_AGENT);
        __syncthreads();
        if (c.tid < 256) { const int a = u * 256 + c.tid, e = Le[c.tid]; asge[a] = e; asgr[a] = Lbase[e] + Lr[c.tid]; asgw[a] = Lw[c.tid]; }
    }
    __syncthreads();
}
__device__ __forceinline__ void ph_gather(const Ctx& c_, int l) { const Ctx c = fresh(c_);
    int* Lps = (int*)c.lds; int* Lcn = Lps + 40;
    unsigned* cnt = (unsigned*)(c.ws + WS_CTL + CTL_CNT) + l * 32;
    if (c.tid < 32) Lcn[c.tid] = (int)__hip_atomic_load(&cnt[c.tid], __ATOMIC_RELAXED, __HIP_MEMORY_SCOPE_AGENT);
    __syncthreads();
    if (c.tid == 0) { int acc = 0; for (int e = 0; e < 32; ++e) { Lps[e] = acc; acc += (Lcn[e] + 255) / 256 * 256; } Lps[32] = acc; }
    __syncthreads();
    int* rowtok = c.w<int>(WS_ROWTOK); float* roww = c.w<float>(WS_ROWW);
    if (c.blk == 0) { int* tile = c.w<int>(WS_TILE); if (c.tid == 0) tile[0] = Lps[32] / 256;
        for (int e = c.tid; e < 32; e += 512) for (int t = Lps[e] / 256; t < Lps[e + 1] / 256; ++t) tile[1 + t] = e; }
    for (int e = c.blk; e < 32; e += c.G) for (int r = Lps[e] + Lcn[e] + c.tid; r < Lps[e + 1]; r += 512) rowtok[r] = -1;
    const int* asge = c.w<int>(WS_ASGE); const int* asgr = c.w<int>(WS_ASGR); const float* asgw = c.w<float>(WS_ASGW);
    for (int a = c.blk * 512 + c.tid; a < NTOK * 2; a += c.G * 512) { const int dest = Lps[asge[a]] + asgr[a]; rowtok[dest] = a; roww[dest] = asgw[a]; }
}
__device__ __forceinline__ void ph_final(const Ctx& c_) { const Ctx c = fresh(c_);
    float* out = c.a->out; const bf16_t* y1 = c.w<bf16_t>(WS_Y1);
    for (size_t e = (size_t)c.blk * 512 + c.tid; e < (size_t)NTOK * 256; e += (size_t)c.G * 512) { const u32x2 y = *(const u32x2*)(y1 + e * 4); f32x4 v = *(const f32x4*)(out + e * 4);
        v += (f32x4){bflo(y.x), bfhi(y.x), bflo(y.y), bfhi(y.y)}; *(f32x4*)(out + e * 4) = v; }
}

constexpr int PH_PER_LAYER = 9, N_PHASES = 2 + PH_PER_LAYER * NL + 1;
__global__ void __launch_bounds__(512, 2) mk_fwd(Args args) {
#ifdef EMU
    unsigned char* lds = emu_lds();
#else
    extern __shared__ __attribute__((aligned(16))) unsigned char lds[];
#endif
    Ctx c; c.a = &args; c.ws = args.ws; c.lds = lds; c.tid = threadIdx.x; c.wid = __builtin_amdgcn_readfirstlane(c.tid >> 6); c.lane = c.tid & 63; c.G = gridDim.x; c.blk = blockIdx.x;
    if (c.tid == 0) *(uint4*)(lds + LDS_XB) = make_uint4(0u, 0u, 0u, 0u);
    __syncthreads();
    XcdBarrier bar; bar.bar = (unsigned*)(args.ws + WS_CTL); bar.x = 0; bar.st = (volatile LAS unsigned*)(lds + LDS_XB);
    if (args.ph_hi - args.ph_lo > 1) bar = xcd_barrier_post((unsigned*)(args.ws + WS_CTL), (volatile LAS unsigned*)(lds + LDS_XB));
    int ph = 0;
#ifndef PHMASK
#define PHMASK 0xFFFFF
#endif
#define PHASE(K, ...) do { if (ph >= args.ph_lo && ph < args.ph_hi) { if constexpr ((PHMASK >> K) & 1) { __VA_ARGS__; } if (ph + 1 < args.ph_hi) xcd_barrier(bar); } ++ph; } while (0)
    PHASE(0, ph_prologue0(c));
    PHASE(1, ph_prologue1(c));
    for (int l = 0; l < NL; ++l) {
        PHASE(2, if (l == 0) ph_cvt(c, 0); ph_normrows(c, l));
        PHASE(3, { pg8::Gemm g{c.w<bf16_t>(WS_HA), c.w<bf16_t>(WS_WIN + (size_t)(l & 1) * WSET), NTOK, ZP, 1024}; pg8::StaticOrder S; S.init(NTOK, ZP, c.G, c.blk); pg8::EpiBf16 E{c.w<bf16_t>(WS_Z), ZP};
                pg8::gemm_phase<pg8::EpiBf16, pg8::StaticOrder, true, true>((LAS unsigned char*)lds, g, S, E); });
        PHASE(4, ph_mixers(c, l));
        PHASE(5, ph_attn(c, l));
        PHASE(6, { pg8::Gemm g{c.w<bf16_t>(WS_YB), c.w<bf16_t>(WS_WOUT + (size_t)(l & 1) * WSET), NTOK, 1024, 1024}; pg8::StaticOrder S; S.init(NTOK, 1024, c.G, c.blk);
                pg8::EpiResid E{(l == 0) ? c.inf(I_X) : args.out, args.out, c.w<float>(WS_MOD) + (size_t)l * NB * 6144 + 2048, 6144, SEQ, (l == 0) ? (const bf16_t*)nullptr : c.w<bf16_t>(WS_Y1)};
                pg8::gemm_phase<pg8::EpiResid, pg8::StaticOrder, true, true>((LAS unsigned char*)lds, g, S, E); });
        PHASE(7, ph_router(c, l));
        PHASE(8, ph_gather(c, l));
        PHASE(9, { pg8::Gemm g{c.w<bf16_t>(WS_HA), c.w<bf16_t>(WS_WUP + (size_t)(l & 1) * WSET), NR, 32 * 1024, 1024}; pg8::MoeOrder S{c.w<int>(WS_TILE), c.G, c.blk}; pg8::EpiSwiglu E{c.w<bf16_t>(WS_Q)};
                pg8::gemm_phase<pg8::EpiSwiglu, pg8::MoeOrder, true, true, true>((LAS unsigned char*)lds, g, S, E, c.w<int>(WS_ROWTOK)); });
        PHASE(10, { pg8::Gemm g{c.w<bf16_t>(WS_Q), c.w<bf16_t>(WS_WDN + (size_t)(l & 1) * WSET), NR, 32 * 1024, 512}; pg8::MoeOrder S{c.w<int>(WS_TILE), c.G, c.blk};
                pg8::EpiDown E{c.w<int>(WS_ROWTOK), c.w<float>(WS_ROWW), args.out, c.w<bf16_t>(WS_Y1), c.w<float>(WS_MOD) + (size_t)l * NB * 6144 + 5120, 6144, SEQ};
                pg8::gemm_phase<pg8::EpiDown, pg8::MoeOrder, true, true>((LAS unsigned char*)lds, g, S, E); });
    }
    PHASE(11, ph_final(c));
#undef PHASE
}

extern "C" void kernel_launch(void* const* d_in, const int* in_sizes, int n_in, void* d_out, int out_size, void* d_ws, size_t ws_size, hipStream_t stream) {
    static int grid = 0;
    if (grid == 0) {
        if (n_in != 30 || out_size != NTOK * 1024 || ws_size < WS_END) { fprintf(stderr, "kernel_launch: shape/workspace mismatch (n_in %d out %d ws %zu need %zu)\n", n_in, out_size, ws_size, (size_t)WS_END); grid = -1; return; }
        int dev = 0, cus = 0;
        if (hipGetDevice(&dev) != hipSuccess || hipDeviceGetAttribute(&cus, hipDeviceAttributeMultiprocessorCount, dev) != hipSuccess) { grid = -1; return; }
        if (hipFuncSetAttribute((const void*)mk_fwd, hipFuncAttributeMaxDynamicSharedMemorySize, LDS_BYTES) != hipSuccess) { fprintf(stderr, "kernel_launch: hipFuncSetAttribute failed\n"); grid = -1; return; }
        int per_cu = 0; (void)hipOccupancyMaxActiveBlocksPerMultiprocessor(&per_cu, (const void*)mk_fwd, 512, LDS_BYTES);
        if (per_cu < 1) fprintf(stderr, "kernel_launch: occupancy query says %d blocks per CU\n", per_cu);
        grid = cus;
    }
    if (grid < 0) return;
    (void)hipMemsetAsync((char*)d_ws + WS_CTL, 0, CTL_BYTES, stream);
    Args a{};
    for (int i = 0; i < 30; ++i) a.in[i] = d_in[i];
    a.out = (float*)d_out; a.ws = (unsigned char*)d_ws;
#if MK_SPLIT
    for (int p = 0; p < N_PHASES; ++p) { a.ph_lo = p; a.ph_hi = p + 1;
#else
    { a.ph_lo = 0; a.ph_hi = N_PHASES;
#endif
#ifdef EMU
        EMU_LAUNCH(mk_fwd, grid, 512, LDS_BYTES, stream, a);
#else
        hipLaunchKernelGGL(mk_fwd, dim3(grid), dim3(512), LDS_BYTES, stream, a);
#endif
    }
}
```

```cpp
#include <hip/hip_runtime.h>
#include <cstdio>
#include <cstdint>
#include <type_traits>

#ifndef CFG_B
#define CFG_B 4
#endif
#ifndef CFG_S
#define CFG_S 8192
#endif
#ifndef CFG_L
#define CFG_L 4
#endif
#ifndef MK_SPLIT
#define MK_SPLIT 0
#endif

#ifdef EMU
#define ASMV(...) ((void)0)
#define LAS
#define LAUNDER_V(x) ((void)0)
#define LAUNDER_S(x) ((void)0)
#else
#define ASMV(...) asm volatile(__VA_ARGS__)
#define LAS __attribute__((address_space(3)))
#define LAUNDER_V(x) asm volatile("" : "+v"(x))
#define LAUNDER_S(x) asm volatile("" : "+s"(x))
#endif

typedef unsigned short bf16_t;
typedef short bf16x8 __attribute__((ext_vector_type(8)));
typedef short s16x4 __attribute__((ext_vector_type(4)));
typedef float f32x4 __attribute__((ext_vector_type(4)));
typedef float f32x16 __attribute__((ext_vector_type(16)));
typedef unsigned u32x4 __attribute__((ext_vector_type(4)));
typedef unsigned u32x2 __attribute__((ext_vector_type(2)));

__device__ __forceinline__ float bf2f(bf16_t h) { return __builtin_bit_cast(float, (unsigned)h << 16); }
__device__ __forceinline__ float bflo(unsigned w) { return __builtin_bit_cast(float, w << 16); }
__device__ __forceinline__ float bfhi(unsigned w) { return __builtin_bit_cast(float, w & 0xffff0000u); }
__device__ __forceinline__ unsigned f2bf_bits(float f) { unsigned u = __builtin_bit_cast(unsigned, f); u += 0x7fffu + ((u >> 16) & 1u); return u >> 16; }
#ifdef EMU
__device__ __forceinline__ unsigned cvt_pk_bf16(float lo, float hi) { return f2bf_bits(lo) | (f2bf_bits(hi) << 16); }
__device__ __forceinline__ unsigned cvt_pk_bf16_pinned(float lo, float hi) { return f2bf_bits(lo) | (f2bf_bits(hi) << 16); }
#else
typedef __bf16 bf16v2_t __attribute__((ext_vector_type(2)));
typedef float f32v2_t __attribute__((ext_vector_type(2)));
__device__ __forceinline__ unsigned cvt_pk_bf16(float lo, float hi) { const bf16v2_t r = __builtin_convertvector((f32v2_t){lo, hi}, bf16v2_t); return __builtin_bit_cast(unsigned, r); }
__device__ __forceinline__ unsigned cvt_pk_bf16_pinned(float lo, float hi) { unsigned r; asm volatile("v_cvt_pk_bf16_f32 %0, %1, %2\n\ts_nop 1" : "=v"(r) : "v"(lo), "v"(hi)); return r; }
#endif
__device__ __forceinline__ float fast_exp(float x) { return __builtin_amdgcn_exp2f(x * 1.44269504089f); }
__device__ __forceinline__ float fsigmoid(float x) { return __builtin_amdgcn_rcpf(1.0f + fast_exp(-x)); }
__device__ __forceinline__ float fsilu(float x) { return x * fsigmoid(x); }
__device__ __forceinline__ float frsqrt(float x) { return __builtin_amdgcn_rsqf(x); }
#ifdef EMU
__device__ __forceinline__ float wave_sum(float v) {
#pragma unroll
    for (int m = 32; m >= 1; m >>= 1) v += __shfl_xor(v, m);
    return v;
}
#else
template <int CTRL, int ROW_MASK> __device__ __forceinline__ float dpp_t(float v) { return __builtin_bit_cast(float, __builtin_amdgcn_update_dpp(0, __builtin_bit_cast(int, v), CTRL, ROW_MASK, 0xF, false)); }
#define dpp_f(v, ctrl, rm) dpp_t<ctrl, rm>(v)
__device__ __forceinline__ float wave_sum(float v) {
    v += dpp_f(v, 0xB1, 0xF);
    v += dpp_f(v, 0x4E, 0xF);
    v += dpp_f(v, 0x141, 0xF);
    v += dpp_f(v, 0x140, 0xF);
    v += dpp_f(v, 0x142, 0xA);
    v += dpp_f(v, 0x143, 0xC);
    return __builtin_bit_cast(float, __builtin_amdgcn_readlane(__builtin_bit_cast(int, v), 63));
}
__device__ __forceinline__ float half_sum(float v, int hi) {
    v += dpp_f(v, 0xB1, 0xF); v += dpp_f(v, 0x4E, 0xF); v += dpp_f(v, 0x141, 0xF); v += dpp_f(v, 0x140, 0xF);
    v += dpp_f(v, 0x142, 0xA);
    const float a = __builtin_bit_cast(float, __builtin_amdgcn_readlane(__builtin_bit_cast(int, v), 31)), b = __builtin_bit_cast(float, __builtin_amdgcn_readlane(__builtin_bit_cast(int, v), 63));
    return hi ? b : a;
}
#endif
#ifdef EMU
__device__ __forceinline__ float half_sum(float v, int) {
#pragma unroll
    for (int m = 1; m < 32; m <<= 1) v += __shfl_xor(v, m);
    return v;
}
#endif

namespace pg8 {
#define PG8_LAS LAS
constexpr int BM = 256, BK = 64, HALF = 128, HTB = HALF * BK * 2  , STAGE_BYTES = 8 * HTB, NXCD = 8, WGM = 8;

__host__ __device__ __forceinline__ int lds_byte(int r, int c) { const int st = (r >> 4) * 2 + (c >> 5), rr = r & 15, cc = c & 31, ob = rr * 64 + cc * 2; return st * 1024 + (ob ^ (((ob >> 9) & 1) << 5)); }
__host__ __device__ __forceinline__ void stage_rc(int b, int& R, int& C) { const int st = b / 1024, sb = b % 1024, swz = sb ^ (((sb >> 9) & 1) << 5); R = (st >> 1) * 16 + swz / 64; C = (st & 1) * 32 + (swz % 64) / 2; }
__host__ __device__ __forceinline__ int perm32(int rho) { const int n = rho >> 4, i = rho & 15; return 8 * (i >> 2) + 4 * n + (i & 3); }

struct Unit { int pm, pn; };
struct Gemm { const bf16_t* A; const bf16_t* Bt; int M, N, K; };

struct StaticOrder {
    int nM, nN, nwg, G, c;
    __host__ __device__ void init(int M, int N, int G_, int c_) { nM = M / BM; nN = N / BM; nwg = nM * nN; G = G_; c = c_; }
    __host__ __device__ bool next(int i, Unit& u) const {
        const long L = (long)i * G + c; if (L >= nwg) return false;
        int wgid = (int)L; { const int q = nwg / NXCD, r = nwg % NXCD, xcd = wgid % NXCD, off = wgid / NXCD; wgid = (xcd < r ? xcd * (q + 1) : r * (q + 1) + (xcd - r) * q) + off; }
        const int nig = WGM * nN, gid = wgid / nig, fm = gid * WGM, gsz = (nM - fm) < WGM ? (nM - fm) : WGM;
        u.pm = fm + ((wgid % nig) % gsz); u.pn = (wgid % nig) / gsz; return true;
    }
    __device__ __forceinline__ void a_ready(const Unit&) const {}
    __device__ __forceinline__ void done(const Unit&) const {}
};
template <class Epi, class Sched, bool ALIGN_EPI = false, bool SP2 = false, bool GATHER = false>
__device__ __forceinline__ void gemm_phase(PG8_LAS unsigned char* lds, const Gemm g, const Sched& S, const Epi& E, const int* rowmap = nullptr) {
    int tid = threadIdx.x; LAUNDER_V(tid); const int wid = __builtin_amdgcn_readfirstlane(tid >> 6), lane = tid & 63, wr = wid >> 2, wc = wid & 3, fr = lane & 15, fq = lane >> 4;
    const int K = g.K, nt = K / BK;
    unsigned voffA[2], voffB[2]; int RA[2], CA[2];
#pragma unroll
    for (int i = 0; i < 2; ++i) { int R, C; stage_rc(tid * 16 + i * 8192, R, C); const int Rb = Epi::PERM ? ((R & ~31) + perm32(R & 31)) : R;
        voffA[i] = (unsigned)(R * K + C) * 2u; voffB[i] = (unsigned)(Rb * K + C) * 2u; RA[i] = R; CA[i] = C; }
    const size_t kstep = (size_t)(BK * 2);
    const size_t hstep = (size_t)HALF * K * 2;
    const size_t tstep = 2 * hstep;
    const size_t hA = GATHER ? (size_t)0 : hstep;
    unsigned vA0[2], vA1[2], nA0[2], nA1[2];
    auto rows_of = [&](const Unit& u, unsigned (&o0)[2], unsigned (&o1)[2]) {
#pragma unroll
        for (int i = 0; i < 2; ++i) { if constexpr (GATHER) { int t0 = rowmap[u.pm * BM + RA[i]], t1 = rowmap[u.pm * BM + HALF + RA[i]]; t0 = t0 < 0 ? 0 : (t0 >> 1); t1 = t1 < 0 ? 0 : (t1 >> 1);
                o0[i] = (unsigned)(t0 * K + CA[i]) * 2u; o1[i] = (unsigned)(t1 * K + CA[i]) * 2u; } else { o0[i] = voffA[i]; o1[i] = voffA[i]; } } };
    const unsigned ldsw = (unsigned)wid * 1024u;
    const int aoff = lds_byte(wr * 64 + fr, fq * 8), boff = lds_byte(wc * 32 + fr, fq * 8);
#define PG8_SA(b, h) (((b) * 2 + (h)) * HTB)
#define PG8_SB(b, h) ((4 + (b) * 2 + (h)) * HTB)
#define PG8_STAGE(bufoff, gbase, voff) do { _Pragma("unroll") for (int _i = 0; _i < 2; ++_i) \
        __builtin_amdgcn_global_load_lds((const unsigned*)((const char*)(gbase) + (voff)[_i]), (PG8_LAS unsigned*)(lds + (bufoff) + ldsw + _i * 8192), 16, 0, 0); } while (0)
#define PG8_LDA(dst, b, h) do { _Pragma("unroll") for (int m = 0; m < 4; ++m) _Pragma("unroll") for (int k = 0; k < 2; ++k) dst[m][k] = *(const PG8_LAS bf16x8*)(lds + PG8_SA(b, h) + aoff + m * 2048 + k * 1024); } while (0)
#define PG8_LDB(dst, b, h) do { _Pragma("unroll") for (int n = 0; n < 2; ++n) _Pragma("unroll") for (int k = 0; k < 2; ++k) dst[n][k] = *(const PG8_LAS bf16x8*)(lds + PG8_SB(b, h) + boff + n * 2048 + k * 1024); } while (0)
#define PG8_MMA(ai, bj, At, Bt) do { __builtin_amdgcn_s_setprio(1); _Pragma("unroll") for (int m = 0; m < 4; ++m) _Pragma("unroll") for (int n = 0; n < 2; ++n) _Pragma("unroll") for (int k = 0; k < 2; ++k) \
        acc[ai][bj][m][n] = __builtin_amdgcn_mfma_f32_16x16x32_bf16(Bt[n][k], At[m][k], acc[ai][bj][m][n], 0, 0, 0); __builtin_amdgcn_s_setprio(0); } while (0)
#define PG8_WAIT_V(n) ASMV("s_waitcnt vmcnt(" #n ")" ::: "memory")
#define PG8_WAIT_L(n) ASMV("s_waitcnt lgkmcnt(" #n ")" ::: "memory")
#define PG8_BAR __builtin_amdgcn_s_barrier()
#define PG8_SCHED __builtin_amdgcn_sched_barrier(0)
    Unit cur, nxt; int ui = 0;
    if (!S.next(0, cur)) return;
    f32x4 acc[2][2][4][2];
#pragma unroll
    for (int a = 0; a < 2; ++a)
#pragma unroll
        for (int b = 0; b < 2; ++b)
#pragma unroll
            for (int m = 0; m < 4; ++m)
#pragma unroll
                for (int n = 0; n < 2; ++n) acc[a][b][m][n] = (f32x4){0.f, 0.f, 0.f, 0.f};
    bf16x8 At[4][2], B0[2][2], B1[2][2];
    const char* cA = GATHER ? (const char*)g.A : (const char*)g.A + (size_t)cur.pm * tstep; rows_of(cur, vA0, vA1); const char* cB = (const char*)g.Bt + (size_t)cur.pn * tstep;
    S.a_ready(cur);
    if constexpr (SP2) {
        PG8_STAGE(PG8_SB(0, 0), cB, voffB); PG8_STAGE(PG8_SB(0, 1), cB + hstep, voffB); PG8_STAGE(PG8_SA(0, 0), cA, vA0); PG8_STAGE(PG8_SA(0, 1), cA + hA, vA1);
        if (wr == 1) PG8_BAR;
        PG8_WAIT_V(2); PG8_BAR;
        PG8_STAGE(PG8_SB(1, 0), cB + kstep, voffB); PG8_STAGE(PG8_SA(1, 0), cA + kstep, vA0); PG8_STAGE(PG8_SB(1, 1), cB + hstep + kstep, voffB);
        PG8_WAIT_V(6); PG8_BAR;
    } else {
        PG8_STAGE(PG8_SB(0, 0), cB, voffB); PG8_STAGE(PG8_SA(0, 0), cA, vA0); PG8_STAGE(PG8_SB(0, 1), cB + hstep, voffB); PG8_STAGE(PG8_SA(0, 1), cA + hA, vA1);
        if (wr == 1) PG8_BAR;
        PG8_WAIT_V(4); PG8_BAR;
        PG8_STAGE(PG8_SB(1, 0), cB + kstep, voffB); PG8_STAGE(PG8_SA(1, 0), cA + kstep, vA0); PG8_STAGE(PG8_SB(1, 1), cB + hstep + kstep, voffB);
        PG8_WAIT_V(6); PG8_BAR;
    }
    for (;;) {
        const bool has_next = S.next(ui + 1, nxt);
        const char* nA = GATHER ? (const char*)g.A : (has_next ? (const char*)g.A + (size_t)nxt.pm * tstep : cA);
        if (has_next) rows_of(nxt, nA0, nA1); else { nA0[0] = vA0[0]; nA0[1] = vA0[1]; nA1[0] = vA1[0]; nA1[1] = vA1[1]; } const char* nB = has_next ? (const char*)g.Bt + (size_t)nxt.pn * tstep : cB;
        for (int t = 0; t < nt; t += 2) {
            const bool last = (t == nt - 2);
            unsigned sA0[2], sA1[2];
#pragma unroll
            for (int i = 0; i < 2; ++i) { sA0[i] = last ? nA0[i] : vA0[i]; sA1[i] = last ? nA1[i] : vA1[i]; }
            const char* a1 = cA + (size_t)(t + 1) * kstep;
            const char* a2 = last ? nA : cA + (size_t)(t + 2) * kstep; const char* b2 = last ? nB : cB + (size_t)(t + 2) * kstep;
            const char* a3 = a2 + kstep; const char* b3 = b2 + kstep;
            if (last && has_next) S.a_ready(nxt);
            if constexpr (SP2) {
            PG8_LDB(B0, 0, 0); PG8_LDB(B1, 0, 1); PG8_SCHED; PG8_LDA(At, 0, 0); PG8_STAGE(PG8_SA(1, 1), a1 + hA, vA1);
            PG8_WAIT_V(8); PG8_WAIT_L(0); PG8_BAR; PG8_MMA(0, 0, At, B0); PG8_MMA(0, 1, At, B1); PG8_BAR; PG8_SCHED;
            PG8_LDA(At, 0, 1); PG8_STAGE(PG8_SB(0, 0), b2, voffB); PG8_STAGE(PG8_SB(0, 1), b2 + hstep, voffB); PG8_STAGE(PG8_SA(0, 0), a2, sA0);
            PG8_WAIT_V(8); PG8_WAIT_L(0); PG8_BAR; PG8_MMA(1, 0, At, B0); PG8_MMA(1, 1, At, B1); PG8_BAR; PG8_SCHED;
            PG8_LDB(B0, 1, 0); PG8_LDB(B1, 1, 1); PG8_SCHED; PG8_LDA(At, 1, 0); PG8_STAGE(PG8_SA(0, 1), a2 + hA, sA1);
            PG8_WAIT_V(8); PG8_WAIT_L(0); PG8_BAR; PG8_MMA(0, 0, At, B0); PG8_MMA(0, 1, At, B1); PG8_BAR; PG8_SCHED;
            PG8_LDA(At, 1, 1); PG8_STAGE(PG8_SB(1, 0), b3, voffB); PG8_STAGE(PG8_SB(1, 1), b3 + hstep, voffB); PG8_STAGE(PG8_SA(1, 0), a3, sA0);
            PG8_WAIT_V(8); PG8_WAIT_L(0); PG8_BAR; PG8_MMA(1, 0, At, B0); PG8_MMA(1, 1, At, B1); PG8_BAR; PG8_SCHED;
            } else {
            PG8_LDB(B0, 0, 0); PG8_SCHED; PG8_LDA(At, 0, 0); PG8_STAGE(PG8_SA(1, 1), a1 + hA, vA1);
            PG8_WAIT_L(8); PG8_BAR; PG8_WAIT_L(0); PG8_MMA(0, 0, At, B0); PG8_BAR; PG8_SCHED;
            PG8_LDB(B1, 0, 1); PG8_STAGE(PG8_SB(0, 0), b2, voffB);
            PG8_BAR; PG8_WAIT_L(0); PG8_MMA(0, 1, At, B1); PG8_BAR;
            PG8_LDA(At, 0, 1); PG8_STAGE(PG8_SA(0, 0), a2, sA0);
            PG8_BAR; PG8_WAIT_L(0); PG8_MMA(1, 0, At, B0); PG8_BAR; PG8_SCHED;
            PG8_STAGE(PG8_SB(0, 1), b2 + hstep, voffB);
            PG8_WAIT_V(6); PG8_BAR; PG8_MMA(1, 1, At, B1); PG8_BAR;
            PG8_LDB(B0, 1, 0); PG8_SCHED; PG8_LDA(At, 1, 0); PG8_STAGE(PG8_SA(0, 1), a2 + hA, sA1);
            PG8_WAIT_L(8); PG8_BAR; PG8_WAIT_L(0); PG8_MMA(0, 0, At, B0); PG8_BAR; PG8_SCHED;
            PG8_LDB(B1, 1, 1); PG8_STAGE(PG8_SB(1, 0), b3, voffB);
            PG8_BAR; PG8_WAIT_L(0); PG8_MMA(0, 1, At, B1); PG8_BAR;
            PG8_LDA(At, 1, 1); PG8_STAGE(PG8_SA(1, 0), a3, sA0);
            PG8_BAR; PG8_WAIT_L(0); PG8_MMA(1, 0, At, B0); PG8_BAR; PG8_SCHED;
            PG8_STAGE(PG8_SB(1, 1), b3 + hstep, voffB);
            PG8_WAIT_V(6); PG8_BAR; PG8_MMA(1, 1, At, B1); PG8_BAR;
            }
        }
        if constexpr (ALIGN_EPI) { if (wr == 0) PG8_BAR; }
        if constexpr (!Epi::AFTER_DRAIN) { E(acc, cur, wr, wc, fr, fq); S.done(cur); }
        if (!has_next) break;
#pragma unroll
        for (int a = 0; a < 2; ++a)
#pragma unroll
            for (int b = 0; b < 2; ++b)
#pragma unroll
                for (int m = 0; m < 4; ++m)
#pragma unroll
                    for (int n = 0; n < 2; ++n) acc[a][b][m][n] = (f32x4){0.f, 0.f, 0.f, 0.f};
        cur = nxt; cA = nA; cB = nB; ++ui; vA0[0] = nA0[0]; vA0[1] = nA0[1]; vA1[0] = nA1[0]; vA1[1] = nA1[1];
        if constexpr (ALIGN_EPI) { if (wr == 1) PG8_BAR; }
    }
    PG8_WAIT_V(0);
    if constexpr (!ALIGN_EPI) { if (wr == 0) PG8_BAR; }
    PG8_BAR;
    if constexpr (Epi::AFTER_DRAIN) { E.fused(acc, cur, wr, wc, fr, fq, lds, wid, lane); S.done(cur); }
#undef PG8_SA
#undef PG8_SB
#undef PG8_STAGE
#undef PG8_LDA
#undef PG8_LDB
#undef PG8_MMA
#undef PG8_WAIT_V
#undef PG8_WAIT_L
#undef PG8_BAR
#undef PG8_SCHED
}

struct EpiBf16 {
    static constexpr bool PERM = true, AFTER_DRAIN = false;
    bf16_t* O; int ldc;
    __device__ __forceinline__ void operator()(const f32x4 (&acc)[2][2][4][2], const Unit& u, int wr, int wc, int fr, int fq) const {
        const int row0 = u.pm * BM + wr * 64 + fr, col0 = u.pn * BM + wc * 32 + 8 * fq;
#pragma unroll
        for (int ai = 0; ai < 2; ++ai)
#pragma unroll
            for (int m = 0; m < 4; ++m) { bf16_t* rowp = O + (size_t)(row0 + ai * HALF + m * 16) * ldc + col0;
#pragma unroll
                for (int bj = 0; bj < 2; ++bj) { const f32x4 v0 = acc[ai][bj][m][0], v1 = acc[ai][bj][m][1];
                    u32x4 w; w.x = cvt_pk_bf16(v0[0], v0[1]); w.y = cvt_pk_bf16(v0[2], v0[3]); w.z = cvt_pk_bf16(v1[0], v1[1]); w.w = cvt_pk_bf16(v1[2], v1[3]);
                    *(u32x4*)(rowp + bj * HALF) = w; } }
    }
};
struct EpiResid {
    static constexpr bool PERM = true, AFTER_DRAIN = false;
    const float* xin; float* xout; const float* gate; int gstride; int seq; const bf16_t* y1;
    __device__ __forceinline__ void operator()(const f32x4 (&acc)[2][2][4][2], const Unit& u, int wr, int wc, int fr, int fq) const {
        const int row0 = u.pm * BM + wr * 64 + fr, col0 = u.pn * BM + wc * 32 + 8 * fq;
#pragma unroll
        for (int ai = 0; ai < 2; ++ai)
#pragma unroll
            for (int m = 0; m < 4; ++m) { const int row = row0 + ai * HALF + m * 16; const float* gp = gate + (size_t)(row / seq) * gstride;
#pragma unroll
                for (int bj = 0; bj < 2; ++bj) { const int c = col0 + bj * HALF; const size_t o = (size_t)row * 1024 + c;
                    const f32x4 g0 = *(const f32x4*)(gp + c), g1 = *(const f32x4*)(gp + c + 4);
                    f32x4 x0 = *(const f32x4*)(xin + o), x1 = *(const f32x4*)(xin + o + 4);
                    if (y1) { const u32x4 y = *(const u32x4*)(y1 + o); x0 += (f32x4){bflo(y.x), bfhi(y.x), bflo(y.y), bfhi(y.y)}; x1 += (f32x4){bflo(y.z), bfhi(y.z), bflo(y.w), bfhi(y.w)}; }
                    *(f32x4*)(xout + o) = x0 + g0 * acc[ai][bj][m][0]; *(f32x4*)(xout + o + 4) = x1 + g1 * acc[ai][bj][m][1]; } }
    }
};
struct EpiSwiglu {
    static constexpr bool PERM = true, AFTER_DRAIN = false;
    bf16_t* HB;
    __device__ __forceinline__ void operator()(const f32x4 (&acc)[2][2][4][2], const Unit& u, int wr, int wc, int fr, int fq) const {
        const int row0 = u.pm * BM + wr * 64 + fr, col0 = (u.pn & 3) * 128 + wc * 32 + 8 * fq;
#pragma unroll
        for (int ai = 0; ai < 2; ++ai)
#pragma unroll
            for (int m = 0; m < 4; ++m) { bf16_t* p = HB + (size_t)(row0 + ai * HALF + m * 16) * 512 + col0;
                float h[8];
#pragma unroll
                for (int n = 0; n < 2; ++n)
#pragma unroll
                    for (int k = 0; k < 4; ++k) h[n * 4 + k] = fsilu(acc[ai][0][m][n][k]) * acc[ai][1][m][n][k];
                u32x4 w; w.x = cvt_pk_bf16(h[0], h[1]); w.y = cvt_pk_bf16(h[2], h[3]); w.z = cvt_pk_bf16(h[4], h[5]); w.w = cvt_pk_bf16(h[6], h[7]);
                *(u32x4*)p = w; }
    }
};
struct EpiDown {
    static constexpr bool PERM = true, AFTER_DRAIN = false;
    const int* row_tok; const float* row_w; float* x; bf16_t* y1; const float* gate; int gstride; int seq;
    __device__ __forceinline__ void operator()(const f32x4 (&acc)[2][2][4][2], const Unit& u, int wr, int wc, int fr, int fq) const {
        const int row0 = u.pm * BM + wr * 64 + fr, col0 = (u.pn & 3) * BM + wc * 32 + 8 * fq;
#pragma unroll
        for (int ai = 0; ai < 2; ++ai)
#pragma unroll
            for (int m = 0; m < 4; ++m) { const int row = row0 + ai * HALF + m * 16; const int ts = row_tok[row];
                if (ts >= 0) { const int tok = ts >> 1; const float w = row_w[row]; const float* gp = gate + (size_t)(tok / seq) * gstride;
#pragma unroll
                    for (int bj = 0; bj < 2; ++bj) { const int c = col0 + bj * HALF; const size_t o = (size_t)tok * 1024 + c;
                        const f32x4 v0 = acc[ai][bj][m][0] * (*(const f32x4*)(gp + c)) * w, v1 = acc[ai][bj][m][1] * (*(const f32x4*)(gp + c + 4)) * w;
                        if (ts & 1) { u32x4 q; q.x = cvt_pk_bf16(v0[0], v0[1]); q.y = cvt_pk_bf16(v0[2], v0[3]); q.z = cvt_pk_bf16(v1[0], v1[1]); q.w = cvt_pk_bf16(v1[2], v1[3]); *(u32x4*)(y1 + o) = q; }
                        else { *(f32x4*)(x + o) = *(const f32x4*)(x + o) + v0; *(f32x4*)(x + o + 4) = *(const f32x4*)(x + o + 4) + v1; } } } }
    }
};
struct MoeOrder {
    const int* tile; int G, c;
    __device__ __forceinline__ bool next(int i, Unit& u) const { const int v = ((G & 7) == 0) ? (c & 7) * (G >> 3) + (c >> 3) : c; const int L = i * G + v, nt = tile[0]; if (L >= nt * 4) return false; u.pm = L >> 2; u.pn = tile[1 + (L >> 2)] * 4 + (L & 3); return true; }
    __device__ __forceinline__ void a_ready(const Unit&) const {}
    __device__ __forceinline__ void done(const Unit&) const {}
};
}

constexpr int NB = CFG_B, SEQ = CFG_S, NL = CFG_L, NTOK = NB * SEQ, DM = 1024, ZP = 2304;
constexpr int NBH = NB * 4, NCH = SEQ / 128, NQT = SEQ / 256;
constexpr int NR = 2 * NTOK + 32 * 256;
constexpr int Z_CQ = 0, Z_CKV = 192, Z_KR = 320, Z_POOL = 352, Z_HQ = 608, Z_HF = 864, Z_HI = 1120, Z_HG = 1376, Z_CA = 1632, Z_CG = 1888;
constexpr float EPS = 1e-6f;
static_assert(SEQ % 256 == 0 && NTOK % 256 == 0 && (NQT % 2) == 0, "shape");
constexpr size_t al256(size_t x) { return (x + 255) & ~(size_t)255; }
constexpr size_t cmax(size_t a, size_t b) { return a > b ? a : b; }
constexpr size_t WS_CTL = 0, CTL_BYTES = 65536;
constexpr size_t CTL_CNT = 16384;
constexpr size_t CTL_HG = 32768;
constexpr size_t WS_MODP = WS_CTL + CTL_BYTES;
constexpr size_t WS_MOD = WS_MODP + al256((size_t)16 * NL * NB * 6144 * 4);
constexpr size_t WS_LB = WS_MOD + al256((size_t)NL * NB * 6144 * 4);
constexpr size_t WS_ROPE = WS_LB + al256((size_t)NL * 256 * 4);
constexpr size_t WS_WIN = WS_ROPE + al256((size_t)NTOK * 32 * 4);
constexpr size_t WS_WOUT = WS_WIN + (size_t)ZP * 1024 * 2;
constexpr size_t WS_WUQ = WS_WOUT + (size_t)1024 * 1024 * 2;
constexpr size_t WS_WUKV = WS_WUQ + al256((size_t)384 * 192 * 2);
constexpr size_t WS_WPOOL = WS_WUKV + al256((size_t)512 * 128 * 2);
constexpr size_t WS_WUP = WS_WPOOL + al256((size_t)4 * 64 * 64 * 2);
constexpr size_t WS_WDN = WS_WUP + (size_t)32 * 1024 * 1024 * 2;
constexpr size_t WS_RWT = WS_WDN + (size_t)32 * 1024 * 512 * 2;
constexpr size_t WSET = WS_RWT + 36 * 1024 * 4 - WS_WIN;
constexpr size_t WS_HA = WS_WIN + 2 * WSET;
constexpr size_t WS_Z = WS_HA + (size_t)NTOK * 1024 * 2;
constexpr size_t Z_BYTES = cmax((size_t)NTOK * ZP * 2, (size_t)NR * 1024 * 2);
constexpr size_t WS_Q = WS_Z + Z_BYTES;
constexpr size_t WS_K = WS_Q + (size_t)NTOK * 4 * 96 * 2;
constexpr size_t WS_VT = WS_K + (size_t)NTOK * 4 * 96 * 2;
constexpr size_t WS_YB = WS_VT + (size_t)NTOK * 4 * 64 * 2;
constexpr size_t R2_BYTES = cmax(WS_YB + (size_t)NTOK * 1024 * 2 - WS_Q, (size_t)NR * 512 * 2);
constexpr size_t WS_Y1 = WS_Q + R2_BYTES;
constexpr size_t WS_SC = WS_Y1 + (size_t)NTOK * 1024 * 2;
constexpr size_t WS_PC = WS_SC + (size_t)NBH * NCH * 4096 * 4;
constexpr size_t WS_S0 = WS_PC + al256((size_t)NBH * NCH * 64 * 4);
constexpr size_t WS_ASGE = WS_S0 + (size_t)NBH * NCH * 4096 * 4;
constexpr size_t WS_ASGR = WS_ASGE + (size_t)NTOK * 8;
constexpr size_t WS_ASGW = WS_ASGR + (size_t)NTOK * 8;
constexpr size_t WS_ROWTOK = WS_ASGW + (size_t)NTOK * 8;
constexpr size_t WS_ROWW = WS_ROWTOK + al256((size_t)NR * 4);
constexpr size_t WS_TILE = WS_ROWW + al256((size_t)NR * 4);
constexpr size_t WS_END = WS_TILE + al256((size_t)(NR / 256 + 16) * 4);
constexpr int LDS_BYTES = 160 * 1024;
constexpr int LDS_XB = LDS_BYTES - 16;

#define XB_TMO      128
#define XB_XCNT(j)  (256  + 64 * (j))
#define XB_XSUB(j)  (1280 + 64 * (j))
#define XB_XGEN(j)  (2304 + 64 * (j))
#define XB_TOP      3328
#define XB_TOPGEN   3392
#define XCD_BAR_WORDS 3456
#define XB_SPIN_CAP (1u << 18)
__device__ __forceinline__ unsigned xb_ld(unsigned* p)              { return __hip_atomic_load(p, __ATOMIC_RELAXED, __HIP_MEMORY_SCOPE_AGENT); }
__device__ __forceinline__ unsigned xb_add(unsigned* p, unsigned v) { return __hip_atomic_fetch_add(p, v, __ATOMIC_RELAXED, __HIP_MEMORY_SCOPE_AGENT); }
__device__ __forceinline__ unsigned xb_xcc_id() { return (unsigned)__builtin_amdgcn_s_getreg((3 << 11) | 20) & 0xFu; }
#define XB_SPIN(cond, bar) do { unsigned _sp = 0; while (cond) { __builtin_amdgcn_s_sleep(1); \
    if ((++_sp & 255u) == 0u) { if (xb_ld(&(bar)[XB_TMO])) break; if (_sp > XB_SPIN_CAP) { atomicAdd(&(bar)[XB_TMO], 1u); break; } } } } while (0)
struct XcdBarrier { unsigned* bar; unsigned x; volatile LAS unsigned* st; };
__device__ __forceinline__ XcdBarrier xcd_barrier_post(unsigned* bar, volatile LAS unsigned* st) {
    XcdBarrier b; b.bar = bar; b.x = xb_xcc_id(); b.st = st;
    if (threadIdx.x == 0) (void)xb_add(&bar[XB_XCNT(b.x)], 1u);
    return b;
}
__device__ __forceinline__ void xcd_barrier_complete(unsigned* bar, unsigned x, unsigned& nloc, unsigned& nx) {
    const unsigned G = gridDim.x * gridDim.y * gridDim.z;
    unsigned sum, cnt, mine, sp = 0u;
    for (;;) {
        sum = 0u; cnt = 0u; mine = 0u;
#pragma unroll
        for (unsigned j = 0; j < 16; ++j) { const unsigned c = xb_ld(&bar[XB_XCNT(j)]); sum += c; cnt += (c > 0u) ? 1u : 0u; mine = (j == x) ? c : mine; }
        if (sum == G) break;
        __builtin_amdgcn_s_sleep(1);
        if ((++sp & 255u) == 0u) { if (xb_ld(&bar[XB_TMO])) break; if (sp > XB_SPIN_CAP) { atomicAdd(&bar[XB_TMO], 1u); break; } }
    }
    nloc = mine > 0u ? mine : 1u; nx = cnt > 0u ? cnt : 1u;
}
__device__ __forceinline__ void xcd_barrier(const XcdBarrier& b) {
    ASMV("s_waitcnt vmcnt(0)" ::: "memory");
    __syncthreads();
    if (threadIdx.x == 0) {
        unsigned* bar = b.bar;
        __builtin_amdgcn_s_waitcnt(0);
        unsigned nloc = b.st[0], nx = b.st[1];
        if (nloc == 0u) { xcd_barrier_complete(bar, b.x, nloc, nx); b.st[0] = nloc; b.st[1] = nx; }
        const unsigned old = xb_add(&bar[XB_XSUB(b.x)], 1u);
        const unsigned gen = old / nloc;
        if (old + 1u == (gen + 1u) * nloc) {
            __builtin_amdgcn_fence(__ATOMIC_RELEASE, "agent");
            ASMV("s_waitcnt vmcnt(0)" ::: "memory");
            const unsigned og = xb_add(&bar[XB_TOP], 1u);
            const unsigned tg = og / nx;
            if (og + 1u == (tg + 1u) * nx) xb_add(&bar[XB_TOPGEN], 1u);
            else XB_SPIN(xb_ld(&bar[XB_TOPGEN]) == tg, bar);
            __builtin_amdgcn_fence(__ATOMIC_ACQUIRE, "agent");
            xb_add(&bar[XB_XGEN(b.x)], 1u);
            ASMV("s_waitcnt vmcnt(0)" ::: "memory");
        } else {
            XB_SPIN(xb_ld(&bar[XB_XGEN(b.x)]) == gen, bar);
            __builtin_amdgcn_fence(__ATOMIC_ACQUIRE, "agent");
            ASMV("s_waitcnt vmcnt(0)" ::: "memory");
        }
    }
    __syncthreads();
}

struct Args { const void* in[30]; float* out; unsigned char* ws; int ph_lo, ph_hi; };
enum { I_X = 0, I_C, I_POS, I_WADA, I_BADA, I_N1G, I_N2G, I_WIN, I_QAG, I_WUQ, I_KVAG, I_WUKV, I_QG, I_KG, I_WPOOL, I_PSCALE, I_LBL, I_HOG, I_DWW, I_DWB, I_LNG, I_LNB,
       I_WOUT, I_RGW, I_RGB, I_REW, I_REB, I_W1, I_W3, I_W2 };
struct Ctx {
    const Args* a; unsigned char* ws; unsigned char* lds; int tid, wid, lane, G, blk;
    __device__ __forceinline__ const float* inf(int i) const { return (const float*)a->in[i]; }
    template <class T> __device__ __forceinline__ T* w(size_t off) const { return (T*)(ws + off); }
};

__device__ __forceinline__ Ctx fresh(const Ctx& c0) { Ctx c = c0; LAUNDER_V(c.tid); LAUNDER_V(c.lane); LAUNDER_S(c.wid); return c; }
__device__ __forceinline__ void ph_prologue0(const Ctx& c_) { const Ctx c = fresh(c_);
    const float* cc = c.inf(I_C); const float* wada = c.inf(I_WADA); float* modp = c.w<float>(WS_MODP);
    for (int u = c.blk; u < NL * 16 * 12; u += c.G) {
        const int l = u / 192, r = u % 192, ic = r / 12, jb = r % 12, j = jb * 512 + c.tid;
        float* Ls = (float*)c.lds;
        __syncthreads();
        if (c.tid < NB * 64) Ls[c.tid] = fsilu(cc[(c.tid >> 6) * 1024 + ic * 64 + (c.tid & 63)]);
        __syncthreads();
        float acc[NB];
#pragma unroll
        for (int b = 0; b < NB; ++b) acc[b] = 0.f;
        const float* wp = wada + ((size_t)l * 1024 + ic * 64) * 6144 + j;
#pragma unroll
        for (int i0 = 0; i0 < 64; i0 += 16) { float wv[16];
#pragma unroll
            for (int i = 0; i < 16; ++i) wv[i] = wp[(size_t)(i0 + i) * 6144];
#pragma unroll
            for (int i = 0; i < 16; ++i)
#pragma unroll
                for (int b = 0; b < NB; ++b) acc[b] += Ls[b * 64 + i0 + i] * wv[i]; }
#pragma unroll
        for (int b = 0; b < NB; ++b) modp[(((size_t)ic * NL + l) * NB + b) * 6144 + j] = acc[b];
    }
    const int* pos = (const int*)c.a->in[I_POS]; float* rc = c.w<float>(WS_ROPE); float* rs = rc + (size_t)NTOK * 16;
    for (int e = c.blk * 512 + c.tid; e < NTOK * 16; e += c.G * 512) { const int t = e >> 4, i = e & 15;
        const float inv = exp2f(-(float)i * (13.287712379549449f / 16.0f));
        const float ang = (float)pos[t] * inv; rc[e] = cosf(ang); rs[e] = sinf(ang); }
    if (c.blk == 0 && c.tid < 256) { const float* lg = c.inf(I_LBL); float* lb = c.w<float>(WS_LB); float mx = -1e30f;
        for (int l = 0; l < NL; ++l) mx = fmaxf(mx, lg[l * 256 + c.tid]);
        float den = 0.f; for (int l = 0; l < NL; ++l) den += expf(lg[l * 256 + c.tid] - mx);
        float cum = 0.f, first = 0.f; for (int l = 0; l < NL; ++l) { cum += expf(lg[l * 256 + c.tid] - mx) / den; if (l == 0) first = cum; lb[l * 256 + c.tid] = cum - first; } }
}
__device__ __forceinline__ void ph_prologue1(const Ctx& c_) { const Ctx c = fresh(c_);
    const float* modp = c.w<float>(WS_MODP); float* mod = c.w<float>(WS_MOD); const float* bada = c.inf(I_BADA);
    for (int e = c.blk * 512 + c.tid; e < NL * NB * 6144; e += c.G * 512) { const int j = e % 6144, l = e / (NB * 6144);
        float s = bada[l * 6144 + j];
#pragma unroll
        for (int ic = 0; ic < 16; ++ic) s += modp[(size_t)ic * NL * NB * 6144 + e];
        mod[e] = s; }
}

__device__ __forceinline__ void ld8bf(const bf16_t* p, float (&o)[8]) { const u32x4 v = *(const u32x4*)p; o[0] = bflo(v.x); o[1] = bfhi(v.x); o[2] = bflo(v.y); o[3] = bfhi(v.y); o[4] = bflo(v.z); o[5] = bfhi(v.z); o[6] = bflo(v.w); o[7] = bfhi(v.w); }
__device__ __forceinline__ u32x4 pk8(const float (&o)[8]) { u32x4 w; w.x = cvt_pk_bf16(o[0], o[1]); w.y = cvt_pk_bf16(o[2], o[3]); w.z = cvt_pk_bf16(o[4], o[5]); w.w = cvt_pk_bf16(o[6], o[7]); return w; }
__device__ __forceinline__ u32x4 pk8p(const float (&o)[8]) { u32x4 w; w.x = cvt_pk_bf16_pinned(o[0], o[1]); w.y = cvt_pk_bf16_pinned(o[2], o[3]); w.z = cvt_pk_bf16_pinned(o[4], o[5]); w.w = cvt_pk_bf16_pinned(o[6], o[7]); return w; }
__device__ __forceinline__ void cvt_tile(const Ctx& c, const float* src, int ldn, int nlim, int k0, int n0, bf16_t* dst, int ldk, int drow0) {
    float* T = (float*)c.lds;
#pragma unroll
    for (int i = 0; i < 8; ++i) { const int e = c.tid + 512 * i, kk = e >> 6, nn = e & 63; T[kk * 65 + nn] = (n0 + nn < nlim) ? src[(size_t)(k0 + kk) * ldn + n0 + nn] : 0.f; }
    __syncthreads();
#pragma unroll
    for (int i = 0; i < 4; ++i) { const int e = c.tid + 512 * i, nn = e >> 5, k2 = e & 31;
        *(unsigned*)(dst + (size_t)(drow0 + nn) * ldk + k0 + 2 * k2) = cvt_pk_bf16(T[(2 * k2) * 65 + nn], T[(2 * k2 + 1) * 65 + nn]); }
    __syncthreads();
}
__device__ __forceinline__ void cvt_big(const Ctx& c, const float* src, int ldn, int nlim, int k0, int n0, bf16_t* dst, int ldk, int mode) {
    float* T = (float*)c.lds;
    f32x4 v[8];
#pragma unroll
    for (int i = 0; i < 8; ++i) { const int e4 = c.tid + 512 * i, kk = e4 >> 6, n4 = e4 & 63; v[i] = (n0 + n4 * 4 < nlim) ? *(const f32x4*)(src + (size_t)(k0 + kk) * ldn + n0 + n4 * 4) : (f32x4){0.f, 0.f, 0.f, 0.f}; }
#pragma unroll
    for (int i = 0; i < 8; ++i) { const int e4 = c.tid + 512 * i, kk = e4 >> 6, n4 = e4 & 63; float* p = T + kk * 261 + n4 * 4; p[0] = v[i][0]; p[1] = v[i][1]; p[2] = v[i][2]; p[3] = v[i][3]; }
    __syncthreads();
#pragma unroll
    for (int i = 0; i < 4; ++i) { const int e = c.tid + 512 * i, k8 = e & 7, nn = e >> 3, n = n0 + nn; float o[8];
#pragma unroll
        for (int j = 0; j < 8; ++j) o[j] = T[(8 * k8 + j) * 261 + nn];
        const int row = (mode == 0) ? n : ((n >> 7) * 256 + (mode - 1) * 128 + (n & 127));
        *(u32x4*)(dst + (size_t)row * ldk + k0 + 8 * k8) = pk8(o); }
    __syncthreads();
}
constexpr int CT_IN = 16 * 9, CT_OUT = 16 * 4, CT_W13 = 32 * 16 * 2, CT_W2 = 32 * 8 * 4, CT_UQ = 3 * 6, CT_UKV = 2 * 8, CT_POOL = 4;
constexpr int CT_TOTAL = CT_IN + CT_OUT + 2 * CT_W13 + CT_W2 + CT_UQ + CT_UKV + CT_POOL;
__device__ __forceinline__ void ph_cvt(const Ctx& c_, int l) { const Ctx c = fresh(c_);
    { const float* rgw = c.inf(I_RGW) + (size_t)l * 1024 * 4; const float* rew = c.inf(I_REW) + (size_t)l * 1024 * 32; float* rwt = c.w<float>(WS_RWT + (size_t)(l & 1) * WSET);
        for (int e = c.blk * 512 + c.tid; e < 36 * 1024; e += c.G * 512) { const int g = e >> 10, k = e & 1023; rwt[e] = (g < 4) ? rgw[k * 4 + g] : rew[k * 32 + g - 4]; } }
    for (int t = c.blk; t < CT_TOTAL; t += c.G) {
        int r = t;
        if (r < 2 * CT_W13) { const int which = r / CT_W13; r %= CT_W13; const int e = r / 32, kt = (r % 32) / 2, nt = r % 2;
            cvt_big(c, c.inf(which ? I_W3 : I_W1) + ((size_t)l * 32 + e) * 1024 * 512, 512, 512, kt * 64, nt * 256, c.w<bf16_t>(WS_WUP + (size_t)(l & 1) * WSET) + (size_t)e * 1024 * 1024, 1024, 1 + which); continue; } r -= 2 * CT_W13;
        if (r < CT_W2) { const int e = r / 32, kt = (r % 32) / 4, nt = r % 4;
            cvt_big(c, c.inf(I_W2) + ((size_t)l * 32 + e) * 512 * 1024, 1024, 1024, kt * 64, nt * 256, c.w<bf16_t>(WS_WDN + (size_t)(l & 1) * WSET) + (size_t)e * 1024 * 512, 512, 0); continue; } r -= CT_W2;
        if (r < CT_IN) { const int kt = r / 9, nt = r % 9; cvt_big(c, c.inf(I_WIN) + (size_t)l * 1024 * 2144, 2144, 2144, kt * 64, nt * 256, c.w<bf16_t>(WS_WIN + (size_t)(l & 1) * WSET), 1024, 0); continue; } r -= CT_IN;
        if (r < CT_OUT) { const int kt = r / 4, nt = r % 4; cvt_big(c, c.inf(I_WOUT) + (size_t)l * 1024 * 1024, 1024, 1024, kt * 64, nt * 256, c.w<bf16_t>(WS_WOUT + (size_t)(l & 1) * WSET), 1024, 0); continue; } r -= CT_OUT;
        if (r < CT_UQ) { const int kt = r / 6, nt = r % 6; cvt_tile(c, c.inf(I_WUQ) + (size_t)l * 192 * 384, 384, 384, kt * 64, nt * 64, c.w<bf16_t>(WS_WUQ + (size_t)(l & 1) * WSET), 192, nt * 64); continue; } r -= CT_UQ;
        if (r < CT_UKV) { const int kt = r / 8, nt = r % 8; cvt_tile(c, c.inf(I_WUKV) + (size_t)l * 128 * 512, 512, 512, kt * 64, nt * 64, c.w<bf16_t>(WS_WUKV + (size_t)(l & 1) * WSET), 128, nt * 64); continue; } r -= CT_UKV;
        cvt_tile(c, c.inf(I_WPOOL) + ((size_t)l * 4 + r) * 4096, 64, 64, 0, 0, c.w<bf16_t>(WS_WPOOL + (size_t)(l & 1) * WSET) + r * 4096, 64, 0);
    }
}
__device__ __forceinline__ void ph_normrows(const Ctx& c_, int l) { const Ctx c = fresh(c_);
    const float* xin = (l == 0) ? c.inf(I_X) : c.a->out; float* xout = c.a->out; const bf16_t* y1 = c.w<bf16_t>(WS_Y1);
    const float* gn = c.inf(I_N1G) + l * 1024; const float* mod = c.w<float>(WS_MOD) + (size_t)l * NB * 6144; bf16_t* ha = c.w<bf16_t>(WS_HA);
    for (int row0 = c.blk * 8 + c.wid; row0 < NTOK; row0 += c.G * 16) {
        f32x4 v[2][4]; float ss[2];
#pragma unroll
        for (int q = 0; q < 2; ++q) { const int row = row0 + q * c.G * 8; ss[q] = 0.f;
            if (row < NTOK) {
#pragma unroll
                for (int i = 0; i < 4; ++i) { const int col = i * 256 + c.lane * 4; v[q][i] = *(const f32x4*)(xin + (size_t)row * 1024 + col);
                    if (l > 0) { const u32x2 y = *(const u32x2*)(y1 + (size_t)row * 1024 + col); v[q][i] += (f32x4){bflo(y.x), bfhi(y.x), bflo(y.y), bfhi(y.y)}; } } } }
#pragma unroll
        for (int q = 0; q < 2; ++q) { const int row = row0 + q * c.G * 8;
            if (row < NTOK) {
#pragma unroll
                for (int i = 0; i < 4; ++i) {
                    ss[q] += v[q][i][0] * v[q][i][0] + v[q][i][1] * v[q][i][1] + v[q][i][2] * v[q][i][2] + v[q][i][3] * v[q][i][3]; } } }
        ss[0] = wave_sum(ss[0]); ss[1] = wave_sum(ss[1]);
#pragma unroll
        for (int q = 0; q < 2; ++q) { const int row = row0 + q * c.G * 8;
            if (row < NTOK) { const int b = row / SEQ; const float* sh = mod + b * 6144; const float* sc = sh + 1024; const float rinv = frsqrt(ss[q] * (1.0f / 1024.0f) + EPS);
#pragma unroll
                for (int i = 0; i < 4; ++i) { const int col = i * 256 + c.lane * 4; const f32x4 g = *(const f32x4*)(gn + col), s1 = *(const f32x4*)(sc + col), s0 = *(const f32x4*)(sh + col);
                    const f32x4 h = v[q][i] * rinv * g * (s1 + 1.0f) + s0; u32x2 o; o.x = cvt_pk_bf16(h[0], h[1]); o.y = cvt_pk_bf16(h[2], h[3]); *(u32x2*)(ha + (size_t)row * 1024 + col) = o; } } }
    }
}

#define MFMA16(a, b, c) __builtin_amdgcn_mfma_f32_16x16x32_bf16((a), (b), (c), 0, 0, 0)
#define MFMA32(a, b, c) __builtin_amdgcn_mfma_f32_32x32x16_bf16((a), (b), (c), 0, 0, 0)

__device__ __forceinline__ void mix_unit(const Ctx& c_, int l, int r0) { const Ctx c = fresh(c_);
    const bf16_t* Z = c.w<bf16_t>(WS_Z); bf16_t* Aq = (bf16_t*)c.lds; bf16_t* Akv = (bf16_t*)(c.lds + 12800); float* Lkr = (float*)(c.lds + 21504);
    float* Lu = (float*)(c.lds + 25600); bf16_t* Lp = (bf16_t*)(c.lds + 73728); float* Lcu = (float*)(c.lds + 90624); float* Lco = (float*)c.lds;
    const int s0 = r0 % SEQ, b = r0 / SEQ, fr = c.lane & 15, fq = c.lane >> 4;
    {   const int t = c.tid >> 4, sub = c.tid & 15; const bf16_t* zr = Z + (size_t)(r0 + t) * ZP;
        const u32x4 zero4 = {0u, 0u, 0u, 0u};
        const u32x4 ra0 = *(const u32x4*)(zr + Z_CQ + sub * 8), ra1 = (sub < 8) ? *(const u32x4*)(zr + Z_CQ + 128 + sub * 8) : zero4, rk0 = *(const u32x4*)(zr + Z_CKV + sub * 8), rkr = (sub < 4) ? *(const u32x4*)(zr + Z_KR + sub * 8) : zero4;
        u32x4 rp[3], rca[4], rcg[4];
#pragma unroll
        for (int i = 0; i < 3; ++i) { const int ch = c.tid + 512 * i, row = ch >> 5, c8 = ch & 31; rp[i] = (ch < 47 * 32 && s0 - 15 + row >= 0) ? *(const u32x4*)(Z + (size_t)(r0 - 15 + row) * ZP + Z_POOL + c8 * 8) : zero4; }
#pragma unroll
        for (int i = 0; i < 4; ++i) { const int ch = c.tid + 512 * i, row = ch >> 5, c8 = ch & 31; const bool ok = (ch < 62 * 32 && s0 - 30 + row >= 0);
            rca[i] = ok ? *(const u32x4*)(Z + (size_t)(r0 - 30 + row) * ZP + Z_CA + c8 * 8) : zero4; rcg[i] = ok ? *(const u32x4*)(Z + (size_t)(r0 - 30 + row) * ZP + Z_CG + c8 * 8) : zero4; }
        auto un8 = [](const u32x4 v, float (&o)[8]) { o[0] = bflo(v.x); o[1] = bfhi(v.x); o[2] = bflo(v.y); o[3] = bfhi(v.y); o[4] = bflo(v.z); o[5] = bfhi(v.z); o[6] = bflo(v.w); o[7] = bfhi(v.w); };
        const float* qag = c.inf(I_QAG) + l * 192; const float* kvag = c.inf(I_KVAG) + l * 128;
        float a0[8], a1[8], k0[8]; float ssq = 0.f, ssk = 0.f; un8(ra0, a0); un8(ra1, a1); un8(rk0, k0);
#pragma unroll
        for (int j = 0; j < 8; ++j) { ssq += a0[j] * a0[j] + a1[j] * a1[j]; ssk += k0[j] * k0[j]; }
#pragma unroll
        for (int m = 1; m < 16; m <<= 1) { ssq += __shfl_xor(ssq, m); ssk += __shfl_xor(ssk, m); }
        const float rq = frsqrt(ssq * (1.0f / 192.0f) + EPS), rk = frsqrt(ssk * (1.0f / 128.0f) + EPS);
#pragma unroll
        for (int j = 0; j < 8; ++j) a0[j] *= rq * qag[sub * 8 + j];
        *(u32x4*)(Aq + t * 200 + sub * 8) = pk8(a0);
        if (sub < 8) {
#pragma unroll
            for (int j = 0; j < 8; ++j) a1[j] *= rq * qag[128 + sub * 8 + j];
            *(u32x4*)(Aq + t * 200 + 128 + sub * 8) = pk8(a1); }
#pragma unroll
        for (int j = 0; j < 8; ++j) k0[j] *= rk * kvag[sub * 8 + j];
        *(u32x4*)(Akv + t * 136 + sub * 8) = pk8(k0);
        if (sub < 4) { float kr[8]; un8(rkr, kr);
#pragma unroll
            for (int j = 0; j < 8; ++j) Lkr[t * 32 + sub * 8 + j] = kr[j]; }
#pragma unroll
        for (int i = 0; i < 3; ++i) { const int ch = c.tid + 512 * i, row = ch >> 5, c8 = ch & 31; if (ch < 47 * 32) { float v[8]; un8(rp[i], v);
            *(f32x4*)(Lu + row * 256 + c8 * 8) = (f32x4){v[0], v[1], v[2], v[3]}; *(f32x4*)(Lu + row * 256 + c8 * 8 + 4) = (f32x4){v[4], v[5], v[6], v[7]}; } }
#pragma unroll
        for (int i = 0; i < 4; ++i) { const int ch = c.tid + 512 * i, row = ch >> 5, c8 = ch & 31; if (ch < 62 * 32) { float a[8], g[8]; un8(rca[i], a); un8(rcg[i], g);
#pragma unroll
            for (int j = 0; j < 8; ++j) a[j] *= fsigmoid(g[j]);
            *(f32x4*)(Lcu + row * 256 + c8 * 8) = (f32x4){a[0], a[1], a[2], a[3]}; *(f32x4*)(Lcu + row * 256 + c8 * 8 + 4) = (f32x4){a[4], a[5], a[6], a[7]}; } }
    }
    __syncthreads();
    const float* rcos = c.w<float>(WS_ROPE); const float* rsin = rcos + (size_t)NTOK * 16;
    if (c.wid < 4) {
        const int h = c.wid; const bf16_t* W = c.w<bf16_t>(WS_WUQ + (size_t)(l & 1) * WSET) + (size_t)(96 * h) * 192; const float* qg = c.inf(I_QG) + l * 96;
        f32x4 acc[6][2];
#pragma unroll
        for (int nf = 0; nf < 6; ++nf) { acc[nf][0] = (f32x4){0.f, 0.f, 0.f, 0.f}; acc[nf][1] = acc[nf][0]; }
#pragma unroll 3
        for (int ks = 0; ks < 6; ++ks) { bf16x8 af[2];
#pragma unroll
            for (int mf = 0; mf < 2; ++mf) af[mf] = *(const bf16x8*)(Aq + (mf * 16 + fr) * 200 + ks * 32 + fq * 8);
#pragma unroll
            for (int nf = 0; nf < 6; ++nf) { const bf16x8 bfr = *(const bf16x8*)(W + (size_t)(16 * nf + fr) * 192 + ks * 32 + fq * 8);
                acc[nf][0] = MFMA16(bfr, af[0], acc[nf][0]); acc[nf][1] = MFMA16(bfr, af[1], acc[nf][1]); } }
#pragma unroll
        for (int mf = 0; mf < 2; ++mf) { float ss = 0.f;
#pragma unroll
            for (int nf = 0; nf < 6; ++nf)
#pragma unroll
                for (int j = 0; j < 4; ++j) ss += acc[nf][mf][j] * acc[nf][mf][j];
            ss += __shfl_xor(ss, 16); ss += __shfl_xor(ss, 32);
            const float rinv = frsqrt(ss * (1.0f / 96.0f) + EPS) * (0.10206207261596575f * 1.44269504089f);
            const int tok = r0 + mf * 16 + fr; bf16_t* qo = c.w<bf16_t>(WS_Q) + ((size_t)(b * 4 + h) * SEQ + s0 + mf * 16 + fr) * 96;
            float v[6][4];
#pragma unroll
            for (int nf = 0; nf < 6; ++nf)
#pragma unroll
                for (int j = 0; j < 4; ++j) v[nf][j] = acc[nf][mf][j] * rinv * qg[16 * nf + 4 * fq + j];
            const f32x4 cs4 = *(const f32x4*)(rcos + (size_t)tok * 16 + 4 * fq), sn4 = *(const f32x4*)(rsin + (size_t)tok * 16 + 4 * fq);
#pragma unroll
            for (int j = 0; j < 4; ++j) { const float x1 = v[4][j], x2 = v[5][j]; v[4][j] = x1 * cs4[j] - x2 * sn4[j]; v[5][j] = x1 * sn4[j] + x2 * cs4[j]; }
#pragma unroll
            for (int nf = 0; nf < 6; ++nf) { u32x2 o; o.x = cvt_pk_bf16(v[nf][0], v[nf][1]); o.y = cvt_pk_bf16(v[nf][2], v[nf][3]); *(u32x2*)(qo + 16 * nf + 4 * fq) = o; } }
    } else {
        const int h = c.wid - 4; const bf16_t* W = c.w<bf16_t>(WS_WUKV + (size_t)(l & 1) * WSET) + (size_t)(128 * h) * 128; const float* kg = c.inf(I_KG) + l * 96;
        f32x4 ak[4][2], av[4][2];
#pragma unroll
        for (int nf = 0; nf < 4; ++nf) { ak[nf][0] = (f32x4){0.f, 0.f, 0.f, 0.f}; ak[nf][1] = ak[nf][0]; av[nf][0] = ak[nf][0]; av[nf][1] = ak[nf][0]; }
#pragma unroll 2
        for (int ks = 0; ks < 4; ++ks) { bf16x8 af[2];
#pragma unroll
            for (int mf = 0; mf < 2; ++mf) af[mf] = *(const bf16x8*)(Akv + (mf * 16 + fr) * 136 + ks * 32 + fq * 8);
#pragma unroll
            for (int nf = 0; nf < 4; ++nf) { const bf16x8 bk = *(const bf16x8*)(W + (size_t)(16 * nf + fr) * 128 + ks * 32 + fq * 8), bv = *(const bf16x8*)(W + (size_t)(64 + 16 * nf + fr) * 128 + ks * 32 + fq * 8);
                ak[nf][0] = MFMA16(bk, af[0], ak[nf][0]); ak[nf][1] = MFMA16(bk, af[1], ak[nf][1]);
                av[nf][0] = MFMA16(af[0], bv, av[nf][0]); av[nf][1] = MFMA16(af[1], bv, av[nf][1]); } }
#pragma unroll
        for (int mf = 0; mf < 2; ++mf) { const int tl = mf * 16 + fr; float ss = 0.f;
#pragma unroll
            for (int nf = 0; nf < 4; ++nf)
#pragma unroll
                for (int j = 0; j < 4; ++j) ss += ak[nf][mf][j] * ak[nf][mf][j];
#pragma unroll
            for (int j = 0; j < 8; ++j) { const float kr = Lkr[tl * 32 + fq * 8 + j]; ss += kr * kr; }
            ss += __shfl_xor(ss, 16); ss += __shfl_xor(ss, 32);
            const float rinv = frsqrt(ss * (1.0f / 96.0f) + EPS);
            const int tok = r0 + tl; bf16_t* ko = c.w<bf16_t>(WS_K) + ((size_t)(b * 4 + h) * SEQ + s0 + tl) * 96;
#pragma unroll
            for (int nf = 0; nf < 4; ++nf) { u32x2 o; o.x = cvt_pk_bf16(ak[nf][mf][0] * rinv * kg[16 * nf + 4 * fq], ak[nf][mf][1] * rinv * kg[16 * nf + 4 * fq + 1]);
                o.y = cvt_pk_bf16(ak[nf][mf][2] * rinv * kg[16 * nf + 4 * fq + 2], ak[nf][mf][3] * rinv * kg[16 * nf + 4 * fq + 3]); *(u32x2*)(ko + 16 * nf + 4 * fq) = o; }
            const f32x4 cs4 = *(const f32x4*)(rcos + (size_t)tok * 16 + 4 * fq), sn4 = *(const f32x4*)(rsin + (size_t)tok * 16 + 4 * fq);
            float o1[4], o2[4];
#pragma unroll
            for (int j = 0; j < 4; ++j) { const int i = 4 * fq + j; const float x1 = Lkr[tl * 32 + i] * rinv * kg[64 + i], x2 = Lkr[tl * 32 + 16 + i] * rinv * kg[80 + i];
                o1[j] = x1 * cs4[j] - x2 * sn4[j]; o2[j] = x1 * sn4[j] + x2 * cs4[j]; }
            { u32x2 o; o.x = cvt_pk_bf16(o1[0], o1[1]); o.y = cvt_pk_bf16(o1[2], o1[3]); *(u32x2*)(ko + 64 + 4 * fq) = o; o.x = cvt_pk_bf16(o2[0], o2[1]); o.y = cvt_pk_bf16(o2[2], o2[3]); *(u32x2*)(ko + 80 + 4 * fq) = o; }
            bf16_t* vo = c.w<bf16_t>(WS_VT) + (size_t)(b * 4 + h) * 64 * SEQ + s0 + mf * 16 + 4 * fq;
#pragma unroll
            for (int nf = 0; nf < 4; ++nf) { u32x2 o; o.x = cvt_pk_bf16(av[nf][mf][0], av[nf][mf][1]); o.y = cvt_pk_bf16(av[nf][mf][2], av[nf][mf][3]); *(u32x2*)(vo + (size_t)(16 * nf + fr) * SEQ) = o; } }
    }
    { const int t = c.tid >> 4, sub = c.tid & 15, g = sub >> 2, w = 2 << g, s = s0 + t; const float inv = 1.0f / (float)((s + 1 < w) ? (s + 1) : w);
#pragma unroll
        for (int k = 0; k < 2; ++k) { const int col = sub * 16 + k * 8; float sum[8];
#pragma unroll
            for (int j = 0; j < 8; ++j) sum[j] = 0.f;
            for (int d = 0; d < w; ++d) { const float* p = Lu + (t + 15 - d) * 256 + col;
#pragma unroll
                for (int j = 0; j < 8; ++j) sum[j] += p[j]; }
            const float* p0 = Lu + (t + 15) * 256 + col;
#pragma unroll
            for (int j = 0; j < 8; ++j) sum[j] = sum[j] * inv - p0[j];
            *(u32x4*)(Lp + t * 264 + col) = pk8(sum); } }
    float cres[16];
    { const int chn = c.tid & 255, half = c.tid >> 8; const float* dw = c.inf(I_DWW) + (size_t)l * 31 * 256 + chn; const float bias = c.inf(I_DWB)[l * 256 + chn];
        float wv[31];
#pragma unroll
        for (int j = 0; j < 31; ++j) wv[j] = dw[j * 256];
#pragma unroll
        for (int tt = 0; tt < 16; ++tt) cres[tt] = bias;
#pragma unroll
        for (int r = 0; r < 46; ++r) { const float u = Lcu[(half * 16 + r) * 256 + chn];
#pragma unroll
            for (int tt = 0; tt < 16; ++tt) { const int j = r - tt; if (j >= 0 && j < 31) cres[tt] += wv[j] * u; } } }
    __syncthreads();
    { const int g = c.wid >> 1, mf = c.wid & 1; const bf16_t* W = c.w<bf16_t>(WS_WPOOL + (size_t)(l & 1) * WSET) + g * 4096; const float* ps = c.inf(I_PSCALE) + l * 256 + g * 64;
        f32x4 acc[4];
#pragma unroll
        for (int nf = 0; nf < 4; ++nf) acc[nf] = (f32x4){0.f, 0.f, 0.f, 0.f};
#pragma unroll
        for (int ks = 0; ks < 2; ++ks) { const bf16x8 af = *(const bf16x8*)(Lp + (mf * 16 + fr) * 264 + g * 64 + ks * 32 + fq * 8);
#pragma unroll
            for (int nf = 0; nf < 4; ++nf) { const bf16x8 bfr = *(const bf16x8*)(W + (16 * nf + fr) * 64 + ks * 32 + fq * 8); acc[nf] = MFMA16(bfr, af, acc[nf]); } }
        bf16_t* yo = c.w<bf16_t>(WS_YB) + (size_t)(r0 + mf * 16 + fr) * 1024 + 256 + g * 64;
#pragma unroll
        for (int nf = 0; nf < 4; ++nf) { const int d = 16 * nf + 4 * fq; u32x2 o; o.x = cvt_pk_bf16(acc[nf][0] * ps[d], acc[nf][1] * ps[d + 1]); o.y = cvt_pk_bf16(acc[nf][2] * ps[d + 2], acc[nf][3] * ps[d + 3]); *(u32x2*)(yo + d) = o; } }
    { const int chn = c.tid & 255, half = c.tid >> 8;
#pragma unroll
        for (int tt = 0; tt < 16; ++tt) Lco[(half * 16 + tt) * 256 + chn] = cres[tt]; }
    __syncthreads();
    { const float* lg = c.inf(I_LNG) + l * 256 + c.lane * 4; const float* lb = c.inf(I_LNB) + l * 256 + c.lane * 4;
#pragma unroll
        for (int k = 0; k < 4; ++k) { const int t = c.wid * 4 + k; const f32x4 v = *(const f32x4*)(Lco + t * 256 + c.lane * 4);
            const float mean = wave_sum(v[0] + v[1] + v[2] + v[3]) * (1.0f / 256.0f); const f32x4 d = v - mean;
            const float var = wave_sum(d[0] * d[0] + d[1] * d[1] + d[2] * d[2] + d[3] * d[3]) * (1.0f / 256.0f); const float rs = frsqrt(var + EPS);
            float y[4];
#pragma unroll
            for (int j = 0; j < 4; ++j) y[j] = fsilu(d[j] * rs * lg[j] + lb[j]);
            u32x2 o; o.x = cvt_pk_bf16(y[0], y[1]); o.y = cvt_pk_bf16(y[2], y[3]); *(u32x2*)(c.w<bf16_t>(WS_YB) + (size_t)(r0 + t) * 1024 + 768 + c.lane * 4) = o; } }
    __syncthreads();
}

constexpr int CW_W13 = 32 * 16 * 16, CW_W2 = 32 * 8 * 32, CW_IN = 16 * 72, CW_OUT = 16 * 32, CW_UQ = 3 * 12, CW_UKV = 2 * 16, CW_POOL = 4 * 2;
constexpr int CW_TOTAL = 2 * CW_W13 + CW_W2 + CW_IN + CW_OUT + CW_UQ + CW_UKV + CW_POOL;
struct CvtTile { const float* src; bf16_t* dst; int ldn, ldk; };
__device__ __forceinline__ void cvt_decode(const Ctx& c, int l, int t, CvtTile& d) {
    const size_t wso = (size_t)(l & 1) * WSET; int r = t;
    if (r < 2 * CW_W13) { const int which = r / CW_W13; r %= CW_W13; const int e = r >> 8, kt = (r >> 4) & 15, nt = r & 15, n0 = nt * 32;
        d.src = c.inf(which ? I_W3 : I_W1) + ((size_t)l * 32 + e) * 1024 * 512 + (size_t)kt * 64 * 512 + n0; d.ldn = 512; d.ldk = 1024;
        d.dst = c.w<bf16_t>(WS_WUP + wso) + (size_t)e * 1024 * 1024 + (size_t)((n0 >> 7) * 256 + which * 128 + (n0 & 127)) * 1024 + kt * 64; return; } r -= 2 * CW_W13;
    if (r < CW_W2) { const int e = r >> 8, kt = (r >> 5) & 7, nt = r & 31;
        d.src = c.inf(I_W2) + ((size_t)l * 32 + e) * 512 * 1024 + (size_t)kt * 64 * 1024 + nt * 32; d.ldn = 1024; d.ldk = 512;
        d.dst = c.w<bf16_t>(WS_WDN + wso) + (size_t)e * 1024 * 512 + (size_t)(nt * 32) * 512 + kt * 64; return; } r -= CW_W2;
    if (r < CW_IN) { const int kt = r / 72, nt = r % 72; d.src = (nt < 67) ? c.inf(I_WIN) + (size_t)l * 1024 * 2144 + (size_t)kt * 64 * 2144 + nt * 32 : nullptr; d.ldn = 2144; d.ldk = 1024;
        d.dst = c.w<bf16_t>(WS_WIN + wso) + (size_t)(nt * 32) * 1024 + kt * 64; return; } r -= CW_IN;
    if (r < CW_OUT) { const int kt = r >> 5, nt = r & 31; d.src = c.inf(I_WOUT) + (size_t)l * 1024 * 1024 + (size_t)kt * 64 * 1024 + nt * 32; d.ldn = 1024; d.ldk = 1024;
        d.dst = c.w<bf16_t>(WS_WOUT + wso) + (size_t)(nt * 32) * 1024 + kt * 64; return; } r -= CW_OUT;
    if (r < CW_UQ) { const int kt = r / 12, nt = r % 12; d.src = c.inf(I_WUQ) + (size_t)l * 192 * 384 + (size_t)kt * 64 * 384 + nt * 32; d.ldn = 384; d.ldk = 192;
        d.dst = c.w<bf16_t>(WS_WUQ + wso) + (size_t)(nt * 32) * 192 + kt * 64; return; } r -= CW_UQ;
    if (r < CW_UKV) { const int kt = r >> 4, nt = r & 15; d.src = c.inf(I_WUKV) + (size_t)l * 128 * 512 + (size_t)kt * 64 * 512 + nt * 32; d.ldn = 512; d.ldk = 128;
        d.dst = c.w<bf16_t>(WS_WUKV + wso) + (size_t)(nt * 32) * 128 + kt * 64; return; } r -= CW_UKV;
    { const int g = r >> 1, nt = r & 1; d.src = c.inf(I_WPOOL) + ((size_t)l * 4 + g) * 4096 + nt * 32; d.ldn = 64; d.ldk = 64; d.dst = c.w<bf16_t>(WS_WPOOL + wso) + g * 4096 + (size_t)(nt * 32) * 64; }
}
__device__ __forceinline__ void cvt_wave(const Ctx& c, int l, int wrank, int nwaves, float* T) {
    { const float* rgw = c.inf(I_RGW) + (size_t)l * 1024 * 4; const float* rew = c.inf(I_REW) + (size_t)l * 1024 * 32; float* rwt = c.w<float>(WS_RWT + (size_t)(l & 1) * WSET);
        for (int e = wrank * 64 + c.lane; e < 36 * 1024; e += nwaves * 64) { const int g = e >> 10, k = e & 1023; rwt[e] = (g < 4) ? rgw[k * 4 + g] : rew[k * 32 + g - 4]; } }
    f32x4 v[8]; CvtTile cur; cur.src = nullptr; cur.dst = nullptr; cur.ldn = 0; cur.ldk = 0;
    auto issue = [&](const CvtTile& d) {
#pragma unroll
        for (int i = 0; i < 8; ++i) { const int e4 = c.lane + 64 * i, kk = e4 >> 3, n4 = e4 & 7; v[i] = d.src ? *(const f32x4*)(d.src + (size_t)kk * d.ldn + n4 * 4) : (f32x4){0.f, 0.f, 0.f, 0.f}; } };
    int t = wrank;
    if (t < CW_TOTAL) { cvt_decode(c, l, t, cur); issue(cur); }
    while (t < CW_TOTAL) {
#pragma unroll
        for (int i = 0; i < 8; ++i) { const int e4 = c.lane + 64 * i, kk = e4 >> 3, n4 = e4 & 7; float* p = T + kk * 33 + n4 * 4; p[0] = v[i][0]; p[1] = v[i][1]; p[2] = v[i][2]; p[3] = v[i][3]; }
        const int tn = t + nwaves; CvtTile nxt = cur; if (tn < CW_TOTAL) { cvt_decode(c, l, tn, nxt); issue(nxt); }
        __builtin_amdgcn_wave_barrier();
        { const int n = c.lane & 31, kh = c.lane >> 5; bf16_t* drow = cur.dst + (size_t)n * cur.ldk + kh * 32;
#pragma unroll
            for (int q = 0; q < 4; ++q) { float o[8];
#pragma unroll
                for (int j = 0; j < 8; ++j) o[j] = T[(kh * 32 + q * 8 + j) * 33 + n];
                *(u32x4*)(drow + q * 8) = pk8(o); } }
        __builtin_amdgcn_wave_barrier();
        t = tn; cur = nxt;
    }
}

#ifdef EMU
static inline float __builtin_amdgcn_logf(float x) { return log2f(x); }
#endif
constexpr int HGP = 68, HGV = 40;
constexpr int HG_LG = 0, HG_LK = 8704, HG_LQ = 17408, HG_LVT = 26112, HG_LEG = 31232, HG_LGG = 31488, HG_BYTES = 31744;
template <bool OUT> __device__ __forceinline__ void hgrn_mfma(const Ctx& c_, int l, int bu, int cvt_layer = NL) { const Ctx c = fresh(c_);
    if (c.wid < 4) {
        const int cu = bu * 4 + c.wid, bh = cu / NCH, chunk = cu % NCH, b = bh >> 2, h = bh & 3, tok0 = b * SEQ + chunk * 128;
        const bf16_t* Z = c.w<bf16_t>(WS_Z); const float lbd = c.w<float>(WS_LB)[l * 256 + h * 64 + c.lane];
        unsigned char* L = c.lds + c.wid * HG_BYTES; float* Lg = (float*)(L + HG_LG); float* Lk = (float*)(L + HG_LK); float* Lq = (float*)(L + HG_LQ); bf16_t* Lvt = (bf16_t*)(L + HG_LVT); float* LeG = (float*)(L + HG_LEG); float* LG = (float*)(L + HG_LGG);
        const int l31 = c.lane & 31, hi = c.lane >> 5;
        f32x16 S[2][2];
        if (OUT) { const float* s0 = c.w<float>(WS_S0) + (size_t)(bh * NCH + chunk) * 4096;
#pragma unroll
            for (int mf = 0; mf < 2; ++mf)
#pragma unroll
                for (int nf = 0; nf < 2; ++nf)
#pragma unroll
                    for (int r = 0; r < 16; ++r) S[mf][nf][r] = s0[(32 * mf + (r & 3) + 8 * (r >> 2) + 4 * hi) * 64 + 32 * nf + l31]; }
        else {
#pragma unroll
            for (int mf = 0; mf < 2; ++mf)
#pragma unroll
                for (int nf = 0; nf < 2; ++nf)
#pragma unroll
                    for (int r = 0; r < 16; ++r) S[mf][nf][r] = 0.f; }
        float gtot = 0.f; const float og0 = OUT ? c.inf(I_HOG)[l * 64 + l31] : 0.f, og1 = OUT ? c.inf(I_HOG)[l * 64 + 32 + l31] : 0.f;
        u32x4 rf[4], rq[4], rv[4];
        { const bf16_t* zn = Z + (size_t)(tok0 + (c.lane >> 3)) * ZP + h * 64 + (c.lane & 7) * 8;
#pragma unroll
            for (int i = 0; i < 4; ++i) { rf[i] = *(const u32x4*)(zn + (size_t)i * 8 * ZP + Z_HF); rv[i] = *(const u32x4*)(zn + (size_t)i * 8 * ZP + Z_HI); if (OUT) rq[i] = *(const u32x4*)(zn + (size_t)i * 8 * ZP + Z_HQ); else rq[i] = (u32x4){0u, 0u, 0u, 0u}; } }
#pragma unroll 1
        for (int sc = 0; sc < 4; ++sc) { const int tokb = tok0 + sc * 32;
            {
                const int rr = c.lane >> 3, c8 = (c.lane & 7) * 8;
#pragma unroll
                for (int i = 0; i < 4; ++i) { const int tr = i * 8 + rr; float x[8];
                    { const u32x4 v = rf[i]; x[0] = bflo(v.x); x[1] = bfhi(v.x); x[2] = bflo(v.y); x[3] = bfhi(v.y); x[4] = bflo(v.z); x[5] = bfhi(v.z); x[6] = bflo(v.w); x[7] = bfhi(v.w); }
                    *(f32x4*)(Lg + tr * HGP + c8) = (f32x4){x[0], x[1], x[2], x[3]}; *(f32x4*)(Lg + tr * HGP + c8 + 4) = (f32x4){x[4], x[5], x[6], x[7]};
                    if (OUT) { const u32x4 v = rq[i]; x[0] = fsilu(bflo(v.x)); x[1] = fsilu(bfhi(v.x)); x[2] = fsilu(bflo(v.y)); x[3] = fsilu(bfhi(v.y)); x[4] = fsilu(bflo(v.z)); x[5] = fsilu(bfhi(v.z)); x[6] = fsilu(bflo(v.w)); x[7] = fsilu(bfhi(v.w));
                        *(f32x4*)(Lq + tr * HGP + c8) = (f32x4){x[0], x[1], x[2], x[3]}; *(f32x4*)(Lq + tr * HGP + c8 + 4) = (f32x4){x[4], x[5], x[6], x[7]}; }
                    { const u32x4 v = rv[i]; const unsigned w4[4] = {v.x, v.y, v.z, v.w};
#pragma unroll
                        for (int k = 0; k < 4; ++k) { Lvt[(c8 + 2 * k) * HGV + tr] = (bf16_t)(w4[k] & 0xffffu); Lvt[(c8 + 2 * k + 1) * HGV + tr] = (bf16_t)(w4[k] >> 16); } } }
                if (sc < 3) { const bf16_t* zn = Z + (size_t)(tokb + 32 + rr) * ZP + h * 64 + c8;
#pragma unroll
                    for (int i = 0; i < 4; ++i) { rf[i] = *(const u32x4*)(zn + (size_t)i * 8 * ZP + Z_HF); rv[i] = *(const u32x4*)(zn + (size_t)i * 8 * ZP + Z_HI); if (OUT) rq[i] = *(const u32x4*)(zn + (size_t)i * 8 * ZP + Z_HQ); } }
                __builtin_amdgcn_wave_barrier();
                float run = 0.f;
#pragma unroll
                for (int t = 0; t < 32; ++t) { const float f = lbd + (1.0f - lbd) * fsigmoid(Lg[t * HGP + c.lane]); run += __builtin_amdgcn_logf(f); Lg[t * HGP + c.lane] = run; Lk[t * HGP + c.lane] = 1.0f - f; }
                LG[c.lane] = run; LeG[c.lane] = __builtin_amdgcn_exp2f(run); gtot += run;
            }
            __builtin_amdgcn_wave_barrier();
            bf16x8 vt[2][2];
#pragma unroll
            for (int nf = 0; nf < 2; ++nf)
#pragma unroll
                for (int ks = 0; ks < 2; ++ks) vt[nf][ks] = *(const bf16x8*)(Lvt + (32 * nf + l31) * HGV + 16 * ks + 8 * hi);
            f32x16 O[2];
            if (OUT) {
#pragma unroll
                for (int r = 0; r < 16; ++r) { O[0][r] = 0.f; O[1][r] = 0.f; }
                float acc[8];
#pragma unroll
                for (int m = 0; m < 8; ++m) acc[m] = 0.f;
                const int sb = (l31 & 16) + 8 * hi;
#pragma unroll 1
                for (int d4 = 0; d4 < 16; ++d4) { const f32x4 qt = *(const f32x4*)(Lq + l31 * HGP + 4 * d4), gt = *(const f32x4*)(Lg + l31 * HGP + 4 * d4);
#pragma unroll
                    for (int mg = 0; mg < 4; ++mg) {
                        f32x4 k4[2], g4[2];
#pragma unroll
                        for (int j = 0; j < 2; ++j) { const int s = sb + 2 * mg + j; k4[j] = *(const f32x4*)(Lk + s * HGP + 4 * d4); g4[j] = *(const f32x4*)(Lg + s * HGP + 4 * d4); }
                        __builtin_amdgcn_sched_barrier(0);
#pragma unroll
                        for (int j = 0; j < 2; ++j)
#pragma unroll
                            for (int e = 0; e < 4; ++e) acc[mg * 2 + j] += qt[e] * k4[j][e] * __builtin_amdgcn_exp2f(gt[e] - g4[j][e]);
                        __builtin_amdgcn_sched_barrier(0); } }
                bf16x8 af[2], afx;
                { float a8[8];
#pragma unroll
                    for (int j = 0; j < 8; ++j) a8[j] = (sb + j <= l31) ? acc[j] : 0.f;
                    const bf16x8 ad = __builtin_bit_cast(bf16x8, pk8p(a8)), az = (bf16x8){0, 0, 0, 0, 0, 0, 0, 0};
                    af[0] = (l31 < 16) ? ad : az; af[1] = (l31 < 16) ? az : ad; }
                {
                    f32x16 dx;
#pragma unroll
                    for (int r = 0; r < 16; ++r) dx[r] = 0.f;
                    const bool lowr = l31 < 16; const float* Lx = lowr ? Lk : Lq;
#pragma unroll
                    for (int kk = 0; kk < 4; ++kk) { const int d0 = 16 * kk + 8 * hi;
                        const f32x4 xa = *(const f32x4*)(Lx + l31 * HGP + d0), xb = *(const f32x4*)(Lx + l31 * HGP + d0 + 4), ga = *(const f32x4*)(Lg + l31 * HGP + d0), gb = *(const f32x4*)(Lg + l31 * HGP + d0 + 4),
                                    ma = *(const f32x4*)(Lg + 15 * HGP + d0), mb = *(const f32x4*)(Lg + 15 * HGP + d0 + 4);
                        float v8[8];
#pragma unroll
                        for (int j = 0; j < 4; ++j) { const float da = ga[j] - ma[j], db = gb[j] - mb[j];
                            v8[j] = xa[j] * __builtin_amdgcn_exp2f(lowr ? -da : da); v8[4 + j] = xb[j] * __builtin_amdgcn_exp2f(lowr ? -db : db); }
                        const bf16x8 vv = __builtin_bit_cast(bf16x8, pk8p(v8)), zz = (bf16x8){0, 0, 0, 0, 0, 0, 0, 0};
                        dx = MFMA32(lowr ? vv : zz, lowr ? zz : vv, dx); }
                    float x8[8];
#pragma unroll
                    for (int j = 0; j < 8; ++j) x8[j] = dx[j];
                    afx = __builtin_bit_cast(bf16x8, pk8(x8)); }
#pragma unroll
                for (int mf = 0; mf < 2; ++mf)
#pragma unroll
                    for (int s = 0; s < 2; ++s) { const int d0 = 32 * mf + 16 * s + 4 * hi;
                        const f32x4 qa = *(const f32x4*)(Lq + l31 * HGP + d0), qb = *(const f32x4*)(Lq + l31 * HGP + d0 + 8), ga = *(const f32x4*)(Lg + l31 * HGP + d0), gb = *(const f32x4*)(Lg + l31 * HGP + d0 + 8);
                        float q8[8];
#pragma unroll
                        for (int j = 0; j < 4; ++j) { q8[j] = qa[j] * __builtin_amdgcn_exp2f(ga[j]); q8[4 + j] = qb[j] * __builtin_amdgcn_exp2f(gb[j]); }
                        const bf16x8 qf = __builtin_bit_cast(bf16x8, pk8p(q8));
#pragma unroll
                        for (int nf = 0; nf < 2; ++nf) { float s8[8];
#pragma unroll
                            for (int j = 0; j < 8; ++j) s8[j] = S[mf][nf][8 * s + j];
                            O[nf] = MFMA32(qf, __builtin_bit_cast(bf16x8, pk8p(s8)), O[nf]); } }
#pragma unroll
                for (int nf = 0; nf < 2; ++nf) {
#pragma unroll
                    for (int ks = 0; ks < 2; ++ks) O[nf] = MFMA32(af[ks], vt[nf][ks], O[nf]);
                    const s16x4 p0 = *(const s16x4*)(Lvt + (32 * nf + l31) * HGV + 4 * hi), p1 = *(const s16x4*)(Lvt + (32 * nf + l31) * HGV + 8 + 4 * hi);
                    O[nf] = MFMA32(afx, ((bf16x8){p0[0], p0[1], p0[2], p0[3], p1[0], p1[1], p1[2], p1[3]}), O[nf]); }
            }
#pragma unroll
            for (int mf = 0; mf < 2; ++mf) {
#pragma unroll
                for (int q = 0; q < 4; ++q) { const f32x4 e4 = *(const f32x4*)(LeG + 32 * mf + 8 * q + 4 * hi);
#pragma unroll
                    for (int e = 0; e < 4; ++e) { S[mf][0][4 * q + e] *= e4[e]; S[mf][1][4 * q + e] *= e4[e]; } }
                const int d = 32 * mf + l31; const float Gd = LG[d];
#pragma unroll
                for (int ks = 0; ks < 2; ++ks) { float k8[8];
#pragma unroll
                    for (int j = 0; j < 8; ++j) { const int s = 16 * ks + 8 * hi + j; k8[j] = Lk[s * HGP + d] * __builtin_amdgcn_exp2f(Gd - Lg[s * HGP + d]); }
                    const bf16x8 kf = __builtin_bit_cast(bf16x8, pk8p(k8));
                    S[mf][0] = MFMA32(kf, vt[0][ks], S[mf][0]); S[mf][1] = MFMA32(kf, vt[1][ks], S[mf][1]); } }
            if (OUT) {
                {
                    const int rr = c.lane >> 3, c8 = (c.lane & 7) * 8; const bf16_t* zg = Z + (size_t)(tokb + rr) * ZP + Z_HG + h * 64 + c8; u32x2 gv[4];
#pragma unroll
                    for (int hf = 0; hf < 2; ++hf) {
#pragma unroll
                    for (int i = 0; i < 4; ++i) gv[i] = *(const u32x2*)(zg + (size_t)i * 8 * ZP + 4 * hf);
#pragma unroll
                    for (int i = 0; i < 4; ++i) { const u32x2 v = gv[i]; *(f32x4*)(Lq + (i * 8 + rr) * HGP + c8 + 4 * hf) = (f32x4){fsilu(bflo(v.x)), fsilu(bfhi(v.x)), fsilu(bflo(v.y)), fsilu(bfhi(v.y))}; } }
                }
                __builtin_amdgcn_wave_barrier();
#pragma unroll
                for (int r = 0; r < 16; ++r) { const int tl = (r & 3) + 8 * (r >> 2) + 4 * hi; float ss = O[0][r] * O[0][r] + O[1][r] * O[1][r];
                    ss = half_sum(ss, hi);
                    const float rinv = frsqrt(ss * (1.0f / 64.0f) + EPS); const size_t tok = (size_t)(tokb + tl);
                    const float g0 = Lq[tl * HGP + l31], g1 = Lq[tl * HGP + 32 + l31];
                    bf16_t* yo = c.w<bf16_t>(WS_YB) + tok * 1024 + 512 + h * 64;
                    yo[l31] = (bf16_t)f2bf_bits(O[0][r] * rinv * og0 * g0); yo[32 + l31] = (bf16_t)f2bf_bits(O[1][r] * rinv * og1 * g1); } }
            __builtin_amdgcn_wave_barrier();
        }
        if (!OUT) { float* sc = c.w<float>(WS_SC) + (size_t)(bh * NCH + chunk) * 4096;
#pragma unroll
            for (int mf = 0; mf < 2; ++mf)
#pragma unroll
                for (int nf = 0; nf < 2; ++nf)
#pragma unroll
                    for (int r = 0; r < 16; ++r) sc[(32 * mf + (r & 3) + 8 * (r >> 2) + 4 * hi) * 64 + 32 * nf + l31] = S[mf][nf][r];
            c.w<float>(WS_PC)[(size_t)(bh * NCH + chunk) * 64 + c.lane] = __builtin_amdgcn_exp2f(gtot); }
    } else if (OUT && cvt_layer < NL) {
        cvt_wave(c, cvt_layer, bu * 4 + (c.wid - 4), NBH * NCH, (float*)(c.lds + 4 * HG_BYTES + (c.wid - 4) * 8448));
    }
    __syncthreads();
}
__device__ __forceinline__ void hgrn_carry(const Ctx& c_, int l) { const Ctx c = fresh(c_);
    const float* SC = c.w<float>(WS_SC); const float* PC = c.w<float>(WS_PC); float* S0 = c.w<float>(WS_S0);
    for (int e = c.blk * 512 + c.tid; e < NBH * 4096; e += c.G * 512) { const int bh = e >> 12, dv = e & 4095, d = dv >> 6; float s = 0.f;
#pragma unroll 8
        for (int ch = 0; ch < NCH; ++ch) { const size_t o = (size_t)(bh * NCH + ch) * 4096 + dv; S0[o] = s; s = PC[(size_t)(bh * NCH + ch) * 64 + d] * s + SC[o]; } }
    ASMV("s_waitcnt vmcnt(0)" ::: "memory");
    __syncthreads();
    if (c.tid == 0) { __builtin_amdgcn_fence(__ATOMIC_RELEASE, "agent"); ASMV("s_waitcnt vmcnt(0)" ::: "memory");
        (void)__hip_atomic_fetch_add((unsigned*)(c.ws + WS_CTL + CTL_HG) + l * 64, 1u, __ATOMIC_RELAXED, __HIP_MEMORY_SCOPE_AGENT); }
}
__device__ __forceinline__ void hgrn_wait_carry(const Ctx& c, int l) {
    if (c.tid == 0) { unsigned* p = (unsigned*)(c.ws + WS_CTL + CTL_HG) + l * 64; unsigned sp = 0;
        while (__hip_atomic_load(p, __ATOMIC_RELAXED, __HIP_MEMORY_SCOPE_AGENT) < (unsigned)c.G) { __builtin_amdgcn_s_sleep(1); if (++sp > (1u << 22)) break; }
        __builtin_amdgcn_fence(__ATOMIC_ACQUIRE, "agent"); ASMV("s_waitcnt vmcnt(0)" ::: "memory"); }
    __syncthreads();
}
__device__ __forceinline__ void ph_mixers(const Ctx& c, int l) {
    if (c.blk & 1) for (int bu = c.blk; bu < NBH * NCH / 4; bu += c.G) hgrn_mfma<false>(c, l, bu);
    for (int u = c.blk; u < NTOK / 32; u += c.G) mix_unit(c, l, u * 32);
    if (!(c.blk & 1)) for (int bu = c.blk; bu < NBH * NCH / 4; bu += c.G) hgrn_mfma<false>(c, l, bu);
}

__device__ __forceinline__ void attn_unit(const Ctx& c_, int bh, int qt) { const Ctx c = fresh(c_);
    const bf16_t* Qg = c.w<bf16_t>(WS_Q) + (size_t)bh * SEQ * 96; const bf16_t* Kg = c.w<bf16_t>(WS_K) + (size_t)bh * SEQ * 96; const bf16_t* Vg = c.w<bf16_t>(WS_VT) + (size_t)bh * 64 * SEQ;
    constexpr int KROW = 104, VROW = 72, KB = 64 * KROW * 2, VB = 64 * VROW * 2;
    const int l31 = c.lane & 31, hi = c.lane >> 5, qrow = qt * 256 + c.wid * 32 + l31;
    bf16x8 qf[6];
#pragma unroll
    for (int ks = 0; ks < 6; ++ks) qf[ks] = *(const bf16x8*)(Qg + (size_t)qrow * 96 + ks * 16 + hi * 8);
    f32x16 o0, o1;
#pragma unroll
    for (int r = 0; r < 16; ++r) { o0[r] = 0.f; o1[r] = 0.f; }
    float mrun = -INFINITY, lsum = 0.f;
    const int nkt = 4 * (qt + 1), mylast = 4 * qt + (c.wid >> 1);
    const int kr0 = c.tid / 12, kc0 = c.tid % 12, kr1 = (c.tid + 512) / 12, kc1 = (c.tid + 512) % 12, vr = c.tid >> 3, vc = c.tid & 7;
    u32x4 sk0, sk1, sv;
    auto gload = [&](int kt) { sk0 = *(const u32x4*)(Kg + (size_t)(kt * 64 + kr0) * 96 + kc0 * 8); if (c.tid < 256) sk1 = *(const u32x4*)(Kg + (size_t)(kt * 64 + kr1) * 96 + kc1 * 8);
                               sv = *(const u32x4*)(Vg + (size_t)vr * SEQ + kt * 64 + vc * 8); };
    auto lstore = [&](int buf) { unsigned char* kb = c.lds + buf * (KB + VB); unsigned char* vb = kb + KB;
                                 *(u32x4*)(kb + (kr0 * KROW + kc0 * 8) * 2) = sk0; if (c.tid < 256) *(u32x4*)(kb + (kr1 * KROW + kc1 * 8) * 2) = sk1; *(u32x4*)(vb + (vr * VROW + vc * 8) * 2) = sv; };
    gload(0); lstore(0); __syncthreads();
    auto tile = [&](const int kt, auto masked) {
            const bf16_t* kb = (const bf16_t*)(c.lds + (kt & 1) * (KB + VB)); const bf16_t* vb = (const bf16_t*)(c.lds + (kt & 1) * (KB + VB) + KB);
            f32x16 s0, s1;
#pragma unroll
            for (int r = 0; r < 16; ++r) { s0[r] = 0.f; s1[r] = 0.f; }
#pragma unroll
            for (int ks = 0; ks < 6; ++ks) { const bf16x8 k0 = *(const bf16x8*)(kb + l31 * KROW + ks * 16 + hi * 8), k1 = *(const bf16x8*)(kb + (32 + l31) * KROW + ks * 16 + hi * 8);
                s0 = MFMA32(k0, qf[ks], s0); s1 = MFMA32(k1, qf[ks], s1); }
            if constexpr (decltype(masked)::value) {
#pragma unroll
                for (int r = 0; r < 16; ++r) { const int key = kt * 64 + (r & 3) + 8 * (r >> 2) + 4 * hi; if (key > qrow) s0[r] = -INFINITY; if (key + 32 > qrow) s1[r] = -INFINITY; } }
            float mx = s0[0];
#pragma unroll
            for (int r = 1; r < 16; ++r) mx = fmaxf(mx, s0[r]);
#pragma unroll
            for (int r = 0; r < 16; ++r) mx = fmaxf(mx, s1[r]);
            mx = fmaxf(mx, __shfl_xor(mx, 32));
            const float mnew = fmaxf(mrun, mx), alpha = __builtin_amdgcn_exp2f(mrun - mnew); mrun = mnew;
            float ps = 0.f;
#pragma unroll
            for (int r = 0; r < 16; ++r) { s0[r] = __builtin_amdgcn_exp2f(s0[r] - mnew); s1[r] = __builtin_amdgcn_exp2f(s1[r] - mnew); ps += s0[r] + s1[r]; }
            lsum = lsum * alpha + ps;
#pragma unroll
            for (int r = 0; r < 16; ++r) { o0[r] *= alpha; o1[r] *= alpha; }
#pragma unroll
            for (int kf = 0; kf < 2; ++kf)
#pragma unroll
                for (int s = 0; s < 2; ++s) { const f32x16& sx = kf ? s1 : s0; u32x4 pw; pw.x = cvt_pk_bf16(sx[8 * s], sx[8 * s + 1]); pw.y = cvt_pk_bf16(sx[8 * s + 2], sx[8 * s + 3]); pw.z = cvt_pk_bf16(sx[8 * s + 4], sx[8 * s + 5]); pw.w = cvt_pk_bf16(sx[8 * s + 6], sx[8 * s + 7]);
                    const bf16x8 pf = __builtin_bit_cast(bf16x8, pw); const int kcol = kf * 32 + 16 * s + 4 * hi;
                    const s16x4 a0 = *(const s16x4*)(vb + l31 * VROW + kcol), a1 = *(const s16x4*)(vb + l31 * VROW + kcol + 8), b0 = *(const s16x4*)(vb + (32 + l31) * VROW + kcol), b1 = *(const s16x4*)(vb + (32 + l31) * VROW + kcol + 8);
                    const bf16x8 v0 = (bf16x8){a0[0], a0[1], a0[2], a0[3], a1[0], a1[1], a1[2], a1[3]}, v1 = (bf16x8){b0[0], b0[1], b0[2], b0[3], b1[0], b1[1], b1[2], b1[3]};
                    o0 = MFMA32(v0, pf, o0); o1 = MFMA32(v1, pf, o1); }
            };
    int kt = 0;
    for (; kt < mylast; ++kt) { gload(kt + 1); tile(kt, std::false_type{}); lstore((kt + 1) & 1); __syncthreads(); }
    { if (kt + 1 < nkt) gload(kt + 1); tile(kt, std::true_type{}); if (kt + 1 < nkt) lstore((kt + 1) & 1); __syncthreads(); ++kt; }
    for (; kt < nkt; ++kt) { if (kt + 1 < nkt) { gload(kt + 1); lstore((kt + 1) & 1); } __syncthreads(); }
    lsum += __shfl_xor(lsum, 32); const float rl = 1.0f / lsum;
    const int b = bh >> 2, h = bh & 3; bf16_t* yo = c.w<bf16_t>(WS_YB) + (size_t)(b * SEQ + qrow) * 1024 + h * 64;
#pragma unroll
    for (int g = 0; g < 4; ++g) { const int dv = 8 * g + 4 * hi; u32x2 w0, w1;
        w0.x = cvt_pk_bf16(o0[4 * g] * rl, o0[4 * g + 1] * rl); w0.y = cvt_pk_bf16(o0[4 * g + 2] * rl, o0[4 * g + 3] * rl); *(u32x2*)(yo + dv) = w0;
        w1.x = cvt_pk_bf16(o1[4 * g] * rl, o1[4 * g + 1] * rl); w1.y = cvt_pk_bf16(o1[4 * g + 2] * rl, o1[4 * g + 3] * rl); *(u32x2*)(yo + 32 + dv) = w1; }
    __syncthreads();
}
__device__ __forceinline__ void ph_attn(const Ctx& c, int l) {
    hgrn_carry(c, l);
    { const int NU = NBH * (NQT / 2);
      if ((c.G & 7) == 0) { const int per = (NU + 7) / 8, x = c.blk & 7, G8 = c.G >> 3;
          for (int j = c.blk >> 3; j < per; j += G8) { const int pu = x * per + j; if (pu < NU) { const int bh = pu / (NQT / 2), p = pu % (NQT / 2); attn_unit(c, bh, NQT - 1 - p); attn_unit(c, bh, p); } } }
      else for (int pu = c.blk; pu < NU; pu += c.G) { const int bh = pu / (NQT / 2), p = pu % (NQT / 2); attn_unit(c, bh, NQT - 1 - p); attn_unit(c, bh, p); } }
    hgrn_wait_carry(c, l);
    for (int bu = c.blk; bu < NBH * NCH / 4; bu += c.G) hgrn_mfma<true>(c, l, bu, l + 1);
}

__device__ __forceinline__ void ph_router(const Ctx& c_, int l, int cnt_off = 0) { const Ctx c = fresh(c_);
    bf16_t* Whi = (bf16_t*)c.lds; bf16_t* Wlo = (bf16_t*)(c.lds + 73728); float* Llog = (float*)(c.lds + 147456) + c.wid * 288; float* Lcb = (float*)(c.lds + 156672);
    int* Le = (int*)(c.lds + 156672 + 256); float* Lw = (float*)(c.lds + 156672 + 256 + 1024); int* Lr = (int*)(c.lds + 156672 + 256 + 2048); int* Lcnt = (int*)(c.lds + 156672 + 256 + 3072); int* Lbase = Lcnt + 32;
    const float* rwt = c.w<float>(WS_RWT + (size_t)(l & 1) * WSET);
    const float* rgb = c.inf(I_RGB) + l * 4; const float* reb = c.inf(I_REB) + l * 32;
    const float* x = c.a->out; const float* gn = c.inf(I_N2G) + l * 1024; const float* mod = c.w<float>(WS_MOD) + (size_t)l * NB * 6144; bf16_t* ha = c.w<bf16_t>(WS_HA);
    unsigned* cnt = (unsigned*)(c.ws + WS_CTL + CTL_CNT) + l * 32 + cnt_off;
    int* asge = c.w<int>(WS_ASGE); int* asgr = c.w<int>(WS_ASGR); float* asgw = c.w<float>(WS_ASGW);
    const int fr = c.lane & 15, fq = c.lane >> 4;
    int staged_b = -1;
    for (int u = c.blk; u < NTOK / 128; u += c.G) {
        const int b = (u * 128) / SEQ; const float* sh = mod + b * 6144 + 3072; const float* sc = sh + 1024;
        __syncthreads();
        if (b != staged_b) { staged_b = b;
            for (int q = c.tid; q < 36 * 128; q += 512) { const int n = q >> 7, ch = q & 127, k0 = ch * 8; float hi8[8], lo8[8];
#pragma unroll
                for (int j = 0; j < 8; ++j) { const float w = rwt[n * 1024 + k0 + j] * gn[k0 + j] * (1.0f + sc[k0 + j]); const float h = bf2f((bf16_t)f2bf_bits(w)); hi8[j] = h; lo8[j] = w - h; }
                const int pc = (ch ^ (n & 15)) * 8; *(u32x4*)(Whi + n * 1024 + pc) = pk8(hi8); *(u32x4*)(Wlo + n * 1024 + pc) = pk8(lo8); }
            for (int g = c.wid; g < 36; g += 8) { float s = 0.f;
#pragma unroll
                for (int i = 0; i < 4; ++i) { const f32x4 w = *(const f32x4*)(rwt + g * 1024 + i * 256 + c.lane * 4), s4 = *(const f32x4*)(sh + i * 256 + c.lane * 4); s += w[0] * s4[0] + w[1] * s4[1] + w[2] * s4[2] + w[3] * s4[3]; }
                s = wave_sum(s); if (c.lane == 0) Lcb[g] = s + (g < 4 ? rgb[g] : reb[g - 4]); } }
        if (c.tid < 32) Lcnt[c.tid] = 0;
        __syncthreads();
        const int rowb = u * 128 + c.wid * 16; const float* xr = x + (size_t)(rowb + fr) * 1024 + 8 * fq;
        f32x4 acc[3] = {{0.f, 0.f, 0.f, 0.f}, {0.f, 0.f, 0.f, 0.f}, {0.f, 0.f, 0.f, 0.f}}; float ssp = 0.f;
#pragma unroll 4
        for (int ks = 0; ks < 32; ++ks) { const f32x4 xa = *(const f32x4*)(xr + 32 * ks), xb = *(const f32x4*)(xr + 32 * ks + 4);
            float xv[8] = {xa[0], xa[1], xa[2], xa[3], xb[0], xb[1], xb[2], xb[3]}, lo8[8];
            u32x4 hw; hw.x = cvt_pk_bf16(xv[0], xv[1]); hw.y = cvt_pk_bf16(xv[2], xv[3]); hw.z = cvt_pk_bf16(xv[4], xv[5]); hw.w = cvt_pk_bf16(xv[6], xv[7]);
            const unsigned hws[4] = {hw.x, hw.y, hw.z, hw.w};
#pragma unroll
            for (int j = 0; j < 8; ++j) { ssp += xv[j] * xv[j]; lo8[j] = xv[j] - ((j & 1) ? bfhi(hws[j >> 1]) : bflo(hws[j >> 1])); }
            const bf16x8 ah = __builtin_bit_cast(bf16x8, hw), al = __builtin_bit_cast(bf16x8, pk8(lo8));
            const int ch = 4 * ks + fq;
#pragma unroll
            for (int nf = 0; nf < 3; ++nf) { const int n = 16 * nf + fr; bf16x8 bh = {0, 0, 0, 0, 0, 0, 0, 0}, bl = bh;
                if (nf < 2 || fr < 4) { const int pc = (ch ^ (n & 15)) * 8; bh = *(const bf16x8*)(Whi + n * 1024 + pc); bl = *(const bf16x8*)(Wlo + n * 1024 + pc); }
                acc[nf] = MFMA16(ah, bh, acc[nf]); acc[nf] = MFMA16(ah, bl, acc[nf]); acc[nf] = MFMA16(al, bh, acc[nf]); } }
        ssp += __shfl_xor(ssp, 16); ssp += __shfl_xor(ssp, 32);
        const float rinv = frsqrt(ssp * (1.0f / 1024.0f) + EPS);
        float rj[4];
#pragma unroll
        for (int j = 0; j < 4; ++j) rj[j] = __shfl(rinv, fq * 4 + j);
#pragma unroll
        for (int half = 0; half < 2; ++half) {
            if ((fq >> 1) == half) {
#pragma unroll
                for (int nf = 0; nf < 3; ++nf) { const int col = 16 * nf + fr; if (col < 36) {
#pragma unroll
                    for (int j = 0; j < 4; ++j) Llog[((fq & 1) * 4 + j) * 36 + col] = acc[nf][j] * rj[j] + Lcb[col]; } } }
            __builtin_amdgcn_wave_barrier();
            if (c.lane < 8) { const float* lg = Llog + c.lane * 36; const int rl = c.wid * 16 + half * 8 + c.lane;
                int gi = 0; float gm = lg[0];
#pragma unroll
                for (int g = 1; g < 4; ++g) { const float t = lg[g]; if (t > gm) { gm = t; gi = g; } }
                float den = 0.f;
#pragma unroll
                for (int g = 0; g < 4; ++g) den += expf(lg[g] - gm);
                const float gw = 1.0f / den;
                float e1 = -INFINITY, e2 = -INFINITY; int i1 = 0, i2 = 0;
#pragma unroll
                for (int j = 0; j < 8; ++j) { const float t = lg[4 + gi * 8 + j]; if (t > e1) { e2 = e1; i2 = i1; e1 = t; i1 = j; } else if (t > e2) { e2 = t; i2 = j; } }
                const float p2 = expf(e2 - e1), w1 = gw / (1.0f + p2), w2 = gw * p2 / (1.0f + p2);
                const int ea = gi * 8 + i1, eb = gi * 8 + i2; Le[rl * 2] = ea; Le[rl * 2 + 1] = eb; Lw[rl * 2] = w1; Lw[rl * 2 + 1] = w2;
                Lr[rl * 2] = atomicAdd(&Lcnt[ea], 1); Lr[rl * 2 + 1] = atomicAdd(&Lcnt[eb], 1); }
            __builtin_amdgcn_wave_barrier();
        }
#pragma unroll 4
        for (int ks = 0; ks < 32; ++ks) { const int k0 = 32 * ks + 8 * fq; const f32x4 xa = *(const f32x4*)(xr + 32 * ks), xb = *(const f32x4*)(xr + 32 * ks + 4);
            const f32x4 ga = *(const f32x4*)(gn + k0) * (*(const f32x4*)(sc + k0) + 1.0f), gb = *(const f32x4*)(gn + k0 + 4) * (*(const f32x4*)(sc + k0 + 4) + 1.0f);
            const f32x4 ha4 = xa * rinv * ga + *(const f32x4*)(sh + k0), hb4 = xb * rinv * gb + *(const f32x4*)(sh + k0 + 4);
            u32x4 o; o.x = cvt_pk_bf16(ha4[0], ha4[1]); o.y = cvt_pk_bf16(ha4[2], ha4[3]); o.z = cvt_pk_bf16(hb4[0], hb4[1]); o.w = cvt_pk_bf16(hb4[2], hb4[3]);
            *(u32x4*)(ha + (size_t)(rowb + fr) * 1024 + k0) = o; }
        __syncthreads();
        if (c.tid < 32) Lbase[c.tid] = (int)__hip_atomic_fetch_add(&cnt[c.tid], (unsigned)Lcnt[c.tid], __ATOMIC_RELAXED, __HIP_MEMORY_SCOPE_AGENT);
        __syncthreads();
        if (c.tid < 256) { const int a = u * 256 + c.tid, e = Le[c.tid]; asge[a] = e; asgr[a] = Lbase[e] + Lr[c.tid]; asgw[a] = Lw[c.tid]; }
    }
    __syncthreads();
}
__device__ __forceinline__ void ph_gather(const Ctx& c_, int l) { const Ctx c = fresh(c_);
    int* Lps = (int*)c.lds; int* Lcn = Lps + 40;
    unsigned* cnt = (unsigned*)(c.ws + WS_CTL + CTL_CNT) + l * 32;
    if (c.tid < 32) Lcn[c.tid] = (int)__hip_atomic_load(&cnt[c.tid], __ATOMIC_RELAXED, __HIP_MEMORY_SCOPE_AGENT);
    __syncthreads();
    if (c.tid == 0) { int acc = 0; for (int e = 0; e < 32; ++e) { Lps[e] = acc; acc += (Lcn[e] + 255) / 256 * 256; } Lps[32] = acc; }
    __syncthreads();
    int* rowtok = c.w<int>(WS_ROWTOK); float* roww = c.w<float>(WS_ROWW);
    if (c.blk == 0) { int* tile = c.w<int>(WS_TILE); if (c.tid == 0) tile[0] = Lps[32] / 256;
        for (int e = c.tid; e < 32; e += 512) for (int t = Lps[e] / 256; t < Lps[e + 1] / 256; ++t) tile[1 + t] = e; }
    for (int e = c.blk; e < 32; e += c.G) for (int r = Lps[e] + Lcn[e] + c.tid; r < Lps[e + 1]; r += 512) rowtok[r] = -1;
    const int* asge = c.w<int>(WS_ASGE); const int* asgr = c.w<int>(WS_ASGR); const float* asgw = c.w<float>(WS_ASGW);
    for (int a = c.blk * 512 + c.tid; a < NTOK * 2; a += c.G * 512) { const int dest = Lps[asge[a]] + asgr[a]; rowtok[dest] = a; roww[dest] = asgw[a]; }
}
__device__ __forceinline__ void ph_final(const Ctx& c_) { const Ctx c = fresh(c_);
    float* out = c.a->out; const bf16_t* y1 = c.w<bf16_t>(WS_Y1);
    for (size_t e = (size_t)c.blk * 512 + c.tid; e < (size_t)NTOK * 256; e += (size_t)c.G * 512) { const u32x2 y = *(const u32x2*)(y1 + e * 4); f32x4 v = *(const f32x4*)(out + e * 4);
        v += (f32x4){bflo(y.x), bfhi(y.x), bflo(y.y), bfhi(y.y)}; *(f32x4*)(out + e * 4) = v; }
}

constexpr int PH_PER_LAYER = 9, N_PHASES = 2 + PH_PER_LAYER * NL + 1;
__global__ void __launch_bounds__(512, 2) mk_fwd(Args args) {
#ifdef EMU
    unsigned char* lds = emu_lds();
#else
    extern __shared__ __attribute__((aligned(16))) unsigned char lds[];
#endif
    Ctx c; c.a = &args; c.ws = args.ws; c.lds = lds; c.tid = threadIdx.x; c.wid = __builtin_amdgcn_readfirstlane(c.tid >> 6); c.lane = c.tid & 63; c.G = gridDim.x; c.blk = blockIdx.x;
    if (c.tid == 0) *(uint4*)(lds + LDS_XB) = make_uint4(0u, 0u, 0u, 0u);
    __syncthreads();
    XcdBarrier bar; bar.bar = (unsigned*)(args.ws + WS_CTL); bar.x = 0; bar.st = (volatile LAS unsigned*)(lds + LDS_XB);
    if (args.ph_hi - args.ph_lo > 1) bar = xcd_barrier_post((unsigned*)(args.ws + WS_CTL), (volatile LAS unsigned*)(lds + LDS_XB));
    int ph = 0;
#ifndef PHMASK
#define PHMASK 0xFFFFF
#endif
#define PHASE(K, ...) do { if (ph >= args.ph_lo && ph < args.ph_hi) { if constexpr ((PHMASK >> K) & 1) { __VA_ARGS__; } if (ph + 1 < args.ph_hi) xcd_barrier(bar); } ++ph; } while (0)
    PHASE(0, ph_prologue0(c));
    PHASE(1, ph_prologue1(c));
    for (int l = 0; l < NL; ++l) {
        PHASE(2, if (l == 0) ph_cvt(c, 0); ph_normrows(c, l));
        PHASE(3, { pg8::Gemm g{c.w<bf16_t>(WS_HA), c.w<bf16_t>(WS_WIN + (size_t)(l & 1) * WSET), NTOK, ZP, 1024}; pg8::StaticOrder S; S.init(NTOK, ZP, c.G, c.blk); pg8::EpiBf16 E{c.w<bf16_t>(WS_Z), ZP};
                pg8::gemm_phase<pg8::EpiBf16, pg8::StaticOrder, true, true>((LAS unsigned char*)lds, g, S, E); });
        PHASE(4, ph_mixers(c, l));
        PHASE(5, ph_attn(c, l));
        PHASE(6, { pg8::Gemm g{c.w<bf16_t>(WS_YB), c.w<bf16_t>(WS_WOUT + (size_t)(l & 1) * WSET), NTOK, 1024, 1024}; pg8::StaticOrder S; S.init(NTOK, 1024, c.G, c.blk);
                pg8::EpiResid E{(l == 0) ? c.inf(I_X) : args.out, args.out, c.w<float>(WS_MOD) + (size_t)l * NB * 6144 + 2048, 6144, SEQ, (l == 0) ? (const bf16_t*)nullptr : c.w<bf16_t>(WS_Y1)};
                pg8::gemm_phase<pg8::EpiResid, pg8::StaticOrder, true, true>((LAS unsigned char*)lds, g, S, E); });
        PHASE(7, ph_router(c, l));
        PHASE(8, ph_gather(c, l));
        PHASE(9, { pg8::Gemm g{c.w<bf16_t>(WS_HA), c.w<bf16_t>(WS_WUP + (size_t)(l & 1) * WSET), NR, 32 * 1024, 1024}; pg8::MoeOrder S{c.w<int>(WS_TILE), c.G, c.blk}; pg8::EpiSwiglu E{c.w<bf16_t>(WS_Q)};
                pg8::gemm_phase<pg8::EpiSwiglu, pg8::MoeOrder, true, true, true>((LAS unsigned char*)lds, g, S, E, c.w<int>(WS_ROWTOK)); });
        PHASE(10, { pg8::Gemm g{c.w<bf16_t>(WS_Q), c.w<bf16_t>(WS_WDN + (size_t)(l & 1) * WSET), NR, 32 * 1024, 512}; pg8::MoeOrder S{c.w<int>(WS_TILE), c.G, c.blk};
                pg8::EpiDown E{c.w<int>(WS_ROWTOK), c.w<float>(WS_ROWW), args.out, c.w<bf16_t>(WS_Y1), c.w<float>(WS_MOD) + (size_t)l * NB * 6144 + 5120, 6144, SEQ};
                pg8::gemm_phase<pg8::EpiDown, pg8::MoeOrder, true, true>((LAS unsigned char*)lds, g, S, E); });
    }
    PHASE(11, ph_final(c));
#undef PHASE
}

extern "C" void kernel_launch(void* const* d_in, const int* in_sizes, int n_in, void* d_out, int out_size, void* d_ws, size_t ws_size, hipStream_t stream) {
    static int grid = 0;
    if (grid == 0) {
        if (n_in != 30 || out_size != NTOK * 1024 || ws_size < WS_END) { fprintf(stderr, "kernel_launch: shape/workspace mismatch (n_in %d out %d ws %zu need %zu)\n", n_in, out_size, ws_size, (size_t)WS_END); grid = -1; return; }
        int dev = 0, cus = 0;
        if (hipGetDevice(&dev) != hipSuccess || hipDeviceGetAttribute(&cus, hipDeviceAttributeMultiprocessorCount, dev) != hipSuccess) { grid = -1; return; }
        if (hipFuncSetAttribute((const void*)mk_fwd, hipFuncAttributeMaxDynamicSharedMemorySize, LDS_BYTES) != hipSuccess) { fprintf(stderr, "kernel_launch: hipFuncSetAttribute failed\n"); grid = -1; return; }
        int per_cu = 0; (void)hipOccupancyMaxActiveBlocksPerMultiprocessor(&per_cu, (const void*)mk_fwd, 512, LDS_BYTES);
        if (per_cu < 1) fprintf(stderr, "kernel_launch: occupancy query says %d blocks per CU\n", per_cu);
        grid = cus;
    }
    if (grid < 0) return;
    (void)hipMemsetAsync((char*)d_ws + WS_CTL, 0, CTL_BYTES, stream);
    Args a{};
    for (int i = 0; i < 30; ++i) a.in[i] = d_in[i];
    a.out = (float*)d_out; a.ws = (unsigned char*)d_ws;
#if MK_SPLIT
    for (int p = 0; p < N_PHASES; ++p) { a.ph_lo = p; a.ph_hi = p + 1;
#else
    { a.ph_lo = 0; a.ph_hi = N_PHASES;
#endif
#ifdef EMU
        EMU_LAUNCH(mk_fwd, grid, 512, LDS_BYTES, stream, a);
#else
        hipLaunchKernelGGL(mk_fwd, dim3(grid), dim3(512), LDS_BYTES, stream, a);
#endif
    }
}
```

```cpp
#include <hip/hip_runtime.h>
#include <cstdio>
#include <cstdint>
#include <type_traits>

#ifndef CFG_B
#define CFG_B 4
#endif
#ifndef CFG_S
#define CFG_S 8192
#endif
#ifndef CFG_L
#define CFG_L 4
#endif
#ifndef MK_SPLIT
#define MK_SPLIT 0
#endif

#ifdef EMU
#define ASMV(...) ((void)0)
#define LAS
#define LAUNDER_V(x) ((void)0)
#define LAUNDER_S(x) ((void)0)
#else
#define ASMV(...) asm volatile(__VA_ARGS__)
#define LAS __attribute__((address_space(3)))
#define LAUNDER_V(x) asm volatile("" : "+v"(x))
#define LAUNDER_S(x) asm volatile("" : "+s"(x))
#endif

typedef unsigned short bf16_t;
typedef short bf16x8 __attribute__((ext_vector_type(8)));
typedef short s16x4 __attribute__((ext_vector_type(4)));
typedef float f32x4 __attribute__((ext_vector_type(4)));
typedef float f32x16 __attribute__((ext_vector_type(16)));
typedef unsigned u32x4 __attribute__((ext_vector_type(4)));
typedef unsigned u32x2 __attribute__((ext_vector_type(2)));

__device__ __forceinline__ float bf2f(bf16_t h) { return __builtin_bit_cast(float, (unsigned)h << 16); }
__device__ __forceinline__ float bflo(unsigned w) { return __builtin_bit_cast(float, w << 16); }
__device__ __forceinline__ float bfhi(unsigned w) { return __builtin_bit_cast(float, w & 0xffff0000u); }
__device__ __forceinline__ unsigned f2bf_bits(float f) { unsigned u = __builtin_bit_cast(unsigned, f); u += 0x7fffu + ((u >> 16) & 1u); return u >> 16; }
#ifdef EMU
__device__ __forceinline__ unsigned cvt_pk_bf16(float lo, float hi) { return f2bf_bits(lo) | (f2bf_bits(hi) << 16); }
__device__ __forceinline__ unsigned cvt_pk_bf16_pinned(float lo, float hi) { return f2bf_bits(lo) | (f2bf_bits(hi) << 16); }
#else
typedef __bf16 bf16v2_t __attribute__((ext_vector_type(2)));
typedef float f32v2_t __attribute__((ext_vector_type(2)));
__device__ __forceinline__ unsigned cvt_pk_bf16(float lo, float hi) { const bf16v2_t r = __builtin_convertvector((f32v2_t){lo, hi}, bf16v2_t); return __builtin_bit_cast(unsigned, r); }
__device__ __forceinline__ unsigned cvt_pk_bf16_pinned(float lo, float hi) { unsigned r; asm volatile("v_cvt_pk_bf16_f32 %0, %1, %2\n\ts_nop 1" : "=v"(r) : "v"(lo), "v"(hi)); return r; }
#endif
__device__ __forceinline__ float fast_exp(float x) { return __builtin_amdgcn_exp2f(x * 1.44269504089f); }
__device__ __forceinline__ float fsigmoid(float x) { return __builtin_amdgcn_rcpf(1.0f + fast_exp(-x)); }
__device__ __forceinline__ float fsilu(float x) { return x * fsigmoid(x); }
__device__ __forceinline__ float frsqrt(float x) { return __builtin_amdgcn_rsqf(x); }
#ifdef EMU
__device__ __forceinline__ float wave_sum(float v) {
#pragma unroll
    for (int m = 32; m >= 1; m >>= 1) v += __shfl_xor(v, m);
    return v;
}
#else
template <int CTRL, int ROW_MASK> __device__ __forceinline__ float dpp_t(float v) { return __builtin_bit_cast(float, __builtin_amdgcn_update_dpp(0, __builtin_bit_cast(int, v), CTRL, ROW_MASK, 0xF, false)); }
#define dpp_f(v, ctrl, rm) dpp_t<ctrl, rm>(v)
__device__ __forceinline__ float wave_sum(float v) {
    v += dpp_f(v, 0xB1, 0xF);
    v += dpp_f(v, 0x4E, 0xF);
    v += dpp_f(v, 0x141, 0xF);
    v += dpp_f(v, 0x140, 0xF);
    v += dpp_f(v, 0x142, 0xA);
    v += dpp_f(v, 0x143, 0xC);
    return __builtin_bit_cast(float, __builtin_amdgcn_readlane(__builtin_bit_cast(int, v), 63));
}
__device__ __forceinline__ float half_sum(float v, int hi) {
    v += dpp_f(v, 0xB1, 0xF); v += dpp_f(v, 0x4E, 0xF); v += dpp_f(v, 0x141, 0xF); v += dpp_f(v, 0x140, 0xF);
    v += dpp_f(v, 0x142, 0xA);
    const float a = __builtin_bit_cast(float, __builtin_amdgcn_readlane(__builtin_bit_cast(int, v), 31)), b = __builtin_bit_cast(float, __builtin_amdgcn_readlane(__builtin_bit_cast(int, v), 63));
    return hi ? b : a;
}
#endif
#ifdef EMU
__device__ __forceinline__ float half_sum(float v, int) {
#pragma unroll
    for (int m = 1; m < 32; m <<= 1) v += __shfl_xor(v, m);
    return v;
}
#endif

namespace pg8 {
#define PG8_LAS LAS
constexpr int BM = 256, BK = 64, HALF = 128, HTB = HALF * BK * 2  , STAGE_BYTES = 8 * HTB, NXCD = 8, WGM = 8;

__host__ __device__ __forceinline__ int lds_byte(int r, int c) { const int st = (r >> 4) * 2 + (c >> 5), rr = r & 15, cc = c & 31, ob = rr * 64 + cc * 2; return st * 1024 + (ob ^ (((ob >> 9) & 1) << 5)); }
__host__ __device__ __forceinline__ void stage_rc(int b, int& R, int& C) { const int st = b / 1024, sb = b % 1024, swz = sb ^ (((sb >> 9) & 1) << 5); R = (st >> 1) * 16 + swz / 64; C = (st & 1) * 32 + (swz % 64) / 2; }
__host__ __device__ __forceinline__ int perm32(int rho) { const int n = rho >> 4, i = rho & 15; return 8 * (i >> 2) + 4 * n + (i & 3); }

struct Unit { int pm, pn; };
struct Gemm { const bf16_t* A; const bf16_t* Bt; int M, N, K; };

struct StaticOrder {
    int nM, nN, nwg, G, c;
    __host__ __device__ void init(int M, int N, int G_, int c_) { nM = M / BM; nN = N / BM; nwg = nM * nN; G = G_; c = c_; }
    __host__ __device__ bool next(int i, Unit& u) const {
        const long L = (long)i * G + c; if (L >= nwg) return false;
        int wgid = (int)L; { const int q = nwg / NXCD, r = nwg % NXCD, xcd = wgid % NXCD, off = wgid / NXCD; wgid = (xcd < r ? xcd * (q + 1) : r * (q + 1) + (xcd - r) * q) + off; }
        const int nig = WGM * nN, gid = wgid / nig, fm = gid * WGM, gsz = (nM - fm) < WGM ? (nM - fm) : WGM;
        u.pm = fm + ((wgid % nig) % gsz); u.pn = (wgid % nig) / gsz; return true;
    }
    __device__ __forceinline__ void a_ready(const Unit&) const {}
    __device__ __forceinline__ void done(const Unit&) const {}
};
template <class Epi, class Sched, bool ALIGN_EPI = false, bool SP2 = false, bool GATHER = false>
__device__ __forceinline__ void gemm_phase(PG8_LAS unsigned char* lds, const Gemm g, const Sched& S, const Epi& E, const int* rowmap = nullptr) {
    int tid = threadIdx.x; LAUNDER_V(tid); const int wid = __builtin_amdgcn_readfirstlane(tid >> 6), lane = tid & 63, wr = wid >> 2, wc = wid & 3, fr = lane & 15, fq = lane >> 4;
    const int K = g.K, nt = K / BK;
    unsigned voffA[2], voffB[2]; int RA[2], CA[2];
#pragma unroll
    for (int i = 0; i < 2; ++i) { int R, C; stage_rc(tid * 16 + i * 8192, R, C); const int Rb = Epi::PERM ? ((R & ~31) + perm32(R & 31)) : R;
        voffA[i] = (unsigned)(R * K + C) * 2u; voffB[i] = (unsigned)(Rb * K + C) * 2u; RA[i] = R; CA[i] = C; }
    const size_t kstep = (size_t)(BK * 2);
    const size_t hstep = (size_t)HALF * K * 2;
    const size_t tstep = 2 * hstep;
    const size_t hA = GATHER ? (size_t)0 : hstep;
    unsigned vA0[2], vA1[2], nA0[2], nA1[2];
    auto rows_of = [&](const Unit& u, unsigned (&o0)[2], unsigned (&o1)[2]) {
#pragma unroll
        for (int i = 0; i < 2; ++i) { if constexpr (GATHER) { int t0 = rowmap[u.pm * BM + RA[i]], t1 = rowmap[u.pm * BM + HALF + RA[i]]; t0 = t0 < 0 ? 0 : (t0 >> 1); t1 = t1 < 0 ? 0 : (t1 >> 1);
                o0[i] = (unsigned)(t0 * K + CA[i]) * 2u; o1[i] = (unsigned)(t1 * K + CA[i]) * 2u; } else { o0[i] = voffA[i]; o1[i] = voffA[i]; } } };
    const unsigned ldsw = (unsigned)wid * 1024u;
    const int aoff = lds_byte(wr * 64 + fr, fq * 8), boff = lds_byte(wc * 32 + fr, fq * 8);
#define PG8_SA(b, h) (((b) * 2 + (h)) * HTB)
#define PG8_SB(b, h) ((4 + (b) * 2 + (h)) * HTB)
#define PG8_STAGE(bufoff, gbase, voff) do { _Pragma("unroll") for (int _i = 0; _i < 2; ++_i) \
        __builtin_amdgcn_global_load_lds((const unsigned*)((const char*)(gbase) + (voff)[_i]), (PG8_LAS unsigned*)(lds + (bufoff) + ldsw + _i * 8192), 16, 0, 0); } while (0)
#define PG8_LDA(dst, b, h) do { _Pragma("unroll") for (int m = 0; m < 4; ++m) _Pragma("unroll") for (int k = 0; k < 2; ++k) dst[m][k] = *(const PG8_LAS bf16x8*)(lds + PG8_SA(b, h) + aoff + m * 2048 + k * 1024); } while (0)
#define PG8_LDB(dst, b, h) do { _Pragma("unroll") for (int n = 0; n < 2; ++n) _Pragma("unroll") for (int k = 0; k < 2; ++k) dst[n][k] = *(const PG8_LAS bf16x8*)(lds + PG8_SB(b, h) + boff + n * 2048 + k * 1024); } while (0)
#define PG8_MMA(ai, bj, At, Bt) do { __builtin_amdgcn_s_setprio(1); _Pragma("unroll") for (int m = 0; m < 4; ++m) _Pragma("unroll") for (int n = 0; n < 2; ++n) _Pragma("unroll") for (int k = 0; k < 2; ++k) \
        acc[ai][bj][m][n] = __builtin_amdgcn_mfma_f32_16x16x32_bf16(Bt[n][k], At[m][k], acc[ai][bj][m][n], 0, 0, 0); __builtin_amdgcn_s_setprio(0); } while (0)
#define PG8_WAIT_V(n) ASMV("s_waitcnt vmcnt(" #n ")" ::: "memory")
#define PG8_WAIT_L(n) ASMV("s_waitcnt lgkmcnt(" #n ")" ::: "memory")
#define PG8_BAR __builtin_amdgcn_s_barrier()
#define PG8_SCHED __builtin_amdgcn_sched_barrier(0)
    Unit cur, nxt; int ui = 0;
    if (!S.next(0, cur)) return;
    f32x4 acc[2][2][4][2];
#pragma unroll
    for (int a = 0; a < 2; ++a)
#pragma unroll
        for (int b = 0; b < 2; ++b)
#pragma unroll
            for (int m = 0; m < 4; ++m)
#pragma unroll
                for (int n = 0; n < 2; ++n) acc[a][b][m][n] = (f32x4){0.f, 0.f, 0.f, 0.f};
    bf16x8 At[4][2], B0[2][2], B1[2][2];
    const char* cA = GATHER ? (const char*)g.A : (const char*)g.A + (size_t)cur.pm * tstep; rows_of(cur, vA0, vA1); const char* cB = (const char*)g.Bt + (size_t)cur.pn * tstep;
    S.a_ready(cur);
    if constexpr (SP2) {
        PG8_STAGE(PG8_SB(0, 0), cB, voffB); PG8_STAGE(PG8_SB(0, 1), cB + hstep, voffB); PG8_STAGE(PG8_SA(0, 0), cA, vA0); PG8_STAGE(PG8_SA(0, 1), cA + hA, vA1);
        if (wr == 1) PG8_BAR;
        PG8_WAIT_V(2); PG8_BAR;
        PG8_STAGE(PG8_SB(1, 0), cB + kstep, voffB); PG8_STAGE(PG8_SA(1, 0), cA + kstep, vA0); PG8_STAGE(PG8_SB(1, 1), cB + hstep + kstep, voffB);
        PG8_WAIT_V(6); PG8_BAR;
    } else {
        PG8_STAGE(PG8_SB(0, 0), cB, voffB); PG8_STAGE(PG8_SA(0, 0), cA, vA0); PG8_STAGE(PG8_SB(0, 1), cB + hstep, voffB); PG8_STAGE(PG8_SA(0, 1), cA + hA, vA1);
        if (wr == 1) PG8_BAR;
        PG8_WAIT_V(4); PG8_BAR;
        PG8_STAGE(PG8_SB(1, 0), cB + kstep, voffB); PG8_STAGE(PG8_SA(1, 0), cA + kstep, vA0); PG8_STAGE(PG8_SB(1, 1), cB + hstep + kstep, voffB);
        PG8_WAIT_V(6); PG8_BAR;
    }
    for (;;) {
        const bool has_next = S.next(ui + 1, nxt);
        const char* nA = GATHER ? (const char*)g.A : (has_next ? (const char*)g.A + (size_t)nxt.pm * tstep : cA);
        if (has_next) rows_of(nxt, nA0, nA1); else { nA0[0] = vA0[0]; nA0[1] = vA0[1]; nA1[0] = vA1[0]; nA1[1] = vA1[1]; } const char* nB = has_next ? (const char*)g.Bt + (size_t)nxt.pn * tstep : cB;
        for (int t = 0; t < nt; t += 2) {
            const bool last = (t == nt - 2);
            unsigned sA0[2], sA1[2];
#pragma unroll
            for (int i = 0; i < 2; ++i) { sA0[i] = last ? nA0[i] : vA0[i]; sA1[i] = last ? nA1[i] : vA1[i]; }
            const char* a1 = cA + (size_t)(t + 1) * kstep;
            const char* a2 = last ? nA : cA + (size_t)(t + 2) * kstep; const char* b2 = last ? nB : cB + (size_t)(t + 2) * kstep;
            const char* a3 = a2 + kstep; const char* b3 = b2 + kstep;
            if (last && has_next) S.a_ready(nxt);
            if constexpr (SP2) {
            PG8_LDB(B0, 0, 0); PG8_LDB(B1, 0, 1); PG8_SCHED; PG8_LDA(At, 0, 0); PG8_STAGE(PG8_SA(1, 1), a1 + hA, vA1);
            PG8_WAIT_V(8); PG8_WAIT_L(0); PG8_BAR; PG8_MMA(0, 0, At, B0); PG8_MMA(0, 1, At, B1); PG8_BAR; PG8_SCHED;
            PG8_LDA(At, 0, 1); PG8_STAGE(PG8_SB(0, 0), b2, voffB); PG8_STAGE(PG8_SB(0, 1), b2 + hstep, voffB); PG8_STAGE(PG8_SA(0, 0), a2, sA0);
            PG8_WAIT_V(8); PG8_WAIT_L(0); PG8_BAR; PG8_MMA(1, 0, At, B0); PG8_MMA(1, 1, At, B1); PG8_BAR; PG8_SCHED;
            PG8_LDB(B0, 1, 0); PG8_LDB(B1, 1, 1); PG8_SCHED; PG8_LDA(At, 1, 0); PG8_STAGE(PG8_SA(0, 1), a2 + hA, sA1);
            PG8_WAIT_V(8); PG8_WAIT_L(0); PG8_BAR; PG8_MMA(0, 0, At, B0); PG8_MMA(0, 1, At, B1); PG8_BAR; PG8_SCHED;
            PG8_LDA(At, 1, 1); PG8_STAGE(PG8_SB(1, 0), b3, voffB); PG8_STAGE(PG8_SB(1, 1), b3 + hstep, voffB); PG8_STAGE(PG8_SA(1, 0), a3, sA0);
            PG8_WAIT_V(8); PG8_WAIT_L(0); PG8_BAR; PG8_MMA(1, 0, At, B0); PG8_MMA(1, 1, At, B1); PG8_BAR; PG8_SCHED;
            } else {
            PG8_LDB(B0, 0, 0); PG8_SCHED; PG8_LDA(At, 0, 0); PG8_STAGE(PG8_SA(1, 1), a1 + hA, vA1);
            PG8_WAIT_L(8); PG8_BAR; PG8_WAIT_L(0); PG8_MMA(0, 0, At, B0); PG8_BAR; PG8_SCHED;
            PG8_LDB(B1, 0, 1); PG8_STAGE(PG8_SB(0, 0), b2, voffB);
            PG8_BAR; PG8_WAIT_L(0); PG8_MMA(0, 1, At, B1); PG8_BAR;
            PG8_LDA(At, 0, 1); PG8_STAGE(PG8_SA(0, 0), a2, sA0);
            PG8_BAR; PG8_WAIT_L(0); PG8_MMA(1, 0, At, B0); PG8_BAR; PG8_SCHED;
            PG8_STAGE(PG8_SB(0, 1), b2 + hstep, voffB);
            PG8_WAIT_V(6); PG8_BAR; PG8_MMA(1, 1, At, B1); PG8_BAR;
            PG8_LDB(B0, 1, 0); PG8_SCHED; PG8_LDA(At, 1, 0); PG8_STAGE(PG8_SA(0, 1), a2 + hA, sA1);
            PG8_WAIT_L(8); PG8_BAR; PG8_WAIT_L(0); PG8_MMA(0, 0, At, B0); PG8_BAR; PG8_SCHED;
            PG8_LDB(B1, 1, 1); PG8_STAGE(PG8_SB(1, 0), b3, voffB);
            PG8_BAR; PG8_WAIT_L(0); PG8_MMA(0, 1, At, B1); PG8_BAR;
            PG8_LDA(At, 1, 1); PG8_STAGE(PG8_SA(1, 0), a3, sA0);
            PG8_BAR; PG8_WAIT_L(0); PG8_MMA(1, 0, At, B0); PG8_BAR; PG8_SCHED;
            PG8_STAGE(PG8_SB(1, 1), b3 + hstep, voffB);
            PG8_WAIT_V(6); PG8_BAR; PG8_MMA(1, 1, At, B1); PG8_BAR;
            }
        }
        if constexpr (ALIGN_EPI) { if (wr == 0) PG8_BAR; }
        if constexpr (!Epi::AFTER_DRAIN) { E(acc, cur, wr, wc, fr, fq); S.done(cur); }
        if (!has_next) break;
#pragma unroll
        for (int a = 0; a < 2; ++a)
#pragma unroll
            for (int b = 0; b < 2; ++b)
#pragma unroll
                for (int m = 0; m < 4; ++m)
#pragma unroll
                    for (int n = 0; n < 2; ++n) acc[a][b][m][n] = (f32x4){0.f, 0.f, 0.f, 0.f};
        cur = nxt; cA = nA; cB = nB; ++ui; vA0[0] = nA0[0]; vA0[1] = nA0[1]; vA1[0] = nA1[0]; vA1[1] = nA1[1];
        if constexpr (ALIGN_EPI) { if (wr == 1) PG8_BAR; }
    }
    PG8_WAIT_V(0);
    if constexpr (!ALIGN_EPI) { if (wr == 0) PG8_BAR; }
    PG8_BAR;
    if constexpr (Epi::AFTER_DRAIN) { E.fused(acc, cur, wr, wc, fr, fq, lds, wid, lane); S.done(cur); }
#undef PG8_SA
#undef PG8_SB
#undef PG8_STAGE
#undef PG8_LDA
#undef PG8_LDB
#undef PG8_MMA
#undef PG8_WAIT_V
#undef PG8_WAIT_L
#undef PG8_BAR
#undef PG8_SCHED
}

struct EpiBf16 {
    static constexpr bool PERM = true, AFTER_DRAIN = false;
    bf16_t* O; int ldc;
    __device__ __forceinline__ void operator()(const f32x4 (&acc)[2][2][4][2], const Unit& u, int wr, int wc, int fr, int fq) const {
        const int row0 = u.pm * BM + wr * 64 + fr, col0 = u.pn * BM + wc * 32 + 8 * fq;
#pragma unroll
        for (int ai = 0; ai < 2; ++ai)
#pragma unroll
            for (int m = 0; m < 4; ++m) { bf16_t* rowp = O + (size_t)(row0 + ai * HALF + m * 16) * ldc + col0;
#pragma unroll
                for (int bj = 0; bj < 2; ++bj) { const f32x4 v0 = acc[ai][bj][m][0], v1 = acc[ai][bj][m][1];
                    u32x4 w; w.x = cvt_pk_bf16(v0[0], v0[1]); w.y = cvt_pk_bf16(v0[2], v0[3]); w.z = cvt_pk_bf16(v1[0], v1[1]); w.w = cvt_pk_bf16(v1[2], v1[3]);
                    *(u32x4*)(rowp + bj * HALF) = w; } }
    }
};
struct EpiResid {
    static constexpr bool PERM = true, AFTER_DRAIN = false;
    const float* xin; const bf16_t* xinb; bf16_t* xout; const float* gate; int gstride; int seq; const bf16_t* y1;
    __device__ __forceinline__ void operator()(const f32x4 (&acc)[2][2][4][2], const Unit& u, int wr, int wc, int fr, int fq) const {
        const int row0 = u.pm * BM + wr * 64 + fr, col0 = u.pn * BM + wc * 32 + 8 * fq;
#pragma unroll
        for (int ai = 0; ai < 2; ++ai)
#pragma unroll
            for (int m = 0; m < 4; ++m) { const int row = row0 + ai * HALF + m * 16; const float* gp = gate + (size_t)(row / seq) * gstride;
#pragma unroll
                for (int bj = 0; bj < 2; ++bj) { const int c = col0 + bj * HALF; const size_t o = (size_t)row * 1024 + c;
                    const f32x4 g0 = *(const f32x4*)(gp + c), g1 = *(const f32x4*)(gp + c + 4);
                    f32x4 x0, x1;
                    if (xin) { x0 = *(const f32x4*)(xin + o); x1 = *(const f32x4*)(xin + o + 4); }
                    else { const u32x4 xw = *(const u32x4*)(xinb + o), y = *(const u32x4*)(y1 + o);
                        x0 = (f32x4){bflo(xw.x), bfhi(xw.x), bflo(xw.y), bfhi(xw.y)} + (f32x4){bflo(y.x), bfhi(y.x), bflo(y.y), bfhi(y.y)};
                        x1 = (f32x4){bflo(xw.z), bfhi(xw.z), bflo(xw.w), bfhi(xw.w)} + (f32x4){bflo(y.z), bfhi(y.z), bflo(y.w), bfhi(y.w)}; }
                    x0 += g0 * acc[ai][bj][m][0]; x1 += g1 * acc[ai][bj][m][1];
                    u32x4 w; w.x = cvt_pk_bf16(x0[0], x0[1]); w.y = cvt_pk_bf16(x0[2], x0[3]); w.z = cvt_pk_bf16(x1[0], x1[1]); w.w = cvt_pk_bf16(x1[2], x1[3]);
                    *(u32x4*)(xout + o) = w; } }
    }
};
struct EpiSwiglu {
    static constexpr bool PERM = true, AFTER_DRAIN = false;
    bf16_t* HB;
    __device__ __forceinline__ void operator()(const f32x4 (&acc)[2][2][4][2], const Unit& u, int wr, int wc, int fr, int fq) const {
        const int row0 = u.pm * BM + wr * 64 + fr, col0 = (u.pn & 3) * 128 + wc * 32 + 8 * fq;
#pragma unroll
        for (int ai = 0; ai < 2; ++ai)
#pragma unroll
            for (int m = 0; m < 4; ++m) { bf16_t* p = HB + (size_t)(row0 + ai * HALF + m * 16) * 512 + col0;
                float h[8];
#pragma unroll
                for (int n = 0; n < 2; ++n)
#pragma unroll
                    for (int k = 0; k < 4; ++k) h[n * 4 + k] = fsilu(acc[ai][0][m][n][k]) * acc[ai][1][m][n][k];
                u32x4 w; w.x = cvt_pk_bf16(h[0], h[1]); w.y = cvt_pk_bf16(h[2], h[3]); w.z = cvt_pk_bf16(h[4], h[5]); w.w = cvt_pk_bf16(h[6], h[7]);
                *(u32x4*)p = w; }
    }
};
struct EpiDown {
    static constexpr bool PERM = true, AFTER_DRAIN = false;
    const int* row_tok; const float* row_w; bf16_t* x; bf16_t* y1; const float* gate; int gstride; int seq;
    __device__ __forceinline__ void operator()(const f32x4 (&acc)[2][2][4][2], const Unit& u, int wr, int wc, int fr, int fq) const {
        const int row0 = u.pm * BM + wr * 64 + fr, col0 = (u.pn & 3) * BM + wc * 32 + 8 * fq;
#pragma unroll
        for (int ai = 0; ai < 2; ++ai)
#pragma unroll
            for (int m = 0; m < 4; ++m) { const int row = row0 + ai * HALF + m * 16; const int ts = row_tok[row];
                if (ts >= 0) { const int tok = ts >> 1; const float w = row_w[row]; const float* gp = gate + (size_t)(tok / seq) * gstride;
#pragma unroll
                    for (int bj = 0; bj < 2; ++bj) { const int c = col0 + bj * HALF; const size_t o = (size_t)tok * 1024 + c;
                        const f32x4 v0 = acc[ai][bj][m][0] * (*(const f32x4*)(gp + c)) * w, v1 = acc[ai][bj][m][1] * (*(const f32x4*)(gp + c + 4)) * w;
                        if (ts & 1) { u32x4 q; q.x = cvt_pk_bf16(v0[0], v0[1]); q.y = cvt_pk_bf16(v0[2], v0[3]); q.z = cvt_pk_bf16(v1[0], v1[1]); q.w = cvt_pk_bf16(v1[2], v1[3]); *(u32x4*)(y1 + o) = q; }
                        else { const u32x4 xw = *(const u32x4*)(x + o); const f32x4 s0 = (f32x4){bflo(xw.x), bfhi(xw.x), bflo(xw.y), bfhi(xw.y)} + v0, s1 = (f32x4){bflo(xw.z), bfhi(xw.z), bflo(xw.w), bfhi(xw.w)} + v1;
                            u32x4 q; q.x = cvt_pk_bf16(s0[0], s0[1]); q.y = cvt_pk_bf16(s0[2], s0[3]); q.z = cvt_pk_bf16(s1[0], s1[1]); q.w = cvt_pk_bf16(s1[2], s1[3]); *(u32x4*)(x + o) = q; } } } }
    }
};
struct MoeOrder {
    const int* tile; int G, c;
    __device__ __forceinline__ bool next(int i, Unit& u) const { const int v = ((G & 7) == 0) ? (c & 7) * (G >> 3) + (c >> 3) : c; const int L = i * G + v, nt = tile[0]; if (L >= nt * 4) return false; u.pm = L >> 2; u.pn = tile[1 + (L >> 2)] * 4 + (L & 3); return true; }
    __device__ __forceinline__ void a_ready(const Unit&) const {}
    __device__ __forceinline__ void done(const Unit&) const {}
};
}

constexpr int NB = CFG_B, SEQ = CFG_S, NL = CFG_L, NTOK = NB * SEQ, DM = 1024, ZP = 2304;
constexpr int NBH = NB * 4, NCH = SEQ / 128, NQT = SEQ / 256;
constexpr int NR = 2 * NTOK + 32 * 256;
constexpr int Z_CQ = 0, Z_CKV = 192, Z_KR = 320, Z_POOL = 352, Z_HQ = 608, Z_HF = 864, Z_HI = 1120, Z_HG = 1376, Z_CA = 1632, Z_CG = 1888;
constexpr float EPS = 1e-6f;
static_assert(SEQ % 256 == 0 && NTOK % 256 == 0 && (NQT % 2) == 0, "shape");
constexpr size_t al256(size_t x) { return (x + 255) & ~(size_t)255; }
constexpr size_t cmax(size_t a, size_t b) { return a > b ? a : b; }
constexpr size_t WS_CTL = 0, CTL_BYTES = 65536;
constexpr size_t CTL_CNT = 16384;
constexpr size_t CTL_HG = 32768;
constexpr size_t WS_MODP = WS_CTL + CTL_BYTES;
constexpr size_t WS_MOD = WS_MODP + al256((size_t)16 * NL * NB * 6144 * 4);
constexpr size_t WS_LB = WS_MOD + al256((size_t)NL * NB * 6144 * 4);
constexpr size_t WS_ROPE = WS_LB + al256((size_t)NL * 256 * 4);
constexpr size_t WS_WIN = WS_ROPE + al256((size_t)NTOK * 32 * 4);
constexpr size_t WS_WOUT = WS_WIN + (size_t)ZP * 1024 * 2;
constexpr size_t WS_WUQ = WS_WOUT + (size_t)1024 * 1024 * 2;
constexpr size_t WS_WUKV = WS_WUQ + al256((size_t)384 * 192 * 2);
constexpr size_t WS_WPOOL = WS_WUKV + al256((size_t)512 * 128 * 2);
constexpr size_t WS_WUP = WS_WPOOL + al256((size_t)4 * 64 * 64 * 2);
constexpr size_t WS_WDN = WS_WUP + (size_t)32 * 1024 * 1024 * 2;
constexpr size_t WS_RWT = WS_WDN + (size_t)32 * 1024 * 512 * 2;
constexpr size_t WSET = WS_RWT + 36 * 1024 * 4 - WS_WIN;
constexpr size_t WS_HA = WS_WIN + 2 * WSET;
constexpr size_t WS_Z = WS_HA + (size_t)NTOK * 1024 * 2;
constexpr size_t Z_BYTES = cmax((size_t)NTOK * ZP * 2, (size_t)NR * 1024 * 2);
constexpr size_t WS_Q = WS_Z + Z_BYTES;
constexpr size_t WS_K = WS_Q + (size_t)NTOK * 4 * 96 * 2;
constexpr size_t WS_VT = WS_K + (size_t)NTOK * 4 * 96 * 2;
constexpr size_t WS_YB = WS_VT + (size_t)NTOK * 4 * 64 * 2;
constexpr size_t R2_BYTES = cmax(WS_YB + (size_t)NTOK * 1024 * 2 - WS_Q, (size_t)NR * 512 * 2);
constexpr size_t WS_Y1 = WS_Q + R2_BYTES;
constexpr size_t WS_SC = WS_Y1 + (size_t)NTOK * 1024 * 2;
constexpr size_t WS_PC = WS_SC + (size_t)NBH * NCH * 4096 * 4;
constexpr size_t WS_S0 = WS_PC + al256((size_t)NBH * NCH * 64 * 4);
constexpr size_t WS_ASGE = WS_S0 + (size_t)NBH * NCH * 4096 * 4;
constexpr size_t WS_ASGR = WS_ASGE + (size_t)NTOK * 8;
constexpr size_t WS_ASGW = WS_ASGR + (size_t)NTOK * 8;
constexpr size_t WS_ROWTOK = WS_ASGW + (size_t)NTOK * 8;
constexpr size_t WS_ROWW = WS_ROWTOK + al256((size_t)NR * 4);
constexpr size_t WS_TILE = WS_ROWW + al256((size_t)NR * 4);
constexpr size_t WS_XB = WS_TILE + al256((size_t)(NR / 256 + 16) * 4);
constexpr size_t WS_END = WS_XB + (size_t)NTOK * 1024 * 2;
constexpr int LDS_BYTES = 160 * 1024;
constexpr int LDS_XB = LDS_BYTES - 16;

#define XB_TMO      128
#define XB_XCNT(j)  (256  + 64 * (j))
#define XB_XSUB(j)  (1280 + 64 * (j))
#define XB_XGEN(j)  (2304 + 64 * (j))
#define XB_TOP      3328
#define XB_TOPGEN   3392
#define XCD_BAR_WORDS 3456
#define XB_SPIN_CAP (1u << 18)
__device__ __forceinline__ unsigned xb_ld(unsigned* p)              { return __hip_atomic_load(p, __ATOMIC_RELAXED, __HIP_MEMORY_SCOPE_AGENT); }
__device__ __forceinline__ unsigned xb_add(unsigned* p, unsigned v) { return __hip_atomic_fetch_add(p, v, __ATOMIC_RELAXED, __HIP_MEMORY_SCOPE_AGENT); }
__device__ __forceinline__ unsigned xb_xcc_id() { return (unsigned)__builtin_amdgcn_s_getreg((3 << 11) | 20) & 0xFu; }
#define XB_SPIN(cond, bar) do { unsigned _sp = 0; while (cond) { __builtin_amdgcn_s_sleep(1); \
    if ((++_sp & 255u) == 0u) { if (xb_ld(&(bar)[XB_TMO])) break; if (_sp > XB_SPIN_CAP) { atomicAdd(&(bar)[XB_TMO], 1u); break; } } } } while (0)
struct XcdBarrier { unsigned* bar; unsigned x; volatile LAS unsigned* st; };
__device__ __forceinline__ XcdBarrier xcd_barrier_post(unsigned* bar, volatile LAS unsigned* st) {
    XcdBarrier b; b.bar = bar; b.x = xb_xcc_id(); b.st = st;
    if (threadIdx.x == 0) (void)xb_add(&bar[XB_XCNT(b.x)], 1u);
    return b;
}
__device__ __forceinline__ void xcd_barrier_complete(unsigned* bar, unsigned x, unsigned& nloc, unsigned& nx) {
    const unsigned G = gridDim.x * gridDim.y * gridDim.z;
    unsigned sum, cnt, mine, sp = 0u;
    for (;;) {
        sum = 0u; cnt = 0u; mine = 0u;
#pragma unroll
        for (unsigned j = 0; j < 16; ++j) { const unsigned c = xb_ld(&bar[XB_XCNT(j)]); sum += c; cnt += (c > 0u) ? 1u : 0u; mine = (j == x) ? c : mine; }
        if (sum == G) break;
        __builtin_amdgcn_s_sleep(1);
        if ((++sp & 255u) == 0u) { if (xb_ld(&bar[XB_TMO])) break; if (sp > XB_SPIN_CAP) { atomicAdd(&bar[XB_TMO], 1u); break; } }
    }
    nloc = mine > 0u ? mine : 1u; nx = cnt > 0u ? cnt : 1u;
}
__device__ __forceinline__ void xcd_barrier(const XcdBarrier& b) {
    ASMV("s_waitcnt vmcnt(0)" ::: "memory");
    __syncthreads();
    if (threadIdx.x == 0) {
        unsigned* bar = b.bar;
        __builtin_amdgcn_s_waitcnt(0);
        unsigned nloc = b.st[0], nx = b.st[1];
        if (nloc == 0u) { xcd_barrier_complete(bar, b.x, nloc, nx); b.st[0] = nloc; b.st[1] = nx; }
        const unsigned old = xb_add(&bar[XB_XSUB(b.x)], 1u);
        const unsigned gen = old / nloc;
        if (old + 1u == (gen + 1u) * nloc) {
            __builtin_amdgcn_fence(__ATOMIC_RELEASE, "agent");
            ASMV("s_waitcnt vmcnt(0)" ::: "memory");
            const unsigned og = xb_add(&bar[XB_TOP], 1u);
            const unsigned tg = og / nx;
            if (og + 1u == (tg + 1u) * nx) xb_add(&bar[XB_TOPGEN], 1u);
            else XB_SPIN(xb_ld(&bar[XB_TOPGEN]) == tg, bar);
            __builtin_amdgcn_fence(__ATOMIC_ACQUIRE, "agent");
            xb_add(&bar[XB_XGEN(b.x)], 1u);
            ASMV("s_waitcnt vmcnt(0)" ::: "memory");
        } else {
            XB_SPIN(xb_ld(&bar[XB_XGEN(b.x)]) == gen, bar);
            __builtin_amdgcn_fence(__ATOMIC_ACQUIRE, "agent");
            ASMV("s_waitcnt vmcnt(0)" ::: "memory");
        }
    }
    __syncthreads();
}

struct Args { const void* in[30]; float* out; unsigned char* ws; int ph_lo, ph_hi; };
enum { I_X = 0, I_C, I_POS, I_WADA, I_BADA, I_N1G, I_N2G, I_WIN, I_QAG, I_WUQ, I_KVAG, I_WUKV, I_QG, I_KG, I_WPOOL, I_PSCALE, I_LBL, I_HOG, I_DWW, I_DWB, I_LNG, I_LNB,
       I_WOUT, I_RGW, I_RGB, I_REW, I_REB, I_W1, I_W3, I_W2 };
struct Ctx {
    const Args* a; unsigned char* ws; unsigned char* lds; int tid, wid, lane, G, blk;
    __device__ __forceinline__ const float* inf(int i) const { return (const float*)a->in[i]; }
    template <class T> __device__ __forceinline__ T* w(size_t off) const { return (T*)(ws + off); }
};

__device__ __forceinline__ Ctx fresh(const Ctx& c0) { Ctx c = c0; LAUNDER_V(c.tid); LAUNDER_V(c.lane); LAUNDER_S(c.wid); return c; }
__device__ __forceinline__ void ph_prologue0(const Ctx& c_) { const Ctx c = fresh(c_);
    const float* cc = c.inf(I_C); const float* wada = c.inf(I_WADA); float* modp = c.w<float>(WS_MODP);
    for (int u = c.blk; u < NL * 16 * 12; u += c.G) {
        const int l = u / 192, r = u % 192, ic = r / 12, jb = r % 12, j = jb * 512 + c.tid;
        float* Ls = (float*)c.lds;
        __syncthreads();
        if (c.tid < NB * 64) Ls[c.tid] = fsilu(cc[(c.tid >> 6) * 1024 + ic * 64 + (c.tid & 63)]);
        __syncthreads();
        float acc[NB];
#pragma unroll
        for (int b = 0; b < NB; ++b) acc[b] = 0.f;
        const float* wp = wada + ((size_t)l * 1024 + ic * 64) * 6144 + j;
#pragma unroll
        for (int i0 = 0; i0 < 64; i0 += 16) { float wv[16];
#pragma unroll
            for (int i = 0; i < 16; ++i) wv[i] = wp[(size_t)(i0 + i) * 6144];
#pragma unroll
            for (int i = 0; i < 16; ++i)
#pragma unroll
                for (int b = 0; b < NB; ++b) acc[b] += Ls[b * 64 + i0 + i] * wv[i]; }
#pragma unroll
        for (int b = 0; b < NB; ++b) modp[(((size_t)ic * NL + l) * NB + b) * 6144 + j] = acc[b];
    }
    const int* pos = (const int*)c.a->in[I_POS]; float* rc = c.w<float>(WS_ROPE); float* rs = rc + (size_t)NTOK * 16;
    for (int e = c.blk * 512 + c.tid; e < NTOK * 16; e += c.G * 512) { const int t = e >> 4, i = e & 15;
        const float inv = exp2f(-(float)i * (13.287712379549449f / 16.0f));
        const float ang = (float)pos[t] * inv; rc[e] = cosf(ang); rs[e] = sinf(ang); }
    if (c.blk == 0 && c.tid < 256) { const float* lg = c.inf(I_LBL); float* lb = c.w<float>(WS_LB); float mx = -1e30f;
        for (int l = 0; l < NL; ++l) mx = fmaxf(mx, lg[l * 256 + c.tid]);
        float den = 0.f; for (int l = 0; l < NL; ++l) den += expf(lg[l * 256 + c.tid] - mx);
        float cum = 0.f, first = 0.f; for (int l = 0; l < NL; ++l) { cum += expf(lg[l * 256 + c.tid] - mx) / den; if (l == 0) first = cum; lb[l * 256 + c.tid] = cum - first; } }
}
__device__ __forceinline__ void ph_prologue1(const Ctx& c_) { const Ctx c = fresh(c_);
    const float* modp = c.w<float>(WS_MODP); float* mod = c.w<float>(WS_MOD); const float* bada = c.inf(I_BADA);
    for (int e = c.blk * 512 + c.tid; e < NL * NB * 6144; e += c.G * 512) { const int j = e % 6144, l = e / (NB * 6144);
        float s = bada[l * 6144 + j];
#pragma unroll
        for (int ic = 0; ic < 16; ++ic) s += modp[(size_t)ic * NL * NB * 6144 + e];
        mod[e] = s; }
}

__device__ __forceinline__ void ld8bf(const bf16_t* p, float (&o)[8]) { const u32x4 v = *(const u32x4*)p; o[0] = bflo(v.x); o[1] = bfhi(v.x); o[2] = bflo(v.y); o[3] = bfhi(v.y); o[4] = bflo(v.z); o[5] = bfhi(v.z); o[6] = bflo(v.w); o[7] = bfhi(v.w); }
__device__ __forceinline__ u32x4 pk8(const float (&o)[8]) { u32x4 w; w.x = cvt_pk_bf16(o[0], o[1]); w.y = cvt_pk_bf16(o[2], o[3]); w.z = cvt_pk_bf16(o[4], o[5]); w.w = cvt_pk_bf16(o[6], o[7]); return w; }
__device__ __forceinline__ u32x4 pk8p(const float (&o)[8]) { u32x4 w; w.x = cvt_pk_bf16_pinned(o[0], o[1]); w.y = cvt_pk_bf16_pinned(o[2], o[3]); w.z = cvt_pk_bf16_pinned(o[4], o[5]); w.w = cvt_pk_bf16_pinned(o[6], o[7]); return w; }
__device__ __forceinline__ void cvt_tile(const Ctx& c, const float* src, int ldn, int nlim, int k0, int n0, bf16_t* dst, int ldk, int drow0) {
    float* T = (float*)c.lds;
#pragma unroll
    for (int i = 0; i < 8; ++i) { const int e = c.tid + 512 * i, kk = e >> 6, nn = e & 63; T[kk * 65 + nn] = (n0 + nn < nlim) ? src[(size_t)(k0 + kk) * ldn + n0 + nn] : 0.f; }
    __syncthreads();
#pragma unroll
    for (int i = 0; i < 4; ++i) { const int e = c.tid + 512 * i, nn = e >> 5, k2 = e & 31;
        *(unsigned*)(dst + (size_t)(drow0 + nn) * ldk + k0 + 2 * k2) = cvt_pk_bf16(T[(2 * k2) * 65 + nn], T[(2 * k2 + 1) * 65 + nn]); }
    __syncthreads();
}
__device__ __forceinline__ void cvt_big(const Ctx& c, const float* src, int ldn, int nlim, int k0, int n0, bf16_t* dst, int ldk, int mode) {
    float* T = (float*)c.lds;
    f32x4 v[8];
#pragma unroll
    for (int i = 0; i < 8; ++i) { const int e4 = c.tid + 512 * i, kk = e4 >> 6, n4 = e4 & 63; v[i] = (n0 + n4 * 4 < nlim) ? *(const f32x4*)(src + (size_t)(k0 + kk) * ldn + n0 + n4 * 4) : (f32x4){0.f, 0.f, 0.f, 0.f}; }
#pragma unroll
    for (int i = 0; i < 8; ++i) { const int e4 = c.tid + 512 * i, kk = e4 >> 6, n4 = e4 & 63; float* p = T + kk * 261 + n4 * 4; p[0] = v[i][0]; p[1] = v[i][1]; p[2] = v[i][2]; p[3] = v[i][3]; }
    __syncthreads();
#pragma unroll
    for (int i = 0; i < 4; ++i) { const int e = c.tid + 512 * i, k8 = e & 7, nn = e >> 3, n = n0 + nn; float o[8];
#pragma unroll
        for (int j = 0; j < 8; ++j) o[j] = T[(8 * k8 + j) * 261 + nn];
        const int row = (mode == 0) ? n : ((n >> 7) * 256 + (mode - 1) * 128 + (n & 127));
        *(u32x4*)(dst + (size_t)row * ldk + k0 + 8 * k8) = pk8(o); }
    __syncthreads();
}
constexpr int CT_IN = 16 * 9, CT_OUT = 16 * 4, CT_W13 = 32 * 16 * 2, CT_W2 = 32 * 8 * 4, CT_UQ = 3 * 6, CT_UKV = 2 * 8, CT_POOL = 4;
constexpr int CT_TOTAL = CT_IN + CT_OUT + 2 * CT_W13 + CT_W2 + CT_UQ + CT_UKV + CT_POOL;
__device__ __forceinline__ void ph_cvt(const Ctx& c_, int l) { const Ctx c = fresh(c_);
    { const float* rgw = c.inf(I_RGW) + (size_t)l * 1024 * 4; const float* rew = c.inf(I_REW) + (size_t)l * 1024 * 32; float* rwt = c.w<float>(WS_RWT + (size_t)(l & 1) * WSET);
        for (int e = c.blk * 512 + c.tid; e < 36 * 1024; e += c.G * 512) { const int g = e >> 10, k = e & 1023; rwt[e] = (g < 4) ? rgw[k * 4 + g] : rew[k * 32 + g - 4]; } }
    for (int t = c.blk; t < CT_TOTAL; t += c.G) {
        int r = t;
        if (r < 2 * CT_W13) { const int which = r / CT_W13; r %= CT_W13; const int e = r / 32, kt = (r % 32) / 2, nt = r % 2;
            cvt_big(c, c.inf(which ? I_W3 : I_W1) + ((size_t)l * 32 + e) * 1024 * 512, 512, 512, kt * 64, nt * 256, c.w<bf16_t>(WS_WUP + (size_t)(l & 1) * WSET) + (size_t)e * 1024 * 1024, 1024, 1 + which); continue; } r -= 2 * CT_W13;
        if (r < CT_W2) { const int e = r / 32, kt = (r % 32) / 4, nt = r % 4;
            cvt_big(c, c.inf(I_W2) + ((size_t)l * 32 + e) * 512 * 1024, 1024, 1024, kt * 64, nt * 256, c.w<bf16_t>(WS_WDN + (size_t)(l & 1) * WSET) + (size_t)e * 1024 * 512, 512, 0); continue; } r -= CT_W2;
        if (r < CT_IN) { const int kt = r / 9, nt = r % 9; cvt_big(c, c.inf(I_WIN) + (size_t)l * 1024 * 2144, 2144, 2144, kt * 64, nt * 256, c.w<bf16_t>(WS_WIN + (size_t)(l & 1) * WSET), 1024, 0); continue; } r -= CT_IN;
        if (r < CT_OUT) { const int kt = r / 4, nt = r % 4; cvt_big(c, c.inf(I_WOUT) + (size_t)l * 1024 * 1024, 1024, 1024, kt * 64, nt * 256, c.w<bf16_t>(WS_WOUT + (size_t)(l & 1) * WSET), 1024, 0); continue; } r -= CT_OUT;
        if (r < CT_UQ) { const int kt = r / 6, nt = r % 6; cvt_tile(c, c.inf(I_WUQ) + (size_t)l * 192 * 384, 384, 384, kt * 64, nt * 64, c.w<bf16_t>(WS_WUQ + (size_t)(l & 1) * WSET), 192, nt * 64); continue; } r -= CT_UQ;
        if (r < CT_UKV) { const int kt = r / 8, nt = r % 8; cvt_tile(c, c.inf(I_WUKV) + (size_t)l * 128 * 512, 512, 512, kt * 64, nt * 64, c.w<bf16_t>(WS_WUKV + (size_t)(l & 1) * WSET), 128, nt * 64); continue; } r -= CT_UKV;
        cvt_tile(c, c.inf(I_WPOOL) + ((size_t)l * 4 + r) * 4096, 64, 64, 0, 0, c.w<bf16_t>(WS_WPOOL + (size_t)(l & 1) * WSET) + r * 4096, 64, 0);
    }
}
__device__ __forceinline__ void ph_normrows(const Ctx& c_, int l) { const Ctx c = fresh(c_);
    const float* xin = c.inf(I_X); const bf16_t* xb = c.w<bf16_t>(WS_XB); const bf16_t* y1 = c.w<bf16_t>(WS_Y1);
    const float* gn = c.inf(I_N1G) + l * 1024; const float* mod = c.w<float>(WS_MOD) + (size_t)l * NB * 6144; bf16_t* ha = c.w<bf16_t>(WS_HA);
    for (int row0 = c.blk * 8 + c.wid; row0 < NTOK; row0 += c.G * 16) {
        f32x4 v[2][4]; float ss[2];
#pragma unroll
        for (int q = 0; q < 2; ++q) { const int row = row0 + q * c.G * 8; ss[q] = 0.f;
            if (row < NTOK) {
#pragma unroll
                for (int i = 0; i < 4; ++i) { const int col = i * 256 + c.lane * 4;
                    if (l == 0) v[q][i] = *(const f32x4*)(xin + (size_t)row * 1024 + col);
                    else { const u32x2 xw = *(const u32x2*)(xb + (size_t)row * 1024 + col), y = *(const u32x2*)(y1 + (size_t)row * 1024 + col);
                        v[q][i] = (f32x4){bflo(xw.x), bfhi(xw.x), bflo(xw.y), bfhi(xw.y)} + (f32x4){bflo(y.x), bfhi(y.x), bflo(y.y), bfhi(y.y)}; } } } }
#pragma unroll
        for (int q = 0; q < 2; ++q) { const int row = row0 + q * c.G * 8;
            if (row < NTOK) {
#pragma unroll
                for (int i = 0; i < 4; ++i) {
                    ss[q] += v[q][i][0] * v[q][i][0] + v[q][i][1] * v[q][i][1] + v[q][i][2] * v[q][i][2] + v[q][i][3] * v[q][i][3]; } } }
        ss[0] = wave_sum(ss[0]); ss[1] = wave_sum(ss[1]);
#pragma unroll
        for (int q = 0; q < 2; ++q) { const int row = row0 + q * c.G * 8;
            if (row < NTOK) { const int b = row / SEQ; const float* sh = mod + b * 6144; const float* sc = sh + 1024; const float rinv = frsqrt(ss[q] * (1.0f / 1024.0f) + EPS);
#pragma unroll
                for (int i = 0; i < 4; ++i) { const int col = i * 256 + c.lane * 4; const f32x4 g = *(const f32x4*)(gn + col), s1 = *(const f32x4*)(sc + col), s0 = *(const f32x4*)(sh + col);
                    const f32x4 h = v[q][i] * rinv * g * (s1 + 1.0f) + s0; u32x2 o; o.x = cvt_pk_bf16(h[0], h[1]); o.y = cvt_pk_bf16(h[2], h[3]); *(u32x2*)(ha + (size_t)row * 1024 + col) = o; } } }
    }
}

#define MFMA16(a, b, c) __builtin_amdgcn_mfma_f32_16x16x32_bf16((a), (b), (c), 0, 0, 0)
#define MFMA32(a, b, c) __builtin_amdgcn_mfma_f32_32x32x16_bf16((a), (b), (c), 0, 0, 0)

__device__ __forceinline__ void mix_unit(const Ctx& c_, int l, int r0) { const Ctx c = fresh(c_);
    const bf16_t* Z = c.w<bf16_t>(WS_Z); bf16_t* Aq = (bf16_t*)c.lds; bf16_t* Akv = (bf16_t*)(c.lds + 12800); float* Lkr = (float*)(c.lds + 21504);
    float* Lu = (float*)(c.lds + 25600); bf16_t* Lp = (bf16_t*)(c.lds + 73728); float* Lcu = (float*)(c.lds + 90624); float* Lco = (float*)c.lds;
    const int s0 = r0 % SEQ, b = r0 / SEQ, fr = c.lane & 15, fq = c.lane >> 4;
    {   const int t = c.tid >> 4, sub = c.tid & 15; const bf16_t* zr = Z + (size_t)(r0 + t) * ZP;
        const u32x4 zero4 = {0u, 0u, 0u, 0u};
        const u32x4 ra0 = *(const u32x4*)(zr + Z_CQ + sub * 8), ra1 = (sub < 8) ? *(const u32x4*)(zr + Z_CQ + 128 + sub * 8) : zero4, rk0 = *(const u32x4*)(zr + Z_CKV + sub * 8), rkr = (sub < 4) ? *(const u32x4*)(zr + Z_KR + sub * 8) : zero4;
        u32x4 rp[3], rca[4], rcg[4];
#pragma unroll
        for (int i = 0; i < 3; ++i) { const int ch = c.tid + 512 * i, row = ch >> 5, c8 = ch & 31; rp[i] = (ch < 47 * 32 && s0 - 15 + row >= 0) ? *(const u32x4*)(Z + (size_t)(r0 - 15 + row) * ZP + Z_POOL + c8 * 8) : zero4; }
#pragma unroll
        for (int i = 0; i < 4; ++i) { const int ch = c.tid + 512 * i, row = ch >> 5, c8 = ch & 31; const bool ok = (ch < 62 * 32 && s0 - 30 + row >= 0);
            rca[i] = ok ? *(const u32x4*)(Z + (size_t)(r0 - 30 + row) * ZP + Z_CA + c8 * 8) : zero4; rcg[i] = ok ? *(const u32x4*)(Z + (size_t)(r0 - 30 + row) * ZP + Z_CG + c8 * 8) : zero4; }
        auto un8 = [](const u32x4 v, float (&o)[8]) { o[0] = bflo(v.x); o[1] = bfhi(v.x); o[2] = bflo(v.y); o[3] = bfhi(v.y); o[4] = bflo(v.z); o[5] = bfhi(v.z); o[6] = bflo(v.w); o[7] = bfhi(v.w); };
        const float* qag = c.inf(I_QAG) + l * 192; const float* kvag = c.inf(I_KVAG) + l * 128;
        float a0[8], a1[8], k0[8]; float ssq = 0.f, ssk = 0.f; un8(ra0, a0); un8(ra1, a1); un8(rk0, k0);
#pragma unroll
        for (int j = 0; j < 8; ++j) { ssq += a0[j] * a0[j] + a1[j] * a1[j]; ssk += k0[j] * k0[j]; }
#pragma unroll
        for (int m = 1; m < 16; m <<= 1) { ssq += __shfl_xor(ssq, m); ssk += __shfl_xor(ssk, m); }
        const float rq = frsqrt(ssq * (1.0f / 192.0f) + EPS), rk = frsqrt(ssk * (1.0f / 128.0f) + EPS);
#pragma unroll
        for (int j = 0; j < 8; ++j) a0[j] *= rq * qag[sub * 8 + j];
        *(u32x4*)(Aq + t * 200 + sub * 8) = pk8(a0);
        if (sub < 8) {
#pragma unroll
            for (int j = 0; j < 8; ++j) a1[j] *= rq * qag[128 + sub * 8 + j];
            *(u32x4*)(Aq + t * 200 + 128 + sub * 8) = pk8(a1); }
#pragma unroll
        for (int j = 0; j < 8; ++j) k0[j] *= rk * kvag[sub * 8 + j];
        *(u32x4*)(Akv + t * 136 + sub * 8) = pk8(k0);
        if (sub < 4) { float kr[8]; un8(rkr, kr);
#pragma unroll
            for (int j = 0; j < 8; ++j) Lkr[t * 32 + sub * 8 + j] = kr[j]; }
#pragma unroll
        for (int i = 0; i < 3; ++i) { const int ch = c.tid + 512 * i, row = ch >> 5, c8 = ch & 31; if (ch < 47 * 32) { float v[8]; un8(rp[i], v);
            *(f32x4*)(Lu + row * 256 + c8 * 8) = (f32x4){v[0], v[1], v[2], v[3]}; *(f32x4*)(Lu + row * 256 + c8 * 8 + 4) = (f32x4){v[4], v[5], v[6], v[7]}; } }
#pragma unroll
        for (int i = 0; i < 4; ++i) { const int ch = c.tid + 512 * i, row = ch >> 5, c8 = ch & 31; if (ch < 62 * 32) { float a[8], g[8]; un8(rca[i], a); un8(rcg[i], g);
#pragma unroll
            for (int j = 0; j < 8; ++j) a[j] *= fsigmoid(g[j]);
            *(f32x4*)(Lcu + row * 256 + c8 * 8) = (f32x4){a[0], a[1], a[2], a[3]}; *(f32x4*)(Lcu + row * 256 + c8 * 8 + 4) = (f32x4){a[4], a[5], a[6], a[7]}; } }
    }
    __syncthreads();
    const float* rcos = c.w<float>(WS_ROPE); const float* rsin = rcos + (size_t)NTOK * 16;
    if (c.wid < 4) {
        const int h = c.wid; const bf16_t* W = c.w<bf16_t>(WS_WUQ + (size_t)(l & 1) * WSET) + (size_t)(96 * h) * 192; const float* qg = c.inf(I_QG) + l * 96;
        f32x4 acc[6][2];
#pragma unroll
        for (int nf = 0; nf < 6; ++nf) { acc[nf][0] = (f32x4){0.f, 0.f, 0.f, 0.f}; acc[nf][1] = acc[nf][0]; }
#pragma unroll 3
        for (int ks = 0; ks < 6; ++ks) { bf16x8 af[2];
#pragma unroll
            for (int mf = 0; mf < 2; ++mf) af[mf] = *(const bf16x8*)(Aq + (mf * 16 + fr) * 200 + ks * 32 + fq * 8);
#pragma unroll
            for (int nf = 0; nf < 6; ++nf) { const bf16x8 bfr = *(const bf16x8*)(W + (size_t)(16 * nf + fr) * 192 + ks * 32 + fq * 8);
                acc[nf][0] = MFMA16(bfr, af[0], acc[nf][0]); acc[nf][1] = MFMA16(bfr, af[1], acc[nf][1]); } }
#pragma unroll
        for (int mf = 0; mf < 2; ++mf) { float ss = 0.f;
#pragma unroll
            for (int nf = 0; nf < 6; ++nf)
#pragma unroll
                for (int j = 0; j < 4; ++j) ss += acc[nf][mf][j] * acc[nf][mf][j];
            ss += __shfl_xor(ss, 16); ss += __shfl_xor(ss, 32);
            const float rinv = frsqrt(ss * (1.0f / 96.0f) + EPS) * (0.10206207261596575f * 1.44269504089f);
            const int tok = r0 + mf * 16 + fr; bf16_t* qo = c.w<bf16_t>(WS_Q) + ((size_t)(b * 4 + h) * SEQ + s0 + mf * 16 + fr) * 96;
            float v[6][4];
#pragma unroll
            for (int nf = 0; nf < 6; ++nf)
#pragma unroll
                for (int j = 0; j < 4; ++j) v[nf][j] = acc[nf][mf][j] * rinv * qg[16 * nf + 4 * fq + j];
            const f32x4 cs4 = *(const f32x4*)(rcos + (size_t)tok * 16 + 4 * fq), sn4 = *(const f32x4*)(rsin + (size_t)tok * 16 + 4 * fq);
#pragma unroll
            for (int j = 0; j < 4; ++j) { const float x1 = v[4][j], x2 = v[5][j]; v[4][j] = x1 * cs4[j] - x2 * sn4[j]; v[5][j] = x1 * sn4[j] + x2 * cs4[j]; }
#pragma unroll
            for (int nf = 0; nf < 6; ++nf) { u32x2 o; o.x = cvt_pk_bf16(v[nf][0], v[nf][1]); o.y = cvt_pk_bf16(v[nf][2], v[nf][3]); *(u32x2*)(qo + 16 * nf + 4 * fq) = o; } }
    } else {
        const int h = c.wid - 4; const bf16_t* W = c.w<bf16_t>(WS_WUKV + (size_t)(l & 1) * WSET) + (size_t)(128 * h) * 128; const float* kg = c.inf(I_KG) + l * 96;
        f32x4 ak[4][2], av[4][2];
#pragma unroll
        for (int nf = 0; nf < 4; ++nf) { ak[nf][0] = (f32x4){0.f, 0.f, 0.f, 0.f}; ak[nf][1] = ak[nf][0]; av[nf][0] = ak[nf][0]; av[nf][1] = ak[nf][0]; }
#pragma unroll 2
        for (int ks = 0; ks < 4; ++ks) { bf16x8 af[2];
#pragma unroll
            for (int mf = 0; mf < 2; ++mf) af[mf] = *(const bf16x8*)(Akv + (mf * 16 + fr) * 136 + ks * 32 + fq * 8);
#pragma unroll
            for (int nf = 0; nf < 4; ++nf) { const bf16x8 bk = *(const bf16x8*)(W + (size_t)(16 * nf + fr) * 128 + ks * 32 + fq * 8), bv = *(const bf16x8*)(W + (size_t)(64 + 16 * nf + fr) * 128 + ks * 32 + fq * 8);
                ak[nf][0] = MFMA16(bk, af[0], ak[nf][0]); ak[nf][1] = MFMA16(bk, af[1], ak[nf][1]);
                av[nf][0] = MFMA16(af[0], bv, av[nf][0]); av[nf][1] = MFMA16(af[1], bv, av[nf][1]); } }
#pragma unroll
        for (int mf = 0; mf < 2; ++mf) { const int tl = mf * 16 + fr; float ss = 0.f;
#pragma unroll
            for (int nf = 0; nf < 4; ++nf)
#pragma unroll
                for (int j = 0; j < 4; ++j) ss += ak[nf][mf][j] * ak[nf][mf][j];
#pragma unroll
            for (int j = 0; j < 8; ++j) { const float kr = Lkr[tl * 32 + fq * 8 + j]; ss += kr * kr; }
            ss += __shfl_xor(ss, 16); ss += __shfl_xor(ss, 32);
            const float rinv = frsqrt(ss * (1.0f / 96.0f) + EPS);
            const int tok = r0 + tl; bf16_t* ko = c.w<bf16_t>(WS_K) + ((size_t)(b * 4 + h) * SEQ + s0 + tl) * 96;
#pragma unroll
            for (int nf = 0; nf < 4; ++nf) { u32x2 o; o.x = cvt_pk_bf16(ak[nf][mf][0] * rinv * kg[16 * nf + 4 * fq], ak[nf][mf][1] * rinv * kg[16 * nf + 4 * fq + 1]);
                o.y = cvt_pk_bf16(ak[nf][mf][2] * rinv * kg[16 * nf + 4 * fq + 2], ak[nf][mf][3] * rinv * kg[16 * nf + 4 * fq + 3]); *(u32x2*)(ko + 16 * nf + 4 * fq) = o; }
            const f32x4 cs4 = *(const f32x4*)(rcos + (size_t)tok * 16 + 4 * fq), sn4 = *(const f32x4*)(rsin + (size_t)tok * 16 + 4 * fq);
            float o1[4], o2[4];
#pragma unroll
            for (int j = 0; j < 4; ++j) { const int i = 4 * fq + j; const float x1 = Lkr[tl * 32 + i] * rinv * kg[64 + i], x2 = Lkr[tl * 32 + 16 + i] * rinv * kg[80 + i];
                o1[j] = x1 * cs4[j] - x2 * sn4[j]; o2[j] = x1 * sn4[j] + x2 * cs4[j]; }
            { u32x2 o; o.x = cvt_pk_bf16(o1[0], o1[1]); o.y = cvt_pk_bf16(o1[2], o1[3]); *(u32x2*)(ko + 64 + 4 * fq) = o; o.x = cvt_pk_bf16(o2[0], o2[1]); o.y = cvt_pk_bf16(o2[2], o2[3]); *(u32x2*)(ko + 80 + 4 * fq) = o; }
            bf16_t* vo = c.w<bf16_t>(WS_VT) + (size_t)(b * 4 + h) * 64 * SEQ + s0 + mf * 16 + 4 * fq;
#pragma unroll
            for (int nf = 0; nf < 4; ++nf) { u32x2 o; o.x = cvt_pk_bf16(av[nf][mf][0], av[nf][mf][1]); o.y = cvt_pk_bf16(av[nf][mf][2], av[nf][mf][3]); *(u32x2*)(vo + (size_t)(16 * nf + fr) * SEQ) = o; } }
    }
    { const int t = c.tid >> 4, sub = c.tid & 15, g = sub >> 2, w = 2 << g, s = s0 + t; const float inv = 1.0f / (float)((s + 1 < w) ? (s + 1) : w);
#pragma unroll
        for (int k = 0; k < 2; ++k) { const int col = sub * 16 + k * 8; float sum[8];
#pragma unroll
            for (int j = 0; j < 8; ++j) sum[j] = 0.f;
            for (int d = 0; d < w; ++d) { const float* p = Lu + (t + 15 - d) * 256 + col;
#pragma unroll
                for (int j = 0; j < 8; ++j) sum[j] += p[j]; }
            const float* p0 = Lu + (t + 15) * 256 + col;
#pragma unroll
            for (int j = 0; j < 8; ++j) sum[j] = sum[j] * inv - p0[j];
            *(u32x4*)(Lp + t * 264 + col) = pk8(sum); } }
    float cres[16];
    { const int chn = c.tid & 255, half = c.tid >> 8; const float* dw = c.inf(I_DWW) + (size_t)l * 31 * 256 + chn; const float bias = c.inf(I_DWB)[l * 256 + chn];
        float wv[31];
#pragma unroll
        for (int j = 0; j < 31; ++j) wv[j] = dw[j * 256];
#pragma unroll
        for (int tt = 0; tt < 16; ++tt) cres[tt] = bias;
#pragma unroll
        for (int r = 0; r < 46; ++r) { const float u = Lcu[(half * 16 + r) * 256 + chn];
#pragma unroll
            for (int tt = 0; tt < 16; ++tt) { const int j = r - tt; if (j >= 0 && j < 31) cres[tt] += wv[j] * u; } } }
    __syncthreads();
    { const int g = c.wid >> 1, mf = c.wid & 1; const bf16_t* W = c.w<bf16_t>(WS_WPOOL + (size_t)(l & 1) * WSET) + g * 4096; const float* ps = c.inf(I_PSCALE) + l * 256 + g * 64;
        f32x4 acc[4];
#pragma unroll
        for (int nf = 0; nf < 4; ++nf) acc[nf] = (f32x4){0.f, 0.f, 0.f, 0.f};
#pragma unroll
        for (int ks = 0; ks < 2; ++ks) { const bf16x8 af = *(const bf16x8*)(Lp + (mf * 16 + fr) * 264 + g * 64 + ks * 32 + fq * 8);
#pragma unroll
            for (int nf = 0; nf < 4; ++nf) { const bf16x8 bfr = *(const bf16x8*)(W + (16 * nf + fr) * 64 + ks * 32 + fq * 8); acc[nf] = MFMA16(bfr, af, acc[nf]); } }
        bf16_t* yo = c.w<bf16_t>(WS_YB) + (size_t)(r0 + mf * 16 + fr) * 1024 + 256 + g * 64;
#pragma unroll
        for (int nf = 0; nf < 4; ++nf) { const int d = 16 * nf + 4 * fq; u32x2 o; o.x = cvt_pk_bf16(acc[nf][0] * ps[d], acc[nf][1] * ps[d + 1]); o.y = cvt_pk_bf16(acc[nf][2] * ps[d + 2], acc[nf][3] * ps[d + 3]); *(u32x2*)(yo + d) = o; } }
    { const int chn = c.tid & 255, half = c.tid >> 8;
#pragma unroll
        for (int tt = 0; tt < 16; ++tt) Lco[(half * 16 + tt) * 256 + chn] = cres[tt]; }
    __syncthreads();
    { const float* lg = c.inf(I_LNG) + l * 256 + c.lane * 4; const float* lb = c.inf(I_LNB) + l * 256 + c.lane * 4;
#pragma unroll
        for (int k = 0; k < 4; ++k) { const int t = c.wid * 4 + k; const f32x4 v = *(const f32x4*)(Lco + t * 256 + c.lane * 4);
            const float mean = wave_sum(v[0] + v[1] + v[2] + v[3]) * (1.0f / 256.0f); const f32x4 d = v - mean;
            const float var = wave_sum(d[0] * d[0] + d[1] * d[1] + d[2] * d[2] + d[3] * d[3]) * (1.0f / 256.0f); const float rs = frsqrt(var + EPS);
            float y[4];
#pragma unroll
            for (int j = 0; j < 4; ++j) y[j] = fsilu(d[j] * rs * lg[j] + lb[j]);
            u32x2 o; o.x = cvt_pk_bf16(y[0], y[1]); o.y = cvt_pk_bf16(y[2], y[3]); *(u32x2*)(c.w<bf16_t>(WS_YB) + (size_t)(r0 + t) * 1024 + 768 + c.lane * 4) = o; } }
    __syncthreads();
}

constexpr int CW_W13 = 32 * 16 * 16, CW_W2 = 32 * 8 * 32, CW_IN = 16 * 72, CW_OUT = 16 * 32, CW_UQ = 3 * 12, CW_UKV = 2 * 16, CW_POOL = 4 * 2;
constexpr int CW_TOTAL = 2 * CW_W13 + CW_W2 + CW_IN + CW_OUT + CW_UQ + CW_UKV + CW_POOL;
struct CvtTile { const float* src; bf16_t* dst; int ldn, ldk; };
__device__ __forceinline__ void cvt_decode(const Ctx& c, int l, int t, CvtTile& d) {
    const size_t wso = (size_t)(l & 1) * WSET; int r = t;
    if (r < 2 * CW_W13) { const int which = r / CW_W13; r %= CW_W13; const int e = r >> 8, kt = (r >> 4) & 15, nt = r & 15, n0 = nt * 32;
        d.src = c.inf(which ? I_W3 : I_W1) + ((size_t)l * 32 + e) * 1024 * 512 + (size_t)kt * 64 * 512 + n0; d.ldn = 512; d.ldk = 1024;
        d.dst = c.w<bf16_t>(WS_WUP + wso) + (size_t)e * 1024 * 1024 + (size_t)((n0 >> 7) * 256 + which * 128 + (n0 & 127)) * 1024 + kt * 64; return; } r -= 2 * CW_W13;
    if (r < CW_W2) { const int e = r >> 8, kt = (r >> 5) & 7, nt = r & 31;
        d.src = c.inf(I_W2) + ((size_t)l * 32 + e) * 512 * 1024 + (size_t)kt * 64 * 1024 + nt * 32; d.ldn = 1024; d.ldk = 512;
        d.dst = c.w<bf16_t>(WS_WDN + wso) + (size_t)e * 1024 * 512 + (size_t)(nt * 32) * 512 + kt * 64; return; } r -= CW_W2;
    if (r < CW_IN) { const int kt = r / 72, nt = r % 72; d.src = (nt < 67) ? c.inf(I_WIN) + (size_t)l * 1024 * 2144 + (size_t)kt * 64 * 2144 + nt * 32 : nullptr; d.ldn = 2144; d.ldk = 1024;
        d.dst = c.w<bf16_t>(WS_WIN + wso) + (size_t)(nt * 32) * 1024 + kt * 64; return; } r -= CW_IN;
    if (r < CW_OUT) { const int kt = r >> 5, nt = r & 31; d.src = c.inf(I_WOUT) + (size_t)l * 1024 * 1024 + (size_t)kt * 64 * 1024 + nt * 32; d.ldn = 1024; d.ldk = 1024;
        d.dst = c.w<bf16_t>(WS_WOUT + wso) + (size_t)(nt * 32) * 1024 + kt * 64; return; } r -= CW_OUT;
    if (r < CW_UQ) { const int kt = r / 12, nt = r % 12; d.src = c.inf(I_WUQ) + (size_t)l * 192 * 384 + (size_t)kt * 64 * 384 + nt * 32; d.ldn = 384; d.ldk = 192;
        d.dst = c.w<bf16_t>(WS_WUQ + wso) + (size_t)(nt * 32) * 192 + kt * 64; return; } r -= CW_UQ;
    if (r < CW_UKV) { const int kt = r >> 4, nt = r & 15; d.src = c.inf(I_WUKV) + (size_t)l * 128 * 512 + (size_t)kt * 64 * 512 + nt * 32; d.ldn = 512; d.ldk = 128;
        d.dst = c.w<bf16_t>(WS_WUKV + wso) + (size_t)(nt * 32) * 128 + kt * 64; return; } r -= CW_UKV;
    { const int g = r >> 1, nt = r & 1; d.src = c.inf(I_WPOOL) + ((size_t)l * 4 + g) * 4096 + nt * 32; d.ldn = 64; d.ldk = 64; d.dst = c.w<bf16_t>(WS_WPOOL + wso) + g * 4096 + (size_t)(nt * 32) * 64; }
}
__device__ __forceinline__ void cvt_wave(const Ctx& c, int l, int wrank, int nwaves, float* T) {
    { const float* rgw = c.inf(I_RGW) + (size_t)l * 1024 * 4; const float* rew = c.inf(I_REW) + (size_t)l * 1024 * 32; float* rwt = c.w<float>(WS_RWT + (size_t)(l & 1) * WSET);
        for (int e = wrank * 64 + c.lane; e < 36 * 1024; e += nwaves * 64) { const int g = e >> 10, k = e & 1023; rwt[e] = (g < 4) ? rgw[k * 4 + g] : rew[k * 32 + g - 4]; } }
    f32x4 v[8]; CvtTile cur; cur.src = nullptr; cur.dst = nullptr; cur.ldn = 0; cur.ldk = 0;
    auto issue = [&](const CvtTile& d) {
#pragma unroll
        for (int i = 0; i < 8; ++i) { const int e4 = c.lane + 64 * i, kk = e4 >> 3, n4 = e4 & 7; v[i] = d.src ? *(const f32x4*)(d.src + (size_t)kk * d.ldn + n4 * 4) : (f32x4){0.f, 0.f, 0.f, 0.f}; } };
    int t = wrank;
    if (t < CW_TOTAL) { cvt_decode(c, l, t, cur); issue(cur); }
    while (t < CW_TOTAL) {
#pragma unroll
        for (int i = 0; i < 8; ++i) { const int e4 = c.lane + 64 * i, kk = e4 >> 3, n4 = e4 & 7; float* p = T + kk * 33 + n4 * 4; p[0] = v[i][0]; p[1] = v[i][1]; p[2] = v[i][2]; p[3] = v[i][3]; }
        const int tn = t + nwaves; CvtTile nxt = cur; if (tn < CW_TOTAL) { cvt_decode(c, l, tn, nxt); issue(nxt); }
        __builtin_amdgcn_wave_barrier();
        { const int n = c.lane & 31, kh = c.lane >> 5; bf16_t* drow = cur.dst + (size_t)n * cur.ldk + kh * 32;
#pragma unroll
            for (int q = 0; q < 4; ++q) { float o[8];
#pragma unroll
                for (int j = 0; j < 8; ++j) o[j] = T[(kh * 32 + q * 8 + j) * 33 + n];
                *(u32x4*)(drow + q * 8) = pk8(o); } }
        __builtin_amdgcn_wave_barrier();
        t = tn; cur = nxt;
    }
}

#ifdef EMU
static inline float __builtin_amdgcn_logf(float x) { return log2f(x); }
#endif
constexpr int HGP = 68, HGV = 40;
constexpr int HG_LG = 0, HG_LK = 8704, HG_LQ = 17408, HG_LVT = 26112, HG_LEG = 31232, HG_LGG = 31488, HG_BYTES = 31744;
template <bool OUT> __device__ __forceinline__ void hgrn_mfma(const Ctx& c_, int l, int bu, int cvt_layer = NL) { const Ctx c = fresh(c_);
    if (c.wid < 4) {
        const int cu = bu * 4 + c.wid, bh = cu / NCH, chunk = cu % NCH, b = bh >> 2, h = bh & 3, tok0 = b * SEQ + chunk * 128;
        const bf16_t* Z = c.w<bf16_t>(WS_Z); const float lbd = c.w<float>(WS_LB)[l * 256 + h * 64 + c.lane];
        unsigned char* L = c.lds + c.wid * HG_BYTES; float* Lg = (float*)(L + HG_LG); float* Lk = (float*)(L + HG_LK); float* Lq = (float*)(L + HG_LQ); bf16_t* Lvt = (bf16_t*)(L + HG_LVT); float* LeG = (float*)(L + HG_LEG); float* LG = (float*)(L + HG_LGG);
        const int l31 = c.lane & 31, hi = c.lane >> 5;
        f32x16 S[2][2];
        if (OUT) { const float* s0 = c.w<float>(WS_S0) + (size_t)(bh * NCH + chunk) * 4096;
#pragma unroll
            for (int mf = 0; mf < 2; ++mf)
#pragma unroll
                for (int nf = 0; nf < 2; ++nf)
#pragma unroll
                    for (int r = 0; r < 16; ++r) S[mf][nf][r] = s0[(32 * mf + (r & 3) + 8 * (r >> 2) + 4 * hi) * 64 + 32 * nf + l31]; }
        else {
#pragma unroll
            for (int mf = 0; mf < 2; ++mf)
#pragma unroll
                for (int nf = 0; nf < 2; ++nf)
#pragma unroll
                    for (int r = 0; r < 16; ++r) S[mf][nf][r] = 0.f; }
        float gtot = 0.f; const float og0 = OUT ? c.inf(I_HOG)[l * 64 + l31] : 0.f, og1 = OUT ? c.inf(I_HOG)[l * 64 + 32 + l31] : 0.f;
        u32x4 rf[4], rq[4], rv[4];
        { const bf16_t* zn = Z + (size_t)(tok0 + (c.lane >> 3)) * ZP + h * 64 + (c.lane & 7) * 8;
#pragma unroll
            for (int i = 0; i < 4; ++i) { rf[i] = *(const u32x4*)(zn + (size_t)i * 8 * ZP + Z_HF); rv[i] = *(const u32x4*)(zn + (size_t)i * 8 * ZP + Z_HI); if (OUT) rq[i] = *(const u32x4*)(zn + (size_t)i * 8 * ZP + Z_HQ); else rq[i] = (u32x4){0u, 0u, 0u, 0u}; } }
#pragma unroll 1
        for (int sc = 0; sc < 4; ++sc) { const int tokb = tok0 + sc * 32;
            {
                const int rr = c.lane >> 3, c8 = (c.lane & 7) * 8;
#pragma unroll
                for (int i = 0; i < 4; ++i) { const int tr = i * 8 + rr; float x[8];
                    { const u32x4 v = rf[i]; x[0] = bflo(v.x); x[1] = bfhi(v.x); x[2] = bflo(v.y); x[3] = bfhi(v.y); x[4] = bflo(v.z); x[5] = bfhi(v.z); x[6] = bflo(v.w); x[7] = bfhi(v.w); }
                    *(f32x4*)(Lg + tr * HGP + c8) = (f32x4){x[0], x[1], x[2], x[3]}; *(f32x4*)(Lg + tr * HGP + c8 + 4) = (f32x4){x[4], x[5], x[6], x[7]};
                    if (OUT) { const u32x4 v = rq[i]; x[0] = fsilu(bflo(v.x)); x[1] = fsilu(bfhi(v.x)); x[2] = fsilu(bflo(v.y)); x[3] = fsilu(bfhi(v.y)); x[4] = fsilu(bflo(v.z)); x[5] = fsilu(bfhi(v.z)); x[6] = fsilu(bflo(v.w)); x[7] = fsilu(bfhi(v.w));
                        *(f32x4*)(Lq + tr * HGP + c8) = (f32x4){x[0], x[1], x[2], x[3]}; *(f32x4*)(Lq + tr * HGP + c8 + 4) = (f32x4){x[4], x[5], x[6], x[7]}; }
                    { const u32x4 v = rv[i]; const unsigned w4[4] = {v.x, v.y, v.z, v.w};
#pragma unroll
                        for (int k = 0; k < 4; ++k) { Lvt[(c8 + 2 * k) * HGV + tr] = (bf16_t)(w4[k] & 0xffffu); Lvt[(c8 + 2 * k + 1) * HGV + tr] = (bf16_t)(w4[k] >> 16); } } }
                if (sc < 3) { const bf16_t* zn = Z + (size_t)(tokb + 32 + rr) * ZP + h * 64 + c8;
#pragma unroll
                    for (int i = 0; i < 4; ++i) { rf[i] = *(const u32x4*)(zn + (size_t)i * 8 * ZP + Z_HF); rv[i] = *(const u32x4*)(zn + (size_t)i * 8 * ZP + Z_HI); if (OUT) rq[i] = *(const u32x4*)(zn + (size_t)i * 8 * ZP + Z_HQ); } }
                __builtin_amdgcn_wave_barrier();
                float run = 0.f;
#pragma unroll
                for (int t = 0; t < 32; ++t) { const float f = lbd + (1.0f - lbd) * fsigmoid(Lg[t * HGP + c.lane]); run += __builtin_amdgcn_logf(f); Lg[t * HGP + c.lane] = run; Lk[t * HGP + c.lane] = 1.0f - f; }
                LG[c.lane] = run; LeG[c.lane] = __builtin_amdgcn_exp2f(run); gtot += run;
            }
            __builtin_amdgcn_wave_barrier();
            bf16x8 vt[2][2];
#pragma unroll
            for (int nf = 0; nf < 2; ++nf)
#pragma unroll
                for (int ks = 0; ks < 2; ++ks) vt[nf][ks] = *(const bf16x8*)(Lvt + (32 * nf + l31) * HGV + 16 * ks + 8 * hi);
            f32x16 O[2];
            if (OUT) {
#pragma unroll
                for (int r = 0; r < 16; ++r) { O[0][r] = 0.f; O[1][r] = 0.f; }
                float acc[8];
#pragma unroll
                for (int m = 0; m < 8; ++m) acc[m] = 0.f;
                const int sb = (l31 & 16) + 8 * hi;
#pragma unroll 1
                for (int d4 = 0; d4 < 16; ++d4) { const f32x4 qt = *(const f32x4*)(Lq + l31 * HGP + 4 * d4), gt = *(const f32x4*)(Lg + l31 * HGP + 4 * d4);
#pragma unroll
                    for (int mg = 0; mg < 4; ++mg) {
                        f32x4 k4[2], g4[2];
#pragma unroll
                        for (int j = 0; j < 2; ++j) { const int s = sb + 2 * mg + j; k4[j] = *(const f32x4*)(Lk + s * HGP + 4 * d4); g4[j] = *(const f32x4*)(Lg + s * HGP + 4 * d4); }
                        __builtin_amdgcn_sched_barrier(0);
#pragma unroll
                        for (int j = 0; j < 2; ++j)
#pragma unroll
                            for (int e = 0; e < 4; ++e) acc[mg * 2 + j] += qt[e] * k4[j][e] * __builtin_amdgcn_exp2f(gt[e] - g4[j][e]);
                        __builtin_amdgcn_sched_barrier(0); } }
                bf16x8 af[2], afx;
                { float a8[8];
#pragma unroll
                    for (int j = 0; j < 8; ++j) a8[j] = (sb + j <= l31) ? acc[j] : 0.f;
                    const bf16x8 ad = __builtin_bit_cast(bf16x8, pk8p(a8)), az = (bf16x8){0, 0, 0, 0, 0, 0, 0, 0};
                    af[0] = (l31 < 16) ? ad : az; af[1] = (l31 < 16) ? az : ad; }
                {
                    f32x16 dx;
#pragma unroll
                    for (int r = 0; r < 16; ++r) dx[r] = 0.f;
                    const bool lowr = l31 < 16; const float* Lx = lowr ? Lk : Lq;
#pragma unroll
                    for (int kk = 0; kk < 4; ++kk) { const int d0 = 16 * kk + 8 * hi;
                        const f32x4 xa = *(const f32x4*)(Lx + l31 * HGP + d0), xb = *(const f32x4*)(Lx + l31 * HGP + d0 + 4), ga = *(const f32x4*)(Lg + l31 * HGP + d0), gb = *(const f32x4*)(Lg + l31 * HGP + d0 + 4),
                                    ma = *(const f32x4*)(Lg + 15 * HGP + d0), mb = *(const f32x4*)(Lg + 15 * HGP + d0 + 4);
                        float v8[8];
#pragma unroll
                        for (int j = 0; j < 4; ++j) { const float da = ga[j] - ma[j], db = gb[j] - mb[j];
                            v8[j] = xa[j] * __builtin_amdgcn_exp2f(lowr ? -da : da); v8[4 + j] = xb[j] * __builtin_amdgcn_exp2f(lowr ? -db : db); }
                        const bf16x8 vv = __builtin_bit_cast(bf16x8, pk8p(v8)), zz = (bf16x8){0, 0, 0, 0, 0, 0, 0, 0};
                        dx = MFMA32(lowr ? vv : zz, lowr ? zz : vv, dx); }
                    float x8[8];
#pragma unroll
                    for (int j = 0; j < 8; ++j) x8[j] = dx[j];
                    afx = __builtin_bit_cast(bf16x8, pk8(x8)); }
#pragma unroll
                for (int mf = 0; mf < 2; ++mf)
#pragma unroll
                    for (int s = 0; s < 2; ++s) { const int d0 = 32 * mf + 16 * s + 4 * hi;
                        const f32x4 qa = *(const f32x4*)(Lq + l31 * HGP + d0), qb = *(const f32x4*)(Lq + l31 * HGP + d0 + 8), ga = *(const f32x4*)(Lg + l31 * HGP + d0), gb = *(const f32x4*)(Lg + l31 * HGP + d0 + 8);
                        float q8[8];
#pragma unroll
                        for (int j = 0; j < 4; ++j) { q8[j] = qa[j] * __builtin_amdgcn_exp2f(ga[j]); q8[4 + j] = qb[j] * __builtin_amdgcn_exp2f(gb[j]); }
                        const bf16x8 qf = __builtin_bit_cast(bf16x8, pk8p(q8));
#pragma unroll
                        for (int nf = 0; nf < 2; ++nf) { float s8[8];
#pragma unroll
                            for (int j = 0; j < 8; ++j) s8[j] = S[mf][nf][8 * s + j];
                            O[nf] = MFMA32(qf, __builtin_bit_cast(bf16x8, pk8p(s8)), O[nf]); } }
#pragma unroll
                for (int nf = 0; nf < 2; ++nf) {
#pragma unroll
                    for (int ks = 0; ks < 2; ++ks) O[nf] = MFMA32(af[ks], vt[nf][ks], O[nf]);
                    const s16x4 p0 = *(const s16x4*)(Lvt + (32 * nf + l31) * HGV + 4 * hi), p1 = *(const s16x4*)(Lvt + (32 * nf + l31) * HGV + 8 + 4 * hi);
                    O[nf] = MFMA32(afx, ((bf16x8){p0[0], p0[1], p0[2], p0[3], p1[0], p1[1], p1[2], p1[3]}), O[nf]); }
            }
#pragma unroll
            for (int mf = 0; mf < 2; ++mf) {
#pragma unroll
                for (int q = 0; q < 4; ++q) { const f32x4 e4 = *(const f32x4*)(LeG + 32 * mf + 8 * q + 4 * hi);
#pragma unroll
                    for (int e = 0; e < 4; ++e) { S[mf][0][4 * q + e] *= e4[e]; S[mf][1][4 * q + e] *= e4[e]; } }
                const int d = 32 * mf + l31; const float Gd = LG[d];
#pragma unroll
                for (int ks = 0; ks < 2; ++ks) { float k8[8];
#pragma unroll
                    for (int j = 0; j < 8; ++j) { const int s = 16 * ks + 8 * hi + j; k8[j] = Lk[s * HGP + d] * __builtin_amdgcn_exp2f(Gd - Lg[s * HGP + d]); }
                    const bf16x8 kf = __builtin_bit_cast(bf16x8, pk8p(k8));
                    S[mf][0] = MFMA32(kf, vt[0][ks], S[mf][0]); S[mf][1] = MFMA32(kf, vt[1][ks], S[mf][1]); } }
            if (OUT) {
                {
                    const int rr = c.lane >> 3, c8 = (c.lane & 7) * 8; const bf16_t* zg = Z + (size_t)(tokb + rr) * ZP + Z_HG + h * 64 + c8; u32x2 gv[4];
#pragma unroll
                    for (int hf = 0; hf < 2; ++hf) {
#pragma unroll
                    for (int i = 0; i < 4; ++i) gv[i] = *(const u32x2*)(zg + (size_t)i * 8 * ZP + 4 * hf);
#pragma unroll
                    for (int i = 0; i < 4; ++i) { const u32x2 v = gv[i]; *(f32x4*)(Lq + (i * 8 + rr) * HGP + c8 + 4 * hf) = (f32x4){fsilu(bflo(v.x)), fsilu(bfhi(v.x)), fsilu(bflo(v.y)), fsilu(bfhi(v.y))}; } }
                }
                __builtin_amdgcn_wave_barrier();
#pragma unroll
                for (int r = 0; r < 16; ++r) { const int tl = (r & 3) + 8 * (r >> 2) + 4 * hi; float ss = O[0][r] * O[0][r] + O[1][r] * O[1][r];
                    ss = half_sum(ss, hi);
                    const float rinv = frsqrt(ss * (1.0f / 64.0f) + EPS); const size_t tok = (size_t)(tokb + tl);
                    const float g0 = Lq[tl * HGP + l31], g1 = Lq[tl * HGP + 32 + l31];
                    bf16_t* yo = c.w<bf16_t>(WS_YB) + tok * 1024 + 512 + h * 64;
                    yo[l31] = (bf16_t)f2bf_bits(O[0][r] * rinv * og0 * g0); yo[32 + l31] = (bf16_t)f2bf_bits(O[1][r] * rinv * og1 * g1); } }
            __builtin_amdgcn_wave_barrier();
        }
        if (!OUT) { float* sc = c.w<float>(WS_SC) + (size_t)(bh * NCH + chunk) * 4096;
#pragma unroll
            for (int mf = 0; mf < 2; ++mf)
#pragma unroll
                for (int nf = 0; nf < 2; ++nf)
#pragma unroll
                    for (int r = 0; r < 16; ++r) sc[(32 * mf + (r & 3) + 8 * (r >> 2) + 4 * hi) * 64 + 32 * nf + l31] = S[mf][nf][r];
            c.w<float>(WS_PC)[(size_t)(bh * NCH + chunk) * 64 + c.lane] = __builtin_amdgcn_exp2f(gtot); }
    } else if (OUT && cvt_layer < NL) {
        cvt_wave(c, cvt_layer, bu * 4 + (c.wid - 4), NBH * NCH, (float*)(c.lds + 4 * HG_BYTES + (c.wid - 4) * 8448));
    }
    __syncthreads();
}
__device__ __forceinline__ void hgrn_carry(const Ctx& c_, int l) { const Ctx c = fresh(c_);
    const float* SC = c.w<float>(WS_SC); const float* PC = c.w<float>(WS_PC); float* S0 = c.w<float>(WS_S0);
    for (int e = c.blk * 512 + c.tid; e < NBH * 4096; e += c.G * 512) { const int bh = e >> 12, dv = e & 4095, d = dv >> 6; float s = 0.f;
#pragma unroll 8
        for (int ch = 0; ch < NCH; ++ch) { const size_t o = (size_t)(bh * NCH + ch) * 4096 + dv; S0[o] = s; s = PC[(size_t)(bh * NCH + ch) * 64 + d] * s + SC[o]; } }
    ASMV("s_waitcnt vmcnt(0)" ::: "memory");
    __syncthreads();
    if (c.tid == 0) { __builtin_amdgcn_fence(__ATOMIC_RELEASE, "agent"); ASMV("s_waitcnt vmcnt(0)" ::: "memory");
        (void)__hip_atomic_fetch_add((unsigned*)(c.ws + WS_CTL + CTL_HG) + l * 64, 1u, __ATOMIC_RELAXED, __HIP_MEMORY_SCOPE_AGENT); }
}
__device__ __forceinline__ void hgrn_wait_carry(const Ctx& c, int l) {
    if (c.tid == 0) { unsigned* p = (unsigned*)(c.ws + WS_CTL + CTL_HG) + l * 64; unsigned sp = 0;
        while (__hip_atomic_load(p, __ATOMIC_RELAXED, __HIP_MEMORY_SCOPE_AGENT) < (unsigned)c.G) { __builtin_amdgcn_s_sleep(1); if (++sp > (1u << 22)) break; }
        __builtin_amdgcn_fence(__ATOMIC_ACQUIRE, "agent"); ASMV("s_waitcnt vmcnt(0)" ::: "memory"); }
    __syncthreads();
}
__device__ __forceinline__ void ph_mixers(const Ctx& c, int l) {
    if (c.blk & 1) for (int bu = c.blk; bu < NBH * NCH / 4; bu += c.G) hgrn_mfma<false>(c, l, bu);
    for (int u = c.blk; u < NTOK / 32; u += c.G) mix_unit(c, l, u * 32);
    if (!(c.blk & 1)) for (int bu = c.blk; bu < NBH * NCH / 4; bu += c.G) hgrn_mfma<false>(c, l, bu);
}

__device__ __forceinline__ void attn_unit(const Ctx& c_, int bh, int qt) { const Ctx c = fresh(c_);
    const bf16_t* Qg = c.w<bf16_t>(WS_Q) + (size_t)bh * SEQ * 96; const bf16_t* Kg = c.w<bf16_t>(WS_K) + (size_t)bh * SEQ * 96; const bf16_t* Vg = c.w<bf16_t>(WS_VT) + (size_t)bh * 64 * SEQ;
    constexpr int KROW = 104, VROW = 72, KB = 64 * KROW * 2, VB = 64 * VROW * 2;
    const int l31 = c.lane & 31, hi = c.lane >> 5, qrow = qt * 256 + c.wid * 32 + l31;
    bf16x8 qf[6];
#pragma unroll
    for (int ks = 0; ks < 6; ++ks) qf[ks] = *(const bf16x8*)(Qg + (size_t)qrow * 96 + ks * 16 + hi * 8);
    f32x16 o0, o1;
#pragma unroll
    for (int r = 0; r < 16; ++r) { o0[r] = 0.f; o1[r] = 0.f; }
    float mrun = -INFINITY, lsum = 0.f;
    const int nkt = 4 * (qt + 1), mylast = 4 * qt + (c.wid >> 1);
    const int kr0 = c.tid / 12, kc0 = c.tid % 12, kr1 = (c.tid + 512) / 12, kc1 = (c.tid + 512) % 12, vr = c.tid >> 3, vc = c.tid & 7;
    u32x4 sk0, sk1, sv;
    auto gload = [&](int kt) { sk0 = *(const u32x4*)(Kg + (size_t)(kt * 64 + kr0) * 96 + kc0 * 8); if (c.tid < 256) sk1 = *(const u32x4*)(Kg + (size_t)(kt * 64 + kr1) * 96 + kc1 * 8);
                               sv = *(const u32x4*)(Vg + (size_t)vr * SEQ + kt * 64 + vc * 8); };
    auto lstore = [&](int buf) { unsigned char* kb = c.lds + buf * (KB + VB); unsigned char* vb = kb + KB;
                                 *(u32x4*)(kb + (kr0 * KROW + kc0 * 8) * 2) = sk0; if (c.tid < 256) *(u32x4*)(kb + (kr1 * KROW + kc1 * 8) * 2) = sk1; *(u32x4*)(vb + (vr * VROW + vc * 8) * 2) = sv; };
    gload(0); lstore(0); __syncthreads();
    auto tile = [&](const int kt, auto masked) {
            const bf16_t* kb = (const bf16_t*)(c.lds + (kt & 1) * (KB + VB)); const bf16_t* vb = (const bf16_t*)(c.lds + (kt & 1) * (KB + VB) + KB);
            f32x16 s0, s1;
#pragma unroll
            for (int r = 0; r < 16; ++r) { s0[r] = 0.f; s1[r] = 0.f; }
#pragma unroll
            for (int ks = 0; ks < 6; ++ks) { const bf16x8 k0 = *(const bf16x8*)(kb + l31 * KROW + ks * 16 + hi * 8), k1 = *(const bf16x8*)(kb + (32 + l31) * KROW + ks * 16 + hi * 8);
                s0 = MFMA32(k0, qf[ks], s0); s1 = MFMA32(k1, qf[ks], s1); }
            if constexpr (decltype(masked)::value) {
#pragma unroll
                for (int r = 0; r < 16; ++r) { const int key = kt * 64 + (r & 3) + 8 * (r >> 2) + 4 * hi; if (key > qrow) s0[r] = -INFINITY; if (key + 32 > qrow) s1[r] = -INFINITY; } }
            float mx = s0[0];
#pragma unroll
            for (int r = 1; r < 16; ++r) mx = fmaxf(mx, s0[r]);
#pragma unroll
            for (int r = 0; r < 16; ++r) mx = fmaxf(mx, s1[r]);
            mx = fmaxf(mx, __shfl_xor(mx, 32));
            const float mnew = fmaxf(mrun, mx), alpha = __builtin_amdgcn_exp2f(mrun - mnew); mrun = mnew;
            float ps = 0.f;
#pragma unroll
            for (int r = 0; r < 16; ++r) { s0[r] = __builtin_amdgcn_exp2f(s0[r] - mnew); s1[r] = __builtin_amdgcn_exp2f(s1[r] - mnew); ps += s0[r] + s1[r]; }
            lsum = lsum * alpha + ps;
#pragma unroll
            for (int r = 0; r < 16; ++r) { o0[r] *= alpha; o1[r] *= alpha; }
#pragma unroll
            for (int kf = 0; kf < 2; ++kf)
#pragma unroll
                for (int s = 0; s < 2; ++s) { const f32x16& sx = kf ? s1 : s0; u32x4 pw; pw.x = cvt_pk_bf16(sx[8 * s], sx[8 * s + 1]); pw.y = cvt_pk_bf16(sx[8 * s + 2], sx[8 * s + 3]); pw.z = cvt_pk_bf16(sx[8 * s + 4], sx[8 * s + 5]); pw.w = cvt_pk_bf16(sx[8 * s + 6], sx[8 * s + 7]);
                    const bf16x8 pf = __builtin_bit_cast(bf16x8, pw); const int kcol = kf * 32 + 16 * s + 4 * hi;
                    const s16x4 a0 = *(const s16x4*)(vb + l31 * VROW + kcol), a1 = *(const s16x4*)(vb + l31 * VROW + kcol + 8), b0 = *(const s16x4*)(vb + (32 + l31) * VROW + kcol), b1 = *(const s16x4*)(vb + (32 + l31) * VROW + kcol + 8);
                    const bf16x8 v0 = (bf16x8){a0[0], a0[1], a0[2], a0[3], a1[0], a1[1], a1[2], a1[3]}, v1 = (bf16x8){b0[0], b0[1], b0[2], b0[3], b1[0], b1[1], b1[2], b1[3]};
                    o0 = MFMA32(v0, pf, o0); o1 = MFMA32(v1, pf, o1); }
            };
    int kt = 0;
    for (; kt < mylast; ++kt) { gload(kt + 1); tile(kt, std::false_type{}); lstore((kt + 1) & 1); __syncthreads(); }
    { if (kt + 1 < nkt) gload(kt + 1); tile(kt, std::true_type{}); if (kt + 1 < nkt) lstore((kt + 1) & 1); __syncthreads(); ++kt; }
    for (; kt < nkt; ++kt) { if (kt + 1 < nkt) { gload(kt + 1); lstore((kt + 1) & 1); } __syncthreads(); }
    lsum += __shfl_xor(lsum, 32); const float rl = 1.0f / lsum;
    const int b = bh >> 2, h = bh & 3; bf16_t* yo = c.w<bf16_t>(WS_YB) + (size_t)(b * SEQ + qrow) * 1024 + h * 64;
#pragma unroll
    for (int g = 0; g < 4; ++g) { const int dv = 8 * g + 4 * hi; u32x2 w0, w1;
        w0.x = cvt_pk_bf16(o0[4 * g] * rl, o0[4 * g + 1] * rl); w0.y = cvt_pk_bf16(o0[4 * g + 2] * rl, o0[4 * g + 3] * rl); *(u32x2*)(yo + dv) = w0;
        w1.x = cvt_pk_bf16(o1[4 * g] * rl, o1[4 * g + 1] * rl); w1.y = cvt_pk_bf16(o1[4 * g + 2] * rl, o1[4 * g + 3] * rl); *(u32x2*)(yo + 32 + dv) = w1; }
    __syncthreads();
}
__device__ __forceinline__ void ph_attn(const Ctx& c, int l) {
    hgrn_carry(c, l);
    { const int NU = NBH * (NQT / 2);
      if ((c.G & 7) == 0) { const int per = (NU + 7) / 8, x = c.blk & 7, G8 = c.G >> 3;
          for (int j = c.blk >> 3; j < per; j += G8) { const int pu = x * per + j; if (pu < NU) { const int bh = pu / (NQT / 2), p = pu % (NQT / 2); attn_unit(c, bh, NQT - 1 - p); attn_unit(c, bh, p); } } }
      else for (int pu = c.blk; pu < NU; pu += c.G) { const int bh = pu / (NQT / 2), p = pu % (NQT / 2); attn_unit(c, bh, NQT - 1 - p); attn_unit(c, bh, p); } }
    hgrn_wait_carry(c, l);
    for (int bu = c.blk; bu < NBH * NCH / 4; bu += c.G) hgrn_mfma<true>(c, l, bu, l + 1);
}

__device__ __forceinline__ void ph_router(const Ctx& c_, int l, int cnt_off = 0) { const Ctx c = fresh(c_);
    bf16_t* Whi = (bf16_t*)c.lds; bf16_t* Wlo = (bf16_t*)(c.lds + 73728); float* Llog = (float*)(c.lds + 147456) + c.wid * 288; float* Lcb = (float*)(c.lds + 156672);
    int* Le = (int*)(c.lds + 156672 + 256); float* Lw = (float*)(c.lds + 156672 + 256 + 1024); int* Lr = (int*)(c.lds + 156672 + 256 + 2048); int* Lcnt = (int*)(c.lds + 156672 + 256 + 3072); int* Lbase = Lcnt + 32;
    const float* rwt = c.w<float>(WS_RWT + (size_t)(l & 1) * WSET);
    const float* rgb = c.inf(I_RGB) + l * 4; const float* reb = c.inf(I_REB) + l * 32;
    const bf16_t* x = c.w<bf16_t>(WS_XB); const float* gn = c.inf(I_N2G) + l * 1024; const float* mod = c.w<float>(WS_MOD) + (size_t)l * NB * 6144; bf16_t* ha = c.w<bf16_t>(WS_HA);
    unsigned* cnt = (unsigned*)(c.ws + WS_CTL + CTL_CNT) + l * 32 + cnt_off;
    int* asge = c.w<int>(WS_ASGE); int* asgr = c.w<int>(WS_ASGR); float* asgw = c.w<float>(WS_ASGW);
    const int fr = c.lane & 15, fq = c.lane >> 4;
    int staged_b = -1;
    for (int u = c.blk; u < NTOK / 128; u += c.G) {
        const int b = (u * 128) / SEQ; const float* sh = mod + b * 6144 + 3072; const float* sc = sh + 1024;
        __syncthreads();
        if (b != staged_b) { staged_b = b;
            for (int q = c.tid; q < 36 * 128; q += 512) { const int n = q >> 7, ch = q & 127, k0 = ch * 8; float hi8[8], lo8[8];
#pragma unroll
                for (int j = 0; j < 8; ++j) { const float w = rwt[n * 1024 + k0 + j] * gn[k0 + j] * (1.0f + sc[k0 + j]); const float h = bf2f((bf16_t)f2bf_bits(w)); hi8[j] = h; lo8[j] = w - h; }
                const int pc = (ch ^ (n & 15)) * 8; *(u32x4*)(Whi + n * 1024 + pc) = pk8(hi8); *(u32x4*)(Wlo + n * 1024 + pc) = pk8(lo8); }
            for (int g = c.wid; g < 36; g += 8) { float s = 0.f;
#pragma unroll
                for (int i = 0; i < 4; ++i) { const f32x4 w = *(const f32x4*)(rwt + g * 1024 + i * 256 + c.lane * 4), s4 = *(const f32x4*)(sh + i * 256 + c.lane * 4); s += w[0] * s4[0] + w[1] * s4[1] + w[2] * s4[2] + w[3] * s4[3]; }
                s = wave_sum(s); if (c.lane == 0) Lcb[g] = s + (g < 4 ? rgb[g] : reb[g - 4]); } }
        if (c.tid < 32) Lcnt[c.tid] = 0;
        __syncthreads();
        const int rowb = u * 128 + c.wid * 16; const bf16_t* xr = x + (size_t)(rowb + fr) * 1024 + 8 * fq;
        f32x4 acc[3] = {{0.f, 0.f, 0.f, 0.f}, {0.f, 0.f, 0.f, 0.f}, {0.f, 0.f, 0.f, 0.f}}; float ssp = 0.f;
#pragma unroll 4
        for (int ks = 0; ks < 32; ++ks) { const u32x4 hw = *(const u32x4*)(xr + 32 * ks);
            const unsigned hws[4] = {hw.x, hw.y, hw.z, hw.w};
#pragma unroll
            for (int j = 0; j < 4; ++j) { const float a = bflo(hws[j]), b = bfhi(hws[j]); ssp += a * a + b * b; }
            const bf16x8 ah = __builtin_bit_cast(bf16x8, hw);
            const int ch = 4 * ks + fq;
#pragma unroll
            for (int nf = 0; nf < 3; ++nf) { const int n = 16 * nf + fr; bf16x8 bh = {0, 0, 0, 0, 0, 0, 0, 0}, bl = bh;
                if (nf < 2 || fr < 4) { const int pc = (ch ^ (n & 15)) * 8; bh = *(const bf16x8*)(Whi + n * 1024 + pc); bl = *(const bf16x8*)(Wlo + n * 1024 + pc); }
                acc[nf] = MFMA16(ah, bh, acc[nf]); acc[nf] = MFMA16(ah, bl, acc[nf]); } }
        ssp += __shfl_xor(ssp, 16); ssp += __shfl_xor(ssp, 32);
        const float rinv = frsqrt(ssp * (1.0f / 1024.0f) + EPS);
        float rj[4];
#pragma unroll
        for (int j = 0; j < 4; ++j) rj[j] = __shfl(rinv, fq * 4 + j);
#pragma unroll
        for (int half = 0; half < 2; ++half) {
            if ((fq >> 1) == half) {
#pragma unroll
                for (int nf = 0; nf < 3; ++nf) { const int col = 16 * nf + fr; if (col < 36) {
#pragma unroll
                    for (int j = 0; j < 4; ++j) Llog[((fq & 1) * 4 + j) * 36 + col] = acc[nf][j] * rj[j] + Lcb[col]; } } }
            __builtin_amdgcn_wave_barrier();
            if (c.lane < 8) { const float* lg = Llog + c.lane * 36; const int rl = c.wid * 16 + half * 8 + c.lane;
                int gi = 0; float gm = lg[0];
#pragma unroll
                for (int g = 1; g < 4; ++g) { const float t = lg[g]; if (t > gm) { gm = t; gi = g; } }
                float den = 0.f;
#pragma unroll
                for (int g = 0; g < 4; ++g) den += expf(lg[g] - gm);
                const float gw = 1.0f / den;
                float e1 = -INFINITY, e2 = -INFINITY; int i1 = 0, i2 = 0;
#pragma unroll
                for (int j = 0; j < 8; ++j) { const float t = lg[4 + gi * 8 + j]; if (t > e1) { e2 = e1; i2 = i1; e1 = t; i1 = j; } else if (t > e2) { e2 = t; i2 = j; } }
                const float p2 = expf(e2 - e1), w1 = gw / (1.0f + p2), w2 = gw * p2 / (1.0f + p2);
                const int ea = gi * 8 + i1, eb = gi * 8 + i2; Le[rl * 2] = ea; Le[rl * 2 + 1] = eb; Lw[rl * 2] = w1; Lw[rl * 2 + 1] = w2;
                Lr[rl * 2] = atomicAdd(&Lcnt[ea], 1); Lr[rl * 2 + 1] = atomicAdd(&Lcnt[eb], 1); }
            __builtin_amdgcn_wave_barrier();
        }
#pragma unroll 4
        for (int ks = 0; ks < 32; ++ks) { const int k0 = 32 * ks + 8 * fq; const u32x4 xw = *(const u32x4*)(xr + 32 * ks); const f32x4 xa = {bflo(xw.x), bfhi(xw.x), bflo(xw.y), bfhi(xw.y)}, xb = {bflo(xw.z), bfhi(xw.z), bflo(xw.w), bfhi(xw.w)};
            const f32x4 ga = *(const f32x4*)(gn + k0) * (*(const f32x4*)(sc + k0) + 1.0f), gb = *(const f32x4*)(gn + k0 + 4) * (*(const f32x4*)(sc + k0 + 4) + 1.0f);
            const f32x4 ha4 = xa * rinv * ga + *(const f32x4*)(sh + k0), hb4 = xb * rinv * gb + *(const f32x4*)(sh + k0 + 4);
            u32x4 o; o.x = cvt_pk_bf16(ha4[0], ha4[1]); o.y = cvt_pk_bf16(ha4[2], ha4[3]); o.z = cvt_pk_bf16(hb4[0], hb4[1]); o.w = cvt_pk_bf16(hb4[2], hb4[3]);
            *(u32x4*)(ha + (size_t)(rowb + fr) * 1024 + k0) = o; }
        __syncthreads();
        if (c.tid < 32) Lbase[c.tid] = (int)__hip_atomic_fetch_add(&cnt[c.tid], (unsigned)Lcnt[c.tid], __ATOMIC_RELAXED, __HIP_MEMORY_SCOPE_AGENT);
        __syncthreads();
        if (c.tid < 256) { const int a = u * 256 + c.tid, e = Le[c.tid]; asge[a] = e; asgr[a] = Lbase[e] + Lr[c.tid]; asgw[a] = Lw[c.tid]; }
    }
    __syncthreads();
}
__device__ __forceinline__ void ph_gather(const Ctx& c_, int l) { const Ctx c = fresh(c_);
    int* Lps = (int*)c.lds; int* Lcn = Lps + 40;
    unsigned* cnt = (unsigned*)(c.ws + WS_CTL + CTL_CNT) + l * 32;
    if (c.tid < 32) Lcn[c.tid] = (int)__hip_atomic_load(&cnt[c.tid], __ATOMIC_RELAXED, __HIP_MEMORY_SCOPE_AGENT);
    __syncthreads();
    if (c.tid == 0) { int acc = 0; for (int e = 0; e < 32; ++e) { Lps[e] = acc; acc += (Lcn[e] + 255) / 256 * 256; } Lps[32] = acc; }
    __syncthreads();
    int* rowtok = c.w<int>(WS_ROWTOK); float* roww = c.w<float>(WS_ROWW);
    if (c.blk == 0) { int* tile = c.w<int>(WS_TILE); if (c.tid == 0) tile[0] = Lps[32] / 256;
        for (int e = c.tid; e < 32; e += 512) for (int t = Lps[e] / 256; t < Lps[e + 1] / 256; ++t) tile[1 + t] = e; }
    for (int e = c.blk; e < 32; e += c.G) for (int r = Lps[e] + Lcn[e] + c.tid; r < Lps[e + 1]; r += 512) rowtok[r] = -1;
    const int* asge = c.w<int>(WS_ASGE); const int* asgr = c.w<int>(WS_ASGR); const float* asgw = c.w<float>(WS_ASGW);
    for (int a = c.blk * 512 + c.tid; a < NTOK * 2; a += c.G * 512) { const int dest = Lps[asge[a]] + asgr[a]; rowtok[dest] = a; roww[dest] = asgw[a]; }
}
__device__ __forceinline__ void ph_final(const Ctx& c_) { const Ctx c = fresh(c_);
    float* out = c.a->out; const bf16_t* y1 = c.w<bf16_t>(WS_Y1);
    const bf16_t* xb = c.w<bf16_t>(WS_XB);
    for (size_t e = (size_t)c.blk * 512 + c.tid; e < (size_t)NTOK * 128; e += (size_t)c.G * 512) { const u32x4 y = *(const u32x4*)(y1 + e * 8), xw = *(const u32x4*)(xb + e * 8);
        *(f32x4*)(out + e * 8) = (f32x4){bflo(xw.x), bfhi(xw.x), bflo(xw.y), bfhi(xw.y)} + (f32x4){bflo(y.x), bfhi(y.x), bflo(y.y), bfhi(y.y)};
        *(f32x4*)(out + e * 8 + 4) = (f32x4){bflo(xw.z), bfhi(xw.z), bflo(xw.w), bfhi(xw.w)} + (f32x4){bflo(y.z), bfhi(y.z), bflo(y.w), bfhi(y.w)}; }
}

constexpr int PH_PER_LAYER = 9, N_PHASES = 2 + PH_PER_LAYER * NL + 1;
__global__ void __launch_bounds__(512, 2) mk_fwd(Args args) {
#ifdef EMU
    unsigned char* lds = emu_lds();
#else
    extern __shared__ __attribute__((aligned(16))) unsigned char lds[];
#endif
    Ctx c; c.a = &args; c.ws = args.ws; c.lds = lds; c.tid = threadIdx.x; c.wid = __builtin_amdgcn_readfirstlane(c.tid >> 6); c.lane = c.tid & 63; c.G = gridDim.x; c.blk = blockIdx.x;
    if (c.tid == 0) *(uint4*)(lds + LDS_XB) = make_uint4(0u, 0u, 0u, 0u);
    __syncthreads();
    XcdBarrier bar; bar.bar = (unsigned*)(args.ws + WS_CTL); bar.x = 0; bar.st = (volatile LAS unsigned*)(lds + LDS_XB);
    if (args.ph_hi - args.ph_lo > 1) bar = xcd_barrier_post((unsigned*)(args.ws + WS_CTL), (volatile LAS unsigned*)(lds + LDS_XB));
    int ph = 0;
#ifndef PHMASK
#define PHMASK 0xFFFFF
#endif
#define PHASE(K, ...) do { if (ph >= args.ph_lo && ph < args.ph_hi) { if constexpr ((PHMASK >> K) & 1) { __VA_ARGS__; } if (ph + 1 < args.ph_hi) xcd_barrier(bar); } ++ph; } while (0)
    PHASE(0, ph_prologue0(c));
    PHASE(1, ph_prologue1(c));
    for (int l = 0; l < NL; ++l) {
        PHASE(2, if (l == 0) ph_cvt(c, 0); ph_normrows(c, l));
        PHASE(3, { pg8::Gemm g{c.w<bf16_t>(WS_HA), c.w<bf16_t>(WS_WIN + (size_t)(l & 1) * WSET), NTOK, ZP, 1024}; pg8::StaticOrder S; S.init(NTOK, ZP, c.G, c.blk); pg8::EpiBf16 E{c.w<bf16_t>(WS_Z), ZP};
                pg8::gemm_phase<pg8::EpiBf16, pg8::StaticOrder, true, true>((LAS unsigned char*)lds, g, S, E); });
        PHASE(4, ph_mixers(c, l));
        PHASE(5, ph_attn(c, l));
        PHASE(6, { pg8::Gemm g{c.w<bf16_t>(WS_YB), c.w<bf16_t>(WS_WOUT + (size_t)(l & 1) * WSET), NTOK, 1024, 1024}; pg8::StaticOrder S; S.init(NTOK, 1024, c.G, c.blk);
                pg8::EpiResid E{(l == 0) ? c.inf(I_X) : (const float*)nullptr, c.w<bf16_t>(WS_XB), c.w<bf16_t>(WS_XB), c.w<float>(WS_MOD) + (size_t)l * NB * 6144 + 2048, 6144, SEQ, c.w<bf16_t>(WS_Y1)};
                pg8::gemm_phase<pg8::EpiResid, pg8::StaticOrder, true, true>((LAS unsigned char*)lds, g, S, E); });
        PHASE(7, ph_router(c, l));
        PHASE(8, ph_gather(c, l));
        PHASE(9, { pg8::Gemm g{c.w<bf16_t>(WS_HA), c.w<bf16_t>(WS_WUP + (size_t)(l & 1) * WSET), NR, 32 * 1024, 1024}; pg8::MoeOrder S{c.w<int>(WS_TILE), c.G, c.blk}; pg8::EpiSwiglu E{c.w<bf16_t>(WS_Q)};
                pg8::gemm_phase<pg8::EpiSwiglu, pg8::MoeOrder, true, true, true>((LAS unsigned char*)lds, g, S, E, c.w<int>(WS_ROWTOK)); });
        PHASE(10, { pg8::Gemm g{c.w<bf16_t>(WS_Q), c.w<bf16_t>(WS_WDN + (size_t)(l & 1) * WSET), NR, 32 * 1024, 512}; pg8::MoeOrder S{c.w<int>(WS_TILE), c.G, c.blk};
                pg8::EpiDown E{c.w<int>(WS_ROWTOK), c.w<float>(WS_ROWW), c.w<bf16_t>(WS_XB), c.w<bf16_t>(WS_Y1), c.w<float>(WS_MOD) + (size_t)l * NB * 6144 + 5120, 6144, SEQ};
                pg8::gemm_phase<pg8::EpiDown, pg8::MoeOrder, true, true>((LAS unsigned char*)lds, g, S, E); });
    }
    PHASE(11, ph_final(c));
#undef PHASE
}

extern "C" void kernel_launch(void* const* d_in, const int* in_sizes, int n_in, void* d_out, int out_size, void* d_ws, size_t ws_size, hipStream_t stream) {
    static int grid = 0;
    if (grid == 0) {
        if (n_in != 30 || out_size != NTOK * 1024 || ws_size < WS_END) { fprintf(stderr, "kernel_launch: shape/workspace mismatch (n_in %d out %d ws %zu need %zu)\n", n_in, out_size, ws_size, (size_t)WS_END); grid = -1; return; }
        int dev = 0, cus = 0;
        if (hipGetDevice(&dev) != hipSuccess || hipDeviceGetAttribute(&cus, hipDeviceAttributeMultiprocessorCount, dev) != hipSuccess) { grid = -1; return; }
        if (hipFuncSetAttribute((const void*)mk_fwd, hipFuncAttributeMaxDynamicSharedMemorySize, LDS_BYTES) != hipSuccess) { fprintf(stderr, "kernel_launch: hipFuncSetAttribute failed\n"); grid = -1; return; }
        int per_cu = 0; (void)hipOccupancyMaxActiveBlocksPerMultiprocessor(&per_cu, (const void*)mk_fwd, 512, LDS_BYTES);
        if (per_cu < 1) fprintf(stderr, "kernel_launch: occupancy query says %d blocks per CU\n", per_cu);
        grid = cus;
    }
    if (grid < 0) return;
    (void)hipMemsetAsync((char*)d_ws + WS_CTL, 0, CTL_BYTES, stream);
    Args a{};
    for (int i = 0; i < 30; ++i) a.in[i] = d_in[i];
    a.out = (float*)d_out; a.ws = (unsigned char*)d_ws;
#if MK_SPLIT
    for (int p = 0; p < N_PHASES; ++p) { a.ph_lo = p; a.ph_hi = p + 1;
#else
    { a.ph_lo = 0; a.ph_hi = N_PHASES;
#endif
#ifdef EMU
        EMU_LAUNCH(mk_fwd, grid, 512, LDS_BYTES, stream, a);
#else
        hipLaunchKernelGGL(mk_fwd, dim3(grid), dim3(512), LDS_BYTES, stream, a);
#endif
    }
}
```

```cpp
#include <hip/hip_runtime.h>
#include <cstdio>
#include <cstdint>
#include <type_traits>

#ifndef CFG_B
#define CFG_B 4
#endif
#ifndef CFG_S
#define CFG_S 8192
#endif
#ifndef CFG_L
#define CFG_L 4
#endif
#ifndef MK_SPLIT
#define MK_SPLIT 0
#endif

#ifdef EMU
#define ASMV(...) ((void)0)
#define LAS
#define LAUNDER_V(x) ((void)0)
#define LAUNDER_S(x) ((void)0)
#else
#define ASMV(...) asm volatile(__VA_ARGS__)
#define LAS __attribute__((address_space(3)))
#define LAUNDER_V(x) asm volatile("" : "+v"(x))
#define LAUNDER_S(x) asm volatile("" : "+s"(x))
#endif

typedef unsigned short bf16_t;
typedef short bf16x8 __attribute__((ext_vector_type(8)));
typedef short s16x4 __attribute__((ext_vector_type(4)));
typedef float f32x2 __attribute__((ext_vector_type(2)));
typedef float f32x4 __attribute__((ext_vector_type(4)));
typedef float f32x16 __attribute__((ext_vector_type(16)));
typedef unsigned u32x4 __attribute__((ext_vector_type(4)));
typedef unsigned u32x2 __attribute__((ext_vector_type(2)));

__device__ __forceinline__ float bf2f(bf16_t h) { return __builtin_bit_cast(float, (unsigned)h << 16); }
__device__ __forceinline__ float bflo(unsigned w) { return __builtin_bit_cast(float, w << 16); }
__device__ __forceinline__ float bfhi(unsigned w) { return __builtin_bit_cast(float, w & 0xffff0000u); }
__device__ __forceinline__ unsigned f2bf_bits(float f) { unsigned u = __builtin_bit_cast(unsigned, f); u += 0x7fffu + ((u >> 16) & 1u); return u >> 16; }
#ifdef EMU
__device__ __forceinline__ unsigned cvt_pk_bf16(float lo, float hi) { return f2bf_bits(lo) | (f2bf_bits(hi) << 16); }
__device__ __forceinline__ unsigned cvt_pk_bf16_pinned(float lo, float hi) { return f2bf_bits(lo) | (f2bf_bits(hi) << 16); }
#else
typedef __bf16 bf16v2_t __attribute__((ext_vector_type(2)));
typedef float f32v2_t __attribute__((ext_vector_type(2)));
__device__ __forceinline__ unsigned cvt_pk_bf16(float lo, float hi) { const bf16v2_t r = __builtin_convertvector((f32v2_t){lo, hi}, bf16v2_t); return __builtin_bit_cast(unsigned, r); }
__device__ __forceinline__ unsigned cvt_pk_bf16_pinned(float lo, float hi) { unsigned r; asm volatile("v_cvt_pk_bf16_f32 %0, %1, %2\n\ts_nop 1" : "=v"(r) : "v"(lo), "v"(hi)); return r; }
#endif
__device__ __forceinline__ float fast_exp(float x) { return __builtin_amdgcn_exp2f(x * 1.44269504089f); }
__device__ __forceinline__ float fsigmoid(float x) { return __builtin_amdgcn_rcpf(1.0f + fast_exp(-x)); }
__device__ __forceinline__ float fsilu(float x) { return x * fsigmoid(x); }
__device__ __forceinline__ float frsqrt(float x) { return __builtin_amdgcn_rsqf(x); }
#ifdef EMU
__device__ __forceinline__ float wave_sum(float v) {
#pragma unroll
    for (int m = 32; m >= 1; m >>= 1) v += __shfl_xor(v, m);
    return v;
}
#else
template <int CTRL, int ROW_MASK> __device__ __forceinline__ float dpp_t(float v) { return __builtin_bit_cast(float, __builtin_amdgcn_update_dpp(0, __builtin_bit_cast(int, v), CTRL, ROW_MASK, 0xF, false)); }
#define dpp_f(v, ctrl, rm) dpp_t<ctrl, rm>(v)
__device__ __forceinline__ float wave_sum(float v) {
    v += dpp_f(v, 0xB1, 0xF);
    v += dpp_f(v, 0x4E, 0xF);
    v += dpp_f(v, 0x141, 0xF);
    v += dpp_f(v, 0x140, 0xF);
    v += dpp_f(v, 0x142, 0xA);
    v += dpp_f(v, 0x143, 0xC);
    return __builtin_bit_cast(float, __builtin_amdgcn_readlane(__builtin_bit_cast(int, v), 63));
}
__device__ __forceinline__ float half_sum(float v, int hi) {
    v += dpp_f(v, 0xB1, 0xF); v += dpp_f(v, 0x4E, 0xF); v += dpp_f(v, 0x141, 0xF); v += dpp_f(v, 0x140, 0xF);
    v += dpp_f(v, 0x142, 0xA);
    const float a = __builtin_bit_cast(float, __builtin_amdgcn_readlane(__builtin_bit_cast(int, v), 31)), b = __builtin_bit_cast(float, __builtin_amdgcn_readlane(__builtin_bit_cast(int, v), 63));
    return hi ? b : a;
}
#endif
#ifdef EMU
__device__ __forceinline__ float half_sum(float v, int) {
#pragma unroll
    for (int m = 1; m < 32; m <<= 1) v += __shfl_xor(v, m);
    return v;
}
#endif

namespace pg8 {
#define PG8_LAS LAS
constexpr int BM = 256, BK = 64, HALF = 128, HTB = HALF * BK * 2  , STAGE_BYTES = 8 * HTB, NXCD = 8, WGM = 8;

__host__ __device__ __forceinline__ int lds_byte(int r, int c) { const int st = (r >> 4) * 2 + (c >> 5), rr = r & 15, cc = c & 31, ob = rr * 64 + cc * 2; return st * 1024 + (ob ^ (((ob >> 9) & 1) << 5)); }
__host__ __device__ __forceinline__ void stage_rc(int b, int& R, int& C) { const int st = b / 1024, sb = b % 1024, swz = sb ^ (((sb >> 9) & 1) << 5); R = (st >> 1) * 16 + swz / 64; C = (st & 1) * 32 + (swz % 64) / 2; }
__host__ __device__ __forceinline__ int perm32(int rho) { const int n = rho >> 4, i = rho & 15; return 8 * (i >> 2) + 4 * n + (i & 3); }

struct Unit { int pm, pn; };
struct Gemm { const bf16_t* A; const bf16_t* Bt; int M, N, K; };

struct StaticOrder {
    int nM, nN, nwg, G, c;
    __host__ __device__ void init(int M, int N, int G_, int c_) { nM = M / BM; nN = N / BM; nwg = nM * nN; G = G_; c = c_; }
    __host__ __device__ bool next(int i, Unit& u) const {
        const long L = (long)i * G + c; if (L >= nwg) return false;
        int wgid = (int)L; { const int q = nwg / NXCD, r = nwg % NXCD, xcd = wgid % NXCD, off = wgid / NXCD; wgid = (xcd < r ? xcd * (q + 1) : r * (q + 1) + (xcd - r) * q) + off; }
        const int nig = WGM * nN, gid = wgid / nig, fm = gid * WGM, gsz = (nM - fm) < WGM ? (nM - fm) : WGM;
        u.pm = fm + ((wgid % nig) % gsz); u.pn = (wgid % nig) / gsz; return true;
    }
    __device__ __forceinline__ void a_ready(const Unit&) const {}
    __device__ __forceinline__ void done(const Unit&) const {}
};
template <class Epi, class Sched, bool ALIGN_EPI = false, bool SP2 = false, bool GATHER = false>
__device__ __forceinline__ void gemm_phase(PG8_LAS unsigned char* lds, const Gemm g, const Sched& S, const Epi& E, const int* rowmap = nullptr) {
    int tid = threadIdx.x; LAUNDER_V(tid); const int wid = __builtin_amdgcn_readfirstlane(tid >> 6), lane = tid & 63, wr = wid >> 2, wc = wid & 3, fr = lane & 15, fq = lane >> 4;
    const int K = g.K, nt = K / BK;
    unsigned voffA[2], voffB[2]; int RA[2], CA[2];
#pragma unroll
    for (int i = 0; i < 2; ++i) { int R, C; stage_rc(tid * 16 + i * 8192, R, C); const int Rb = Epi::PERM ? ((R & ~31) + perm32(R & 31)) : R;
        voffA[i] = (unsigned)(R * K + C) * 2u; voffB[i] = (unsigned)(Rb * K + C) * 2u; RA[i] = R; CA[i] = C; }
    const size_t kstep = (size_t)(BK * 2);
    const size_t hstep = (size_t)HALF * K * 2;
    const size_t tstep = 2 * hstep;
    const size_t hA = GATHER ? (size_t)0 : hstep;
    unsigned vA0[2], vA1[2], nA0[2], nA1[2];
    auto rows_of = [&](const Unit& u, unsigned (&o0)[2], unsigned (&o1)[2]) {
#pragma unroll
        for (int i = 0; i < 2; ++i) { if constexpr (GATHER) { int t0 = rowmap[u.pm * BM + RA[i]], t1 = rowmap[u.pm * BM + HALF + RA[i]]; t0 = t0 < 0 ? 0 : (t0 >> 1); t1 = t1 < 0 ? 0 : (t1 >> 1);
                o0[i] = (unsigned)(t0 * K + CA[i]) * 2u; o1[i] = (unsigned)(t1 * K + CA[i]) * 2u; } else { o0[i] = voffA[i]; o1[i] = voffA[i]; } } };
    const unsigned ldsw = (unsigned)wid * 1024u;
    const int aoff = lds_byte(wr * 64 + fr, fq * 8), boff = lds_byte(wc * 32 + fr, fq * 8);
#define PG8_SA(b, h) (((b) * 2 + (h)) * HTB)
#define PG8_SB(b, h) ((4 + (b) * 2 + (h)) * HTB)
#define PG8_STAGE(bufoff, gbase, voff) do { _Pragma("unroll") for (int _i = 0; _i < 2; ++_i) \
        __builtin_amdgcn_global_load_lds((const unsigned*)((const char*)(gbase) + (voff)[_i]), (PG8_LAS unsigned*)(lds + (bufoff) + ldsw + _i * 8192), 16, 0, 0); } while (0)
#define PG8_LDA(dst, b, h) do { _Pragma("unroll") for (int m = 0; m < 4; ++m) _Pragma("unroll") for (int k = 0; k < 2; ++k) dst[m][k] = *(const PG8_LAS bf16x8*)(lds + PG8_SA(b, h) + aoff + m * 2048 + k * 1024); } while (0)
#define PG8_LDB(dst, b, h) do { _Pragma("unroll") for (int n = 0; n < 2; ++n) _Pragma("unroll") for (int k = 0; k < 2; ++k) dst[n][k] = *(const PG8_LAS bf16x8*)(lds + PG8_SB(b, h) + boff + n * 2048 + k * 1024); } while (0)
#define PG8_MMA(ai, bj, At, Bt) do { __builtin_amdgcn_s_setprio(1); _Pragma("unroll") for (int m = 0; m < 4; ++m) _Pragma("unroll") for (int n = 0; n < 2; ++n) _Pragma("unroll") for (int k = 0; k < 2; ++k) \
        acc[ai][bj][m][n] = __builtin_amdgcn_mfma_f32_16x16x32_bf16(Bt[n][k], At[m][k], acc[ai][bj][m][n], 0, 0, 0); __builtin_amdgcn_s_setprio(0); } while (0)
#define PG8_WAIT_V(n) ASMV("s_waitcnt vmcnt(" #n ")" ::: "memory")
#define PG8_WAIT_L(n) ASMV("s_waitcnt lgkmcnt(" #n ")" ::: "memory")
#define PG8_BAR __builtin_amdgcn_s_barrier()
#define PG8_SCHED __builtin_amdgcn_sched_barrier(0)
    Unit cur, nxt; int ui = 0;
    if (!S.next(0, cur)) return;
    f32x4 acc[2][2][4][2];
#pragma unroll
    for (int a = 0; a < 2; ++a)
#pragma unroll
        for (int b = 0; b < 2; ++b)
#pragma unroll
            for (int m = 0; m < 4; ++m)
#pragma unroll
                for (int n = 0; n < 2; ++n) acc[a][b][m][n] = (f32x4){0.f, 0.f, 0.f, 0.f};
    bf16x8 At[4][2], B0[2][2], B1[2][2];
    const char* cA = GATHER ? (const char*)g.A : (const char*)g.A + (size_t)cur.pm * tstep; rows_of(cur, vA0, vA1); const char* cB = (const char*)g.Bt + (size_t)cur.pn * tstep;
    S.a_ready(cur);
    if constexpr (SP2) {
        PG8_STAGE(PG8_SB(0, 0), cB, voffB); PG8_STAGE(PG8_SB(0, 1), cB + hstep, voffB); PG8_STAGE(PG8_SA(0, 0), cA, vA0); PG8_STAGE(PG8_SA(0, 1), cA + hA, vA1);
        if (wr == 1) PG8_BAR;
        PG8_WAIT_V(2); PG8_BAR;
        PG8_STAGE(PG8_SB(1, 0), cB + kstep, voffB); PG8_STAGE(PG8_SA(1, 0), cA + kstep, vA0); PG8_STAGE(PG8_SB(1, 1), cB + hstep + kstep, voffB);
        PG8_WAIT_V(6); PG8_BAR;
    } else {
        PG8_STAGE(PG8_SB(0, 0), cB, voffB); PG8_STAGE(PG8_SA(0, 0), cA, vA0); PG8_STAGE(PG8_SB(0, 1), cB + hstep, voffB); PG8_STAGE(PG8_SA(0, 1), cA + hA, vA1);
        if (wr == 1) PG8_BAR;
        PG8_WAIT_V(4); PG8_BAR;
        PG8_STAGE(PG8_SB(1, 0), cB + kstep, voffB); PG8_STAGE(PG8_SA(1, 0), cA + kstep, vA0); PG8_STAGE(PG8_SB(1, 1), cB + hstep + kstep, voffB);
        PG8_WAIT_V(6); PG8_BAR;
    }
    for (;;) {
        const bool has_next = S.next(ui + 1, nxt);
        const char* nA = GATHER ? (const char*)g.A : (has_next ? (const char*)g.A + (size_t)nxt.pm * tstep : cA);
        if (has_next) rows_of(nxt, nA0, nA1); else { nA0[0] = vA0[0]; nA0[1] = vA0[1]; nA1[0] = vA1[0]; nA1[1] = vA1[1]; } const char* nB = has_next ? (const char*)g.Bt + (size_t)nxt.pn * tstep : cB;
        for (int t = 0; t < nt; t += 2) {
            const bool last = (t == nt - 2);
            unsigned sA0[2], sA1[2];
#pragma unroll
            for (int i = 0; i < 2; ++i) { sA0[i] = last ? nA0[i] : vA0[i]; sA1[i] = last ? nA1[i] : vA1[i]; }
            const char* a1 = cA + (size_t)(t + 1) * kstep;
            const char* a2 = last ? nA : cA + (size_t)(t + 2) * kstep; const char* b2 = last ? nB : cB + (size_t)(t + 2) * kstep;
            const char* a3 = a2 + kstep; const char* b3 = b2 + kstep;
            if (last && has_next) S.a_ready(nxt);
            if constexpr (SP2) {
            PG8_LDB(B0, 0, 0); PG8_LDB(B1, 0, 1); PG8_SCHED; PG8_LDA(At, 0, 0); PG8_STAGE(PG8_SA(1, 1), a1 + hA, vA1);
            PG8_WAIT_V(8); PG8_WAIT_L(0); PG8_BAR; PG8_MMA(0, 0, At, B0); PG8_MMA(0, 1, At, B1); PG8_BAR; PG8_SCHED;
            PG8_LDA(At, 0, 1); PG8_STAGE(PG8_SB(0, 0), b2, voffB); PG8_STAGE(PG8_SB(0, 1), b2 + hstep, voffB); PG8_STAGE(PG8_SA(0, 0), a2, sA0);
            PG8_WAIT_V(8); PG8_WAIT_L(0); PG8_BAR; PG8_MMA(1, 0, At, B0); PG8_MMA(1, 1, At, B1); PG8_BAR; PG8_SCHED;
            PG8_LDB(B0, 1, 0); PG8_LDB(B1, 1, 1); PG8_SCHED; PG8_LDA(At, 1, 0); PG8_STAGE(PG8_SA(0, 1), a2 + hA, sA1);
            PG8_WAIT_V(8); PG8_WAIT_L(0); PG8_BAR; PG8_MMA(0, 0, At, B0); PG8_MMA(0, 1, At, B1); PG8_BAR; PG8_SCHED;
            PG8_LDA(At, 1, 1); PG8_STAGE(PG8_SB(1, 0), b3, voffB); PG8_STAGE(PG8_SB(1, 1), b3 + hstep, voffB); PG8_STAGE(PG8_SA(1, 0), a3, sA0);
            PG8_WAIT_V(8); PG8_WAIT_L(0); PG8_BAR; PG8_MMA(1, 0, At, B0); PG8_MMA(1, 1, At, B1); PG8_BAR; PG8_SCHED;
            } else {
            PG8_LDB(B0, 0, 0); PG8_SCHED; PG8_LDA(At, 0, 0); PG8_STAGE(PG8_SA(1, 1), a1 + hA, vA1);
            PG8_WAIT_L(8); PG8_BAR; PG8_WAIT_L(0); PG8_MMA(0, 0, At, B0); PG8_BAR; PG8_SCHED;
            PG8_LDB(B1, 0, 1); PG8_STAGE(PG8_SB(0, 0), b2, voffB);
            PG8_BAR; PG8_WAIT_L(0); PG8_MMA(0, 1, At, B1); PG8_BAR;
            PG8_LDA(At, 0, 1); PG8_STAGE(PG8_SA(0, 0), a2, sA0);
            PG8_BAR; PG8_WAIT_L(0); PG8_MMA(1, 0, At, B0); PG8_BAR; PG8_SCHED;
            PG8_STAGE(PG8_SB(0, 1), b2 + hstep, voffB);
            PG8_WAIT_V(6); PG8_BAR; PG8_MMA(1, 1, At, B1); PG8_BAR;
            PG8_LDB(B0, 1, 0); PG8_SCHED; PG8_LDA(At, 1, 0); PG8_STAGE(PG8_SA(0, 1), a2 + hA, sA1);
            PG8_WAIT_L(8); PG8_BAR; PG8_WAIT_L(0); PG8_MMA(0, 0, At, B0); PG8_BAR; PG8_SCHED;
            PG8_LDB(B1, 1, 1); PG8_STAGE(PG8_SB(1, 0), b3, voffB);
            PG8_BAR; PG8_WAIT_L(0); PG8_MMA(0, 1, At, B1); PG8_BAR;
            PG8_LDA(At, 1, 1); PG8_STAGE(PG8_SA(1, 0), a3, sA0);
            PG8_BAR; PG8_WAIT_L(0); PG8_MMA(1, 0, At, B0); PG8_BAR; PG8_SCHED;
            PG8_STAGE(PG8_SB(1, 1), b3 + hstep, voffB);
            PG8_WAIT_V(6); PG8_BAR; PG8_MMA(1, 1, At, B1); PG8_BAR;
            }
        }
        if constexpr (ALIGN_EPI) { if (wr == 0) PG8_BAR; }
        if constexpr (!Epi::AFTER_DRAIN) { E(acc, cur, wr, wc, fr, fq); S.done(cur); }
        if (!has_next) break;
#pragma unroll
        for (int a = 0; a < 2; ++a)
#pragma unroll
            for (int b = 0; b < 2; ++b)
#pragma unroll
                for (int m = 0; m < 4; ++m)
#pragma unroll
                    for (int n = 0; n < 2; ++n) acc[a][b][m][n] = (f32x4){0.f, 0.f, 0.f, 0.f};
        cur = nxt; cA = nA; cB = nB; ++ui; vA0[0] = nA0[0]; vA0[1] = nA0[1]; vA1[0] = nA1[0]; vA1[1] = nA1[1];
        if constexpr (ALIGN_EPI) { if (wr == 1) PG8_BAR; }
    }
    PG8_WAIT_V(0);
    if constexpr (!ALIGN_EPI) { if (wr == 0) PG8_BAR; }
    PG8_BAR;
    if constexpr (Epi::AFTER_DRAIN) { E.fused(acc, cur, wr, wc, fr, fq, lds, wid, lane); S.done(cur); }
#undef PG8_SA
#undef PG8_SB
#undef PG8_STAGE
#undef PG8_LDA
#undef PG8_LDB
#undef PG8_MMA
#undef PG8_WAIT_V
#undef PG8_WAIT_L
#undef PG8_BAR
#undef PG8_SCHED
}

struct EpiBf16 {
    static constexpr bool PERM = true, AFTER_DRAIN = false;
    bf16_t* O; int ldc;
    __device__ __forceinline__ void operator()(const f32x4 (&acc)[2][2][4][2], const Unit& u, int wr, int wc, int fr, int fq) const {
        const int row0 = u.pm * BM + wr * 64 + fr, col0 = u.pn * BM + wc * 32 + 8 * fq;
#pragma unroll
        for (int ai = 0; ai < 2; ++ai)
#pragma unroll
            for (int m = 0; m < 4; ++m) { bf16_t* rowp = O + (size_t)(row0 + ai * HALF + m * 16) * ldc + col0;
#pragma unroll
                for (int bj = 0; bj < 2; ++bj) { const f32x4 v0 = acc[ai][bj][m][0], v1 = acc[ai][bj][m][1];
                    u32x4 w; w.x = cvt_pk_bf16(v0[0], v0[1]); w.y = cvt_pk_bf16(v0[2], v0[3]); w.z = cvt_pk_bf16(v1[0], v1[1]); w.w = cvt_pk_bf16(v1[2], v1[3]);
                    *(u32x4*)(rowp + bj * HALF) = w; } }
    }
};
struct EpiResid {
    static constexpr bool PERM = true, AFTER_DRAIN = false;
    const float* xin; const bf16_t* xinb; bf16_t* xout; const float* gate; int gstride; int seq; const bf16_t* y1;
    __device__ __forceinline__ void operator()(const f32x4 (&acc)[2][2][4][2], const Unit& u, int wr, int wc, int fr, int fq) const {
        const int row0 = u.pm * BM + wr * 64 + fr, col0 = u.pn * BM + wc * 32 + 8 * fq;
#pragma unroll
        for (int ai = 0; ai < 2; ++ai)
#pragma unroll
            for (int m = 0; m < 4; ++m) { const int row = row0 + ai * HALF + m * 16; const float* gp = gate + (size_t)(row / seq) * gstride;
#pragma unroll
                for (int bj = 0; bj < 2; ++bj) { const int c = col0 + bj * HALF; const size_t o = (size_t)row * 1024 + c;
                    const f32x4 g0 = *(const f32x4*)(gp + c), g1 = *(const f32x4*)(gp + c + 4);
                    f32x4 x0, x1;
                    if (xin) { x0 = *(const f32x4*)(xin + o); x1 = *(const f32x4*)(xin + o + 4); }
                    else { const u32x4 xw = *(const u32x4*)(xinb + o), y = *(const u32x4*)(y1 + o);
                        x0 = (f32x4){bflo(xw.x), bfhi(xw.x), bflo(xw.y), bfhi(xw.y)} + (f32x4){bflo(y.x), bfhi(y.x), bflo(y.y), bfhi(y.y)};
                        x1 = (f32x4){bflo(xw.z), bfhi(xw.z), bflo(xw.w), bfhi(xw.w)} + (f32x4){bflo(y.z), bfhi(y.z), bflo(y.w), bfhi(y.w)}; }
                    x0 += g0 * acc[ai][bj][m][0]; x1 += g1 * acc[ai][bj][m][1];
                    u32x4 w; w.x = cvt_pk_bf16(x0[0], x0[1]); w.y = cvt_pk_bf16(x0[2], x0[3]); w.z = cvt_pk_bf16(x1[0], x1[1]); w.w = cvt_pk_bf16(x1[2], x1[3]);
                    *(u32x4*)(xout + o) = w; } }
    }
};
struct EpiSwiglu {
    static constexpr bool PERM = true, AFTER_DRAIN = false;
    bf16_t* HB;
    __device__ __forceinline__ void operator()(const f32x4 (&acc)[2][2][4][2], const Unit& u, int wr, int wc, int fr, int fq) const {
        const int row0 = u.pm * BM + wr * 64 + fr, col0 = (u.pn & 3) * 128 + wc * 32 + 8 * fq;
#pragma unroll
        for (int ai = 0; ai < 2; ++ai)
#pragma unroll
            for (int m = 0; m < 4; ++m) { bf16_t* p = HB + (size_t)(row0 + ai * HALF + m * 16) * 512 + col0;
                float h[8];
#pragma unroll
                for (int n = 0; n < 2; ++n)
#pragma unroll
                    for (int k = 0; k < 4; ++k) h[n * 4 + k] = fsilu(acc[ai][0][m][n][k]) * acc[ai][1][m][n][k];
                u32x4 w; w.x = cvt_pk_bf16(h[0], h[1]); w.y = cvt_pk_bf16(h[2], h[3]); w.z = cvt_pk_bf16(h[4], h[5]); w.w = cvt_pk_bf16(h[6], h[7]);
                *(u32x4*)p = w; }
    }
};
struct EpiDown {
    static constexpr bool PERM = true, AFTER_DRAIN = false;
    const int* row_tok; const float* row_w; bf16_t* x; bf16_t* y1; const float* gate; int gstride; int seq;
    __device__ __forceinline__ void operator()(const f32x4 (&acc)[2][2][4][2], const Unit& u, int wr, int wc, int fr, int fq) const {
        const int row0 = u.pm * BM + wr * 64 + fr, col0 = (u.pn & 3) * BM + wc * 32 + 8 * fq;
#pragma unroll
        for (int ai = 0; ai < 2; ++ai)
#pragma unroll
            for (int m = 0; m < 4; ++m) { const int row = row0 + ai * HALF + m * 16; const int ts = row_tok[row];
                if (ts >= 0) { const int tok = ts >> 1; const float w = row_w[row]; const float* gp = gate + (size_t)(tok / seq) * gstride;
#pragma unroll
                    for (int bj = 0; bj < 2; ++bj) { const int c = col0 + bj * HALF; const size_t o = (size_t)tok * 1024 + c;
                        const f32x4 v0 = acc[ai][bj][m][0] * (*(const f32x4*)(gp + c)) * w, v1 = acc[ai][bj][m][1] * (*(const f32x4*)(gp + c + 4)) * w;
                        if (ts & 1) { u32x4 q; q.x = cvt_pk_bf16(v0[0], v0[1]); q.y = cvt_pk_bf16(v0[2], v0[3]); q.z = cvt_pk_bf16(v1[0], v1[1]); q.w = cvt_pk_bf16(v1[2], v1[3]); *(u32x4*)(y1 + o) = q; }
                        else { const u32x4 xw = *(const u32x4*)(x + o); const f32x4 s0 = (f32x4){bflo(xw.x), bfhi(xw.x), bflo(xw.y), bfhi(xw.y)} + v0, s1 = (f32x4){bflo(xw.z), bfhi(xw.z), bflo(xw.w), bfhi(xw.w)} + v1;
                            u32x4 q; q.x = cvt_pk_bf16(s0[0], s0[1]); q.y = cvt_pk_bf16(s0[2], s0[3]); q.z = cvt_pk_bf16(s1[0], s1[1]); q.w = cvt_pk_bf16(s1[2], s1[3]); *(u32x4*)(x + o) = q; } } } }
    }
};
struct MoeOrder {
    const int* tile; int G, c;
    __device__ __forceinline__ bool next(int i, Unit& u) const { const int v = ((G & 7) == 0) ? (c & 7) * (G >> 3) + (c >> 3) : c; const int L = i * G + v, nt = tile[0]; if (L >= nt * 4) return false; u.pm = L >> 2; u.pn = tile[1 + (L >> 2)] * 4 + (L & 3); return true; }
    __device__ __forceinline__ void a_ready(const Unit&) const {}
    __device__ __forceinline__ void done(const Unit&) const {}
};
}

constexpr int NB = CFG_B, SEQ = CFG_S, NL = CFG_L, NTOK = NB * SEQ, DM = 1024, ZP = 2304;
constexpr int NBH = NB * 4, NCH = SEQ / 128, NQT = SEQ / 256;
constexpr int NR = 2 * NTOK + 32 * 256;
constexpr int Z_CQ = 0, Z_CKV = 192, Z_KR = 320, Z_POOL = 352, Z_HQ = 608, Z_HF = 864, Z_HI = 1120, Z_HG = 1376, Z_CA = 1632, Z_CG = 1888;
constexpr float EPS = 1e-6f;
static_assert(SEQ % 256 == 0 && NTOK % 256 == 0 && (NQT % 2) == 0, "shape");
constexpr size_t al256(size_t x) { return (x + 255) & ~(size_t)255; }
constexpr size_t cmax(size_t a, size_t b) { return a > b ? a : b; }
constexpr size_t WS_CTL = 0, CTL_BYTES = 65536;
constexpr size_t CTL_CNT = 16384;
constexpr size_t CTL_HG = 32768;
constexpr size_t WS_MODP = WS_CTL + CTL_BYTES;
constexpr size_t WS_MOD = WS_MODP + al256((size_t)16 * NL * NB * 6144 * 4);
constexpr size_t WS_LB = WS_MOD + al256((size_t)NL * NB * 6144 * 4);
constexpr size_t WS_ROPE = WS_LB + al256((size_t)NL * 256 * 4);
constexpr size_t WS_WIN = WS_ROPE + al256((size_t)NTOK * 32 * 4);
constexpr size_t WS_WOUT = WS_WIN + (size_t)ZP * 1024 * 2;
constexpr size_t WS_WUQ = WS_WOUT + (size_t)1024 * 1024 * 2;
constexpr size_t WS_WUKV = WS_WUQ + al256((size_t)384 * 192 * 2);
constexpr size_t WS_WPOOL = WS_WUKV + al256((size_t)512 * 128 * 2);
constexpr size_t WS_WUP = WS_WPOOL + al256((size_t)4 * 64 * 64 * 2);
constexpr size_t WS_WDN = WS_WUP + (size_t)32 * 1024 * 1024 * 2;
constexpr size_t WS_RWT = WS_WDN + (size_t)32 * 1024 * 512 * 2;
constexpr size_t WSET = WS_RWT + 36 * 1024 * 4 - WS_WIN;
constexpr size_t WS_HA = WS_WIN + 2 * WSET;
constexpr size_t WS_Z = WS_HA + (size_t)NTOK * 1024 * 2;
constexpr size_t Z_BYTES = cmax((size_t)NTOK * ZP * 2, (size_t)NR * 1024 * 2);
constexpr size_t WS_Q = WS_Z + Z_BYTES;
constexpr size_t WS_K = WS_Q + (size_t)NTOK * 4 * 96 * 2;
constexpr size_t WS_VT = WS_K + (size_t)NTOK * 4 * 96 * 2;
constexpr size_t WS_YB = WS_VT + (size_t)NTOK * 4 * 64 * 2;
constexpr size_t R2_BYTES = cmax(WS_YB + (size_t)NTOK * 1024 * 2 - WS_Q, (size_t)NR * 512 * 2);
constexpr size_t WS_Y1 = WS_Q + R2_BYTES;
constexpr size_t WS_SC = WS_Y1 + (size_t)NTOK * 1024 * 2;
constexpr size_t WS_PC = WS_SC + (size_t)NBH * NCH * 4096 * 4;
constexpr size_t WS_S0 = WS_PC + al256((size_t)NBH * NCH * 64 * 4);
constexpr size_t WS_ASGE = WS_S0 + (size_t)NBH * NCH * 4096 * 4;
constexpr size_t WS_ASGR = WS_ASGE + (size_t)NTOK * 8;
constexpr size_t WS_ASGW = WS_ASGR + (size_t)NTOK * 8;
constexpr size_t WS_ROWTOK = WS_ASGW + (size_t)NTOK * 8;
constexpr size_t WS_ROWW = WS_ROWTOK + al256((size_t)NR * 4);
constexpr size_t WS_TILE = WS_ROWW + al256((size_t)NR * 4);
constexpr size_t WS_XB = WS_TILE + al256((size_t)(NR / 256 + 16) * 4);
constexpr size_t WS_END = WS_XB + (size_t)NTOK * 1024 * 2;
constexpr int LDS_BYTES = 160 * 1024;
constexpr int LDS_XB = LDS_BYTES - 16;

#define XB_TMO      128
#define XB_XCNT(j)  (256  + 64 * (j))
#define XB_XSUB(j)  (1280 + 64 * (j))
#define XB_XGEN(j)  (2304 + 64 * (j))
#define XB_TOP      3328
#define XB_TOPGEN   3392
#define XCD_BAR_WORDS 3456
#define XB_SPIN_CAP (1u << 18)
__device__ __forceinline__ unsigned xb_ld(unsigned* p)              { return __hip_atomic_load(p, __ATOMIC_RELAXED, __HIP_MEMORY_SCOPE_AGENT); }
__device__ __forceinline__ unsigned xb_add(unsigned* p, unsigned v) { return __hip_atomic_fetch_add(p, v, __ATOMIC_RELAXED, __HIP_MEMORY_SCOPE_AGENT); }
__device__ __forceinline__ unsigned xb_xcc_id() { return (unsigned)__builtin_amdgcn_s_getreg((3 << 11) | 20) & 0xFu; }
#define XB_SPIN(cond, bar) do { unsigned _sp = 0; while (cond) { __builtin_amdgcn_s_sleep(1); \
    if ((++_sp & 255u) == 0u) { if (xb_ld(&(bar)[XB_TMO])) break; if (_sp > XB_SPIN_CAP) { atomicAdd(&(bar)[XB_TMO], 1u); break; } } } } while (0)
struct XcdBarrier { unsigned* bar; unsigned x; volatile LAS unsigned* st; };
__device__ __forceinline__ XcdBarrier xcd_barrier_post(unsigned* bar, volatile LAS unsigned* st) {
    XcdBarrier b; b.bar = bar; b.x = xb_xcc_id(); b.st = st;
    if (threadIdx.x == 0) (void)xb_add(&bar[XB_XCNT(b.x)], 1u);
    return b;
}
__device__ __forceinline__ void xcd_barrier_complete(unsigned* bar, unsigned x, unsigned& nloc, unsigned& nx) {
    const unsigned G = gridDim.x * gridDim.y * gridDim.z;
    unsigned sum, cnt, mine, sp = 0u;
    for (;;) {
        sum = 0u; cnt = 0u; mine = 0u;
#pragma unroll
        for (unsigned j = 0; j < 16; ++j) { const unsigned c = xb_ld(&bar[XB_XCNT(j)]); sum += c; cnt += (c > 0u) ? 1u : 0u; mine = (j == x) ? c : mine; }
        if (sum == G) break;
        __builtin_amdgcn_s_sleep(1);
        if ((++sp & 255u) == 0u) { if (xb_ld(&bar[XB_TMO])) break; if (sp > XB_SPIN_CAP) { atomicAdd(&bar[XB_TMO], 1u); break; } }
    }
    nloc = mine > 0u ? mine : 1u; nx = cnt > 0u ? cnt : 1u;
}
__device__ __forceinline__ void xcd_barrier(const XcdBarrier& b) {
    ASMV("s_waitcnt vmcnt(0)" ::: "memory");
    __syncthreads();
    if (threadIdx.x == 0) {
        unsigned* bar = b.bar;
        __builtin_amdgcn_s_waitcnt(0);
        unsigned nloc = b.st[0], nx = b.st[1];
        if (nloc == 0u) { xcd_barrier_complete(bar, b.x, nloc, nx); b.st[0] = nloc; b.st[1] = nx; }
        const unsigned old = xb_add(&bar[XB_XSUB(b.x)], 1u);
        const unsigned gen = old / nloc;
        if (old + 1u == (gen + 1u) * nloc) {
            __builtin_amdgcn_fence(__ATOMIC_RELEASE, "agent");
            ASMV("s_waitcnt vmcnt(0)" ::: "memory");
            const unsigned og = xb_add(&bar[XB_TOP], 1u);
            const unsigned tg = og / nx;
            if (og + 1u == (tg + 1u) * nx) xb_add(&bar[XB_TOPGEN], 1u);
            else XB_SPIN(xb_ld(&bar[XB_TOPGEN]) == tg, bar);
            __builtin_amdgcn_fence(__ATOMIC_ACQUIRE, "agent");
            xb_add(&bar[XB_XGEN(b.x)], 1u);
            ASMV("s_waitcnt vmcnt(0)" ::: "memory");
        } else {
            XB_SPIN(xb_ld(&bar[XB_XGEN(b.x)]) == gen, bar);
            __builtin_amdgcn_fence(__ATOMIC_ACQUIRE, "agent");
            ASMV("s_waitcnt vmcnt(0)" ::: "memory");
        }
    }
    __syncthreads();
}

struct Args { const void* in[30]; float* out; unsigned char* ws; int ph_lo, ph_hi; };
enum { I_X = 0, I_C, I_POS, I_WADA, I_BADA, I_N1G, I_N2G, I_WIN, I_QAG, I_WUQ, I_KVAG, I_WUKV, I_QG, I_KG, I_WPOOL, I_PSCALE, I_LBL, I_HOG, I_DWW, I_DWB, I_LNG, I_LNB,
       I_WOUT, I_RGW, I_RGB, I_REW, I_REB, I_W1, I_W3, I_W2 };
struct Ctx {
    const Args* a; unsigned char* ws; unsigned char* lds; int tid, wid, lane, G, blk;
    __device__ __forceinline__ const float* inf(int i) const { return (const float*)a->in[i]; }
    template <class T> __device__ __forceinline__ T* w(size_t off) const { return (T*)(ws + off); }
};

__device__ __forceinline__ Ctx fresh(const Ctx& c0) { Ctx c = c0; LAUNDER_V(c.tid); LAUNDER_V(c.lane); LAUNDER_S(c.wid); return c; }
__device__ __forceinline__ void ph_prologue0(const Ctx& c_) { const Ctx c = fresh(c_);
    const float* cc = c.inf(I_C); const float* wada = c.inf(I_WADA); float* modp = c.w<float>(WS_MODP);
    for (int u = c.blk; u < NL * 16 * 12; u += c.G) {
        const int l = u / 192, r = u % 192, ic = r / 12, jb = r % 12, j = jb * 512 + c.tid;
        float* Ls = (float*)c.lds;
        __syncthreads();
        if (c.tid < NB * 64) Ls[c.tid] = fsilu(cc[(c.tid >> 6) * 1024 + ic * 64 + (c.tid & 63)]);
        __syncthreads();
        float acc[NB];
#pragma unroll
        for (int b = 0; b < NB; ++b) acc[b] = 0.f;
        const float* wp = wada + ((size_t)l * 1024 + ic * 64) * 6144 + j;
#pragma unroll
        for (int i0 = 0; i0 < 64; i0 += 16) { float wv[16];
#pragma unroll
            for (int i = 0; i < 16; ++i) wv[i] = wp[(size_t)(i0 + i) * 6144];
#pragma unroll
            for (int i = 0; i < 16; ++i)
#pragma unroll
                for (int b = 0; b < NB; ++b) acc[b] += Ls[b * 64 + i0 + i] * wv[i]; }
#pragma unroll
        for (int b = 0; b < NB; ++b) modp[(((size_t)ic * NL + l) * NB + b) * 6144 + j] = acc[b];
    }
    const int* pos = (const int*)c.a->in[I_POS]; float* rc = c.w<float>(WS_ROPE); float* rs = rc + (size_t)NTOK * 16;
    for (int e = c.blk * 512 + c.tid; e < NTOK * 16; e += c.G * 512) { const int t = e >> 4, i = e & 15;
        const float inv = exp2f(-(float)i * (13.287712379549449f / 16.0f));
        const float ang = (float)pos[t] * inv; rc[e] = cosf(ang); rs[e] = sinf(ang); }
    if (c.blk == 0 && c.tid < 256) { const float* lg = c.inf(I_LBL); float* lb = c.w<float>(WS_LB); float mx = -1e30f;
        for (int l = 0; l < NL; ++l) mx = fmaxf(mx, lg[l * 256 + c.tid]);
        float den = 0.f; for (int l = 0; l < NL; ++l) den += expf(lg[l * 256 + c.tid] - mx);
        float cum = 0.f, first = 0.f; for (int l = 0; l < NL; ++l) { cum += expf(lg[l * 256 + c.tid] - mx) / den; if (l == 0) first = cum; lb[l * 256 + c.tid] = cum - first; } }
}
__device__ __forceinline__ void ph_prologue1(const Ctx& c_) { const Ctx c = fresh(c_);
    const float* modp = c.w<float>(WS_MODP); float* mod = c.w<float>(WS_MOD); const float* bada = c.inf(I_BADA);
    for (int e = c.blk * 512 + c.tid; e < NL * NB * 6144; e += c.G * 512) { const int j = e % 6144, l = e / (NB * 6144);
        float s = bada[l * 6144 + j];
#pragma unroll
        for (int ic = 0; ic < 16; ++ic) s += modp[(size_t)ic * NL * NB * 6144 + e];
        mod[e] = s; }
}

__device__ __forceinline__ void ld8bf(const bf16_t* p, float (&o)[8]) { const u32x4 v = *(const u32x4*)p; o[0] = bflo(v.x); o[1] = bfhi(v.x); o[2] = bflo(v.y); o[3] = bfhi(v.y); o[4] = bflo(v.z); o[5] = bfhi(v.z); o[6] = bflo(v.w); o[7] = bfhi(v.w); }
__device__ __forceinline__ u32x4 pk8(const float (&o)[8]) { u32x4 w; w.x = cvt_pk_bf16(o[0], o[1]); w.y = cvt_pk_bf16(o[2], o[3]); w.z = cvt_pk_bf16(o[4], o[5]); w.w = cvt_pk_bf16(o[6], o[7]); return w; }
__device__ __forceinline__ u32x4 pk8p(const float (&o)[8]) { u32x4 w; w.x = cvt_pk_bf16_pinned(o[0], o[1]); w.y = cvt_pk_bf16_pinned(o[2], o[3]); w.z = cvt_pk_bf16_pinned(o[4], o[5]); w.w = cvt_pk_bf16_pinned(o[6], o[7]); return w; }
__device__ __forceinline__ void cvt_tile(const Ctx& c, const float* src, int ldn, int nlim, int k0, int n0, bf16_t* dst, int ldk, int drow0) {
    float* T = (float*)c.lds;
#pragma unroll
    for (int i = 0; i < 8; ++i) { const int e = c.tid + 512 * i, kk = e >> 6, nn = e & 63; T[kk * 65 + nn] = (n0 + nn < nlim) ? src[(size_t)(k0 + kk) * ldn + n0 + nn] : 0.f; }
    __syncthreads();
#pragma unroll
    for (int i = 0; i < 4; ++i) { const int e = c.tid + 512 * i, nn = e >> 5, k2 = e & 31;
        *(unsigned*)(dst + (size_t)(drow0 + nn) * ldk + k0 + 2 * k2) = cvt_pk_bf16(T[(2 * k2) * 65 + nn], T[(2 * k2 + 1) * 65 + nn]); }
    __syncthreads();
}
__device__ __forceinline__ void cvt_big(const Ctx& c, const float* src, int ldn, int nlim, int k0, int n0, bf16_t* dst, int ldk, int mode) {
    float* T = (float*)c.lds;
    f32x4 v[8];
#pragma unroll
    for (int i = 0; i < 8; ++i) { const int e4 = c.tid + 512 * i, kk = e4 >> 6, n4 = e4 & 63; v[i] = (n0 + n4 * 4 < nlim) ? *(const f32x4*)(src + (size_t)(k0 + kk) * ldn + n0 + n4 * 4) : (f32x4){0.f, 0.f, 0.f, 0.f}; }
#pragma unroll
    for (int i = 0; i < 8; ++i) { const int e4 = c.tid + 512 * i, kk = e4 >> 6, n4 = e4 & 63; float* p = T + kk * 261 + n4 * 4; p[0] = v[i][0]; p[1] = v[i][1]; p[2] = v[i][2]; p[3] = v[i][3]; }
    __syncthreads();
#pragma unroll
    for (int i = 0; i < 4; ++i) { const int e = c.tid + 512 * i, k8 = e & 7, nn = e >> 3, n = n0 + nn; float o[8];
#pragma unroll
        for (int j = 0; j < 8; ++j) o[j] = T[(8 * k8 + j) * 261 + nn];
        const int row = (mode == 0) ? n : ((n >> 7) * 256 + (mode - 1) * 128 + (n & 127));
        *(u32x4*)(dst + (size_t)row * ldk + k0 + 8 * k8) = pk8(o); }
    __syncthreads();
}
constexpr int CT_IN = 16 * 9, CT_OUT = 16 * 4, CT_W13 = 32 * 16 * 2, CT_W2 = 32 * 8 * 4, CT_UQ = 3 * 6, CT_UKV = 2 * 8, CT_POOL = 4;
constexpr int CT_TOTAL = CT_IN + CT_OUT + 2 * CT_W13 + CT_W2 + CT_UQ + CT_UKV + CT_POOL;
__device__ __forceinline__ void ph_cvt(const Ctx& c_, int l) { const Ctx c = fresh(c_);
    { const float* rgw = c.inf(I_RGW) + (size_t)l * 1024 * 4; const float* rew = c.inf(I_REW) + (size_t)l * 1024 * 32; float* rwt = c.w<float>(WS_RWT + (size_t)(l & 1) * WSET);
        for (int e = c.blk * 512 + c.tid; e < 36 * 1024; e += c.G * 512) { const int g = e >> 10, k = e & 1023; rwt[e] = (g < 4) ? rgw[k * 4 + g] : rew[k * 32 + g - 4]; } }
    for (int t = c.blk; t < CT_TOTAL; t += c.G) {
        int r = t;
        if (r < 2 * CT_W13) { const int which = r / CT_W13; r %= CT_W13; const int e = r / 32, kt = (r % 32) / 2, nt = r % 2;
            cvt_big(c, c.inf(which ? I_W3 : I_W1) + ((size_t)l * 32 + e) * 1024 * 512, 512, 512, kt * 64, nt * 256, c.w<bf16_t>(WS_WUP + (size_t)(l & 1) * WSET) + (size_t)e * 1024 * 1024, 1024, 1 + which); continue; } r -= 2 * CT_W13;
        if (r < CT_W2) { const int e = r / 32, kt = (r % 32) / 4, nt = r % 4;
            cvt_big(c, c.inf(I_W2) + ((size_t)l * 32 + e) * 512 * 1024, 1024, 1024, kt * 64, nt * 256, c.w<bf16_t>(WS_WDN + (size_t)(l & 1) * WSET) + (size_t)e * 1024 * 512, 512, 0); continue; } r -= CT_W2;
        if (r < CT_IN) { const int kt = r / 9, nt = r % 9; cvt_big(c, c.inf(I_WIN) + (size_t)l * 1024 * 2144, 2144, 2144, kt * 64, nt * 256, c.w<bf16_t>(WS_WIN + (size_t)(l & 1) * WSET), 1024, 0); continue; } r -= CT_IN;
        if (r < CT_OUT) { const int kt = r / 4, nt = r % 4; cvt_big(c, c.inf(I_WOUT) + (size_t)l * 1024 * 1024, 1024, 1024, kt * 64, nt * 256, c.w<bf16_t>(WS_WOUT + (size_t)(l & 1) * WSET), 1024, 0); continue; } r -= CT_OUT;
        if (r < CT_UQ) { const int kt = r / 6, nt = r % 6; cvt_tile(c, c.inf(I_WUQ) + (size_t)l * 192 * 384, 384, 384, kt * 64, nt * 64, c.w<bf16_t>(WS_WUQ + (size_t)(l & 1) * WSET), 192, nt * 64); continue; } r -= CT_UQ;
        if (r < CT_UKV) { const int kt = r / 8, nt = r % 8; cvt_tile(c, c.inf(I_WUKV) + (size_t)l * 128 * 512, 512, 512, kt * 64, nt * 64, c.w<bf16_t>(WS_WUKV + (size_t)(l & 1) * WSET), 128, nt * 64); continue; } r -= CT_UKV;
        cvt_tile(c, c.inf(I_WPOOL) + ((size_t)l * 4 + r) * 4096, 64, 64, 0, 0, c.w<bf16_t>(WS_WPOOL + (size_t)(l & 1) * WSET) + r * 4096, 64, 0);
    }
}
__device__ __forceinline__ void ph_normrows(const Ctx& c_, int l) { const Ctx c = fresh(c_);
    const float* xin = c.inf(I_X); const bf16_t* xb = c.w<bf16_t>(WS_XB); const bf16_t* y1 = c.w<bf16_t>(WS_Y1);
    const float* gn = c.inf(I_N1G) + l * 1024; const float* mod = c.w<float>(WS_MOD) + (size_t)l * NB * 6144; bf16_t* ha = c.w<bf16_t>(WS_HA);
    for (int row0 = c.blk * 8 + c.wid; row0 < NTOK; row0 += c.G * 16) {
        f32x4 v[2][4]; float ss[2];
#pragma unroll
        for (int q = 0; q < 2; ++q) { const int row = row0 + q * c.G * 8; ss[q] = 0.f;
            if (row < NTOK) {
#pragma unroll
                for (int i = 0; i < 4; ++i) { const int col = i * 256 + c.lane * 4;
                    if (l == 0) v[q][i] = *(const f32x4*)(xin + (size_t)row * 1024 + col);
                    else { const u32x2 xw = *(const u32x2*)(xb + (size_t)row * 1024 + col), y = *(const u32x2*)(y1 + (size_t)row * 1024 + col);
                        v[q][i] = (f32x4){bflo(xw.x), bfhi(xw.x), bflo(xw.y), bfhi(xw.y)} + (f32x4){bflo(y.x), bfhi(y.x), bflo(y.y), bfhi(y.y)}; } } } }
#pragma unroll
        for (int q = 0; q < 2; ++q) { const int row = row0 + q * c.G * 8;
            if (row < NTOK) {
#pragma unroll
                for (int i = 0; i < 4; ++i) {
                    ss[q] += v[q][i][0] * v[q][i][0] + v[q][i][1] * v[q][i][1] + v[q][i][2] * v[q][i][2] + v[q][i][3] * v[q][i][3]; } } }
        ss[0] = wave_sum(ss[0]); ss[1] = wave_sum(ss[1]);
#pragma unroll
        for (int q = 0; q < 2; ++q) { const int row = row0 + q * c.G * 8;
            if (row < NTOK) { const int b = row / SEQ; const float* sh = mod + b * 6144; const float* sc = sh + 1024; const float rinv = frsqrt(ss[q] * (1.0f / 1024.0f) + EPS);
#pragma unroll
                for (int i = 0; i < 4; ++i) { const int col = i * 256 + c.lane * 4; const f32x4 g = *(const f32x4*)(gn + col), s1 = *(const f32x4*)(sc + col), s0 = *(const f32x4*)(sh + col);
                    const f32x4 h = v[q][i] * rinv * g * (s1 + 1.0f) + s0; u32x2 o; o.x = cvt_pk_bf16(h[0], h[1]); o.y = cvt_pk_bf16(h[2], h[3]); *(u32x2*)(ha + (size_t)row * 1024 + col) = o; } } }
    }
}

#define MFMA16(a, b, c) __builtin_amdgcn_mfma_f32_16x16x32_bf16((a), (b), (c), 0, 0, 0)
#define MFMA32(a, b, c) __builtin_amdgcn_mfma_f32_32x32x16_bf16((a), (b), (c), 0, 0, 0)

__device__ __forceinline__ void mix_unit(const Ctx& c_, int l, int r0) { const Ctx c = fresh(c_);
    const bf16_t* Z = c.w<bf16_t>(WS_Z); bf16_t* Aq = (bf16_t*)c.lds; bf16_t* Akv = (bf16_t*)(c.lds + 12800); float* Lkr = (float*)(c.lds + 21504);
    float* Lu = (float*)(c.lds + 25600); bf16_t* Lp = (bf16_t*)(c.lds + 73728); float* Lcu = (float*)(c.lds + 90624); float* Lco = (float*)c.lds;
    const int s0 = r0 % SEQ, b = r0 / SEQ, fr = c.lane & 15, fq = c.lane >> 4;
    {   const int t = c.tid >> 4, sub = c.tid & 15; const bf16_t* zr = Z + (size_t)(r0 + t) * ZP;
        const u32x4 zero4 = {0u, 0u, 0u, 0u};
        const u32x4 ra0 = *(const u32x4*)(zr + Z_CQ + sub * 8), ra1 = (sub < 8) ? *(const u32x4*)(zr + Z_CQ + 128 + sub * 8) : zero4, rk0 = *(const u32x4*)(zr + Z_CKV + sub * 8), rkr = (sub < 4) ? *(const u32x4*)(zr + Z_KR + sub * 8) : zero4;
        u32x4 rp[3], rca[4], rcg[4];
#pragma unroll
        for (int i = 0; i < 3; ++i) { const int ch = c.tid + 512 * i, row = ch >> 5, c8 = ch & 31; rp[i] = (ch < 47 * 32 && s0 - 15 + row >= 0) ? *(const u32x4*)(Z + (size_t)(r0 - 15 + row) * ZP + Z_POOL + c8 * 8) : zero4; }
#pragma unroll
        for (int i = 0; i < 4; ++i) { const int ch = c.tid + 512 * i, row = ch >> 5, c8 = ch & 31; const bool ok = (ch < 62 * 32 && s0 - 30 + row >= 0);
            rca[i] = ok ? *(const u32x4*)(Z + (size_t)(r0 - 30 + row) * ZP + Z_CA + c8 * 8) : zero4; rcg[i] = ok ? *(const u32x4*)(Z + (size_t)(r0 - 30 + row) * ZP + Z_CG + c8 * 8) : zero4; }
        auto un8 = [](const u32x4 v, float (&o)[8]) { o[0] = bflo(v.x); o[1] = bfhi(v.x); o[2] = bflo(v.y); o[3] = bfhi(v.y); o[4] = bflo(v.z); o[5] = bfhi(v.z); o[6] = bflo(v.w); o[7] = bfhi(v.w); };
        const float* qag = c.inf(I_QAG) + l * 192; const float* kvag = c.inf(I_KVAG) + l * 128;
        float a0[8], a1[8], k0[8]; float ssq = 0.f, ssk = 0.f; un8(ra0, a0); un8(ra1, a1); un8(rk0, k0);
#pragma unroll
        for (int j = 0; j < 8; ++j) { ssq += a0[j] * a0[j] + a1[j] * a1[j]; ssk += k0[j] * k0[j]; }
#pragma unroll
        for (int m = 1; m < 16; m <<= 1) { ssq += __shfl_xor(ssq, m); ssk += __shfl_xor(ssk, m); }
        const float rq = frsqrt(ssq * (1.0f / 192.0f) + EPS), rk = frsqrt(ssk * (1.0f / 128.0f) + EPS);
#pragma unroll
        for (int j = 0; j < 8; ++j) a0[j] *= rq * qag[sub * 8 + j];
        *(u32x4*)(Aq + t * 200 + sub * 8) = pk8(a0);
        if (sub < 8) {
#pragma unroll
            for (int j = 0; j < 8; ++j) a1[j] *= rq * qag[128 + sub * 8 + j];
            *(u32x4*)(Aq + t * 200 + 128 + sub * 8) = pk8(a1); }
#pragma unroll
        for (int j = 0; j < 8; ++j) k0[j] *= rk * kvag[sub * 8 + j];
        *(u32x4*)(Akv + t * 136 + sub * 8) = pk8(k0);
        if (sub < 4) { float kr[8]; un8(rkr, kr);
#pragma unroll
            for (int j = 0; j < 8; ++j) Lkr[t * 32 + sub * 8 + j] = kr[j]; }
#pragma unroll
        for (int i = 0; i < 3; ++i) { const int ch = c.tid + 512 * i, row = ch >> 5, c8 = ch & 31; if (ch < 47 * 32) { float v[8]; un8(rp[i], v);
            *(f32x4*)(Lu + row * 256 + c8 * 8) = (f32x4){v[0], v[1], v[2], v[3]}; *(f32x4*)(Lu + row * 256 + c8 * 8 + 4) = (f32x4){v[4], v[5], v[6], v[7]}; } }
#pragma unroll
        for (int i = 0; i < 4; ++i) { const int ch = c.tid + 512 * i, row = ch >> 5, c8 = ch & 31; if (ch < 62 * 32) { float a[8], g[8]; un8(rca[i], a); un8(rcg[i], g);
#pragma unroll
            for (int j = 0; j < 8; ++j) a[j] *= fsigmoid(g[j]);
            *(f32x4*)(Lcu + row * 256 + c8 * 8) = (f32x4){a[0], a[1], a[2], a[3]}; *(f32x4*)(Lcu + row * 256 + c8 * 8 + 4) = (f32x4){a[4], a[5], a[6], a[7]}; } }
    }
    __syncthreads();
    const float* rcos = c.w<float>(WS_ROPE); const float* rsin = rcos + (size_t)NTOK * 16;
    if (c.wid < 4) {
        const int h = c.wid; const bf16_t* W = c.w<bf16_t>(WS_WUQ + (size_t)(l & 1) * WSET) + (size_t)(96 * h) * 192; const float* qg = c.inf(I_QG) + l * 96;
        f32x4 acc[6][2];
#pragma unroll
        for (int nf = 0; nf < 6; ++nf) { acc[nf][0] = (f32x4){0.f, 0.f, 0.f, 0.f}; acc[nf][1] = acc[nf][0]; }
#pragma unroll 3
        for (int ks = 0; ks < 6; ++ks) { bf16x8 af[2];
#pragma unroll
            for (int mf = 0; mf < 2; ++mf) af[mf] = *(const bf16x8*)(Aq + (mf * 16 + fr) * 200 + ks * 32 + fq * 8);
#pragma unroll
            for (int nf = 0; nf < 6; ++nf) { const bf16x8 bfr = *(const bf16x8*)(W + (size_t)(16 * nf + fr) * 192 + ks * 32 + fq * 8);
                acc[nf][0] = MFMA16(bfr, af[0], acc[nf][0]); acc[nf][1] = MFMA16(bfr, af[1], acc[nf][1]); } }
#pragma unroll
        for (int mf = 0; mf < 2; ++mf) { float ss = 0.f;
#pragma unroll
            for (int nf = 0; nf < 6; ++nf)
#pragma unroll
                for (int j = 0; j < 4; ++j) ss += acc[nf][mf][j] * acc[nf][mf][j];
            ss += __shfl_xor(ss, 16); ss += __shfl_xor(ss, 32);
            const float rinv = frsqrt(ss * (1.0f / 96.0f) + EPS) * (0.10206207261596575f * 1.44269504089f);
            const int tok = r0 + mf * 16 + fr; bf16_t* qo = c.w<bf16_t>(WS_Q) + ((size_t)(b * 4 + h) * SEQ + s0 + mf * 16 + fr) * 96;
            float v[6][4];
#pragma unroll
            for (int nf = 0; nf < 6; ++nf)
#pragma unroll
                for (int j = 0; j < 4; ++j) v[nf][j] = acc[nf][mf][j] * rinv * qg[16 * nf + 4 * fq + j];
            const f32x4 cs4 = *(const f32x4*)(rcos + (size_t)tok * 16 + 4 * fq), sn4 = *(const f32x4*)(rsin + (size_t)tok * 16 + 4 * fq);
#pragma unroll
            for (int j = 0; j < 4; ++j) { const float x1 = v[4][j], x2 = v[5][j]; v[4][j] = x1 * cs4[j] - x2 * sn4[j]; v[5][j] = x1 * sn4[j] + x2 * cs4[j]; }
#pragma unroll
            for (int nf = 0; nf < 6; ++nf) { u32x2 o; o.x = cvt_pk_bf16(v[nf][0], v[nf][1]); o.y = cvt_pk_bf16(v[nf][2], v[nf][3]); *(u32x2*)(qo + 16 * nf + 4 * fq) = o; } }
    } else {
        const int h = c.wid - 4; const bf16_t* W = c.w<bf16_t>(WS_WUKV + (size_t)(l & 1) * WSET) + (size_t)(128 * h) * 128; const float* kg = c.inf(I_KG) + l * 96;
        f32x4 ak[4][2], av[4][2];
#pragma unroll
        for (int nf = 0; nf < 4; ++nf) { ak[nf][0] = (f32x4){0.f, 0.f, 0.f, 0.f}; ak[nf][1] = ak[nf][0]; av[nf][0] = ak[nf][0]; av[nf][1] = ak[nf][0]; }
#pragma unroll 2
        for (int ks = 0; ks < 4; ++ks) { bf16x8 af[2];
#pragma unroll
            for (int mf = 0; mf < 2; ++mf) af[mf] = *(const bf16x8*)(Akv + (mf * 16 + fr) * 136 + ks * 32 + fq * 8);
#pragma unroll
            for (int nf = 0; nf < 4; ++nf) { const bf16x8 bk = *(const bf16x8*)(W + (size_t)(16 * nf + fr) * 128 + ks * 32 + fq * 8), bv = *(const bf16x8*)(W + (size_t)(64 + 16 * nf + fr) * 128 + ks * 32 + fq * 8);
                ak[nf][0] = MFMA16(bk, af[0], ak[nf][0]); ak[nf][1] = MFMA16(bk, af[1], ak[nf][1]);
                av[nf][0] = MFMA16(af[0], bv, av[nf][0]); av[nf][1] = MFMA16(af[1], bv, av[nf][1]); } }
#pragma unroll
        for (int mf = 0; mf < 2; ++mf) { const int tl = mf * 16 + fr; float ss = 0.f;
#pragma unroll
            for (int nf = 0; nf < 4; ++nf)
#pragma unroll
                for (int j = 0; j < 4; ++j) ss += ak[nf][mf][j] * ak[nf][mf][j];
#pragma unroll
            for (int j = 0; j < 8; ++j) { const float kr = Lkr[tl * 32 + fq * 8 + j]; ss += kr * kr; }
            ss += __shfl_xor(ss, 16); ss += __shfl_xor(ss, 32);
            const float rinv = frsqrt(ss * (1.0f / 96.0f) + EPS);
            const int tok = r0 + tl; bf16_t* ko = c.w<bf16_t>(WS_K) + ((size_t)(b * 4 + h) * SEQ + s0 + tl) * 96;
#pragma unroll
            for (int nf = 0; nf < 4; ++nf) { u32x2 o; o.x = cvt_pk_bf16(ak[nf][mf][0] * rinv * kg[16 * nf + 4 * fq], ak[nf][mf][1] * rinv * kg[16 * nf + 4 * fq + 1]);
                o.y = cvt_pk_bf16(ak[nf][mf][2] * rinv * kg[16 * nf + 4 * fq + 2], ak[nf][mf][3] * rinv * kg[16 * nf + 4 * fq + 3]); *(u32x2*)(ko + 16 * nf + 4 * fq) = o; }
            const f32x4 cs4 = *(const f32x4*)(rcos + (size_t)tok * 16 + 4 * fq), sn4 = *(const f32x4*)(rsin + (size_t)tok * 16 + 4 * fq);
            float o1[4], o2[4];
#pragma unroll
            for (int j = 0; j < 4; ++j) { const int i = 4 * fq + j; const float x1 = Lkr[tl * 32 + i] * rinv * kg[64 + i], x2 = Lkr[tl * 32 + 16 + i] * rinv * kg[80 + i];
                o1[j] = x1 * cs4[j] - x2 * sn4[j]; o2[j] = x1 * sn4[j] + x2 * cs4[j]; }
            { u32x2 o; o.x = cvt_pk_bf16(o1[0], o1[1]); o.y = cvt_pk_bf16(o1[2], o1[3]); *(u32x2*)(ko + 64 + 4 * fq) = o; o.x = cvt_pk_bf16(o2[0], o2[1]); o.y = cvt_pk_bf16(o2[2], o2[3]); *(u32x2*)(ko + 80 + 4 * fq) = o; }
            bf16_t* vo = c.w<bf16_t>(WS_VT) + (size_t)(b * 4 + h) * 64 * SEQ + s0 + mf * 16 + 4 * fq;
#pragma unroll
            for (int nf = 0; nf < 4; ++nf) { u32x2 o; o.x = cvt_pk_bf16(av[nf][mf][0], av[nf][mf][1]); o.y = cvt_pk_bf16(av[nf][mf][2], av[nf][mf][3]); *(u32x2*)(vo + (size_t)(16 * nf + fr) * SEQ) = o; } }
    }
    { const int t = c.tid >> 4, sub = c.tid & 15, g = sub >> 2, w = 2 << g, s = s0 + t; const float inv = 1.0f / (float)((s + 1 < w) ? (s + 1) : w);
#pragma unroll
        for (int k = 0; k < 2; ++k) { const int col = sub * 16 + k * 8; float sum[8];
#pragma unroll
            for (int j = 0; j < 8; ++j) sum[j] = 0.f;
            for (int d = 0; d < w; ++d) { const float* p = Lu + (t + 15 - d) * 256 + col;
#pragma unroll
                for (int j = 0; j < 8; ++j) sum[j] += p[j]; }
            const float* p0 = Lu + (t + 15) * 256 + col;
#pragma unroll
            for (int j = 0; j < 8; ++j) sum[j] = sum[j] * inv - p0[j];
            *(u32x4*)(Lp + t * 264 + col) = pk8(sum); } }
    float cres[16];
    { const int chn = c.tid & 255, half = c.tid >> 8; const float* dw = c.inf(I_DWW) + (size_t)l * 31 * 256 + chn; const float bias = c.inf(I_DWB)[l * 256 + chn];
        float wv[31];
#pragma unroll
        for (int j = 0; j < 31; ++j) wv[j] = dw[j * 256];
#pragma unroll
        for (int tt = 0; tt < 16; ++tt) cres[tt] = bias;
#pragma unroll
        for (int r = 0; r < 46; ++r) { const float u = Lcu[(half * 16 + r) * 256 + chn];
#pragma unroll
            for (int tt = 0; tt < 16; ++tt) { const int j = r - tt; if (j >= 0 && j < 31) cres[tt] += wv[j] * u; } } }
    __syncthreads();
    { const int g = c.wid >> 1, mf = c.wid & 1; const bf16_t* W = c.w<bf16_t>(WS_WPOOL + (size_t)(l & 1) * WSET) + g * 4096; const float* ps = c.inf(I_PSCALE) + l * 256 + g * 64;
        f32x4 acc[4];
#pragma unroll
        for (int nf = 0; nf < 4; ++nf) acc[nf] = (f32x4){0.f, 0.f, 0.f, 0.f};
#pragma unroll
        for (int ks = 0; ks < 2; ++ks) { const bf16x8 af = *(const bf16x8*)(Lp + (mf * 16 + fr) * 264 + g * 64 + ks * 32 + fq * 8);
#pragma unroll
            for (int nf = 0; nf < 4; ++nf) { const bf16x8 bfr = *(const bf16x8*)(W + (16 * nf + fr) * 64 + ks * 32 + fq * 8); acc[nf] = MFMA16(bfr, af, acc[nf]); } }
        bf16_t* yo = c.w<bf16_t>(WS_YB) + (size_t)(r0 + mf * 16 + fr) * 1024 + 256 + g * 64;
#pragma unroll
        for (int nf = 0; nf < 4; ++nf) { const int d = 16 * nf + 4 * fq; u32x2 o; o.x = cvt_pk_bf16(acc[nf][0] * ps[d], acc[nf][1] * ps[d + 1]); o.y = cvt_pk_bf16(acc[nf][2] * ps[d + 2], acc[nf][3] * ps[d + 3]); *(u32x2*)(yo + d) = o; } }
    { const int chn = c.tid & 255, half = c.tid >> 8;
#pragma unroll
        for (int tt = 0; tt < 16; ++tt) Lco[(half * 16 + tt) * 256 + chn] = cres[tt]; }
    __syncthreads();
    { const float* lg = c.inf(I_LNG) + l * 256 + c.lane * 4; const float* lb = c.inf(I_LNB) + l * 256 + c.lane * 4;
#pragma unroll
        for (int k = 0; k < 4; ++k) { const int t = c.wid * 4 + k; const f32x4 v = *(const f32x4*)(Lco + t * 256 + c.lane * 4);
            const float mean = wave_sum(v[0] + v[1] + v[2] + v[3]) * (1.0f / 256.0f); const f32x4 d = v - mean;
            const float var = wave_sum(d[0] * d[0] + d[1] * d[1] + d[2] * d[2] + d[3] * d[3]) * (1.0f / 256.0f); const float rs = frsqrt(var + EPS);
            float y[4];
#pragma unroll
            for (int j = 0; j < 4; ++j) y[j] = fsilu(d[j] * rs * lg[j] + lb[j]);
            u32x2 o; o.x = cvt_pk_bf16(y[0], y[1]); o.y = cvt_pk_bf16(y[2], y[3]); *(u32x2*)(c.w<bf16_t>(WS_YB) + (size_t)(r0 + t) * 1024 + 768 + c.lane * 4) = o; } }
    __syncthreads();
}

constexpr int CW_W13 = 32 * 16 * 16, CW_W2 = 32 * 8 * 32, CW_IN = 16 * 72, CW_OUT = 16 * 32, CW_UQ = 3 * 12, CW_UKV = 2 * 16, CW_POOL = 4 * 2;
constexpr int CW_TOTAL = 2 * CW_W13 + CW_W2 + CW_IN + CW_OUT + CW_UQ + CW_UKV + CW_POOL;
struct CvtTile { const float* src; bf16_t* dst; int ldn, ldk; };
__device__ __forceinline__ void cvt_decode(const Ctx& c, int l, int t, CvtTile& d) {
    const size_t wso = (size_t)(l & 1) * WSET; int r = t;
    if (r < 2 * CW_W13) { const int which = r / CW_W13; r %= CW_W13; const int e = r >> 8, kt = (r >> 4) & 15, nt = r & 15, n0 = nt * 32;
        d.src = c.inf(which ? I_W3 : I_W1) + ((size_t)l * 32 + e) * 1024 * 512 + (size_t)kt * 64 * 512 + n0; d.ldn = 512; d.ldk = 1024;
        d.dst = c.w<bf16_t>(WS_WUP + wso) + (size_t)e * 1024 * 1024 + (size_t)((n0 >> 7) * 256 + which * 128 + (n0 & 127)) * 1024 + kt * 64; return; } r -= 2 * CW_W13;
    if (r < CW_W2) { const int e = r >> 8, kt = (r >> 5) & 7, nt = r & 31;
        d.src = c.inf(I_W2) + ((size_t)l * 32 + e) * 512 * 1024 + (size_t)kt * 64 * 1024 + nt * 32; d.ldn = 1024; d.ldk = 512;
        d.dst = c.w<bf16_t>(WS_WDN + wso) + (size_t)e * 1024 * 512 + (size_t)(nt * 32) * 512 + kt * 64; return; } r -= CW_W2;
    if (r < CW_IN) { const int kt = r / 72, nt = r % 72; d.src = (nt < 67) ? c.inf(I_WIN) + (size_t)l * 1024 * 2144 + (size_t)kt * 64 * 2144 + nt * 32 : nullptr; d.ldn = 2144; d.ldk = 1024;
        d.dst = c.w<bf16_t>(WS_WIN + wso) + (size_t)(nt * 32) * 1024 + kt * 64; return; } r -= CW_IN;
    if (r < CW_OUT) { const int kt = r >> 5, nt = r & 31; d.src = c.inf(I_WOUT) + (size_t)l * 1024 * 1024 + (size_t)kt * 64 * 1024 + nt * 32; d.ldn = 1024; d.ldk = 1024;
        d.dst = c.w<bf16_t>(WS_WOUT + wso) + (size_t)(nt * 32) * 1024 + kt * 64; return; } r -= CW_OUT;
    if (r < CW_UQ) { const int kt = r / 12, nt = r % 12; d.src = c.inf(I_WUQ) + (size_t)l * 192 * 384 + (size_t)kt * 64 * 384 + nt * 32; d.ldn = 384; d.ldk = 192;
        d.dst = c.w<bf16_t>(WS_WUQ + wso) + (size_t)(nt * 32) * 192 + kt * 64; return; } r -= CW_UQ;
    if (r < CW_UKV) { const int kt = r >> 4, nt = r & 15; d.src = c.inf(I_WUKV) + (size_t)l * 128 * 512 + (size_t)kt * 64 * 512 + nt * 32; d.ldn = 512; d.ldk = 128;
        d.dst = c.w<bf16_t>(WS_WUKV + wso) + (size_t)(nt * 32) * 128 + kt * 64; return; } r -= CW_UKV;
    { const int g = r >> 1, nt = r & 1; d.src = c.inf(I_WPOOL) + ((size_t)l * 4 + g) * 4096 + nt * 32; d.ldn = 64; d.ldk = 64; d.dst = c.w<bf16_t>(WS_WPOOL + wso) + g * 4096 + (size_t)(nt * 32) * 64; }
}
__device__ __forceinline__ void cvt_wave(const Ctx& c, int l, int wrank, int nwaves, float* T) {
    { const float* rgw = c.inf(I_RGW) + (size_t)l * 1024 * 4; const float* rew = c.inf(I_REW) + (size_t)l * 1024 * 32; float* rwt = c.w<float>(WS_RWT + (size_t)(l & 1) * WSET);
        for (int e = wrank * 64 + c.lane; e < 36 * 1024; e += nwaves * 64) { const int g = e >> 10, k = e & 1023; rwt[e] = (g < 4) ? rgw[k * 4 + g] : rew[k * 32 + g - 4]; } }
    f32x4 v[8]; CvtTile cur; cur.src = nullptr; cur.dst = nullptr; cur.ldn = 0; cur.ldk = 0;
    auto issue = [&](const CvtTile& d) {
#pragma unroll
        for (int i = 0; i < 8; ++i) { const int e4 = c.lane + 64 * i, kk = e4 >> 3, n4 = e4 & 7; v[i] = d.src ? *(const f32x4*)(d.src + (size_t)kk * d.ldn + n4 * 4) : (f32x4){0.f, 0.f, 0.f, 0.f}; } };
    int t = wrank;
    if (t < CW_TOTAL) { cvt_decode(c, l, t, cur); issue(cur); }
    while (t < CW_TOTAL) {
#pragma unroll
        for (int i = 0; i < 8; ++i) { const int e4 = c.lane + 64 * i, kk = e4 >> 3, n4 = e4 & 7; float* p = T + kk * 33 + n4 * 4; p[0] = v[i][0]; p[1] = v[i][1]; p[2] = v[i][2]; p[3] = v[i][3]; }
        const int tn = t + nwaves; CvtTile nxt = cur; if (tn < CW_TOTAL) { cvt_decode(c, l, tn, nxt); issue(nxt); }
        __builtin_amdgcn_wave_barrier();
        { const int n = c.lane & 31, kh = c.lane >> 5; bf16_t* drow = cur.dst + (size_t)n * cur.ldk + kh * 32;
#pragma unroll
            for (int q = 0; q < 4; ++q) { float o[8];
#pragma unroll
                for (int j = 0; j < 8; ++j) o[j] = T[(kh * 32 + q * 8 + j) * 33 + n];
                *(u32x4*)(drow + q * 8) = pk8(o); } }
        __builtin_amdgcn_wave_barrier();
        t = tn; cur = nxt;
    }
}

#ifdef EMU
static inline float __builtin_amdgcn_logf(float x) { return log2f(x); }
#endif
constexpr int HGP = 68, HGV = 40;
constexpr int HG_LG = 0, HG_LK = 8704, HG_LQ = 17408, HG_LVT = 26112, HG_LEG = 31232, HG_LGG = 31488, HG_BYTES = 31744;
template <bool OUT> __device__ __forceinline__ void hgrn_mfma(const Ctx& c_, int l, int bu, int cvt_layer = NL) { const Ctx c = fresh(c_);
    if (c.wid < 4) {
        const int cu = bu * 4 + c.wid, bh = cu / NCH, chunk = cu % NCH, b = bh >> 2, h = bh & 3, tok0 = b * SEQ + chunk * 128;
        const bf16_t* Z = c.w<bf16_t>(WS_Z); const float lbd = c.w<float>(WS_LB)[l * 256 + h * 64 + c.lane];
        unsigned char* L = c.lds + c.wid * HG_BYTES; float* Lg = (float*)(L + HG_LG); float* Lk = (float*)(L + HG_LK); float* Lq = (float*)(L + HG_LQ); bf16_t* Lvt = (bf16_t*)(L + HG_LVT); float* LeG = (float*)(L + HG_LEG); float* LG = (float*)(L + HG_LGG);
        const int l31 = c.lane & 31, hi = c.lane >> 5;
        f32x16 S[2][2];
        if (OUT) { const float* s0 = c.w<float>(WS_S0) + (size_t)(bh * NCH + chunk) * 4096;
#pragma unroll
            for (int mf = 0; mf < 2; ++mf)
#pragma unroll
                for (int nf = 0; nf < 2; ++nf)
#pragma unroll
                    for (int r = 0; r < 16; ++r) S[mf][nf][r] = s0[(32 * mf + (r & 3) + 8 * (r >> 2) + 4 * hi) * 64 + 32 * nf + l31]; }
        else {
#pragma unroll
            for (int mf = 0; mf < 2; ++mf)
#pragma unroll
                for (int nf = 0; nf < 2; ++nf)
#pragma unroll
                    for (int r = 0; r < 16; ++r) S[mf][nf][r] = 0.f; }
        float gtot = 0.f; const float og0 = OUT ? c.inf(I_HOG)[l * 64 + l31] : 0.f, og1 = OUT ? c.inf(I_HOG)[l * 64 + 32 + l31] : 0.f;
        u32x4 rf[4], rq[4], rv[4];
        { const bf16_t* zn = Z + (size_t)(tok0 + (c.lane >> 3)) * ZP + h * 64 + (c.lane & 7) * 8;
#pragma unroll
            for (int i = 0; i < 4; ++i) { rf[i] = *(const u32x4*)(zn + (size_t)i * 8 * ZP + Z_HF); rv[i] = *(const u32x4*)(zn + (size_t)i * 8 * ZP + Z_HI); if (OUT) rq[i] = *(const u32x4*)(zn + (size_t)i * 8 * ZP + Z_HQ); else rq[i] = (u32x4){0u, 0u, 0u, 0u}; } }
#pragma unroll 1
        for (int sc = 0; sc < 4; ++sc) { const int tokb = tok0 + sc * 32;
            {
                const int rr = c.lane >> 3, c8 = (c.lane & 7) * 8;
#pragma unroll
                for (int i = 0; i < 4; ++i) { const int tr = i * 8 + rr; float x[8];
                    { const u32x4 v = rf[i]; x[0] = bflo(v.x); x[1] = bfhi(v.x); x[2] = bflo(v.y); x[3] = bfhi(v.y); x[4] = bflo(v.z); x[5] = bfhi(v.z); x[6] = bflo(v.w); x[7] = bfhi(v.w); }
                    *(f32x4*)(Lg + tr * HGP + c8) = (f32x4){x[0], x[1], x[2], x[3]}; *(f32x4*)(Lg + tr * HGP + c8 + 4) = (f32x4){x[4], x[5], x[6], x[7]};
                    if (OUT) { const u32x4 v = rq[i]; x[0] = fsilu(bflo(v.x)); x[1] = fsilu(bfhi(v.x)); x[2] = fsilu(bflo(v.y)); x[3] = fsilu(bfhi(v.y)); x[4] = fsilu(bflo(v.z)); x[5] = fsilu(bfhi(v.z)); x[6] = fsilu(bflo(v.w)); x[7] = fsilu(bfhi(v.w));
                        *(f32x4*)(Lq + tr * HGP + c8) = (f32x4){x[0], x[1], x[2], x[3]}; *(f32x4*)(Lq + tr * HGP + c8 + 4) = (f32x4){x[4], x[5], x[6], x[7]}; }
                    { const u32x4 v = rv[i]; const unsigned w4[4] = {v.x, v.y, v.z, v.w};
#pragma unroll
                        for (int k = 0; k < 4; ++k) { Lvt[(c8 + 2 * k) * HGV + tr] = (bf16_t)(w4[k] & 0xffffu); Lvt[(c8 + 2 * k + 1) * HGV + tr] = (bf16_t)(w4[k] >> 16); } } }
                if (sc < 3) { const bf16_t* zn = Z + (size_t)(tokb + 32 + rr) * ZP + h * 64 + c8;
#pragma unroll
                    for (int i = 0; i < 4; ++i) { rf[i] = *(const u32x4*)(zn + (size_t)i * 8 * ZP + Z_HF); rv[i] = *(const u32x4*)(zn + (size_t)i * 8 * ZP + Z_HI); if (OUT) rq[i] = *(const u32x4*)(zn + (size_t)i * 8 * ZP + Z_HQ); } }
                __builtin_amdgcn_wave_barrier();
                float run = 0.f;
#pragma unroll
                for (int t = 0; t < 32; ++t) { const float f = lbd + (1.0f - lbd) * fsigmoid(Lg[t * HGP + c.lane]); run += __builtin_amdgcn_logf(f); Lg[t * HGP + c.lane] = run; Lk[t * HGP + c.lane] = 1.0f - f; }
                LG[c.lane] = run; LeG[c.lane] = __builtin_amdgcn_exp2f(run); gtot += run;
            }
            __builtin_amdgcn_wave_barrier();
            bf16x8 vt[2][2];
#pragma unroll
            for (int nf = 0; nf < 2; ++nf)
#pragma unroll
                for (int ks = 0; ks < 2; ++ks) vt[nf][ks] = *(const bf16x8*)(Lvt + (32 * nf + l31) * HGV + 16 * ks + 8 * hi);
            f32x16 O[2];
            if (OUT) {
#pragma unroll
                for (int r = 0; r < 16; ++r) { O[0][r] = 0.f; O[1][r] = 0.f; }
                float acc[8];
#pragma unroll
                for (int m = 0; m < 8; ++m) acc[m] = 0.f;
                const int sb = (l31 & 16) + 8 * hi;
#pragma unroll 1
                for (int d4 = 0; d4 < 16; ++d4) { const f32x4 qt = *(const f32x4*)(Lq + l31 * HGP + 4 * d4), gt = *(const f32x4*)(Lg + l31 * HGP + 4 * d4);
#pragma unroll
                    for (int mg = 0; mg < 4; ++mg) {
                        f32x4 k4[2], g4[2];
#pragma unroll
                        for (int j = 0; j < 2; ++j) { const int s = sb + 2 * mg + j; k4[j] = *(const f32x4*)(Lk + s * HGP + 4 * d4); g4[j] = *(const f32x4*)(Lg + s * HGP + 4 * d4); }
                        __builtin_amdgcn_sched_barrier(0);
#pragma unroll
                        for (int j = 0; j < 2; ++j)
#pragma unroll
                            for (int e = 0; e < 4; ++e) acc[mg * 2 + j] += qt[e] * k4[j][e] * __builtin_amdgcn_exp2f(gt[e] - g4[j][e]);
                        __builtin_amdgcn_sched_barrier(0); } }
                bf16x8 af[2], afx;
                { float a8[8];
#pragma unroll
                    for (int j = 0; j < 8; ++j) a8[j] = (sb + j <= l31) ? acc[j] : 0.f;
                    const bf16x8 ad = __builtin_bit_cast(bf16x8, pk8p(a8)), az = (bf16x8){0, 0, 0, 0, 0, 0, 0, 0};
                    af[0] = (l31 < 16) ? ad : az; af[1] = (l31 < 16) ? az : ad; }
                {
                    f32x16 dx;
#pragma unroll
                    for (int r = 0; r < 16; ++r) dx[r] = 0.f;
                    const bool lowr = l31 < 16; const float* Lx = lowr ? Lk : Lq;
#pragma unroll
                    for (int kk = 0; kk < 4; ++kk) { const int d0 = 16 * kk + 8 * hi;
                        const f32x4 xa = *(const f32x4*)(Lx + l31 * HGP + d0), xb = *(const f32x4*)(Lx + l31 * HGP + d0 + 4), ga = *(const f32x4*)(Lg + l31 * HGP + d0), gb = *(const f32x4*)(Lg + l31 * HGP + d0 + 4),
                                    ma = *(const f32x4*)(Lg + 15 * HGP + d0), mb = *(const f32x4*)(Lg + 15 * HGP + d0 + 4);
                        float v8[8];
#pragma unroll
                        for (int j = 0; j < 4; ++j) { const float da = ga[j] - ma[j], db = gb[j] - mb[j];
                            v8[j] = xa[j] * __builtin_amdgcn_exp2f(lowr ? -da : da); v8[4 + j] = xb[j] * __builtin_amdgcn_exp2f(lowr ? -db : db); }
                        const bf16x8 vv = __builtin_bit_cast(bf16x8, pk8p(v8)), zz = (bf16x8){0, 0, 0, 0, 0, 0, 0, 0};
                        dx = MFMA32(lowr ? vv : zz, lowr ? zz : vv, dx); }
                    float x8[8];
#pragma unroll
                    for (int j = 0; j < 8; ++j) x8[j] = dx[j];
                    afx = __builtin_bit_cast(bf16x8, pk8(x8)); }
#pragma unroll
                for (int mf = 0; mf < 2; ++mf)
#pragma unroll
                    for (int s = 0; s < 2; ++s) { const int d0 = 32 * mf + 16 * s + 4 * hi;
                        const f32x4 qa = *(const f32x4*)(Lq + l31 * HGP + d0), qb = *(const f32x4*)(Lq + l31 * HGP + d0 + 8), ga = *(const f32x4*)(Lg + l31 * HGP + d0), gb = *(const f32x4*)(Lg + l31 * HGP + d0 + 8);
                        float q8[8];
#pragma unroll
                        for (int j = 0; j < 4; ++j) { q8[j] = qa[j] * __builtin_amdgcn_exp2f(ga[j]); q8[4 + j] = qb[j] * __builtin_amdgcn_exp2f(gb[j]); }
                        const bf16x8 qf = __builtin_bit_cast(bf16x8, pk8p(q8));
#pragma unroll
                        for (int nf = 0; nf < 2; ++nf) { float s8[8];
#pragma unroll
                            for (int j = 0; j < 8; ++j) s8[j] = S[mf][nf][8 * s + j];
                            O[nf] = MFMA32(qf, __builtin_bit_cast(bf16x8, pk8p(s8)), O[nf]); } }
#pragma unroll
                for (int nf = 0; nf < 2; ++nf) {
#pragma unroll
                    for (int ks = 0; ks < 2; ++ks) O[nf] = MFMA32(af[ks], vt[nf][ks], O[nf]);
                    const s16x4 p0 = *(const s16x4*)(Lvt + (32 * nf + l31) * HGV + 4 * hi), p1 = *(const s16x4*)(Lvt + (32 * nf + l31) * HGV + 8 + 4 * hi);
                    O[nf] = MFMA32(afx, ((bf16x8){p0[0], p0[1], p0[2], p0[3], p1[0], p1[1], p1[2], p1[3]}), O[nf]); }
            }
#pragma unroll
            for (int mf = 0; mf < 2; ++mf) {
#pragma unroll
                for (int q = 0; q < 4; ++q) { const f32x4 e4 = *(const f32x4*)(LeG + 32 * mf + 8 * q + 4 * hi);
#pragma unroll
                    for (int e = 0; e < 4; ++e) { S[mf][0][4 * q + e] *= e4[e]; S[mf][1][4 * q + e] *= e4[e]; } }
                const int d = 32 * mf + l31; const float Gd = LG[d];
#pragma unroll
                for (int ks = 0; ks < 2; ++ks) { float k8[8];
#pragma unroll
                    for (int j = 0; j < 8; ++j) { const int s = 16 * ks + 8 * hi + j; k8[j] = Lk[s * HGP + d] * __builtin_amdgcn_exp2f(Gd - Lg[s * HGP + d]); }
                    const bf16x8 kf = __builtin_bit_cast(bf16x8, pk8p(k8));
                    S[mf][0] = MFMA32(kf, vt[0][ks], S[mf][0]); S[mf][1] = MFMA32(kf, vt[1][ks], S[mf][1]); } }
            if (OUT) {
                {
                    const int rr = c.lane >> 3, c8 = (c.lane & 7) * 8; const bf16_t* zg = Z + (size_t)(tokb + rr) * ZP + Z_HG + h * 64 + c8; u32x2 gv[4];
#pragma unroll
                    for (int hf = 0; hf < 2; ++hf) {
#pragma unroll
                    for (int i = 0; i < 4; ++i) gv[i] = *(const u32x2*)(zg + (size_t)i * 8 * ZP + 4 * hf);
#pragma unroll
                    for (int i = 0; i < 4; ++i) { const u32x2 v = gv[i]; *(f32x4*)(Lq + (i * 8 + rr) * HGP + c8 + 4 * hf) = (f32x4){fsilu(bflo(v.x)), fsilu(bfhi(v.x)), fsilu(bflo(v.y)), fsilu(bfhi(v.y))}; } }
                }
                __builtin_amdgcn_wave_barrier();
#pragma unroll
                for (int r = 0; r < 16; ++r) { const int tl = (r & 3) + 8 * (r >> 2) + 4 * hi; float ss = O[0][r] * O[0][r] + O[1][r] * O[1][r];
                    ss = half_sum(ss, hi);
                    const float rinv = frsqrt(ss * (1.0f / 64.0f) + EPS); const size_t tok = (size_t)(tokb + tl);
                    const float g0 = Lq[tl * HGP + l31], g1 = Lq[tl * HGP + 32 + l31];
                    bf16_t* yo = c.w<bf16_t>(WS_YB) + tok * 1024 + 512 + h * 64;
                    yo[l31] = (bf16_t)f2bf_bits(O[0][r] * rinv * og0 * g0); yo[32 + l31] = (bf16_t)f2bf_bits(O[1][r] * rinv * og1 * g1); } }
            __builtin_amdgcn_wave_barrier();
        }
        if (!OUT) { float* sc = c.w<float>(WS_SC) + (size_t)(bh * NCH + chunk) * 4096;
#pragma unroll
            for (int mf = 0; mf < 2; ++mf)
#pragma unroll
                for (int nf = 0; nf < 2; ++nf)
#pragma unroll
                    for (int r = 0; r < 16; ++r) sc[(32 * mf + (r & 3) + 8 * (r >> 2) + 4 * hi) * 64 + 32 * nf + l31] = S[mf][nf][r];
            c.w<float>(WS_PC)[(size_t)(bh * NCH + chunk) * 64 + c.lane] = __builtin_amdgcn_exp2f(gtot); }
    } else if (OUT && cvt_layer < NL) {
        cvt_wave(c, cvt_layer, bu * 4 + (c.wid - 4), NBH * NCH, (float*)(c.lds + 4 * HG_BYTES + (c.wid - 4) * 8448));
    }
    __syncthreads();
}
__device__ __forceinline__ void hgrn_carry(const Ctx& c_, int l) { const Ctx c = fresh(c_);
    const float* SC = c.w<float>(WS_SC); const float* PC = c.w<float>(WS_PC); float* S0 = c.w<float>(WS_S0);
    for (int e = c.blk * 512 + c.tid; e < NBH * 4096; e += c.G * 512) { const int bh = e >> 12, dv = e & 4095, d = dv >> 6; float s = 0.f;
#pragma unroll 8
        for (int ch = 0; ch < NCH; ++ch) { const size_t o = (size_t)(bh * NCH + ch) * 4096 + dv; S0[o] = s; s = PC[(size_t)(bh * NCH + ch) * 64 + d] * s + SC[o]; } }
    ASMV("s_waitcnt vmcnt(0)" ::: "memory");
    __syncthreads();
    if (c.tid == 0) { __builtin_amdgcn_fence(__ATOMIC_RELEASE, "agent"); ASMV("s_waitcnt vmcnt(0)" ::: "memory");
        (void)__hip_atomic_fetch_add((unsigned*)(c.ws + WS_CTL + CTL_HG) + l * 64, 1u, __ATOMIC_RELAXED, __HIP_MEMORY_SCOPE_AGENT); }
}
__device__ __forceinline__ void hgrn_wait_carry(const Ctx& c, int l) {
    if (c.tid == 0) { unsigned* p = (unsigned*)(c.ws + WS_CTL + CTL_HG) + l * 64; unsigned sp = 0;
        while (__hip_atomic_load(p, __ATOMIC_RELAXED, __HIP_MEMORY_SCOPE_AGENT) < (unsigned)c.G) { __builtin_amdgcn_s_sleep(1); if (++sp > (1u << 22)) break; }
        __builtin_amdgcn_fence(__ATOMIC_ACQUIRE, "agent"); ASMV("s_waitcnt vmcnt(0)" ::: "memory"); }
    __syncthreads();
}
__device__ __forceinline__ void ph_mixers(const Ctx& c, int l) {
    if (c.blk & 1) for (int bu = c.blk; bu < NBH * NCH / 4; bu += c.G) hgrn_mfma<false>(c, l, bu);
    for (int u = c.blk; u < NTOK / 32; u += c.G) mix_unit(c, l, u * 32);
    if (!(c.blk & 1)) for (int bu = c.blk; bu < NBH * NCH / 4; bu += c.G) hgrn_mfma<false>(c, l, bu);
}

template <bool FIXED>
__device__ __forceinline__ void attn_unit(const Ctx& c_, int bh, int qt, float negM) { const Ctx c = fresh(c_);
    const bf16_t* Qg = c.w<bf16_t>(WS_Q) + (size_t)bh * SEQ * 96; const bf16_t* Kg = c.w<bf16_t>(WS_K) + (size_t)bh * SEQ * 96; const bf16_t* Vg = c.w<bf16_t>(WS_VT) + (size_t)bh * 64 * SEQ;
    constexpr int KROW = 104, VROW = 72, KB = 64 * KROW * 2, VB = 64 * VROW * 2;
    const int l31 = c.lane & 31, hi = c.lane >> 5, qrow = qt * 256 + c.wid * 32 + l31;
    bf16x8 qf[6];
#pragma unroll
    for (int ks = 0; ks < 6; ++ks) qf[ks] = *(const bf16x8*)(Qg + (size_t)qrow * 96 + ks * 16 + hi * 8);
    f32x16 o0, o1;
#pragma unroll
    for (int r = 0; r < 16; ++r) { o0[r] = 0.f; o1[r] = 0.f; }
    float mrun = -INFINITY, lsum = 0.f; f32x2 lsum2 = {0.f, 0.f};
    const int nkt = 4 * (qt + 1), mylast = 4 * qt + (c.wid >> 1);
    const int kr0 = c.tid / 12, kc0 = c.tid % 12, kr1 = (c.tid + 512) / 12, kc1 = (c.tid + 512) % 12, vr = c.tid >> 3, vc = c.tid & 7;
    u32x4 sk0, sk1, sv;
    auto gload = [&](int kt) { sk0 = *(const u32x4*)(Kg + (size_t)(kt * 64 + kr0) * 96 + kc0 * 8); if (c.tid < 256) sk1 = *(const u32x4*)(Kg + (size_t)(kt * 64 + kr1) * 96 + kc1 * 8);
                               sv = *(const u32x4*)(Vg + (size_t)vr * SEQ + kt * 64 + vc * 8); };
    auto lstore = [&](int buf) { unsigned char* kb = c.lds + buf * (KB + VB); unsigned char* vb = kb + KB;
                                 *(u32x4*)(kb + (kr0 * KROW + kc0 * 8) * 2) = sk0; if (c.tid < 256) *(u32x4*)(kb + (kr1 * KROW + kc1 * 8) * 2) = sk1; *(u32x4*)(vb + (vr * VROW + vc * 8) * 2) = sv; };
    gload(0); lstore(0); __syncthreads();
    auto tile = [&](const int kt, auto masked) {
            const bf16_t* kb = (const bf16_t*)(c.lds + (kt & 1) * (KB + VB)); const bf16_t* vb = (const bf16_t*)(c.lds + (kt & 1) * (KB + VB) + KB);
            f32x16 s0, s1;
#pragma unroll
            for (int r = 0; r < 16; ++r) { s0[r] = FIXED ? negM : 0.f; s1[r] = FIXED ? negM : 0.f; }
#pragma unroll
            for (int ks = 0; ks < 6; ++ks) { const bf16x8 k0 = *(const bf16x8*)(kb + l31 * KROW + ks * 16 + hi * 8), k1 = *(const bf16x8*)(kb + (32 + l31) * KROW + ks * 16 + hi * 8);
                s0 = MFMA32(k0, qf[ks], s0); s1 = MFMA32(k1, qf[ks], s1); }
            if constexpr (decltype(masked)::value) {
#pragma unroll
                for (int r = 0; r < 16; ++r) { const int key = kt * 64 + (r & 3) + 8 * (r >> 2) + 4 * hi; if (key > qrow) s0[r] = -INFINITY; if (key + 32 > qrow) s1[r] = -INFINITY; } }
            if constexpr (FIXED) {
#pragma unroll
                for (int r = 0; r < 16; ++r) { s0[r] = __builtin_amdgcn_exp2f(s0[r]); s1[r] = __builtin_amdgcn_exp2f(s1[r]); }
#pragma unroll
                for (int r = 0; r < 16; r += 2) { lsum2 += (f32x2){s0[r], s0[r + 1]}; lsum2 += (f32x2){s1[r], s1[r + 1]}; }
            } else {
            float mx = s0[0];
#pragma unroll
            for (int r = 1; r < 16; ++r) mx = fmaxf(mx, s0[r]);
#pragma unroll
            for (int r = 0; r < 16; ++r) mx = fmaxf(mx, s1[r]);
            mx = fmaxf(mx, __shfl_xor(mx, 32));
            const float mnew = fmaxf(mrun, mx), alpha = __builtin_amdgcn_exp2f(mrun - mnew); mrun = mnew;
            float ps = 0.f;
#pragma unroll
            for (int r = 0; r < 16; ++r) { s0[r] = __builtin_amdgcn_exp2f(s0[r] - mnew); s1[r] = __builtin_amdgcn_exp2f(s1[r] - mnew); ps += s0[r] + s1[r]; }
            lsum = lsum * alpha + ps;
#pragma unroll
            for (int r = 0; r < 16; ++r) { o0[r] *= alpha; o1[r] *= alpha; }
            }
#pragma unroll
            for (int kf = 0; kf < 2; ++kf)
#pragma unroll
                for (int s = 0; s < 2; ++s) { const f32x16& sx = kf ? s1 : s0; u32x4 pw; pw.x = cvt_pk_bf16(sx[8 * s], sx[8 * s + 1]); pw.y = cvt_pk_bf16(sx[8 * s + 2], sx[8 * s + 3]); pw.z = cvt_pk_bf16(sx[8 * s + 4], sx[8 * s + 5]); pw.w = cvt_pk_bf16(sx[8 * s + 6], sx[8 * s + 7]);
                    const bf16x8 pf = __builtin_bit_cast(bf16x8, pw); const int kcol = kf * 32 + 16 * s + 4 * hi;
                    const s16x4 a0 = *(const s16x4*)(vb + l31 * VROW + kcol), a1 = *(const s16x4*)(vb + l31 * VROW + kcol + 8), b0 = *(const s16x4*)(vb + (32 + l31) * VROW + kcol), b1 = *(const s16x4*)(vb + (32 + l31) * VROW + kcol + 8);
                    const bf16x8 v0 = (bf16x8){a0[0], a0[1], a0[2], a0[3], a1[0], a1[1], a1[2], a1[3]}, v1 = (bf16x8){b0[0], b0[1], b0[2], b0[3], b1[0], b1[1], b1[2], b1[3]};
                    o0 = MFMA32(v0, pf, o0); o1 = MFMA32(v1, pf, o1); }
            };
    int kt = 0;
    for (; kt < mylast; ++kt) { gload(kt + 1); tile(kt, std::false_type{}); lstore((kt + 1) & 1); __syncthreads(); }
    { if (kt + 1 < nkt) gload(kt + 1); tile(kt, std::true_type{}); if (kt + 1 < nkt) lstore((kt + 1) & 1); __syncthreads(); ++kt; }
    for (; kt < nkt; ++kt) { if (kt + 1 < nkt) { gload(kt + 1); lstore((kt + 1) & 1); } __syncthreads(); }
    if constexpr (FIXED) lsum = lsum2[0] + lsum2[1];
    lsum += __shfl_xor(lsum, 32); const float rl = 1.0f / lsum;
    const int b = bh >> 2, h = bh & 3; bf16_t* yo = c.w<bf16_t>(WS_YB) + (size_t)(b * SEQ + qrow) * 1024 + h * 64;
#pragma unroll
    for (int g = 0; g < 4; ++g) { const int dv = 8 * g + 4 * hi; u32x2 w0, w1;
        w0.x = cvt_pk_bf16(o0[4 * g] * rl, o0[4 * g + 1] * rl); w0.y = cvt_pk_bf16(o0[4 * g + 2] * rl, o0[4 * g + 3] * rl); *(u32x2*)(yo + dv) = w0;
        w1.x = cvt_pk_bf16(o1[4 * g] * rl, o1[4 * g + 1] * rl); w1.y = cvt_pk_bf16(o1[4 * g + 2] * rl, o1[4 * g + 3] * rl); *(u32x2*)(yo + 32 + dv) = w1; }
    __syncthreads();
}
template <bool FIXED>
__device__ __forceinline__ void attn_units(const Ctx& c, float negM) {
    { const int NU = NBH * (NQT / 2);
      if ((c.G & 7) == 0) { const int per = (NU + 7) / 8, x = c.blk & 7, G8 = c.G >> 3;
          for (int j = c.blk >> 3; j < per; j += G8) { const int pu = x * per + j; if (pu < NU) { const int bh = pu / (NQT / 2), p = pu % (NQT / 2); attn_unit<FIXED>(c, bh, NQT - 1 - p, negM); attn_unit<FIXED>(c, bh, p, negM); } } }
      else for (int pu = c.blk; pu < NU; pu += c.G) { const int bh = pu / (NQT / 2), p = pu % (NQT / 2); attn_unit<FIXED>(c, bh, NQT - 1 - p, negM); attn_unit<FIXED>(c, bh, p, negM); } }
}
__device__ __forceinline__ void ph_attn(const Ctx& c, int l) {
    hgrn_carry(c, l);
    {
        const float* qg = c.inf(I_QG) + l * 96; const float* kg = c.inf(I_KG) + l * 96;
        int ln = c.lane; LAUNDER_V(ln);
        float gq = fmaxf(fabsf(qg[ln]), fabsf(qg[32 + (ln & 63)])), gk = fmaxf(fabsf(kg[ln]), fabsf(kg[32 + (ln & 63)]));
#pragma unroll
        for (int o = 1; o < 64; o <<= 1) { gq = fmaxf(gq, __shfl_xor(gq, o)); gk = fmaxf(gk, __shfl_xor(gk, o)); }
        const float M = 9.797958971132712f * 1.44269504089f * 1.02f * gq * gk;
        if (M <= 60.0f) attn_units<true>(c, -M); else attn_units<false>(c, 0.f); }
    hgrn_wait_carry(c, l);
    for (int bu = c.blk; bu < NBH * NCH / 4; bu += c.G) hgrn_mfma<true>(c, l, bu, l + 1);
}

__device__ __forceinline__ void ph_router(const Ctx& c_, int l, int cnt_off = 0) { const Ctx c = fresh(c_);
    bf16_t* Whi = (bf16_t*)c.lds; bf16_t* Wlo = (bf16_t*)(c.lds + 73728); float* Llog = (float*)(c.lds + 147456) + c.wid * 288; float* Lcb = (float*)(c.lds + 156672);
    int* Le = (int*)(c.lds + 156672 + 256); float* Lw = (float*)(c.lds + 156672 + 256 + 1024); int* Lr = (int*)(c.lds + 156672 + 256 + 2048); int* Lcnt = (int*)(c.lds + 156672 + 256 + 3072); int* Lbase = Lcnt + 32;
    const float* rwt = c.w<float>(WS_RWT + (size_t)(l & 1) * WSET);
    const float* rgb = c.inf(I_RGB) + l * 4; const float* reb = c.inf(I_REB) + l * 32;
    const bf16_t* x = c.w<bf16_t>(WS_XB); const float* gn = c.inf(I_N2G) + l * 1024; const float* mod = c.w<float>(WS_MOD) + (size_t)l * NB * 6144; bf16_t* ha = c.w<bf16_t>(WS_HA);
    unsigned* cnt = (unsigned*)(c.ws + WS_CTL + CTL_CNT) + l * 32 + cnt_off;
    int* asge = c.w<int>(WS_ASGE); int* asgr = c.w<int>(WS_ASGR); float* asgw = c.w<float>(WS_ASGW);
    const int fr = c.lane & 15, fq = c.lane >> 4;
    int staged_b = -1;
    for (int u = c.blk; u < NTOK / 128; u += c.G) {
        const int b = (u * 128) / SEQ; const float* sh = mod + b * 6144 + 3072; const float* sc = sh + 1024;
        __syncthreads();
        if (b != staged_b) { staged_b = b;
            for (int q = c.tid; q < 36 * 128; q += 512) { const int n = q >> 7, ch = q & 127, k0 = ch * 8; float hi8[8], lo8[8];
#pragma unroll
                for (int j = 0; j < 8; ++j) { const float w = rwt[n * 1024 + k0 + j] * gn[k0 + j] * (1.0f + sc[k0 + j]); const float h = bf2f((bf16_t)f2bf_bits(w)); hi8[j] = h; lo8[j] = w - h; }
                const int pc = (ch ^ (n & 15)) * 8; *(u32x4*)(Whi + n * 1024 + pc) = pk8(hi8); *(u32x4*)(Wlo + n * 1024 + pc) = pk8(lo8); }
            for (int g = c.wid; g < 36; g += 8) { float s = 0.f;
#pragma unroll
                for (int i = 0; i < 4; ++i) { const f32x4 w = *(const f32x4*)(rwt + g * 1024 + i * 256 + c.lane * 4), s4 = *(const f32x4*)(sh + i * 256 + c.lane * 4); s += w[0] * s4[0] + w[1] * s4[1] + w[2] * s4[2] + w[3] * s4[3]; }
                s = wave_sum(s); if (c.lane == 0) Lcb[g] = s + (g < 4 ? rgb[g] : reb[g - 4]); } }
        if (c.tid < 32) Lcnt[c.tid] = 0;
        __syncthreads();
        const int rowb = u * 128 + c.wid * 16; const bf16_t* xr = x + (size_t)(rowb + fr) * 1024 + 8 * fq;
        f32x4 acc[3] = {{0.f, 0.f, 0.f, 0.f}, {0.f, 0.f, 0.f, 0.f}, {0.f, 0.f, 0.f, 0.f}}; float ssp = 0.f;
#pragma unroll 4
        for (int ks = 0; ks < 32; ++ks) { const u32x4 hw = *(const u32x4*)(xr + 32 * ks);
            const unsigned hws[4] = {hw.x, hw.y, hw.z, hw.w};
#pragma unroll
            for (int j = 0; j < 4; ++j) { const float a = bflo(hws[j]), b = bfhi(hws[j]); ssp += a * a + b * b; }
            const bf16x8 ah = __builtin_bit_cast(bf16x8, hw);
            const int ch = 4 * ks + fq;
#pragma unroll
            for (int nf = 0; nf < 3; ++nf) { const int n = 16 * nf + fr; bf16x8 bh = {0, 0, 0, 0, 0, 0, 0, 0}, bl = bh;
                if (nf < 2 || fr < 4) { const int pc = (ch ^ (n & 15)) * 8; bh = *(const bf16x8*)(Whi + n * 1024 + pc); bl = *(const bf16x8*)(Wlo + n * 1024 + pc); }
                acc[nf] = MFMA16(ah, bh, acc[nf]); acc[nf] = MFMA16(ah, bl, acc[nf]); } }
        ssp += __shfl_xor(ssp, 16); ssp += __shfl_xor(ssp, 32);
        const float rinv = frsqrt(ssp * (1.0f / 1024.0f) + EPS);
        float rj[4];
#pragma unroll
        for (int j = 0; j < 4; ++j) rj[j] = __shfl(rinv, fq * 4 + j);
#pragma unroll
        for (int half = 0; half < 2; ++half) {
            if ((fq >> 1) == half) {
#pragma unroll
                for (int nf = 0; nf < 3; ++nf) { const int col = 16 * nf + fr; if (col < 36) {
#pragma unroll
                    for (int j = 0; j < 4; ++j) Llog[((fq & 1) * 4 + j) * 36 + col] = acc[nf][j] * rj[j] + Lcb[col]; } } }
            __builtin_amdgcn_wave_barrier();
            if (c.lane < 8) { const float* lg = Llog + c.lane * 36; const int rl = c.wid * 16 + half * 8 + c.lane;
                int gi = 0; float gm = lg[0];
#pragma unroll
                for (int g = 1; g < 4; ++g) { const float t = lg[g]; if (t > gm) { gm = t; gi = g; } }
                float den = 0.f;
#pragma unroll
                for (int g = 0; g < 4; ++g) den += expf(lg[g] - gm);
                const float gw = 1.0f / den;
                float e1 = -INFINITY, e2 = -INFINITY; int i1 = 0, i2 = 0;
#pragma unroll
                for (int j = 0; j < 8; ++j) { const float t = lg[4 + gi * 8 + j]; if (t > e1) { e2 = e1; i2 = i1; e1 = t; i1 = j; } else if (t > e2) { e2 = t; i2 = j; } }
                const float p2 = expf(e2 - e1), w1 = gw / (1.0f + p2), w2 = gw * p2 / (1.0f + p2);
                const int ea = gi * 8 + i1, eb = gi * 8 + i2; Le[rl * 2] = ea; Le[rl * 2 + 1] = eb; Lw[rl * 2] = w1; Lw[rl * 2 + 1] = w2;
                Lr[rl * 2] = atomicAdd(&Lcnt[ea], 1); Lr[rl * 2 + 1] = atomicAdd(&Lcnt[eb], 1); }
            __builtin_amdgcn_wave_barrier();
        }
#pragma unroll 4
        for (int ks = 0; ks < 32; ++ks) { const int k0 = 32 * ks + 8 * fq; const u32x4 xw = *(const u32x4*)(xr + 32 * ks); const f32x4 xa = {bflo(xw.x), bfhi(xw.x), bflo(xw.y), bfhi(xw.y)}, xb = {bflo(xw.z), bfhi(xw.z), bflo(xw.w), bfhi(xw.w)};
            const f32x4 ga = *(const f32x4*)(gn + k0) * (*(const f32x4*)(sc + k0) + 1.0f), gb = *(const f32x4*)(gn + k0 + 4) * (*(const f32x4*)(sc + k0 + 4) + 1.0f);
            const f32x4 ha4 = xa * rinv * ga + *(const f32x4*)(sh + k0), hb4 = xb * rinv * gb + *(const f32x4*)(sh + k0 + 4);
            u32x4 o; o.x = cvt_pk_bf16(ha4[0], ha4[1]); o.y = cvt_pk_bf16(ha4[2], ha4[3]); o.z = cvt_pk_bf16(hb4[0], hb4[1]); o.w = cvt_pk_bf16(hb4[2], hb4[3]);
            *(u32x4*)(ha + (size_t)(rowb + fr) * 1024 + k0) = o; }
        __syncthreads();
        if (c.tid < 32) Lbase[c.tid] = (int)__hip_atomic_fetch_add(&cnt[c.tid], (unsigned)Lcnt[c.tid], __ATOMIC_RELAXED, __HIP_MEMORY_SCOPE_AGENT);
        __syncthreads();
        if (c.tid < 256) { const int a = u * 256 + c.tid, e = Le[c.tid]; asge[a] = e; asgr[a] = Lbase[e] + Lr[c.tid]; asgw[a] = Lw[c.tid]; }
    }
    __syncthreads();
}
__device__ __forceinline__ void ph_gather(const Ctx& c_, int l) { const Ctx c = fresh(c_);
    int* Lps = (int*)c.lds; int* Lcn = Lps + 40;
    unsigned* cnt = (unsigned*)(c.ws + WS_CTL + CTL_CNT) + l * 32;
    if (c.tid < 32) Lcn[c.tid] = (int)__hip_atomic_load(&cnt[c.tid], __ATOMIC_RELAXED, __HIP_MEMORY_SCOPE_AGENT);
    __syncthreads();
    if (c.tid == 0) { int acc = 0; for (int e = 0; e < 32; ++e) { Lps[e] = acc; acc += (Lcn[e] + 255) / 256 * 256; } Lps[32] = acc; }
    __syncthreads();
    int* rowtok = c.w<int>(WS_ROWTOK); float* roww = c.w<float>(WS_ROWW);
    if (c.blk == 0) { int* tile = c.w<int>(WS_TILE); if (c.tid == 0) tile[0] = Lps[32] / 256;
        for (int e = c.tid; e < 32; e += 512) for (int t = Lps[e] / 256; t < Lps[e + 1] / 256; ++t) tile[1 + t] = e; }
    for (int e = c.blk; e < 32; e += c.G) for (int r = Lps[e] + Lcn[e] + c.tid; r < Lps[e + 1]; r += 512) rowtok[r] = -1;
    const int* asge = c.w<int>(WS_ASGE); const int* asgr = c.w<int>(WS_ASGR); const float* asgw = c.w<float>(WS_ASGW);
    for (int a = c.blk * 512 + c.tid; a < NTOK * 2; a += c.G * 512) { const int dest = Lps[asge[a]] + asgr[a]; rowtok[dest] = a; roww[dest] = asgw[a]; }
}
__device__ __forceinline__ void ph_final(const Ctx& c_) { const Ctx c = fresh(c_);
    float* out = c.a->out; const bf16_t* y1 = c.w<bf16_t>(WS_Y1);
    const bf16_t* xb = c.w<bf16_t>(WS_XB);
    for (size_t e = (size_t)c.blk * 512 + c.tid; e < (size_t)NTOK * 128; e += (size_t)c.G * 512) { const u32x4 y = *(const u32x4*)(y1 + e * 8), xw = *(const u32x4*)(xb + e * 8);
        *(f32x4*)(out + e * 8) = (f32x4){bflo(xw.x), bfhi(xw.x), bflo(xw.y), bfhi(xw.y)} + (f32x4){bflo(y.x), bfhi(y.x), bflo(y.y), bfhi(y.y)};
        *(f32x4*)(out + e * 8 + 4) = (f32x4){bflo(xw.z), bfhi(xw.z), bflo(xw.w), bfhi(xw.w)} + (f32x4){bflo(y.z), bfhi(y.z), bflo(y.w), bfhi(y.w)}; }
}

constexpr int PH_PER_LAYER = 9, N_PHASES = 2 + PH_PER_LAYER * NL + 1;
__global__ void __launch_bounds__(512, 2) mk_fwd(Args args) {
#ifdef EMU
    unsigned char* lds = emu_lds();
#else
    extern __shared__ __attribute__((aligned(16))) unsigned char lds[];
#endif
    Ctx c; c.a = &args; c.ws = args.ws; c.lds = lds; c.tid = threadIdx.x; c.wid = __builtin_amdgcn_readfirstlane(c.tid >> 6); c.lane = c.tid & 63; c.G = gridDim.x; c.blk = blockIdx.x;
    if (c.tid == 0) *(uint4*)(lds + LDS_XB) = make_uint4(0u, 0u, 0u, 0u);
    __syncthreads();
    XcdBarrier bar; bar.bar = (unsigned*)(args.ws + WS_CTL); bar.x = 0; bar.st = (volatile LAS unsigned*)(lds + LDS_XB);
    if (args.ph_hi - args.ph_lo > 1) bar = xcd_barrier_post((unsigned*)(args.ws + WS_CTL), (volatile LAS unsigned*)(lds + LDS_XB));
    int ph = 0;
#ifndef PHMASK
#define PHMASK 0xFFFFF
#endif
#define PHASE(K, ...) do { if (ph >= args.ph_lo && ph < args.ph_hi) { if constexpr ((PHMASK >> K) & 1) { __VA_ARGS__; } if (ph + 1 < args.ph_hi) xcd_barrier(bar); } ++ph; } while (0)
    PHASE(0, ph_prologue0(c));
    PHASE(1, ph_prologue1(c));
    for (int l = 0; l < NL; ++l) {
        PHASE(2, if (l == 0) ph_cvt(c, 0); ph_normrows(c, l));
        PHASE(3, { pg8::Gemm g{c.w<bf16_t>(WS_HA), c.w<bf16_t>(WS_WIN + (size_t)(l & 1) * WSET), NTOK, ZP, 1024}; pg8::StaticOrder S; S.init(NTOK, ZP, c.G, c.blk); pg8::EpiBf16 E{c.w<bf16_t>(WS_Z), ZP};
                pg8::gemm_phase<pg8::EpiBf16, pg8::StaticOrder, true, true>((LAS unsigned char*)lds, g, S, E); });
        PHASE(4, ph_mixers(c, l));
        PHASE(5, ph_attn(c, l));
        PHASE(6, { pg8::Gemm g{c.w<bf16_t>(WS_YB), c.w<bf16_t>(WS_WOUT + (size_t)(l & 1) * WSET), NTOK, 1024, 1024}; pg8::StaticOrder S; S.init(NTOK, 1024, c.G, c.blk);
                pg8::EpiResid E{(l == 0) ? c.inf(I_X) : (const float*)nullptr, c.w<bf16_t>(WS_XB), c.w<bf16_t>(WS_XB), c.w<float>(WS_MOD) + (size_t)l * NB * 6144 + 2048, 6144, SEQ, c.w<bf16_t>(WS_Y1)};
                pg8::gemm_phase<pg8::EpiResid, pg8::StaticOrder, true, true>((LAS unsigned char*)lds, g, S, E); });
        PHASE(7, ph_router(c, l));
        PHASE(8, ph_gather(c, l));
        PHASE(9, { pg8::Gemm g{c.w<bf16_t>(WS_HA), c.w<bf16_t>(WS_WUP + (size_t)(l & 1) * WSET), NR, 32 * 1024, 1024}; pg8::MoeOrder S{c.w<int>(WS_TILE), c.G, c.blk}; pg8::EpiSwiglu E{c.w<bf16_t>(WS_Q)};
                pg8::gemm_phase<pg8::EpiSwiglu, pg8::MoeOrder, true, true, true>((LAS unsigned char*)lds, g, S, E, c.w<int>(WS_ROWTOK)); });
        PHASE(10, { pg8::Gemm g{c.w<bf16_t>(WS_Q), c.w<bf16_t>(WS_WDN + (size_t)(l & 1) * WSET), NR, 32 * 1024, 512}; pg8::MoeOrder S{c.w<int>(WS_TILE), c.G, c.blk};
                pg8::EpiDown E{c.w<int>(WS_ROWTOK), c.w<float>(WS_ROWW), c.w<bf16_t>(WS_XB), c.w<bf16_t>(WS_Y1), c.w<float>(WS_MOD) + (size_t)l * NB * 6144 + 5120, 6144, SEQ};
                pg8::gemm_phase<pg8::EpiDown, pg8::MoeOrder, true, true>((LAS unsigned char*)lds, g, S, E); });
    }
    PHASE(11, ph_final(c));
#undef PHASE
}

extern "C" void kernel_launch(void* const* d_in, const int* in_sizes, int n_in, void* d_out, int out_size, void* d_ws, size_t ws_size, hipStream_t stream) {
    static int grid = 0;
    if (grid == 0) {
        if (n_in != 30 || out_size != NTOK * 1024 || ws_size < WS_END) { fprintf(stderr, "kernel_launch: shape/workspace mismatch (n_in %d out %d ws %zu need %zu)\n", n_in, out_size, ws_size, (size_t)WS_END); grid = -1; return; }
        int dev = 0, cus = 0;
        if (hipGetDevice(&dev) != hipSuccess || hipDeviceGetAttribute(&cus, hipDeviceAttributeMultiprocessorCount, dev) != hipSuccess) { grid = -1; return; }
        if (hipFuncSetAttribute((const void*)mk_fwd, hipFuncAttributeMaxDynamicSharedMemorySize, LDS_BYTES) != hipSuccess) { fprintf(stderr, "kernel_launch: hipFuncSetAttribute failed\n"); grid = -1; return; }
        int per_cu = 0; (void)hipOccupancyMaxActiveBlocksPerMultiprocessor(&per_cu, (const void*)mk_fwd, 512, LDS_BYTES);
        if (per_cu < 1) fprintf(stderr, "kernel_launch: occupancy query says %d blocks per CU\n", per_cu);
        grid = cus;
    }
    if (grid < 0) return;
    (void)hipMemsetAsync((char*)d_ws + WS_CTL, 0, CTL_BYTES, stream);
    Args a{};
    for (int i = 0; i < 30; ++i) a.in[i] = d_in[i];
    a.out = (float*)d_out; a.ws = (unsigned char*)d_ws;
#if MK_SPLIT
    for (int p = 0; p < N_PHASES; ++p) { a.ph_lo = p; a.ph_hi = p + 1;
#else
    { a.ph_lo = 0; a.ph_hi = N_PHASES;
#endif
#ifdef EMU
        EMU_LAUNCH(mk_fwd, grid, 512, LDS_BYTES, stream, a);
#else
        hipLaunchKernelGGL(mk_fwd, dim3(grid), dim3(512), LDS_BYTES, stream, a);
#endif
    }
}
```

```cpp
#include <hip/hip_runtime.h>
#include <cstdio>
#include <cstdint>
#include <type_traits>

#ifndef CFG_B
#define CFG_B 4
#endif
#ifndef CFG_S
#define CFG_S 8192
#endif
#ifndef CFG_L
#define CFG_L 4
#endif
#ifndef MK_SPLIT
#define MK_SPLIT 0
#endif

#ifdef EMU
#define ASMV(...) ((void)0)
#define LAS
#define LAUNDER_V(x) ((void)0)
#define LAUNDER_S(x) ((void)0)
#else
#define ASMV(...) asm volatile(__VA_ARGS__)
#define LAS __attribute__((address_space(3)))
#define LAUNDER_V(x) asm volatile("" : "+v"(x))
#define LAUNDER_S(x) asm volatile("" : "+s"(x))
#endif

typedef unsigned short bf16_t;
typedef short bf16x8 __attribute__((ext_vector_type(8)));
typedef short s16x4 __attribute__((ext_vector_type(4)));
typedef float f32x2 __attribute__((ext_vector_type(2)));
typedef float f32x4 __attribute__((ext_vector_type(4)));
typedef float f32x16 __attribute__((ext_vector_type(16)));
typedef unsigned u32x4 __attribute__((ext_vector_type(4)));
typedef unsigned u32x2 __attribute__((ext_vector_type(2)));

__device__ __forceinline__ float bf2f(bf16_t h) { return __builtin_bit_cast(float, (unsigned)h << 16); }
__device__ __forceinline__ float bflo(unsigned w) { return __builtin_bit_cast(float, w << 16); }
__device__ __forceinline__ float bfhi(unsigned w) { return __builtin_bit_cast(float, w & 0xffff0000u); }
__device__ __forceinline__ unsigned f2bf_bits(float f) { unsigned u = __builtin_bit_cast(unsigned, f); u += 0x7fffu + ((u >> 16) & 1u); return u >> 16; }
#ifdef EMU
__device__ __forceinline__ unsigned cvt_pk_bf16(float lo, float hi) { return f2bf_bits(lo) | (f2bf_bits(hi) << 16); }
__device__ __forceinline__ unsigned cvt_pk_bf16_pinned(float lo, float hi) { return f2bf_bits(lo) | (f2bf_bits(hi) << 16); }
#else
typedef __bf16 bf16v2_t __attribute__((ext_vector_type(2)));
typedef float f32v2_t __attribute__((ext_vector_type(2)));
__device__ __forceinline__ unsigned cvt_pk_bf16(float lo, float hi) { const bf16v2_t r = __builtin_convertvector((f32v2_t){lo, hi}, bf16v2_t); return __builtin_bit_cast(unsigned, r); }
__device__ __forceinline__ unsigned cvt_pk_bf16_pinned(float lo, float hi) { unsigned r; asm volatile("v_cvt_pk_bf16_f32 %0, %1, %2\n\ts_nop 1" : "=v"(r) : "v"(lo), "v"(hi)); return r; }
#endif
__device__ __forceinline__ float fast_exp(float x) { return __builtin_amdgcn_exp2f(x * 1.44269504089f); }
__device__ __forceinline__ float fsigmoid(float x) { return __builtin_amdgcn_rcpf(1.0f + fast_exp(-x)); }
__device__ __forceinline__ float fsilu(float x) { return x * fsigmoid(x); }
__device__ __forceinline__ float frsqrt(float x) { return __builtin_amdgcn_rsqf(x); }
#ifdef EMU
__device__ __forceinline__ float wave_sum(float v) {
#pragma unroll
    for (int m = 32; m >= 1; m >>= 1) v += __shfl_xor(v, m);
    return v;
}
#else
template <int CTRL, int ROW_MASK> __device__ __forceinline__ float dpp_t(float v) { return __builtin_bit_cast(float, __builtin_amdgcn_update_dpp(0, __builtin_bit_cast(int, v), CTRL, ROW_MASK, 0xF, false)); }
#define dpp_f(v, ctrl, rm) dpp_t<ctrl, rm>(v)
__device__ __forceinline__ float wave_sum(float v) {
    v += dpp_f(v, 0xB1, 0xF);
    v += dpp_f(v, 0x4E, 0xF);
    v += dpp_f(v, 0x141, 0xF);
    v += dpp_f(v, 0x140, 0xF);
    v += dpp_f(v, 0x142, 0xA);
    v += dpp_f(v, 0x143, 0xC);
    return __builtin_bit_cast(float, __builtin_amdgcn_readlane(__builtin_bit_cast(int, v), 63));
}
__device__ __forceinline__ float half_sum(float v, int hi) {
    v += dpp_f(v, 0xB1, 0xF); v += dpp_f(v, 0x4E, 0xF); v += dpp_f(v, 0x141, 0xF); v += dpp_f(v, 0x140, 0xF);
    v += dpp_f(v, 0x142, 0xA);
    const float a = __builtin_bit_cast(float, __builtin_amdgcn_readlane(__builtin_bit_cast(int, v), 31)), b = __builtin_bit_cast(float, __builtin_amdgcn_readlane(__builtin_bit_cast(int, v), 63));
    return hi ? b : a;
}
#endif
#ifdef EMU
__device__ __forceinline__ float half_sum(float v, int) {
#pragma unroll
    for (int m = 1; m < 32; m <<= 1) v += __shfl_xor(v, m);
    return v;
}
#endif

namespace pg8 {
#define PG8_LAS LAS
constexpr int BM = 256, BK = 64, HALF = 128, HTB = HALF * BK * 2  , STAGE_BYTES = 8 * HTB, NXCD = 8, WGM = 8;

__host__ __device__ __forceinline__ int lds_byte(int r, int c) { const int st = (r >> 4) * 2 + (c >> 5), rr = r & 15, cc = c & 31, ob = rr * 64 + cc * 2; return st * 1024 + (ob ^ (((ob >> 9) & 1) << 5)); }
__host__ __device__ __forceinline__ void stage_rc(int b, int& R, int& C) { const int st = b / 1024, sb = b % 1024, swz = sb ^ (((sb >> 9) & 1) << 5); R = (st >> 1) * 16 + swz / 64; C = (st & 1) * 32 + (swz % 64) / 2; }
__host__ __device__ __forceinline__ int perm32(int rho) { const int n = rho >> 4, i = rho & 15; return 8 * (i >> 2) + 4 * n + (i & 3); }

struct Unit { int pm, pn, narrow; };
struct Gemm { const bf16_t* A; const bf16_t* Bt; int M, N, K; };

struct StaticOrder {
    static constexpr bool HAS_NARROW = false;
    int nM, nN, nwg, G, c;
    __host__ __device__ void init(int M, int N, int G_, int c_) { nM = M / BM; nN = N / BM; nwg = nM * nN; G = G_; c = c_; }
    __host__ __device__ bool next(int i, Unit& u) const {
        const long L = (long)i * G + c; if (L >= nwg) return false;
        int wgid = (int)L; { const int q = nwg / NXCD, r = nwg % NXCD, xcd = wgid % NXCD, off = wgid / NXCD; wgid = (xcd < r ? xcd * (q + 1) : r * (q + 1) + (xcd - r) * q) + off; }
        const int nig = WGM * nN, gid = wgid / nig, fm = gid * WGM, gsz = (nM - fm) < WGM ? (nM - fm) : WGM;
        u.pm = fm + ((wgid % nig) % gsz); u.pn = (wgid % nig) / gsz; return true;
    }
    __device__ __forceinline__ void a_ready(const Unit&) const {}
    __device__ __forceinline__ void done(const Unit&) const {}
};
struct TailNarrowOrder {
    static constexpr bool HAS_NARROW = true;
    StaticOrder full; int nM, G, c;
    __host__ __device__ void init(int M, int G_, int c_) { nM = M / BM; G = G_; c = c_; full.init(M, 8 * BM, G_, c_); }
    __host__ __device__ bool next(int i, Unit& u) const { const long L = (long)i * G + c;
        if (L < full.nwg) { const bool ok = full.next(i, u); u.narrow = 0; return ok; }
        if (L >= full.nwg + nM) return false;
        u.pm = (int)(L - full.nwg); u.pn = 8; u.narrow = 1; return true; }
    __device__ __forceinline__ void a_ready(const Unit&) const {}
    __device__ __forceinline__ void done(const Unit&) const {}
};
template <class Epi, class Sched, bool ALIGN_EPI = false, bool SP2 = false, bool GATHER = false>
__device__ __forceinline__ void gemm_phase(PG8_LAS unsigned char* lds, const Gemm g, const Sched& S, const Epi& E, const int* rowmap = nullptr) {
    int tid = threadIdx.x; LAUNDER_V(tid); const int wid = __builtin_amdgcn_readfirstlane(tid >> 6), lane = tid & 63, wr = wid >> 2, wc = wid & 3, fr = lane & 15, fq = lane >> 4;
    const int K = g.K, nt = K / BK;
    unsigned voffA[2], voffB[2]; int RA[2], CA[2];
#pragma unroll
    for (int i = 0; i < 2; ++i) { int R, C; stage_rc(tid * 16 + i * 8192, R, C); const int Rb = Epi::PERM ? ((R & ~31) + perm32(R & 31)) : R;
        voffA[i] = (unsigned)(R * K + C) * 2u; voffB[i] = (unsigned)(Rb * K + C) * 2u; RA[i] = R; CA[i] = C; }
    const size_t kstep = (size_t)(BK * 2);
    const size_t hstep = (size_t)HALF * K * 2;
    const size_t tstep = 2 * hstep;
    const size_t hA = GATHER ? (size_t)0 : hstep;
    unsigned vA0[2], vA1[2], nA0[2], nA1[2];
    auto rows_of = [&](const Unit& u, unsigned (&o0)[2], unsigned (&o1)[2]) {
#pragma unroll
        for (int i = 0; i < 2; ++i) { if constexpr (GATHER) { int t0 = rowmap[u.pm * BM + RA[i]], t1 = rowmap[u.pm * BM + HALF + RA[i]]; t0 = t0 < 0 ? 0 : (t0 >> 1); t1 = t1 < 0 ? 0 : (t1 >> 1);
                o0[i] = (unsigned)(t0 * K + CA[i]) * 2u; o1[i] = (unsigned)(t1 * K + CA[i]) * 2u; } else { o0[i] = voffA[i]; o1[i] = voffA[i]; } } };
    const unsigned ldsw = (unsigned)wid * 1024u;
    const int aoff = lds_byte(wr * 64 + fr, fq * 8), boff = lds_byte(wc * 32 + fr, fq * 8);
#define PG8_SA(b, h) (((b) * 2 + (h)) * HTB)
#define PG8_SB(b, h) ((4 + (b) * 2 + (h)) * HTB)
#define PG8_STAGE(bufoff, gbase, voff) do { _Pragma("unroll") for (int _i = 0; _i < 2; ++_i) \
        __builtin_amdgcn_global_load_lds((const unsigned*)((const char*)(gbase) + (voff)[_i]), (PG8_LAS unsigned*)(lds + (bufoff) + ldsw + _i * 8192), 16, 0, 0); } while (0)
#define PG8_LDA(dst, b, h) do { _Pragma("unroll") for (int m = 0; m < 4; ++m) _Pragma("unroll") for (int k = 0; k < 2; ++k) dst[m][k] = *(const PG8_LAS bf16x8*)(lds + PG8_SA(b, h) + aoff + m * 2048 + k * 1024); } while (0)
#define PG8_LDB(dst, b, h) do { _Pragma("unroll") for (int n = 0; n < 2; ++n) _Pragma("unroll") for (int k = 0; k < 2; ++k) dst[n][k] = *(const PG8_LAS bf16x8*)(lds + PG8_SB(b, h) + boff + n * 2048 + k * 1024); } while (0)
#define PG8_MMA(ai, bj, At, Bt) do { __builtin_amdgcn_s_setprio(1); _Pragma("unroll") for (int m = 0; m < 4; ++m) _Pragma("unroll") for (int n = 0; n < 2; ++n) _Pragma("unroll") for (int k = 0; k < 2; ++k) \
        acc[ai][bj][m][n] = __builtin_amdgcn_mfma_f32_16x16x32_bf16(Bt[n][k], At[m][k], acc[ai][bj][m][n], 0, 0, 0); __builtin_amdgcn_s_setprio(0); } while (0)
#define PG8_WAIT_V(n) ASMV("s_waitcnt vmcnt(" #n ")" ::: "memory")
#define PG8_WAIT_L(n) ASMV("s_waitcnt lgkmcnt(" #n ")" ::: "memory")
#define PG8_BAR __builtin_amdgcn_s_barrier()
#define PG8_SCHED __builtin_amdgcn_sched_barrier(0)
    Unit cur, nxt; int ui = 0;
    if (!S.next(0, cur)) return;
    f32x4 acc[2][2][4][2];
#pragma unroll
    for (int a = 0; a < 2; ++a)
#pragma unroll
        for (int b = 0; b < 2; ++b)
#pragma unroll
            for (int m = 0; m < 4; ++m)
#pragma unroll
                for (int n = 0; n < 2; ++n) acc[a][b][m][n] = (f32x4){0.f, 0.f, 0.f, 0.f};
    bf16x8 At[4][2], B0[2][2], B1[2][2];
    const char* cA = GATHER ? (const char*)g.A : (const char*)g.A + (size_t)cur.pm * tstep; rows_of(cur, vA0, vA1); const char* cB = (const char*)g.Bt + (size_t)cur.pn * tstep;
    S.a_ready(cur);
    if constexpr (SP2) {
        PG8_STAGE(PG8_SB(0, 0), cB, voffB); PG8_STAGE(PG8_SB(0, 1), cB + hstep, voffB); PG8_STAGE(PG8_SA(0, 0), cA, vA0); PG8_STAGE(PG8_SA(0, 1), cA + hA, vA1);
        if (wr == 1) PG8_BAR;
        PG8_WAIT_V(2); PG8_BAR;
        PG8_STAGE(PG8_SB(1, 0), cB + kstep, voffB); PG8_STAGE(PG8_SA(1, 0), cA + kstep, vA0); PG8_STAGE(PG8_SB(1, 1), cB + hstep + kstep, voffB);
        PG8_WAIT_V(6); PG8_BAR;
    } else {
        PG8_STAGE(PG8_SB(0, 0), cB, voffB); PG8_STAGE(PG8_SA(0, 0), cA, vA0); PG8_STAGE(PG8_SB(0, 1), cB + hstep, voffB); PG8_STAGE(PG8_SA(0, 1), cA + hA, vA1);
        if (wr == 1) PG8_BAR;
        PG8_WAIT_V(4); PG8_BAR;
        PG8_STAGE(PG8_SB(1, 0), cB + kstep, voffB); PG8_STAGE(PG8_SA(1, 0), cA + kstep, vA0); PG8_STAGE(PG8_SB(1, 1), cB + hstep + kstep, voffB);
        PG8_WAIT_V(6); PG8_BAR;
    }
    for (;;) {
        const bool has_next = S.next(ui + 1, nxt);
        const char* nA = GATHER ? (const char*)g.A : (has_next ? (const char*)g.A + (size_t)nxt.pm * tstep : cA);
        if (has_next) rows_of(nxt, nA0, nA1); else { nA0[0] = vA0[0]; nA0[1] = vA0[1]; nA1[0] = vA1[0]; nA1[1] = vA1[1]; } const char* nB = has_next ? (const char*)g.Bt + (size_t)nxt.pn * tstep : cB;
        for (int t = 0; t < nt; t += 2) {
            const bool last = (t == nt - 2);
            unsigned sA0[2], sA1[2];
#pragma unroll
            for (int i = 0; i < 2; ++i) { sA0[i] = last ? nA0[i] : vA0[i]; sA1[i] = last ? nA1[i] : vA1[i]; }
            const char* a1 = cA + (size_t)(t + 1) * kstep;
            const char* a2 = last ? nA : cA + (size_t)(t + 2) * kstep; const char* b2 = last ? nB : cB + (size_t)(t + 2) * kstep;
            const char* a3 = a2 + kstep; const char* b3 = b2 + kstep;
            if (last && has_next) S.a_ready(nxt);
            if constexpr (SP2) {
            PG8_LDB(B0, 0, 0); PG8_LDB(B1, 0, 1); PG8_SCHED; PG8_LDA(At, 0, 0); PG8_STAGE(PG8_SA(1, 1), a1 + hA, vA1);
            PG8_WAIT_V(8); PG8_WAIT_L(0); PG8_BAR; PG8_MMA(0, 0, At, B0); if (!Sched::HAS_NARROW || !cur.narrow) PG8_MMA(0, 1, At, B1); PG8_BAR; PG8_SCHED;
            PG8_LDA(At, 0, 1); PG8_STAGE(PG8_SB(0, 0), b2, voffB); PG8_STAGE(PG8_SB(0, 1), b2 + hstep, voffB); PG8_STAGE(PG8_SA(0, 0), a2, sA0);
            PG8_WAIT_V(8); PG8_WAIT_L(0); PG8_BAR; PG8_MMA(1, 0, At, B0); if (!Sched::HAS_NARROW || !cur.narrow) PG8_MMA(1, 1, At, B1); PG8_BAR; PG8_SCHED;
            PG8_LDB(B0, 1, 0); PG8_LDB(B1, 1, 1); PG8_SCHED; PG8_LDA(At, 1, 0); PG8_STAGE(PG8_SA(0, 1), a2 + hA, sA1);
            PG8_WAIT_V(8); PG8_WAIT_L(0); PG8_BAR; PG8_MMA(0, 0, At, B0); if (!Sched::HAS_NARROW || !cur.narrow) PG8_MMA(0, 1, At, B1); PG8_BAR; PG8_SCHED;
            PG8_LDA(At, 1, 1); PG8_STAGE(PG8_SB(1, 0), b3, voffB); PG8_STAGE(PG8_SB(1, 1), b3 + hstep, voffB); PG8_STAGE(PG8_SA(1, 0), a3, sA0);
            PG8_WAIT_V(8); PG8_WAIT_L(0); PG8_BAR; PG8_MMA(1, 0, At, B0); if (!Sched::HAS_NARROW || !cur.narrow) PG8_MMA(1, 1, At, B1); PG8_BAR; PG8_SCHED;
            } else {
            PG8_LDB(B0, 0, 0); PG8_SCHED; PG8_LDA(At, 0, 0); PG8_STAGE(PG8_SA(1, 1), a1 + hA, vA1);
            PG8_WAIT_L(8); PG8_BAR; PG8_WAIT_L(0); PG8_MMA(0, 0, At, B0); PG8_BAR; PG8_SCHED;
            PG8_LDB(B1, 0, 1); PG8_STAGE(PG8_SB(0, 0), b2, voffB);
            PG8_BAR; PG8_WAIT_L(0); if (!Sched::HAS_NARROW || !cur.narrow) PG8_MMA(0, 1, At, B1); PG8_BAR;
            PG8_LDA(At, 0, 1); PG8_STAGE(PG8_SA(0, 0), a2, sA0);
            PG8_BAR; PG8_WAIT_L(0); PG8_MMA(1, 0, At, B0); PG8_BAR; PG8_SCHED;
            PG8_STAGE(PG8_SB(0, 1), b2 + hstep, voffB);
            PG8_WAIT_V(6); PG8_BAR; if (!Sched::HAS_NARROW || !cur.narrow) PG8_MMA(1, 1, At, B1); PG8_BAR;
            PG8_LDB(B0, 1, 0); PG8_SCHED; PG8_LDA(At, 1, 0); PG8_STAGE(PG8_SA(0, 1), a2 + hA, sA1);
            PG8_WAIT_L(8); PG8_BAR; PG8_WAIT_L(0); PG8_MMA(0, 0, At, B0); PG8_BAR; PG8_SCHED;
            PG8_LDB(B1, 1, 1); PG8_STAGE(PG8_SB(1, 0), b3, voffB);
            PG8_BAR; PG8_WAIT_L(0); if (!Sched::HAS_NARROW || !cur.narrow) PG8_MMA(0, 1, At, B1); PG8_BAR;
            PG8_LDA(At, 1, 1); PG8_STAGE(PG8_SA(1, 0), a3, sA0);
            PG8_BAR; PG8_WAIT_L(0); PG8_MMA(1, 0, At, B0); PG8_BAR; PG8_SCHED;
            PG8_STAGE(PG8_SB(1, 1), b3 + hstep, voffB);
            PG8_WAIT_V(6); PG8_BAR; if (!Sched::HAS_NARROW || !cur.narrow) PG8_MMA(1, 1, At, B1); PG8_BAR;
            }
        }
        if constexpr (ALIGN_EPI) { if (wr == 0) PG8_BAR; }
        if constexpr (!Epi::AFTER_DRAIN) { E(acc, cur, wr, wc, fr, fq); S.done(cur); }
        if (!has_next) break;
#pragma unroll
        for (int a = 0; a < 2; ++a)
#pragma unroll
            for (int b = 0; b < 2; ++b)
#pragma unroll
                for (int m = 0; m < 4; ++m)
#pragma unroll
                    for (int n = 0; n < 2; ++n) acc[a][b][m][n] = (f32x4){0.f, 0.f, 0.f, 0.f};
        cur = nxt; cA = nA; cB = nB; ++ui; vA0[0] = nA0[0]; vA0[1] = nA0[1]; vA1[0] = nA1[0]; vA1[1] = nA1[1];
        if constexpr (ALIGN_EPI) { if (wr == 1) PG8_BAR; }
    }
    PG8_WAIT_V(0);
    if constexpr (!ALIGN_EPI) { if (wr == 0) PG8_BAR; }
    PG8_BAR;
    if constexpr (Epi::AFTER_DRAIN) { E.fused(acc, cur, wr, wc, fr, fq, lds, wid, lane); S.done(cur); }
#undef PG8_SA
#undef PG8_SB
#undef PG8_STAGE
#undef PG8_LDA
#undef PG8_LDB
#undef PG8_MMA
#undef PG8_WAIT_V
#undef PG8_WAIT_L
#undef PG8_BAR
#undef PG8_SCHED
}

struct EpiBf16 {
    static constexpr bool PERM = true, AFTER_DRAIN = false;
    bf16_t* O; int ldc;
    __device__ __forceinline__ void operator()(const f32x4 (&acc)[2][2][4][2], const Unit& u, int wr, int wc, int fr, int fq) const {
        const int row0 = u.pm * BM + wr * 64 + fr, col0 = u.pn * BM + wc * 32 + 8 * fq;
#pragma unroll
        for (int ai = 0; ai < 2; ++ai)
#pragma unroll
            for (int m = 0; m < 4; ++m) { bf16_t* rowp = O + (size_t)(row0 + ai * HALF + m * 16) * ldc + col0;
#pragma unroll
                for (int bj = 0; bj < 2; ++bj) { const f32x4 v0 = acc[ai][bj][m][0], v1 = acc[ai][bj][m][1];
                    u32x4 w; w.x = cvt_pk_bf16(v0[0], v0[1]); w.y = cvt_pk_bf16(v0[2], v0[3]); w.z = cvt_pk_bf16(v1[0], v1[1]); w.w = cvt_pk_bf16(v1[2], v1[3]);
                    *(u32x4*)(rowp + bj * HALF) = w; } }
    }
};
struct EpiResid {
    static constexpr bool PERM = true, AFTER_DRAIN = false;
    const float* xin; const bf16_t* xinb; bf16_t* xout; const float* gate; int gstride; int seq; const bf16_t* y1;
    __device__ __forceinline__ void operator()(const f32x4 (&acc)[2][2][4][2], const Unit& u, int wr, int wc, int fr, int fq) const {
        const int row0 = u.pm * BM + wr * 64 + fr, col0 = u.pn * BM + wc * 32 + 8 * fq;
#pragma unroll
        for (int ai = 0; ai < 2; ++ai)
#pragma unroll
            for (int m = 0; m < 4; ++m) { const int row = row0 + ai * HALF + m * 16; const float* gp = gate + (size_t)(row / seq) * gstride;
#pragma unroll
                for (int bj = 0; bj < 2; ++bj) { const int c = col0 + bj * HALF; const size_t o = (size_t)row * 1024 + c;
                    const f32x4 g0 = *(const f32x4*)(gp + c), g1 = *(const f32x4*)(gp + c + 4);
                    f32x4 x0, x1;
                    if (xin) { x0 = *(const f32x4*)(xin + o); x1 = *(const f32x4*)(xin + o + 4); }
                    else { const u32x4 xw = *(const u32x4*)(xinb + o), y = *(const u32x4*)(y1 + o);
                        x0 = (f32x4){bflo(xw.x), bfhi(xw.x), bflo(xw.y), bfhi(xw.y)} + (f32x4){bflo(y.x), bfhi(y.x), bflo(y.y), bfhi(y.y)};
                        x1 = (f32x4){bflo(xw.z), bfhi(xw.z), bflo(xw.w), bfhi(xw.w)} + (f32x4){bflo(y.z), bfhi(y.z), bflo(y.w), bfhi(y.w)}; }
                    x0 += g0 * acc[ai][bj][m][0]; x1 += g1 * acc[ai][bj][m][1];
                    u32x4 w; w.x = cvt_pk_bf16(x0[0], x0[1]); w.y = cvt_pk_bf16(x0[2], x0[3]); w.z = cvt_pk_bf16(x1[0], x1[1]); w.w = cvt_pk_bf16(x1[2], x1[3]);
                    *(u32x4*)(xout + o) = w; } }
    }
};
struct EpiSwiglu {
    static constexpr bool PERM = true, AFTER_DRAIN = false;
    bf16_t* HB;
    __device__ __forceinline__ void operator()(const f32x4 (&acc)[2][2][4][2], const Unit& u, int wr, int wc, int fr, int fq) const {
        const int row0 = u.pm * BM + wr * 64 + fr, col0 = (u.pn & 3) * 128 + wc * 32 + 8 * fq;
#pragma unroll
        for (int ai = 0; ai < 2; ++ai)
#pragma unroll
            for (int m = 0; m < 4; ++m) { bf16_t* p = HB + (size_t)(row0 + ai * HALF + m * 16) * 512 + col0;
                float h[8];
#pragma unroll
                for (int n = 0; n < 2; ++n)
#pragma unroll
                    for (int k = 0; k < 4; ++k) h[n * 4 + k] = fsilu(acc[ai][0][m][n][k]) * acc[ai][1][m][n][k];
                u32x4 w; w.x = cvt_pk_bf16(h[0], h[1]); w.y = cvt_pk_bf16(h[2], h[3]); w.z = cvt_pk_bf16(h[4], h[5]); w.w = cvt_pk_bf16(h[6], h[7]);
                *(u32x4*)p = w; }
    }
};
struct EpiDown {
    static constexpr bool PERM = true, AFTER_DRAIN = false;
    const int* row_tok; const float* row_w; bf16_t* x; bf16_t* y1; const float* gate; int gstride; int seq;
    __device__ __forceinline__ void operator()(const f32x4 (&acc)[2][2][4][2], const Unit& u, int wr, int wc, int fr, int fq) const {
        const int row0 = u.pm * BM + wr * 64 + fr, col0 = (u.pn & 3) * BM + wc * 32 + 8 * fq;
#pragma unroll
        for (int ai = 0; ai < 2; ++ai)
#pragma unroll
            for (int m = 0; m < 4; ++m) { const int row = row0 + ai * HALF + m * 16; const int ts = row_tok[row];
                if (ts >= 0) { const int tok = ts >> 1; const float w = row_w[row]; const float* gp = gate + (size_t)(tok / seq) * gstride;
#pragma unroll
                    for (int bj = 0; bj < 2; ++bj) { const int c = col0 + bj * HALF; const size_t o = (size_t)tok * 1024 + c;
                        const f32x4 v0 = acc[ai][bj][m][0] * (*(const f32x4*)(gp + c)) * w, v1 = acc[ai][bj][m][1] * (*(const f32x4*)(gp + c + 4)) * w;
                        if (ts & 1) { u32x4 q; q.x = cvt_pk_bf16(v0[0], v0[1]); q.y = cvt_pk_bf16(v0[2], v0[3]); q.z = cvt_pk_bf16(v1[0], v1[1]); q.w = cvt_pk_bf16(v1[2], v1[3]); *(u32x4*)(y1 + o) = q; }
                        else { const u32x4 xw = *(const u32x4*)(x + o); const f32x4 s0 = (f32x4){bflo(xw.x), bfhi(xw.x), bflo(xw.y), bfhi(xw.y)} + v0, s1 = (f32x4){bflo(xw.z), bfhi(xw.z), bflo(xw.w), bfhi(xw.w)} + v1;
                            u32x4 q; q.x = cvt_pk_bf16(s0[0], s0[1]); q.y = cvt_pk_bf16(s0[2], s0[3]); q.z = cvt_pk_bf16(s1[0], s1[1]); q.w = cvt_pk_bf16(s1[2], s1[3]); *(u32x4*)(x + o) = q; } } } }
    }
};
struct MoeOrder {
    static constexpr bool HAS_NARROW = false;
    const int* tile; int G, c;
    __device__ __forceinline__ bool next(int i, Unit& u) const { const int v = ((G & 7) == 0) ? (c & 7) * (G >> 3) + (c >> 3) : c; const int L = i * G + v, nt = tile[0]; if (L >= nt * 4) return false; u.pm = L >> 2; u.pn = tile[1 + (L >> 2)] * 4 + (L & 3); return true; }
    __device__ __forceinline__ void a_ready(const Unit&) const {}
    __device__ __forceinline__ void done(const Unit&) const {}
};
}

constexpr int NB = CFG_B, SEQ = CFG_S, NL = CFG_L, NTOK = NB * SEQ, DM = 1024, ZP = 2304;
constexpr int NBH = NB * 4, NCH = SEQ / 128, NQT = SEQ / 256;
constexpr int NR = 2 * NTOK + 32 * 256;
constexpr int Z_CQ = 0, Z_CKV = 192, Z_KR = 320, Z_POOL = 352, Z_HQ = 608, Z_HF = 864, Z_HI = 1120, Z_HG = 1376, Z_CA = 1632, Z_CG = 1888;
constexpr float EPS = 1e-6f;
static_assert(SEQ % 256 == 0 && NTOK % 256 == 0 && (NQT % 2) == 0, "shape");
constexpr size_t al256(size_t x) { return (x + 255) & ~(size_t)255; }
constexpr size_t cmax(size_t a, size_t b) { return a > b ? a : b; }
constexpr size_t WS_CTL = 0, CTL_BYTES = 65536;
constexpr size_t CTL_CNT = 16384;
constexpr size_t CTL_HG = 32768;
constexpr size_t WS_MODP = WS_CTL + CTL_BYTES;
constexpr size_t WS_MOD = WS_MODP + al256((size_t)16 * NL * NB * 6144 * 4);
constexpr size_t WS_LB = WS_MOD + al256((size_t)NL * NB * 6144 * 4);
constexpr size_t WS_ROPE = WS_LB + al256((size_t)NL * 256 * 4);
constexpr size_t WS_WIN = WS_ROPE + al256((size_t)NTOK * 32 * 4);
constexpr size_t WS_WOUT = WS_WIN + (size_t)ZP * 1024 * 2;
constexpr size_t WS_WUQ = WS_WOUT + (size_t)1024 * 1024 * 2;
constexpr size_t WS_WUKV = WS_WUQ + al256((size_t)384 * 192 * 2);
constexpr size_t WS_WPOOL = WS_WUKV + al256((size_t)512 * 128 * 2);
constexpr size_t WS_WUP = WS_WPOOL + al256((size_t)4 * 64 * 64 * 2);
constexpr size_t WS_WDN = WS_WUP + (size_t)32 * 1024 * 1024 * 2;
constexpr size_t WS_RWT = WS_WDN + (size_t)32 * 1024 * 512 * 2;
constexpr size_t WSET = WS_RWT + 36 * 1024 * 4 - WS_WIN;
constexpr size_t WS_HA = WS_WIN + 2 * WSET;
constexpr size_t WS_Z = WS_HA + (size_t)NTOK * 1024 * 2;
constexpr size_t Z_BYTES = cmax((size_t)NTOK * ZP * 2, (size_t)NR * 1024 * 2);
constexpr size_t WS_Q = WS_Z + Z_BYTES;
constexpr size_t WS_K = WS_Q + (size_t)NTOK * 4 * 96 * 2;
constexpr size_t WS_VT = WS_K + (size_t)NTOK * 4 * 96 * 2;
constexpr size_t WS_YB = WS_VT + (size_t)NTOK * 4 * 64 * 2;
constexpr size_t R2_BYTES = cmax(WS_YB + (size_t)NTOK * 1024 * 2 - WS_Q, (size_t)NR * 512 * 2);
constexpr size_t WS_Y1 = WS_Q + R2_BYTES;
constexpr size_t WS_SC = WS_Y1 + (size_t)NTOK * 1024 * 2;
constexpr size_t WS_PC = WS_SC + (size_t)NBH * NCH * 4096 * 4;
constexpr size_t WS_S0 = WS_PC + al256((size_t)NBH * NCH * 64 * 4);
constexpr size_t WS_ASGE = WS_S0 + (size_t)NBH * NCH * 4096 * 4;
constexpr size_t WS_ASGR = WS_ASGE + (size_t)NTOK * 8;
constexpr size_t WS_ASGW = WS_ASGR + (size_t)NTOK * 8;
constexpr size_t WS_ROWTOK = WS_ASGW + (size_t)NTOK * 8;
constexpr size_t WS_ROWW = WS_ROWTOK + al256((size_t)NR * 4);
constexpr size_t WS_TILE = WS_ROWW + al256((size_t)NR * 4);
constexpr size_t WS_XB = WS_TILE + al256((size_t)(NR / 256 + 16) * 4);
constexpr size_t WS_END = WS_XB + (size_t)NTOK * 1024 * 2;
constexpr int LDS_BYTES = 160 * 1024;
constexpr int LDS_XB = LDS_BYTES - 16;

#define XB_TMO      128
#define XB_XCNT(j)  (256  + 64 * (j))
#define XB_XSUB(j)  (1280 + 64 * (j))
#define XB_XGEN(j)  (2304 + 64 * (j))
#define XB_TOP      3328
#define XB_TOPGEN   3392
#define XCD_BAR_WORDS 3456
#define XB_SPIN_CAP (1u << 18)
__device__ __forceinline__ unsigned xb_ld(unsigned* p)              { return __hip_atomic_load(p, __ATOMIC_RELAXED, __HIP_MEMORY_SCOPE_AGENT); }
__device__ __forceinline__ unsigned xb_add(unsigned* p, unsigned v) { return __hip_atomic_fetch_add(p, v, __ATOMIC_RELAXED, __HIP_MEMORY_SCOPE_AGENT); }
__device__ __forceinline__ unsigned xb_xcc_id() { return (unsigned)__builtin_amdgcn_s_getreg((3 << 11) | 20) & 0xFu; }
#define XB_SPIN(cond, bar) do { unsigned _sp = 0; while (cond) { __builtin_amdgcn_s_sleep(1); \
    if ((++_sp & 255u) == 0u) { if (xb_ld(&(bar)[XB_TMO])) break; if (_sp > XB_SPIN_CAP) { atomicAdd(&(bar)[XB_TMO], 1u); break; } } } } while (0)
struct XcdBarrier { unsigned* bar; unsigned x; volatile LAS unsigned* st; };
__device__ __forceinline__ XcdBarrier xcd_barrier_post(unsigned* bar, volatile LAS unsigned* st) {
    XcdBarrier b; b.bar = bar; b.x = xb_xcc_id(); b.st = st;
    if (threadIdx.x == 0) (void)xb_add(&bar[XB_XCNT(b.x)], 1u);
    return b;
}
__device__ __forceinline__ void xcd_barrier_complete(unsigned* bar, unsigned x, unsigned& nloc, unsigned& nx) {
    const unsigned G = gridDim.x * gridDim.y * gridDim.z;
    unsigned sum, cnt, mine, sp = 0u;
    for (;;) {
        sum = 0u; cnt = 0u; mine = 0u;
#pragma unroll
        for (unsigned j = 0; j < 16; ++j) { const unsigned c = xb_ld(&bar[XB_XCNT(j)]); sum += c; cnt += (c > 0u) ? 1u : 0u; mine = (j == x) ? c : mine; }
        if (sum == G) break;
        __builtin_amdgcn_s_sleep(1);
        if ((++sp & 255u) == 0u) { if (xb_ld(&bar[XB_TMO])) break; if (sp > XB_SPIN_CAP) { atomicAdd(&bar[XB_TMO], 1u); break; } }
    }
    nloc = mine > 0u ? mine : 1u; nx = cnt > 0u ? cnt : 1u;
}
__device__ __forceinline__ void xcd_barrier(const XcdBarrier& b) {
    ASMV("s_waitcnt vmcnt(0)" ::: "memory");
    __syncthreads();
    if (threadIdx.x == 0) {
        unsigned* bar = b.bar;
        __builtin_amdgcn_s_waitcnt(0);
        unsigned nloc = b.st[0], nx = b.st[1];
        if (nloc == 0u) { xcd_barrier_complete(bar, b.x, nloc, nx); b.st[0] = nloc; b.st[1] = nx; }
        const unsigned old = xb_add(&bar[XB_XSUB(b.x)], 1u);
        const unsigned gen = old / nloc;
        if (old + 1u == (gen + 1u) * nloc) {
            __builtin_amdgcn_fence(__ATOMIC_RELEASE, "agent");
            ASMV("s_waitcnt vmcnt(0)" ::: "memory");
            const unsigned og = xb_add(&bar[XB_TOP], 1u);
            const unsigned tg = og / nx;
            if (og + 1u == (tg + 1u) * nx) xb_add(&bar[XB_TOPGEN], 1u);
            else XB_SPIN(xb_ld(&bar[XB_TOPGEN]) == tg, bar);
            __builtin_amdgcn_fence(__ATOMIC_ACQUIRE, "agent");
            xb_add(&bar[XB_XGEN(b.x)], 1u);
            ASMV("s_waitcnt vmcnt(0)" ::: "memory");
        } else {
            XB_SPIN(xb_ld(&bar[XB_XGEN(b.x)]) == gen, bar);
            __builtin_amdgcn_fence(__ATOMIC_ACQUIRE, "agent");
            ASMV("s_waitcnt vmcnt(0)" ::: "memory");
        }
    }
    __syncthreads();
}

struct Args { const void* in[30]; float* out; unsigned char* ws; int ph_lo, ph_hi; };
enum { I_X = 0, I_C, I_POS, I_WADA, I_BADA, I_N1G, I_N2G, I_WIN, I_QAG, I_WUQ, I_KVAG, I_WUKV, I_QG, I_KG, I_WPOOL, I_PSCALE, I_LBL, I_HOG, I_DWW, I_DWB, I_LNG, I_LNB,
       I_WOUT, I_RGW, I_RGB, I_REW, I_REB, I_W1, I_W3, I_W2 };
struct Ctx {
    const Args* a; unsigned char* ws; unsigned char* lds; int tid, wid, lane, G, blk;
    __device__ __forceinline__ const float* inf(int i) const { return (const float*)a->in[i]; }
    template <class T> __device__ __forceinline__ T* w(size_t off) const { return (T*)(ws + off); }
};

__device__ __forceinline__ Ctx fresh(const Ctx& c0) { Ctx c = c0; LAUNDER_V(c.tid); LAUNDER_V(c.lane); LAUNDER_S(c.wid); return c; }
__device__ __forceinline__ void ph_prologue0(const Ctx& c_) { const Ctx c = fresh(c_);
    const float* cc = c.inf(I_C); const float* wada = c.inf(I_WADA); float* modp = c.w<float>(WS_MODP);
    for (int u = c.blk; u < NL * 16 * 12; u += c.G) {
        const int l = u / 192, r = u % 192, ic = r / 12, jb = r % 12, j = jb * 512 + c.tid;
        float* Ls = (float*)c.lds;
        __syncthreads();
        if (c.tid < NB * 64) Ls[c.tid] = fsilu(cc[(c.tid >> 6) * 1024 + ic * 64 + (c.tid & 63)]);
        __syncthreads();
        float acc[NB];
#pragma unroll
        for (int b = 0; b < NB; ++b) acc[b] = 0.f;
        const float* wp = wada + ((size_t)l * 1024 + ic * 64) * 6144 + j;
#pragma unroll
        for (int i0 = 0; i0 < 64; i0 += 16) { float wv[16];
#pragma unroll
            for (int i = 0; i < 16; ++i) wv[i] = wp[(size_t)(i0 + i) * 6144];
#pragma unroll
            for (int i = 0; i < 16; ++i)
#pragma unroll
                for (int b = 0; b < NB; ++b) acc[b] += Ls[b * 64 + i0 + i] * wv[i]; }
#pragma unroll
        for (int b = 0; b < NB; ++b) modp[(((size_t)ic * NL + l) * NB + b) * 6144 + j] = acc[b];
    }
    const int* pos = (const int*)c.a->in[I_POS]; float* rc = c.w<float>(WS_ROPE); float* rs = rc + (size_t)NTOK * 16;
    for (int e = c.blk * 512 + c.tid; e < NTOK * 16; e += c.G * 512) { const int t = e >> 4, i = e & 15;
        const float inv = exp2f(-(float)i * (13.287712379549449f / 16.0f));
        const float ang = (float)pos[t] * inv; rc[e] = cosf(ang); rs[e] = sinf(ang); }
    if (c.blk == 0 && c.tid < 256) { const float* lg = c.inf(I_LBL); float* lb = c.w<float>(WS_LB); float mx = -1e30f;
        for (int l = 0; l < NL; ++l) mx = fmaxf(mx, lg[l * 256 + c.tid]);
        float den = 0.f; for (int l = 0; l < NL; ++l) den += expf(lg[l * 256 + c.tid] - mx);
        float cum = 0.f, first = 0.f; for (int l = 0; l < NL; ++l) { cum += expf(lg[l * 256 + c.tid] - mx) / den; if (l == 0) first = cum; lb[l * 256 + c.tid] = cum - first; } }
}
__device__ __forceinline__ void ph_prologue1(const Ctx& c_) { const Ctx c = fresh(c_);
    const float* modp = c.w<float>(WS_MODP); float* mod = c.w<float>(WS_MOD); const float* bada = c.inf(I_BADA);
    for (int e = c.blk * 512 + c.tid; e < NL * NB * 6144; e += c.G * 512) { const int j = e % 6144, l = e / (NB * 6144);
        float s = bada[l * 6144 + j];
#pragma unroll
        for (int ic = 0; ic < 16; ++ic) s += modp[(size_t)ic * NL * NB * 6144 + e];
        mod[e] = s; }
}

__device__ __forceinline__ void ld8bf(const bf16_t* p, float (&o)[8]) { const u32x4 v = *(const u32x4*)p; o[0] = bflo(v.x); o[1] = bfhi(v.x); o[2] = bflo(v.y); o[3] = bfhi(v.y); o[4] = bflo(v.z); o[5] = bfhi(v.z); o[6] = bflo(v.w); o[7] = bfhi(v.w); }
__device__ __forceinline__ u32x4 pk8(const float (&o)[8]) { u32x4 w; w.x = cvt_pk_bf16(o[0], o[1]); w.y = cvt_pk_bf16(o[2], o[3]); w.z = cvt_pk_bf16(o[4], o[5]); w.w = cvt_pk_bf16(o[6], o[7]); return w; }
__device__ __forceinline__ u32x4 pk8p(const float (&o)[8]) { u32x4 w; w.x = cvt_pk_bf16_pinned(o[0], o[1]); w.y = cvt_pk_bf16_pinned(o[2], o[3]); w.z = cvt_pk_bf16_pinned(o[4], o[5]); w.w = cvt_pk_bf16_pinned(o[6], o[7]); return w; }
__device__ __forceinline__ void cvt_tile(const Ctx& c, const float* src, int ldn, int nlim, int k0, int n0, bf16_t* dst, int ldk, int drow0) {
    float* T = (float*)c.lds;
#pragma unroll
    for (int i = 0; i < 8; ++i) { const int e = c.tid + 512 * i, kk = e >> 6, nn = e & 63; T[kk * 65 + nn] = (n0 + nn < nlim) ? src[(size_t)(k0 + kk) * ldn + n0 + nn] : 0.f; }
    __syncthreads();
#pragma unroll
    for (int i = 0; i < 4; ++i) { const int e = c.tid + 512 * i, nn = e >> 5, k2 = e & 31;
        *(unsigned*)(dst + (size_t)(drow0 + nn) * ldk + k0 + 2 * k2) = cvt_pk_bf16(T[(2 * k2) * 65 + nn], T[(2 * k2 + 1) * 65 + nn]); }
    __syncthreads();
}
__device__ __forceinline__ void cvt_big(const Ctx& c, const float* src, int ldn, int nlim, int k0, int n0, bf16_t* dst, int ldk, int mode) {
    float* T = (float*)c.lds;
    f32x4 v[8];
#pragma unroll
    for (int i = 0; i < 8; ++i) { const int e4 = c.tid + 512 * i, kk = e4 >> 6, n4 = e4 & 63; v[i] = (n0 + n4 * 4 < nlim) ? *(const f32x4*)(src + (size_t)(k0 + kk) * ldn + n0 + n4 * 4) : (f32x4){0.f, 0.f, 0.f, 0.f}; }
#pragma unroll
    for (int i = 0; i < 8; ++i) { const int e4 = c.tid + 512 * i, kk = e4 >> 6, n4 = e4 & 63; float* p = T + kk * 261 + n4 * 4; p[0] = v[i][0]; p[1] = v[i][1]; p[2] = v[i][2]; p[3] = v[i][3]; }
    __syncthreads();
#pragma unroll
    for (int i = 0; i < 4; ++i) { const int e = c.tid + 512 * i, k8 = e & 7, nn = e >> 3, n = n0 + nn; float o[8];
#pragma unroll
        for (int j = 0; j < 8; ++j) o[j] = T[(8 * k8 + j) * 261 + nn];
        const int row = (mode == 0) ? n : ((n >> 7) * 256 + (mode - 1) * 128 + (n & 127));
        *(u32x4*)(dst + (size_t)row * ldk + k0 + 8 * k8) = pk8(o); }
    __syncthreads();
}
constexpr int CT_IN = 16 * 9, CT_OUT = 16 * 4, CT_W13 = 32 * 16 * 2, CT_W2 = 32 * 8 * 4, CT_UQ = 3 * 6, CT_UKV = 2 * 8, CT_POOL = 4;
constexpr int CT_TOTAL = CT_IN + CT_OUT + 2 * CT_W13 + CT_W2 + CT_UQ + CT_UKV + CT_POOL;
__device__ __forceinline__ void ph_cvt(const Ctx& c_, int l) { const Ctx c = fresh(c_);
    { const float* rgw = c.inf(I_RGW) + (size_t)l * 1024 * 4; const float* rew = c.inf(I_REW) + (size_t)l * 1024 * 32; float* rwt = c.w<float>(WS_RWT + (size_t)(l & 1) * WSET);
        for (int e = c.blk * 512 + c.tid; e < 36 * 1024; e += c.G * 512) { const int g = e >> 10, k = e & 1023; rwt[e] = (g < 4) ? rgw[k * 4 + g] : rew[k * 32 + g - 4]; } }
    for (int t = c.blk; t < CT_TOTAL; t += c.G) {
        int r = t;
        if (r < 2 * CT_W13) { const int which = r / CT_W13; r %= CT_W13; const int e = r / 32, kt = (r % 32) / 2, nt = r % 2;
            cvt_big(c, c.inf(which ? I_W3 : I_W1) + ((size_t)l * 32 + e) * 1024 * 512, 512, 512, kt * 64, nt * 256, c.w<bf16_t>(WS_WUP + (size_t)(l & 1) * WSET) + (size_t)e * 1024 * 1024, 1024, 1 + which); continue; } r -= 2 * CT_W13;
        if (r < CT_W2) { const int e = r / 32, kt = (r % 32) / 4, nt = r % 4;
            cvt_big(c, c.inf(I_W2) + ((size_t)l * 32 + e) * 512 * 1024, 1024, 1024, kt * 64, nt * 256, c.w<bf16_t>(WS_WDN + (size_t)(l & 1) * WSET) + (size_t)e * 1024 * 512, 512, 0); continue; } r -= CT_W2;
        if (r < CT_IN) { const int kt = r / 9, nt = r % 9; cvt_big(c, c.inf(I_WIN) + (size_t)l * 1024 * 2144, 2144, 2144, kt * 64, nt * 256, c.w<bf16_t>(WS_WIN + (size_t)(l & 1) * WSET), 1024, 0); continue; } r -= CT_IN;
        if (r < CT_OUT) { const int kt = r / 4, nt = r % 4; cvt_big(c, c.inf(I_WOUT) + (size_t)l * 1024 * 1024, 1024, 1024, kt * 64, nt * 256, c.w<bf16_t>(WS_WOUT + (size_t)(l & 1) * WSET), 1024, 0); continue; } r -= CT_OUT;
        if (r < CT_UQ) { const int kt = r / 6, nt = r % 6; cvt_tile(c, c.inf(I_WUQ) + (size_t)l * 192 * 384, 384, 384, kt * 64, nt * 64, c.w<bf16_t>(WS_WUQ + (size_t)(l & 1) * WSET), 192, nt * 64); continue; } r -= CT_UQ;
        if (r < CT_UKV) { const int kt = r / 8, nt = r % 8; cvt_tile(c, c.inf(I_WUKV) + (size_t)l * 128 * 512, 512, 512, kt * 64, nt * 64, c.w<bf16_t>(WS_WUKV + (size_t)(l & 1) * WSET), 128, nt * 64); continue; } r -= CT_UKV;
        cvt_tile(c, c.inf(I_WPOOL) + ((size_t)l * 4 + r) * 4096, 64, 64, 0, 0, c.w<bf16_t>(WS_WPOOL + (size_t)(l & 1) * WSET) + r * 4096, 64, 0);
    }
}
__device__ __forceinline__ void ph_normrows(const Ctx& c_, int l) { const Ctx c = fresh(c_);
    const float* xin = c.inf(I_X); const bf16_t* xb = c.w<bf16_t>(WS_XB); const bf16_t* y1 = c.w<bf16_t>(WS_Y1);
    const float* gn = c.inf(I_N1G) + l * 1024; const float* mod = c.w<float>(WS_MOD) + (size_t)l * NB * 6144; bf16_t* ha = c.w<bf16_t>(WS_HA);
    for (int row0 = c.blk * 8 + c.wid; row0 < NTOK; row0 += c.G * 16) {
        f32x4 v[2][4]; float ss[2];
#pragma unroll
        for (int q = 0; q < 2; ++q) { const int row = row0 + q * c.G * 8; ss[q] = 0.f;
            if (row < NTOK) {
#pragma unroll
                for (int i = 0; i < 4; ++i) { const int col = i * 256 + c.lane * 4;
                    if (l == 0) v[q][i] = *(const f32x4*)(xin + (size_t)row * 1024 + col);
                    else { const u32x2 xw = *(const u32x2*)(xb + (size_t)row * 1024 + col), y = *(const u32x2*)(y1 + (size_t)row * 1024 + col);
                        v[q][i] = (f32x4){bflo(xw.x), bfhi(xw.x), bflo(xw.y), bfhi(xw.y)} + (f32x4){bflo(y.x), bfhi(y.x), bflo(y.y), bfhi(y.y)}; } } } }
#pragma unroll
        for (int q = 0; q < 2; ++q) { const int row = row0 + q * c.G * 8;
            if (row < NTOK) {
#pragma unroll
                for (int i = 0; i < 4; ++i) {
                    ss[q] += v[q][i][0] * v[q][i][0] + v[q][i][1] * v[q][i][1] + v[q][i][2] * v[q][i][2] + v[q][i][3] * v[q][i][3]; } } }
        ss[0] = wave_sum(ss[0]); ss[1] = wave_sum(ss[1]);
#pragma unroll
        for (int q = 0; q < 2; ++q) { const int row = row0 + q * c.G * 8;
            if (row < NTOK) { const int b = row / SEQ; const float* sh = mod + b * 6144; const float* sc = sh + 1024; const float rinv = frsqrt(ss[q] * (1.0f / 1024.0f) + EPS);
#pragma unroll
                for (int i = 0; i < 4; ++i) { const int col = i * 256 + c.lane * 4; const f32x4 g = *(const f32x4*)(gn + col), s1 = *(const f32x4*)(sc + col), s0 = *(const f32x4*)(sh + col);
                    const f32x4 h = v[q][i] * rinv * g * (s1 + 1.0f) + s0; u32x2 o; o.x = cvt_pk_bf16(h[0], h[1]); o.y = cvt_pk_bf16(h[2], h[3]); *(u32x2*)(ha + (size_t)row * 1024 + col) = o; } } }
    }
}

#define MFMA16(a, b, c) __builtin_amdgcn_mfma_f32_16x16x32_bf16((a), (b), (c), 0, 0, 0)
#define MFMA32(a, b, c) __builtin_amdgcn_mfma_f32_32x32x16_bf16((a), (b), (c), 0, 0, 0)

__device__ __forceinline__ void mix_unit(const Ctx& c_, int l, int r0) { const Ctx c = fresh(c_);
    const bf16_t* Z = c.w<bf16_t>(WS_Z); bf16_t* Aq = (bf16_t*)c.lds; bf16_t* Akv = (bf16_t*)(c.lds + 12800); float* Lkr = (float*)(c.lds + 21504);
    float* Lu = (float*)(c.lds + 25600); bf16_t* Lp = (bf16_t*)(c.lds + 73728); float* Lcu = (float*)(c.lds + 90624); float* Lco = (float*)c.lds;
    const int s0 = r0 % SEQ, b = r0 / SEQ, fr = c.lane & 15, fq = c.lane >> 4;
    {   const int t = c.tid >> 4, sub = c.tid & 15; const bf16_t* zr = Z + (size_t)(r0 + t) * ZP;
        const u32x4 zero4 = {0u, 0u, 0u, 0u};
        const u32x4 ra0 = *(const u32x4*)(zr + Z_CQ + sub * 8), ra1 = (sub < 8) ? *(const u32x4*)(zr + Z_CQ + 128 + sub * 8) : zero4, rk0 = *(const u32x4*)(zr + Z_CKV + sub * 8), rkr = (sub < 4) ? *(const u32x4*)(zr + Z_KR + sub * 8) : zero4;
        u32x4 rp[3], rca[4], rcg[4];
#pragma unroll
        for (int i = 0; i < 3; ++i) { const int ch = c.tid + 512 * i, row = ch >> 5, c8 = ch & 31; rp[i] = (ch < 47 * 32 && s0 - 15 + row >= 0) ? *(const u32x4*)(Z + (size_t)(r0 - 15 + row) * ZP + Z_POOL + c8 * 8) : zero4; }
#pragma unroll
        for (int i = 0; i < 4; ++i) { const int ch = c.tid + 512 * i, row = ch >> 5, c8 = ch & 31; const bool ok = (ch < 62 * 32 && s0 - 30 + row >= 0);
            rca[i] = ok ? *(const u32x4*)(Z + (size_t)(r0 - 30 + row) * ZP + Z_CA + c8 * 8) : zero4; rcg[i] = ok ? *(const u32x4*)(Z + (size_t)(r0 - 30 + row) * ZP + Z_CG + c8 * 8) : zero4; }
        auto un8 = [](const u32x4 v, float (&o)[8]) { o[0] = bflo(v.x); o[1] = bfhi(v.x); o[2] = bflo(v.y); o[3] = bfhi(v.y); o[4] = bflo(v.z); o[5] = bfhi(v.z); o[6] = bflo(v.w); o[7] = bfhi(v.w); };
        const float* qag = c.inf(I_QAG) + l * 192; const float* kvag = c.inf(I_KVAG) + l * 128;
        float a0[8], a1[8], k0[8]; float ssq = 0.f, ssk = 0.f; un8(ra0, a0); un8(ra1, a1); un8(rk0, k0);
#pragma unroll
        for (int j = 0; j < 8; ++j) { ssq += a0[j] * a0[j] + a1[j] * a1[j]; ssk += k0[j] * k0[j]; }
#pragma unroll
        for (int m = 1; m < 16; m <<= 1) { ssq += __shfl_xor(ssq, m); ssk += __shfl_xor(ssk, m); }
        const float rq = frsqrt(ssq * (1.0f / 192.0f) + EPS), rk = frsqrt(ssk * (1.0f / 128.0f) + EPS);
#pragma unroll
        for (int j = 0; j < 8; ++j) a0[j] *= rq * qag[sub * 8 + j];
        *(u32x4*)(Aq + t * 200 + sub * 8) = pk8(a0);
        if (sub < 8) {
#pragma unroll
            for (int j = 0; j < 8; ++j) a1[j] *= rq * qag[128 + sub * 8 + j];
            *(u32x4*)(Aq + t * 200 + 128 + sub * 8) = pk8(a1); }
#pragma unroll
        for (int j = 0; j < 8; ++j) k0[j] *= rk * kvag[sub * 8 + j];
        *(u32x4*)(Akv + t * 136 + sub * 8) = pk8(k0);
        if (sub < 4) { float kr[8]; un8(rkr, kr);
#pragma unroll
            for (int j = 0; j < 8; ++j) Lkr[t * 32 + sub * 8 + j] = kr[j]; }
#pragma unroll
        for (int i = 0; i < 3; ++i) { const int ch = c.tid + 512 * i, row = ch >> 5, c8 = ch & 31; if (ch < 47 * 32) { float v[8]; un8(rp[i], v);
            *(f32x4*)(Lu + row * 256 + c8 * 8) = (f32x4){v[0], v[1], v[2], v[3]}; *(f32x4*)(Lu + row * 256 + c8 * 8 + 4) = (f32x4){v[4], v[5], v[6], v[7]}; } }
#pragma unroll
        for (int i = 0; i < 4; ++i) { const int ch = c.tid + 512 * i, row = ch >> 5, c8 = ch & 31; if (ch < 62 * 32) { float a[8], g[8]; un8(rca[i], a); un8(rcg[i], g);
#pragma unroll
            for (int j = 0; j < 8; ++j) a[j] *= fsigmoid(g[j]);
            *(f32x4*)(Lcu + row * 256 + c8 * 8) = (f32x4){a[0], a[1], a[2], a[3]}; *(f32x4*)(Lcu + row * 256 + c8 * 8 + 4) = (f32x4){a[4], a[5], a[6], a[7]}; } }
    }
    __syncthreads();
    const float* rcos = c.w<float>(WS_ROPE); const float* rsin = rcos + (size_t)NTOK * 16;
    if (c.wid < 4) {
        const int h = c.wid; const bf16_t* W = c.w<bf16_t>(WS_WUQ + (size_t)(l & 1) * WSET) + (size_t)(96 * h) * 192; const float* qg = c.inf(I_QG) + l * 96;
        f32x4 acc[6][2];
#pragma unroll
        for (int nf = 0; nf < 6; ++nf) { acc[nf][0] = (f32x4){0.f, 0.f, 0.f, 0.f}; acc[nf][1] = acc[nf][0]; }
#pragma unroll 3
        for (int ks = 0; ks < 6; ++ks) { bf16x8 af[2];
#pragma unroll
            for (int mf = 0; mf < 2; ++mf) af[mf] = *(const bf16x8*)(Aq + (mf * 16 + fr) * 200 + ks * 32 + fq * 8);
#pragma unroll
            for (int nf = 0; nf < 6; ++nf) { const bf16x8 bfr = *(const bf16x8*)(W + (size_t)(16 * nf + fr) * 192 + ks * 32 + fq * 8);
                acc[nf][0] = MFMA16(bfr, af[0], acc[nf][0]); acc[nf][1] = MFMA16(bfr, af[1], acc[nf][1]); } }
#pragma unroll
        for (int mf = 0; mf < 2; ++mf) { float ss = 0.f;
#pragma unroll
            for (int nf = 0; nf < 6; ++nf)
#pragma unroll
                for (int j = 0; j < 4; ++j) ss += acc[nf][mf][j] * acc[nf][mf][j];
            ss += __shfl_xor(ss, 16); ss += __shfl_xor(ss, 32);
            const float rinv = frsqrt(ss * (1.0f / 96.0f) + EPS) * (0.10206207261596575f * 1.44269504089f);
            const int tok = r0 + mf * 16 + fr; bf16_t* qo = c.w<bf16_t>(WS_Q) + ((size_t)(b * 4 + h) * SEQ + s0 + mf * 16 + fr) * 96;
            float v[6][4];
#pragma unroll
            for (int nf = 0; nf < 6; ++nf)
#pragma unroll
                for (int j = 0; j < 4; ++j) v[nf][j] = acc[nf][mf][j] * rinv * qg[16 * nf + 4 * fq + j];
            const f32x4 cs4 = *(const f32x4*)(rcos + (size_t)tok * 16 + 4 * fq), sn4 = *(const f32x4*)(rsin + (size_t)tok * 16 + 4 * fq);
#pragma unroll
            for (int j = 0; j < 4; ++j) { const float x1 = v[4][j], x2 = v[5][j]; v[4][j] = x1 * cs4[j] - x2 * sn4[j]; v[5][j] = x1 * sn4[j] + x2 * cs4[j]; }
#pragma unroll
            for (int nf = 0; nf < 6; ++nf) { u32x2 o; o.x = cvt_pk_bf16(v[nf][0], v[nf][1]); o.y = cvt_pk_bf16(v[nf][2], v[nf][3]); *(u32x2*)(qo + 16 * nf + 4 * fq) = o; } }
    } else {
        const int h = c.wid - 4; const bf16_t* W = c.w<bf16_t>(WS_WUKV + (size_t)(l & 1) * WSET) + (size_t)(128 * h) * 128; const float* kg = c.inf(I_KG) + l * 96;
        f32x4 ak[4][2], av[4][2];
#pragma unroll
        for (int nf = 0; nf < 4; ++nf) { ak[nf][0] = (f32x4){0.f, 0.f, 0.f, 0.f}; ak[nf][1] = ak[nf][0]; av[nf][0] = ak[nf][0]; av[nf][1] = ak[nf][0]; }
#pragma unroll 2
        for (int ks = 0; ks < 4; ++ks) { bf16x8 af[2];
#pragma unroll
            for (int mf = 0; mf < 2; ++mf) af[mf] = *(const bf16x8*)(Akv + (mf * 16 + fr) * 136 + ks * 32 + fq * 8);
#pragma unroll
            for (int nf = 0; nf < 4; ++nf) { const bf16x8 bk = *(const bf16x8*)(W + (size_t)(16 * nf + fr) * 128 + ks * 32 + fq * 8), bv = *(const bf16x8*)(W + (size_t)(64 + 16 * nf + fr) * 128 + ks * 32 + fq * 8);
                ak[nf][0] = MFMA16(bk, af[0], ak[nf][0]); ak[nf][1] = MFMA16(bk, af[1], ak[nf][1]);
                av[nf][0] = MFMA16(af[0], bv, av[nf][0]); av[nf][1] = MFMA16(af[1], bv, av[nf][1]); } }
#pragma unroll
        for (int mf = 0; mf < 2; ++mf) { const int tl = mf * 16 + fr; float ss = 0.f;
#pragma unroll
            for (int nf = 0; nf < 4; ++nf)
#pragma unroll
                for (int j = 0; j < 4; ++j) ss += ak[nf][mf][j] * ak[nf][mf][j];
#pragma unroll
            for (int j = 0; j < 8; ++j) { const float kr = Lkr[tl * 32 + fq * 8 + j]; ss += kr * kr; }
            ss += __shfl_xor(ss, 16); ss += __shfl_xor(ss, 32);
            const float rinv = frsqrt(ss * (1.0f / 96.0f) + EPS);
            const int tok = r0 + tl; bf16_t* ko = c.w<bf16_t>(WS_K) + ((size_t)(b * 4 + h) * SEQ + s0 + tl) * 96;
#pragma unroll
            for (int nf = 0; nf < 4; ++nf) { u32x2 o; o.x = cvt_pk_bf16(ak[nf][mf][0] * rinv * kg[16 * nf + 4 * fq], ak[nf][mf][1] * rinv * kg[16 * nf + 4 * fq + 1]);
                o.y = cvt_pk_bf16(ak[nf][mf][2] * rinv * kg[16 * nf + 4 * fq + 2], ak[nf][mf][3] * rinv * kg[16 * nf + 4 * fq + 3]); *(u32x2*)(ko + 16 * nf + 4 * fq) = o; }
            const f32x4 cs4 = *(const f32x4*)(rcos + (size_t)tok * 16 + 4 * fq), sn4 = *(const f32x4*)(rsin + (size_t)tok * 16 + 4 * fq);
            float o1[4], o2[4];
#pragma unroll
            for (int j = 0; j < 4; ++j) { const int i = 4 * fq + j; const float x1 = Lkr[tl * 32 + i] * rinv * kg[64 + i], x2 = Lkr[tl * 32 + 16 + i] * rinv * kg[80 + i];
                o1[j] = x1 * cs4[j] - x2 * sn4[j]; o2[j] = x1 * sn4[j] + x2 * cs4[j]; }
            { u32x2 o; o.x = cvt_pk_bf16(o1[0], o1[1]); o.y = cvt_pk_bf16(o1[2], o1[3]); *(u32x2*)(ko + 64 + 4 * fq) = o; o.x = cvt_pk_bf16(o2[0], o2[1]); o.y = cvt_pk_bf16(o2[2], o2[3]); *(u32x2*)(ko + 80 + 4 * fq) = o; }
            bf16_t* vo = c.w<bf16_t>(WS_VT) + (size_t)(b * 4 + h) * 64 * SEQ + s0 + mf * 16 + 4 * fq;
#pragma unroll
            for (int nf = 0; nf < 4; ++nf) { u32x2 o; o.x = cvt_pk_bf16(av[nf][mf][0], av[nf][mf][1]); o.y = cvt_pk_bf16(av[nf][mf][2], av[nf][mf][3]); *(u32x2*)(vo + (size_t)(16 * nf + fr) * SEQ) = o; } }
    }
    { const int t = c.tid >> 4, sub = c.tid & 15, g = sub >> 2, w = 2 << g, s = s0 + t; const float inv = 1.0f / (float)((s + 1 < w) ? (s + 1) : w);
#pragma unroll
        for (int k = 0; k < 2; ++k) { const int col = sub * 16 + k * 8; float sum[8];
#pragma unroll
            for (int j = 0; j < 8; ++j) sum[j] = 0.f;
            for (int d = 0; d < w; ++d) { const float* p = Lu + (t + 15 - d) * 256 + col;
#pragma unroll
                for (int j = 0; j < 8; ++j) sum[j] += p[j]; }
            const float* p0 = Lu + (t + 15) * 256 + col;
#pragma unroll
            for (int j = 0; j < 8; ++j) sum[j] = sum[j] * inv - p0[j];
            *(u32x4*)(Lp + t * 264 + col) = pk8(sum); } }
    float cres[16];
    { const int chn = c.tid & 255, half = c.tid >> 8; const float* dw = c.inf(I_DWW) + (size_t)l * 31 * 256 + chn; const float bias = c.inf(I_DWB)[l * 256 + chn];
        float wv[31];
#pragma unroll
        for (int j = 0; j < 31; ++j) wv[j] = dw[j * 256];
#pragma unroll
        for (int tt = 0; tt < 16; ++tt) cres[tt] = bias;
#pragma unroll
        for (int r = 0; r < 46; ++r) { const float u = Lcu[(half * 16 + r) * 256 + chn];
#pragma unroll
            for (int tt = 0; tt < 16; ++tt) { const int j = r - tt; if (j >= 0 && j < 31) cres[tt] += wv[j] * u; } } }
    __syncthreads();
    { const int g = c.wid >> 1, mf = c.wid & 1; const bf16_t* W = c.w<bf16_t>(WS_WPOOL + (size_t)(l & 1) * WSET) + g * 4096; const float* ps = c.inf(I_PSCALE) + l * 256 + g * 64;
        f32x4 acc[4];
#pragma unroll
        for (int nf = 0; nf < 4; ++nf) acc[nf] = (f32x4){0.f, 0.f, 0.f, 0.f};
#pragma unroll
        for (int ks = 0; ks < 2; ++ks) { const bf16x8 af = *(const bf16x8*)(Lp + (mf * 16 + fr) * 264 + g * 64 + ks * 32 + fq * 8);
#pragma unroll
            for (int nf = 0; nf < 4; ++nf) { const bf16x8 bfr = *(const bf16x8*)(W + (16 * nf + fr) * 64 + ks * 32 + fq * 8); acc[nf] = MFMA16(bfr, af, acc[nf]); } }
        bf16_t* yo = c.w<bf16_t>(WS_YB) + (size_t)(r0 + mf * 16 + fr) * 1024 + 256 + g * 64;
#pragma unroll
        for (int nf = 0; nf < 4; ++nf) { const int d = 16 * nf + 4 * fq; u32x2 o; o.x = cvt_pk_bf16(acc[nf][0] * ps[d], acc[nf][1] * ps[d + 1]); o.y = cvt_pk_bf16(acc[nf][2] * ps[d + 2], acc[nf][3] * ps[d + 3]); *(u32x2*)(yo + d) = o; } }
    { const int chn = c.tid & 255, half = c.tid >> 8;
#pragma unroll
        for (int tt = 0; tt < 16; ++tt) Lco[(half * 16 + tt) * 256 + chn] = cres[tt]; }
    __syncthreads();
    { const float* lg = c.inf(I_LNG) + l * 256 + c.lane * 4; const float* lb = c.inf(I_LNB) + l * 256 + c.lane * 4;
#pragma unroll
        for (int k = 0; k < 4; ++k) { const int t = c.wid * 4 + k; const f32x4 v = *(const f32x4*)(Lco + t * 256 + c.lane * 4);
            const float mean = wave_sum(v[0] + v[1] + v[2] + v[3]) * (1.0f / 256.0f); const f32x4 d = v - mean;
            const float var = wave_sum(d[0] * d[0] + d[1] * d[1] + d[2] * d[2] + d[3] * d[3]) * (1.0f / 256.0f); const float rs = frsqrt(var + EPS);
            float y[4];
#pragma unroll
            for (int j = 0; j < 4; ++j) y[j] = fsilu(d[j] * rs * lg[j] + lb[j]);
            u32x2 o; o.x = cvt_pk_bf16(y[0], y[1]); o.y = cvt_pk_bf16(y[2], y[3]); *(u32x2*)(c.w<bf16_t>(WS_YB) + (size_t)(r0 + t) * 1024 + 768 + c.lane * 4) = o; } }
    __syncthreads();
}

constexpr int CW_W13 = 32 * 16 * 16, CW_W2 = 32 * 8 * 32, CW_IN = 16 * 72, CW_OUT = 16 * 32, CW_UQ = 3 * 12, CW_UKV = 2 * 16, CW_POOL = 4 * 2;
constexpr int CW_TOTAL = 2 * CW_W13 + CW_W2 + CW_IN + CW_OUT + CW_UQ + CW_UKV + CW_POOL;
struct CvtTile { const float* src; bf16_t* dst; int ldn, ldk; };
__device__ __forceinline__ void cvt_decode(const Ctx& c, int l, int t, CvtTile& d) {
    const size_t wso = (size_t)(l & 1) * WSET; int r = t;
    if (r < 2 * CW_W13) { const int which = r / CW_W13; r %= CW_W13; const int e = r >> 8, kt = (r >> 4) & 15, nt = r & 15, n0 = nt * 32;
        d.src = c.inf(which ? I_W3 : I_W1) + ((size_t)l * 32 + e) * 1024 * 512 + (size_t)kt * 64 * 512 + n0; d.ldn = 512; d.ldk = 1024;
        d.dst = c.w<bf16_t>(WS_WUP + wso) + (size_t)e * 1024 * 1024 + (size_t)((n0 >> 7) * 256 + which * 128 + (n0 & 127)) * 1024 + kt * 64; return; } r -= 2 * CW_W13;
    if (r < CW_W2) { const int e = r >> 8, kt = (r >> 5) & 7, nt = r & 31;
        d.src = c.inf(I_W2) + ((size_t)l * 32 + e) * 512 * 1024 + (size_t)kt * 64 * 1024 + nt * 32; d.ldn = 1024; d.ldk = 512;
        d.dst = c.w<bf16_t>(WS_WDN + wso) + (size_t)e * 1024 * 512 + (size_t)(nt * 32) * 512 + kt * 64; return; } r -= CW_W2;
    if (r < CW_IN) { const int kt = r / 72, nt = r % 72; d.src = (nt < 67) ? c.inf(I_WIN) + (size_t)l * 1024 * 2144 + (size_t)kt * 64 * 2144 + nt * 32 : nullptr; d.ldn = 2144; d.ldk = 1024;
        d.dst = c.w<bf16_t>(WS_WIN + wso) + (size_t)(nt * 32) * 1024 + kt * 64; return; } r -= CW_IN;
    if (r < CW_OUT) { const int kt = r >> 5, nt = r & 31; d.src = c.inf(I_WOUT) + (size_t)l * 1024 * 1024 + (size_t)kt * 64 * 1024 + nt * 32; d.ldn = 1024; d.ldk = 1024;
        d.dst = c.w<bf16_t>(WS_WOUT + wso) + (size_t)(nt * 32) * 1024 + kt * 64; return; } r -= CW_OUT;
    if (r < CW_UQ) { const int kt = r / 12, nt = r % 12; d.src = c.inf(I_WUQ) + (size_t)l * 192 * 384 + (size_t)kt * 64 * 384 + nt * 32; d.ldn = 384; d.ldk = 192;
        d.dst = c.w<bf16_t>(WS_WUQ + wso) + (size_t)(nt * 32) * 192 + kt * 64; return; } r -= CW_UQ;
    if (r < CW_UKV) { const int kt = r >> 4, nt = r & 15; d.src = c.inf(I_WUKV) + (size_t)l * 128 * 512 + (size_t)kt * 64 * 512 + nt * 32; d.ldn = 512; d.ldk = 128;
        d.dst = c.w<bf16_t>(WS_WUKV + wso) + (size_t)(nt * 32) * 128 + kt * 64; return; } r -= CW_UKV;
    { const int g = r >> 1, nt = r & 1; d.src = c.inf(I_WPOOL) + ((size_t)l * 4 + g) * 4096 + nt * 32; d.ldn = 64; d.ldk = 64; d.dst = c.w<bf16_t>(WS_WPOOL + wso) + g * 4096 + (size_t)(nt * 32) * 64; }
}
__device__ __forceinline__ void cvt_wave(const Ctx& c, int l, int wrank, int nwaves, float* T) {
    { const float* rgw = c.inf(I_RGW) + (size_t)l * 1024 * 4; const float* rew = c.inf(I_REW) + (size_t)l * 1024 * 32; float* rwt = c.w<float>(WS_RWT + (size_t)(l & 1) * WSET);
        for (int e = wrank * 64 + c.lane; e < 36 * 1024; e += nwaves * 64) { const int g = e >> 10, k = e & 1023; rwt[e] = (g < 4) ? rgw[k * 4 + g] : rew[k * 32 + g - 4]; } }
    f32x4 v[8]; CvtTile cur; cur.src = nullptr; cur.dst = nullptr; cur.ldn = 0; cur.ldk = 0;
    auto issue = [&](const CvtTile& d) {
#pragma unroll
        for (int i = 0; i < 8; ++i) { const int e4 = c.lane + 64 * i, kk = e4 >> 3, n4 = e4 & 7; v[i] = d.src ? *(const f32x4*)(d.src + (size_t)kk * d.ldn + n4 * 4) : (f32x4){0.f, 0.f, 0.f, 0.f}; } };
    int t = wrank;
    if (t < CW_TOTAL) { cvt_decode(c, l, t, cur); issue(cur); }
    while (t < CW_TOTAL) {
#pragma unroll
        for (int i = 0; i < 8; ++i) { const int e4 = c.lane + 64 * i, kk = e4 >> 3, n4 = e4 & 7; float* p = T + kk * 33 + n4 * 4; p[0] = v[i][0]; p[1] = v[i][1]; p[2] = v[i][2]; p[3] = v[i][3]; }
        const int tn = t + nwaves; CvtTile nxt = cur; if (tn < CW_TOTAL) { cvt_decode(c, l, tn, nxt); issue(nxt); }
        __builtin_amdgcn_wave_barrier();
        { const int n = c.lane & 31, kh = c.lane >> 5; bf16_t* drow = cur.dst + (size_t)n * cur.ldk + kh * 32;
#pragma unroll
            for (int q = 0; q < 4; ++q) { float o[8];
#pragma unroll
                for (int j = 0; j < 8; ++j) o[j] = T[(kh * 32 + q * 8 + j) * 33 + n];
                *(u32x4*)(drow + q * 8) = pk8(o); } }
        __builtin_amdgcn_wave_barrier();
        t = tn; cur = nxt;
    }
}

#ifdef EMU
static inline float __builtin_amdgcn_logf(float x) { return log2f(x); }
#endif
constexpr int HGP = 68, HGV = 40;
constexpr int HG_LG = 0, HG_LK = 8704, HG_LQ = 17408, HG_LVT = 26112, HG_LEG = 31232, HG_LGG = 31488, HG_BYTES = 31744;
template <bool OUT> __device__ __forceinline__ void hgrn_mfma(const Ctx& c_, int l, int bu, int cvt_layer = NL) { const Ctx c = fresh(c_);
    if (c.wid < 4) {
        const int cu = bu * 4 + c.wid, bh = cu / NCH, chunk = cu % NCH, b = bh >> 2, h = bh & 3, tok0 = b * SEQ + chunk * 128;
        const bf16_t* Z = c.w<bf16_t>(WS_Z); const float lbd = c.w<float>(WS_LB)[l * 256 + h * 64 + c.lane];
        unsigned char* L = c.lds + c.wid * HG_BYTES; float* Lg = (float*)(L + HG_LG); float* Lk = (float*)(L + HG_LK); float* Lq = (float*)(L + HG_LQ); bf16_t* Lvt = (bf16_t*)(L + HG_LVT); float* LeG = (float*)(L + HG_LEG); float* LG = (float*)(L + HG_LGG);
        const int l31 = c.lane & 31, hi = c.lane >> 5;
        f32x16 S[2][2];
        if (OUT) { const float* s0 = c.w<float>(WS_S0) + (size_t)(bh * NCH + chunk) * 4096;
#pragma unroll
            for (int mf = 0; mf < 2; ++mf)
#pragma unroll
                for (int nf = 0; nf < 2; ++nf)
#pragma unroll
                    for (int r = 0; r < 16; ++r) S[mf][nf][r] = s0[(32 * mf + (r & 3) + 8 * (r >> 2) + 4 * hi) * 64 + 32 * nf + l31]; }
        else {
#pragma unroll
            for (int mf = 0; mf < 2; ++mf)
#pragma unroll
                for (int nf = 0; nf < 2; ++nf)
#pragma unroll
                    for (int r = 0; r < 16; ++r) S[mf][nf][r] = 0.f; }
        float gtot = 0.f; const float og0 = OUT ? c.inf(I_HOG)[l * 64 + l31] : 0.f, og1 = OUT ? c.inf(I_HOG)[l * 64 + 32 + l31] : 0.f;
        u32x4 rf[4], rq[4], rv[4];
        { const bf16_t* zn = Z + (size_t)(tok0 + (c.lane >> 3)) * ZP + h * 64 + (c.lane & 7) * 8;
#pragma unroll
            for (int i = 0; i < 4; ++i) { rf[i] = *(const u32x4*)(zn + (size_t)i * 8 * ZP + Z_HF); rv[i] = *(const u32x4*)(zn + (size_t)i * 8 * ZP + Z_HI); if (OUT) rq[i] = *(const u32x4*)(zn + (size_t)i * 8 * ZP + Z_HQ); else rq[i] = (u32x4){0u, 0u, 0u, 0u}; } }
#pragma unroll 1
        for (int sc = 0; sc < 4; ++sc) { const int tokb = tok0 + sc * 32;
            {
                const int rr = c.lane >> 3, c8 = (c.lane & 7) * 8;
#pragma unroll
                for (int i = 0; i < 4; ++i) { const int tr = i * 8 + rr; float x[8];
                    { const u32x4 v = rf[i]; x[0] = bflo(v.x); x[1] = bfhi(v.x); x[2] = bflo(v.y); x[3] = bfhi(v.y); x[4] = bflo(v.z); x[5] = bfhi(v.z); x[6] = bflo(v.w); x[7] = bfhi(v.w); }
                    *(f32x4*)(Lg + tr * HGP + c8) = (f32x4){x[0], x[1], x[2], x[3]}; *(f32x4*)(Lg + tr * HGP + c8 + 4) = (f32x4){x[4], x[5], x[6], x[7]};
                    if (OUT) { const u32x4 v = rq[i]; x[0] = fsilu(bflo(v.x)); x[1] = fsilu(bfhi(v.x)); x[2] = fsilu(bflo(v.y)); x[3] = fsilu(bfhi(v.y)); x[4] = fsilu(bflo(v.z)); x[5] = fsilu(bfhi(v.z)); x[6] = fsilu(bflo(v.w)); x[7] = fsilu(bfhi(v.w));
                        *(f32x4*)(Lq + tr * HGP + c8) = (f32x4){x[0], x[1], x[2], x[3]}; *(f32x4*)(Lq + tr * HGP + c8 + 4) = (f32x4){x[4], x[5], x[6], x[7]}; }
                    { const u32x4 v = rv[i]; const unsigned w4[4] = {v.x, v.y, v.z, v.w};
#pragma unroll
                        for (int k = 0; k < 4; ++k) { Lvt[(c8 + 2 * k) * HGV + tr] = (bf16_t)(w4[k] & 0xffffu); Lvt[(c8 + 2 * k + 1) * HGV + tr] = (bf16_t)(w4[k] >> 16); } } }
                if (sc < 3) { const bf16_t* zn = Z + (size_t)(tokb + 32 + rr) * ZP + h * 64 + c8;
#pragma unroll
                    for (int i = 0; i < 4; ++i) { rf[i] = *(const u32x4*)(zn + (size_t)i * 8 * ZP + Z_HF); rv[i] = *(const u32x4*)(zn + (size_t)i * 8 * ZP + Z_HI); if (OUT) rq[i] = *(const u32x4*)(zn + (size_t)i * 8 * ZP + Z_HQ); } }
                __builtin_amdgcn_wave_barrier();
                float run = 0.f;
#pragma unroll
                for (int t = 0; t < 32; ++t) { const float f = lbd + (1.0f - lbd) * fsigmoid(Lg[t * HGP + c.lane]); run += __builtin_amdgcn_logf(f); Lg[t * HGP + c.lane] = run; Lk[t * HGP + c.lane] = 1.0f - f; }
                LG[c.lane] = run; LeG[c.lane] = __builtin_amdgcn_exp2f(run); gtot += run;
            }
            __builtin_amdgcn_wave_barrier();
            bf16x8 vt[2][2];
#pragma unroll
            for (int nf = 0; nf < 2; ++nf)
#pragma unroll
                for (int ks = 0; ks < 2; ++ks) vt[nf][ks] = *(const bf16x8*)(Lvt + (32 * nf + l31) * HGV + 16 * ks + 8 * hi);
            f32x16 O[2];
            if (OUT) {
#pragma unroll
                for (int r = 0; r < 16; ++r) { O[0][r] = 0.f; O[1][r] = 0.f; }
                float acc[8];
#pragma unroll
                for (int m = 0; m < 8; ++m) acc[m] = 0.f;
                const int sb = (l31 & 16) + 8 * hi;
#pragma unroll 1
                for (int d4 = 0; d4 < 16; ++d4) { const f32x4 qt = *(const f32x4*)(Lq + l31 * HGP + 4 * d4), gt = *(const f32x4*)(Lg + l31 * HGP + 4 * d4);
#pragma unroll
                    for (int mg = 0; mg < 4; ++mg) {
                        f32x4 k4[2], g4[2];
#pragma unroll
                        for (int j = 0; j < 2; ++j) { const int s = sb + 2 * mg + j; k4[j] = *(const f32x4*)(Lk + s * HGP + 4 * d4); g4[j] = *(const f32x4*)(Lg + s * HGP + 4 * d4); }
                        __builtin_amdgcn_sched_barrier(0);
#pragma unroll
                        for (int j = 0; j < 2; ++j)
#pragma unroll
                            for (int e = 0; e < 4; ++e) acc[mg * 2 + j] += qt[e] * k4[j][e] * __builtin_amdgcn_exp2f(gt[e] - g4[j][e]);
                        __builtin_amdgcn_sched_barrier(0); } }
                bf16x8 af[2], afx;
                { float a8[8];
#pragma unroll
                    for (int j = 0; j < 8; ++j) a8[j] = (sb + j <= l31) ? acc[j] : 0.f;
                    const bf16x8 ad = __builtin_bit_cast(bf16x8, pk8p(a8)), az = (bf16x8){0, 0, 0, 0, 0, 0, 0, 0};
                    af[0] = (l31 < 16) ? ad : az; af[1] = (l31 < 16) ? az : ad; }
                {
                    f32x16 dx;
#pragma unroll
                    for (int r = 0; r < 16; ++r) dx[r] = 0.f;
                    const bool lowr = l31 < 16; const float* Lx = lowr ? Lk : Lq;
#pragma unroll
                    for (int kk = 0; kk < 4; ++kk) { const int d0 = 16 * kk + 8 * hi;
                        const f32x4 xa = *(const f32x4*)(Lx + l31 * HGP + d0), xb = *(const f32x4*)(Lx + l31 * HGP + d0 + 4), ga = *(const f32x4*)(Lg + l31 * HGP + d0), gb = *(const f32x4*)(Lg + l31 * HGP + d0 + 4),
                                    ma = *(const f32x4*)(Lg + 15 * HGP + d0), mb = *(const f32x4*)(Lg + 15 * HGP + d0 + 4);
                        float v8[8];
#pragma unroll
                        for (int j = 0; j < 4; ++j) { const float da = ga[j] - ma[j], db = gb[j] - mb[j];
                            v8[j] = xa[j] * __builtin_amdgcn_exp2f(lowr ? -da : da); v8[4 + j] = xb[j] * __builtin_amdgcn_exp2f(lowr ? -db : db); }
                        const bf16x8 vv = __builtin_bit_cast(bf16x8, pk8p(v8)), zz = (bf16x8){0, 0, 0, 0, 0, 0, 0, 0};
                        dx = MFMA32(lowr ? vv : zz, lowr ? zz : vv, dx); }
                    float x8[8];
#pragma unroll
                    for (int j = 0; j < 8; ++j) x8[j] = dx[j];
                    afx = __builtin_bit_cast(bf16x8, pk8(x8)); }
#pragma unroll
                for (int mf = 0; mf < 2; ++mf)
#pragma unroll
                    for (int s = 0; s < 2; ++s) { const int d0 = 32 * mf + 16 * s + 4 * hi;
                        const f32x4 qa = *(const f32x4*)(Lq + l31 * HGP + d0), qb = *(const f32x4*)(Lq + l31 * HGP + d0 + 8), ga = *(const f32x4*)(Lg + l31 * HGP + d0), gb = *(const f32x4*)(Lg + l31 * HGP + d0 + 8);
                        float q8[8];
#pragma unroll
                        for (int j = 0; j < 4; ++j) { q8[j] = qa[j] * __builtin_amdgcn_exp2f(ga[j]); q8[4 + j] = qb[j] * __builtin_amdgcn_exp2f(gb[j]); }
                        const bf16x8 qf = __builtin_bit_cast(bf16x8, pk8p(q8));
#pragma unroll
                        for (int nf = 0; nf < 2; ++nf) { float s8[8];
#pragma unroll
                            for (int j = 0; j < 8; ++j) s8[j] = S[mf][nf][8 * s + j];
                            O[nf] = MFMA32(qf, __builtin_bit_cast(bf16x8, pk8p(s8)), O[nf]); } }
#pragma unroll
                for (int nf = 0; nf < 2; ++nf) {
#pragma unroll
                    for (int ks = 0; ks < 2; ++ks) O[nf] = MFMA32(af[ks], vt[nf][ks], O[nf]);
                    const s16x4 p0 = *(const s16x4*)(Lvt + (32 * nf + l31) * HGV + 4 * hi), p1 = *(const s16x4*)(Lvt + (32 * nf + l31) * HGV + 8 + 4 * hi);
                    O[nf] = MFMA32(afx, ((bf16x8){p0[0], p0[1], p0[2], p0[3], p1[0], p1[1], p1[2], p1[3]}), O[nf]); }
            }
#pragma unroll
            for (int mf = 0; mf < 2; ++mf) {
#pragma unroll
                for (int q = 0; q < 4; ++q) { const f32x4 e4 = *(const f32x4*)(LeG + 32 * mf + 8 * q + 4 * hi);
#pragma unroll
                    for (int e = 0; e < 4; ++e) { S[mf][0][4 * q + e] *= e4[e]; S[mf][1][4 * q + e] *= e4[e]; } }
                const int d = 32 * mf + l31; const float Gd = LG[d];
#pragma unroll
                for (int ks = 0; ks < 2; ++ks) { float k8[8];
#pragma unroll
                    for (int j = 0; j < 8; ++j) { const int s = 16 * ks + 8 * hi + j; k8[j] = Lk[s * HGP + d] * __builtin_amdgcn_exp2f(Gd - Lg[s * HGP + d]); }
                    const bf16x8 kf = __builtin_bit_cast(bf16x8, pk8p(k8));
                    S[mf][0] = MFMA32(kf, vt[0][ks], S[mf][0]); S[mf][1] = MFMA32(kf, vt[1][ks], S[mf][1]); } }
            if (OUT) {
                {
                    const int rr = c.lane >> 3, c8 = (c.lane & 7) * 8; const bf16_t* zg = Z + (size_t)(tokb + rr) * ZP + Z_HG + h * 64 + c8; u32x2 gv[4];
#pragma unroll
                    for (int hf = 0; hf < 2; ++hf) {
#pragma unroll
                    for (int i = 0; i < 4; ++i) gv[i] = *(const u32x2*)(zg + (size_t)i * 8 * ZP + 4 * hf);
#pragma unroll
                    for (int i = 0; i < 4; ++i) { const u32x2 v = gv[i]; *(f32x4*)(Lq + (i * 8 + rr) * HGP + c8 + 4 * hf) = (f32x4){fsilu(bflo(v.x)), fsilu(bfhi(v.x)), fsilu(bflo(v.y)), fsilu(bfhi(v.y))}; } }
                }
                __builtin_amdgcn_wave_barrier();
#pragma unroll
                for (int r = 0; r < 16; ++r) { const int tl = (r & 3) + 8 * (r >> 2) + 4 * hi; float ss = O[0][r] * O[0][r] + O[1][r] * O[1][r];
                    ss = half_sum(ss, hi);
                    const float rinv = frsqrt(ss * (1.0f / 64.0f) + EPS); const size_t tok = (size_t)(tokb + tl);
                    const float g0 = Lq[tl * HGP + l31], g1 = Lq[tl * HGP + 32 + l31];
                    bf16_t* yo = c.w<bf16_t>(WS_YB) + tok * 1024 + 512 + h * 64;
                    yo[l31] = (bf16_t)f2bf_bits(O[0][r] * rinv * og0 * g0); yo[32 + l31] = (bf16_t)f2bf_bits(O[1][r] * rinv * og1 * g1); } }
            __builtin_amdgcn_wave_barrier();
        }
        if (!OUT) { float* sc = c.w<float>(WS_SC) + (size_t)(bh * NCH + chunk) * 4096;
#pragma unroll
            for (int mf = 0; mf < 2; ++mf)
#pragma unroll
                for (int nf = 0; nf < 2; ++nf)
#pragma unroll
                    for (int r = 0; r < 16; ++r) sc[(32 * mf + (r & 3) + 8 * (r >> 2) + 4 * hi) * 64 + 32 * nf + l31] = S[mf][nf][r];
            c.w<float>(WS_PC)[(size_t)(bh * NCH + chunk) * 64 + c.lane] = __builtin_amdgcn_exp2f(gtot); }
    } else if (OUT && cvt_layer < NL) {
        cvt_wave(c, cvt_layer, bu * 4 + (c.wid - 4), NBH * NCH, (float*)(c.lds + 4 * HG_BYTES + (c.wid - 4) * 8448));
    }
    __syncthreads();
}
__device__ __forceinline__ void hgrn_carry(const Ctx& c_, int l) { const Ctx c = fresh(c_);
    const float* SC = c.w<float>(WS_SC); const float* PC = c.w<float>(WS_PC); float* S0 = c.w<float>(WS_S0);
    for (int e = c.blk * 512 + c.tid; e < NBH * 4096; e += c.G * 512) { const int bh = e >> 12, dv = e & 4095, d = dv >> 6; float s = 0.f;
#pragma unroll 8
        for (int ch = 0; ch < NCH; ++ch) { const size_t o = (size_t)(bh * NCH + ch) * 4096 + dv; S0[o] = s; s = PC[(size_t)(bh * NCH + ch) * 64 + d] * s + SC[o]; } }
    ASMV("s_waitcnt vmcnt(0)" ::: "memory");
    __syncthreads();
    if (c.tid == 0) { __builtin_amdgcn_fence(__ATOMIC_RELEASE, "agent"); ASMV("s_waitcnt vmcnt(0)" ::: "memory");
        (void)__hip_atomic_fetch_add((unsigned*)(c.ws + WS_CTL + CTL_HG) + l * 64, 1u, __ATOMIC_RELAXED, __HIP_MEMORY_SCOPE_AGENT); }
}
__device__ __forceinline__ void hgrn_wait_carry(const Ctx& c, int l) {
    if (c.tid == 0) { unsigned* p = (unsigned*)(c.ws + WS_CTL + CTL_HG) + l * 64; unsigned sp = 0;
        while (__hip_atomic_load(p, __ATOMIC_RELAXED, __HIP_MEMORY_SCOPE_AGENT) < (unsigned)c.G) { __builtin_amdgcn_s_sleep(1); if (++sp > (1u << 22)) break; }
        __builtin_amdgcn_fence(__ATOMIC_ACQUIRE, "agent"); ASMV("s_waitcnt vmcnt(0)" ::: "memory"); }
    __syncthreads();
}
__device__ __forceinline__ void ph_mixers(const Ctx& c, int l) {
    if (c.blk & 1) for (int bu = c.blk; bu < NBH * NCH / 4; bu += c.G) hgrn_mfma<false>(c, l, bu);
    for (int u = c.blk; u < NTOK / 32; u += c.G) mix_unit(c, l, u * 32);
    if (!(c.blk & 1)) for (int bu = c.blk; bu < NBH * NCH / 4; bu += c.G) hgrn_mfma<false>(c, l, bu);
}

template <bool FIXED>
__device__ __forceinline__ void attn_unit(const Ctx& c_, int bh, int qt, float negM) { const Ctx c = fresh(c_);
    const bf16_t* Qg = c.w<bf16_t>(WS_Q) + (size_t)bh * SEQ * 96; const bf16_t* Kg = c.w<bf16_t>(WS_K) + (size_t)bh * SEQ * 96; const bf16_t* Vg = c.w<bf16_t>(WS_VT) + (size_t)bh * 64 * SEQ;
    constexpr int KROW = 104, VROW = 72, KB = 64 * KROW * 2, VB = 64 * VROW * 2;
    const int l31 = c.lane & 31, hi = c.lane >> 5, qrow = qt * 256 + c.wid * 32 + l31;
    bf16x8 qf[6];
#pragma unroll
    for (int ks = 0; ks < 6; ++ks) qf[ks] = *(const bf16x8*)(Qg + (size_t)qrow * 96 + ks * 16 + hi * 8);
    f32x16 o0, o1;
#pragma unroll
    for (int r = 0; r < 16; ++r) { o0[r] = 0.f; o1[r] = 0.f; }
    float mrun = -INFINITY, lsum = 0.f; f32x2 lsum2 = {0.f, 0.f};
    const int nkt = 4 * (qt + 1), mylast = 4 * qt + (c.wid >> 1);
    const int kr0 = c.tid / 12, kc0 = c.tid % 12, kr1 = (c.tid + 512) / 12, kc1 = (c.tid + 512) % 12, vr = c.tid >> 3, vc = c.tid & 7;
    u32x4 sk0, sk1, sv;
    auto gload = [&](int kt) { sk0 = *(const u32x4*)(Kg + (size_t)(kt * 64 + kr0) * 96 + kc0 * 8); if (c.tid < 256) sk1 = *(const u32x4*)(Kg + (size_t)(kt * 64 + kr1) * 96 + kc1 * 8);
                               sv = *(const u32x4*)(Vg + (size_t)vr * SEQ + kt * 64 + vc * 8); };
    auto lstore = [&](int buf) { unsigned char* kb = c.lds + buf * (KB + VB); unsigned char* vb = kb + KB;
                                 *(u32x4*)(kb + (kr0 * KROW + kc0 * 8) * 2) = sk0; if (c.tid < 256) *(u32x4*)(kb + (kr1 * KROW + kc1 * 8) * 2) = sk1; *(u32x4*)(vb + (vr * VROW + vc * 8) * 2) = sv; };
    gload(0); lstore(0); __syncthreads();
    auto tile = [&](const int kt, auto masked) {
            const bf16_t* kb = (const bf16_t*)(c.lds + (kt & 1) * (KB + VB)); const bf16_t* vb = (const bf16_t*)(c.lds + (kt & 1) * (KB + VB) + KB);
            f32x16 s0, s1;
#pragma unroll
            for (int r = 0; r < 16; ++r) { s0[r] = FIXED ? negM : 0.f; s1[r] = FIXED ? negM : 0.f; }
#pragma unroll
            for (int ks = 0; ks < 6; ++ks) { const bf16x8 k0 = *(const bf16x8*)(kb + l31 * KROW + ks * 16 + hi * 8), k1 = *(const bf16x8*)(kb + (32 + l31) * KROW + ks * 16 + hi * 8);
                s0 = MFMA32(k0, qf[ks], s0); s1 = MFMA32(k1, qf[ks], s1); }
            if constexpr (decltype(masked)::value) {
#pragma unroll
                for (int r = 0; r < 16; ++r) { const int key = kt * 64 + (r & 3) + 8 * (r >> 2) + 4 * hi; if (key > qrow) s0[r] = -INFINITY; if (key + 32 > qrow) s1[r] = -INFINITY; } }
            if constexpr (FIXED) {
#pragma unroll
                for (int r = 0; r < 16; ++r) { s0[r] = __builtin_amdgcn_exp2f(s0[r]); s1[r] = __builtin_amdgcn_exp2f(s1[r]); }
#pragma unroll
                for (int r = 0; r < 16; r += 2) { lsum2 += (f32x2){s0[r], s0[r + 1]}; lsum2 += (f32x2){s1[r], s1[r + 1]}; }
            } else {
            float mx = s0[0];
#pragma unroll
            for (int r = 1; r < 16; ++r) mx = fmaxf(mx, s0[r]);
#pragma unroll
            for (int r = 0; r < 16; ++r) mx = fmaxf(mx, s1[r]);
            mx = fmaxf(mx, __shfl_xor(mx, 32));
            const float mnew = fmaxf(mrun, mx), alpha = __builtin_amdgcn_exp2f(mrun - mnew); mrun = mnew;
            float ps = 0.f;
#pragma unroll
            for (int r = 0; r < 16; ++r) { s0[r] = __builtin_amdgcn_exp2f(s0[r] - mnew); s1[r] = __builtin_amdgcn_exp2f(s1[r] - mnew); ps += s0[r] + s1[r]; }
            lsum = lsum * alpha + ps;
#pragma unroll
            for (int r = 0; r < 16; ++r) { o0[r] *= alpha; o1[r] *= alpha; }
            }
#pragma unroll
            for (int kf = 0; kf < 2; ++kf)
#pragma unroll
                for (int s = 0; s < 2; ++s) { const f32x16& sx = kf ? s1 : s0; u32x4 pw; pw.x = cvt_pk_bf16(sx[8 * s], sx[8 * s + 1]); pw.y = cvt_pk_bf16(sx[8 * s + 2], sx[8 * s + 3]); pw.z = cvt_pk_bf16(sx[8 * s + 4], sx[8 * s + 5]); pw.w = cvt_pk_bf16(sx[8 * s + 6], sx[8 * s + 7]);
                    const bf16x8 pf = __builtin_bit_cast(bf16x8, pw); const int kcol = kf * 32 + 16 * s + 4 * hi;
                    const s16x4 a0 = *(const s16x4*)(vb + l31 * VROW + kcol), a1 = *(const s16x4*)(vb + l31 * VROW + kcol + 8), b0 = *(const s16x4*)(vb + (32 + l31) * VROW + kcol), b1 = *(const s16x4*)(vb + (32 + l31) * VROW + kcol + 8);
                    const bf16x8 v0 = (bf16x8){a0[0], a0[1], a0[2], a0[3], a1[0], a1[1], a1[2], a1[3]}, v1 = (bf16x8){b0[0], b0[1], b0[2], b0[3], b1[0], b1[1], b1[2], b1[3]};
                    o0 = MFMA32(v0, pf, o0); o1 = MFMA32(v1, pf, o1); }
            };
    int kt = 0;
    for (; kt < mylast; ++kt) { gload(kt + 1); tile(kt, std::false_type{}); lstore((kt + 1) & 1); __syncthreads(); }
    { if (kt + 1 < nkt) gload(kt + 1); tile(kt, std::true_type{}); if (kt + 1 < nkt) lstore((kt + 1) & 1); __syncthreads(); ++kt; }
    for (; kt < nkt; ++kt) { if (kt + 1 < nkt) { gload(kt + 1); lstore((kt + 1) & 1); } __syncthreads(); }
    if constexpr (FIXED) lsum = lsum2[0] + lsum2[1];
    lsum += __shfl_xor(lsum, 32); const float rl = 1.0f / lsum;
    const int b = bh >> 2, h = bh & 3; bf16_t* yo = c.w<bf16_t>(WS_YB) + (size_t)(b * SEQ + qrow) * 1024 + h * 64;
#pragma unroll
    for (int g = 0; g < 4; ++g) { const int dv = 8 * g + 4 * hi; u32x2 w0, w1;
        w0.x = cvt_pk_bf16(o0[4 * g] * rl, o0[4 * g + 1] * rl); w0.y = cvt_pk_bf16(o0[4 * g + 2] * rl, o0[4 * g + 3] * rl); *(u32x2*)(yo + dv) = w0;
        w1.x = cvt_pk_bf16(o1[4 * g] * rl, o1[4 * g + 1] * rl); w1.y = cvt_pk_bf16(o1[4 * g + 2] * rl, o1[4 * g + 3] * rl); *(u32x2*)(yo + 32 + dv) = w1; }
    __syncthreads();
}
template <bool FIXED>
__device__ __forceinline__ void attn_units(const Ctx& c, float negM) {
    { const int NU = NBH * (NQT / 2);
      if ((c.G & 7) == 0) { const int per = (NU + 7) / 8, x = c.blk & 7, G8 = c.G >> 3;
          for (int j = c.blk >> 3; j < per; j += G8) { const int pu = x * per + j; if (pu < NU) { const int bh = pu / (NQT / 2), p = pu % (NQT / 2); attn_unit<FIXED>(c, bh, NQT - 1 - p, negM); attn_unit<FIXED>(c, bh, p, negM); } } }
      else for (int pu = c.blk; pu < NU; pu += c.G) { const int bh = pu / (NQT / 2), p = pu % (NQT / 2); attn_unit<FIXED>(c, bh, NQT - 1 - p, negM); attn_unit<FIXED>(c, bh, p, negM); } }
}
__device__ __forceinline__ void ph_attn(const Ctx& c, int l) {
    hgrn_carry(c, l);
    {
        const float* qg = c.inf(I_QG) + l * 96; const float* kg = c.inf(I_KG) + l * 96;
        int ln = c.lane; LAUNDER_V(ln);
        float gq = fmaxf(fabsf(qg[ln]), fabsf(qg[32 + (ln & 63)])), gk = fmaxf(fabsf(kg[ln]), fabsf(kg[32 + (ln & 63)]));
#pragma unroll
        for (int o = 1; o < 64; o <<= 1) { gq = fmaxf(gq, __shfl_xor(gq, o)); gk = fmaxf(gk, __shfl_xor(gk, o)); }
        const float M = 9.797958971132712f * 1.44269504089f * 1.02f * gq * gk;
        if (M <= 60.0f) attn_units<true>(c, -M); else attn_units<false>(c, 0.f); }
    hgrn_wait_carry(c, l);
    for (int bu = c.blk; bu < NBH * NCH / 4; bu += c.G) hgrn_mfma<true>(c, l, bu, l + 1);
}

__device__ __forceinline__ void ph_router(const Ctx& c_, int l, int cnt_off = 0) { const Ctx c = fresh(c_);
    bf16_t* Whi = (bf16_t*)c.lds; bf16_t* Wlo = (bf16_t*)(c.lds + 73728); float* Llog = (float*)(c.lds + 147456) + c.wid * 288; float* Lcb = (float*)(c.lds + 156672);
    int* Le = (int*)(c.lds + 156672 + 256); float* Lw = (float*)(c.lds + 156672 + 256 + 1024); int* Lr = (int*)(c.lds + 156672 + 256 + 2048); int* Lcnt = (int*)(c.lds + 156672 + 256 + 3072); int* Lbase = Lcnt + 32;
    const float* rwt = c.w<float>(WS_RWT + (size_t)(l & 1) * WSET);
    const float* rgb = c.inf(I_RGB) + l * 4; const float* reb = c.inf(I_REB) + l * 32;
    const bf16_t* x = c.w<bf16_t>(WS_XB); const float* gn = c.inf(I_N2G) + l * 1024; const float* mod = c.w<float>(WS_MOD) + (size_t)l * NB * 6144; bf16_t* ha = c.w<bf16_t>(WS_HA);
    unsigned* cnt = (unsigned*)(c.ws + WS_CTL + CTL_CNT) + l * 32 + cnt_off;
    int* asge = c.w<int>(WS_ASGE); int* asgr = c.w<int>(WS_ASGR); float* asgw = c.w<float>(WS_ASGW);
    const int fr = c.lane & 15, fq = c.lane >> 4;
    int staged_b = -1;
    for (int u = c.blk; u < NTOK / 128; u += c.G) {
        const int b = (u * 128) / SEQ; const float* sh = mod + b * 6144 + 3072; const float* sc = sh + 1024;
        __syncthreads();
        if (b != staged_b) { staged_b = b;
            for (int q = c.tid; q < 36 * 128; q += 512) { const int n = q >> 7, ch = q & 127, k0 = ch * 8; float hi8[8], lo8[8];
#pragma unroll
                for (int j = 0; j < 8; ++j) { const float w = rwt[n * 1024 + k0 + j] * gn[k0 + j] * (1.0f + sc[k0 + j]); const float h = bf2f((bf16_t)f2bf_bits(w)); hi8[j] = h; lo8[j] = w - h; }
                const int pc = (ch ^ (n & 15)) * 8; *(u32x4*)(Whi + n * 1024 + pc) = pk8(hi8); *(u32x4*)(Wlo + n * 1024 + pc) = pk8(lo8); }
            for (int g = c.wid; g < 36; g += 8) { float s = 0.f;
#pragma unroll
                for (int i = 0; i < 4; ++i) { const f32x4 w = *(const f32x4*)(rwt + g * 1024 + i * 256 + c.lane * 4), s4 = *(const f32x4*)(sh + i * 256 + c.lane * 4); s += w[0] * s4[0] + w[1] * s4[1] + w[2] * s4[2] + w[3] * s4[3]; }
                s = wave_sum(s); if (c.lane == 0) Lcb[g] = s + (g < 4 ? rgb[g] : reb[g - 4]); } }
        if (c.tid < 32) Lcnt[c.tid] = 0;
        __syncthreads();
        const int rowb = u * 128 + c.wid * 16; const bf16_t* xr = x + (size_t)(rowb + fr) * 1024 + 8 * fq;
        f32x4 acc[3] = {{0.f, 0.f, 0.f, 0.f}, {0.f, 0.f, 0.f, 0.f}, {0.f, 0.f, 0.f, 0.f}}; float ssp = 0.f;
#pragma unroll 4
        for (int ks = 0; ks < 32; ++ks) { const u32x4 hw = *(const u32x4*)(xr + 32 * ks);
            const unsigned hws[4] = {hw.x, hw.y, hw.z, hw.w};
#pragma unroll
            for (int j = 0; j < 4; ++j) { const float a = bflo(hws[j]), b = bfhi(hws[j]); ssp += a * a + b * b; }
            const bf16x8 ah = __builtin_bit_cast(bf16x8, hw);
            const int ch = 4 * ks + fq;
#pragma unroll
            for (int nf = 0; nf < 3; ++nf) { const int n = 16 * nf + fr; bf16x8 bh = {0, 0, 0, 0, 0, 0, 0, 0}, bl = bh;
                if (nf < 2 || fr < 4) { const int pc = (ch ^ (n & 15)) * 8; bh = *(const bf16x8*)(Whi + n * 1024 + pc); bl = *(const bf16x8*)(Wlo + n * 1024 + pc); }
                acc[nf] = MFMA16(ah, bh, acc[nf]); acc[nf] = MFMA16(ah, bl, acc[nf]); } }
        ssp += __shfl_xor(ssp, 16); ssp += __shfl_xor(ssp, 32);
        const float rinv = frsqrt(ssp * (1.0f / 1024.0f) + EPS);
        float rj[4];
#pragma unroll
        for (int j = 0; j < 4; ++j) rj[j] = __shfl(rinv, fq * 4 + j);
#pragma unroll
        for (int half = 0; half < 2; ++half) {
            if ((fq >> 1) == half) {
#pragma unroll
                for (int nf = 0; nf < 3; ++nf) { const int col = 16 * nf + fr; if (col < 36) {
#pragma unroll
                    for (int j = 0; j < 4; ++j) Llog[((fq & 1) * 4 + j) * 36 + col] = acc[nf][j] * rj[j] + Lcb[col]; } } }
            __builtin_amdgcn_wave_barrier();
            if (c.lane < 8) { const float* lg = Llog + c.lane * 36; const int rl = c.wid * 16 + half * 8 + c.lane;
                int gi = 0; float gm = lg[0];
#pragma unroll
                for (int g = 1; g < 4; ++g) { const float t = lg[g]; if (t > gm) { gm = t; gi = g; } }
                float den = 0.f;
#pragma unroll
                for (int g = 0; g < 4; ++g) den += expf(lg[g] - gm);
                const float gw = 1.0f / den;
                float e1 = -INFINITY, e2 = -INFINITY; int i1 = 0, i2 = 0;
#pragma unroll
                for (int j = 0; j < 8; ++j) { const float t = lg[4 + gi * 8 + j]; if (t > e1) { e2 = e1; i2 = i1; e1 = t; i1 = j; } else if (t > e2) { e2 = t; i2 = j; } }
                const float p2 = expf(e2 - e1), w1 = gw / (1.0f + p2), w2 = gw * p2 / (1.0f + p2);
                const int ea = gi * 8 + i1, eb = gi * 8 + i2; Le[rl * 2] = ea; Le[rl * 2 + 1] = eb; Lw[rl * 2] = w1; Lw[rl * 2 + 1] = w2;
                Lr[rl * 2] = atomicAdd(&Lcnt[ea], 1); Lr[rl * 2 + 1] = atomicAdd(&Lcnt[eb], 1); }
            __builtin_amdgcn_wave_barrier();
        }
#pragma unroll 4
        for (int ks = 0; ks < 32; ++ks) { const int k0 = 32 * ks + 8 * fq; const u32x4 xw = *(const u32x4*)(xr + 32 * ks); const f32x4 xa = {bflo(xw.x), bfhi(xw.x), bflo(xw.y), bfhi(xw.y)}, xb = {bflo(xw.z), bfhi(xw.z), bflo(xw.w), bfhi(xw.w)};
            const f32x4 ga = *(const f32x4*)(gn + k0) * (*(const f32x4*)(sc + k0) + 1.0f), gb = *(const f32x4*)(gn + k0 + 4) * (*(const f32x4*)(sc + k0 + 4) + 1.0f);
            const f32x4 ha4 = xa * rinv * ga + *(const f32x4*)(sh + k0), hb4 = xb * rinv * gb + *(const f32x4*)(sh + k0 + 4);
            u32x4 o; o.x = cvt_pk_bf16(ha4[0], ha4[1]); o.y = cvt_pk_bf16(ha4[2], ha4[3]); o.z = cvt_pk_bf16(hb4[0], hb4[1]); o.w = cvt_pk_bf16(hb4[2], hb4[3]);
            *(u32x4*)(ha + (size_t)(rowb + fr) * 1024 + k0) = o; }
        __syncthreads();
        if (c.tid < 32) Lbase[c.tid] = (int)__hip_atomic_fetch_add(&cnt[c.tid], (unsigned)Lcnt[c.tid], __ATOMIC_RELAXED, __HIP_MEMORY_SCOPE_AGENT);
        __syncthreads();
        if (c.tid < 256) { const int a = u * 256 + c.tid, e = Le[c.tid]; asge[a] = e; asgr[a] = Lbase[e] + Lr[c.tid]; asgw[a] = Lw[c.tid]; }
    }
    __syncthreads();
}
__device__ __forceinline__ void ph_gather(const Ctx& c_, int l) { const Ctx c = fresh(c_);
    int* Lps = (int*)c.lds; int* Lcn = Lps + 40;
    unsigned* cnt = (unsigned*)(c.ws + WS_CTL + CTL_CNT) + l * 32;
    if (c.tid < 32) Lcn[c.tid] = (int)__hip_atomic_load(&cnt[c.tid], __ATOMIC_RELAXED, __HIP_MEMORY_SCOPE_AGENT);
    __syncthreads();
    if (c.tid == 0) { int acc = 0; for (int e = 0; e < 32; ++e) { Lps[e] = acc; acc += (Lcn[e] + 255) / 256 * 256; } Lps[32] = acc; }
    __syncthreads();
    int* rowtok = c.w<int>(WS_ROWTOK); float* roww = c.w<float>(WS_ROWW);
    if (c.blk == 0) { int* tile = c.w<int>(WS_TILE); if (c.tid == 0) tile[0] = Lps[32] / 256;
        for (int e = c.tid; e < 32; e += 512) for (int t = Lps[e] / 256; t < Lps[e + 1] / 256; ++t) tile[1 + t] = e; }
    for (int e = c.blk; e < 32; e += c.G) for (int r = Lps[e] + Lcn[e] + c.tid; r < Lps[e + 1]; r += 512) rowtok[r] = -1;
    const int* asge = c.w<int>(WS_ASGE); const int* asgr = c.w<int>(WS_ASGR); const float* asgw = c.w<float>(WS_ASGW);
    for (int a = c.blk * 512 + c.tid; a < NTOK * 2; a += c.G * 512) { const int dest = Lps[asge[a]] + asgr[a]; rowtok[dest] = a; roww[dest] = asgw[a]; }
}
__device__ __forceinline__ void ph_final(const Ctx& c_) { const Ctx c = fresh(c_);
    float* out = c.a->out; const bf16_t* y1 = c.w<bf16_t>(WS_Y1);
    const bf16_t* xb = c.w<bf16_t>(WS_XB);
    for (size_t e = (size_t)c.blk * 512 + c.tid; e < (size_t)NTOK * 128; e += (size_t)c.G * 512) { const u32x4 y = *(const u32x4*)(y1 + e * 8), xw = *(const u32x4*)(xb + e * 8);
        *(f32x4*)(out + e * 8) = (f32x4){bflo(xw.x), bfhi(xw.x), bflo(xw.y), bfhi(xw.y)} + (f32x4){bflo(y.x), bfhi(y.x), bflo(y.y), bfhi(y.y)};
        *(f32x4*)(out + e * 8 + 4) = (f32x4){bflo(xw.z), bfhi(xw.z), bflo(xw.w), bfhi(xw.w)} + (f32x4){bflo(y.z), bfhi(y.z), bflo(y.w), bfhi(y.w)}; }
}

constexpr int PH_PER_LAYER = 9, N_PHASES = 2 + PH_PER_LAYER * NL + 1;
__global__ void __launch_bounds__(512, 2) mk_fwd(Args args) {
#ifdef EMU
    unsigned char* lds = emu_lds();
#else
    extern __shared__ __attribute__((aligned(16))) unsigned char lds[];
#endif
    Ctx c; c.a = &args; c.ws = args.ws; c.lds = lds; c.tid = threadIdx.x; c.wid = __builtin_amdgcn_readfirstlane(c.tid >> 6); c.lane = c.tid & 63; c.G = gridDim.x; c.blk = blockIdx.x;
    if (c.tid == 0) *(uint4*)(lds + LDS_XB) = make_uint4(0u, 0u, 0u, 0u);
    __syncthreads();
    XcdBarrier bar; bar.bar = (unsigned*)(args.ws + WS_CTL); bar.x = 0; bar.st = (volatile LAS unsigned*)(lds + LDS_XB);
    if (args.ph_hi - args.ph_lo > 1) bar = xcd_barrier_post((unsigned*)(args.ws + WS_CTL), (volatile LAS unsigned*)(lds + LDS_XB));
    int ph = 0;
#ifndef PHMASK
#define PHMASK 0xFFFFF
#endif
#define PHASE(K, ...) do { if (ph >= args.ph_lo && ph < args.ph_hi) { if constexpr ((PHMASK >> K) & 1) { __VA_ARGS__; } if (ph + 1 < args.ph_hi) xcd_barrier(bar); } ++ph; } while (0)
    PHASE(0, ph_prologue0(c));
    PHASE(1, ph_prologue1(c));
    for (int l = 0; l < NL; ++l) {
        PHASE(2, if (l == 0) ph_cvt(c, 0); ph_normrows(c, l));
        PHASE(3, { pg8::Gemm g{c.w<bf16_t>(WS_HA), c.w<bf16_t>(WS_WIN + (size_t)(l & 1) * WSET), NTOK, ZP, 1024}; pg8::TailNarrowOrder S; S.init(NTOK, c.G, c.blk); pg8::EpiBf16 E{c.w<bf16_t>(WS_Z), ZP};
                pg8::gemm_phase<pg8::EpiBf16, pg8::TailNarrowOrder, true, true>((LAS unsigned char*)lds, g, S, E); });
        PHASE(4, ph_mixers(c, l));
        PHASE(5, ph_attn(c, l));
        PHASE(6, { pg8::Gemm g{c.w<bf16_t>(WS_YB), c.w<bf16_t>(WS_WOUT + (size_t)(l & 1) * WSET), NTOK, 1024, 1024}; pg8::StaticOrder S; S.init(NTOK, 1024, c.G, c.blk);
                pg8::EpiResid E{(l == 0) ? c.inf(I_X) : (const float*)nullptr, c.w<bf16_t>(WS_XB), c.w<bf16_t>(WS_XB), c.w<float>(WS_MOD) + (size_t)l * NB * 6144 + 2048, 6144, SEQ, c.w<bf16_t>(WS_Y1)};
                pg8::gemm_phase<pg8::EpiResid, pg8::StaticOrder, true, true>((LAS unsigned char*)lds, g, S, E); });
        PHASE(7, ph_router(c, l));
        PHASE(8, ph_gather(c, l));
        PHASE(9, { pg8::Gemm g{c.w<bf16_t>(WS_HA), c.w<bf16_t>(WS_WUP + (size_t)(l & 1) * WSET), NR, 32 * 1024, 1024}; pg8::MoeOrder S{c.w<int>(WS_TILE), c.G, c.blk}; pg8::EpiSwiglu E{c.w<bf16_t>(WS_Q)};
                pg8::gemm_phase<pg8::EpiSwiglu, pg8::MoeOrder, true, true, true>((LAS unsigned char*)lds, g, S, E, c.w<int>(WS_ROWTOK)); });
        PHASE(10, { pg8::Gemm g{c.w<bf16_t>(WS_Q), c.w<bf16_t>(WS_WDN + (size_t)(l & 1) * WSET), NR, 32 * 1024, 512}; pg8::MoeOrder S{c.w<int>(WS_TILE), c.G, c.blk};
                pg8::EpiDown E{c.w<int>(WS_ROWTOK), c.w<float>(WS_ROWW), c.w<bf16_t>(WS_XB), c.w<bf16_t>(WS_Y1), c.w<float>(WS_MOD) + (size_t)l * NB * 6144 + 5120, 6144, SEQ};
                pg8::gemm_phase<pg8::EpiDown, pg8::MoeOrder, true, true>((LAS unsigned char*)lds, g, S, E); });
    }
    PHASE(11, ph_final(c));
#undef PHASE
}

extern "C" void kernel_launch(void* const* d_in, const int* in_sizes, int n_in, void* d_out, int out_size, void* d_ws, size_t ws_size, hipStream_t stream) {
    static int grid = 0;
    if (grid == 0) {
        if (n_in != 30 || out_size != NTOK * 1024 || ws_size < WS_END) { fprintf(stderr, "kernel_launch: shape/workspace mismatch (n_in %d out %d ws %zu need %zu)\n", n_in, out_size, ws_size, (size_t)WS_END); grid = -1; return; }
        int dev = 0, cus = 0;
        if (hipGetDevice(&dev) != hipSuccess || hipDeviceGetAttribute(&cus, hipDeviceAttributeMultiprocessorCount, dev) != hipSuccess) { grid = -1; return; }
        if (hipFuncSetAttribute((const void*)mk_fwd, hipFuncAttributeMaxDynamicSharedMemorySize, LDS_BYTES) != hipSuccess) { fprintf(stderr, "kernel_launch: hipFuncSetAttribute failed\n"); grid = -1; return; }
        int per_cu = 0; (void)hipOccupancyMaxActiveBlocksPerMultiprocessor(&per_cu, (const void*)mk_fwd, 512, LDS_BYTES);
        if (per_cu < 1) fprintf(stderr, "kernel_launch: occupancy query says %d blocks per CU\n", per_cu);
        grid = cus;
    }
    if (grid < 0) return;
    (void)hipMemsetAsync((char*)d_ws + WS_CTL, 0, CTL_BYTES, stream);
    Args a{};
    for (int i = 0; i < 30; ++i) a.in[i] = d_in[i];
    a.out = (float*)d_out; a.ws = (unsigned char*)d_ws;
#if MK_SPLIT
    for (int p = 0; p < N_PHASES; ++p) { a.ph_lo = p; a.ph_hi = p + 1;
#else
    { a.ph_lo = 0; a.ph_hi = N_PHASES;
#endif
#ifdef EMU
        EMU_LAUNCH(mk_fwd, grid, 512, LDS_BYTES, stream, a);
#else
        hipLaunchKernelGGL(mk_fwd, dim3(grid), dim3(512), LDS_BYTES, stream, a);
#endif
    }
}
```

```cpp
#include <hip/hip_runtime.h>
#include <cstdio>
#include <cstdint>
#include <type_traits>

#ifndef CFG_B
#define CFG_B 4
#endif
#ifndef CFG_S
#define CFG_S 8192
#endif
#ifndef CFG_L
#define CFG_L 4
#endif
#ifndef MK_SPLIT
#define MK_SPLIT 0
#endif

#ifdef EMU
#define ASMV(...) ((void)0)
#define LAS
#define LAUNDER_V(x) ((void)0)
#define LAUNDER_S(x) ((void)0)
#else
#define ASMV(...) asm volatile(__VA_ARGS__)
#define LAS __attribute__((address_space(3)))
#define LAUNDER_V(x) asm volatile("" : "+v"(x))
#define LAUNDER_S(x) asm volatile("" : "+s"(x))
#endif

typedef unsigned short bf16_t;
typedef short bf16x8 __attribute__((ext_vector_type(8)));
typedef short s16x4 __attribute__((ext_vector_type(4)));
typedef float f32x2 __attribute__((ext_vector_type(2)));
typedef float f32x4 __attribute__((ext_vector_type(4)));
typedef float f32x16 __attribute__((ext_vector_type(16)));
typedef unsigned u32x4 __attribute__((ext_vector_type(4)));
typedef unsigned u32x2 __attribute__((ext_vector_type(2)));

__device__ __forceinline__ float bf2f(bf16_t h) { return __builtin_bit_cast(float, (unsigned)h << 16); }
__device__ __forceinline__ float bflo(unsigned w) { return __builtin_bit_cast(float, w << 16); }
__device__ __forceinline__ float bfhi(unsigned w) { return __builtin_bit_cast(float, w & 0xffff0000u); }
__device__ __forceinline__ unsigned f2bf_bits(float f) { unsigned u = __builtin_bit_cast(unsigned, f); u += 0x7fffu + ((u >> 16) & 1u); return u >> 16; }
#ifdef EMU
__device__ __forceinline__ unsigned cvt_pk_bf16(float lo, float hi) { return f2bf_bits(lo) | (f2bf_bits(hi) << 16); }
__device__ __forceinline__ unsigned cvt_pk_bf16_pinned(float lo, float hi) { return f2bf_bits(lo) | (f2bf_bits(hi) << 16); }
#else
typedef __bf16 bf16v2_t __attribute__((ext_vector_type(2)));
typedef float f32v2_t __attribute__((ext_vector_type(2)));
__device__ __forceinline__ unsigned cvt_pk_bf16(float lo, float hi) { const bf16v2_t r = __builtin_convertvector((f32v2_t){lo, hi}, bf16v2_t); return __builtin_bit_cast(unsigned, r); }
__device__ __forceinline__ unsigned cvt_pk_bf16_pinned(float lo, float hi) { unsigned r; asm volatile("v_cvt_pk_bf16_f32 %0, %1, %2\n\ts_nop 1" : "=v"(r) : "v"(lo), "v"(hi)); return r; }
#endif
__device__ __forceinline__ float fast_exp(float x) { return __builtin_amdgcn_exp2f(x * 1.44269504089f); }
__device__ __forceinline__ float fsigmoid(float x) { return __builtin_amdgcn_rcpf(1.0f + fast_exp(-x)); }
__device__ __forceinline__ float fsilu(float x) { return x * fsigmoid(x); }
__device__ __forceinline__ float frsqrt(float x) { return __builtin_amdgcn_rsqf(x); }
#ifdef EMU
__device__ __forceinline__ float wave_sum(float v) {
#pragma unroll
    for (int m = 32; m >= 1; m >>= 1) v += __shfl_xor(v, m);
    return v;
}
#else
template <int CTRL, int ROW_MASK> __device__ __forceinline__ float dpp_t(float v) { return __builtin_bit_cast(float, __builtin_amdgcn_update_dpp(0, __builtin_bit_cast(int, v), CTRL, ROW_MASK, 0xF, false)); }
#define dpp_f(v, ctrl, rm) dpp_t<ctrl, rm>(v)
__device__ __forceinline__ float wave_sum(float v) {
    v += dpp_f(v, 0xB1, 0xF);
    v += dpp_f(v, 0x4E, 0xF);
    v += dpp_f(v, 0x141, 0xF);
    v += dpp_f(v, 0x140, 0xF);
    v += dpp_f(v, 0x142, 0xA);
    v += dpp_f(v, 0x143, 0xC);
    return __builtin_bit_cast(float, __builtin_amdgcn_readlane(__builtin_bit_cast(int, v), 63));
}
__device__ __forceinline__ float half_sum(float v, int hi) {
    v += dpp_f(v, 0xB1, 0xF); v += dpp_f(v, 0x4E, 0xF); v += dpp_f(v, 0x141, 0xF); v += dpp_f(v, 0x140, 0xF);
    v += dpp_f(v, 0x142, 0xA);
    const float a = __builtin_bit_cast(float, __builtin_amdgcn_readlane(__builtin_bit_cast(int, v), 31)), b = __builtin_bit_cast(float, __builtin_amdgcn_readlane(__builtin_bit_cast(int, v), 63));
    return hi ? b : a;
}
#endif
#ifdef EMU
__device__ __forceinline__ float half_sum(float v, int) {
#pragma unroll
    for (int m = 1; m < 32; m <<= 1) v += __shfl_xor(v, m);
    return v;
}
#endif

namespace pg8 {
#define PG8_LAS LAS
constexpr int BM = 256, BK = 64, HALF = 128, HTB = HALF * BK * 2  , STAGE_BYTES = 8 * HTB, NXCD = 8, WGM = 8;

__host__ __device__ __forceinline__ int lds_byte(int r, int c) { const int st = (r >> 4) * 2 + (c >> 5), rr = r & 15, cc = c & 31, ob = rr * 64 + cc * 2; return st * 1024 + (ob ^ (((ob >> 9) & 1) << 5)); }
__host__ __device__ __forceinline__ void stage_rc(int b, int& R, int& C) { const int st = b / 1024, sb = b % 1024, swz = sb ^ (((sb >> 9) & 1) << 5); R = (st >> 1) * 16 + swz / 64; C = (st & 1) * 32 + (swz % 64) / 2; }
__host__ __device__ __forceinline__ int perm32(int rho) { const int n = rho >> 4, i = rho & 15; return 8 * (i >> 2) + 4 * n + (i & 3); }

struct Unit { int pm, pn, narrow; };
struct Gemm { const bf16_t* A; const bf16_t* Bt; int M, N, K; };

struct StaticOrder {
    static constexpr bool HAS_NARROW = false;
    int nM, nN, nwg, G, c;
    __host__ __device__ void init(int M, int N, int G_, int c_) { nM = M / BM; nN = N / BM; nwg = nM * nN; G = G_; c = c_; }
    __host__ __device__ bool next(int i, Unit& u) const {
        const long L = (long)i * G + c; if (L >= nwg) return false;
        int wgid = (int)L; { const int q = nwg / NXCD, r = nwg % NXCD, xcd = wgid % NXCD, off = wgid / NXCD; wgid = (xcd < r ? xcd * (q + 1) : r * (q + 1) + (xcd - r) * q) + off; }
        const int nig = WGM * nN, gid = wgid / nig, fm = gid * WGM, gsz = (nM - fm) < WGM ? (nM - fm) : WGM;
        u.pm = fm + ((wgid % nig) % gsz); u.pn = (wgid % nig) / gsz; return true;
    }
    __device__ __forceinline__ void a_ready(const Unit&) const {}
    __device__ __forceinline__ void done(const Unit&) const {}
};
struct TailNarrowOrder {
    static constexpr bool HAS_NARROW = true;
    StaticOrder full; int nM, G, c;
    __host__ __device__ void init(int M, int G_, int c_) { nM = M / BM; G = G_; c = c_; full.init(M, 8 * BM, G_, c_); }
    __host__ __device__ bool next(int i, Unit& u) const { const long L = (long)i * G + c;
        if (L < full.nwg) { const bool ok = full.next(i, u); u.narrow = 0; return ok; }
        if (L >= full.nwg + nM) return false;
        u.pm = (int)(L - full.nwg); u.pn = 8; u.narrow = 1; return true; }
    __device__ __forceinline__ void a_ready(const Unit&) const {}
    __device__ __forceinline__ void done(const Unit&) const {}
};
template <class Epi, class Sched, bool ALIGN_EPI = false, bool SP2 = false, bool GATHER = false>
__device__ __forceinline__ void gemm_phase(PG8_LAS unsigned char* lds, const Gemm g, const Sched& S, const Epi& E, const int* rowmap = nullptr) {
    int tid = threadIdx.x; LAUNDER_V(tid); const int wid = __builtin_amdgcn_readfirstlane(tid >> 6), lane = tid & 63, wr = wid >> 2, wc = wid & 3, fr = lane & 15, fq = lane >> 4;
    const int K = g.K, nt = K / BK;
    unsigned voffA[2], voffB[2]; int RA[2], CA[2];
#pragma unroll
    for (int i = 0; i < 2; ++i) { int R, C; stage_rc(tid * 16 + i * 8192, R, C); const int Rb = Epi::PERM ? ((R & ~31) + perm32(R & 31)) : R;
        voffA[i] = (unsigned)(R * K + C) * 2u; voffB[i] = (unsigned)(Rb * K + C) * 2u; RA[i] = R; CA[i] = C; }
    const size_t kstep = (size_t)(BK * 2);
    const size_t hstep = (size_t)HALF * K * 2;
    const size_t tstep = 2 * hstep;
    const size_t hA = GATHER ? (size_t)0 : hstep;
    unsigned vA0[2], vA1[2], nA0[2], nA1[2];
    auto rows_of = [&](const Unit& u, unsigned (&o0)[2], unsigned (&o1)[2]) {
#pragma unroll
        for (int i = 0; i < 2; ++i) { if constexpr (GATHER) { int t0 = rowmap[u.pm * BM + RA[i]], t1 = rowmap[u.pm * BM + HALF + RA[i]]; t0 = t0 < 0 ? 0 : (t0 >> 1); t1 = t1 < 0 ? 0 : (t1 >> 1);
                o0[i] = (unsigned)(t0 * K + CA[i]) * 2u; o1[i] = (unsigned)(t1 * K + CA[i]) * 2u; } else { o0[i] = voffA[i]; o1[i] = voffA[i]; } } };
    const unsigned ldsw = (unsigned)wid * 1024u;
    const int aoff = lds_byte(wr * 64 + fr, fq * 8), boff = lds_byte(wc * 32 + fr, fq * 8);
#define PG8_SA(b, h) (((b) * 2 + (h)) * HTB)
#define PG8_SB(b, h) ((4 + (b) * 2 + (h)) * HTB)
#define PG8_STAGE(bufoff, gbase, voff) do { _Pragma("unroll") for (int _i = 0; _i < 2; ++_i) \
        __builtin_amdgcn_global_load_lds((const unsigned*)((const char*)(gbase) + (voff)[_i]), (PG8_LAS unsigned*)(lds + (bufoff) + ldsw + _i * 8192), 16, 0, 0); } while (0)
#define PG8_LDA(dst, b, h) do { _Pragma("unroll") for (int m = 0; m < 4; ++m) _Pragma("unroll") for (int k = 0; k < 2; ++k) dst[m][k] = *(const PG8_LAS bf16x8*)(lds + PG8_SA(b, h) + aoff + m * 2048 + k * 1024); } while (0)
#define PG8_LDB(dst, b, h) do { _Pragma("unroll") for (int n = 0; n < 2; ++n) _Pragma("unroll") for (int k = 0; k < 2; ++k) dst[n][k] = *(const PG8_LAS bf16x8*)(lds + PG8_SB(b, h) + boff + n * 2048 + k * 1024); } while (0)
#define PG8_MMA(ai, bj, At, Bt) do { __builtin_amdgcn_s_setprio(1); _Pragma("unroll") for (int m = 0; m < 4; ++m) _Pragma("unroll") for (int n = 0; n < 2; ++n) _Pragma("unroll") for (int k = 0; k < 2; ++k) \
        acc[ai][bj][m][n] = __builtin_amdgcn_mfma_f32_16x16x32_bf16(Bt[n][k], At[m][k], acc[ai][bj][m][n], 0, 0, 0); __builtin_amdgcn_s_setprio(0); } while (0)
#define PG8_WAIT_V(n) ASMV("s_waitcnt vmcnt(" #n ")" ::: "memory")
#define PG8_WAIT_L(n) ASMV("s_waitcnt lgkmcnt(" #n ")" ::: "memory")
#define PG8_BAR __builtin_amdgcn_s_barrier()
#define PG8_SCHED __builtin_amdgcn_sched_barrier(0)
    Unit cur, nxt; int ui = 0;
    if (!S.next(0, cur)) return;
    f32x4 acc[2][2][4][2];
#pragma unroll
    for (int a = 0; a < 2; ++a)
#pragma unroll
        for (int b = 0; b < 2; ++b)
#pragma unroll
            for (int m = 0; m < 4; ++m)
#pragma unroll
                for (int n = 0; n < 2; ++n) acc[a][b][m][n] = (f32x4){0.f, 0.f, 0.f, 0.f};
    bf16x8 At[4][2], B0[2][2], B1[2][2];
    const char* cA = GATHER ? (const char*)g.A : (const char*)g.A + (size_t)cur.pm * tstep; rows_of(cur, vA0, vA1); const char* cB = (const char*)g.Bt + (size_t)cur.pn * tstep;
    S.a_ready(cur);
    if constexpr (SP2) {
        PG8_STAGE(PG8_SB(0, 0), cB, voffB); PG8_STAGE(PG8_SB(0, 1), cB + hstep, voffB); PG8_STAGE(PG8_SA(0, 0), cA, vA0); PG8_STAGE(PG8_SA(0, 1), cA + hA, vA1);
        if (wr == 1) PG8_BAR;
        PG8_WAIT_V(2); PG8_BAR;
        PG8_STAGE(PG8_SB(1, 0), cB + kstep, voffB); PG8_STAGE(PG8_SA(1, 0), cA + kstep, vA0); PG8_STAGE(PG8_SB(1, 1), cB + hstep + kstep, voffB);
        PG8_WAIT_V(6); PG8_BAR;
    } else {
        PG8_STAGE(PG8_SB(0, 0), cB, voffB); PG8_STAGE(PG8_SA(0, 0), cA, vA0); PG8_STAGE(PG8_SB(0, 1), cB + hstep, voffB); PG8_STAGE(PG8_SA(0, 1), cA + hA, vA1);
        if (wr == 1) PG8_BAR;
        PG8_WAIT_V(4); PG8_BAR;
        PG8_STAGE(PG8_SB(1, 0), cB + kstep, voffB); PG8_STAGE(PG8_SA(1, 0), cA + kstep, vA0); PG8_STAGE(PG8_SB(1, 1), cB + hstep + kstep, voffB);
        PG8_WAIT_V(6); PG8_BAR;
    }
    for (;;) {
        const bool has_next = S.next(ui + 1, nxt);
        const char* nA = GATHER ? (const char*)g.A : (has_next ? (const char*)g.A + (size_t)nxt.pm * tstep : cA);
        if (has_next) rows_of(nxt, nA0, nA1); else { nA0[0] = vA0[0]; nA0[1] = vA0[1]; nA1[0] = vA1[0]; nA1[1] = vA1[1]; } const char* nB = has_next ? (const char*)g.Bt + (size_t)nxt.pn * tstep : cB;
        for (int t = 0; t < nt; t += 2) {
            const bool last = (t == nt - 2);
            unsigned sA0[2], sA1[2];
#pragma unroll
            for (int i = 0; i < 2; ++i) { sA0[i] = last ? nA0[i] : vA0[i]; sA1[i] = last ? nA1[i] : vA1[i]; }
            const char* a1 = cA + (size_t)(t + 1) * kstep;
            const char* a2 = last ? nA : cA + (size_t)(t + 2) * kstep; const char* b2 = last ? nB : cB + (size_t)(t + 2) * kstep;
            const char* a3 = a2 + kstep; const char* b3 = b2 + kstep;
            if (last && has_next) S.a_ready(nxt);
            if constexpr (SP2) {
            PG8_LDB(B0, 0, 0); PG8_LDB(B1, 0, 1); PG8_SCHED; PG8_LDA(At, 0, 0); PG8_STAGE(PG8_SA(1, 1), a1 + hA, vA1);
            PG8_WAIT_V(8); PG8_WAIT_L(0); PG8_BAR; PG8_MMA(0, 0, At, B0); if (!Sched::HAS_NARROW || !cur.narrow) PG8_MMA(0, 1, At, B1); PG8_BAR; PG8_SCHED;
            PG8_LDA(At, 0, 1); PG8_STAGE(PG8_SB(0, 0), b2, voffB); PG8_STAGE(PG8_SB(0, 1), b2 + hstep, voffB); PG8_STAGE(PG8_SA(0, 0), a2, sA0);
            PG8_WAIT_V(8); PG8_WAIT_L(0); PG8_BAR; PG8_MMA(1, 0, At, B0); if (!Sched::HAS_NARROW || !cur.narrow) PG8_MMA(1, 1, At, B1); PG8_BAR; PG8_SCHED;
            PG8_LDB(B0, 1, 0); PG8_LDB(B1, 1, 1); PG8_SCHED; PG8_LDA(At, 1, 0); PG8_STAGE(PG8_SA(0, 1), a2 + hA, sA1);
            PG8_WAIT_V(8); PG8_WAIT_L(0); PG8_BAR; PG8_MMA(0, 0, At, B0); if (!Sched::HAS_NARROW || !cur.narrow) PG8_MMA(0, 1, At, B1); PG8_BAR; PG8_SCHED;
            PG8_LDA(At, 1, 1); PG8_STAGE(PG8_SB(1, 0), b3, voffB); PG8_STAGE(PG8_SB(1, 1), b3 + hstep, voffB); PG8_STAGE(PG8_SA(1, 0), a3, sA0);
            PG8_WAIT_V(8); PG8_WAIT_L(0); PG8_BAR; PG8_MMA(1, 0, At, B0); if (!Sched::HAS_NARROW || !cur.narrow) PG8_MMA(1, 1, At, B1); PG8_BAR; PG8_SCHED;
            } else {
            PG8_LDB(B0, 0, 0); PG8_SCHED; PG8_LDA(At, 0, 0); PG8_STAGE(PG8_SA(1, 1), a1 + hA, vA1);
            PG8_WAIT_L(8); PG8_BAR; PG8_WAIT_L(0); PG8_MMA(0, 0, At, B0); PG8_BAR; PG8_SCHED;
            PG8_LDB(B1, 0, 1); PG8_STAGE(PG8_SB(0, 0), b2, voffB);
            PG8_BAR; PG8_WAIT_L(0); if (!Sched::HAS_NARROW || !cur.narrow) PG8_MMA(0, 1, At, B1); PG8_BAR;
            PG8_LDA(At, 0, 1); PG8_STAGE(PG8_SA(0, 0), a2, sA0);
            PG8_BAR; PG8_WAIT_L(0); PG8_MMA(1, 0, At, B0); PG8_BAR; PG8_SCHED;
            PG8_STAGE(PG8_SB(0, 1), b2 + hstep, voffB);
            PG8_WAIT_V(6); PG8_BAR; if (!Sched::HAS_NARROW || !cur.narrow) PG8_MMA(1, 1, At, B1); PG8_BAR;
            PG8_LDB(B0, 1, 0); PG8_SCHED; PG8_LDA(At, 1, 0); PG8_STAGE(PG8_SA(0, 1), a2 + hA, sA1);
            PG8_WAIT_L(8); PG8_BAR; PG8_WAIT_L(0); PG8_MMA(0, 0, At, B0); PG8_BAR; PG8_SCHED;
            PG8_LDB(B1, 1, 1); PG8_STAGE(PG8_SB(1, 0), b3, voffB);
            PG8_BAR; PG8_WAIT_L(0); if (!Sched::HAS_NARROW || !cur.narrow) PG8_MMA(0, 1, At, B1); PG8_BAR;
            PG8_LDA(At, 1, 1); PG8_STAGE(PG8_SA(1, 0), a3, sA0);
            PG8_BAR; PG8_WAIT_L(0); PG8_MMA(1, 0, At, B0); PG8_BAR; PG8_SCHED;
            PG8_STAGE(PG8_SB(1, 1), b3 + hstep, voffB);
            PG8_WAIT_V(6); PG8_BAR; if (!Sched::HAS_NARROW || !cur.narrow) PG8_MMA(1, 1, At, B1); PG8_BAR;
            }
        }
        if constexpr (ALIGN_EPI) { if (wr == 0) PG8_BAR; }
        if constexpr (!Epi::AFTER_DRAIN) { E(acc, cur, wr, wc, fr, fq); S.done(cur); }
        if (!has_next) break;
#pragma unroll
        for (int a = 0; a < 2; ++a)
#pragma unroll
            for (int b = 0; b < 2; ++b)
#pragma unroll
                for (int m = 0; m < 4; ++m)
#pragma unroll
                    for (int n = 0; n < 2; ++n) acc[a][b][m][n] = (f32x4){0.f, 0.f, 0.f, 0.f};
        cur = nxt; cA = nA; cB = nB; ++ui; vA0[0] = nA0[0]; vA0[1] = nA0[1]; vA1[0] = nA1[0]; vA1[1] = nA1[1];
        if constexpr (ALIGN_EPI) { if (wr == 1) PG8_BAR; }
    }
    PG8_WAIT_V(0);
    if constexpr (!ALIGN_EPI) { if (wr == 0) PG8_BAR; }
    PG8_BAR;
    if constexpr (Epi::AFTER_DRAIN) { E.fused(acc, cur, wr, wc, fr, fq, lds, wid, lane); S.done(cur); }
#undef PG8_SA
#undef PG8_SB
#undef PG8_STAGE
#undef PG8_LDA
#undef PG8_LDB
#undef PG8_MMA
#undef PG8_WAIT_V
#undef PG8_WAIT_L
#undef PG8_BAR
#undef PG8_SCHED
}

struct EpiBf16 {
    static constexpr bool PERM = true, AFTER_DRAIN = false;
    bf16_t* O; int ldc;
    __device__ __forceinline__ void operator()(const f32x4 (&acc)[2][2][4][2], const Unit& u, int wr, int wc, int fr, int fq) const {
        const int row0 = u.pm * BM + wr * 64 + fr, col0 = u.pn * BM + wc * 32 + 8 * fq;
#pragma unroll
        for (int ai = 0; ai < 2; ++ai)
#pragma unroll
            for (int m = 0; m < 4; ++m) { bf16_t* rowp = O + (size_t)(row0 + ai * HALF + m * 16) * ldc + col0;
#pragma unroll
                for (int bj = 0; bj < 2; ++bj) { const f32x4 v0 = acc[ai][bj][m][0], v1 = acc[ai][bj][m][1];
                    u32x4 w; w.x = cvt_pk_bf16(v0[0], v0[1]); w.y = cvt_pk_bf16(v0[2], v0[3]); w.z = cvt_pk_bf16(v1[0], v1[1]); w.w = cvt_pk_bf16(v1[2], v1[3]);
                    *(u32x4*)(rowp + bj * HALF) = w; } }
    }
};
struct EpiResid {
    static constexpr bool PERM = true, AFTER_DRAIN = false;
    const float* xin; const bf16_t* xinb; bf16_t* xout; const float* gate; int gstride; int seq; const bf16_t* y1;
    __device__ __forceinline__ void operator()(const f32x4 (&acc)[2][2][4][2], const Unit& u, int wr, int wc, int fr, int fq) const {
        const int row0 = u.pm * BM + wr * 64 + fr, col0 = u.pn * BM + wc * 32 + 8 * fq;
#pragma unroll
        for (int ai = 0; ai < 2; ++ai)
#pragma unroll
            for (int m = 0; m < 4; ++m) { const int row = row0 + ai * HALF + m * 16; const float* gp = gate + (size_t)(row / seq) * gstride;
#pragma unroll
                for (int bj = 0; bj < 2; ++bj) { const int c = col0 + bj * HALF; const size_t o = (size_t)row * 1024 + c;
                    const f32x4 g0 = *(const f32x4*)(gp + c), g1 = *(const f32x4*)(gp + c + 4);
                    f32x4 x0, x1;
                    if (xin) { x0 = *(const f32x4*)(xin + o); x1 = *(const f32x4*)(xin + o + 4); }
                    else { const u32x4 xw = *(const u32x4*)(xinb + o), y = *(const u32x4*)(y1 + o);
                        x0 = (f32x4){bflo(xw.x), bfhi(xw.x), bflo(xw.y), bfhi(xw.y)} + (f32x4){bflo(y.x), bfhi(y.x), bflo(y.y), bfhi(y.y)};
                        x1 = (f32x4){bflo(xw.z), bfhi(xw.z), bflo(xw.w), bfhi(xw.w)} + (f32x4){bflo(y.z), bfhi(y.z), bflo(y.w), bfhi(y.w)}; }
                    x0 += g0 * acc[ai][bj][m][0]; x1 += g1 * acc[ai][bj][m][1];
                    u32x4 w; w.x = cvt_pk_bf16(x0[0], x0[1]); w.y = cvt_pk_bf16(x0[2], x0[3]); w.z = cvt_pk_bf16(x1[0], x1[1]); w.w = cvt_pk_bf16(x1[2], x1[3]);
                    *(u32x4*)(xout + o) = w; } }
    }
};
struct EpiSwiglu {
    static constexpr bool PERM = true, AFTER_DRAIN = false;
    bf16_t* HB;
    __device__ __forceinline__ void operator()(const f32x4 (&acc)[2][2][4][2], const Unit& u, int wr, int wc, int fr, int fq) const {
        const int row0 = u.pm * BM + wr * 64 + fr, col0 = (u.pn & 3) * 128 + wc * 32 + 8 * fq;
#pragma unroll
        for (int ai = 0; ai < 2; ++ai)
#pragma unroll
            for (int m = 0; m < 4; ++m) { bf16_t* p = HB + (size_t)(row0 + ai * HALF + m * 16) * 512 + col0;
                float h[8];
#pragma unroll
                for (int n = 0; n < 2; ++n)
#pragma unroll
                    for (int k = 0; k < 4; ++k) h[n * 4 + k] = fsilu(acc[ai][0][m][n][k]) * acc[ai][1][m][n][k];
                u32x4 w; w.x = cvt_pk_bf16(h[0], h[1]); w.y = cvt_pk_bf16(h[2], h[3]); w.z = cvt_pk_bf16(h[4], h[5]); w.w = cvt_pk_bf16(h[6], h[7]);
                *(u32x4*)p = w; }
    }
};
struct EpiDown {
    static constexpr bool PERM = true, AFTER_DRAIN = false;
    const int* row_tok; const float* row_w; bf16_t* x; bf16_t* y1; const float* gate; int gstride; int seq;
    __device__ __forceinline__ void operator()(const f32x4 (&acc)[2][2][4][2], const Unit& u, int wr, int wc, int fr, int fq) const {
        const int row0 = u.pm * BM + wr * 64 + fr, col0 = (u.pn & 3) * BM + wc * 32 + 8 * fq;
#pragma unroll
        for (int ai = 0; ai < 2; ++ai)
#pragma unroll
            for (int m = 0; m < 4; ++m) { const int row = row0 + ai * HALF + m * 16; const int ts = row_tok[row];
                if (ts >= 0) { const int tok = ts >> 1; const float w = row_w[row]; const float* gp = gate + (size_t)(tok / seq) * gstride;
#pragma unroll
                    for (int bj = 0; bj < 2; ++bj) { const int c = col0 + bj * HALF; const size_t o = (size_t)tok * 1024 + c;
                        const f32x4 v0 = acc[ai][bj][m][0] * (*(const f32x4*)(gp + c)) * w, v1 = acc[ai][bj][m][1] * (*(const f32x4*)(gp + c + 4)) * w;
                        if (ts & 1) { u32x4 q; q.x = cvt_pk_bf16(v0[0], v0[1]); q.y = cvt_pk_bf16(v0[2], v0[3]); q.z = cvt_pk_bf16(v1[0], v1[1]); q.w = cvt_pk_bf16(v1[2], v1[3]); *(u32x4*)(y1 + o) = q; }
                        else { const u32x4 xw = *(const u32x4*)(x + o); const f32x4 s0 = (f32x4){bflo(xw.x), bfhi(xw.x), bflo(xw.y), bfhi(xw.y)} + v0, s1 = (f32x4){bflo(xw.z), bfhi(xw.z), bflo(xw.w), bfhi(xw.w)} + v1;
                            u32x4 q; q.x = cvt_pk_bf16(s0[0], s0[1]); q.y = cvt_pk_bf16(s0[2], s0[3]); q.z = cvt_pk_bf16(s1[0], s1[1]); q.w = cvt_pk_bf16(s1[2], s1[3]); *(u32x4*)(x + o) = q; } } } }
    }
};
struct MoeOrder {
    static constexpr bool HAS_NARROW = false;
    const int* tile; int G, c;
    __device__ __forceinline__ bool next(int i, Unit& u) const { const int v = ((G & 7) == 0) ? (c & 7) * (G >> 3) + (c >> 3) : c; const int L = i * G + v, nt = tile[0]; if (L >= nt * 4) return false; u.pm = L >> 2; u.pn = tile[1 + (L >> 2)] * 4 + (L & 3); return true; }
    __device__ __forceinline__ void a_ready(const Unit&) const {}
    __device__ __forceinline__ void done(const Unit&) const {}
};
}

constexpr int NB = CFG_B, SEQ = CFG_S, NL = CFG_L, NTOK = NB * SEQ, DM = 1024, ZP = 2304;
constexpr int NBH = NB * 4, NCH = SEQ / 128, NQT = SEQ / 256;
constexpr int NR = 2 * NTOK + 32 * 256;
constexpr int Z_CQ = 0, Z_CKV = 192, Z_KR = 320, Z_POOL = 352, Z_HQ = 608, Z_HF = 864, Z_HI = 1120, Z_HG = 1376, Z_CA = 1632, Z_CG = 1888;
constexpr float EPS = 1e-6f;
static_assert(SEQ % 256 == 0 && NTOK % 256 == 0 && (NQT % 2) == 0, "shape");
constexpr size_t al256(size_t x) { return (x + 255) & ~(size_t)255; }
constexpr size_t cmax(size_t a, size_t b) { return a > b ? a : b; }
constexpr size_t WS_CTL = 0, CTL_BYTES = 65536;
constexpr size_t CTL_CNT = 16384;
constexpr size_t CTL_HG = 32768;
constexpr size_t WS_MODP = WS_CTL + CTL_BYTES;
constexpr size_t WS_MOD = WS_MODP + al256((size_t)16 * NL * NB * 6144 * 4);
constexpr size_t WS_LB = WS_MOD + al256((size_t)NL * NB * 6144 * 4);
constexpr size_t WS_ROPE = WS_LB + al256((size_t)NL * 256 * 4);
constexpr size_t WS_WIN = WS_ROPE + al256((size_t)NTOK * 32 * 4);
constexpr size_t WS_WOUT = WS_WIN + (size_t)ZP * 1024 * 2;
constexpr size_t WS_WUQ = WS_WOUT + (size_t)1024 * 1024 * 2;
constexpr size_t WS_WUKV = WS_WUQ + al256((size_t)384 * 192 * 2);
constexpr size_t WS_WPOOL = WS_WUKV + al256((size_t)512 * 128 * 2);
constexpr size_t WS_WUP = WS_WPOOL + al256((size_t)4 * 64 * 64 * 2);
constexpr size_t WS_WDN = WS_WUP + (size_t)32 * 1024 * 1024 * 2;
constexpr size_t WS_RWT = WS_WDN + (size_t)32 * 1024 * 512 * 2;
constexpr size_t WSET = WS_RWT + 36 * 1024 * 4 - WS_WIN;
constexpr size_t WS_HA = WS_WIN + 2 * WSET;
constexpr size_t WS_Z = WS_HA + (size_t)NTOK * 1024 * 2;
constexpr size_t Z_BYTES = cmax((size_t)NTOK * ZP * 2, (size_t)NR * 1024 * 2);
constexpr size_t WS_Q = WS_Z + Z_BYTES;
constexpr size_t WS_K = WS_Q + (size_t)NTOK * 4 * 96 * 2;
constexpr size_t WS_VT = WS_K + (size_t)NTOK * 4 * 96 * 2;
constexpr size_t WS_YB = WS_VT + (size_t)NTOK * 4 * 64 * 2;
constexpr size_t R2_BYTES = cmax(WS_YB + (size_t)NTOK * 1024 * 2 - WS_Q, (size_t)NR * 512 * 2);
constexpr size_t WS_Y1 = WS_Q + R2_BYTES;
constexpr size_t WS_SC = WS_Y1 + (size_t)NTOK * 1024 * 2;
constexpr size_t WS_PC = WS_SC + (size_t)NBH * NCH * 4096 * 4;
constexpr size_t WS_S0 = WS_PC + al256((size_t)NBH * NCH * 64 * 4);
constexpr size_t WS_ASGE = WS_S0 + (size_t)NBH * NCH * 4096 * 4;
constexpr size_t WS_ASGR = WS_ASGE + (size_t)NTOK * 8;
constexpr size_t WS_ASGW = WS_ASGR + (size_t)NTOK * 8;
constexpr size_t WS_ROWTOK = WS_ASGW + (size_t)NTOK * 8;
constexpr size_t WS_ROWW = WS_ROWTOK + al256((size_t)NR * 4);
constexpr size_t WS_TILE = WS_ROWW + al256((size_t)NR * 4);
constexpr size_t WS_XB = WS_TILE + al256((size_t)(NR / 256 + 16) * 4);
constexpr size_t WS_END = WS_XB + (size_t)NTOK * 1024 * 2;
constexpr int LDS_BYTES = 160 * 1024;
constexpr int LDS_XB = LDS_BYTES - 16;

#define XB_TMO      128
#define XB_XCNT(j)  (256  + 64 * (j))
#define XB_XSUB(j)  (1280 + 64 * (j))
#define XB_XGEN(j)  (2304 + 64 * (j))
#define XB_TOP      3328
#define XB_TOPGEN   3392
#define XCD_BAR_WORDS 3456
#define XB_SPIN_CAP (1u << 18)
__device__ __forceinline__ unsigned xb_ld(unsigned* p)              { return __hip_atomic_load(p, __ATOMIC_RELAXED, __HIP_MEMORY_SCOPE_AGENT); }
__device__ __forceinline__ unsigned xb_add(unsigned* p, unsigned v) { return __hip_atomic_fetch_add(p, v, __ATOMIC_RELAXED, __HIP_MEMORY_SCOPE_AGENT); }
__device__ __forceinline__ unsigned xb_xcc_id() { return (unsigned)__builtin_amdgcn_s_getreg((3 << 11) | 20) & 0xFu; }
#define XB_SPIN(cond, bar) do { unsigned _sp = 0; while (cond) { __builtin_amdgcn_s_sleep(1); \
    if ((++_sp & 255u) == 0u) { if (xb_ld(&(bar)[XB_TMO])) break; if (_sp > XB_SPIN_CAP) { atomicAdd(&(bar)[XB_TMO], 1u); break; } } } } while (0)
struct XcdBarrier { unsigned* bar; unsigned x; volatile LAS unsigned* st; };
__device__ __forceinline__ XcdBarrier xcd_barrier_post(unsigned* bar, volatile LAS unsigned* st) {
    XcdBarrier b; b.bar = bar; b.x = xb_xcc_id(); b.st = st;
    if (threadIdx.x == 0) (void)xb_add(&bar[XB_XCNT(b.x)], 1u);
    return b;
}
__device__ __forceinline__ void xcd_barrier_complete(unsigned* bar, unsigned x, unsigned& nloc, unsigned& nx) {
    const unsigned G = gridDim.x * gridDim.y * gridDim.z;
    unsigned sum, cnt, mine, sp = 0u;
    for (;;) {
        sum = 0u; cnt = 0u; mine = 0u;
#pragma unroll
        for (unsigned j = 0; j < 16; ++j) { const unsigned c = xb_ld(&bar[XB_XCNT(j)]); sum += c; cnt += (c > 0u) ? 1u : 0u; mine = (j == x) ? c : mine; }
        if (sum == G) break;
        __builtin_amdgcn_s_sleep(1);
        if ((++sp & 255u) == 0u) { if (xb_ld(&bar[XB_TMO])) break; if (sp > XB_SPIN_CAP) { atomicAdd(&bar[XB_TMO], 1u); break; } }
    }
    nloc = mine > 0u ? mine : 1u; nx = cnt > 0u ? cnt : 1u;
}
__device__ __forceinline__ void xcd_barrier(const XcdBarrier& b) {
    ASMV("s_waitcnt vmcnt(0)" ::: "memory");
    __syncthreads();
    if (threadIdx.x == 0) {
        unsigned* bar = b.bar;
        __builtin_amdgcn_s_waitcnt(0);
        unsigned nloc = b.st[0], nx = b.st[1];
        if (nloc == 0u) { xcd_barrier_complete(bar, b.x, nloc, nx); b.st[0] = nloc; b.st[1] = nx; }
        const unsigned old = xb_add(&bar[XB_XSUB(b.x)], 1u);
        const unsigned gen = old / nloc;
        if (old + 1u == (gen + 1u) * nloc) {
            __builtin_amdgcn_fence(__ATOMIC_RELEASE, "agent");
            ASMV("s_waitcnt vmcnt(0)" ::: "memory");
            const unsigned og = xb_add(&bar[XB_TOP], 1u);
            const unsigned tg = og / nx;
            if (og + 1u == (tg + 1u) * nx) xb_add(&bar[XB_TOPGEN], 1u);
            else XB_SPIN(xb_ld(&bar[XB_TOPGEN]) == tg, bar);
            __builtin_amdgcn_fence(__ATOMIC_ACQUIRE, "agent");
            xb_add(&bar[XB_XGEN(b.x)], 1u);
            ASMV("s_waitcnt vmcnt(0)" ::: "memory");
        } else {
            XB_SPIN(xb_ld(&bar[XB_XGEN(b.x)]) == gen, bar);
            __builtin_amdgcn_fence(__ATOMIC_ACQUIRE, "agent");
            ASMV("s_waitcnt vmcnt(0)" ::: "memory");
        }
    }
    __syncthreads();
}

struct Args { const void* in[30]; float* out; unsigned char* ws; int ph_lo, ph_hi; };
enum { I_X = 0, I_C, I_POS, I_WADA, I_BADA, I_N1G, I_N2G, I_WIN, I_QAG, I_WUQ, I_KVAG, I_WUKV, I_QG, I_KG, I_WPOOL, I_PSCALE, I_LBL, I_HOG, I_DWW, I_DWB, I_LNG, I_LNB,
       I_WOUT, I_RGW, I_RGB, I_REW, I_REB, I_W1, I_W3, I_W2 };
struct Ctx {
    const Args* a; unsigned char* ws; unsigned char* lds; int tid, wid, lane, G, blk;
    __device__ __forceinline__ const float* inf(int i) const { return (const float*)a->in[i]; }
    template <class T> __device__ __forceinline__ T* w(size_t off) const { return (T*)(ws + off); }
};

__device__ __forceinline__ Ctx fresh(const Ctx& c0) { Ctx c = c0; LAUNDER_V(c.tid); LAUNDER_V(c.lane); LAUNDER_S(c.wid); return c; }
__device__ __forceinline__ void ph_prologue0(const Ctx& c_) { const Ctx c = fresh(c_);
    const float* cc = c.inf(I_C); const float* wada = c.inf(I_WADA); float* modp = c.w<float>(WS_MODP);
    for (int u = c.blk; u < NL * 16 * 12; u += c.G) {
        const int l = u / 192, r = u % 192, ic = r / 12, jb = r % 12, j = jb * 512 + c.tid;
        float* Ls = (float*)c.lds;
        __syncthreads();
        if (c.tid < NB * 64) Ls[c.tid] = fsilu(cc[(c.tid >> 6) * 1024 + ic * 64 + (c.tid & 63)]);
        __syncthreads();
        float acc[NB];
#pragma unroll
        for (int b = 0; b < NB; ++b) acc[b] = 0.f;
        const float* wp = wada + ((size_t)l * 1024 + ic * 64) * 6144 + j;
#pragma unroll
        for (int i0 = 0; i0 < 64; i0 += 16) { float wv[16];
#pragma unroll
            for (int i = 0; i < 16; ++i) wv[i] = wp[(size_t)(i0 + i) * 6144];
#pragma unroll
            for (int i = 0; i < 16; ++i)
#pragma unroll
                for (int b = 0; b < NB; ++b) acc[b] += Ls[b * 64 + i0 + i] * wv[i]; }
#pragma unroll
        for (int b = 0; b < NB; ++b) modp[(((size_t)ic * NL + l) * NB + b) * 6144 + j] = acc[b];
    }
    const int* pos = (const int*)c.a->in[I_POS]; float* rc = c.w<float>(WS_ROPE); float* rs = rc + (size_t)NTOK * 16;
    for (int e = c.blk * 512 + c.tid; e < NTOK * 16; e += c.G * 512) { const int t = e >> 4, i = e & 15;
        const float inv = exp2f(-(float)i * (13.287712379549449f / 16.0f));
        const float ang = (float)pos[t] * inv; rc[e] = cosf(ang); rs[e] = sinf(ang); }
    if (c.blk == 0 && c.tid < 256) { const float* lg = c.inf(I_LBL); float* lb = c.w<float>(WS_LB); float mx = -1e30f;
        for (int l = 0; l < NL; ++l) mx = fmaxf(mx, lg[l * 256 + c.tid]);
        float den = 0.f; for (int l = 0; l < NL; ++l) den += expf(lg[l * 256 + c.tid] - mx);
        float cum = 0.f, first = 0.f; for (int l = 0; l < NL; ++l) { cum += expf(lg[l * 256 + c.tid] - mx) / den; if (l == 0) first = cum; lb[l * 256 + c.tid] = cum - first; } }
}
__device__ __forceinline__ void ph_prologue1(const Ctx& c_) { const Ctx c = fresh(c_);
    const float* modp = c.w<float>(WS_MODP); float* mod = c.w<float>(WS_MOD); const float* bada = c.inf(I_BADA);
    for (int e = c.blk * 512 + c.tid; e < NL * NB * 6144; e += c.G * 512) { const int j = e % 6144, l = e / (NB * 6144);
        float s = bada[l * 6144 + j];
#pragma unroll
        for (int ic = 0; ic < 16; ++ic) s += modp[(size_t)ic * NL * NB * 6144 + e];
        mod[e] = s; }
}

__device__ __forceinline__ void ld8bf(const bf16_t* p, float (&o)[8]) { const u32x4 v = *(const u32x4*)p; o[0] = bflo(v.x); o[1] = bfhi(v.x); o[2] = bflo(v.y); o[3] = bfhi(v.y); o[4] = bflo(v.z); o[5] = bfhi(v.z); o[6] = bflo(v.w); o[7] = bfhi(v.w); }
__device__ __forceinline__ u32x4 pk8(const float (&o)[8]) { u32x4 w; w.x = cvt_pk_bf16(o[0], o[1]); w.y = cvt_pk_bf16(o[2], o[3]); w.z = cvt_pk_bf16(o[4], o[5]); w.w = cvt_pk_bf16(o[6], o[7]); return w; }
__device__ __forceinline__ u32x4 pk8p(const float (&o)[8]) { u32x4 w; w.x = cvt_pk_bf16_pinned(o[0], o[1]); w.y = cvt_pk_bf16_pinned(o[2], o[3]); w.z = cvt_pk_bf16_pinned(o[4], o[5]); w.w = cvt_pk_bf16_pinned(o[6], o[7]); return w; }
__device__ __forceinline__ void cvt_tile(const Ctx& c, const float* src, int ldn, int nlim, int k0, int n0, bf16_t* dst, int ldk, int drow0) {
    float* T = (float*)c.lds;
#pragma unroll
    for (int i = 0; i < 8; ++i) { const int e = c.tid + 512 * i, kk = e >> 6, nn = e & 63; T[kk * 65 + nn] = (n0 + nn < nlim) ? src[(size_t)(k0 + kk) * ldn + n0 + nn] : 0.f; }
    __syncthreads();
#pragma unroll
    for (int i = 0; i < 4; ++i) { const int e = c.tid + 512 * i, nn = e >> 5, k2 = e & 31;
        *(unsigned*)(dst + (size_t)(drow0 + nn) * ldk + k0 + 2 * k2) = cvt_pk_bf16(T[(2 * k2) * 65 + nn], T[(2 * k2 + 1) * 65 + nn]); }
    __syncthreads();
}
__device__ __forceinline__ void cvt_big(const Ctx& c, const float* src, int ldn, int nlim, int k0, int n0, bf16_t* dst, int ldk, int mode) {
    float* T = (float*)c.lds;
    f32x4 v[8];
#pragma unroll
    for (int i = 0; i < 8; ++i) { const int e4 = c.tid + 512 * i, kk = e4 >> 6, n4 = e4 & 63; v[i] = (n0 + n4 * 4 < nlim) ? *(const f32x4*)(src + (size_t)(k0 + kk) * ldn + n0 + n4 * 4) : (f32x4){0.f, 0.f, 0.f, 0.f}; }
#pragma unroll
    for (int i = 0; i < 8; ++i) { const int e4 = c.tid + 512 * i, kk = e4 >> 6, n4 = e4 & 63; float* p = T + kk * 261 + n4 * 4; p[0] = v[i][0]; p[1] = v[i][1]; p[2] = v[i][2]; p[3] = v[i][3]; }
    __syncthreads();
#pragma unroll
    for (int i = 0; i < 4; ++i) { const int e = c.tid + 512 * i, k8 = e & 7, nn = e >> 3, n = n0 + nn; float o[8];
#pragma unroll
        for (int j = 0; j < 8; ++j) o[j] = T[(8 * k8 + j) * 261 + nn];
        const int row = (mode == 0) ? n : ((n >> 7) * 256 + (mode - 1) * 128 + (n & 127));
        *(u32x4*)(dst + (size_t)row * ldk + k0 + 8 * k8) = pk8(o); }
    __syncthreads();
}
constexpr int CT_IN = 16 * 9, CT_OUT = 16 * 4, CT_W13 = 32 * 16 * 2, CT_W2 = 32 * 8 * 4, CT_UQ = 3 * 6, CT_UKV = 2 * 8, CT_POOL = 4;
constexpr int CT_TOTAL = CT_IN + CT_OUT + 2 * CT_W13 + CT_W2 + CT_UQ + CT_UKV + CT_POOL;
__device__ __forceinline__ void ph_cvt(const Ctx& c_, int l) { const Ctx c = fresh(c_);
    { const float* rgw = c.inf(I_RGW) + (size_t)l * 1024 * 4; const float* rew = c.inf(I_REW) + (size_t)l * 1024 * 32; float* rwt = c.w<float>(WS_RWT + (size_t)(l & 1) * WSET);
        for (int e = c.blk * 512 + c.tid; e < 36 * 1024; e += c.G * 512) { const int g = e >> 10, k = e & 1023; rwt[e] = (g < 4) ? rgw[k * 4 + g] : rew[k * 32 + g - 4]; } }
    for (int t = c.blk; t < CT_TOTAL; t += c.G) {
        int r = t;
        if (r < 2 * CT_W13) { const int which = r / CT_W13; r %= CT_W13; const int e = r / 32, kt = (r % 32) / 2, nt = r % 2;
            cvt_big(c, c.inf(which ? I_W3 : I_W1) + ((size_t)l * 32 + e) * 1024 * 512, 512, 512, kt * 64, nt * 256, c.w<bf16_t>(WS_WUP + (size_t)(l & 1) * WSET) + (size_t)e * 1024 * 1024, 1024, 1 + which); continue; } r -= 2 * CT_W13;
        if (r < CT_W2) { const int e = r / 32, kt = (r % 32) / 4, nt = r % 4;
            cvt_big(c, c.inf(I_W2) + ((size_t)l * 32 + e) * 512 * 1024, 1024, 1024, kt * 64, nt * 256, c.w<bf16_t>(WS_WDN + (size_t)(l & 1) * WSET) + (size_t)e * 1024 * 512, 512, 0); continue; } r -= CT_W2;
        if (r < CT_IN) { const int kt = r / 9, nt = r % 9; cvt_big(c, c.inf(I_WIN) + (size_t)l * 1024 * 2144, 2144, 2144, kt * 64, nt * 256, c.w<bf16_t>(WS_WIN + (size_t)(l & 1) * WSET), 1024, 0); continue; } r -= CT_IN;
        if (r < CT_OUT) { const int kt = r / 4, nt = r % 4; cvt_big(c, c.inf(I_WOUT) + (size_t)l * 1024 * 1024, 1024, 1024, kt * 64, nt * 256, c.w<bf16_t>(WS_WOUT + (size_t)(l & 1) * WSET), 1024, 0); continue; } r -= CT_OUT;
        if (r < CT_UQ) { const int kt = r / 6, nt = r % 6; cvt_tile(c, c.inf(I_WUQ) + (size_t)l * 192 * 384, 384, 384, kt * 64, nt * 64, c.w<bf16_t>(WS_WUQ + (size_t)(l & 1) * WSET), 192, nt * 64); continue; } r -= CT_UQ;
        if (r < CT_UKV) { const int kt = r / 8, nt = r % 8; cvt_tile(c, c.inf(I_WUKV) + (size_t)l * 128 * 512, 512, 512, kt * 64, nt * 64, c.w<bf16_t>(WS_WUKV + (size_t)(l & 1) * WSET), 128, nt * 64); continue; } r -= CT_UKV;
        cvt_tile(c, c.inf(I_WPOOL) + ((size_t)l * 4 + r) * 4096, 64, 64, 0, 0, c.w<bf16_t>(WS_WPOOL + (size_t)(l & 1) * WSET) + r * 4096, 64, 0);
    }
}
__device__ __forceinline__ void ph_normrows(const Ctx& c_, int l) { const Ctx c = fresh(c_);
    const float* xin = c.inf(I_X); const bf16_t* xb = c.w<bf16_t>(WS_XB); const bf16_t* y1 = c.w<bf16_t>(WS_Y1);
    const float* gn = c.inf(I_N1G) + l * 1024; const float* mod = c.w<float>(WS_MOD) + (size_t)l * NB * 6144; bf16_t* ha = c.w<bf16_t>(WS_HA);
    constexpr int RQ = 4;
    for (int row0 = c.blk * 8 + c.wid; row0 < NTOK; row0 += c.G * 8 * RQ) {
        f32x4 v[RQ][2][2]; float ss[RQ];
        if (l == 0) {
#pragma unroll
            for (int q = 0; q < RQ; ++q) { const int row = row0 + q * c.G * 8;
                if (row < NTOK) {
#pragma unroll
                    for (int i = 0; i < 2; ++i) { const float* p = xin + (size_t)row * 1024 + i * 512 + c.lane * 8; v[q][i][0] = *(const f32x4*)p; v[q][i][1] = *(const f32x4*)(p + 4); } } }
        } else {
            u32x4 xw[RQ][2], yw[RQ][2];
#pragma unroll
            for (int q = 0; q < RQ; ++q) { const int row = row0 + q * c.G * 8;
                if (row < NTOK) {
#pragma unroll
                    for (int i = 0; i < 2; ++i) { const size_t o = (size_t)row * 1024 + i * 512 + c.lane * 8; xw[q][i] = *(const u32x4*)(xb + o); yw[q][i] = *(const u32x4*)(y1 + o); } } }
#pragma unroll
            for (int q = 0; q < RQ; ++q)
#pragma unroll
                for (int i = 0; i < 2; ++i) { const u32x4 a = xw[q][i], b = yw[q][i];
                    v[q][i][0] = (f32x4){bflo(a.x), bfhi(a.x), bflo(a.y), bfhi(a.y)} + (f32x4){bflo(b.x), bfhi(b.x), bflo(b.y), bfhi(b.y)};
                    v[q][i][1] = (f32x4){bflo(a.z), bfhi(a.z), bflo(a.w), bfhi(a.w)} + (f32x4){bflo(b.z), bfhi(b.z), bflo(b.w), bfhi(b.w)}; }
        }
#pragma unroll
        for (int q = 0; q < RQ; ++q) { float s = 0.f;
#pragma unroll
            for (int i = 0; i < 2; ++i)
#pragma unroll
                for (int h = 0; h < 2; ++h) { const f32x4 w = v[q][i][h]; s += w[0] * w[0] + w[1] * w[1] + w[2] * w[2] + w[3] * w[3]; }
            ss[q] = (row0 + q * c.G * 8 < NTOK) ? s : 0.f; }
#pragma unroll
        for (int q = 0; q < RQ; ++q) ss[q] = wave_sum(ss[q]);
#pragma unroll
        for (int q = 0; q < RQ; ++q) { const int row = row0 + q * c.G * 8;
            if (row < NTOK) { const int b = row / SEQ; const float* sh = mod + b * 6144; const float* sc = sh + 1024; const float rinv = frsqrt(ss[q] * (1.0f / 1024.0f) + EPS);
#pragma unroll
                for (int i = 0; i < 2; ++i) { const int col = i * 512 + c.lane * 8; float o8[8];
#pragma unroll
                    for (int h = 0; h < 2; ++h) { const f32x4 g = *(const f32x4*)(gn + col + 4 * h), s1 = *(const f32x4*)(sc + col + 4 * h), s0 = *(const f32x4*)(sh + col + 4 * h);
                        const f32x4 hv = v[q][i][h] * rinv * g * (s1 + 1.0f) + s0; o8[4 * h] = hv[0]; o8[4 * h + 1] = hv[1]; o8[4 * h + 2] = hv[2]; o8[4 * h + 3] = hv[3]; }
                    *(u32x4*)(ha + (size_t)row * 1024 + col) = pk8(o8); } } }
    }
}

#define MFMA16(a, b, c) __builtin_amdgcn_mfma_f32_16x16x32_bf16((a), (b), (c), 0, 0, 0)
#define MFMA32(a, b, c) __builtin_amdgcn_mfma_f32_32x32x16_bf16((a), (b), (c), 0, 0, 0)

__device__ __forceinline__ void mix_unit(const Ctx& c_, int l, int r0) { const Ctx c = fresh(c_);
    const bf16_t* Z = c.w<bf16_t>(WS_Z); bf16_t* Aq = (bf16_t*)c.lds; bf16_t* Akv = (bf16_t*)(c.lds + 12800); float* Lkr = (float*)(c.lds + 21504);
    float* Lu = (float*)(c.lds + 25600); bf16_t* Lp = (bf16_t*)(c.lds + 73728); float* Lcu = (float*)(c.lds + 90624); float* Lco = (float*)c.lds;
    const int s0 = r0 % SEQ, b = r0 / SEQ, fr = c.lane & 15, fq = c.lane >> 4;
    {   const int t = c.tid >> 4, sub = c.tid & 15; const bf16_t* zr = Z + (size_t)(r0 + t) * ZP;
        const u32x4 zero4 = {0u, 0u, 0u, 0u};
        const u32x4 ra0 = *(const u32x4*)(zr + Z_CQ + sub * 8), ra1 = (sub < 8) ? *(const u32x4*)(zr + Z_CQ + 128 + sub * 8) : zero4, rk0 = *(const u32x4*)(zr + Z_CKV + sub * 8), rkr = (sub < 4) ? *(const u32x4*)(zr + Z_KR + sub * 8) : zero4;
        u32x4 rp[3], rca[4], rcg[4];
#pragma unroll
        for (int i = 0; i < 3; ++i) { const int ch = c.tid + 512 * i, row = ch >> 5, c8 = ch & 31; rp[i] = (ch < 47 * 32 && s0 - 15 + row >= 0) ? *(const u32x4*)(Z + (size_t)(r0 - 15 + row) * ZP + Z_POOL + c8 * 8) : zero4; }
#pragma unroll
        for (int i = 0; i < 4; ++i) { const int ch = c.tid + 512 * i, row = ch >> 5, c8 = ch & 31; const bool ok = (ch < 62 * 32 && s0 - 30 + row >= 0);
            rca[i] = ok ? *(const u32x4*)(Z + (size_t)(r0 - 30 + row) * ZP + Z_CA + c8 * 8) : zero4; rcg[i] = ok ? *(const u32x4*)(Z + (size_t)(r0 - 30 + row) * ZP + Z_CG + c8 * 8) : zero4; }
        auto un8 = [](const u32x4 v, float (&o)[8]) { o[0] = bflo(v.x); o[1] = bfhi(v.x); o[2] = bflo(v.y); o[3] = bfhi(v.y); o[4] = bflo(v.z); o[5] = bfhi(v.z); o[6] = bflo(v.w); o[7] = bfhi(v.w); };
        const float* qag = c.inf(I_QAG) + l * 192; const float* kvag = c.inf(I_KVAG) + l * 128;
        float a0[8], a1[8], k0[8]; float ssq = 0.f, ssk = 0.f; un8(ra0, a0); un8(ra1, a1); un8(rk0, k0);
#pragma unroll
        for (int j = 0; j < 8; ++j) { ssq += a0[j] * a0[j] + a1[j] * a1[j]; ssk += k0[j] * k0[j]; }
#pragma unroll
        for (int m = 1; m < 16; m <<= 1) { ssq += __shfl_xor(ssq, m); ssk += __shfl_xor(ssk, m); }
        const float rq = frsqrt(ssq * (1.0f / 192.0f) + EPS), rk = frsqrt(ssk * (1.0f / 128.0f) + EPS);
#pragma unroll
        for (int j = 0; j < 8; ++j) a0[j] *= rq * qag[sub * 8 + j];
        *(u32x4*)(Aq + t * 200 + sub * 8) = pk8(a0);
        if (sub < 8) {
#pragma unroll
            for (int j = 0; j < 8; ++j) a1[j] *= rq * qag[128 + sub * 8 + j];
            *(u32x4*)(Aq + t * 200 + 128 + sub * 8) = pk8(a1); }
#pragma unroll
        for (int j = 0; j < 8; ++j) k0[j] *= rk * kvag[sub * 8 + j];
        *(u32x4*)(Akv + t * 136 + sub * 8) = pk8(k0);
        if (sub < 4) { float kr[8]; un8(rkr, kr);
#pragma unroll
            for (int j = 0; j < 8; ++j) Lkr[t * 32 + sub * 8 + j] = kr[j]; }
#pragma unroll
        for (int i = 0; i < 3; ++i) { const int ch = c.tid + 512 * i, row = ch >> 5, c8 = ch & 31; if (ch < 47 * 32) { float v[8]; un8(rp[i], v);
            *(f32x4*)(Lu + row * 256 + c8 * 8) = (f32x4){v[0], v[1], v[2], v[3]}; *(f32x4*)(Lu + row * 256 + c8 * 8 + 4) = (f32x4){v[4], v[5], v[6], v[7]}; } }
#pragma unroll
        for (int i = 0; i < 4; ++i) { const int ch = c.tid + 512 * i, row = ch >> 5, c8 = ch & 31; if (ch < 62 * 32) { float a[8], g[8]; un8(rca[i], a); un8(rcg[i], g);
#pragma unroll
            for (int j = 0; j < 8; ++j) a[j] *= fsigmoid(g[j]);
            *(f32x4*)(Lcu + row * 256 + c8 * 8) = (f32x4){a[0], a[1], a[2], a[3]}; *(f32x4*)(Lcu + row * 256 + c8 * 8 + 4) = (f32x4){a[4], a[5], a[6], a[7]}; } }
    }
    __syncthreads();
    const float* rcos = c.w<float>(WS_ROPE); const float* rsin = rcos + (size_t)NTOK * 16;
    if (c.wid < 4) {
        const int h = c.wid; const bf16_t* W = c.w<bf16_t>(WS_WUQ + (size_t)(l & 1) * WSET) + (size_t)(96 * h) * 192; const float* qg = c.inf(I_QG) + l * 96;
        f32x4 acc[6][2];
#pragma unroll
        for (int nf = 0; nf < 6; ++nf) { acc[nf][0] = (f32x4){0.f, 0.f, 0.f, 0.f}; acc[nf][1] = acc[nf][0]; }
#pragma unroll 3
        for (int ks = 0; ks < 6; ++ks) { bf16x8 af[2];
#pragma unroll
            for (int mf = 0; mf < 2; ++mf) af[mf] = *(const bf16x8*)(Aq + (mf * 16 + fr) * 200 + ks * 32 + fq * 8);
#pragma unroll
            for (int nf = 0; nf < 6; ++nf) { const bf16x8 bfr = *(const bf16x8*)(W + (size_t)(16 * nf + fr) * 192 + ks * 32 + fq * 8);
                acc[nf][0] = MFMA16(bfr, af[0], acc[nf][0]); acc[nf][1] = MFMA16(bfr, af[1], acc[nf][1]); } }
#pragma unroll
        for (int mf = 0; mf < 2; ++mf) { float ss = 0.f;
#pragma unroll
            for (int nf = 0; nf < 6; ++nf)
#pragma unroll
                for (int j = 0; j < 4; ++j) ss += acc[nf][mf][j] * acc[nf][mf][j];
            ss += __shfl_xor(ss, 16); ss += __shfl_xor(ss, 32);
            const float rinv = frsqrt(ss * (1.0f / 96.0f) + EPS) * (0.10206207261596575f * 1.44269504089f);
            const int tok = r0 + mf * 16 + fr; bf16_t* qo = c.w<bf16_t>(WS_Q) + ((size_t)(b * 4 + h) * SEQ + s0 + mf * 16 + fr) * 96;
            float v[6][4];
#pragma unroll
            for (int nf = 0; nf < 6; ++nf)
#pragma unroll
                for (int j = 0; j < 4; ++j) v[nf][j] = acc[nf][mf][j] * rinv * qg[16 * nf + 4 * fq + j];
            const f32x4 cs4 = *(const f32x4*)(rcos + (size_t)tok * 16 + 4 * fq), sn4 = *(const f32x4*)(rsin + (size_t)tok * 16 + 4 * fq);
#pragma unroll
            for (int j = 0; j < 4; ++j) { const float x1 = v[4][j], x2 = v[5][j]; v[4][j] = x1 * cs4[j] - x2 * sn4[j]; v[5][j] = x1 * sn4[j] + x2 * cs4[j]; }
#pragma unroll
            for (int nf = 0; nf < 6; ++nf) { u32x2 o; o.x = cvt_pk_bf16(v[nf][0], v[nf][1]); o.y = cvt_pk_bf16(v[nf][2], v[nf][3]); *(u32x2*)(qo + 16 * nf + 4 * fq) = o; } }
    } else {
        const int h = c.wid - 4; const bf16_t* W = c.w<bf16_t>(WS_WUKV + (size_t)(l & 1) * WSET) + (size_t)(128 * h) * 128; const float* kg = c.inf(I_KG) + l * 96;
        f32x4 ak[4][2], av[4][2];
#pragma unroll
        for (int nf = 0; nf < 4; ++nf) { ak[nf][0] = (f32x4){0.f, 0.f, 0.f, 0.f}; ak[nf][1] = ak[nf][0]; av[nf][0] = ak[nf][0]; av[nf][1] = ak[nf][0]; }
#pragma unroll 2
        for (int ks = 0; ks < 4; ++ks) { bf16x8 af[2];
#pragma unroll
            for (int mf = 0; mf < 2; ++mf) af[mf] = *(const bf16x8*)(Akv + (mf * 16 + fr) * 136 + ks * 32 + fq * 8);
#pragma unroll
            for (int nf = 0; nf < 4; ++nf) { const bf16x8 bk = *(const bf16x8*)(W + (size_t)(16 * nf + fr) * 128 + ks * 32 + fq * 8), bv = *(const bf16x8*)(W + (size_t)(64 + 16 * nf + fr) * 128 + ks * 32 + fq * 8);
                ak[nf][0] = MFMA16(bk, af[0], ak[nf][0]); ak[nf][1] = MFMA16(bk, af[1], ak[nf][1]);
                av[nf][0] = MFMA16(af[0], bv, av[nf][0]); av[nf][1] = MFMA16(af[1], bv, av[nf][1]); } }
#pragma unroll
        for (int mf = 0; mf < 2; ++mf) { const int tl = mf * 16 + fr; float ss = 0.f;
#pragma unroll
            for (int nf = 0; nf < 4; ++nf)
#pragma unroll
                for (int j = 0; j < 4; ++j) ss += ak[nf][mf][j] * ak[nf][mf][j];
#pragma unroll
            for (int j = 0; j < 8; ++j) { const float kr = Lkr[tl * 32 + fq * 8 + j]; ss += kr * kr; }
            ss += __shfl_xor(ss, 16); ss += __shfl_xor(ss, 32);
            const float rinv = frsqrt(ss * (1.0f / 96.0f) + EPS);
            const int tok = r0 + tl; bf16_t* ko = c.w<bf16_t>(WS_K) + ((size_t)(b * 4 + h) * SEQ + s0 + tl) * 96;
#pragma unroll
            for (int nf = 0; nf < 4; ++nf) { u32x2 o; o.x = cvt_pk_bf16(ak[nf][mf][0] * rinv * kg[16 * nf + 4 * fq], ak[nf][mf][1] * rinv * kg[16 * nf + 4 * fq + 1]);
                o.y = cvt_pk_bf16(ak[nf][mf][2] * rinv * kg[16 * nf + 4 * fq + 2], ak[nf][mf][3] * rinv * kg[16 * nf + 4 * fq + 3]); *(u32x2*)(ko + 16 * nf + 4 * fq) = o; }
            const f32x4 cs4 = *(const f32x4*)(rcos + (size_t)tok * 16 + 4 * fq), sn4 = *(const f32x4*)(rsin + (size_t)tok * 16 + 4 * fq);
            float o1[4], o2[4];
#pragma unroll
            for (int j = 0; j < 4; ++j) { const int i = 4 * fq + j; const float x1 = Lkr[tl * 32 + i] * rinv * kg[64 + i], x2 = Lkr[tl * 32 + 16 + i] * rinv * kg[80 + i];
                o1[j] = x1 * cs4[j] - x2 * sn4[j]; o2[j] = x1 * sn4[j] + x2 * cs4[j]; }
            { u32x2 o; o.x = cvt_pk_bf16(o1[0], o1[1]); o.y = cvt_pk_bf16(o1[2], o1[3]); *(u32x2*)(ko + 64 + 4 * fq) = o; o.x = cvt_pk_bf16(o2[0], o2[1]); o.y = cvt_pk_bf16(o2[2], o2[3]); *(u32x2*)(ko + 80 + 4 * fq) = o; }
            bf16_t* vo = c.w<bf16_t>(WS_VT) + (size_t)(b * 4 + h) * 64 * SEQ + s0 + mf * 16 + 4 * fq;
#pragma unroll
            for (int nf = 0; nf < 4; ++nf) { u32x2 o; o.x = cvt_pk_bf16(av[nf][mf][0], av[nf][mf][1]); o.y = cvt_pk_bf16(av[nf][mf][2], av[nf][mf][3]); *(u32x2*)(vo + (size_t)(16 * nf + fr) * SEQ) = o; } }
    }
    { const int t = c.tid >> 4, sub = c.tid & 15, g = sub >> 2, w = 2 << g, s = s0 + t; const float inv = 1.0f / (float)((s + 1 < w) ? (s + 1) : w);
#pragma unroll
        for (int k = 0; k < 2; ++k) { const int col = sub * 16 + k * 8; float sum[8];
#pragma unroll
            for (int j = 0; j < 8; ++j) sum[j] = 0.f;
            for (int d = 0; d < w; ++d) { const float* p = Lu + (t + 15 - d) * 256 + col;
#pragma unroll
                for (int j = 0; j < 8; ++j) sum[j] += p[j]; }
            const float* p0 = Lu + (t + 15) * 256 + col;
#pragma unroll
            for (int j = 0; j < 8; ++j) sum[j] = sum[j] * inv - p0[j];
            *(u32x4*)(Lp + t * 264 + col) = pk8(sum); } }
    float cres[16];
    { const int chn = c.tid & 255, half = c.tid >> 8; const float* dw = c.inf(I_DWW) + (size_t)l * 31 * 256 + chn; const float bias = c.inf(I_DWB)[l * 256 + chn];
        float wv[31];
#pragma unroll
        for (int j = 0; j < 31; ++j) wv[j] = dw[j * 256];
#pragma unroll
        for (int tt = 0; tt < 16; ++tt) cres[tt] = bias;
#pragma unroll
        for (int r = 0; r < 46; ++r) { const float u = Lcu[(half * 16 + r) * 256 + chn];
#pragma unroll
            for (int tt = 0; tt < 16; ++tt) { const int j = r - tt; if (j >= 0 && j < 31) cres[tt] += wv[j] * u; } } }
    __syncthreads();
    { const int g = c.wid >> 1, mf = c.wid & 1; const bf16_t* W = c.w<bf16_t>(WS_WPOOL + (size_t)(l & 1) * WSET) + g * 4096; const float* ps = c.inf(I_PSCALE) + l * 256 + g * 64;
        f32x4 acc[4];
#pragma unroll
        for (int nf = 0; nf < 4; ++nf) acc[nf] = (f32x4){0.f, 0.f, 0.f, 0.f};
#pragma unroll
        for (int ks = 0; ks < 2; ++ks) { const bf16x8 af = *(const bf16x8*)(Lp + (mf * 16 + fr) * 264 + g * 64 + ks * 32 + fq * 8);
#pragma unroll
            for (int nf = 0; nf < 4; ++nf) { const bf16x8 bfr = *(const bf16x8*)(W + (16 * nf + fr) * 64 + ks * 32 + fq * 8); acc[nf] = MFMA16(bfr, af, acc[nf]); } }
        bf16_t* yo = c.w<bf16_t>(WS_YB) + (size_t)(r0 + mf * 16 + fr) * 1024 + 256 + g * 64;
#pragma unroll
        for (int nf = 0; nf < 4; ++nf) { const int d = 16 * nf + 4 * fq; u32x2 o; o.x = cvt_pk_bf16(acc[nf][0] * ps[d], acc[nf][1] * ps[d + 1]); o.y = cvt_pk_bf16(acc[nf][2] * ps[d + 2], acc[nf][3] * ps[d + 3]); *(u32x2*)(yo + d) = o; } }
    { const int chn = c.tid & 255, half = c.tid >> 8;
#pragma unroll
        for (int tt = 0; tt < 16; ++tt) Lco[(half * 16 + tt) * 256 + chn] = cres[tt]; }
    __syncthreads();
    { const float* lg = c.inf(I_LNG) + l * 256 + c.lane * 4; const float* lb = c.inf(I_LNB) + l * 256 + c.lane * 4;
#pragma unroll
        for (int k = 0; k < 4; ++k) { const int t = c.wid * 4 + k; const f32x4 v = *(const f32x4*)(Lco + t * 256 + c.lane * 4);
            const float mean = wave_sum(v[0] + v[1] + v[2] + v[3]) * (1.0f / 256.0f); const f32x4 d = v - mean;
            const float var = wave_sum(d[0] * d[0] + d[1] * d[1] + d[2] * d[2] + d[3] * d[3]) * (1.0f / 256.0f); const float rs = frsqrt(var + EPS);
            float y[4];
#pragma unroll
            for (int j = 0; j < 4; ++j) y[j] = fsilu(d[j] * rs * lg[j] + lb[j]);
            u32x2 o; o.x = cvt_pk_bf16(y[0], y[1]); o.y = cvt_pk_bf16(y[2], y[3]); *(u32x2*)(c.w<bf16_t>(WS_YB) + (size_t)(r0 + t) * 1024 + 768 + c.lane * 4) = o; } }
    __syncthreads();
}

constexpr int CW_W13 = 32 * 16 * 16, CW_W2 = 32 * 8 * 32, CW_IN = 16 * 72, CW_OUT = 16 * 32, CW_UQ = 3 * 12, CW_UKV = 2 * 16, CW_POOL = 4 * 2;
constexpr int CW_TOTAL = 2 * CW_W13 + CW_W2 + CW_IN + CW_OUT + CW_UQ + CW_UKV + CW_POOL;
struct CvtTile { const float* src; bf16_t* dst; int ldn, ldk; };
__device__ __forceinline__ void cvt_decode(const Ctx& c, int l, int t, CvtTile& d) {
    const size_t wso = (size_t)(l & 1) * WSET; int r = t;
    if (r < 2 * CW_W13) { const int which = r / CW_W13; r %= CW_W13; const int e = r >> 8, kt = (r >> 4) & 15, nt = r & 15, n0 = nt * 32;
        d.src = c.inf(which ? I_W3 : I_W1) + ((size_t)l * 32 + e) * 1024 * 512 + (size_t)kt * 64 * 512 + n0; d.ldn = 512; d.ldk = 1024;
        d.dst = c.w<bf16_t>(WS_WUP + wso) + (size_t)e * 1024 * 1024 + (size_t)((n0 >> 7) * 256 + which * 128 + (n0 & 127)) * 1024 + kt * 64; return; } r -= 2 * CW_W13;
    if (r < CW_W2) { const int e = r >> 8, kt = (r >> 5) & 7, nt = r & 31;
        d.src = c.inf(I_W2) + ((size_t)l * 32 + e) * 512 * 1024 + (size_t)kt * 64 * 1024 + nt * 32; d.ldn = 1024; d.ldk = 512;
        d.dst = c.w<bf16_t>(WS_WDN + wso) + (size_t)e * 1024 * 512 + (size_t)(nt * 32) * 512 + kt * 64; return; } r -= CW_W2;
    if (r < CW_IN) { const int kt = r / 72, nt = r % 72; d.src = (nt < 67) ? c.inf(I_WIN) + (size_t)l * 1024 * 2144 + (size_t)kt * 64 * 2144 + nt * 32 : nullptr; d.ldn = 2144; d.ldk = 1024;
        d.dst = c.w<bf16_t>(WS_WIN + wso) + (size_t)(nt * 32) * 1024 + kt * 64; return; } r -= CW_IN;
    if (r < CW_OUT) { const int kt = r >> 5, nt = r & 31; d.src = c.inf(I_WOUT) + (size_t)l * 1024 * 1024 + (size_t)kt * 64 * 1024 + nt * 32; d.ldn = 1024; d.ldk = 1024;
        d.dst = c.w<bf16_t>(WS_WOUT + wso) + (size_t)(nt * 32) * 1024 + kt * 64; return; } r -= CW_OUT;
    if (r < CW_UQ) { const int kt = r / 12, nt = r % 12; d.src = c.inf(I_WUQ) + (size_t)l * 192 * 384 + (size_t)kt * 64 * 384 + nt * 32; d.ldn = 384; d.ldk = 192;
        d.dst = c.w<bf16_t>(WS_WUQ + wso) + (size_t)(nt * 32) * 192 + kt * 64; return; } r -= CW_UQ;
    if (r < CW_UKV) { const int kt = r >> 4, nt = r & 15; d.src = c.inf(I_WUKV) + (size_t)l * 128 * 512 + (size_t)kt * 64 * 512 + nt * 32; d.ldn = 512; d.ldk = 128;
        d.dst = c.w<bf16_t>(WS_WUKV + wso) + (size_t)(nt * 32) * 128 + kt * 64; return; } r -= CW_UKV;
    { const int g = r >> 1, nt = r & 1; d.src = c.inf(I_WPOOL) + ((size_t)l * 4 + g) * 4096 + nt * 32; d.ldn = 64; d.ldk = 64; d.dst = c.w<bf16_t>(WS_WPOOL + wso) + g * 4096 + (size_t)(nt * 32) * 64; }
}
__device__ __forceinline__ void cvt_wave(const Ctx& c, int l, int wrank, int nwaves, float* T) {
    { const float* rgw = c.inf(I_RGW) + (size_t)l * 1024 * 4; const float* rew = c.inf(I_REW) + (size_t)l * 1024 * 32; float* rwt = c.w<float>(WS_RWT + (size_t)(l & 1) * WSET);
        for (int e = wrank * 64 + c.lane; e < 36 * 1024; e += nwaves * 64) { const int g = e >> 10, k = e & 1023; rwt[e] = (g < 4) ? rgw[k * 4 + g] : rew[k * 32 + g - 4]; } }
    f32x4 v[8]; CvtTile cur; cur.src = nullptr; cur.dst = nullptr; cur.ldn = 0; cur.ldk = 0;
    auto issue = [&](const CvtTile& d) {
#pragma unroll
        for (int i = 0; i < 8; ++i) { const int e4 = c.lane + 64 * i, kk = e4 >> 3, n4 = e4 & 7; v[i] = d.src ? *(const f32x4*)(d.src + (size_t)kk * d.ldn + n4 * 4) : (f32x4){0.f, 0.f, 0.f, 0.f}; } };
    int t = wrank;
    if (t < CW_TOTAL) { cvt_decode(c, l, t, cur); issue(cur); }
    while (t < CW_TOTAL) {
#pragma unroll
        for (int i = 0; i < 8; ++i) { const int e4 = c.lane + 64 * i, kk = e4 >> 3, n4 = e4 & 7; float* p = T + kk * 33 + n4 * 4; p[0] = v[i][0]; p[1] = v[i][1]; p[2] = v[i][2]; p[3] = v[i][3]; }
        const int tn = t + nwaves; CvtTile nxt = cur; if (tn < CW_TOTAL) { cvt_decode(c, l, tn, nxt); issue(nxt); }
        __builtin_amdgcn_wave_barrier();
        { const int n = c.lane & 31, kh = c.lane >> 5; bf16_t* drow = cur.dst + (size_t)n * cur.ldk + kh * 32;
#pragma unroll
            for (int q = 0; q < 4; ++q) { float o[8];
#pragma unroll
                for (int j = 0; j < 8; ++j) o[j] = T[(kh * 32 + q * 8 + j) * 33 + n];
                *(u32x4*)(drow + q * 8) = pk8(o); } }
        __builtin_amdgcn_wave_barrier();
        t = tn; cur = nxt;
    }
}

#ifdef EMU
static inline float __builtin_amdgcn_logf(float x) { return log2f(x); }
#endif
constexpr int HGP = 68, HGV = 40;
constexpr int HG_LG = 0, HG_LK = 8704, HG_LQ = 17408, HG_LVT = 26112, HG_LEG = 31232, HG_LGG = 31488, HG_BYTES = 31744;
template <bool OUT> __device__ __forceinline__ void hgrn_mfma(const Ctx& c_, int l, int bu, int cvt_layer = NL) { const Ctx c = fresh(c_);
    if (c.wid < 4) {
        const int cu = bu * 4 + c.wid, bh = cu / NCH, chunk = cu % NCH, b = bh >> 2, h = bh & 3, tok0 = b * SEQ + chunk * 128;
        const bf16_t* Z = c.w<bf16_t>(WS_Z); const float lbd = c.w<float>(WS_LB)[l * 256 + h * 64 + c.lane];
        unsigned char* L = c.lds + c.wid * HG_BYTES; float* Lg = (float*)(L + HG_LG); float* Lk = (float*)(L + HG_LK); float* Lq = (float*)(L + HG_LQ); bf16_t* Lvt = (bf16_t*)(L + HG_LVT); float* LeG = (float*)(L + HG_LEG); float* LG = (float*)(L + HG_LGG);
        const int l31 = c.lane & 31, hi = c.lane >> 5;
        f32x16 S[2][2];
        if (OUT) { const float* s0 = c.w<float>(WS_S0) + (size_t)(bh * NCH + chunk) * 4096;
#pragma unroll
            for (int mf = 0; mf < 2; ++mf)
#pragma unroll
                for (int nf = 0; nf < 2; ++nf)
#pragma unroll
                    for (int r = 0; r < 16; ++r) S[mf][nf][r] = s0[(32 * mf + (r & 3) + 8 * (r >> 2) + 4 * hi) * 64 + 32 * nf + l31]; }
        else {
#pragma unroll
            for (int mf = 0; mf < 2; ++mf)
#pragma unroll
                for (int nf = 0; nf < 2; ++nf)
#pragma unroll
                    for (int r = 0; r < 16; ++r) S[mf][nf][r] = 0.f; }
        float gtot = 0.f; const float og0 = OUT ? c.inf(I_HOG)[l * 64 + l31] : 0.f, og1 = OUT ? c.inf(I_HOG)[l * 64 + 32 + l31] : 0.f;
        u32x4 rf[4], rq[4], rv[4];
        { const bf16_t* zn = Z + (size_t)(tok0 + (c.lane >> 3)) * ZP + h * 64 + (c.lane & 7) * 8;
#pragma unroll
            for (int i = 0; i < 4; ++i) { rf[i] = *(const u32x4*)(zn + (size_t)i * 8 * ZP + Z_HF); rv[i] = *(const u32x4*)(zn + (size_t)i * 8 * ZP + Z_HI); if (OUT) rq[i] = *(const u32x4*)(zn + (size_t)i * 8 * ZP + Z_HQ); else rq[i] = (u32x4){0u, 0u, 0u, 0u}; } }
#pragma unroll 1
        for (int sc = 0; sc < 4; ++sc) { const int tokb = tok0 + sc * 32;
            {
                const int rr = c.lane >> 3, c8 = (c.lane & 7) * 8;
#pragma unroll
                for (int i = 0; i < 4; ++i) { const int tr = i * 8 + rr; float x[8];
                    { const u32x4 v = rf[i]; x[0] = bflo(v.x); x[1] = bfhi(v.x); x[2] = bflo(v.y); x[3] = bfhi(v.y); x[4] = bflo(v.z); x[5] = bfhi(v.z); x[6] = bflo(v.w); x[7] = bfhi(v.w); }
                    *(f32x4*)(Lg + tr * HGP + c8) = (f32x4){x[0], x[1], x[2], x[3]}; *(f32x4*)(Lg + tr * HGP + c8 + 4) = (f32x4){x[4], x[5], x[6], x[7]};
                    if (OUT) { const u32x4 v = rq[i]; x[0] = fsilu(bflo(v.x)); x[1] = fsilu(bfhi(v.x)); x[2] = fsilu(bflo(v.y)); x[3] = fsilu(bfhi(v.y)); x[4] = fsilu(bflo(v.z)); x[5] = fsilu(bfhi(v.z)); x[6] = fsilu(bflo(v.w)); x[7] = fsilu(bfhi(v.w));
                        *(f32x4*)(Lq + tr * HGP + c8) = (f32x4){x[0], x[1], x[2], x[3]}; *(f32x4*)(Lq + tr * HGP + c8 + 4) = (f32x4){x[4], x[5], x[6], x[7]}; }
                    { const u32x4 v = rv[i]; const unsigned w4[4] = {v.x, v.y, v.z, v.w};
#pragma unroll
                        for (int k = 0; k < 4; ++k) { Lvt[(c8 + 2 * k) * HGV + tr] = (bf16_t)(w4[k] & 0xffffu); Lvt[(c8 + 2 * k + 1) * HGV + tr] = (bf16_t)(w4[k] >> 16); } } }
                if (sc < 3) { const bf16_t* zn = Z + (size_t)(tokb + 32 + rr) * ZP + h * 64 + c8;
#pragma unroll
                    for (int i = 0; i < 4; ++i) { rf[i] = *(const u32x4*)(zn + (size_t)i * 8 * ZP + Z_HF); rv[i] = *(const u32x4*)(zn + (size_t)i * 8 * ZP + Z_HI); if (OUT) rq[i] = *(const u32x4*)(zn + (size_t)i * 8 * ZP + Z_HQ); } }
                __builtin_amdgcn_wave_barrier();
                float run = 0.f;
#pragma unroll
                for (int t = 0; t < 32; ++t) { const float f = lbd + (1.0f - lbd) * fsigmoid(Lg[t * HGP + c.lane]); run += __builtin_amdgcn_logf(f); Lg[t * HGP + c.lane] = run; Lk[t * HGP + c.lane] = 1.0f - f; }
                LG[c.lane] = run; LeG[c.lane] = __builtin_amdgcn_exp2f(run); gtot += run;
            }
            __builtin_amdgcn_wave_barrier();
            bf16x8 vt[2][2];
#pragma unroll
            for (int nf = 0; nf < 2; ++nf)
#pragma unroll
                for (int ks = 0; ks < 2; ++ks) vt[nf][ks] = *(const bf16x8*)(Lvt + (32 * nf + l31) * HGV + 16 * ks + 8 * hi);
            f32x16 O[2];
            if (OUT) {
#pragma unroll
                for (int r = 0; r < 16; ++r) { O[0][r] = 0.f; O[1][r] = 0.f; }
                float acc[8];
#pragma unroll
                for (int m = 0; m < 8; ++m) acc[m] = 0.f;
                const int sb = (l31 & 16) + 8 * hi;
#pragma unroll 1
                for (int d4 = 0; d4 < 16; ++d4) { const f32x4 qt = *(const f32x4*)(Lq + l31 * HGP + 4 * d4), gt = *(const f32x4*)(Lg + l31 * HGP + 4 * d4);
#pragma unroll
                    for (int mg = 0; mg < 4; ++mg) {
                        f32x4 k4[2], g4[2];
#pragma unroll
                        for (int j = 0; j < 2; ++j) { const int s = sb + 2 * mg + j; k4[j] = *(const f32x4*)(Lk + s * HGP + 4 * d4); g4[j] = *(const f32x4*)(Lg + s * HGP + 4 * d4); }
                        __builtin_amdgcn_sched_barrier(0);
#pragma unroll
                        for (int j = 0; j < 2; ++j)
#pragma unroll
                            for (int e = 0; e < 4; ++e) acc[mg * 2 + j] += qt[e] * k4[j][e] * __builtin_amdgcn_exp2f(gt[e] - g4[j][e]);
                        __builtin_amdgcn_sched_barrier(0); } }
                bf16x8 af[2], afx;
                { float a8[8];
#pragma unroll
                    for (int j = 0; j < 8; ++j) a8[j] = (sb + j <= l31) ? acc[j] : 0.f;
                    const bf16x8 ad = __builtin_bit_cast(bf16x8, pk8p(a8)), az = (bf16x8){0, 0, 0, 0, 0, 0, 0, 0};
                    af[0] = (l31 < 16) ? ad : az; af[1] = (l31 < 16) ? az : ad; }
                {
                    f32x16 dx;
#pragma unroll
                    for (int r = 0; r < 16; ++r) dx[r] = 0.f;
                    const bool lowr = l31 < 16; const float* Lx = lowr ? Lk : Lq;
#pragma unroll
                    for (int kk = 0; kk < 4; ++kk) { const int d0 = 16 * kk + 8 * hi;
                        const f32x4 xa = *(const f32x4*)(Lx + l31 * HGP + d0), xb = *(const f32x4*)(Lx + l31 * HGP + d0 + 4), ga = *(const f32x4*)(Lg + l31 * HGP + d0), gb = *(const f32x4*)(Lg + l31 * HGP + d0 + 4),
                                    ma = *(const f32x4*)(Lg + 15 * HGP + d0), mb = *(const f32x4*)(Lg + 15 * HGP + d0 + 4);
                        float v8[8];
#pragma unroll
                        for (int j = 0; j < 4; ++j) { const float da = ga[j] - ma[j], db = gb[j] - mb[j];
                            v8[j] = xa[j] * __builtin_amdgcn_exp2f(lowr ? -da : da); v8[4 + j] = xb[j] * __builtin_amdgcn_exp2f(lowr ? -db : db); }
                        const bf16x8 vv = __builtin_bit_cast(bf16x8, pk8p(v8)), zz = (bf16x8){0, 0, 0, 0, 0, 0, 0, 0};
                        dx = MFMA32(lowr ? vv : zz, lowr ? zz : vv, dx); }
                    float x8[8];
#pragma unroll
                    for (int j = 0; j < 8; ++j) x8[j] = dx[j];
                    afx = __builtin_bit_cast(bf16x8, pk8(x8)); }
#pragma unroll
                for (int mf = 0; mf < 2; ++mf)
#pragma unroll
                    for (int s = 0; s < 2; ++s) { const int d0 = 32 * mf + 16 * s + 4 * hi;
                        const f32x4 qa = *(const f32x4*)(Lq + l31 * HGP + d0), qb = *(const f32x4*)(Lq + l31 * HGP + d0 + 8), ga = *(const f32x4*)(Lg + l31 * HGP + d0), gb = *(const f32x4*)(Lg + l31 * HGP + d0 + 8);
                        float q8[8];
#pragma unroll
                        for (int j = 0; j < 4; ++j) { q8[j] = qa[j] * __builtin_amdgcn_exp2f(ga[j]); q8[4 + j] = qb[j] * __builtin_amdgcn_exp2f(gb[j]); }
                        const bf16x8 qf = __builtin_bit_cast(bf16x8, pk8p(q8));
#pragma unroll
                        for (int nf = 0; nf < 2; ++nf) { float s8[8];
#pragma unroll
                            for (int j = 0; j < 8; ++j) s8[j] = S[mf][nf][8 * s + j];
                            O[nf] = MFMA32(qf, __builtin_bit_cast(bf16x8, pk8p(s8)), O[nf]); } }
#pragma unroll
                for (int nf = 0; nf < 2; ++nf) {
#pragma unroll
                    for (int ks = 0; ks < 2; ++ks) O[nf] = MFMA32(af[ks], vt[nf][ks], O[nf]);
                    const s16x4 p0 = *(const s16x4*)(Lvt + (32 * nf + l31) * HGV + 4 * hi), p1 = *(const s16x4*)(Lvt + (32 * nf + l31) * HGV + 8 + 4 * hi);
                    O[nf] = MFMA32(afx, ((bf16x8){p0[0], p0[1], p0[2], p0[3], p1[0], p1[1], p1[2], p1[3]}), O[nf]); }
            }
#pragma unroll
            for (int mf = 0; mf < 2; ++mf) {
#pragma unroll
                for (int q = 0; q < 4; ++q) { const f32x4 e4 = *(const f32x4*)(LeG + 32 * mf + 8 * q + 4 * hi);
#pragma unroll
                    for (int e = 0; e < 4; ++e) { S[mf][0][4 * q + e] *= e4[e]; S[mf][1][4 * q + e] *= e4[e]; } }
                const int d = 32 * mf + l31; const float Gd = LG[d];
#pragma unroll
                for (int ks = 0; ks < 2; ++ks) { float k8[8];
#pragma unroll
                    for (int j = 0; j < 8; ++j) { const int s = 16 * ks + 8 * hi + j; k8[j] = Lk[s * HGP + d] * __builtin_amdgcn_exp2f(Gd - Lg[s * HGP + d]); }
                    const bf16x8 kf = __builtin_bit_cast(bf16x8, pk8p(k8));
                    S[mf][0] = MFMA32(kf, vt[0][ks], S[mf][0]); S[mf][1] = MFMA32(kf, vt[1][ks], S[mf][1]); } }
            if (OUT) {
                {
                    const int rr = c.lane >> 3, c8 = (c.lane & 7) * 8; const bf16_t* zg = Z + (size_t)(tokb + rr) * ZP + Z_HG + h * 64 + c8; u32x2 gv[4];
#pragma unroll
                    for (int hf = 0; hf < 2; ++hf) {
#pragma unroll
                    for (int i = 0; i < 4; ++i) gv[i] = *(const u32x2*)(zg + (size_t)i * 8 * ZP + 4 * hf);
#pragma unroll
                    for (int i = 0; i < 4; ++i) { const u32x2 v = gv[i]; *(f32x4*)(Lq + (i * 8 + rr) * HGP + c8 + 4 * hf) = (f32x4){fsilu(bflo(v.x)), fsilu(bfhi(v.x)), fsilu(bflo(v.y)), fsilu(bfhi(v.y))}; } }
                }
                __builtin_amdgcn_wave_barrier();
#pragma unroll
                for (int r = 0; r < 16; ++r) { const int tl = (r & 3) + 8 * (r >> 2) + 4 * hi; float ss = O[0][r] * O[0][r] + O[1][r] * O[1][r];
                    ss = half_sum(ss, hi);
                    const float rinv = frsqrt(ss * (1.0f / 64.0f) + EPS); const size_t tok = (size_t)(tokb + tl);
                    const float g0 = Lq[tl * HGP + l31], g1 = Lq[tl * HGP + 32 + l31];
                    bf16_t* yo = c.w<bf16_t>(WS_YB) + tok * 1024 + 512 + h * 64;
                    yo[l31] = (bf16_t)f2bf_bits(O[0][r] * rinv * og0 * g0); yo[32 + l31] = (bf16_t)f2bf_bits(O[1][r] * rinv * og1 * g1); } }
            __builtin_amdgcn_wave_barrier();
        }
        if (!OUT) { float* sc = c.w<float>(WS_SC) + (size_t)(bh * NCH + chunk) * 4096;
#pragma unroll
            for (int mf = 0; mf < 2; ++mf)
#pragma unroll
                for (int nf = 0; nf < 2; ++nf)
#pragma unroll
                    for (int r = 0; r < 16; ++r) sc[(32 * mf + (r & 3) + 8 * (r >> 2) + 4 * hi) * 64 + 32 * nf + l31] = S[mf][nf][r];
            c.w<float>(WS_PC)[(size_t)(bh * NCH + chunk) * 64 + c.lane] = __builtin_amdgcn_exp2f(gtot); }
    } else if (OUT && cvt_layer < NL) {
        cvt_wave(c, cvt_layer, bu * 4 + (c.wid - 4), NBH * NCH, (float*)(c.lds + 4 * HG_BYTES + (c.wid - 4) * 8448));
    }
    __syncthreads();
}
__device__ __forceinline__ void hgrn_carry(const Ctx& c_, int l) { const Ctx c = fresh(c_);
    const float* SC = c.w<float>(WS_SC); const float* PC = c.w<float>(WS_PC); float* S0 = c.w<float>(WS_S0);
    for (int e = c.blk * 512 + c.tid; e < NBH * 4096; e += c.G * 512) { const int bh = e >> 12, dv = e & 4095, d = dv >> 6; float s = 0.f;
#pragma unroll 8
        for (int ch = 0; ch < NCH; ++ch) { const size_t o = (size_t)(bh * NCH + ch) * 4096 + dv; S0[o] = s; s = PC[(size_t)(bh * NCH + ch) * 64 + d] * s + SC[o]; } }
    ASMV("s_waitcnt vmcnt(0)" ::: "memory");
    __syncthreads();
    if (c.tid == 0) { __builtin_amdgcn_fence(__ATOMIC_RELEASE, "agent"); ASMV("s_waitcnt vmcnt(0)" ::: "memory");
        (void)__hip_atomic_fetch_add((unsigned*)(c.ws + WS_CTL + CTL_HG) + l * 64, 1u, __ATOMIC_RELAXED, __HIP_MEMORY_SCOPE_AGENT); }
}
__device__ __forceinline__ void hgrn_wait_carry(const Ctx& c, int l) {
    if (c.tid == 0) { unsigned* p = (unsigned*)(c.ws + WS_CTL + CTL_HG) + l * 64; unsigned sp = 0;
        while (__hip_atomic_load(p, __ATOMIC_RELAXED, __HIP_MEMORY_SCOPE_AGENT) < (unsigned)c.G) { __builtin_amdgcn_s_sleep(1); if (++sp > (1u << 22)) break; }
        __builtin_amdgcn_fence(__ATOMIC_ACQUIRE, "agent"); ASMV("s_waitcnt vmcnt(0)" ::: "memory"); }
    __syncthreads();
}
__device__ __forceinline__ void ph_mixers(const Ctx& c, int l) {
    if (c.blk & 1) for (int bu = c.blk; bu < NBH * NCH / 4; bu += c.G) hgrn_mfma<false>(c, l, bu);
    for (int u = c.blk; u < NTOK / 32; u += c.G) mix_unit(c, l, u * 32);
    if (!(c.blk & 1)) for (int bu = c.blk; bu < NBH * NCH / 4; bu += c.G) hgrn_mfma<false>(c, l, bu);
}

template <bool FIXED>
__device__ __forceinline__ void attn_unit(const Ctx& c_, int bh, int qt, float negM) { const Ctx c = fresh(c_);
    const bf16_t* Qg = c.w<bf16_t>(WS_Q) + (size_t)bh * SEQ * 96; const bf16_t* Kg = c.w<bf16_t>(WS_K) + (size_t)bh * SEQ * 96; const bf16_t* Vg = c.w<bf16_t>(WS_VT) + (size_t)bh * 64 * SEQ;
    constexpr int KROW = 104, VROW = 72, KB = 64 * KROW * 2, VB = 64 * VROW * 2;
    const int l31 = c.lane & 31, hi = c.lane >> 5, qrow = qt * 256 + c.wid * 32 + l31;
    bf16x8 qf[6];
#pragma unroll
    for (int ks = 0; ks < 6; ++ks) qf[ks] = *(const bf16x8*)(Qg + (size_t)qrow * 96 + ks * 16 + hi * 8);
    f32x16 o0, o1;
#pragma unroll
    for (int r = 0; r < 16; ++r) { o0[r] = 0.f; o1[r] = 0.f; }
    float mrun = -INFINITY, lsum = 0.f; f32x2 lsum2 = {0.f, 0.f};
    const int nkt = 4 * (qt + 1), mylast = 4 * qt + (c.wid >> 1);
    const int kr0 = c.tid / 12, kc0 = c.tid % 12, kr1 = (c.tid + 512) / 12, kc1 = (c.tid + 512) % 12, vr = c.tid >> 3, vc = c.tid & 7;
    u32x4 sk0, sk1, sv;
    auto gload = [&](int kt) { sk0 = *(const u32x4*)(Kg + (size_t)(kt * 64 + kr0) * 96 + kc0 * 8); if (c.tid < 256) sk1 = *(const u32x4*)(Kg + (size_t)(kt * 64 + kr1) * 96 + kc1 * 8);
                               sv = *(const u32x4*)(Vg + (size_t)vr * SEQ + kt * 64 + vc * 8); };
    auto lstore = [&](int buf) { unsigned char* kb = c.lds + buf * (KB + VB); unsigned char* vb = kb + KB;
                                 *(u32x4*)(kb + (kr0 * KROW + kc0 * 8) * 2) = sk0; if (c.tid < 256) *(u32x4*)(kb + (kr1 * KROW + kc1 * 8) * 2) = sk1; *(u32x4*)(vb + (vr * VROW + vc * 8) * 2) = sv; };
    gload(0); lstore(0); __syncthreads();
    auto tile = [&](const int kt, auto masked) {
            const bf16_t* kb = (const bf16_t*)(c.lds + (kt & 1) * (KB + VB)); const bf16_t* vb = (const bf16_t*)(c.lds + (kt & 1) * (KB + VB) + KB);
            f32x16 s0, s1;
#pragma unroll
            for (int r = 0; r < 16; ++r) { s0[r] = FIXED ? negM : 0.f; s1[r] = FIXED ? negM : 0.f; }
#pragma unroll
            for (int ks = 0; ks < 6; ++ks) { const bf16x8 k0 = *(const bf16x8*)(kb + l31 * KROW + ks * 16 + hi * 8), k1 = *(const bf16x8*)(kb + (32 + l31) * KROW + ks * 16 + hi * 8);
                s0 = MFMA32(k0, qf[ks], s0); s1 = MFMA32(k1, qf[ks], s1); }
            if constexpr (decltype(masked)::value) {
#pragma unroll
                for (int r = 0; r < 16; ++r) { const int key = kt * 64 + (r & 3) + 8 * (r >> 2) + 4 * hi; if (key > qrow) s0[r] = -INFINITY; if (key + 32 > qrow) s1[r] = -INFINITY; } }
            if constexpr (FIXED) {
#pragma unroll
                for (int r = 0; r < 16; ++r) { s0[r] = __builtin_amdgcn_exp2f(s0[r]); s1[r] = __builtin_amdgcn_exp2f(s1[r]); }
#pragma unroll
                for (int r = 0; r < 16; r += 2) { lsum2 += (f32x2){s0[r], s0[r + 1]}; lsum2 += (f32x2){s1[r], s1[r + 1]}; }
            } else {
            float mx = s0[0];
#pragma unroll
            for (int r = 1; r < 16; ++r) mx = fmaxf(mx, s0[r]);
#pragma unroll
            for (int r = 0; r < 16; ++r) mx = fmaxf(mx, s1[r]);
            mx = fmaxf(mx, __shfl_xor(mx, 32));
            const float mnew = fmaxf(mrun, mx), alpha = __builtin_amdgcn_exp2f(mrun - mnew); mrun = mnew;
            float ps = 0.f;
#pragma unroll
            for (int r = 0; r < 16; ++r) { s0[r] = __builtin_amdgcn_exp2f(s0[r] - mnew); s1[r] = __builtin_amdgcn_exp2f(s1[r] - mnew); ps += s0[r] + s1[r]; }
            lsum = lsum * alpha + ps;
#pragma unroll
            for (int r = 0; r < 16; ++r) { o0[r] *= alpha; o1[r] *= alpha; }
            }
#pragma unroll
            for (int kf = 0; kf < 2; ++kf)
#pragma unroll
                for (int s = 0; s < 2; ++s) { const f32x16& sx = kf ? s1 : s0; u32x4 pw; pw.x = cvt_pk_bf16(sx[8 * s], sx[8 * s + 1]); pw.y = cvt_pk_bf16(sx[8 * s + 2], sx[8 * s + 3]); pw.z = cvt_pk_bf16(sx[8 * s + 4], sx[8 * s + 5]); pw.w = cvt_pk_bf16(sx[8 * s + 6], sx[8 * s + 7]);
                    const bf16x8 pf = __builtin_bit_cast(bf16x8, pw); const int kcol = kf * 32 + 16 * s + 4 * hi;
                    const s16x4 a0 = *(const s16x4*)(vb + l31 * VROW + kcol), a1 = *(const s16x4*)(vb + l31 * VROW + kcol + 8), b0 = *(const s16x4*)(vb + (32 + l31) * VROW + kcol), b1 = *(const s16x4*)(vb + (32 + l31) * VROW + kcol + 8);
                    const bf16x8 v0 = (bf16x8){a0[0], a0[1], a0[2], a0[3], a1[0], a1[1], a1[2], a1[3]}, v1 = (bf16x8){b0[0], b0[1], b0[2], b0[3], b1[0], b1[1], b1[2], b1[3]};
                    o0 = MFMA32(v0, pf, o0); o1 = MFMA32(v1, pf, o1); }
            };
    int kt = 0;
    for (; kt < mylast; ++kt) { gload(kt + 1); tile(kt, std::false_type{}); lstore((kt + 1) & 1); __syncthreads(); }
    { if (kt + 1 < nkt) gload(kt + 1); tile(kt, std::true_type{}); if (kt + 1 < nkt) lstore((kt + 1) & 1); __syncthreads(); ++kt; }
    for (; kt < nkt; ++kt) { if (kt + 1 < nkt) { gload(kt + 1); lstore((kt + 1) & 1); } __syncthreads(); }
    if constexpr (FIXED) lsum = lsum2[0] + lsum2[1];
    lsum += __shfl_xor(lsum, 32); const float rl = 1.0f / lsum;
    const int b = bh >> 2, h = bh & 3; bf16_t* yo = c.w<bf16_t>(WS_YB) + (size_t)(b * SEQ + qrow) * 1024 + h * 64;
#pragma unroll
    for (int g = 0; g < 4; ++g) { const int dv = 8 * g + 4 * hi; u32x2 w0, w1;
        w0.x = cvt_pk_bf16(o0[4 * g] * rl, o0[4 * g + 1] * rl); w0.y = cvt_pk_bf16(o0[4 * g + 2] * rl, o0[4 * g + 3] * rl); *(u32x2*)(yo + dv) = w0;
        w1.x = cvt_pk_bf16(o1[4 * g] * rl, o1[4 * g + 1] * rl); w1.y = cvt_pk_bf16(o1[4 * g + 2] * rl, o1[4 * g + 3] * rl); *(u32x2*)(yo + 32 + dv) = w1; }
    __syncthreads();
}
template <bool FIXED>
__device__ __forceinline__ void attn_units(const Ctx& c, float negM) {
    { const int NU = NBH * (NQT / 2);
      if ((c.G & 7) == 0) { const int per = (NU + 7) / 8, x = c.blk & 7, G8 = c.G >> 3;
          for (int j = c.blk >> 3; j < per; j += G8) { const int pu = x * per + j; if (pu < NU) { const int bh = pu / (NQT / 2), p = pu % (NQT / 2); attn_unit<FIXED>(c, bh, NQT - 1 - p, negM); attn_unit<FIXED>(c, bh, p, negM); } } }
      else for (int pu = c.blk; pu < NU; pu += c.G) { const int bh = pu / (NQT / 2), p = pu % (NQT / 2); attn_unit<FIXED>(c, bh, NQT - 1 - p, negM); attn_unit<FIXED>(c, bh, p, negM); } }
}
__device__ __forceinline__ void ph_attn(const Ctx& c, int l) {
    hgrn_carry(c, l);
    {
        const float* qg = c.inf(I_QG) + l * 96; const float* kg = c.inf(I_KG) + l * 96;
        int ln = c.lane; LAUNDER_V(ln);
        float gq = fmaxf(fabsf(qg[ln]), fabsf(qg[32 + (ln & 63)])), gk = fmaxf(fabsf(kg[ln]), fabsf(kg[32 + (ln & 63)]));
#pragma unroll
        for (int o = 1; o < 64; o <<= 1) { gq = fmaxf(gq, __shfl_xor(gq, o)); gk = fmaxf(gk, __shfl_xor(gk, o)); }
        const float M = 9.797958971132712f * 1.44269504089f * 1.02f * gq * gk;
        if (M <= 60.0f) attn_units<true>(c, -M); else attn_units<false>(c, 0.f); }
    hgrn_wait_carry(c, l);
    for (int bu = c.blk; bu < NBH * NCH / 4; bu += c.G) hgrn_mfma<true>(c, l, bu, l + 1);
}

__device__ __forceinline__ void ph_router(const Ctx& c_, int l, int cnt_off = 0) { const Ctx c = fresh(c_);
    bf16_t* Whi = (bf16_t*)c.lds; bf16_t* Wlo = (bf16_t*)(c.lds + 73728); float* Llog = (float*)(c.lds + 147456) + c.wid * 288; float* Lcb = (float*)(c.lds + 156672);
    int* Le = (int*)(c.lds + 156672 + 256); float* Lw = (float*)(c.lds + 156672 + 256 + 1024); int* Lr = (int*)(c.lds + 156672 + 256 + 2048); int* Lcnt = (int*)(c.lds + 156672 + 256 + 3072); int* Lbase = Lcnt + 32;
    const float* rwt = c.w<float>(WS_RWT + (size_t)(l & 1) * WSET);
    const float* rgb = c.inf(I_RGB) + l * 4; const float* reb = c.inf(I_REB) + l * 32;
    const bf16_t* x = c.w<bf16_t>(WS_XB); const float* gn = c.inf(I_N2G) + l * 1024; const float* mod = c.w<float>(WS_MOD) + (size_t)l * NB * 6144; bf16_t* ha = c.w<bf16_t>(WS_HA);
    unsigned* cnt = (unsigned*)(c.ws + WS_CTL + CTL_CNT) + l * 32 + cnt_off;
    int* asge = c.w<int>(WS_ASGE); int* asgr = c.w<int>(WS_ASGR); float* asgw = c.w<float>(WS_ASGW);
    const int fr = c.lane & 15, fq = c.lane >> 4;
    int staged_b = -1;
    for (int u = c.blk; u < NTOK / 128; u += c.G) {
        const int b = (u * 128) / SEQ; const float* sh = mod + b * 6144 + 3072; const float* sc = sh + 1024;
        __syncthreads();
        if (b != staged_b) { staged_b = b;
            for (int q = c.tid; q < 36 * 128; q += 512) { const int n = q >> 7, ch = q & 127, k0 = ch * 8; float hi8[8], lo8[8];
#pragma unroll
                for (int j = 0; j < 8; ++j) { const float w = rwt[n * 1024 + k0 + j] * gn[k0 + j] * (1.0f + sc[k0 + j]); const float h = bf2f((bf16_t)f2bf_bits(w)); hi8[j] = h; lo8[j] = w - h; }
                const int pc = (ch ^ (n & 15)) * 8; *(u32x4*)(Whi + n * 1024 + pc) = pk8(hi8); *(u32x4*)(Wlo + n * 1024 + pc) = pk8(lo8); }
            for (int g = c.wid; g < 36; g += 8) { float s = 0.f;
#pragma unroll
                for (int i = 0; i < 4; ++i) { const f32x4 w = *(const f32x4*)(rwt + g * 1024 + i * 256 + c.lane * 4), s4 = *(const f32x4*)(sh + i * 256 + c.lane * 4); s += w[0] * s4[0] + w[1] * s4[1] + w[2] * s4[2] + w[3] * s4[3]; }
                s = wave_sum(s); if (c.lane == 0) Lcb[g] = s + (g < 4 ? rgb[g] : reb[g - 4]); } }
        if (c.tid < 32) Lcnt[c.tid] = 0;
        __syncthreads();
        const int rowb = u * 128 + c.wid * 16; const bf16_t* xr = x + (size_t)(rowb + fr) * 1024 + 8 * fq;
        f32x4 acc[3] = {{0.f, 0.f, 0.f, 0.f}, {0.f, 0.f, 0.f, 0.f}, {0.f, 0.f, 0.f, 0.f}}; float ssp = 0.f;
#pragma unroll 8
        for (int ks = 0; ks < 32; ++ks) { const u32x4 hw = *(const u32x4*)(xr + 32 * ks);
            const unsigned hws[4] = {hw.x, hw.y, hw.z, hw.w};
#pragma unroll
            for (int j = 0; j < 4; ++j) { const float a = bflo(hws[j]), b = bfhi(hws[j]); ssp += a * a + b * b; }
            const bf16x8 ah = __builtin_bit_cast(bf16x8, hw);
            const int ch = 4 * ks + fq;
#pragma unroll
            for (int nf = 0; nf < 3; ++nf) { const int n = 16 * nf + fr; bf16x8 bh = {0, 0, 0, 0, 0, 0, 0, 0}, bl = bh;
                if (nf < 2 || fr < 4) { const int pc = (ch ^ (n & 15)) * 8; bh = *(const bf16x8*)(Whi + n * 1024 + pc); bl = *(const bf16x8*)(Wlo + n * 1024 + pc); }
                acc[nf] = MFMA16(ah, bh, acc[nf]); acc[nf] = MFMA16(ah, bl, acc[nf]); } }
        ssp += __shfl_xor(ssp, 16); ssp += __shfl_xor(ssp, 32);
        const float rinv = frsqrt(ssp * (1.0f / 1024.0f) + EPS);
        float rj[4];
#pragma unroll
        for (int j = 0; j < 4; ++j) rj[j] = __shfl(rinv, fq * 4 + j);
#pragma unroll
        for (int half = 0; half < 2; ++half) {
            if ((fq >> 1) == half) {
#pragma unroll
                for (int nf = 0; nf < 3; ++nf) { const int col = 16 * nf + fr; if (col < 36) {
#pragma unroll
                    for (int j = 0; j < 4; ++j) Llog[((fq & 1) * 4 + j) * 36 + col] = acc[nf][j] * rj[j] + Lcb[col]; } } }
            __builtin_amdgcn_wave_barrier();
            if (c.lane < 8) { const float* lg = Llog + c.lane * 36; const int rl = c.wid * 16 + half * 8 + c.lane;
                int gi = 0; float gm = lg[0];
#pragma unroll
                for (int g = 1; g < 4; ++g) { const float t = lg[g]; if (t > gm) { gm = t; gi = g; } }
                float den = 0.f;
#pragma unroll
                for (int g = 0; g < 4; ++g) den += expf(lg[g] - gm);
                const float gw = 1.0f / den;
                float e1 = -INFINITY, e2 = -INFINITY; int i1 = 0, i2 = 0;
#pragma unroll
                for (int j = 0; j < 8; ++j) { const float t = lg[4 + gi * 8 + j]; if (t > e1) { e2 = e1; i2 = i1; e1 = t; i1 = j; } else if (t > e2) { e2 = t; i2 = j; } }
                const float p2 = expf(e2 - e1), w1 = gw / (1.0f + p2), w2 = gw * p2 / (1.0f + p2);
                const int ea = gi * 8 + i1, eb = gi * 8 + i2; Le[rl * 2] = ea; Le[rl * 2 + 1] = eb; Lw[rl * 2] = w1; Lw[rl * 2 + 1] = w2;
                Lr[rl * 2] = atomicAdd(&Lcnt[ea], 1); Lr[rl * 2 + 1] = atomicAdd(&Lcnt[eb], 1); }
            __builtin_amdgcn_wave_barrier();
        }
#pragma unroll 8
        for (int ks = 0; ks < 32; ++ks) { const int k0 = 32 * ks + 8 * fq; const u32x4 xw = *(const u32x4*)(xr + 32 * ks); const f32x4 xa = {bflo(xw.x), bfhi(xw.x), bflo(xw.y), bfhi(xw.y)}, xb = {bflo(xw.z), bfhi(xw.z), bflo(xw.w), bfhi(xw.w)};
            const f32x4 ga = *(const f32x4*)(gn + k0) * (*(const f32x4*)(sc + k0) + 1.0f), gb = *(const f32x4*)(gn + k0 + 4) * (*(const f32x4*)(sc + k0 + 4) + 1.0f);
            const f32x4 ha4 = xa * rinv * ga + *(const f32x4*)(sh + k0), hb4 = xb * rinv * gb + *(const f32x4*)(sh + k0 + 4);
            u32x4 o; o.x = cvt_pk_bf16(ha4[0], ha4[1]); o.y = cvt_pk_bf16(ha4[2], ha4[3]); o.z = cvt_pk_bf16(hb4[0], hb4[1]); o.w = cvt_pk_bf16(hb4[2], hb4[3]);
            *(u32x4*)(ha + (size_t)(rowb + fr) * 1024 + k0) = o; }
        __syncthreads();
        if (c.tid < 32) Lbase[c.tid] = (int)__hip_atomic_fetch_add(&cnt[c.tid], (unsigned)Lcnt[c.tid], __ATOMIC_RELAXED, __HIP_MEMORY_SCOPE_AGENT);
        __syncthreads();
        if (c.tid < 256) { const int a = u * 256 + c.tid, e = Le[c.tid]; asge[a] = e; asgr[a] = Lbase[e] + Lr[c.tid]; asgw[a] = Lw[c.tid]; }
    }
    __syncthreads();
}
__device__ __forceinline__ void ph_gather(const Ctx& c_, int l) { const Ctx c = fresh(c_);
    int* Lps = (int*)c.lds; int* Lcn = Lps + 40;
    unsigned* cnt = (unsigned*)(c.ws + WS_CTL + CTL_CNT) + l * 32;
    if (c.tid < 32) Lcn[c.tid] = (int)__hip_atomic_load(&cnt[c.tid], __ATOMIC_RELAXED, __HIP_MEMORY_SCOPE_AGENT);
    __syncthreads();
    if (c.tid == 0) { int acc = 0; for (int e = 0; e < 32; ++e) { Lps[e] = acc; acc += (Lcn[e] + 255) / 256 * 256; } Lps[32] = acc; }
    __syncthreads();
    int* rowtok = c.w<int>(WS_ROWTOK); float* roww = c.w<float>(WS_ROWW);
    if (c.blk == 0) { int* tile = c.w<int>(WS_TILE); if (c.tid == 0) tile[0] = Lps[32] / 256;
        for (int e = c.tid; e < 32; e += 512) for (int t = Lps[e] / 256; t < Lps[e + 1] / 256; ++t) tile[1 + t] = e; }
    for (int e = c.blk; e < 32; e += c.G) for (int r = Lps[e] + Lcn[e] + c.tid; r < Lps[e + 1]; r += 512) rowtok[r] = -1;
    const int* asge = c.w<int>(WS_ASGE); const int* asgr = c.w<int>(WS_ASGR); const float* asgw = c.w<float>(WS_ASGW);
    for (int a = c.blk * 512 + c.tid; a < NTOK * 2; a += c.G * 512) { const int dest = Lps[asge[a]] + asgr[a]; rowtok[dest] = a; roww[dest] = asgw[a]; }
}
__device__ __forceinline__ void ph_final(const Ctx& c_) { const Ctx c = fresh(c_);
    float* out = c.a->out; const bf16_t* y1 = c.w<bf16_t>(WS_Y1);
    const bf16_t* xb = c.w<bf16_t>(WS_XB);
    for (size_t e = (size_t)c.blk * 512 + c.tid; e < (size_t)NTOK * 128; e += (size_t)c.G * 512) { const u32x4 y = *(const u32x4*)(y1 + e * 8), xw = *(const u32x4*)(xb + e * 8);
        *(f32x4*)(out + e * 8) = (f32x4){bflo(xw.x), bfhi(xw.x), bflo(xw.y), bfhi(xw.y)} + (f32x4){bflo(y.x), bfhi(y.x), bflo(y.y), bfhi(y.y)};
        *(f32x4*)(out + e * 8 + 4) = (f32x4){bflo(xw.z), bfhi(xw.z), bflo(xw.w), bfhi(xw.w)} + (f32x4){bflo(y.z), bfhi(y.z), bflo(y.w), bfhi(y.w)}; }
}

constexpr int PH_PER_LAYER = 9, N_PHASES = 2 + PH_PER_LAYER * NL + 1;
__global__ void __launch_bounds__(512, 2) mk_fwd(Args args) {
#ifdef EMU
    unsigned char* lds = emu_lds();
#else
    extern __shared__ __attribute__((aligned(16))) unsigned char lds[];
#endif
    Ctx c; c.a = &args; c.ws = args.ws; c.lds = lds; c.tid = threadIdx.x; c.wid = __builtin_amdgcn_readfirstlane(c.tid >> 6); c.lane = c.tid & 63; c.G = gridDim.x; c.blk = blockIdx.x;
    if (c.tid == 0) *(uint4*)(lds + LDS_XB) = make_uint4(0u, 0u, 0u, 0u);
    __syncthreads();
    XcdBarrier bar; bar.bar = (unsigned*)(args.ws + WS_CTL); bar.x = 0; bar.st = (volatile LAS unsigned*)(lds + LDS_XB);
    if (args.ph_hi - args.ph_lo > 1) bar = xcd_barrier_post((unsigned*)(args.ws + WS_CTL), (volatile LAS unsigned*)(lds + LDS_XB));
    int ph = 0;
#ifndef PHMASK
#define PHMASK 0xFFFFF
#endif
#define PHASE(K, ...) do { if (ph >= args.ph_lo && ph < args.ph_hi) { if constexpr ((PHMASK >> K) & 1) { __VA_ARGS__; } if (ph + 1 < args.ph_hi) xcd_barrier(bar); } ++ph; } while (0)
    PHASE(0, ph_prologue0(c));
    PHASE(1, ph_prologue1(c));
    for (int l = 0; l < NL; ++l) {
        PHASE(2, if (l == 0) ph_cvt(c, 0); ph_normrows(c, l));
        PHASE(3, { pg8::Gemm g{c.w<bf16_t>(WS_HA), c.w<bf16_t>(WS_WIN + (size_t)(l & 1) * WSET), NTOK, ZP, 1024}; pg8::TailNarrowOrder S; S.init(NTOK, c.G, c.blk); pg8::EpiBf16 E{c.w<bf16_t>(WS_Z), ZP};
                pg8::gemm_phase<pg8::EpiBf16, pg8::TailNarrowOrder, true, true>((LAS unsigned char*)lds, g, S, E); });
        PHASE(4, ph_mixers(c, l));
        PHASE(5, ph_attn(c, l));
        PHASE(6, { pg8::Gemm g{c.w<bf16_t>(WS_YB), c.w<bf16_t>(WS_WOUT + (size_t)(l & 1) * WSET), NTOK, 1024, 1024}; pg8::StaticOrder S; S.init(NTOK, 1024, c.G, c.blk);
                pg8::EpiResid E{(l == 0) ? c.inf(I_X) : (const float*)nullptr, c.w<bf16_t>(WS_XB), c.w<bf16_t>(WS_XB), c.w<float>(WS_MOD) + (size_t)l * NB * 6144 + 2048, 6144, SEQ, c.w<bf16_t>(WS_Y1)};
                pg8::gemm_phase<pg8::EpiResid, pg8::StaticOrder, true, true>((LAS unsigned char*)lds, g, S, E); });
        PHASE(7, ph_router(c, l));
        PHASE(8, ph_gather(c, l));
        PHASE(9, { pg8::Gemm g{c.w<bf16_t>(WS_HA), c.w<bf16_t>(WS_WUP + (size_t)(l & 1) * WSET), NR, 32 * 1024, 1024}; pg8::MoeOrder S{c.w<int>(WS_TILE), c.G, c.blk}; pg8::EpiSwiglu E{c.w<bf16_t>(WS_Q)};
                pg8::gemm_phase<pg8::EpiSwiglu, pg8::MoeOrder, true, true, true>((LAS unsigned char*)lds, g, S, E, c.w<int>(WS_ROWTOK)); });
        PHASE(10, { pg8::Gemm g{c.w<bf16_t>(WS_Q), c.w<bf16_t>(WS_WDN + (size_t)(l & 1) * WSET), NR, 32 * 1024, 512}; pg8::MoeOrder S{c.w<int>(WS_TILE), c.G, c.blk};
                pg8::EpiDown E{c.w<int>(WS_ROWTOK), c.w<float>(WS_ROWW), c.w<bf16_t>(WS_XB), c.w<bf16_t>(WS_Y1), c.w<float>(WS_MOD) + (size_t)l * NB * 6144 + 5120, 6144, SEQ};
                pg8::gemm_phase<pg8::EpiDown, pg8::MoeOrder, true, true>((LAS unsigned char*)lds, g, S, E); });
    }
    PHASE(11, ph_final(c));
#undef PHASE
}

extern "C" void kernel_launch(void* const* d_in, const int* in_sizes, int n_in, void* d_out, int out_size, void* d_ws, size_t ws_size, hipStream_t stream) {
    static int grid = 0;
    if (grid == 0) {
        if (n_in != 30 || out_size != NTOK * 1024 || ws_size < WS_END) { fprintf(stderr, "kernel_launch: shape/workspace mismatch (n_in %d out %d ws %zu need %zu)\n", n_in, out_size, ws_size, (size_t)WS_END); grid = -1; return; }
        int dev = 0, cus = 0;
        if (hipGetDevice(&dev) != hipSuccess || hipDeviceGetAttribute(&cus, hipDeviceAttributeMultiprocessorCount, dev) != hipSuccess) { grid = -1; return; }
        if (hipFuncSetAttribute((const void*)mk_fwd, hipFuncAttributeMaxDynamicSharedMemorySize, LDS_BYTES) != hipSuccess) { fprintf(stderr, "kernel_launch: hipFuncSetAttribute failed\n"); grid = -1; return; }
        int per_cu = 0; (void)hipOccupancyMaxActiveBlocksPerMultiprocessor(&per_cu, (const void*)mk_fwd, 512, LDS_BYTES);
        if (per_cu < 1) fprintf(stderr, "kernel_launch: occupancy query says %d blocks per CU\n", per_cu);
        grid = cus;
    }
    if (grid < 0) return;
    (void)hipMemsetAsync((char*)d_ws + WS_CTL, 0, CTL_BYTES, stream);
    Args a{};
    for (int i = 0; i < 30; ++i) a.in[i] = d_in[i];
    a.out = (float*)d_out; a.ws = (unsigned char*)d_ws;
#if MK_SPLIT
    for (int p = 0; p < N_PHASES; ++p) { a.ph_lo = p; a.ph_hi = p + 1;
#else
    { a.ph_lo = 0; a.ph_hi = N_PHASES;
#endif
#ifdef EMU
        EMU_LAUNCH(mk_fwd, grid, 512, LDS_BYTES, stream, a);
#else
        hipLaunchKernelGGL(mk_fwd, dim3(grid), dim3(512), LDS_BYTES, stream, a);
#endif
    }
}
```

```cpp
#include <hip/hip_runtime.h>
#include <cstdio>
#include <cstdint>
#include <type_traits>

#ifndef CFG_B
#define CFG_B 4
#endif
#ifndef CFG_S
#define CFG_S 8192
#endif
#ifndef CFG_L
#define CFG_L 4
#endif
#ifndef MK_SPLIT
#define MK_SPLIT 0
#endif

#ifdef EMU
#define ASMV(...) ((void)0)
#define LAS
#define LAUNDER_V(x) ((void)0)
#define LAUNDER_S(x) ((void)0)
#else
#define ASMV(...) asm volatile(__VA_ARGS__)
#define LAS __attribute__((address_space(3)))
#define LAUNDER_V(x) asm volatile("" : "+v"(x))
#define LAUNDER_S(x) asm volatile("" : "+s"(x))
#endif

typedef unsigned short bf16_t;
typedef short bf16x8 __attribute__((ext_vector_type(8)));
typedef short s16x4 __attribute__((ext_vector_type(4)));
typedef float f32x2 __attribute__((ext_vector_type(2)));
typedef float f32x4 __attribute__((ext_vector_type(4)));
typedef float f32x16 __attribute__((ext_vector_type(16)));
typedef unsigned u32x4 __attribute__((ext_vector_type(4)));
typedef unsigned u32x2 __attribute__((ext_vector_type(2)));

__device__ __forceinline__ float bf2f(bf16_t h) { return __builtin_bit_cast(float, (unsigned)h << 16); }
__device__ __forceinline__ float bflo(unsigned w) { return __builtin_bit_cast(float, w << 16); }
__device__ __forceinline__ float bfhi(unsigned w) { return __builtin_bit_cast(float, w & 0xffff0000u); }
__device__ __forceinline__ unsigned f2bf_bits(float f) { unsigned u = __builtin_bit_cast(unsigned, f); u += 0x7fffu + ((u >> 16) & 1u); return u >> 16; }
#ifdef EMU
__device__ __forceinline__ unsigned cvt_pk_bf16(float lo, float hi) { return f2bf_bits(lo) | (f2bf_bits(hi) << 16); }
__device__ __forceinline__ unsigned cvt_pk_bf16_pinned(float lo, float hi) { return f2bf_bits(lo) | (f2bf_bits(hi) << 16); }
#else
typedef __bf16 bf16v2_t __attribute__((ext_vector_type(2)));
typedef float f32v2_t __attribute__((ext_vector_type(2)));
__device__ __forceinline__ unsigned cvt_pk_bf16(float lo, float hi) { const bf16v2_t r = __builtin_convertvector((f32v2_t){lo, hi}, bf16v2_t); return __builtin_bit_cast(unsigned, r); }
__device__ __forceinline__ unsigned cvt_pk_bf16_pinned(float lo, float hi) { unsigned r; asm volatile("v_cvt_pk_bf16_f32 %0, %1, %2\n\ts_nop 1" : "=v"(r) : "v"(lo), "v"(hi)); return r; }
#endif
__device__ __forceinline__ float fast_exp(float x) { return __builtin_amdgcn_exp2f(x * 1.44269504089f); }
__device__ __forceinline__ float fsigmoid(float x) { return __builtin_amdgcn_rcpf(1.0f + fast_exp(-x)); }
__device__ __forceinline__ float fsilu(float x) { return x * fsigmoid(x); }
__device__ __forceinline__ float frsqrt(float x) { return __builtin_amdgcn_rsqf(x); }
#ifdef EMU
__device__ __forceinline__ float wave_sum(float v) {
#pragma unroll
    for (int m = 32; m >= 1; m >>= 1) v += __shfl_xor(v, m);
    return v;
}
#else
template <int CTRL, int ROW_MASK> __device__ __forceinline__ float dpp_t(float v) { return __builtin_bit_cast(float, __builtin_amdgcn_update_dpp(0, __builtin_bit_cast(int, v), CTRL, ROW_MASK, 0xF, false)); }
#define dpp_f(v, ctrl, rm) dpp_t<ctrl, rm>(v)
__device__ __forceinline__ float wave_sum(float v) {
    v += dpp_f(v, 0xB1, 0xF);
    v += dpp_f(v, 0x4E, 0xF);
    v += dpp_f(v, 0x141, 0xF);
    v += dpp_f(v, 0x140, 0xF);
    v += dpp_f(v, 0x142, 0xA);
    v += dpp_f(v, 0x143, 0xC);
    return __builtin_bit_cast(float, __builtin_amdgcn_readlane(__builtin_bit_cast(int, v), 63));
}
__device__ __forceinline__ float half_sum(float v, int hi) {
    v += dpp_f(v, 0xB1, 0xF); v += dpp_f(v, 0x4E, 0xF); v += dpp_f(v, 0x141, 0xF); v += dpp_f(v, 0x140, 0xF);
    v += dpp_f(v, 0x142, 0xA);
    const float a = __builtin_bit_cast(float, __builtin_amdgcn_readlane(__builtin_bit_cast(int, v), 31)), b = __builtin_bit_cast(float, __builtin_amdgcn_readlane(__builtin_bit_cast(int, v), 63));
    return hi ? b : a;
}
#endif
#ifdef EMU
__device__ __forceinline__ float half_sum(float v, int) {
#pragma unroll
    for (int m = 1; m < 32; m <<= 1) v += __shfl_xor(v, m);
    return v;
}
#endif

namespace pg8 {
#define PG8_LAS LAS
constexpr int BM = 256, BK = 64, HALF = 128, HTB = HALF * BK * 2  , STAGE_BYTES = 8 * HTB, NXCD = 8, WGM = 8;

__host__ __device__ __forceinline__ int lds_byte(int r, int c) { const int st = (r >> 4) * 2 + (c >> 5), rr = r & 15, cc = c & 31, ob = rr * 64 + cc * 2; return st * 1024 + (ob ^ (((ob >> 9) & 1) << 5)); }
__host__ __device__ __forceinline__ void stage_rc(int b, int& R, int& C) { const int st = b / 1024, sb = b % 1024, swz = sb ^ (((sb >> 9) & 1) << 5); R = (st >> 1) * 16 + swz / 64; C = (st & 1) * 32 + (swz % 64) / 2; }
__host__ __device__ __forceinline__ int perm32(int rho) { const int n = rho >> 4, i = rho & 15; return 8 * (i >> 2) + 4 * n + (i & 3); }

struct Unit { int pm, pn, narrow, rbase, nvalid; };
struct Gemm { const bf16_t* A; const bf16_t* Bt; int M, N, K; };

struct StaticOrder {
    static constexpr bool HAS_NARROW = false;
    int nM, nN, nwg, G, c;
    __host__ __device__ void init(int M, int N, int G_, int c_) { nM = M / BM; nN = N / BM; nwg = nM * nN; G = G_; c = c_; }
    __host__ __device__ bool next(int i, Unit& u) const {
        const long L = (long)i * G + c; if (L >= nwg) return false;
        int wgid = (int)L; { const int q = nwg / NXCD, r = nwg % NXCD, xcd = wgid % NXCD, off = wgid / NXCD; wgid = (xcd < r ? xcd * (q + 1) : r * (q + 1) + (xcd - r) * q) + off; }
        const int nig = WGM * nN, gid = wgid / nig, fm = gid * WGM, gsz = (nM - fm) < WGM ? (nM - fm) : WGM;
        u.pm = fm + ((wgid % nig) % gsz); u.pn = (wgid % nig) / gsz; return true;
    }
    __device__ __forceinline__ void a_ready(const Unit&) const {}
    __device__ __forceinline__ void done(const Unit&) const {}
};
struct TailNarrowOrder {
    static constexpr bool HAS_NARROW = true;
    StaticOrder full; int nM, G, c;
    __host__ __device__ void init(int M, int G_, int c_) { nM = M / BM; G = G_; c = c_; full.init(M, 8 * BM, G_, c_); }
    __host__ __device__ bool next(int i, Unit& u) const { const long L = (long)i * G + c;
        if (L < full.nwg) { const bool ok = full.next(i, u); u.narrow = 0; return ok; }
        if (L >= full.nwg + nM) return false;
        u.pm = (int)(L - full.nwg); u.pn = 8; u.narrow = 1; return true; }
    __device__ __forceinline__ void a_ready(const Unit&) const {}
    __device__ __forceinline__ void done(const Unit&) const {}
};
template <class Epi, class Sched, bool ALIGN_EPI = false, bool SP2 = false, bool GATHER = false>
__device__ __forceinline__ void gemm_phase(PG8_LAS unsigned char* lds, const Gemm g, const Sched& S, const Epi& E, const int* rowmap = nullptr) {
    int tid = threadIdx.x; LAUNDER_V(tid); const int wid = __builtin_amdgcn_readfirstlane(tid >> 6), lane = tid & 63, wr = wid >> 2, wc = wid & 3, fr = lane & 15, fq = lane >> 4;
    const int K = g.K, nt = K / BK;
    unsigned voffA[2], voffB[2]; int RA[2], CA[2];
#pragma unroll
    for (int i = 0; i < 2; ++i) { int R, C; stage_rc(tid * 16 + i * 8192, R, C); const int Rb = Epi::PERM ? ((R & ~31) + perm32(R & 31)) : R;
        voffA[i] = (unsigned)(R * K + C) * 2u; voffB[i] = (unsigned)(Rb * K + C) * 2u; RA[i] = R; CA[i] = C; }
    const size_t kstep = (size_t)(BK * 2);
    const size_t hstep = (size_t)HALF * K * 2;
    const size_t tstep = 2 * hstep;
    const size_t hA = GATHER ? (size_t)0 : hstep;
    unsigned vA0[2], vA1[2], nA0[2], nA1[2];
    auto rows_of = [&](const Unit& u, unsigned (&o0)[2], unsigned (&o1)[2]) {
#pragma unroll
        for (int i = 0; i < 2; ++i) { if constexpr (GATHER) { int t0 = (RA[i] < u.nvalid) ? rowmap[u.rbase + RA[i]] : -1, t1 = (HALF + RA[i] < u.nvalid) ? rowmap[u.rbase + HALF + RA[i]] : -1; t0 = t0 < 0 ? 0 : (t0 >> 1); t1 = t1 < 0 ? 0 : (t1 >> 1);
                o0[i] = (unsigned)(t0 * K + CA[i]) * 2u; o1[i] = (unsigned)(t1 * K + CA[i]) * 2u; } else { o0[i] = voffA[i]; o1[i] = voffA[i]; } } };
    const unsigned ldsw = (unsigned)wid * 1024u;
    const int aoff = lds_byte(wr * 64 + fr, fq * 8), boff = lds_byte(wc * 32 + fr, fq * 8);
#define PG8_SA(b, h) (((b) * 2 + (h)) * HTB)
#define PG8_SB(b, h) ((4 + (b) * 2 + (h)) * HTB)
#define PG8_STAGE(bufoff, gbase, voff) do { _Pragma("unroll") for (int _i = 0; _i < 2; ++_i) \
        __builtin_amdgcn_global_load_lds((const unsigned*)((const char*)(gbase) + (voff)[_i]), (PG8_LAS unsigned*)(lds + (bufoff) + ldsw + _i * 8192), 16, 0, 0); } while (0)
#define PG8_LDA(dst, b, h) do { _Pragma("unroll") for (int m = 0; m < 4; ++m) _Pragma("unroll") for (int k = 0; k < 2; ++k) dst[m][k] = *(const PG8_LAS bf16x8*)(lds + PG8_SA(b, h) + aoff + m * 2048 + k * 1024); } while (0)
#define PG8_LDB(dst, b, h) do { _Pragma("unroll") for (int n = 0; n < 2; ++n) _Pragma("unroll") for (int k = 0; k < 2; ++k) dst[n][k] = *(const PG8_LAS bf16x8*)(lds + PG8_SB(b, h) + boff + n * 2048 + k * 1024); } while (0)
#define PG8_MMA(ai, bj, At, Bt) do { __builtin_amdgcn_s_setprio(1); _Pragma("unroll") for (int m = 0; m < 4; ++m) _Pragma("unroll") for (int n = 0; n < 2; ++n) _Pragma("unroll") for (int k = 0; k < 2; ++k) \
        acc[ai][bj][m][n] = __builtin_amdgcn_mfma_f32_16x16x32_bf16(Bt[n][k], At[m][k], acc[ai][bj][m][n], 0, 0, 0); __builtin_amdgcn_s_setprio(0); } while (0)
#define PG8_WAIT_V(n) ASMV("s_waitcnt vmcnt(" #n ")" ::: "memory")
#define PG8_WAIT_L(n) ASMV("s_waitcnt lgkmcnt(" #n ")" ::: "memory")
#define PG8_BAR __builtin_amdgcn_s_barrier()
#define PG8_SCHED __builtin_amdgcn_sched_barrier(0)
    Unit cur, nxt; int ui = 0;
    if (!S.next(0, cur)) return;
    f32x4 acc[2][2][4][2];
#pragma unroll
    for (int a = 0; a < 2; ++a)
#pragma unroll
        for (int b = 0; b < 2; ++b)
#pragma unroll
            for (int m = 0; m < 4; ++m)
#pragma unroll
                for (int n = 0; n < 2; ++n) acc[a][b][m][n] = (f32x4){0.f, 0.f, 0.f, 0.f};
    bf16x8 At[4][2], B0[2][2], B1[2][2];
    const char* cA = GATHER ? (const char*)g.A : (const char*)g.A + (size_t)cur.pm * tstep; rows_of(cur, vA0, vA1); const char* cB = (const char*)g.Bt + (size_t)cur.pn * tstep;
    S.a_ready(cur);
    if constexpr (SP2) {
        PG8_STAGE(PG8_SB(0, 0), cB, voffB); PG8_STAGE(PG8_SB(0, 1), cB + hstep, voffB); PG8_STAGE(PG8_SA(0, 0), cA, vA0); PG8_STAGE(PG8_SA(0, 1), cA + hA, vA1);
        if (wr == 1) PG8_BAR;
        PG8_WAIT_V(2); PG8_BAR;
        PG8_STAGE(PG8_SB(1, 0), cB + kstep, voffB); PG8_STAGE(PG8_SA(1, 0), cA + kstep, vA0); PG8_STAGE(PG8_SB(1, 1), cB + hstep + kstep, voffB);
        PG8_WAIT_V(6); PG8_BAR;
    } else {
        PG8_STAGE(PG8_SB(0, 0), cB, voffB); PG8_STAGE(PG8_SA(0, 0), cA, vA0); PG8_STAGE(PG8_SB(0, 1), cB + hstep, voffB); PG8_STAGE(PG8_SA(0, 1), cA + hA, vA1);
        if (wr == 1) PG8_BAR;
        PG8_WAIT_V(4); PG8_BAR;
        PG8_STAGE(PG8_SB(1, 0), cB + kstep, voffB); PG8_STAGE(PG8_SA(1, 0), cA + kstep, vA0); PG8_STAGE(PG8_SB(1, 1), cB + hstep + kstep, voffB);
        PG8_WAIT_V(6); PG8_BAR;
    }
    for (;;) {
        const bool has_next = S.next(ui + 1, nxt);
        const char* nA = GATHER ? (const char*)g.A : (has_next ? (const char*)g.A + (size_t)nxt.pm * tstep : cA);
        if (has_next) rows_of(nxt, nA0, nA1); else { nA0[0] = vA0[0]; nA0[1] = vA0[1]; nA1[0] = vA1[0]; nA1[1] = vA1[1]; } const char* nB = has_next ? (const char*)g.Bt + (size_t)nxt.pn * tstep : cB;
        for (int t = 0; t < nt; t += 2) {
            const bool last = (t == nt - 2);
            unsigned sA0[2], sA1[2];
#pragma unroll
            for (int i = 0; i < 2; ++i) { sA0[i] = last ? nA0[i] : vA0[i]; sA1[i] = last ? nA1[i] : vA1[i]; }
            const char* a1 = cA + (size_t)(t + 1) * kstep;
            const char* a2 = last ? nA : cA + (size_t)(t + 2) * kstep; const char* b2 = last ? nB : cB + (size_t)(t + 2) * kstep;
            const char* a3 = a2 + kstep; const char* b3 = b2 + kstep;
            if (last && has_next) S.a_ready(nxt);
            if constexpr (SP2) {
            PG8_LDB(B0, 0, 0); PG8_LDB(B1, 0, 1); PG8_SCHED; PG8_LDA(At, 0, 0); PG8_STAGE(PG8_SA(1, 1), a1 + hA, vA1);
            PG8_WAIT_V(8); PG8_WAIT_L(0); PG8_BAR; PG8_MMA(0, 0, At, B0); if (!Sched::HAS_NARROW || !cur.narrow) PG8_MMA(0, 1, At, B1); PG8_BAR; PG8_SCHED;
            PG8_LDA(At, 0, 1); PG8_STAGE(PG8_SB(0, 0), b2, voffB); PG8_STAGE(PG8_SB(0, 1), b2 + hstep, voffB); PG8_STAGE(PG8_SA(0, 0), a2, sA0);
            PG8_WAIT_V(8); PG8_WAIT_L(0); PG8_BAR; PG8_MMA(1, 0, At, B0); if (!Sched::HAS_NARROW || !cur.narrow) PG8_MMA(1, 1, At, B1); PG8_BAR; PG8_SCHED;
            PG8_LDB(B0, 1, 0); PG8_LDB(B1, 1, 1); PG8_SCHED; PG8_LDA(At, 1, 0); PG8_STAGE(PG8_SA(0, 1), a2 + hA, sA1);
            PG8_WAIT_V(8); PG8_WAIT_L(0); PG8_BAR; PG8_MMA(0, 0, At, B0); if (!Sched::HAS_NARROW || !cur.narrow) PG8_MMA(0, 1, At, B1); PG8_BAR; PG8_SCHED;
            PG8_LDA(At, 1, 1); PG8_STAGE(PG8_SB(1, 0), b3, voffB); PG8_STAGE(PG8_SB(1, 1), b3 + hstep, voffB); PG8_STAGE(PG8_SA(1, 0), a3, sA0);
            PG8_WAIT_V(8); PG8_WAIT_L(0); PG8_BAR; PG8_MMA(1, 0, At, B0); if (!Sched::HAS_NARROW || !cur.narrow) PG8_MMA(1, 1, At, B1); PG8_BAR; PG8_SCHED;
            } else {
            PG8_LDB(B0, 0, 0); PG8_SCHED; PG8_LDA(At, 0, 0); PG8_STAGE(PG8_SA(1, 1), a1 + hA, vA1);
            PG8_WAIT_L(8); PG8_BAR; PG8_WAIT_L(0); PG8_MMA(0, 0, At, B0); PG8_BAR; PG8_SCHED;
            PG8_LDB(B1, 0, 1); PG8_STAGE(PG8_SB(0, 0), b2, voffB);
            PG8_BAR; PG8_WAIT_L(0); if (!Sched::HAS_NARROW || !cur.narrow) PG8_MMA(0, 1, At, B1); PG8_BAR;
            PG8_LDA(At, 0, 1); PG8_STAGE(PG8_SA(0, 0), a2, sA0);
            PG8_BAR; PG8_WAIT_L(0); PG8_MMA(1, 0, At, B0); PG8_BAR; PG8_SCHED;
            PG8_STAGE(PG8_SB(0, 1), b2 + hstep, voffB);
            PG8_WAIT_V(6); PG8_BAR; if (!Sched::HAS_NARROW || !cur.narrow) PG8_MMA(1, 1, At, B1); PG8_BAR;
            PG8_LDB(B0, 1, 0); PG8_SCHED; PG8_LDA(At, 1, 0); PG8_STAGE(PG8_SA(0, 1), a2 + hA, sA1);
            PG8_WAIT_L(8); PG8_BAR; PG8_WAIT_L(0); PG8_MMA(0, 0, At, B0); PG8_BAR; PG8_SCHED;
            PG8_LDB(B1, 1, 1); PG8_STAGE(PG8_SB(1, 0), b3, voffB);
            PG8_BAR; PG8_WAIT_L(0); if (!Sched::HAS_NARROW || !cur.narrow) PG8_MMA(0, 1, At, B1); PG8_BAR;
            PG8_LDA(At, 1, 1); PG8_STAGE(PG8_SA(1, 0), a3, sA0);
            PG8_BAR; PG8_WAIT_L(0); PG8_MMA(1, 0, At, B0); PG8_BAR; PG8_SCHED;
            PG8_STAGE(PG8_SB(1, 1), b3 + hstep, voffB);
            PG8_WAIT_V(6); PG8_BAR; if (!Sched::HAS_NARROW || !cur.narrow) PG8_MMA(1, 1, At, B1); PG8_BAR;
            }
        }
        if constexpr (ALIGN_EPI) { if (wr == 0) PG8_BAR; }
        if constexpr (!Epi::AFTER_DRAIN) { E(acc, cur, wr, wc, fr, fq); S.done(cur); }
        if (!has_next) break;
#pragma unroll
        for (int a = 0; a < 2; ++a)
#pragma unroll
            for (int b = 0; b < 2; ++b)
#pragma unroll
                for (int m = 0; m < 4; ++m)
#pragma unroll
                    for (int n = 0; n < 2; ++n) acc[a][b][m][n] = (f32x4){0.f, 0.f, 0.f, 0.f};
        cur = nxt; cA = nA; cB = nB; ++ui; vA0[0] = nA0[0]; vA0[1] = nA0[1]; vA1[0] = nA1[0]; vA1[1] = nA1[1];
        if constexpr (ALIGN_EPI) { if (wr == 1) PG8_BAR; }
    }
    PG8_WAIT_V(0);
    if constexpr (!ALIGN_EPI) { if (wr == 0) PG8_BAR; }
    PG8_BAR;
    if constexpr (Epi::AFTER_DRAIN) { E.fused(acc, cur, wr, wc, fr, fq, lds, wid, lane); S.done(cur); }
#undef PG8_SA
#undef PG8_SB
#undef PG8_STAGE
#undef PG8_LDA
#undef PG8_LDB
#undef PG8_MMA
#undef PG8_WAIT_V
#undef PG8_WAIT_L
#undef PG8_BAR
#undef PG8_SCHED
}

struct EpiBf16 {
    static constexpr bool PERM = true, AFTER_DRAIN = false;
    bf16_t* O; int ldc;
    __device__ __forceinline__ void operator()(const f32x4 (&acc)[2][2][4][2], const Unit& u, int wr, int wc, int fr, int fq) const {
        const int row0 = u.pm * BM + wr * 64 + fr, col0 = u.pn * BM + wc * 32 + 8 * fq;
#pragma unroll
        for (int ai = 0; ai < 2; ++ai)
#pragma unroll
            for (int m = 0; m < 4; ++m) { bf16_t* rowp = O + (size_t)(row0 + ai * HALF + m * 16) * ldc + col0;
#pragma unroll
                for (int bj = 0; bj < 2; ++bj) { const f32x4 v0 = acc[ai][bj][m][0], v1 = acc[ai][bj][m][1];
                    u32x4 w; w.x = cvt_pk_bf16(v0[0], v0[1]); w.y = cvt_pk_bf16(v0[2], v0[3]); w.z = cvt_pk_bf16(v1[0], v1[1]); w.w = cvt_pk_bf16(v1[2], v1[3]);
                    *(u32x4*)(rowp + bj * HALF) = w; } }
    }
};
struct EpiResid {
    static constexpr bool PERM = true, AFTER_DRAIN = false;
    const float* xin; const bf16_t* xinb; bf16_t* xout; const float* gate; int gstride; int seq; const bf16_t* y1;
    __device__ __forceinline__ void operator()(const f32x4 (&acc)[2][2][4][2], const Unit& u, int wr, int wc, int fr, int fq) const {
        const int row0 = u.pm * BM + wr * 64 + fr, col0 = u.pn * BM + wc * 32 + 8 * fq;
#pragma unroll
        for (int ai = 0; ai < 2; ++ai)
#pragma unroll
            for (int m = 0; m < 4; ++m) { const int row = row0 + ai * HALF + m * 16; const float* gp = gate + (size_t)(row / seq) * gstride;
#pragma unroll
                for (int bj = 0; bj < 2; ++bj) { const int c = col0 + bj * HALF; const size_t o = (size_t)row * 1024 + c;
                    const f32x4 g0 = *(const f32x4*)(gp + c), g1 = *(const f32x4*)(gp + c + 4);
                    f32x4 x0, x1;
                    if (xin) { x0 = *(const f32x4*)(xin + o); x1 = *(const f32x4*)(xin + o + 4); }
                    else { const u32x4 xw = *(const u32x4*)(xinb + o), y = *(const u32x4*)(y1 + o);
                        x0 = (f32x4){bflo(xw.x), bfhi(xw.x), bflo(xw.y), bfhi(xw.y)} + (f32x4){bflo(y.x), bfhi(y.x), bflo(y.y), bfhi(y.y)};
                        x1 = (f32x4){bflo(xw.z), bfhi(xw.z), bflo(xw.w), bfhi(xw.w)} + (f32x4){bflo(y.z), bfhi(y.z), bflo(y.w), bfhi(y.w)}; }
                    x0 += g0 * acc[ai][bj][m][0]; x1 += g1 * acc[ai][bj][m][1];
                    u32x4 w; w.x = cvt_pk_bf16(x0[0], x0[1]); w.y = cvt_pk_bf16(x0[2], x0[3]); w.z = cvt_pk_bf16(x1[0], x1[1]); w.w = cvt_pk_bf16(x1[2], x1[3]);
                    *(u32x4*)(xout + o) = w; } }
    }
};
struct EpiSwiglu {
    static constexpr bool PERM = true, AFTER_DRAIN = false;
    bf16_t* HB;
    __device__ __forceinline__ void operator()(const f32x4 (&acc)[2][2][4][2], const Unit& u, int wr, int wc, int fr, int fq) const {
        const int row0 = u.pm * BM + wr * 64 + fr, col0 = (u.pn & 3) * 128 + wc * 32 + 8 * fq;
#pragma unroll
        for (int ai = 0; ai < 2; ++ai)
#pragma unroll
            for (int m = 0; m < 4; ++m) { bf16_t* p = HB + (size_t)(row0 + ai * HALF + m * 16) * 512 + col0;
                float h[8];
#pragma unroll
                for (int n = 0; n < 2; ++n)
#pragma unroll
                    for (int k = 0; k < 4; ++k) h[n * 4 + k] = fsilu(acc[ai][0][m][n][k]) * acc[ai][1][m][n][k];
                u32x4 w; w.x = cvt_pk_bf16(h[0], h[1]); w.y = cvt_pk_bf16(h[2], h[3]); w.z = cvt_pk_bf16(h[4], h[5]); w.w = cvt_pk_bf16(h[6], h[7]);
                *(u32x4*)p = w; }
    }
};
struct EpiDown {
    static constexpr bool PERM = true, AFTER_DRAIN = false;
    const int* row_tok; const float* row_w; bf16_t* x; bf16_t* y1; const float* gate; int gstride; int seq;
    __device__ __forceinline__ void operator()(const f32x4 (&acc)[2][2][4][2], const Unit& u, int wr, int wc, int fr, int fq) const {
        const int col0 = (u.pn & 3) * BM + wc * 32 + 8 * fq;
#pragma unroll
        for (int ai = 0; ai < 2; ++ai)
#pragma unroll
            for (int m = 0; m < 4; ++m) { const int lr = wr * 64 + fr + ai * HALF + m * 16;
                if (lr < u.nvalid) { const int ts = row_tok[u.rbase + lr]; const int tok = ts >> 1; const float w = row_w[u.rbase + lr]; const float* gp = gate + (size_t)(tok / seq) * gstride;
#pragma unroll
                    for (int bj = 0; bj < 2; ++bj) { const int c = col0 + bj * HALF; const size_t o = (size_t)tok * 1024 + c;
                        const f32x4 v0 = acc[ai][bj][m][0] * (*(const f32x4*)(gp + c)) * w, v1 = acc[ai][bj][m][1] * (*(const f32x4*)(gp + c + 4)) * w;
                        if (ts & 1) { u32x4 q; q.x = cvt_pk_bf16(v0[0], v0[1]); q.y = cvt_pk_bf16(v0[2], v0[3]); q.z = cvt_pk_bf16(v1[0], v1[1]); q.w = cvt_pk_bf16(v1[2], v1[3]); *(u32x4*)(y1 + o) = q; }
                        else { const u32x4 xw = *(const u32x4*)(x + o); const f32x4 s0 = (f32x4){bflo(xw.x), bfhi(xw.x), bflo(xw.y), bfhi(xw.y)} + v0, s1 = (f32x4){bflo(xw.z), bfhi(xw.z), bflo(xw.w), bfhi(xw.w)} + v1;
                            u32x4 q; q.x = cvt_pk_bf16(s0[0], s0[1]); q.y = cvt_pk_bf16(s0[2], s0[3]); q.z = cvt_pk_bf16(s1[0], s1[1]); q.w = cvt_pk_bf16(s1[2], s1[3]); *(u32x4*)(x + o) = q; } } } }
    }
};
struct MoeOrder {
    static constexpr bool HAS_NARROW = false;
    const PG8_LAS int* tab; int cap, G, c;
    __device__ __forceinline__ bool next(int i, Unit& u) const { const int v = ((G & 7) == 0) ? (c & 7) * (G >> 3) + (c >> 3) : c; const int L = i * G + v, nt = tab[64]; if (L >= nt * 4) return false;
        const int pm = L >> 2, e = tab[72 + pm], j = pm - tab[32 + e], nv = tab[e] - j * BM; u.pm = pm; u.pn = e * 4 + (L & 3); u.rbase = e * cap + j * BM; u.nvalid = nv > BM ? BM : nv; return true; }
    __device__ __forceinline__ void a_ready(const Unit&) const {}
    __device__ __forceinline__ void done(const Unit&) const {}
};
}

constexpr int NB = CFG_B, SEQ = CFG_S, NL = CFG_L, NTOK = NB * SEQ, DM = 1024, ZP = 2304;
constexpr int NBH = NB * 4, NCH = SEQ / 128, NQT = SEQ / 256;
constexpr int NR = 2 * NTOK + 32 * 256;
constexpr int Z_CQ = 0, Z_CKV = 192, Z_KR = 320, Z_POOL = 352, Z_HQ = 608, Z_HF = 864, Z_HI = 1120, Z_HG = 1376, Z_CA = 1632, Z_CG = 1888;
constexpr float EPS = 1e-6f;
static_assert(SEQ % 256 == 0 && NTOK % 256 == 0 && (NQT % 2) == 0, "shape");
constexpr size_t al256(size_t x) { return (x + 255) & ~(size_t)255; }
constexpr size_t cmax(size_t a, size_t b) { return a > b ? a : b; }
constexpr size_t WS_CTL = 0, CTL_BYTES = 65536;
constexpr size_t CTL_CNT = 16384;
constexpr size_t CTL_HG = 32768;
constexpr size_t WS_MODP = WS_CTL + CTL_BYTES;
constexpr size_t WS_MOD = WS_MODP + al256((size_t)16 * NL * NB * 6144 * 4);
constexpr size_t WS_LB = WS_MOD + al256((size_t)NL * NB * 6144 * 4);
constexpr size_t WS_ROPE = WS_LB + al256((size_t)NL * 256 * 4);
constexpr size_t WS_WIN = WS_ROPE + al256((size_t)NTOK * 32 * 4);
constexpr size_t WS_WOUT = WS_WIN + (size_t)ZP * 1024 * 2;
constexpr size_t WS_WUQ = WS_WOUT + (size_t)1024 * 1024 * 2;
constexpr size_t WS_WUKV = WS_WUQ + al256((size_t)384 * 192 * 2);
constexpr size_t WS_WPOOL = WS_WUKV + al256((size_t)512 * 128 * 2);
constexpr size_t WS_WUP = WS_WPOOL + al256((size_t)4 * 64 * 64 * 2);
constexpr size_t WS_WDN = WS_WUP + (size_t)32 * 1024 * 1024 * 2;
constexpr size_t WS_RWT = WS_WDN + (size_t)32 * 1024 * 512 * 2;
constexpr size_t WSET = WS_RWT + 36 * 1024 * 4 - WS_WIN;
constexpr size_t WS_HA = WS_WIN + 2 * WSET;
constexpr size_t WS_Z = WS_HA + (size_t)NTOK * 1024 * 2;
constexpr size_t Z_BYTES = cmax((size_t)NTOK * ZP * 2, (size_t)NR * 1024 * 2);
constexpr size_t WS_Q = WS_Z + Z_BYTES;
constexpr size_t WS_K = WS_Q + (size_t)NTOK * 4 * 96 * 2;
constexpr size_t WS_VT = WS_K + (size_t)NTOK * 4 * 96 * 2;
constexpr size_t WS_YB = WS_VT + (size_t)NTOK * 4 * 64 * 2;
constexpr size_t R2_BYTES = cmax(WS_YB + (size_t)NTOK * 1024 * 2 - WS_Q, (size_t)NR * 512 * 2);
constexpr size_t WS_Y1 = WS_Q + R2_BYTES;
constexpr size_t WS_SC = WS_Y1 + (size_t)NTOK * 1024 * 2;
constexpr size_t WS_PC = WS_SC + (size_t)NBH * NCH * 4096 * 4;
constexpr size_t WS_S0 = WS_PC + al256((size_t)NBH * NCH * 64 * 4);
constexpr size_t WS_ASGE = WS_S0 + (size_t)NBH * NCH * 4096 * 4;
constexpr size_t WS_ASGR = WS_ASGE + (size_t)NTOK * 8;
constexpr size_t WS_ASGW = WS_ASGR + (size_t)NTOK * 8;
constexpr int MOE_CAP = NTOK;
constexpr size_t WS_ROWTOK = WS_ASGW + (size_t)NTOK * 8;
constexpr size_t WS_ROWW = WS_ROWTOK + (size_t)32 * MOE_CAP * 4;
constexpr size_t WS_TILE = WS_ROWW + (size_t)32 * MOE_CAP * 4;
constexpr size_t WS_XB = WS_TILE + al256((size_t)(NR / 256 + 16) * 4);
constexpr size_t WS_END = WS_XB + (size_t)NTOK * 1024 * 2;
constexpr int LDS_BYTES = 160 * 1024;
constexpr int LDS_XB = LDS_BYTES - 16;

#define XB_TMO      128
#define XB_XCNT(j)  (256  + 64 * (j))
#define XB_XSUB(j)  (1280 + 64 * (j))
#define XB_XGEN(j)  (2304 + 64 * (j))
#define XB_TOP      3328
#define XB_TOPGEN   3392
#define XCD_BAR_WORDS 3456
#define XB_SPIN_CAP (1u << 18)
__device__ __forceinline__ unsigned xb_ld(unsigned* p)              { return __hip_atomic_load(p, __ATOMIC_RELAXED, __HIP_MEMORY_SCOPE_AGENT); }
__device__ __forceinline__ unsigned xb_add(unsigned* p, unsigned v) { return __hip_atomic_fetch_add(p, v, __ATOMIC_RELAXED, __HIP_MEMORY_SCOPE_AGENT); }
__device__ __forceinline__ unsigned xb_xcc_id() { return (unsigned)__builtin_amdgcn_s_getreg((3 << 11) | 20) & 0xFu; }
#define XB_SPIN(cond, bar) do { unsigned _sp = 0; while (cond) { __builtin_amdgcn_s_sleep(1); \
    if ((++_sp & 255u) == 0u) { if (xb_ld(&(bar)[XB_TMO])) break; if (_sp > XB_SPIN_CAP) { atomicAdd(&(bar)[XB_TMO], 1u); break; } } } } while (0)
struct XcdBarrier { unsigned* bar; unsigned x; volatile LAS unsigned* st; };
__device__ __forceinline__ XcdBarrier xcd_barrier_post(unsigned* bar, volatile LAS unsigned* st) {
    XcdBarrier b; b.bar = bar; b.x = xb_xcc_id(); b.st = st;
    if (threadIdx.x == 0) (void)xb_add(&bar[XB_XCNT(b.x)], 1u);
    return b;
}
__device__ __forceinline__ void xcd_barrier_complete(unsigned* bar, unsigned x, unsigned& nloc, unsigned& nx) {
    const unsigned G = gridDim.x * gridDim.y * gridDim.z;
    unsigned sum, cnt, mine, sp = 0u;
    for (;;) {
        sum = 0u; cnt = 0u; mine = 0u;
#pragma unroll
        for (unsigned j = 0; j < 16; ++j) { const unsigned c = xb_ld(&bar[XB_XCNT(j)]); sum += c; cnt += (c > 0u) ? 1u : 0u; mine = (j == x) ? c : mine; }
        if (sum == G) break;
        __builtin_amdgcn_s_sleep(1);
        if ((++sp & 255u) == 0u) { if (xb_ld(&bar[XB_TMO])) break; if (sp > XB_SPIN_CAP) { atomicAdd(&bar[XB_TMO], 1u); break; } }
    }
    nloc = mine > 0u ? mine : 1u; nx = cnt > 0u ? cnt : 1u;
}
__device__ __forceinline__ void xcd_barrier(const XcdBarrier& b) {
    ASMV("s_waitcnt vmcnt(0)" ::: "memory");
    __syncthreads();
    if (threadIdx.x == 0) {
        unsigned* bar = b.bar;
        __builtin_amdgcn_s_waitcnt(0);
        unsigned nloc = b.st[0], nx = b.st[1];
        if (nloc == 0u) { xcd_barrier_complete(bar, b.x, nloc, nx); b.st[0] = nloc; b.st[1] = nx; }
        const unsigned old = xb_add(&bar[XB_XSUB(b.x)], 1u);
        const unsigned gen = old / nloc;
        if (old + 1u == (gen + 1u) * nloc) {
            __builtin_amdgcn_fence(__ATOMIC_RELEASE, "agent");
            ASMV("s_waitcnt vmcnt(0)" ::: "memory");
            const unsigned og = xb_add(&bar[XB_TOP], 1u);
            const unsigned tg = og / nx;
            if (og + 1u == (tg + 1u) * nx) xb_add(&bar[XB_TOPGEN], 1u);
            else XB_SPIN(xb_ld(&bar[XB_TOPGEN]) == tg, bar);
            __builtin_amdgcn_fence(__ATOMIC_ACQUIRE, "agent");
            xb_add(&bar[XB_XGEN(b.x)], 1u);
            ASMV("s_waitcnt vmcnt(0)" ::: "memory");
        } else {
            XB_SPIN(xb_ld(&bar[XB_XGEN(b.x)]) == gen, bar);
            __builtin_amdgcn_fence(__ATOMIC_ACQUIRE, "agent");
            ASMV("s_waitcnt vmcnt(0)" ::: "memory");
        }
    }
    __syncthreads();
}

struct Args { const void* in[30]; float* out; unsigned char* ws; int ph_lo, ph_hi; };
enum { I_X = 0, I_C, I_POS, I_WADA, I_BADA, I_N1G, I_N2G, I_WIN, I_QAG, I_WUQ, I_KVAG, I_WUKV, I_QG, I_KG, I_WPOOL, I_PSCALE, I_LBL, I_HOG, I_DWW, I_DWB, I_LNG, I_LNB,
       I_WOUT, I_RGW, I_RGB, I_REW, I_REB, I_W1, I_W3, I_W2 };
struct Ctx {
    const Args* a; unsigned char* ws; unsigned char* lds; int tid, wid, lane, G, blk;
    __device__ __forceinline__ const float* inf(int i) const { return (const float*)a->in[i]; }
    template <class T> __device__ __forceinline__ T* w(size_t off) const { return (T*)(ws + off); }
};

__device__ __forceinline__ Ctx fresh(const Ctx& c0) { Ctx c = c0; LAUNDER_V(c.tid); LAUNDER_V(c.lane); LAUNDER_S(c.wid); return c; }
__device__ __forceinline__ void ph_prologue0(const Ctx& c_) { const Ctx c = fresh(c_);
    const float* cc = c.inf(I_C); const float* wada = c.inf(I_WADA); float* modp = c.w<float>(WS_MODP);
    for (int u = c.blk; u < NL * 16 * 12; u += c.G) {
        const int l = u / 192, r = u % 192, ic = r / 12, jb = r % 12, j = jb * 512 + c.tid;
        float* Ls = (float*)c.lds;
        __syncthreads();
        if (c.tid < NB * 64) Ls[c.tid] = fsilu(cc[(c.tid >> 6) * 1024 + ic * 64 + (c.tid & 63)]);
        __syncthreads();
        float acc[NB];
#pragma unroll
        for (int b = 0; b < NB; ++b) acc[b] = 0.f;
        const float* wp = wada + ((size_t)l * 1024 + ic * 64) * 6144 + j;
#pragma unroll
        for (int i0 = 0; i0 < 64; i0 += 16) { float wv[16];
#pragma unroll
            for (int i = 0; i < 16; ++i) wv[i] = wp[(size_t)(i0 + i) * 6144];
#pragma unroll
            for (int i = 0; i < 16; ++i)
#pragma unroll
                for (int b = 0; b < NB; ++b) acc[b] += Ls[b * 64 + i0 + i] * wv[i]; }
#pragma unroll
        for (int b = 0; b < NB; ++b) modp[(((size_t)ic * NL + l) * NB + b) * 6144 + j] = acc[b];
    }
    const int* pos = (const int*)c.a->in[I_POS]; float* rc = c.w<float>(WS_ROPE); float* rs = rc + (size_t)NTOK * 16;
    for (int e = c.blk * 512 + c.tid; e < NTOK * 16; e += c.G * 512) { const int t = e >> 4, i = e & 15;
        const float inv = exp2f(-(float)i * (13.287712379549449f / 16.0f));
        const float ang = (float)pos[t] * inv; rc[e] = cosf(ang); rs[e] = sinf(ang); }
    if (c.blk == 0 && c.tid < 256) { const float* lg = c.inf(I_LBL); float* lb = c.w<float>(WS_LB); float mx = -1e30f;
        for (int l = 0; l < NL; ++l) mx = fmaxf(mx, lg[l * 256 + c.tid]);
        float den = 0.f; for (int l = 0; l < NL; ++l) den += expf(lg[l * 256 + c.tid] - mx);
        float cum = 0.f, first = 0.f; for (int l = 0; l < NL; ++l) { cum += expf(lg[l * 256 + c.tid] - mx) / den; if (l == 0) first = cum; lb[l * 256 + c.tid] = cum - first; } }
}
__device__ __forceinline__ void ph_prologue1(const Ctx& c_) { const Ctx c = fresh(c_);
    const float* modp = c.w<float>(WS_MODP); float* mod = c.w<float>(WS_MOD); const float* bada = c.inf(I_BADA);
    for (int e = c.blk * 512 + c.tid; e < NL * NB * 6144; e += c.G * 512) { const int j = e % 6144, l = e / (NB * 6144);
        float s = bada[l * 6144 + j];
#pragma unroll
        for (int ic = 0; ic < 16; ++ic) s += modp[(size_t)ic * NL * NB * 6144 + e];
        mod[e] = s; }
}

__device__ __forceinline__ void ld8bf(const bf16_t* p, float (&o)[8]) { const u32x4 v = *(const u32x4*)p; o[0] = bflo(v.x); o[1] = bfhi(v.x); o[2] = bflo(v.y); o[3] = bfhi(v.y); o[4] = bflo(v.z); o[5] = bfhi(v.z); o[6] = bflo(v.w); o[7] = bfhi(v.w); }
__device__ __forceinline__ u32x4 pk8(const float (&o)[8]) { u32x4 w; w.x = cvt_pk_bf16(o[0], o[1]); w.y = cvt_pk_bf16(o[2], o[3]); w.z = cvt_pk_bf16(o[4], o[5]); w.w = cvt_pk_bf16(o[6], o[7]); return w; }
__device__ __forceinline__ u32x4 pk8p(const float (&o)[8]) { u32x4 w; w.x = cvt_pk_bf16_pinned(o[0], o[1]); w.y = cvt_pk_bf16_pinned(o[2], o[3]); w.z = cvt_pk_bf16_pinned(o[4], o[5]); w.w = cvt_pk_bf16_pinned(o[6], o[7]); return w; }
__device__ __forceinline__ void cvt_tile(const Ctx& c, const float* src, int ldn, int nlim, int k0, int n0, bf16_t* dst, int ldk, int drow0) {
    float* T = (float*)c.lds;
#pragma unroll
    for (int i = 0; i < 8; ++i) { const int e = c.tid + 512 * i, kk = e >> 6, nn = e & 63; T[kk * 65 + nn] = (n0 + nn < nlim) ? src[(size_t)(k0 + kk) * ldn + n0 + nn] : 0.f; }
    __syncthreads();
#pragma unroll
    for (int i = 0; i < 4; ++i) { const int e = c.tid + 512 * i, nn = e >> 5, k2 = e & 31;
        *(unsigned*)(dst + (size_t)(drow0 + nn) * ldk + k0 + 2 * k2) = cvt_pk_bf16(T[(2 * k2) * 65 + nn], T[(2 * k2 + 1) * 65 + nn]); }
    __syncthreads();
}
__device__ __forceinline__ void cvt_big(const Ctx& c, const float* src, int ldn, int nlim, int k0, int n0, bf16_t* dst, int ldk, int mode) {
    float* T = (float*)c.lds;
    f32x4 v[8];
#pragma unroll
    for (int i = 0; i < 8; ++i) { const int e4 = c.tid + 512 * i, kk = e4 >> 6, n4 = e4 & 63; v[i] = (n0 + n4 * 4 < nlim) ? *(const f32x4*)(src + (size_t)(k0 + kk) * ldn + n0 + n4 * 4) : (f32x4){0.f, 0.f, 0.f, 0.f}; }
#pragma unroll
    for (int i = 0; i < 8; ++i) { const int e4 = c.tid + 512 * i, kk = e4 >> 6, n4 = e4 & 63; float* p = T + kk * 261 + n4 * 4; p[0] = v[i][0]; p[1] = v[i][1]; p[2] = v[i][2]; p[3] = v[i][3]; }
    __syncthreads();
#pragma unroll
    for (int i = 0; i < 4; ++i) { const int e = c.tid + 512 * i, k8 = e & 7, nn = e >> 3, n = n0 + nn; float o[8];
#pragma unroll
        for (int j = 0; j < 8; ++j) o[j] = T[(8 * k8 + j) * 261 + nn];
        const int row = (mode == 0) ? n : ((n >> 7) * 256 + (mode - 1) * 128 + (n & 127));
        *(u32x4*)(dst + (size_t)row * ldk + k0 + 8 * k8) = pk8(o); }
    __syncthreads();
}
constexpr int CT_IN = 16 * 9, CT_OUT = 16 * 4, CT_W13 = 32 * 16 * 2, CT_W2 = 32 * 8 * 4, CT_UQ = 3 * 6, CT_UKV = 2 * 8, CT_POOL = 4;
constexpr int CT_TOTAL = CT_IN + CT_OUT + 2 * CT_W13 + CT_W2 + CT_UQ + CT_UKV + CT_POOL;
__device__ __forceinline__ void ph_cvt(const Ctx& c_, int l) { const Ctx c = fresh(c_);
    { const float* rgw = c.inf(I_RGW) + (size_t)l * 1024 * 4; const float* rew = c.inf(I_REW) + (size_t)l * 1024 * 32; float* rwt = c.w<float>(WS_RWT + (size_t)(l & 1) * WSET);
        for (int e = c.blk * 512 + c.tid; e < 36 * 1024; e += c.G * 512) { const int g = e >> 10, k = e & 1023; rwt[e] = (g < 4) ? rgw[k * 4 + g] : rew[k * 32 + g - 4]; } }
    for (int t = c.blk; t < CT_TOTAL; t += c.G) {
        int r = t;
        if (r < 2 * CT_W13) { const int which = r / CT_W13; r %= CT_W13; const int e = r / 32, kt = (r % 32) / 2, nt = r % 2;
            cvt_big(c, c.inf(which ? I_W3 : I_W1) + ((size_t)l * 32 + e) * 1024 * 512, 512, 512, kt * 64, nt * 256, c.w<bf16_t>(WS_WUP + (size_t)(l & 1) * WSET) + (size_t)e * 1024 * 1024, 1024, 1 + which); continue; } r -= 2 * CT_W13;
        if (r < CT_W2) { const int e = r / 32, kt = (r % 32) / 4, nt = r % 4;
            cvt_big(c, c.inf(I_W2) + ((size_t)l * 32 + e) * 512 * 1024, 1024, 1024, kt * 64, nt * 256, c.w<bf16_t>(WS_WDN + (size_t)(l & 1) * WSET) + (size_t)e * 1024 * 512, 512, 0); continue; } r -= CT_W2;
        if (r < CT_IN) { const int kt = r / 9, nt = r % 9; cvt_big(c, c.inf(I_WIN) + (size_t)l * 1024 * 2144, 2144, 2144, kt * 64, nt * 256, c.w<bf16_t>(WS_WIN + (size_t)(l & 1) * WSET), 1024, 0); continue; } r -= CT_IN;
        if (r < CT_OUT) { const int kt = r / 4, nt = r % 4; cvt_big(c, c.inf(I_WOUT) + (size_t)l * 1024 * 1024, 1024, 1024, kt * 64, nt * 256, c.w<bf16_t>(WS_WOUT + (size_t)(l & 1) * WSET), 1024, 0); continue; } r -= CT_OUT;
        if (r < CT_UQ) { const int kt = r / 6, nt = r % 6; cvt_tile(c, c.inf(I_WUQ) + (size_t)l * 192 * 384, 384, 384, kt * 64, nt * 64, c.w<bf16_t>(WS_WUQ + (size_t)(l & 1) * WSET), 192, nt * 64); continue; } r -= CT_UQ;
        if (r < CT_UKV) { const int kt = r / 8, nt = r % 8; cvt_tile(c, c.inf(I_WUKV) + (size_t)l * 128 * 512, 512, 512, kt * 64, nt * 64, c.w<bf16_t>(WS_WUKV + (size_t)(l & 1) * WSET), 128, nt * 64); continue; } r -= CT_UKV;
        cvt_tile(c, c.inf(I_WPOOL) + ((size_t)l * 4 + r) * 4096, 64, 64, 0, 0, c.w<bf16_t>(WS_WPOOL + (size_t)(l & 1) * WSET) + r * 4096, 64, 0);
    }
}
__device__ __forceinline__ void ph_normrows(const Ctx& c_, int l) { const Ctx c = fresh(c_);
    const float* xin = c.inf(I_X); const bf16_t* xb = c.w<bf16_t>(WS_XB); const bf16_t* y1 = c.w<bf16_t>(WS_Y1);
    const float* gn = c.inf(I_N1G) + l * 1024; const float* mod = c.w<float>(WS_MOD) + (size_t)l * NB * 6144; bf16_t* ha = c.w<bf16_t>(WS_HA);
    constexpr int RQ = 4;
    for (int row0 = c.blk * 8 + c.wid; row0 < NTOK; row0 += c.G * 8 * RQ) {
        f32x4 v[RQ][2][2]; float ss[RQ];
        if (l == 0) {
#pragma unroll
            for (int q = 0; q < RQ; ++q) { const int row = row0 + q * c.G * 8;
                if (row < NTOK) {
#pragma unroll
                    for (int i = 0; i < 2; ++i) { const float* p = xin + (size_t)row * 1024 + i * 512 + c.lane * 8; v[q][i][0] = *(const f32x4*)p; v[q][i][1] = *(const f32x4*)(p + 4); } } }
        } else {
            u32x4 xw[RQ][2], yw[RQ][2];
#pragma unroll
            for (int q = 0; q < RQ; ++q) { const int row = row0 + q * c.G * 8;
                if (row < NTOK) {
#pragma unroll
                    for (int i = 0; i < 2; ++i) { const size_t o = (size_t)row * 1024 + i * 512 + c.lane * 8; xw[q][i] = *(const u32x4*)(xb + o); yw[q][i] = *(const u32x4*)(y1 + o); } } }
#pragma unroll
            for (int q = 0; q < RQ; ++q)
#pragma unroll
                for (int i = 0; i < 2; ++i) { const u32x4 a = xw[q][i], b = yw[q][i];
                    v[q][i][0] = (f32x4){bflo(a.x), bfhi(a.x), bflo(a.y), bfhi(a.y)} + (f32x4){bflo(b.x), bfhi(b.x), bflo(b.y), bfhi(b.y)};
                    v[q][i][1] = (f32x4){bflo(a.z), bfhi(a.z), bflo(a.w), bfhi(a.w)} + (f32x4){bflo(b.z), bfhi(b.z), bflo(b.w), bfhi(b.w)}; }
        }
#pragma unroll
        for (int q = 0; q < RQ; ++q) { float s = 0.f;
#pragma unroll
            for (int i = 0; i < 2; ++i)
#pragma unroll
                for (int h = 0; h < 2; ++h) { const f32x4 w = v[q][i][h]; s += w[0] * w[0] + w[1] * w[1] + w[2] * w[2] + w[3] * w[3]; }
            ss[q] = (row0 + q * c.G * 8 < NTOK) ? s : 0.f; }
#pragma unroll
        for (int q = 0; q < RQ; ++q) ss[q] = wave_sum(ss[q]);
#pragma unroll
        for (int q = 0; q < RQ; ++q) { const int row = row0 + q * c.G * 8;
            if (row < NTOK) { const int b = row / SEQ; const float* sh = mod + b * 6144; const float* sc = sh + 1024; const float rinv = frsqrt(ss[q] * (1.0f / 1024.0f) + EPS);
#pragma unroll
                for (int i = 0; i < 2; ++i) { const int col = i * 512 + c.lane * 8; float o8[8];
#pragma unroll
                    for (int h = 0; h < 2; ++h) { const f32x4 g = *(const f32x4*)(gn + col + 4 * h), s1 = *(const f32x4*)(sc + col + 4 * h), s0 = *(const f32x4*)(sh + col + 4 * h);
                        const f32x4 hv = v[q][i][h] * rinv * g * (s1 + 1.0f) + s0; o8[4 * h] = hv[0]; o8[4 * h + 1] = hv[1]; o8[4 * h + 2] = hv[2]; o8[4 * h + 3] = hv[3]; }
                    *(u32x4*)(ha + (size_t)row * 1024 + col) = pk8(o8); } } }
    }
}

#define MFMA16(a, b, c) __builtin_amdgcn_mfma_f32_16x16x32_bf16((a), (b), (c), 0, 0, 0)
#define MFMA32(a, b, c) __builtin_amdgcn_mfma_f32_32x32x16_bf16((a), (b), (c), 0, 0, 0)

__device__ __forceinline__ void mix_unit(const Ctx& c_, int l, int r0) { const Ctx c = fresh(c_);
    const bf16_t* Z = c.w<bf16_t>(WS_Z); bf16_t* Aq = (bf16_t*)c.lds; bf16_t* Akv = (bf16_t*)(c.lds + 12800); float* Lkr = (float*)(c.lds + 21504);
    float* Lu = (float*)(c.lds + 25600); bf16_t* Lp = (bf16_t*)(c.lds + 73728); float* Lcu = (float*)(c.lds + 90624); float* Lco = (float*)c.lds;
    const int s0 = r0 % SEQ, b = r0 / SEQ, fr = c.lane & 15, fq = c.lane >> 4;
    {   const int t = c.tid >> 4, sub = c.tid & 15; const bf16_t* zr = Z + (size_t)(r0 + t) * ZP;
        const u32x4 zero4 = {0u, 0u, 0u, 0u};
        const u32x4 ra0 = *(const u32x4*)(zr + Z_CQ + sub * 8), ra1 = (sub < 8) ? *(const u32x4*)(zr + Z_CQ + 128 + sub * 8) : zero4, rk0 = *(const u32x4*)(zr + Z_CKV + sub * 8), rkr = (sub < 4) ? *(const u32x4*)(zr + Z_KR + sub * 8) : zero4;
        u32x4 rp[3], rca[4], rcg[4];
#pragma unroll
        for (int i = 0; i < 3; ++i) { const int ch = c.tid + 512 * i, row = ch >> 5, c8 = ch & 31; rp[i] = (ch < 47 * 32 && s0 - 15 + row >= 0) ? *(const u32x4*)(Z + (size_t)(r0 - 15 + row) * ZP + Z_POOL + c8 * 8) : zero4; }
#pragma unroll
        for (int i = 0; i < 4; ++i) { const int ch = c.tid + 512 * i, row = ch >> 5, c8 = ch & 31; const bool ok = (ch < 62 * 32 && s0 - 30 + row >= 0);
            rca[i] = ok ? *(const u32x4*)(Z + (size_t)(r0 - 30 + row) * ZP + Z_CA + c8 * 8) : zero4; rcg[i] = ok ? *(const u32x4*)(Z + (size_t)(r0 - 30 + row) * ZP + Z_CG + c8 * 8) : zero4; }
        auto un8 = [](const u32x4 v, float (&o)[8]) { o[0] = bflo(v.x); o[1] = bfhi(v.x); o[2] = bflo(v.y); o[3] = bfhi(v.y); o[4] = bflo(v.z); o[5] = bfhi(v.z); o[6] = bflo(v.w); o[7] = bfhi(v.w); };
        const float* qag = c.inf(I_QAG) + l * 192; const float* kvag = c.inf(I_KVAG) + l * 128;
        float a0[8], a1[8], k0[8]; float ssq = 0.f, ssk = 0.f; un8(ra0, a0); un8(ra1, a1); un8(rk0, k0);
#pragma unroll
        for (int j = 0; j < 8; ++j) { ssq += a0[j] * a0[j] + a1[j] * a1[j]; ssk += k0[j] * k0[j]; }
#pragma unroll
        for (int m = 1; m < 16; m <<= 1) { ssq += __shfl_xor(ssq, m); ssk += __shfl_xor(ssk, m); }
        const float rq = frsqrt(ssq * (1.0f / 192.0f) + EPS), rk = frsqrt(ssk * (1.0f / 128.0f) + EPS);
#pragma unroll
        for (int j = 0; j < 8; ++j) a0[j] *= rq * qag[sub * 8 + j];
        *(u32x4*)(Aq + t * 200 + sub * 8) = pk8(a0);
        if (sub < 8) {
#pragma unroll
            for (int j = 0; j < 8; ++j) a1[j] *= rq * qag[128 + sub * 8 + j];
            *(u32x4*)(Aq + t * 200 + 128 + sub * 8) = pk8(a1); }
#pragma unroll
        for (int j = 0; j < 8; ++j) k0[j] *= rk * kvag[sub * 8 + j];
        *(u32x4*)(Akv + t * 136 + sub * 8) = pk8(k0);
        if (sub < 4) { float kr[8]; un8(rkr, kr);
#pragma unroll
            for (int j = 0; j < 8; ++j) Lkr[t * 32 + sub * 8 + j] = kr[j]; }
#pragma unroll
        for (int i = 0; i < 3; ++i) { const int ch = c.tid + 512 * i, row = ch >> 5, c8 = ch & 31; if (ch < 47 * 32) { float v[8]; un8(rp[i], v);
            *(f32x4*)(Lu + row * 256 + c8 * 8) = (f32x4){v[0], v[1], v[2], v[3]}; *(f32x4*)(Lu + row * 256 + c8 * 8 + 4) = (f32x4){v[4], v[5], v[6], v[7]}; } }
#pragma unroll
        for (int i = 0; i < 4; ++i) { const int ch = c.tid + 512 * i, row = ch >> 5, c8 = ch & 31; if (ch < 62 * 32) { float a[8], g[8]; un8(rca[i], a); un8(rcg[i], g);
#pragma unroll
            for (int j = 0; j < 8; ++j) a[j] *= fsigmoid(g[j]);
            *(f32x4*)(Lcu + row * 256 + c8 * 8) = (f32x4){a[0], a[1], a[2], a[3]}; *(f32x4*)(Lcu + row * 256 + c8 * 8 + 4) = (f32x4){a[4], a[5], a[6], a[7]}; } }
    }
    __syncthreads();
    const float* rcos = c.w<float>(WS_ROPE); const float* rsin = rcos + (size_t)NTOK * 16;
    if (c.wid < 4) {
        const int h = c.wid; const bf16_t* W = c.w<bf16_t>(WS_WUQ + (size_t)(l & 1) * WSET) + (size_t)(96 * h) * 192; const float* qg = c.inf(I_QG) + l * 96;
        f32x4 acc[6][2];
#pragma unroll
        for (int nf = 0; nf < 6; ++nf) { acc[nf][0] = (f32x4){0.f, 0.f, 0.f, 0.f}; acc[nf][1] = acc[nf][0]; }
#pragma unroll 3
        for (int ks = 0; ks < 6; ++ks) { bf16x8 af[2];
#pragma unroll
            for (int mf = 0; mf < 2; ++mf) af[mf] = *(const bf16x8*)(Aq + (mf * 16 + fr) * 200 + ks * 32 + fq * 8);
#pragma unroll
            for (int nf = 0; nf < 6; ++nf) { const bf16x8 bfr = *(const bf16x8*)(W + (size_t)(16 * nf + fr) * 192 + ks * 32 + fq * 8);
                acc[nf][0] = MFMA16(bfr, af[0], acc[nf][0]); acc[nf][1] = MFMA16(bfr, af[1], acc[nf][1]); } }
#pragma unroll
        for (int mf = 0; mf < 2; ++mf) { float ss = 0.f;
#pragma unroll
            for (int nf = 0; nf < 6; ++nf)
#pragma unroll
                for (int j = 0; j < 4; ++j) ss += acc[nf][mf][j] * acc[nf][mf][j];
            ss += __shfl_xor(ss, 16); ss += __shfl_xor(ss, 32);
            const float rinv = frsqrt(ss * (1.0f / 96.0f) + EPS) * (0.10206207261596575f * 1.44269504089f);
            const int tok = r0 + mf * 16 + fr; bf16_t* qo = c.w<bf16_t>(WS_Q) + ((size_t)(b * 4 + h) * SEQ + s0 + mf * 16 + fr) * 96;
            float v[6][4];
#pragma unroll
            for (int nf = 0; nf < 6; ++nf)
#pragma unroll
                for (int j = 0; j < 4; ++j) v[nf][j] = acc[nf][mf][j] * rinv * qg[16 * nf + 4 * fq + j];
            const f32x4 cs4 = *(const f32x4*)(rcos + (size_t)tok * 16 + 4 * fq), sn4 = *(const f32x4*)(rsin + (size_t)tok * 16 + 4 * fq);
#pragma unroll
            for (int j = 0; j < 4; ++j) { const float x1 = v[4][j], x2 = v[5][j]; v[4][j] = x1 * cs4[j] - x2 * sn4[j]; v[5][j] = x1 * sn4[j] + x2 * cs4[j]; }
#pragma unroll
            for (int nf = 0; nf < 6; ++nf) { u32x2 o; o.x = cvt_pk_bf16(v[nf][0], v[nf][1]); o.y = cvt_pk_bf16(v[nf][2], v[nf][3]); *(u32x2*)(qo + 16 * nf + 4 * fq) = o; } }
    } else {
        const int h = c.wid - 4; const bf16_t* W = c.w<bf16_t>(WS_WUKV + (size_t)(l & 1) * WSET) + (size_t)(128 * h) * 128; const float* kg = c.inf(I_KG) + l * 96;
        f32x4 ak[4][2], av[4][2];
#pragma unroll
        for (int nf = 0; nf < 4; ++nf) { ak[nf][0] = (f32x4){0.f, 0.f, 0.f, 0.f}; ak[nf][1] = ak[nf][0]; av[nf][0] = ak[nf][0]; av[nf][1] = ak[nf][0]; }
#pragma unroll 2
        for (int ks = 0; ks < 4; ++ks) { bf16x8 af[2];
#pragma unroll
            for (int mf = 0; mf < 2; ++mf) af[mf] = *(const bf16x8*)(Akv + (mf * 16 + fr) * 136 + ks * 32 + fq * 8);
#pragma unroll
            for (int nf = 0; nf < 4; ++nf) { const bf16x8 bk = *(const bf16x8*)(W + (size_t)(16 * nf + fr) * 128 + ks * 32 + fq * 8), bv = *(const bf16x8*)(W + (size_t)(64 + 16 * nf + fr) * 128 + ks * 32 + fq * 8);
                ak[nf][0] = MFMA16(bk, af[0], ak[nf][0]); ak[nf][1] = MFMA16(bk, af[1], ak[nf][1]);
                av[nf][0] = MFMA16(af[0], bv, av[nf][0]); av[nf][1] = MFMA16(af[1], bv, av[nf][1]); } }
#pragma unroll
        for (int mf = 0; mf < 2; ++mf) { const int tl = mf * 16 + fr; float ss = 0.f;
#pragma unroll
            for (int nf = 0; nf < 4; ++nf)
#pragma unroll
                for (int j = 0; j < 4; ++j) ss += ak[nf][mf][j] * ak[nf][mf][j];
#pragma unroll
            for (int j = 0; j < 8; ++j) { const float kr = Lkr[tl * 32 + fq * 8 + j]; ss += kr * kr; }
            ss += __shfl_xor(ss, 16); ss += __shfl_xor(ss, 32);
            const float rinv = frsqrt(ss * (1.0f / 96.0f) + EPS);
            const int tok = r0 + tl; bf16_t* ko = c.w<bf16_t>(WS_K) + ((size_t)(b * 4 + h) * SEQ + s0 + tl) * 96;
#pragma unroll
            for (int nf = 0; nf < 4; ++nf) { u32x2 o; o.x = cvt_pk_bf16(ak[nf][mf][0] * rinv * kg[16 * nf + 4 * fq], ak[nf][mf][1] * rinv * kg[16 * nf + 4 * fq + 1]);
                o.y = cvt_pk_bf16(ak[nf][mf][2] * rinv * kg[16 * nf + 4 * fq + 2], ak[nf][mf][3] * rinv * kg[16 * nf + 4 * fq + 3]); *(u32x2*)(ko + 16 * nf + 4 * fq) = o; }
            const f32x4 cs4 = *(const f32x4*)(rcos + (size_t)tok * 16 + 4 * fq), sn4 = *(const f32x4*)(rsin + (size_t)tok * 16 + 4 * fq);
            float o1[4], o2[4];
#pragma unroll
            for (int j = 0; j < 4; ++j) { const int i = 4 * fq + j; const float x1 = Lkr[tl * 32 + i] * rinv * kg[64 + i], x2 = Lkr[tl * 32 + 16 + i] * rinv * kg[80 + i];
                o1[j] = x1 * cs4[j] - x2 * sn4[j]; o2[j] = x1 * sn4[j] + x2 * cs4[j]; }
            { u32x2 o; o.x = cvt_pk_bf16(o1[0], o1[1]); o.y = cvt_pk_bf16(o1[2], o1[3]); *(u32x2*)(ko + 64 + 4 * fq) = o; o.x = cvt_pk_bf16(o2[0], o2[1]); o.y = cvt_pk_bf16(o2[2], o2[3]); *(u32x2*)(ko + 80 + 4 * fq) = o; }
            bf16_t* vo = c.w<bf16_t>(WS_VT) + (size_t)(b * 4 + h) * 64 * SEQ + s0 + mf * 16 + 4 * fq;
#pragma unroll
            for (int nf = 0; nf < 4; ++nf) { u32x2 o; o.x = cvt_pk_bf16(av[nf][mf][0], av[nf][mf][1]); o.y = cvt_pk_bf16(av[nf][mf][2], av[nf][mf][3]); *(u32x2*)(vo + (size_t)(16 * nf + fr) * SEQ) = o; } }
    }
    { const int t = c.tid >> 4, sub = c.tid & 15, g = sub >> 2, w = 2 << g, s = s0 + t; const float inv = 1.0f / (float)((s + 1 < w) ? (s + 1) : w);
#pragma unroll
        for (int k = 0; k < 2; ++k) { const int col = sub * 16 + k * 8; float sum[8];
#pragma unroll
            for (int j = 0; j < 8; ++j) sum[j] = 0.f;
            for (int d = 0; d < w; ++d) { const float* p = Lu + (t + 15 - d) * 256 + col;
#pragma unroll
                for (int j = 0; j < 8; ++j) sum[j] += p[j]; }
            const float* p0 = Lu + (t + 15) * 256 + col;
#pragma unroll
            for (int j = 0; j < 8; ++j) sum[j] = sum[j] * inv - p0[j];
            *(u32x4*)(Lp + t * 264 + col) = pk8(sum); } }
    float cres[16];
    { const int chn = c.tid & 255, half = c.tid >> 8; const float* dw = c.inf(I_DWW) + (size_t)l * 31 * 256 + chn; const float bias = c.inf(I_DWB)[l * 256 + chn];
        float wv[31];
#pragma unroll
        for (int j = 0; j < 31; ++j) wv[j] = dw[j * 256];
#pragma unroll
        for (int tt = 0; tt < 16; ++tt) cres[tt] = bias;
#pragma unroll
        for (int r = 0; r < 46; ++r) { const float u = Lcu[(half * 16 + r) * 256 + chn];
#pragma unroll
            for (int tt = 0; tt < 16; ++tt) { const int j = r - tt; if (j >= 0 && j < 31) cres[tt] += wv[j] * u; } } }
    __syncthreads();
    { const int g = c.wid >> 1, mf = c.wid & 1; const bf16_t* W = c.w<bf16_t>(WS_WPOOL + (size_t)(l & 1) * WSET) + g * 4096; const float* ps = c.inf(I_PSCALE) + l * 256 + g * 64;
        f32x4 acc[4];
#pragma unroll
        for (int nf = 0; nf < 4; ++nf) acc[nf] = (f32x4){0.f, 0.f, 0.f, 0.f};
#pragma unroll
        for (int ks = 0; ks < 2; ++ks) { const bf16x8 af = *(const bf16x8*)(Lp + (mf * 16 + fr) * 264 + g * 64 + ks * 32 + fq * 8);
#pragma unroll
            for (int nf = 0; nf < 4; ++nf) { const bf16x8 bfr = *(const bf16x8*)(W + (16 * nf + fr) * 64 + ks * 32 + fq * 8); acc[nf] = MFMA16(bfr, af, acc[nf]); } }
        bf16_t* yo = c.w<bf16_t>(WS_YB) + (size_t)(r0 + mf * 16 + fr) * 1024 + 256 + g * 64;
#pragma unroll
        for (int nf = 0; nf < 4; ++nf) { const int d = 16 * nf + 4 * fq; u32x2 o; o.x = cvt_pk_bf16(acc[nf][0] * ps[d], acc[nf][1] * ps[d + 1]); o.y = cvt_pk_bf16(acc[nf][2] * ps[d + 2], acc[nf][3] * ps[d + 3]); *(u32x2*)(yo + d) = o; } }
    { const int chn = c.tid & 255, half = c.tid >> 8;
#pragma unroll
        for (int tt = 0; tt < 16; ++tt) Lco[(half * 16 + tt) * 256 + chn] = cres[tt]; }
    __syncthreads();
    { const float* lg = c.inf(I_LNG) + l * 256 + c.lane * 4; const float* lb = c.inf(I_LNB) + l * 256 + c.lane * 4;
#pragma unroll
        for (int k = 0; k < 4; ++k) { const int t = c.wid * 4 + k; const f32x4 v = *(const f32x4*)(Lco + t * 256 + c.lane * 4);
            const float mean = wave_sum(v[0] + v[1] + v[2] + v[3]) * (1.0f / 256.0f); const f32x4 d = v - mean;
            const float var = wave_sum(d[0] * d[0] + d[1] * d[1] + d[2] * d[2] + d[3] * d[3]) * (1.0f / 256.0f); const float rs = frsqrt(var + EPS);
            float y[4];
#pragma unroll
            for (int j = 0; j < 4; ++j) y[j] = fsilu(d[j] * rs * lg[j] + lb[j]);
            u32x2 o; o.x = cvt_pk_bf16(y[0], y[1]); o.y = cvt_pk_bf16(y[2], y[3]); *(u32x2*)(c.w<bf16_t>(WS_YB) + (size_t)(r0 + t) * 1024 + 768 + c.lane * 4) = o; } }
    __syncthreads();
}

constexpr int CW_W13 = 32 * 16 * 16, CW_W2 = 32 * 8 * 32, CW_IN = 16 * 72, CW_OUT = 16 * 32, CW_UQ = 3 * 12, CW_UKV = 2 * 16, CW_POOL = 4 * 2;
constexpr int CW_TOTAL = 2 * CW_W13 + CW_W2 + CW_IN + CW_OUT + CW_UQ + CW_UKV + CW_POOL;
struct CvtTile { const float* src; bf16_t* dst; int ldn, ldk; };
__device__ __forceinline__ void cvt_decode(const Ctx& c, int l, int t, CvtTile& d) {
    const size_t wso = (size_t)(l & 1) * WSET; int r = t;
    if (r < 2 * CW_W13) { const int which = r / CW_W13; r %= CW_W13; const int e = r >> 8, kt = (r >> 4) & 15, nt = r & 15, n0 = nt * 32;
        d.src = c.inf(which ? I_W3 : I_W1) + ((size_t)l * 32 + e) * 1024 * 512 + (size_t)kt * 64 * 512 + n0; d.ldn = 512; d.ldk = 1024;
        d.dst = c.w<bf16_t>(WS_WUP + wso) + (size_t)e * 1024 * 1024 + (size_t)((n0 >> 7) * 256 + which * 128 + (n0 & 127)) * 1024 + kt * 64; return; } r -= 2 * CW_W13;
    if (r < CW_W2) { const int e = r >> 8, kt = (r >> 5) & 7, nt = r & 31;
        d.src = c.inf(I_W2) + ((size_t)l * 32 + e) * 512 * 1024 + (size_t)kt * 64 * 1024 + nt * 32; d.ldn = 1024; d.ldk = 512;
        d.dst = c.w<bf16_t>(WS_WDN + wso) + (size_t)e * 1024 * 512 + (size_t)(nt * 32) * 512 + kt * 64; return; } r -= CW_W2;
    if (r < CW_IN) { const int kt = r / 72, nt = r % 72; d.src = (nt < 67) ? c.inf(I_WIN) + (size_t)l * 1024 * 2144 + (size_t)kt * 64 * 2144 + nt * 32 : nullptr; d.ldn = 2144; d.ldk = 1024;
        d.dst = c.w<bf16_t>(WS_WIN + wso) + (size_t)(nt * 32) * 1024 + kt * 64; return; } r -= CW_IN;
    if (r < CW_OUT) { const int kt = r >> 5, nt = r & 31; d.src = c.inf(I_WOUT) + (size_t)l * 1024 * 1024 + (size_t)kt * 64 * 1024 + nt * 32; d.ldn = 1024; d.ldk = 1024;
        d.dst = c.w<bf16_t>(WS_WOUT + wso) + (size_t)(nt * 32) * 1024 + kt * 64; return; } r -= CW_OUT;
    if (r < CW_UQ) { const int kt = r / 12, nt = r % 12; d.src = c.inf(I_WUQ) + (size_t)l * 192 * 384 + (size_t)kt * 64 * 384 + nt * 32; d.ldn = 384; d.ldk = 192;
        d.dst = c.w<bf16_t>(WS_WUQ + wso) + (size_t)(nt * 32) * 192 + kt * 64; return; } r -= CW_UQ;
    if (r < CW_UKV) { const int kt = r >> 4, nt = r & 15; d.src = c.inf(I_WUKV) + (size_t)l * 128 * 512 + (size_t)kt * 64 * 512 + nt * 32; d.ldn = 512; d.ldk = 128;
        d.dst = c.w<bf16_t>(WS_WUKV + wso) + (size_t)(nt * 32) * 128 + kt * 64; return; } r -= CW_UKV;
    { const int g = r >> 1, nt = r & 1; d.src = c.inf(I_WPOOL) + ((size_t)l * 4 + g) * 4096 + nt * 32; d.ldn = 64; d.ldk = 64; d.dst = c.w<bf16_t>(WS_WPOOL + wso) + g * 4096 + (size_t)(nt * 32) * 64; }
}
__device__ __forceinline__ void cvt_wave(const Ctx& c, int l, int wrank, int nwaves, float* T) {
    { const float* rgw = c.inf(I_RGW) + (size_t)l * 1024 * 4; const float* rew = c.inf(I_REW) + (size_t)l * 1024 * 32; float* rwt = c.w<float>(WS_RWT + (size_t)(l & 1) * WSET);
        for (int e = wrank * 64 + c.lane; e < 36 * 1024; e += nwaves * 64) { const int g = e >> 10, k = e & 1023; rwt[e] = (g < 4) ? rgw[k * 4 + g] : rew[k * 32 + g - 4]; } }
    f32x4 v[8]; CvtTile cur; cur.src = nullptr; cur.dst = nullptr; cur.ldn = 0; cur.ldk = 0;
    auto issue = [&](const CvtTile& d) {
#pragma unroll
        for (int i = 0; i < 8; ++i) { const int e4 = c.lane + 64 * i, kk = e4 >> 3, n4 = e4 & 7; v[i] = d.src ? *(const f32x4*)(d.src + (size_t)kk * d.ldn + n4 * 4) : (f32x4){0.f, 0.f, 0.f, 0.f}; } };
    int t = wrank;
    if (t < CW_TOTAL) { cvt_decode(c, l, t, cur); issue(cur); }
    while (t < CW_TOTAL) {
#pragma unroll
        for (int i = 0; i < 8; ++i) { const int e4 = c.lane + 64 * i, kk = e4 >> 3, n4 = e4 & 7; float* p = T + kk * 33 + n4 * 4; p[0] = v[i][0]; p[1] = v[i][1]; p[2] = v[i][2]; p[3] = v[i][3]; }
        const int tn = t + nwaves; CvtTile nxt = cur; if (tn < CW_TOTAL) { cvt_decode(c, l, tn, nxt); issue(nxt); }
        __builtin_amdgcn_wave_barrier();
        { const int n = c.lane & 31, kh = c.lane >> 5; bf16_t* drow = cur.dst + (size_t)n * cur.ldk + kh * 32;
#pragma unroll
            for (int q = 0; q < 4; ++q) { float o[8];
#pragma unroll
                for (int j = 0; j < 8; ++j) o[j] = T[(kh * 32 + q * 8 + j) * 33 + n];
                *(u32x4*)(drow + q * 8) = pk8(o); } }
        __builtin_amdgcn_wave_barrier();
        t = tn; cur = nxt;
    }
}

#ifdef EMU
static inline float __builtin_amdgcn_logf(float x) { return log2f(x); }
#endif
constexpr int HGP = 68, HGV = 40;
constexpr int HG_LG = 0, HG_LK = 8704, HG_LQ = 17408, HG_LVT = 26112, HG_LEG = 31232, HG_LGG = 31488, HG_BYTES = 31744;
template <bool OUT> __device__ __forceinline__ void hgrn_mfma(const Ctx& c_, int l, int bu, int cvt_layer = NL) { const Ctx c = fresh(c_);
    if (c.wid < 4) {
        const int cu = bu * 4 + c.wid, bh = cu / NCH, chunk = cu % NCH, b = bh >> 2, h = bh & 3, tok0 = b * SEQ + chunk * 128;
        const bf16_t* Z = c.w<bf16_t>(WS_Z); const float lbd = c.w<float>(WS_LB)[l * 256 + h * 64 + c.lane];
        unsigned char* L = c.lds + c.wid * HG_BYTES; float* Lg = (float*)(L + HG_LG); float* Lk = (float*)(L + HG_LK); float* Lq = (float*)(L + HG_LQ); bf16_t* Lvt = (bf16_t*)(L + HG_LVT); float* LeG = (float*)(L + HG_LEG); float* LG = (float*)(L + HG_LGG);
        const int l31 = c.lane & 31, hi = c.lane >> 5;
        f32x16 S[2][2];
        if (OUT) { const float* s0 = c.w<float>(WS_S0) + (size_t)(bh * NCH + chunk) * 4096;
#pragma unroll
            for (int mf = 0; mf < 2; ++mf)
#pragma unroll
                for (int nf = 0; nf < 2; ++nf)
#pragma unroll
                    for (int r = 0; r < 16; ++r) S[mf][nf][r] = s0[(32 * mf + (r & 3) + 8 * (r >> 2) + 4 * hi) * 64 + 32 * nf + l31]; }
        else {
#pragma unroll
            for (int mf = 0; mf < 2; ++mf)
#pragma unroll
                for (int nf = 0; nf < 2; ++nf)
#pragma unroll
                    for (int r = 0; r < 16; ++r) S[mf][nf][r] = 0.f; }
        float gtot = 0.f; const float og0 = OUT ? c.inf(I_HOG)[l * 64 + l31] : 0.f, og1 = OUT ? c.inf(I_HOG)[l * 64 + 32 + l31] : 0.f;
        u32x4 rf[4], rq[4], rv[4];
        { const bf16_t* zn = Z + (size_t)(tok0 + (c.lane >> 3)) * ZP + h * 64 + (c.lane & 7) * 8;
#pragma unroll
            for (int i = 0; i < 4; ++i) { rf[i] = *(const u32x4*)(zn + (size_t)i * 8 * ZP + Z_HF); rv[i] = *(const u32x4*)(zn + (size_t)i * 8 * ZP + Z_HI); if (OUT) rq[i] = *(const u32x4*)(zn + (size_t)i * 8 * ZP + Z_HQ); else rq[i] = (u32x4){0u, 0u, 0u, 0u}; } }
#pragma unroll 1
        for (int sc = 0; sc < 4; ++sc) { const int tokb = tok0 + sc * 32;
            {
                const int rr = c.lane >> 3, c8 = (c.lane & 7) * 8;
#pragma unroll
                for (int i = 0; i < 4; ++i) { const int tr = i * 8 + rr; float x[8];
                    { const u32x4 v = rf[i]; x[0] = bflo(v.x); x[1] = bfhi(v.x); x[2] = bflo(v.y); x[3] = bfhi(v.y); x[4] = bflo(v.z); x[5] = bfhi(v.z); x[6] = bflo(v.w); x[7] = bfhi(v.w); }
                    *(f32x4*)(Lg + tr * HGP + c8) = (f32x4){x[0], x[1], x[2], x[3]}; *(f32x4*)(Lg + tr * HGP + c8 + 4) = (f32x4){x[4], x[5], x[6], x[7]};
                    if (OUT) { const u32x4 v = rq[i]; x[0] = fsilu(bflo(v.x)); x[1] = fsilu(bfhi(v.x)); x[2] = fsilu(bflo(v.y)); x[3] = fsilu(bfhi(v.y)); x[4] = fsilu(bflo(v.z)); x[5] = fsilu(bfhi(v.z)); x[6] = fsilu(bflo(v.w)); x[7] = fsilu(bfhi(v.w));
                        *(f32x4*)(Lq + tr * HGP + c8) = (f32x4){x[0], x[1], x[2], x[3]}; *(f32x4*)(Lq + tr * HGP + c8 + 4) = (f32x4){x[4], x[5], x[6], x[7]}; }
                    { const u32x4 v = rv[i]; const unsigned w4[4] = {v.x, v.y, v.z, v.w};
#pragma unroll
                        for (int k = 0; k < 4; ++k) { Lvt[(c8 + 2 * k) * HGV + tr] = (bf16_t)(w4[k] & 0xffffu); Lvt[(c8 + 2 * k + 1) * HGV + tr] = (bf16_t)(w4[k] >> 16); } } }
                if (sc < 3) { const bf16_t* zn = Z + (size_t)(tokb + 32 + rr) * ZP + h * 64 + c8;
#pragma unroll
                    for (int i = 0; i < 4; ++i) { rf[i] = *(const u32x4*)(zn + (size_t)i * 8 * ZP + Z_HF); rv[i] = *(const u32x4*)(zn + (size_t)i * 8 * ZP + Z_HI); if (OUT) rq[i] = *(const u32x4*)(zn + (size_t)i * 8 * ZP + Z_HQ); } }
                __builtin_amdgcn_wave_barrier();
                float run = 0.f;
#pragma unroll
                for (int t = 0; t < 32; ++t) { const float f = lbd + (1.0f - lbd) * fsigmoid(Lg[t * HGP + c.lane]); run += __builtin_amdgcn_logf(f); Lg[t * HGP + c.lane] = run; Lk[t * HGP + c.lane] = 1.0f - f; }
                LG[c.lane] = run; LeG[c.lane] = __builtin_amdgcn_exp2f(run); gtot += run;
            }
            __builtin_amdgcn_wave_barrier();
            bf16x8 vt[2][2];
#pragma unroll
            for (int nf = 0; nf < 2; ++nf)
#pragma unroll
                for (int ks = 0; ks < 2; ++ks) vt[nf][ks] = *(const bf16x8*)(Lvt + (32 * nf + l31) * HGV + 16 * ks + 8 * hi);
            f32x16 O[2];
            if (OUT) {
#pragma unroll
                for (int r = 0; r < 16; ++r) { O[0][r] = 0.f; O[1][r] = 0.f; }
                float acc[8];
#pragma unroll
                for (int m = 0; m < 8; ++m) acc[m] = 0.f;
                const int sb = (l31 & 16) + 8 * hi;
#pragma unroll 1
                for (int d4 = 0; d4 < 16; ++d4) { const f32x4 qt = *(const f32x4*)(Lq + l31 * HGP + 4 * d4), gt = *(const f32x4*)(Lg + l31 * HGP + 4 * d4);
#pragma unroll
                    for (int mg = 0; mg < 4; ++mg) {
                        f32x4 k4[2], g4[2];
#pragma unroll
                        for (int j = 0; j < 2; ++j) { const int s = sb + 2 * mg + j; k4[j] = *(const f32x4*)(Lk + s * HGP + 4 * d4); g4[j] = *(const f32x4*)(Lg + s * HGP + 4 * d4); }
                        __builtin_amdgcn_sched_barrier(0);
#pragma unroll
                        for (int j = 0; j < 2; ++j)
#pragma unroll
                            for (int e = 0; e < 4; ++e) acc[mg * 2 + j] += qt[e] * k4[j][e] * __builtin_amdgcn_exp2f(gt[e] - g4[j][e]);
                        __builtin_amdgcn_sched_barrier(0); } }
                bf16x8 af[2], afx;
                { float a8[8];
#pragma unroll
                    for (int j = 0; j < 8; ++j) a8[j] = (sb + j <= l31) ? acc[j] : 0.f;
                    const bf16x8 ad = __builtin_bit_cast(bf16x8, pk8p(a8)), az = (bf16x8){0, 0, 0, 0, 0, 0, 0, 0};
                    af[0] = (l31 < 16) ? ad : az; af[1] = (l31 < 16) ? az : ad; }
                {
                    f32x16 dx;
#pragma unroll
                    for (int r = 0; r < 16; ++r) dx[r] = 0.f;
                    const bool lowr = l31 < 16; const float* Lx = lowr ? Lk : Lq;
#pragma unroll
                    for (int kk = 0; kk < 4; ++kk) { const int d0 = 16 * kk + 8 * hi;
                        const f32x4 xa = *(const f32x4*)(Lx + l31 * HGP + d0), xb = *(const f32x4*)(Lx + l31 * HGP + d0 + 4), ga = *(const f32x4*)(Lg + l31 * HGP + d0), gb = *(const f32x4*)(Lg + l31 * HGP + d0 + 4),
                                    ma = *(const f32x4*)(Lg + 15 * HGP + d0), mb = *(const f32x4*)(Lg + 15 * HGP + d0 + 4);
                        float v8[8];
#pragma unroll
                        for (int j = 0; j < 4; ++j) { const float da = ga[j] - ma[j], db = gb[j] - mb[j];
                            v8[j] = xa[j] * __builtin_amdgcn_exp2f(lowr ? -da : da); v8[4 + j] = xb[j] * __builtin_amdgcn_exp2f(lowr ? -db : db); }
                        const bf16x8 vv = __builtin_bit_cast(bf16x8, pk8p(v8)), zz = (bf16x8){0, 0, 0, 0, 0, 0, 0, 0};
                        dx = MFMA32(lowr ? vv : zz, lowr ? zz : vv, dx); }
                    float x8[8];
#pragma unroll
                    for (int j = 0; j < 8; ++j) x8[j] = dx[j];
                    afx = __builtin_bit_cast(bf16x8, pk8(x8)); }
#pragma unroll
                for (int mf = 0; mf < 2; ++mf)
#pragma unroll
                    for (int s = 0; s < 2; ++s) { const int d0 = 32 * mf + 16 * s + 4 * hi;
                        const f32x4 qa = *(const f32x4*)(Lq + l31 * HGP + d0), qb = *(const f32x4*)(Lq + l31 * HGP + d0 + 8), ga = *(const f32x4*)(Lg + l31 * HGP + d0), gb = *(const f32x4*)(Lg + l31 * HGP + d0 + 8);
                        float q8[8];
#pragma unroll
                        for (int j = 0; j < 4; ++j) { q8[j] = qa[j] * __builtin_amdgcn_exp2f(ga[j]); q8[4 + j] = qb[j] * __builtin_amdgcn_exp2f(gb[j]); }
                        const bf16x8 qf = __builtin_bit_cast(bf16x8, pk8p(q8));
#pragma unroll
                        for (int nf = 0; nf < 2; ++nf) { float s8[8];
#pragma unroll
                            for (int j = 0; j < 8; ++j) s8[j] = S[mf][nf][8 * s + j];
                            O[nf] = MFMA32(qf, __builtin_bit_cast(bf16x8, pk8p(s8)), O[nf]); } }
#pragma unroll
                for (int nf = 0; nf < 2; ++nf) {
#pragma unroll
                    for (int ks = 0; ks < 2; ++ks) O[nf] = MFMA32(af[ks], vt[nf][ks], O[nf]);
                    const s16x4 p0 = *(const s16x4*)(Lvt + (32 * nf + l31) * HGV + 4 * hi), p1 = *(const s16x4*)(Lvt + (32 * nf + l31) * HGV + 8 + 4 * hi);
                    O[nf] = MFMA32(afx, ((bf16x8){p0[0], p0[1], p0[2], p0[3], p1[0], p1[1], p1[2], p1[3]}), O[nf]); }
            }
#pragma unroll
            for (int mf = 0; mf < 2; ++mf) {
#pragma unroll
                for (int q = 0; q < 4; ++q) { const f32x4 e4 = *(const f32x4*)(LeG + 32 * mf + 8 * q + 4 * hi);
#pragma unroll
                    for (int e = 0; e < 4; ++e) { S[mf][0][4 * q + e] *= e4[e]; S[mf][1][4 * q + e] *= e4[e]; } }
                const int d = 32 * mf + l31; const float Gd = LG[d];
#pragma unroll
                for (int ks = 0; ks < 2; ++ks) { float k8[8];
#pragma unroll
                    for (int j = 0; j < 8; ++j) { const int s = 16 * ks + 8 * hi + j; k8[j] = Lk[s * HGP + d] * __builtin_amdgcn_exp2f(Gd - Lg[s * HGP + d]); }
                    const bf16x8 kf = __builtin_bit_cast(bf16x8, pk8p(k8));
                    S[mf][0] = MFMA32(kf, vt[0][ks], S[mf][0]); S[mf][1] = MFMA32(kf, vt[1][ks], S[mf][1]); } }
            if (OUT) {
                {
                    const int rr = c.lane >> 3, c8 = (c.lane & 7) * 8; const bf16_t* zg = Z + (size_t)(tokb + rr) * ZP + Z_HG + h * 64 + c8; u32x2 gv[4];
#pragma unroll
                    for (int hf = 0; hf < 2; ++hf) {
#pragma unroll
                    for (int i = 0; i < 4; ++i) gv[i] = *(const u32x2*)(zg + (size_t)i * 8 * ZP + 4 * hf);
#pragma unroll
                    for (int i = 0; i < 4; ++i) { const u32x2 v = gv[i]; *(f32x4*)(Lq + (i * 8 + rr) * HGP + c8 + 4 * hf) = (f32x4){fsilu(bflo(v.x)), fsilu(bfhi(v.x)), fsilu(bflo(v.y)), fsilu(bfhi(v.y))}; } }
                }
                __builtin_amdgcn_wave_barrier();
#pragma unroll
                for (int r = 0; r < 16; ++r) { const int tl = (r & 3) + 8 * (r >> 2) + 4 * hi; float ss = O[0][r] * O[0][r] + O[1][r] * O[1][r];
                    ss = half_sum(ss, hi);
                    const float rinv = frsqrt(ss * (1.0f / 64.0f) + EPS); const size_t tok = (size_t)(tokb + tl);
                    const float g0 = Lq[tl * HGP + l31], g1 = Lq[tl * HGP + 32 + l31];
                    bf16_t* yo = c.w<bf16_t>(WS_YB) + tok * 1024 + 512 + h * 64;
                    yo[l31] = (bf16_t)f2bf_bits(O[0][r] * rinv * og0 * g0); yo[32 + l31] = (bf16_t)f2bf_bits(O[1][r] * rinv * og1 * g1); } }
            __builtin_amdgcn_wave_barrier();
        }
        if (!OUT) { float* sc = c.w<float>(WS_SC) + (size_t)(bh * NCH + chunk) * 4096;
#pragma unroll
            for (int mf = 0; mf < 2; ++mf)
#pragma unroll
                for (int nf = 0; nf < 2; ++nf)
#pragma unroll
                    for (int r = 0; r < 16; ++r) sc[(32 * mf + (r & 3) + 8 * (r >> 2) + 4 * hi) * 64 + 32 * nf + l31] = S[mf][nf][r];
            c.w<float>(WS_PC)[(size_t)(bh * NCH + chunk) * 64 + c.lane] = __builtin_amdgcn_exp2f(gtot); }
    } else if (OUT && cvt_layer < NL) {
        cvt_wave(c, cvt_layer, bu * 4 + (c.wid - 4), NBH * NCH, (float*)(c.lds + 4 * HG_BYTES + (c.wid - 4) * 8448));
    }
    __syncthreads();
}
__device__ __forceinline__ void hgrn_carry(const Ctx& c_, int l) { const Ctx c = fresh(c_);
    const float* SC = c.w<float>(WS_SC); const float* PC = c.w<float>(WS_PC); float* S0 = c.w<float>(WS_S0);
    for (int e = c.blk * 512 + c.tid; e < NBH * 4096; e += c.G * 512) { const int bh = e >> 12, dv = e & 4095, d = dv >> 6; float s = 0.f;
#pragma unroll 8
        for (int ch = 0; ch < NCH; ++ch) { const size_t o = (size_t)(bh * NCH + ch) * 4096 + dv; S0[o] = s; s = PC[(size_t)(bh * NCH + ch) * 64 + d] * s + SC[o]; } }
    ASMV("s_waitcnt vmcnt(0)" ::: "memory");
    __syncthreads();
    if (c.tid == 0) { __builtin_amdgcn_fence(__ATOMIC_RELEASE, "agent"); ASMV("s_waitcnt vmcnt(0)" ::: "memory");
        (void)__hip_atomic_fetch_add((unsigned*)(c.ws + WS_CTL + CTL_HG) + l * 64, 1u, __ATOMIC_RELAXED, __HIP_MEMORY_SCOPE_AGENT); }
}
__device__ __forceinline__ void hgrn_wait_carry(const Ctx& c, int l) {
    if (c.tid == 0) { unsigned* p = (unsigned*)(c.ws + WS_CTL + CTL_HG) + l * 64; unsigned sp = 0;
        while (__hip_atomic_load(p, __ATOMIC_RELAXED, __HIP_MEMORY_SCOPE_AGENT) < (unsigned)c.G) { __builtin_amdgcn_s_sleep(1); if (++sp > (1u << 22)) break; }
        __builtin_amdgcn_fence(__ATOMIC_ACQUIRE, "agent"); ASMV("s_waitcnt vmcnt(0)" ::: "memory"); }
    __syncthreads();
}
__device__ __forceinline__ void ph_mixers(const Ctx& c, int l) {
    if (c.blk & 1) for (int bu = c.blk; bu < NBH * NCH / 4; bu += c.G) hgrn_mfma<false>(c, l, bu);
    for (int u = c.blk; u < NTOK / 32; u += c.G) mix_unit(c, l, u * 32);
    if (!(c.blk & 1)) for (int bu = c.blk; bu < NBH * NCH / 4; bu += c.G) hgrn_mfma<false>(c, l, bu);
}

template <bool FIXED>
__device__ __forceinline__ void attn_unit(const Ctx& c_, int bh, int qt, float negM) { const Ctx c = fresh(c_);
    const bf16_t* Qg = c.w<bf16_t>(WS_Q) + (size_t)bh * SEQ * 96; const bf16_t* Kg = c.w<bf16_t>(WS_K) + (size_t)bh * SEQ * 96; const bf16_t* Vg = c.w<bf16_t>(WS_VT) + (size_t)bh * 64 * SEQ;
    constexpr int KROW = 104, VROW = 72, KB = 64 * KROW * 2, VB = 64 * VROW * 2;
    const int l31 = c.lane & 31, hi = c.lane >> 5, qrow = qt * 256 + c.wid * 32 + l31;
    bf16x8 qf[6];
#pragma unroll
    for (int ks = 0; ks < 6; ++ks) qf[ks] = *(const bf16x8*)(Qg + (size_t)qrow * 96 + ks * 16 + hi * 8);
    f32x16 o0, o1;
#pragma unroll
    for (int r = 0; r < 16; ++r) { o0[r] = 0.f; o1[r] = 0.f; }
    float mrun = -INFINITY, lsum = 0.f; f32x2 lsum2 = {0.f, 0.f};
    const int nkt = 4 * (qt + 1), mylast = 4 * qt + (c.wid >> 1);
    const int kr0 = c.tid / 12, kc0 = c.tid % 12, kr1 = (c.tid + 512) / 12, kc1 = (c.tid + 512) % 12, vr = c.tid >> 3, vc = c.tid & 7;
    u32x4 sk0[2], sk1[2], sv[2];
    auto gload = [&](int j) {
#pragma unroll
        for (int h = 0; h < 2; ++h) { const int kt = 2 * j + h; sk0[h] = *(const u32x4*)(Kg + (size_t)(kt * 64 + kr0) * 96 + kc0 * 8); if (c.tid < 256) sk1[h] = *(const u32x4*)(Kg + (size_t)(kt * 64 + kr1) * 96 + kc1 * 8);
                               sv[h] = *(const u32x4*)(Vg + (size_t)vr * SEQ + kt * 64 + vc * 8); } };
    auto lstore = [&](int buf) {
#pragma unroll
        for (int h = 0; h < 2; ++h) { unsigned char* kb = c.lds + (buf * 2 + h) * (KB + VB); unsigned char* vb = kb + KB;
                                 *(u32x4*)(kb + (kr0 * KROW + kc0 * 8) * 2) = sk0[h]; if (c.tid < 256) *(u32x4*)(kb + (kr1 * KROW + kc1 * 8) * 2) = sk1[h]; *(u32x4*)(vb + (vr * VROW + vc * 8) * 2) = sv[h]; } };
    gload(0); lstore(0); __syncthreads();
    auto tile = [&](const int kt, auto masked) {
            const bf16_t* kb = (const bf16_t*)(c.lds + (kt & 3) * (KB + VB)); const bf16_t* vb = (const bf16_t*)(c.lds + (kt & 3) * (KB + VB) + KB);
            f32x16 s0, s1;
#pragma unroll
            for (int r = 0; r < 16; ++r) { s0[r] = FIXED ? negM : 0.f; s1[r] = FIXED ? negM : 0.f; }
#pragma unroll
            for (int ks = 0; ks < 6; ++ks) { const bf16x8 k0 = *(const bf16x8*)(kb + l31 * KROW + ks * 16 + hi * 8), k1 = *(const bf16x8*)(kb + (32 + l31) * KROW + ks * 16 + hi * 8);
                s0 = MFMA32(k0, qf[ks], s0); s1 = MFMA32(k1, qf[ks], s1); }
            if constexpr (decltype(masked)::value) {
#pragma unroll
                for (int r = 0; r < 16; ++r) { const int key = kt * 64 + (r & 3) + 8 * (r >> 2) + 4 * hi; if (key > qrow) s0[r] = -INFINITY; if (key + 32 > qrow) s1[r] = -INFINITY; } }
            if constexpr (FIXED) {
#pragma unroll
                for (int r = 0; r < 16; ++r) { s0[r] = __builtin_amdgcn_exp2f(s0[r]); s1[r] = __builtin_amdgcn_exp2f(s1[r]); }
#pragma unroll
                for (int r = 0; r < 16; r += 2) { lsum2 += (f32x2){s0[r], s0[r + 1]}; lsum2 += (f32x2){s1[r], s1[r + 1]}; }
            } else {
            float mx = s0[0];
#pragma unroll
            for (int r = 1; r < 16; ++r) mx = fmaxf(mx, s0[r]);
#pragma unroll
            for (int r = 0; r < 16; ++r) mx = fmaxf(mx, s1[r]);
            mx = fmaxf(mx, __shfl_xor(mx, 32));
            const float mnew = fmaxf(mrun, mx), alpha = __builtin_amdgcn_exp2f(mrun - mnew); mrun = mnew;
            float ps = 0.f;
#pragma unroll
            for (int r = 0; r < 16; ++r) { s0[r] = __builtin_amdgcn_exp2f(s0[r] - mnew); s1[r] = __builtin_amdgcn_exp2f(s1[r] - mnew); ps += s0[r] + s1[r]; }
            lsum = lsum * alpha + ps;
#pragma unroll
            for (int r = 0; r < 16; ++r) { o0[r] *= alpha; o1[r] *= alpha; }
            }
#pragma unroll
            for (int kf = 0; kf < 2; ++kf)
#pragma unroll
                for (int s = 0; s < 2; ++s) { const f32x16& sx = kf ? s1 : s0; u32x4 pw; pw.x = cvt_pk_bf16(sx[8 * s], sx[8 * s + 1]); pw.y = cvt_pk_bf16(sx[8 * s + 2], sx[8 * s + 3]); pw.z = cvt_pk_bf16(sx[8 * s + 4], sx[8 * s + 5]); pw.w = cvt_pk_bf16(sx[8 * s + 6], sx[8 * s + 7]);
                    const bf16x8 pf = __builtin_bit_cast(bf16x8, pw); const int kcol = kf * 32 + 16 * s + 4 * hi;
                    const s16x4 a0 = *(const s16x4*)(vb + l31 * VROW + kcol), a1 = *(const s16x4*)(vb + l31 * VROW + kcol + 8), b0 = *(const s16x4*)(vb + (32 + l31) * VROW + kcol), b1 = *(const s16x4*)(vb + (32 + l31) * VROW + kcol + 8);
                    const bf16x8 v0 = (bf16x8){a0[0], a0[1], a0[2], a0[3], a1[0], a1[1], a1[2], a1[3]}, v1 = (bf16x8){b0[0], b0[1], b0[2], b0[3], b1[0], b1[1], b1[2], b1[3]};
                    o0 = MFMA32(v0, pf, o0); o1 = MFMA32(v1, pf, o1); }
            };
    const int nkj = nkt >> 1, jl = mylast >> 1;
    int j = 0;
    for (; j < jl; ++j) { gload(j + 1); tile(2 * j, std::false_type{}); tile(2 * j + 1, std::false_type{}); lstore((j + 1) & 1); __syncthreads(); }
    { if (mylast & 1) { tile(2 * j, std::false_type{}); tile(2 * j + 1, std::true_type{}); } else tile(2 * j, std::true_type{});
      if (j + 1 < nkj) { gload(j + 1); lstore((j + 1) & 1); }
      __syncthreads(); ++j; }
    for (; j < nkj; ++j) { if (j + 1 < nkj) { gload(j + 1); lstore((j + 1) & 1); } __syncthreads(); }
    if constexpr (FIXED) lsum = lsum2[0] + lsum2[1];
    lsum += __shfl_xor(lsum, 32); const float rl = 1.0f / lsum;
    const int b = bh >> 2, h = bh & 3; bf16_t* yo = c.w<bf16_t>(WS_YB) + (size_t)(b * SEQ + qrow) * 1024 + h * 64;
#pragma unroll
    for (int g = 0; g < 4; ++g) { const int dv = 8 * g + 4 * hi; u32x2 w0, w1;
        w0.x = cvt_pk_bf16(o0[4 * g] * rl, o0[4 * g + 1] * rl); w0.y = cvt_pk_bf16(o0[4 * g + 2] * rl, o0[4 * g + 3] * rl); *(u32x2*)(yo + dv) = w0;
        w1.x = cvt_pk_bf16(o1[4 * g] * rl, o1[4 * g + 1] * rl); w1.y = cvt_pk_bf16(o1[4 * g + 2] * rl, o1[4 * g + 3] * rl); *(u32x2*)(yo + 32 + dv) = w1; }
    __syncthreads();
}
template <bool FIXED>
__device__ __forceinline__ void attn_units(const Ctx& c, float negM) {
    { const int NU = NBH * (NQT / 2);
      if ((c.G & 7) == 0) { const int per = (NU + 7) / 8, x = c.blk & 7, G8 = c.G >> 3;
          for (int j = c.blk >> 3; j < per; j += G8) { const int pu = x * per + j; if (pu < NU) { const int bh = pu / (NQT / 2), p = pu % (NQT / 2); attn_unit<FIXED>(c, bh, NQT - 1 - p, negM); attn_unit<FIXED>(c, bh, p, negM); } } }
      else for (int pu = c.blk; pu < NU; pu += c.G) { const int bh = pu / (NQT / 2), p = pu % (NQT / 2); attn_unit<FIXED>(c, bh, NQT - 1 - p, negM); attn_unit<FIXED>(c, bh, p, negM); } }
}
__device__ __forceinline__ void ph_attn(const Ctx& c, int l) {
    hgrn_carry(c, l);
    {
        const float* qg = c.inf(I_QG) + l * 96; const float* kg = c.inf(I_KG) + l * 96;
        int ln = c.lane; LAUNDER_V(ln);
        float gq = fmaxf(fabsf(qg[ln]), fabsf(qg[32 + (ln & 63)])), gk = fmaxf(fabsf(kg[ln]), fabsf(kg[32 + (ln & 63)]));
#pragma unroll
        for (int o = 1; o < 64; o <<= 1) { gq = fmaxf(gq, __shfl_xor(gq, o)); gk = fmaxf(gk, __shfl_xor(gk, o)); }
        const float M = 9.797958971132712f * 1.44269504089f * 1.02f * gq * gk;
        if (M <= 60.0f) attn_units<true>(c, -M); else attn_units<false>(c, 0.f); }
    hgrn_wait_carry(c, l);
    for (int bu = c.blk; bu < NBH * NCH / 4; bu += c.G) hgrn_mfma<true>(c, l, bu, l + 1);
}

__device__ __forceinline__ void ph_router(const Ctx& c_, int l, int cnt_off = 0) { const Ctx c = fresh(c_);
    bf16_t* Whi = (bf16_t*)c.lds; bf16_t* Wlo = (bf16_t*)(c.lds + 73728); float* Llog = (float*)(c.lds + 147456) + c.wid * 288; float* Lcb = (float*)(c.lds + 156672);
    int* Le = (int*)(c.lds + 156672 + 256); float* Lw = (float*)(c.lds + 156672 + 256 + 1024); int* Lr = (int*)(c.lds + 156672 + 256 + 2048); int* Lcnt = (int*)(c.lds + 156672 + 256 + 3072); int* Lbase = Lcnt + 32;
    const float* rwt = c.w<float>(WS_RWT + (size_t)(l & 1) * WSET);
    const float* rgb = c.inf(I_RGB) + l * 4; const float* reb = c.inf(I_REB) + l * 32;
    const bf16_t* x = c.w<bf16_t>(WS_XB); const float* gn = c.inf(I_N2G) + l * 1024; const float* mod = c.w<float>(WS_MOD) + (size_t)l * NB * 6144; bf16_t* ha = c.w<bf16_t>(WS_HA);
    unsigned* cnt = (unsigned*)(c.ws + WS_CTL + CTL_CNT) + l * 32 + cnt_off;
    int* rowtok = c.w<int>(WS_ROWTOK); float* roww = c.w<float>(WS_ROWW);
    const int fr = c.lane & 15, fq = c.lane >> 4;
    int staged_b = -1;
    for (int u = c.blk; u < NTOK / 128; u += c.G) {
        const int b = (u * 128) / SEQ; const float* sh = mod + b * 6144 + 3072; const float* sc = sh + 1024;
        __syncthreads();
        if (b != staged_b) { staged_b = b;
            for (int q = c.tid; q < 36 * 128; q += 512) { const int n = q >> 7, ch = q & 127, k0 = ch * 8; float hi8[8], lo8[8];
#pragma unroll
                for (int j = 0; j < 8; ++j) { const float w = rwt[n * 1024 + k0 + j] * gn[k0 + j] * (1.0f + sc[k0 + j]); const float h = bf2f((bf16_t)f2bf_bits(w)); hi8[j] = h; lo8[j] = w - h; }
                const int pc = (ch ^ (n & 15)) * 8; *(u32x4*)(Whi + n * 1024 + pc) = pk8(hi8); *(u32x4*)(Wlo + n * 1024 + pc) = pk8(lo8); }
            for (int g = c.wid; g < 36; g += 8) { float s = 0.f;
#pragma unroll
                for (int i = 0; i < 4; ++i) { const f32x4 w = *(const f32x4*)(rwt + g * 1024 + i * 256 + c.lane * 4), s4 = *(const f32x4*)(sh + i * 256 + c.lane * 4); s += w[0] * s4[0] + w[1] * s4[1] + w[2] * s4[2] + w[3] * s4[3]; }
                s = wave_sum(s); if (c.lane == 0) Lcb[g] = s + (g < 4 ? rgb[g] : reb[g - 4]); } }
        if (c.tid < 32) Lcnt[c.tid] = 0;
        __syncthreads();
        const int rowb = u * 128 + c.wid * 16; const bf16_t* xr = x + (size_t)(rowb + fr) * 1024 + 8 * fq;
        f32x4 acc[3] = {{0.f, 0.f, 0.f, 0.f}, {0.f, 0.f, 0.f, 0.f}, {0.f, 0.f, 0.f, 0.f}}; float ssp = 0.f;
#pragma unroll 8
        for (int ks = 0; ks < 32; ++ks) { const u32x4 hw = *(const u32x4*)(xr + 32 * ks);
            const unsigned hws[4] = {hw.x, hw.y, hw.z, hw.w};
#pragma unroll
            for (int j = 0; j < 4; ++j) { const float a = bflo(hws[j]), b = bfhi(hws[j]); ssp += a * a + b * b; }
            const bf16x8 ah = __builtin_bit_cast(bf16x8, hw);
            const int ch = 4 * ks + fq;
#pragma unroll
            for (int nf = 0; nf < 3; ++nf) { const int n = 16 * nf + fr; bf16x8 bh = {0, 0, 0, 0, 0, 0, 0, 0}, bl = bh;
                if (nf < 2 || fr < 4) { const int pc = (ch ^ (n & 15)) * 8; bh = *(const bf16x8*)(Whi + n * 1024 + pc); bl = *(const bf16x8*)(Wlo + n * 1024 + pc); }
                acc[nf] = MFMA16(ah, bh, acc[nf]); acc[nf] = MFMA16(ah, bl, acc[nf]); } }
        ssp += __shfl_xor(ssp, 16); ssp += __shfl_xor(ssp, 32);
        const float rinv = frsqrt(ssp * (1.0f / 1024.0f) + EPS);
        float rj[4];
#pragma unroll
        for (int j = 0; j < 4; ++j) rj[j] = __shfl(rinv, fq * 4 + j);
#pragma unroll
        for (int half = 0; half < 2; ++half) {
            if ((fq >> 1) == half) {
#pragma unroll
                for (int nf = 0; nf < 3; ++nf) { const int col = 16 * nf + fr; if (col < 36) {
#pragma unroll
                    for (int j = 0; j < 4; ++j) Llog[((fq & 1) * 4 + j) * 36 + col] = acc[nf][j] * rj[j] + Lcb[col]; } } }
            __builtin_amdgcn_wave_barrier();
            if (c.lane < 8) { const float* lg = Llog + c.lane * 36; const int rl = c.wid * 16 + half * 8 + c.lane;
                int gi = 0; float gm = lg[0];
#pragma unroll
                for (int g = 1; g < 4; ++g) { const float t = lg[g]; if (t > gm) { gm = t; gi = g; } }
                float den = 0.f;
#pragma unroll
                for (int g = 0; g < 4; ++g) den += expf(lg[g] - gm);
                const float gw = 1.0f / den;
                float e1 = -INFINITY, e2 = -INFINITY; int i1 = 0, i2 = 0;
#pragma unroll
                for (int j = 0; j < 8; ++j) { const float t = lg[4 + gi * 8 + j]; if (t > e1) { e2 = e1; i2 = i1; e1 = t; i1 = j; } else if (t > e2) { e2 = t; i2 = j; } }
                const float p2 = expf(e2 - e1), w1 = gw / (1.0f + p2), w2 = gw * p2 / (1.0f + p2);
                const int ea = gi * 8 + i1, eb = gi * 8 + i2; Le[rl * 2] = ea; Le[rl * 2 + 1] = eb; Lw[rl * 2] = w1; Lw[rl * 2 + 1] = w2;
                Lr[rl * 2] = atomicAdd(&Lcnt[ea], 1); Lr[rl * 2 + 1] = atomicAdd(&Lcnt[eb], 1); }
            __builtin_amdgcn_wave_barrier();
        }
#pragma unroll 8
        for (int ks = 0; ks < 32; ++ks) { const int k0 = 32 * ks + 8 * fq; const u32x4 xw = *(const u32x4*)(xr + 32 * ks); const f32x4 xa = {bflo(xw.x), bfhi(xw.x), bflo(xw.y), bfhi(xw.y)}, xb = {bflo(xw.z), bfhi(xw.z), bflo(xw.w), bfhi(xw.w)};
            const f32x4 ga = *(const f32x4*)(gn + k0) * (*(const f32x4*)(sc + k0) + 1.0f), gb = *(const f32x4*)(gn + k0 + 4) * (*(const f32x4*)(sc + k0 + 4) + 1.0f);
            const f32x4 ha4 = xa * rinv * ga + *(const f32x4*)(sh + k0), hb4 = xb * rinv * gb + *(const f32x4*)(sh + k0 + 4);
            u32x4 o; o.x = cvt_pk_bf16(ha4[0], ha4[1]); o.y = cvt_pk_bf16(ha4[2], ha4[3]); o.z = cvt_pk_bf16(hb4[0], hb4[1]); o.w = cvt_pk_bf16(hb4[2], hb4[3]);
            *(u32x4*)(ha + (size_t)(rowb + fr) * 1024 + k0) = o; }
        __syncthreads();
        if (c.tid < 32) Lbase[c.tid] = (int)__hip_atomic_fetch_add(&cnt[c.tid], (unsigned)Lcnt[c.tid], __ATOMIC_RELAXED, __HIP_MEMORY_SCOPE_AGENT);
        __syncthreads();
        if (c.tid < 256) { const int a = u * 256 + c.tid, e = Le[c.tid], dest = e * MOE_CAP + Lbase[e] + Lr[c.tid]; rowtok[dest] = a; roww[dest] = Lw[c.tid]; }
    }
    __syncthreads();
}
constexpr int LDS_MOETAB = 131072;
__device__ __forceinline__ void moe_tables(const Ctx& c_, int l) { const Ctx c = fresh(c_);
    int* tab = (int*)(c.lds + LDS_MOETAB); unsigned* cnt = (unsigned*)(c.ws + WS_CTL + CTL_CNT) + l * 32;
    __syncthreads();
    if (c.tid < 32) tab[c.tid] = (int)__hip_atomic_load(&cnt[c.tid], __ATOMIC_RELAXED, __HIP_MEMORY_SCOPE_AGENT);
    __syncthreads();
    if (c.tid == 0) { int acc = 0; for (int e = 0; e < 32; ++e) { tab[32 + e] = acc; acc += (tab[e] + 255) >> 8; } tab[64] = acc; }
    __syncthreads();
    if (c.tid < 32) for (int t2 = tab[32 + c.tid]; t2 < tab[33 + c.tid]; ++t2) tab[72 + t2] = c.tid;
    __syncthreads();
}
__device__ __forceinline__ void ph_final(const Ctx& c_) { const Ctx c = fresh(c_);
    float* out = c.a->out; const bf16_t* y1 = c.w<bf16_t>(WS_Y1);
    const bf16_t* xb = c.w<bf16_t>(WS_XB);
    for (size_t e = (size_t)c.blk * 512 + c.tid; e < (size_t)NTOK * 128; e += (size_t)c.G * 512) { const u32x4 y = *(const u32x4*)(y1 + e * 8), xw = *(const u32x4*)(xb + e * 8);
        *(f32x4*)(out + e * 8) = (f32x4){bflo(xw.x), bfhi(xw.x), bflo(xw.y), bfhi(xw.y)} + (f32x4){bflo(y.x), bfhi(y.x), bflo(y.y), bfhi(y.y)};
        *(f32x4*)(out + e * 8 + 4) = (f32x4){bflo(xw.z), bfhi(xw.z), bflo(xw.w), bfhi(xw.w)} + (f32x4){bflo(y.z), bfhi(y.z), bflo(y.w), bfhi(y.w)}; }
}

constexpr int PH_PER_LAYER = 8, N_PHASES = 2 + PH_PER_LAYER * NL + 1;
__global__ void __launch_bounds__(512, 2) mk_fwd(Args args) {
#ifdef EMU
    unsigned char* lds = emu_lds();
#else
    extern __shared__ __attribute__((aligned(16))) unsigned char lds[];
#endif
    Ctx c; c.a = &args; c.ws = args.ws; c.lds = lds; c.tid = threadIdx.x; c.wid = __builtin_amdgcn_readfirstlane(c.tid >> 6); c.lane = c.tid & 63; c.G = gridDim.x; c.blk = blockIdx.x;
    if (c.tid == 0) *(uint4*)(lds + LDS_XB) = make_uint4(0u, 0u, 0u, 0u);
    __syncthreads();
    XcdBarrier bar; bar.bar = (unsigned*)(args.ws + WS_CTL); bar.x = 0; bar.st = (volatile LAS unsigned*)(lds + LDS_XB);
    if (args.ph_hi - args.ph_lo > 1) bar = xcd_barrier_post((unsigned*)(args.ws + WS_CTL), (volatile LAS unsigned*)(lds + LDS_XB));
    int ph = 0;
#ifndef PHMASK
#define PHMASK 0xFFFFF
#endif
#define PHASE(K, ...) do { if (ph >= args.ph_lo && ph < args.ph_hi) { if constexpr ((PHMASK >> K) & 1) { __VA_ARGS__; } if (ph + 1 < args.ph_hi) xcd_barrier(bar); } ++ph; } while (0)
    PHASE(0, ph_prologue0(c));
    PHASE(1, ph_prologue1(c));
    for (int l = 0; l < NL; ++l) {
        PHASE(2, if (l == 0) ph_cvt(c, 0); ph_normrows(c, l));
        PHASE(3, { pg8::Gemm g{c.w<bf16_t>(WS_HA), c.w<bf16_t>(WS_WIN + (size_t)(l & 1) * WSET), NTOK, ZP, 1024}; pg8::TailNarrowOrder S; S.init(NTOK, c.G, c.blk); pg8::EpiBf16 E{c.w<bf16_t>(WS_Z), ZP};
                pg8::gemm_phase<pg8::EpiBf16, pg8::TailNarrowOrder, true, true>((LAS unsigned char*)lds, g, S, E); });
        PHASE(4, ph_mixers(c, l));
        PHASE(5, ph_attn(c, l));
        PHASE(6, { pg8::Gemm g{c.w<bf16_t>(WS_YB), c.w<bf16_t>(WS_WOUT + (size_t)(l & 1) * WSET), NTOK, 1024, 1024}; pg8::StaticOrder S; S.init(NTOK, 1024, c.G, c.blk);
                pg8::EpiResid E{(l == 0) ? c.inf(I_X) : (const float*)nullptr, c.w<bf16_t>(WS_XB), c.w<bf16_t>(WS_XB), c.w<float>(WS_MOD) + (size_t)l * NB * 6144 + 2048, 6144, SEQ, c.w<bf16_t>(WS_Y1)};
                pg8::gemm_phase<pg8::EpiResid, pg8::StaticOrder, true, true>((LAS unsigned char*)lds, g, S, E); });
        PHASE(7, ph_router(c, l));
        PHASE(9, { pg8::Gemm g{c.w<bf16_t>(WS_HA), c.w<bf16_t>(WS_WUP + (size_t)(l & 1) * WSET), NR, 32 * 1024, 1024}; moe_tables(c, l); pg8::MoeOrder S{(const LAS int*)((LAS unsigned char*)lds + LDS_MOETAB), MOE_CAP, c.G, c.blk}; pg8::EpiSwiglu E{c.w<bf16_t>(WS_Q)};
                pg8::gemm_phase<pg8::EpiSwiglu, pg8::MoeOrder, true, true, true>((LAS unsigned char*)lds, g, S, E, c.w<int>(WS_ROWTOK)); });
        PHASE(10, { pg8::Gemm g{c.w<bf16_t>(WS_Q), c.w<bf16_t>(WS_WDN + (size_t)(l & 1) * WSET), NR, 32 * 1024, 512}; moe_tables(c, l); pg8::MoeOrder S{(const LAS int*)((LAS unsigned char*)lds + LDS_MOETAB), MOE_CAP, c.G, c.blk};
                pg8::EpiDown E{c.w<int>(WS_ROWTOK), c.w<float>(WS_ROWW), c.w<bf16_t>(WS_XB), c.w<bf16_t>(WS_Y1), c.w<float>(WS_MOD) + (size_t)l * NB * 6144 + 5120, 6144, SEQ};
                pg8::gemm_phase<pg8::EpiDown, pg8::MoeOrder, true, true>((LAS unsigned char*)lds, g, S, E); });
    }
    PHASE(11, ph_final(c));
#undef PHASE
}

extern "C" void kernel_launch(void* const* d_in, const int* in_sizes, int n_in, void* d_out, int out_size, void* d_ws, size_t ws_size, hipStream_t stream) {
    static int grid = 0;
    if (grid == 0) {
        if (n_in != 30 || out_size != NTOK * 1024 || ws_size < WS_END) { fprintf(stderr, "kernel_launch: shape/workspace mismatch (n_in %d out %d ws %zu need %zu)\n", n_in, out_size, ws_size, (size_t)WS_END); grid = -1; return; }
        int dev = 0, cus = 0;
        if (hipGetDevice(&dev) != hipSuccess || hipDeviceGetAttribute(&cus, hipDeviceAttributeMultiprocessorCount, dev) != hipSuccess) { grid = -1; return; }
        if (hipFuncSetAttribute((const void*)mk_fwd, hipFuncAttributeMaxDynamicSharedMemorySize, LDS_BYTES) != hipSuccess) { fprintf(stderr, "kernel_launch: hipFuncSetAttribute failed\n"); grid = -1; return; }
        int per_cu = 0; (void)hipOccupancyMaxActiveBlocksPerMultiprocessor(&per_cu, (const void*)mk_fwd, 512, LDS_BYTES);
        if (per_cu < 1) fprintf(stderr, "kernel_launch: occupancy query says %d blocks per CU\n", per_cu);
        grid = cus;
    }
    if (grid < 0) return;
    (void)hipMemsetAsync((char*)d_ws + WS_CTL, 0, CTL_BYTES, stream);
    Args a{};
    for (int i = 0; i < 30; ++i) a.in[i] = d_in[i];
    a.out = (float*)d_out; a.ws = (unsigned char*)d_ws;
#if MK_SPLIT
    for (int p = 0; p < N_PHASES; ++p) { a.ph_lo = p; a.ph_hi = p + 1;
#else
    { a.ph_lo = 0; a.ph_hi = N_PHASES;
#endif
#ifdef EMU
        EMU_LAUNCH(mk_fwd, grid, 512, LDS_BYTES, stream, a);
#else
        hipLaunchKernelGGL(mk_fwd, dim3(grid), dim3(512), LDS_BYTES, stream, a);
#endif
    }
}
```

```cpp
#include <hip/hip_runtime.h>
#include <cstdio>
#include <cstdint>
#include <type_traits>

#ifndef CFG_B
#define CFG_B 4
#endif
#ifndef CFG_S
#define CFG_S 8192
#endif
#ifndef CFG_L
#define CFG_L 4
#endif
#ifndef MK_SPLIT
#define MK_SPLIT 0
#endif

#ifdef EMU
#define ASMV(...) ((void)0)
#define LAS
#define LAUNDER_V(x) ((void)0)
#define LAUNDER_S(x) ((void)0)
#else
#define ASMV(...) asm volatile(__VA_ARGS__)
#define LAS __attribute__((address_space(3)))
#define LAUNDER_V(x) asm volatile("" : "+v"(x))
#define LAUNDER_S(x) asm volatile("" : "+s"(x))
#endif

typedef unsigned short bf16_t;
typedef short bf16x8 __attribute__((ext_vector_type(8)));
typedef short s16x4 __attribute__((ext_vector_type(4)));
typedef float f32x2 __attribute__((ext_vector_type(2)));
typedef float f32x4 __attribute__((ext_vector_type(4)));
typedef float f32x16 __attribute__((ext_vector_type(16)));
typedef unsigned u32x4 __attribute__((ext_vector_type(4)));
typedef unsigned u32x2 __attribute__((ext_vector_type(2)));

__device__ __forceinline__ float bf2f(bf16_t h) { return __builtin_bit_cast(float, (unsigned)h << 16); }
__device__ __forceinline__ float bflo(unsigned w) { return __builtin_bit_cast(float, w << 16); }
__device__ __forceinline__ float bfhi(unsigned w) { return __builtin_bit_cast(float, w & 0xffff0000u); }
__device__ __forceinline__ unsigned f2bf_bits(float f) { unsigned u = __builtin_bit_cast(unsigned, f); u += 0x7fffu + ((u >> 16) & 1u); return u >> 16; }
#ifdef EMU
__device__ __forceinline__ unsigned cvt_pk_bf16(float lo, float hi) { return f2bf_bits(lo) | (f2bf_bits(hi) << 16); }
__device__ __forceinline__ unsigned cvt_pk_bf16_pinned(float lo, float hi) { return f2bf_bits(lo) | (f2bf_bits(hi) << 16); }
#else
typedef __bf16 bf16v2_t __attribute__((ext_vector_type(2)));
typedef float f32v2_t __attribute__((ext_vector_type(2)));
__device__ __forceinline__ unsigned cvt_pk_bf16(float lo, float hi) { const bf16v2_t r = __builtin_convertvector((f32v2_t){lo, hi}, bf16v2_t); return __builtin_bit_cast(unsigned, r); }
__device__ __forceinline__ unsigned cvt_pk_bf16_pinned(float lo, float hi) { unsigned r; asm volatile("v_cvt_pk_bf16_f32 %0, %1, %2\n\ts_nop 1" : "=v"(r) : "v"(lo), "v"(hi)); return r; }
#endif
__device__ __forceinline__ float fast_exp(float x) { return __builtin_amdgcn_exp2f(x * 1.44269504089f); }
__device__ __forceinline__ float fsigmoid(float x) { return __builtin_amdgcn_rcpf(1.0f + fast_exp(-x)); }
__device__ __forceinline__ float fsilu(float x) { return x * fsigmoid(x); }
__device__ __forceinline__ float frsqrt(float x) { return __builtin_amdgcn_rsqf(x); }
#ifdef EMU
__device__ __forceinline__ float wave_sum(float v) {
#pragma unroll
    for (int m = 32; m >= 1; m >>= 1) v += __shfl_xor(v, m);
    return v;
}
#else
template <int CTRL, int ROW_MASK> __device__ __forceinline__ float dpp_t(float v) { return __builtin_bit_cast(float, __builtin_amdgcn_update_dpp(0, __builtin_bit_cast(int, v), CTRL, ROW_MASK, 0xF, false)); }
#define dpp_f(v, ctrl, rm) dpp_t<ctrl, rm>(v)
__device__ __forceinline__ float wave_sum(float v) {
    v += dpp_f(v, 0xB1, 0xF);
    v += dpp_f(v, 0x4E, 0xF);
    v += dpp_f(v, 0x141, 0xF);
    v += dpp_f(v, 0x140, 0xF);
    v += dpp_f(v, 0x142, 0xA);
    v += dpp_f(v, 0x143, 0xC);
    return __builtin_bit_cast(float, __builtin_amdgcn_readlane(__builtin_bit_cast(int, v), 63));
}
__device__ __forceinline__ float half_sum(float v, int hi) {
    v += dpp_f(v, 0xB1, 0xF); v += dpp_f(v, 0x4E, 0xF); v += dpp_f(v, 0x141, 0xF); v += dpp_f(v, 0x140, 0xF);
    v += dpp_f(v, 0x142, 0xA);
    const float a = __builtin_bit_cast(float, __builtin_amdgcn_readlane(__builtin_bit_cast(int, v), 31)), b = __builtin_bit_cast(float, __builtin_amdgcn_readlane(__builtin_bit_cast(int, v), 63));
    return hi ? b : a;
}
#endif
#ifdef EMU
__device__ __forceinline__ float half_sum(float v, int) {
#pragma unroll
    for (int m = 1; m < 32; m <<= 1) v += __shfl_xor(v, m);
    return v;
}
#endif

namespace pg8 {
#define PG8_LAS LAS
constexpr int BM = 256, BK = 64, HALF = 128, HTB = HALF * BK * 2  , STAGE_BYTES = 8 * HTB, NXCD = 8, WGM = 8;

__host__ __device__ __forceinline__ int lds_byte(int r, int c) { const int st = (r >> 4) * 2 + (c >> 5), rr = r & 15, cc = c & 31, ob = rr * 64 + cc * 2; return st * 1024 + (ob ^ (((ob >> 9) & 1) << 5)); }
__host__ __device__ __forceinline__ void stage_rc(int b, int& R, int& C) { const int st = b / 1024, sb = b % 1024, swz = sb ^ (((sb >> 9) & 1) << 5); R = (st >> 1) * 16 + swz / 64; C = (st & 1) * 32 + (swz % 64) / 2; }
__host__ __device__ __forceinline__ int perm32(int rho) { const int n = rho >> 4, i = rho & 15; return 8 * (i >> 2) + 4 * n + (i & 3); }

struct Unit { int pm, pn, narrow, rbase, nvalid; };
struct Gemm { const bf16_t* A; const bf16_t* Bt; int M, N, K; };

struct StaticOrder {
    static constexpr bool HAS_NARROW = false;
    int nM, nN, nwg, G, c;
    __host__ __device__ void init(int M, int N, int G_, int c_) { nM = M / BM; nN = N / BM; nwg = nM * nN; G = G_; c = c_; }
    __host__ __device__ bool next(int i, Unit& u) const {
        const long L = (long)i * G + c; if (L >= nwg) return false;
        int wgid = (int)L; { const int q = nwg / NXCD, r = nwg % NXCD, xcd = wgid % NXCD, off = wgid / NXCD; wgid = (xcd < r ? xcd * (q + 1) : r * (q + 1) + (xcd - r) * q) + off; }
        const int nig = WGM * nN, gid = wgid / nig, fm = gid * WGM, gsz = (nM - fm) < WGM ? (nM - fm) : WGM;
        u.pm = fm + ((wgid % nig) % gsz); u.pn = (wgid % nig) / gsz; return true;
    }
    __device__ __forceinline__ void a_ready(const Unit&) const {}
    __device__ __forceinline__ void done(const Unit&) const {}
};
struct TailNarrowOrder {
    static constexpr bool HAS_NARROW = true;
    StaticOrder full; int nM, G, c;
    __host__ __device__ void init(int M, int G_, int c_) { nM = M / BM; G = G_; c = c_; full.init(M, 8 * BM, G_, c_); }
    __host__ __device__ bool next(int i, Unit& u) const { const long L = (long)i * G + c;
        if (L < full.nwg) { const bool ok = full.next(i, u); u.narrow = 0; return ok; }
        if (L >= full.nwg + nM) return false;
        u.pm = (int)(L - full.nwg); u.pn = 8; u.narrow = 1; return true; }
    __device__ __forceinline__ void a_ready(const Unit&) const {}
    __device__ __forceinline__ void done(const Unit&) const {}
};
template <class Epi, class Sched, bool ALIGN_EPI = false, bool SP2 = false, bool GATHER = false>
__device__ __forceinline__ void gemm_phase(PG8_LAS unsigned char* lds, const Gemm g, const Sched& S, const Epi& E, const int* rowmap = nullptr) {
    int tid = threadIdx.x; LAUNDER_V(tid); const int wid = __builtin_amdgcn_readfirstlane(tid >> 6), lane = tid & 63, wr = wid >> 2, wc = wid & 3, fr = lane & 15, fq = lane >> 4;
    const int K = g.K, nt = K / BK;
    unsigned voffA[2], voffB[2]; int RA[2], CA[2];
#pragma unroll
    for (int i = 0; i < 2; ++i) { int R, C; stage_rc(tid * 16 + i * 8192, R, C); const int Rb = Epi::PERM ? ((R & ~31) + perm32(R & 31)) : R;
        voffA[i] = (unsigned)(R * K + C) * 2u; voffB[i] = (unsigned)(Rb * K + C) * 2u; RA[i] = R; CA[i] = C; }
    const size_t kstep = (size_t)(BK * 2);
    const size_t hstep = (size_t)HALF * K * 2;
    const size_t tstep = 2 * hstep;
    const size_t hA = GATHER ? (size_t)0 : hstep;
    unsigned vA0[2], vA1[2], nA0[2], nA1[2];
    auto rows_of = [&](const Unit& u, unsigned (&o0)[2], unsigned (&o1)[2]) {
#pragma unroll
        for (int i = 0; i < 2; ++i) { if constexpr (GATHER) { int t0 = (RA[i] < u.nvalid) ? rowmap[u.rbase + RA[i]] : -1, t1 = (HALF + RA[i] < u.nvalid) ? rowmap[u.rbase + HALF + RA[i]] : -1; t0 = t0 < 0 ? 0 : (t0 >> 1); t1 = t1 < 0 ? 0 : (t1 >> 1);
                o0[i] = (unsigned)(t0 * K + CA[i]) * 2u; o1[i] = (unsigned)(t1 * K + CA[i]) * 2u; } else { o0[i] = voffA[i]; o1[i] = voffA[i]; } } };
    const unsigned ldsw = (unsigned)wid * 1024u;
    const int aoff = lds_byte(wr * 64 + fr, fq * 8), boff = lds_byte(wc * 32 + fr, fq * 8);
#define PG8_SA(b, h) (((b) * 2 + (h)) * HTB)
#define PG8_SB(b, h) ((4 + (b) * 2 + (h)) * HTB)
#define PG8_STAGE(bufoff, gbase, voff) do { _Pragma("unroll") for (int _i = 0; _i < 2; ++_i) \
        __builtin_amdgcn_global_load_lds((const unsigned*)((const char*)(gbase) + (voff)[_i]), (PG8_LAS unsigned*)(lds + (bufoff) + ldsw + _i * 8192), 16, 0, 0); } while (0)
#define PG8_LDA(dst, b, h) do { _Pragma("unroll") for (int m = 0; m < 4; ++m) _Pragma("unroll") for (int k = 0; k < 2; ++k) dst[m][k] = *(const PG8_LAS bf16x8*)(lds + PG8_SA(b, h) + aoff + m * 2048 + k * 1024); } while (0)
#define PG8_LDB(dst, b, h) do { _Pragma("unroll") for (int n = 0; n < 2; ++n) _Pragma("unroll") for (int k = 0; k < 2; ++k) dst[n][k] = *(const PG8_LAS bf16x8*)(lds + PG8_SB(b, h) + boff + n * 2048 + k * 1024); } while (0)
#define PG8_MMA(ai, bj, At, Bt) do { __builtin_amdgcn_s_setprio(1); _Pragma("unroll") for (int m = 0; m < 4; ++m) _Pragma("unroll") for (int n = 0; n < 2; ++n) _Pragma("unroll") for (int k = 0; k < 2; ++k) \
        acc[ai][bj][m][n] = __builtin_amdgcn_mfma_f32_16x16x32_bf16(Bt[n][k], At[m][k], acc[ai][bj][m][n], 0, 0, 0); __builtin_amdgcn_s_setprio(0); } while (0)
#define PG8_WAIT_V(n) ASMV("s_waitcnt vmcnt(" #n ")" ::: "memory")
#define PG8_WAIT_L(n) ASMV("s_waitcnt lgkmcnt(" #n ")" ::: "memory")
#define PG8_BAR __builtin_amdgcn_s_barrier()
#define PG8_SCHED __builtin_amdgcn_sched_barrier(0)
    Unit cur, nxt; int ui = 0;
    if (!S.next(0, cur)) return;
    f32x4 acc[2][2][4][2];
#pragma unroll
    for (int a = 0; a < 2; ++a)
#pragma unroll
        for (int b = 0; b < 2; ++b)
#pragma unroll
            for (int m = 0; m < 4; ++m)
#pragma unroll
                for (int n = 0; n < 2; ++n) acc[a][b][m][n] = (f32x4){0.f, 0.f, 0.f, 0.f};
    bf16x8 At[4][2], B0[2][2], B1[2][2];
    const char* cA = GATHER ? (const char*)g.A : (const char*)g.A + (size_t)cur.pm * tstep; rows_of(cur, vA0, vA1); const char* cB = (const char*)g.Bt + (size_t)cur.pn * tstep;
    typename Epi::Pre pre; E.prefetch(pre, cur, wr, fr);
    S.a_ready(cur);
    if constexpr (SP2) {
        PG8_STAGE(PG8_SB(0, 0), cB, voffB); PG8_STAGE(PG8_SB(0, 1), cB + hstep, voffB); PG8_STAGE(PG8_SA(0, 0), cA, vA0); PG8_STAGE(PG8_SA(0, 1), cA + hA, vA1);
        if (wr == 1) PG8_BAR;
        PG8_WAIT_V(2); PG8_BAR;
        PG8_STAGE(PG8_SB(1, 0), cB + kstep, voffB); PG8_STAGE(PG8_SA(1, 0), cA + kstep, vA0); PG8_STAGE(PG8_SB(1, 1), cB + hstep + kstep, voffB);
        PG8_WAIT_V(6); PG8_BAR;
    } else {
        PG8_STAGE(PG8_SB(0, 0), cB, voffB); PG8_STAGE(PG8_SA(0, 0), cA, vA0); PG8_STAGE(PG8_SB(0, 1), cB + hstep, voffB); PG8_STAGE(PG8_SA(0, 1), cA + hA, vA1);
        if (wr == 1) PG8_BAR;
        PG8_WAIT_V(4); PG8_BAR;
        PG8_STAGE(PG8_SB(1, 0), cB + kstep, voffB); PG8_STAGE(PG8_SA(1, 0), cA + kstep, vA0); PG8_STAGE(PG8_SB(1, 1), cB + hstep + kstep, voffB);
        PG8_WAIT_V(6); PG8_BAR;
    }
    for (;;) {
        const bool has_next = S.next(ui + 1, nxt);
        const char* nA = GATHER ? (const char*)g.A : (has_next ? (const char*)g.A + (size_t)nxt.pm * tstep : cA);
        if (has_next) rows_of(nxt, nA0, nA1); else { nA0[0] = vA0[0]; nA0[1] = vA0[1]; nA1[0] = vA1[0]; nA1[1] = vA1[1]; } const char* nB = has_next ? (const char*)g.Bt + (size_t)nxt.pn * tstep : cB;
        for (int t = 0; t < nt; t += 2) {
            const bool last = (t == nt - 2);
            unsigned sA0[2], sA1[2];
#pragma unroll
            for (int i = 0; i < 2; ++i) { sA0[i] = last ? nA0[i] : vA0[i]; sA1[i] = last ? nA1[i] : vA1[i]; }
            const char* a1 = cA + (size_t)(t + 1) * kstep;
            const char* a2 = last ? nA : cA + (size_t)(t + 2) * kstep; const char* b2 = last ? nB : cB + (size_t)(t + 2) * kstep;
            const char* a3 = a2 + kstep; const char* b3 = b2 + kstep;
            if (last && has_next) S.a_ready(nxt);
            if constexpr (SP2) {
            PG8_LDB(B0, 0, 0); PG8_LDB(B1, 0, 1); PG8_SCHED; PG8_LDA(At, 0, 0); PG8_STAGE(PG8_SA(1, 1), a1 + hA, vA1);
            PG8_WAIT_V(8); PG8_WAIT_L(0); PG8_BAR; PG8_MMA(0, 0, At, B0); if (!Sched::HAS_NARROW || !cur.narrow) PG8_MMA(0, 1, At, B1); PG8_BAR; PG8_SCHED;
            PG8_LDA(At, 0, 1); PG8_STAGE(PG8_SB(0, 0), b2, voffB); PG8_STAGE(PG8_SB(0, 1), b2 + hstep, voffB); PG8_STAGE(PG8_SA(0, 0), a2, sA0);
            PG8_WAIT_V(8); PG8_WAIT_L(0); PG8_BAR; PG8_MMA(1, 0, At, B0); if (!Sched::HAS_NARROW || !cur.narrow) PG8_MMA(1, 1, At, B1); PG8_BAR; PG8_SCHED;
            PG8_LDB(B0, 1, 0); PG8_LDB(B1, 1, 1); PG8_SCHED; PG8_LDA(At, 1, 0); PG8_STAGE(PG8_SA(0, 1), a2 + hA, sA1);
            PG8_WAIT_V(8); PG8_WAIT_L(0); PG8_BAR; PG8_MMA(0, 0, At, B0); if (!Sched::HAS_NARROW || !cur.narrow) PG8_MMA(0, 1, At, B1); PG8_BAR; PG8_SCHED;
            PG8_LDA(At, 1, 1); PG8_STAGE(PG8_SB(1, 0), b3, voffB); PG8_STAGE(PG8_SB(1, 1), b3 + hstep, voffB); PG8_STAGE(PG8_SA(1, 0), a3, sA0);
            PG8_WAIT_V(8); PG8_WAIT_L(0); PG8_BAR; PG8_MMA(1, 0, At, B0); if (!Sched::HAS_NARROW || !cur.narrow) PG8_MMA(1, 1, At, B1); PG8_BAR; PG8_SCHED;
            } else {
            PG8_LDB(B0, 0, 0); PG8_SCHED; PG8_LDA(At, 0, 0); PG8_STAGE(PG8_SA(1, 1), a1 + hA, vA1);
            PG8_WAIT_L(8); PG8_BAR; PG8_WAIT_L(0); PG8_MMA(0, 0, At, B0); PG8_BAR; PG8_SCHED;
            PG8_LDB(B1, 0, 1); PG8_STAGE(PG8_SB(0, 0), b2, voffB);
            PG8_BAR; PG8_WAIT_L(0); if (!Sched::HAS_NARROW || !cur.narrow) PG8_MMA(0, 1, At, B1); PG8_BAR;
            PG8_LDA(At, 0, 1); PG8_STAGE(PG8_SA(0, 0), a2, sA0);
            PG8_BAR; PG8_WAIT_L(0); PG8_MMA(1, 0, At, B0); PG8_BAR; PG8_SCHED;
            PG8_STAGE(PG8_SB(0, 1), b2 + hstep, voffB);
            PG8_WAIT_V(6); PG8_BAR; if (!Sched::HAS_NARROW || !cur.narrow) PG8_MMA(1, 1, At, B1); PG8_BAR;
            PG8_LDB(B0, 1, 0); PG8_SCHED; PG8_LDA(At, 1, 0); PG8_STAGE(PG8_SA(0, 1), a2 + hA, sA1);
            PG8_WAIT_L(8); PG8_BAR; PG8_WAIT_L(0); PG8_MMA(0, 0, At, B0); PG8_BAR; PG8_SCHED;
            PG8_LDB(B1, 1, 1); PG8_STAGE(PG8_SB(1, 0), b3, voffB);
            PG8_BAR; PG8_WAIT_L(0); if (!Sched::HAS_NARROW || !cur.narrow) PG8_MMA(0, 1, At, B1); PG8_BAR;
            PG8_LDA(At, 1, 1); PG8_STAGE(PG8_SA(1, 0), a3, sA0);
            PG8_BAR; PG8_WAIT_L(0); PG8_MMA(1, 0, At, B0); PG8_BAR; PG8_SCHED;
            PG8_STAGE(PG8_SB(1, 1), b3 + hstep, voffB);
            PG8_WAIT_V(6); PG8_BAR; if (!Sched::HAS_NARROW || !cur.narrow) PG8_MMA(1, 1, At, B1); PG8_BAR;
            }
        }
        if constexpr (ALIGN_EPI) { if (wr == 0) PG8_BAR; }
        if constexpr (!Epi::AFTER_DRAIN) { E(acc, cur, wr, wc, fr, fq, pre); S.done(cur); }
        if (!has_next) break;
#pragma unroll
        for (int a = 0; a < 2; ++a)
#pragma unroll
            for (int b = 0; b < 2; ++b)
#pragma unroll
                for (int m = 0; m < 4; ++m)
#pragma unroll
                    for (int n = 0; n < 2; ++n) acc[a][b][m][n] = (f32x4){0.f, 0.f, 0.f, 0.f};
        cur = nxt; cA = nA; cB = nB; ++ui; vA0[0] = nA0[0]; vA0[1] = nA0[1]; vA1[0] = nA1[0]; vA1[1] = nA1[1];
        E.prefetch(pre, cur, wr, fr);
        if constexpr (ALIGN_EPI) { if (wr == 1) PG8_BAR; }
    }
    PG8_WAIT_V(0);
    if constexpr (!ALIGN_EPI) { if (wr == 0) PG8_BAR; }
    PG8_BAR;
    if constexpr (Epi::AFTER_DRAIN) { E.fused(acc, cur, wr, wc, fr, fq, lds, wid, lane); S.done(cur); }
#undef PG8_SA
#undef PG8_SB
#undef PG8_STAGE
#undef PG8_LDA
#undef PG8_LDB
#undef PG8_MMA
#undef PG8_WAIT_V
#undef PG8_WAIT_L
#undef PG8_BAR
#undef PG8_SCHED
}

struct EpiBf16 {
    static constexpr bool PERM = true, AFTER_DRAIN = false;
    bf16_t* O; int ldc;
    struct Pre {}; __device__ __forceinline__ void prefetch(Pre&, const Unit&, int, int) const {}
    __device__ __forceinline__ void operator()(const f32x4 (&acc)[2][2][4][2], const Unit& u, int wr, int wc, int fr, int fq, const Pre&) const {
        const int row0 = u.pm * BM + wr * 64 + fr, col0 = u.pn * BM + wc * 32 + 8 * fq;
#pragma unroll
        for (int ai = 0; ai < 2; ++ai)
#pragma unroll
            for (int m = 0; m < 4; ++m) { bf16_t* rowp = O + (size_t)(row0 + ai * HALF + m * 16) * ldc + col0;
#pragma unroll
                for (int bj = 0; bj < 2; ++bj) { const f32x4 v0 = acc[ai][bj][m][0], v1 = acc[ai][bj][m][1];
                    u32x4 w; w.x = cvt_pk_bf16(v0[0], v0[1]); w.y = cvt_pk_bf16(v0[2], v0[3]); w.z = cvt_pk_bf16(v1[0], v1[1]); w.w = cvt_pk_bf16(v1[2], v1[3]);
                    *(u32x4*)(rowp + bj * HALF) = w; } }
    }
};
struct EpiResid {
    static constexpr bool PERM = true, AFTER_DRAIN = false;
    const float* xin; const bf16_t* xinb; bf16_t* xout; const float* gate; int gstride; int seq; const bf16_t* y1;
    struct Pre {}; __device__ __forceinline__ void prefetch(Pre&, const Unit&, int, int) const {}
    __device__ __forceinline__ void operator()(const f32x4 (&acc)[2][2][4][2], const Unit& u, int wr, int wc, int fr, int fq, const Pre&) const {
        const int row0 = u.pm * BM + wr * 64 + fr, col0 = u.pn * BM + wc * 32 + 8 * fq;
#pragma unroll
        for (int ai = 0; ai < 2; ++ai)
#pragma unroll
            for (int m = 0; m < 4; ++m) { const int row = row0 + ai * HALF + m * 16; const float* gp = gate + (size_t)(row / seq) * gstride;
#pragma unroll
                for (int bj = 0; bj < 2; ++bj) { const int c = col0 + bj * HALF; const size_t o = (size_t)row * 1024 + c;
                    const f32x4 g0 = *(const f32x4*)(gp + c), g1 = *(const f32x4*)(gp + c + 4);
                    f32x4 x0, x1;
                    if (xin) { x0 = *(const f32x4*)(xin + o); x1 = *(const f32x4*)(xin + o + 4); }
                    else { const u32x4 xw = *(const u32x4*)(xinb + o), y = *(const u32x4*)(y1 + o);
                        x0 = (f32x4){bflo(xw.x), bfhi(xw.x), bflo(xw.y), bfhi(xw.y)} + (f32x4){bflo(y.x), bfhi(y.x), bflo(y.y), bfhi(y.y)};
                        x1 = (f32x4){bflo(xw.z), bfhi(xw.z), bflo(xw.w), bfhi(xw.w)} + (f32x4){bflo(y.z), bfhi(y.z), bflo(y.w), bfhi(y.w)}; }
                    x0 += g0 * acc[ai][bj][m][0]; x1 += g1 * acc[ai][bj][m][1];
                    u32x4 w; w.x = cvt_pk_bf16(x0[0], x0[1]); w.y = cvt_pk_bf16(x0[2], x0[3]); w.z = cvt_pk_bf16(x1[0], x1[1]); w.w = cvt_pk_bf16(x1[2], x1[3]);
                    *(u32x4*)(xout + o) = w; } }
    }
};
struct EpiSwiglu {
    static constexpr bool PERM = true, AFTER_DRAIN = false;
    bf16_t* HB;
    struct Pre {}; __device__ __forceinline__ void prefetch(Pre&, const Unit&, int, int) const {}
    __device__ __forceinline__ void operator()(const f32x4 (&acc)[2][2][4][2], const Unit& u, int wr, int wc, int fr, int fq, const Pre&) const {
        const int row0 = u.pm * BM + wr * 64 + fr, col0 = (u.pn & 3) * 128 + wc * 32 + 8 * fq;
#pragma unroll
        for (int ai = 0; ai < 2; ++ai)
#pragma unroll
            for (int m = 0; m < 4; ++m) { bf16_t* p = HB + (size_t)(row0 + ai * HALF + m * 16) * 512 + col0;
                float h[8];
#pragma unroll
                for (int n = 0; n < 2; ++n)
#pragma unroll
                    for (int k = 0; k < 4; ++k) h[n * 4 + k] = fsilu(acc[ai][0][m][n][k]) * acc[ai][1][m][n][k];
                u32x4 w; w.x = cvt_pk_bf16(h[0], h[1]); w.y = cvt_pk_bf16(h[2], h[3]); w.z = cvt_pk_bf16(h[4], h[5]); w.w = cvt_pk_bf16(h[6], h[7]);
                *(u32x4*)p = w; }
    }
};
struct EpiDown {
    static constexpr bool PERM = true, AFTER_DRAIN = false;
    const int* row_tok; const float* row_w; bf16_t* x; bf16_t* y1; const float* gate; int gstride; int seq;
    struct Pre { int ts[8]; };
    __device__ __forceinline__ void prefetch(Pre& p, const Unit& u, int wr, int fr) const {
#pragma unroll
        for (int ai = 0; ai < 2; ++ai)
#pragma unroll
            for (int m = 0; m < 4; ++m) { const int lr = wr * 64 + fr + ai * HALF + m * 16; p.ts[ai * 4 + m] = (lr < u.nvalid) ? row_tok[u.rbase + lr] : -1; } }
    __device__ __forceinline__ void operator()(const f32x4 (&acc)[2][2][4][2], const Unit& u, int wr, int wc, int fr, int fq, const Pre& pre) const {
        const int col0 = (u.pn & 3) * BM + wc * 32 + 8 * fq;
#pragma unroll
        for (int ai = 0; ai < 2; ++ai)
#pragma unroll
            for (int m = 0; m < 4; ++m) { const int ts = pre.ts[ai * 4 + m];
                if (ts >= 0) { const int tok = ts >> 1; const float w = row_w[u.rbase + wr * 64 + fr + ai * HALF + m * 16]; const float* gp = gate + (size_t)(tok / seq) * gstride;
#pragma unroll
                    for (int bj = 0; bj < 2; ++bj) { const int c = col0 + bj * HALF; const size_t o = (size_t)tok * 1024 + c;
                        const f32x4 v0 = acc[ai][bj][m][0] * (*(const f32x4*)(gp + c)) * w, v1 = acc[ai][bj][m][1] * (*(const f32x4*)(gp + c + 4)) * w;
                        if (ts & 1) { u32x4 q; q.x = cvt_pk_bf16(v0[0], v0[1]); q.y = cvt_pk_bf16(v0[2], v0[3]); q.z = cvt_pk_bf16(v1[0], v1[1]); q.w = cvt_pk_bf16(v1[2], v1[3]); *(u32x4*)(y1 + o) = q; }
                        else { const u32x4 xw = *(const u32x4*)(x + o); const f32x4 s0 = (f32x4){bflo(xw.x), bfhi(xw.x), bflo(xw.y), bfhi(xw.y)} + v0, s1 = (f32x4){bflo(xw.z), bfhi(xw.z), bflo(xw.w), bfhi(xw.w)} + v1;
                            u32x4 q; q.x = cvt_pk_bf16(s0[0], s0[1]); q.y = cvt_pk_bf16(s0[2], s0[3]); q.z = cvt_pk_bf16(s1[0], s1[1]); q.w = cvt_pk_bf16(s1[2], s1[3]); *(u32x4*)(x + o) = q; } } } }
    }
};
struct MoeOrder {
    static constexpr bool HAS_NARROW = false;
    const PG8_LAS int* tab; int cap, G, c;
    __device__ __forceinline__ bool next(int i, Unit& u) const { const int v = ((G & 7) == 0) ? (c & 7) * (G >> 3) + (c >> 3) : c; const int L = i * G + v, nt = tab[64]; if (L >= nt * 4) return false;
        const int pm = L >> 2, e = tab[72 + pm], j = pm - tab[32 + e], nv = tab[e] - j * BM; u.pm = pm; u.pn = e * 4 + (L & 3); u.rbase = e * cap + j * BM; u.nvalid = nv > BM ? BM : nv; return true; }
    __device__ __forceinline__ void a_ready(const Unit&) const {}
    __device__ __forceinline__ void done(const Unit&) const {}
};
}

constexpr int NB = CFG_B, SEQ = CFG_S, NL = CFG_L, NTOK = NB * SEQ, DM = 1024, ZP = 2304;
constexpr int NBH = NB * 4, NCH = SEQ / 128, NQT = SEQ / 256;
constexpr int NR = 2 * NTOK + 32 * 256;
constexpr int Z_CQ = 0, Z_CKV = 192, Z_KR = 320, Z_POOL = 352, Z_HQ = 608, Z_HF = 864, Z_HI = 1120, Z_HG = 1376, Z_CA = 1632, Z_CG = 1888;
constexpr float EPS = 1e-6f;
static_assert(SEQ % 256 == 0 && NTOK % 256 == 0 && (NQT % 2) == 0, "shape");
constexpr size_t al256(size_t x) { return (x + 255) & ~(size_t)255; }
constexpr size_t cmax(size_t a, size_t b) { return a > b ? a : b; }
constexpr size_t WS_CTL = 0, CTL_BYTES = 65536;
constexpr size_t CTL_CNT = 16384;
constexpr size_t CTL_HG = 32768;
constexpr size_t WS_MODP = WS_CTL + CTL_BYTES;
constexpr size_t WS_MOD = WS_MODP + al256((size_t)16 * NL * NB * 6144 * 4);
constexpr size_t WS_LB = WS_MOD + al256((size_t)NL * NB * 6144 * 4);
constexpr size_t WS_ROPE = WS_LB + al256((size_t)NL * 256 * 4);
constexpr size_t WS_WIN = WS_ROPE + al256((size_t)NTOK * 32 * 4);
constexpr size_t WS_WOUT = WS_WIN + (size_t)ZP * 1024 * 2;
constexpr size_t WS_WUQ = WS_WOUT + (size_t)1024 * 1024 * 2;
constexpr size_t WS_WUKV = WS_WUQ + al256((size_t)384 * 192 * 2);
constexpr size_t WS_WPOOL = WS_WUKV + al256((size_t)512 * 128 * 2);
constexpr size_t WS_WUP = WS_WPOOL + al256((size_t)4 * 64 * 64 * 2);
constexpr size_t WS_WDN = WS_WUP + (size_t)32 * 1024 * 1024 * 2;
constexpr size_t WS_RWT = WS_WDN + (size_t)32 * 1024 * 512 * 2;
constexpr size_t WSET = WS_RWT + 36 * 1024 * 4 - WS_WIN;
constexpr size_t WS_HA = WS_WIN + 2 * WSET;
constexpr size_t WS_Z = WS_HA + (size_t)NTOK * 1024 * 2;
constexpr size_t Z_BYTES = cmax((size_t)NTOK * ZP * 2, (size_t)NR * 1024 * 2);
constexpr size_t WS_Q = WS_Z + Z_BYTES;
constexpr size_t WS_K = WS_Q + (size_t)NTOK * 4 * 96 * 2;
constexpr size_t WS_VT = WS_K + (size_t)NTOK * 4 * 96 * 2;
constexpr size_t WS_YB = WS_VT + (size_t)NTOK * 4 * 64 * 2;
constexpr size_t R2_BYTES = cmax(WS_YB + (size_t)NTOK * 1024 * 2 - WS_Q, (size_t)NR * 512 * 2);
constexpr size_t WS_Y1 = WS_Q + R2_BYTES;
constexpr size_t WS_SC = WS_Y1 + (size_t)NTOK * 1024 * 2;
constexpr size_t WS_PC = WS_SC + (size_t)NBH * NCH * 4096 * 4;
constexpr size_t WS_S0 = WS_PC + al256((size_t)NBH * NCH * 64 * 4);
constexpr size_t WS_ASGE = WS_S0 + (size_t)NBH * NCH * 4096 * 4;
constexpr size_t WS_ASGR = WS_ASGE + (size_t)NTOK * 8;
constexpr size_t WS_ASGW = WS_ASGR + (size_t)NTOK * 8;
constexpr int MOE_CAP = NTOK;
constexpr size_t WS_ROWTOK = WS_ASGW + (size_t)NTOK * 8;
constexpr size_t WS_ROWW = WS_ROWTOK + (size_t)32 * MOE_CAP * 4;
constexpr size_t WS_TILE = WS_ROWW + (size_t)32 * MOE_CAP * 4;
constexpr size_t WS_XB = WS_TILE + al256((size_t)(NR / 256 + 16) * 4);
constexpr size_t WS_END = WS_XB + (size_t)NTOK * 1024 * 2;
constexpr int LDS_BYTES = 160 * 1024;
constexpr int LDS_XB = LDS_BYTES - 16;

#define XB_TMO      128
#define XB_XCNT(j)  (256  + 64 * (j))
#define XB_XSUB(j)  (1280 + 64 * (j))
#define XB_XGEN(j)  (2304 + 64 * (j))
#define XB_TOP      3328
#define XB_TOPGEN   3392
#define XCD_BAR_WORDS 3456
#define XB_SPIN_CAP (1u << 18)
__device__ __forceinline__ unsigned xb_ld(unsigned* p)              { return __hip_atomic_load(p, __ATOMIC_RELAXED, __HIP_MEMORY_SCOPE_AGENT); }
__device__ __forceinline__ unsigned xb_add(unsigned* p, unsigned v) { return __hip_atomic_fetch_add(p, v, __ATOMIC_RELAXED, __HIP_MEMORY_SCOPE_AGENT); }
__device__ __forceinline__ unsigned xb_xcc_id() { return (unsigned)__builtin_amdgcn_s_getreg((3 << 11) | 20) & 0xFu; }
#define XB_SPIN(cond, bar) do { unsigned _sp = 0; while (cond) { __builtin_amdgcn_s_sleep(1); \
    if ((++_sp & 255u) == 0u) { if (xb_ld(&(bar)[XB_TMO])) break; if (_sp > XB_SPIN_CAP) { atomicAdd(&(bar)[XB_TMO], 1u); break; } } } } while (0)
struct XcdBarrier { unsigned* bar; unsigned x; volatile LAS unsigned* st; };
__device__ __forceinline__ XcdBarrier xcd_barrier_post(unsigned* bar, volatile LAS unsigned* st) {
    XcdBarrier b; b.bar = bar; b.x = xb_xcc_id(); b.st = st;
    if (threadIdx.x == 0) (void)xb_add(&bar[XB_XCNT(b.x)], 1u);
    return b;
}
__device__ __forceinline__ void xcd_barrier_complete(unsigned* bar, unsigned x, unsigned& nloc, unsigned& nx) {
    const unsigned G = gridDim.x * gridDim.y * gridDim.z;
    unsigned sum, cnt, mine, sp = 0u;
    for (;;) {
        sum = 0u; cnt = 0u; mine = 0u;
#pragma unroll
        for (unsigned j = 0; j < 16; ++j) { const unsigned c = xb_ld(&bar[XB_XCNT(j)]); sum += c; cnt += (c > 0u) ? 1u : 0u; mine = (j == x) ? c : mine; }
        if (sum == G) break;
        __builtin_amdgcn_s_sleep(1);
        if ((++sp & 255u) == 0u) { if (xb_ld(&bar[XB_TMO])) break; if (sp > XB_SPIN_CAP) { atomicAdd(&bar[XB_TMO], 1u); break; } }
    }
    nloc = mine > 0u ? mine : 1u; nx = cnt > 0u ? cnt : 1u;
}
__device__ __forceinline__ void xcd_barrier(const XcdBarrier& b) {
    ASMV("s_waitcnt vmcnt(0)" ::: "memory");
    __syncthreads();
    if (threadIdx.x == 0) {
        unsigned* bar = b.bar;
        __builtin_amdgcn_s_waitcnt(0);
        unsigned nloc = b.st[0], nx = b.st[1];
        if (nloc == 0u) { xcd_barrier_complete(bar, b.x, nloc, nx); b.st[0] = nloc; b.st[1] = nx; }
        const unsigned old = xb_add(&bar[XB_XSUB(b.x)], 1u);
        const unsigned gen = old / nloc;
        if (old + 1u == (gen + 1u) * nloc) {
            __builtin_amdgcn_fence(__ATOMIC_RELEASE, "agent");
            ASMV("s_waitcnt vmcnt(0)" ::: "memory");
            const unsigned og = xb_add(&bar[XB_TOP], 1u);
            const unsigned tg = og / nx;
            if (og + 1u == (tg + 1u) * nx) xb_add(&bar[XB_TOPGEN], 1u);
            else XB_SPIN(xb_ld(&bar[XB_TOPGEN]) == tg, bar);
            __builtin_amdgcn_fence(__ATOMIC_ACQUIRE, "agent");
            xb_add(&bar[XB_XGEN(b.x)], 1u);
            ASMV("s_waitcnt vmcnt(0)" ::: "memory");
        } else {
            XB_SPIN(xb_ld(&bar[XB_XGEN(b.x)]) == gen, bar);
            __builtin_amdgcn_fence(__ATOMIC_ACQUIRE, "agent");
            ASMV("s_waitcnt vmcnt(0)" ::: "memory");
        }
    }
    __syncthreads();
}

struct Args { const void* in[30]; float* out; unsigned char* ws; int ph_lo, ph_hi; };
enum { I_X = 0, I_C, I_POS, I_WADA, I_BADA, I_N1G, I_N2G, I_WIN, I_QAG, I_WUQ, I_KVAG, I_WUKV, I_QG, I_KG, I_WPOOL, I_PSCALE, I_LBL, I_HOG, I_DWW, I_DWB, I_LNG, I_LNB,
       I_WOUT, I_RGW, I_RGB, I_REW, I_REB, I_W1, I_W3, I_W2 };
struct Ctx {
    const Args* a; unsigned char* ws; unsigned char* lds; int tid, wid, lane, G, blk;
    __device__ __forceinline__ const float* inf(int i) const { return (const float*)a->in[i]; }
    template <class T> __device__ __forceinline__ T* w(size_t off) const { return (T*)(ws + off); }
};

__device__ __forceinline__ Ctx fresh(const Ctx& c0) { Ctx c = c0; LAUNDER_V(c.tid); LAUNDER_V(c.lane); LAUNDER_S(c.wid); return c; }
__device__ __forceinline__ void ph_prologue0(const Ctx& c_) { const Ctx c = fresh(c_);
    const float* cc = c.inf(I_C); const float* wada = c.inf(I_WADA); float* modp = c.w<float>(WS_MODP);
    for (int u = c.blk; u < NL * 16 * 12; u += c.G) {
        const int l = u / 192, r = u % 192, ic = r / 12, jb = r % 12, j = jb * 512 + c.tid;
        float* Ls = (float*)c.lds;
        __syncthreads();
        if (c.tid < NB * 64) Ls[c.tid] = fsilu(cc[(c.tid >> 6) * 1024 + ic * 64 + (c.tid & 63)]);
        __syncthreads();
        float acc[NB];
#pragma unroll
        for (int b = 0; b < NB; ++b) acc[b] = 0.f;
        const float* wp = wada + ((size_t)l * 1024 + ic * 64) * 6144 + j;
#pragma unroll
        for (int i0 = 0; i0 < 64; i0 += 16) { float wv[16];
#pragma unroll
            for (int i = 0; i < 16; ++i) wv[i] = wp[(size_t)(i0 + i) * 6144];
#pragma unroll
            for (int i = 0; i < 16; ++i)
#pragma unroll
                for (int b = 0; b < NB; ++b) acc[b] += Ls[b * 64 + i0 + i] * wv[i]; }
#pragma unroll
        for (int b = 0; b < NB; ++b) modp[(((size_t)ic * NL + l) * NB + b) * 6144 + j] = acc[b];
    }
    const int* pos = (const int*)c.a->in[I_POS]; float* rc = c.w<float>(WS_ROPE); float* rs = rc + (size_t)NTOK * 16;
    for (int e = c.blk * 512 + c.tid; e < NTOK * 16; e += c.G * 512) { const int t = e >> 4, i = e & 15;
        const float inv = exp2f(-(float)i * (13.287712379549449f / 16.0f));
        const float ang = (float)pos[t] * inv; rc[e] = cosf(ang); rs[e] = sinf(ang); }
    if (c.blk == 0 && c.tid < 256) { const float* lg = c.inf(I_LBL); float* lb = c.w<float>(WS_LB); float mx = -1e30f;
        for (int l = 0; l < NL; ++l) mx = fmaxf(mx, lg[l * 256 + c.tid]);
        float den = 0.f; for (int l = 0; l < NL; ++l) den += expf(lg[l * 256 + c.tid] - mx);
        float cum = 0.f, first = 0.f; for (int l = 0; l < NL; ++l) { cum += expf(lg[l * 256 + c.tid] - mx) / den; if (l == 0) first = cum; lb[l * 256 + c.tid] = cum - first; } }
}
__device__ __forceinline__ void ph_prologue1(const Ctx& c_) { const Ctx c = fresh(c_);
    const float* modp = c.w<float>(WS_MODP); float* mod = c.w<float>(WS_MOD); const float* bada = c.inf(I_BADA);
    for (int e = c.blk * 512 + c.tid; e < NL * NB * 6144; e += c.G * 512) { const int j = e % 6144, l = e / (NB * 6144);
        float s = bada[l * 6144 + j];
#pragma unroll
        for (int ic = 0; ic < 16; ++ic) s += modp[(size_t)ic * NL * NB * 6144 + e];
        mod[e] = s; }
}

__device__ __forceinline__ void ld8bf(const bf16_t* p, float (&o)[8]) { const u32x4 v = *(const u32x4*)p; o[0] = bflo(v.x); o[1] = bfhi(v.x); o[2] = bflo(v.y); o[3] = bfhi(v.y); o[4] = bflo(v.z); o[5] = bfhi(v.z); o[6] = bflo(v.w); o[7] = bfhi(v.w); }
__device__ __forceinline__ u32x4 pk8(const float (&o)[8]) { u32x4 w; w.x = cvt_pk_bf16(o[0], o[1]); w.y = cvt_pk_bf16(o[2], o[3]); w.z = cvt_pk_bf16(o[4], o[5]); w.w = cvt_pk_bf16(o[6], o[7]); return w; }
__device__ __forceinline__ u32x4 pk8p(const float (&o)[8]) { u32x4 w; w.x = cvt_pk_bf16_pinned(o[0], o[1]); w.y = cvt_pk_bf16_pinned(o[2], o[3]); w.z = cvt_pk_bf16_pinned(o[4], o[5]); w.w = cvt_pk_bf16_pinned(o[6], o[7]); return w; }
__device__ __forceinline__ void cvt_tile(const Ctx& c, const float* src, int ldn, int nlim, int k0, int n0, bf16_t* dst, int ldk, int drow0) {
    float* T = (float*)c.lds;
#pragma unroll
    for (int i = 0; i < 8; ++i) { const int e = c.tid + 512 * i, kk = e >> 6, nn = e & 63; T[kk * 65 + nn] = (n0 + nn < nlim) ? src[(size_t)(k0 + kk) * ldn + n0 + nn] : 0.f; }
    __syncthreads();
#pragma unroll
    for (int i = 0; i < 4; ++i) { const int e = c.tid + 512 * i, nn = e >> 5, k2 = e & 31;
        *(unsigned*)(dst + (size_t)(drow0 + nn) * ldk + k0 + 2 * k2) = cvt_pk_bf16(T[(2 * k2) * 65 + nn], T[(2 * k2 + 1) * 65 + nn]); }
    __syncthreads();
}
__device__ __forceinline__ void cvt_big(const Ctx& c, const float* src, int ldn, int nlim, int k0, int n0, bf16_t* dst, int ldk, int mode) {
    float* T = (float*)c.lds;
    f32x4 v[8];
#pragma unroll
    for (int i = 0; i < 8; ++i) { const int e4 = c.tid + 512 * i, kk = e4 >> 6, n4 = e4 & 63; v[i] = (n0 + n4 * 4 < nlim) ? *(const f32x4*)(src + (size_t)(k0 + kk) * ldn + n0 + n4 * 4) : (f32x4){0.f, 0.f, 0.f, 0.f}; }
#pragma unroll
    for (int i = 0; i < 8; ++i) { const int e4 = c.tid + 512 * i, kk = e4 >> 6, n4 = e4 & 63; float* p = T + kk * 261 + n4 * 4; p[0] = v[i][0]; p[1] = v[i][1]; p[2] = v[i][2]; p[3] = v[i][3]; }
    __syncthreads();
#pragma unroll
    for (int i = 0; i < 4; ++i) { const int e = c.tid + 512 * i, k8 = e & 7, nn = e >> 3, n = n0 + nn; float o[8];
#pragma unroll
        for (int j = 0; j < 8; ++j) o[j] = T[(8 * k8 + j) * 261 + nn];
        const int row = (mode == 0) ? n : ((n >> 7) * 256 + (mode - 1) * 128 + (n & 127));
        *(u32x4*)(dst + (size_t)row * ldk + k0 + 8 * k8) = pk8(o); }
    __syncthreads();
}
constexpr int CT_IN = 16 * 9, CT_OUT = 16 * 4, CT_W13 = 32 * 16 * 2, CT_W2 = 32 * 8 * 4, CT_UQ = 3 * 6, CT_UKV = 2 * 8, CT_POOL = 4;
constexpr int CT_TOTAL = CT_IN + CT_OUT + 2 * CT_W13 + CT_W2 + CT_UQ + CT_UKV + CT_POOL;
__device__ __forceinline__ void ph_cvt(const Ctx& c_, int l) { const Ctx c = fresh(c_);
    { const float* rgw = c.inf(I_RGW) + (size_t)l * 1024 * 4; const float* rew = c.inf(I_REW) + (size_t)l * 1024 * 32; float* rwt = c.w<float>(WS_RWT + (size_t)(l & 1) * WSET);
        for (int e = c.blk * 512 + c.tid; e < 36 * 1024; e += c.G * 512) { const int g = e >> 10, k = e & 1023; rwt[e] = (g < 4) ? rgw[k * 4 + g] : rew[k * 32 + g - 4]; } }
    for (int t = c.blk; t < CT_TOTAL; t += c.G) {
        int r = t;
        if (r < 2 * CT_W13) { const int which = r / CT_W13; r %= CT_W13; const int e = r / 32, kt = (r % 32) / 2, nt = r % 2;
            cvt_big(c, c.inf(which ? I_W3 : I_W1) + ((size_t)l * 32 + e) * 1024 * 512, 512, 512, kt * 64, nt * 256, c.w<bf16_t>(WS_WUP + (size_t)(l & 1) * WSET) + (size_t)e * 1024 * 1024, 1024, 1 + which); continue; } r -= 2 * CT_W13;
        if (r < CT_W2) { const int e = r / 32, kt = (r % 32) / 4, nt = r % 4;
            cvt_big(c, c.inf(I_W2) + ((size_t)l * 32 + e) * 512 * 1024, 1024, 1024, kt * 64, nt * 256, c.w<bf16_t>(WS_WDN + (size_t)(l & 1) * WSET) + (size_t)e * 1024 * 512, 512, 0); continue; } r -= CT_W2;
        if (r < CT_IN) { const int kt = r / 9, nt = r % 9; cvt_big(c, c.inf(I_WIN) + (size_t)l * 1024 * 2144, 2144, 2144, kt * 64, nt * 256, c.w<bf16_t>(WS_WIN + (size_t)(l & 1) * WSET), 1024, 0); continue; } r -= CT_IN;
        if (r < CT_OUT) { const int kt = r / 4, nt = r % 4; cvt_big(c, c.inf(I_WOUT) + (size_t)l * 1024 * 1024, 1024, 1024, kt * 64, nt * 256, c.w<bf16_t>(WS_WOUT + (size_t)(l & 1) * WSET), 1024, 0); continue; } r -= CT_OUT;
        if (r < CT_UQ) { const int kt = r / 6, nt = r % 6; cvt_tile(c, c.inf(I_WUQ) + (size_t)l * 192 * 384, 384, 384, kt * 64, nt * 64, c.w<bf16_t>(WS_WUQ + (size_t)(l & 1) * WSET), 192, nt * 64); continue; } r -= CT_UQ;
        if (r < CT_UKV) { const int kt = r / 8, nt = r % 8; cvt_tile(c, c.inf(I_WUKV) + (size_t)l * 128 * 512, 512, 512, kt * 64, nt * 64, c.w<bf16_t>(WS_WUKV + (size_t)(l & 1) * WSET), 128, nt * 64); continue; } r -= CT_UKV;
        cvt_tile(c, c.inf(I_WPOOL) + ((size_t)l * 4 + r) * 4096, 64, 64, 0, 0, c.w<bf16_t>(WS_WPOOL + (size_t)(l & 1) * WSET) + r * 4096, 64, 0);
    }
}
__device__ __forceinline__ void ph_normrows(const Ctx& c_, int l) { const Ctx c = fresh(c_);
    const float* xin = c.inf(I_X); const bf16_t* xb = c.w<bf16_t>(WS_XB); const bf16_t* y1 = c.w<bf16_t>(WS_Y1);
    const float* gn = c.inf(I_N1G) + l * 1024; const float* mod = c.w<float>(WS_MOD) + (size_t)l * NB * 6144; bf16_t* ha = c.w<bf16_t>(WS_HA);
    constexpr int RQ = 4;
    for (int row0 = c.blk * 8 + c.wid; row0 < NTOK; row0 += c.G * 8 * RQ) {
        f32x4 v[RQ][2][2]; float ss[RQ];
        if (l == 0) {
#pragma unroll
            for (int q = 0; q < RQ; ++q) { const int row = row0 + q * c.G * 8;
                if (row < NTOK) {
#pragma unroll
                    for (int i = 0; i < 2; ++i) { const float* p = xin + (size_t)row * 1024 + i * 512 + c.lane * 8; v[q][i][0] = *(const f32x4*)p; v[q][i][1] = *(const f32x4*)(p + 4); } } }
        } else {
            u32x4 xw[RQ][2], yw[RQ][2];
#pragma unroll
            for (int q = 0; q < RQ; ++q) { const int row = row0 + q * c.G * 8;
                if (row < NTOK) {
#pragma unroll
                    for (int i = 0; i < 2; ++i) { const size_t o = (size_t)row * 1024 + i * 512 + c.lane * 8; xw[q][i] = *(const u32x4*)(xb + o); yw[q][i] = *(const u32x4*)(y1 + o); } } }
#pragma unroll
            for (int q = 0; q < RQ; ++q)
#pragma unroll
                for (int i = 0; i < 2; ++i) { const u32x4 a = xw[q][i], b = yw[q][i];
                    v[q][i][0] = (f32x4){bflo(a.x), bfhi(a.x), bflo(a.y), bfhi(a.y)} + (f32x4){bflo(b.x), bfhi(b.x), bflo(b.y), bfhi(b.y)};
                    v[q][i][1] = (f32x4){bflo(a.z), bfhi(a.z), bflo(a.w), bfhi(a.w)} + (f32x4){bflo(b.z), bfhi(b.z), bflo(b.w), bfhi(b.w)}; }
        }
#pragma unroll
        for (int q = 0; q < RQ; ++q) { float s = 0.f;
#pragma unroll
            for (int i = 0; i < 2; ++i)
#pragma unroll
                for (int h = 0; h < 2; ++h) { const f32x4 w = v[q][i][h]; s += w[0] * w[0] + w[1] * w[1] + w[2] * w[2] + w[3] * w[3]; }
            ss[q] = (row0 + q * c.G * 8 < NTOK) ? s : 0.f; }
#pragma unroll
        for (int q = 0; q < RQ; ++q) ss[q] = wave_sum(ss[q]);
#pragma unroll
        for (int q = 0; q < RQ; ++q) { const int row = row0 + q * c.G * 8;
            if (row < NTOK) { const int b = row / SEQ; const float* sh = mod + b * 6144; const float* sc = sh + 1024; const float rinv = frsqrt(ss[q] * (1.0f / 1024.0f) + EPS);
#pragma unroll
                for (int i = 0; i < 2; ++i) { const int col = i * 512 + c.lane * 8; float o8[8];
#pragma unroll
                    for (int h = 0; h < 2; ++h) { const f32x4 g = *(const f32x4*)(gn + col + 4 * h), s1 = *(const f32x4*)(sc + col + 4 * h), s0 = *(const f32x4*)(sh + col + 4 * h);
                        const f32x4 hv = v[q][i][h] * rinv * g * (s1 + 1.0f) + s0; o8[4 * h] = hv[0]; o8[4 * h + 1] = hv[1]; o8[4 * h + 2] = hv[2]; o8[4 * h + 3] = hv[3]; }
                    *(u32x4*)(ha + (size_t)row * 1024 + col) = pk8(o8); } } }
    }
}

#define MFMA16(a, b, c) __builtin_amdgcn_mfma_f32_16x16x32_bf16((a), (b), (c), 0, 0, 0)
#define MFMA32(a, b, c) __builtin_amdgcn_mfma_f32_32x32x16_bf16((a), (b), (c), 0, 0, 0)

__device__ __forceinline__ void mix_unit(const Ctx& c_, int l, int r0) { const Ctx c = fresh(c_);
    const bf16_t* Z = c.w<bf16_t>(WS_Z); bf16_t* Aq = (bf16_t*)c.lds; bf16_t* Akv = (bf16_t*)(c.lds + 12800); float* Lkr = (float*)(c.lds + 21504);
    float* Lu = (float*)(c.lds + 25600); bf16_t* Lp = (bf16_t*)(c.lds + 73728); float* Lcu = (float*)(c.lds + 90624); float* Lco = (float*)c.lds;
    const int s0 = r0 % SEQ, b = r0 / SEQ, fr = c.lane & 15, fq = c.lane >> 4;
    {   const int t = c.tid >> 4, sub = c.tid & 15; const bf16_t* zr = Z + (size_t)(r0 + t) * ZP;
        const u32x4 zero4 = {0u, 0u, 0u, 0u};
        const u32x4 ra0 = *(const u32x4*)(zr + Z_CQ + sub * 8), ra1 = (sub < 8) ? *(const u32x4*)(zr + Z_CQ + 128 + sub * 8) : zero4, rk0 = *(const u32x4*)(zr + Z_CKV + sub * 8), rkr = (sub < 4) ? *(const u32x4*)(zr + Z_KR + sub * 8) : zero4;
        u32x4 rp[3], rca[4], rcg[4];
#pragma unroll
        for (int i = 0; i < 3; ++i) { const int ch = c.tid + 512 * i, row = ch >> 5, c8 = ch & 31; rp[i] = (ch < 47 * 32 && s0 - 15 + row >= 0) ? *(const u32x4*)(Z + (size_t)(r0 - 15 + row) * ZP + Z_POOL + c8 * 8) : zero4; }
#pragma unroll
        for (int i = 0; i < 4; ++i) { const int ch = c.tid + 512 * i, row = ch >> 5, c8 = ch & 31; const bool ok = (ch < 62 * 32 && s0 - 30 + row >= 0);
            rca[i] = ok ? *(const u32x4*)(Z + (size_t)(r0 - 30 + row) * ZP + Z_CA + c8 * 8) : zero4; rcg[i] = ok ? *(const u32x4*)(Z + (size_t)(r0 - 30 + row) * ZP + Z_CG + c8 * 8) : zero4; }
        auto un8 = [](const u32x4 v, float (&o)[8]) { o[0] = bflo(v.x); o[1] = bfhi(v.x); o[2] = bflo(v.y); o[3] = bfhi(v.y); o[4] = bflo(v.z); o[5] = bfhi(v.z); o[6] = bflo(v.w); o[7] = bfhi(v.w); };
        const float* qag = c.inf(I_QAG) + l * 192; const float* kvag = c.inf(I_KVAG) + l * 128;
        float a0[8], a1[8], k0[8]; float ssq = 0.f, ssk = 0.f; un8(ra0, a0); un8(ra1, a1); un8(rk0, k0);
#pragma unroll
        for (int j = 0; j < 8; ++j) { ssq += a0[j] * a0[j] + a1[j] * a1[j]; ssk += k0[j] * k0[j]; }
#pragma unroll
        for (int m = 1; m < 16; m <<= 1) { ssq += __shfl_xor(ssq, m); ssk += __shfl_xor(ssk, m); }
        const float rq = frsqrt(ssq * (1.0f / 192.0f) + EPS), rk = frsqrt(ssk * (1.0f / 128.0f) + EPS);
#pragma unroll
        for (int j = 0; j < 8; ++j) a0[j] *= rq * qag[sub * 8 + j];
        *(u32x4*)(Aq + t * 200 + sub * 8) = pk8(a0);
        if (sub < 8) {
#pragma unroll
            for (int j = 0; j < 8; ++j) a1[j] *= rq * qag[128 + sub * 8 + j];
            *(u32x4*)(Aq + t * 200 + 128 + sub * 8) = pk8(a1); }
#pragma unroll
        for (int j = 0; j < 8; ++j) k0[j] *= rk * kvag[sub * 8 + j];
        *(u32x4*)(Akv + t * 136 + sub * 8) = pk8(k0);
        if (sub < 4) { float kr[8]; un8(rkr, kr);
#pragma unroll
            for (int j = 0; j < 8; ++j) Lkr[t * 32 + sub * 8 + j] = kr[j]; }
#pragma unroll
        for (int i = 0; i < 3; ++i) { const int ch = c.tid + 512 * i, row = ch >> 5, c8 = ch & 31; if (ch < 47 * 32) { float v[8]; un8(rp[i], v);
            *(f32x4*)(Lu + row * 256 + c8 * 8) = (f32x4){v[0], v[1], v[2], v[3]}; *(f32x4*)(Lu + row * 256 + c8 * 8 + 4) = (f32x4){v[4], v[5], v[6], v[7]}; } }
#pragma unroll
        for (int i = 0; i < 4; ++i) { const int ch = c.tid + 512 * i, row = ch >> 5, c8 = ch & 31; if (ch < 62 * 32) { float a[8], g[8]; un8(rca[i], a); un8(rcg[i], g);
#pragma unroll
            for (int j = 0; j < 8; ++j) a[j] *= fsigmoid(g[j]);
            *(f32x4*)(Lcu + row * 256 + c8 * 8) = (f32x4){a[0], a[1], a[2], a[3]}; *(f32x4*)(Lcu + row * 256 + c8 * 8 + 4) = (f32x4){a[4], a[5], a[6], a[7]}; } }
    }
    __syncthreads();
    const float* rcos = c.w<float>(WS_ROPE); const float* rsin = rcos + (size_t)NTOK * 16;
    if (c.wid < 4) {
        const int h = c.wid; const bf16_t* W = c.w<bf16_t>(WS_WUQ + (size_t)(l & 1) * WSET) + (size_t)(96 * h) * 192; const float* qg = c.inf(I_QG) + l * 96;
        f32x4 acc[6][2];
#pragma unroll
        for (int nf = 0; nf < 6; ++nf) { acc[nf][0] = (f32x4){0.f, 0.f, 0.f, 0.f}; acc[nf][1] = acc[nf][0]; }
#pragma unroll 3
        for (int ks = 0; ks < 6; ++ks) { bf16x8 af[2];
#pragma unroll
            for (int mf = 0; mf < 2; ++mf) af[mf] = *(const bf16x8*)(Aq + (mf * 16 + fr) * 200 + ks * 32 + fq * 8);
#pragma unroll
            for (int nf = 0; nf < 6; ++nf) { const bf16x8 bfr = *(const bf16x8*)(W + (size_t)(16 * nf + fr) * 192 + ks * 32 + fq * 8);
                acc[nf][0] = MFMA16(bfr, af[0], acc[nf][0]); acc[nf][1] = MFMA16(bfr, af[1], acc[nf][1]); } }
#pragma unroll
        for (int mf = 0; mf < 2; ++mf) { float ss = 0.f;
#pragma unroll
            for (int nf = 0; nf < 6; ++nf)
#pragma unroll
                for (int j = 0; j < 4; ++j) ss += acc[nf][mf][j] * acc[nf][mf][j];
            ss += __shfl_xor(ss, 16); ss += __shfl_xor(ss, 32);
            const float rinv = frsqrt(ss * (1.0f / 96.0f) + EPS) * (0.10206207261596575f * 1.44269504089f);
            const int tok = r0 + mf * 16 + fr; bf16_t* qo = c.w<bf16_t>(WS_Q) + ((size_t)(b * 4 + h) * SEQ + s0 + mf * 16 + fr) * 96;
            float v[6][4];
#pragma unroll
            for (int nf = 0; nf < 6; ++nf)
#pragma unroll
                for (int j = 0; j < 4; ++j) v[nf][j] = acc[nf][mf][j] * rinv * qg[16 * nf + 4 * fq + j];
            const f32x4 cs4 = *(const f32x4*)(rcos + (size_t)tok * 16 + 4 * fq), sn4 = *(const f32x4*)(rsin + (size_t)tok * 16 + 4 * fq);
#pragma unroll
            for (int j = 0; j < 4; ++j) { const float x1 = v[4][j], x2 = v[5][j]; v[4][j] = x1 * cs4[j] - x2 * sn4[j]; v[5][j] = x1 * sn4[j] + x2 * cs4[j]; }
#pragma unroll
            for (int nf = 0; nf < 6; ++nf) { u32x2 o; o.x = cvt_pk_bf16(v[nf][0], v[nf][1]); o.y = cvt_pk_bf16(v[nf][2], v[nf][3]); *(u32x2*)(qo + 16 * nf + 4 * fq) = o; } }
    } else {
        const int h = c.wid - 4; const bf16_t* W = c.w<bf16_t>(WS_WUKV + (size_t)(l & 1) * WSET) + (size_t)(128 * h) * 128; const float* kg = c.inf(I_KG) + l * 96;
        f32x4 ak[4][2], av[4][2];
#pragma unroll
        for (int nf = 0; nf < 4; ++nf) { ak[nf][0] = (f32x4){0.f, 0.f, 0.f, 0.f}; ak[nf][1] = ak[nf][0]; av[nf][0] = ak[nf][0]; av[nf][1] = ak[nf][0]; }
#pragma unroll 2
        for (int ks = 0; ks < 4; ++ks) { bf16x8 af[2];
#pragma unroll
            for (int mf = 0; mf < 2; ++mf) af[mf] = *(const bf16x8*)(Akv + (mf * 16 + fr) * 136 + ks * 32 + fq * 8);
#pragma unroll
            for (int nf = 0; nf < 4; ++nf) { const bf16x8 bk = *(const bf16x8*)(W + (size_t)(16 * nf + fr) * 128 + ks * 32 + fq * 8), bv = *(const bf16x8*)(W + (size_t)(64 + 16 * nf + fr) * 128 + ks * 32 + fq * 8);
                ak[nf][0] = MFMA16(bk, af[0], ak[nf][0]); ak[nf][1] = MFMA16(bk, af[1], ak[nf][1]);
                av[nf][0] = MFMA16(af[0], bv, av[nf][0]); av[nf][1] = MFMA16(af[1], bv, av[nf][1]); } }
#pragma unroll
        for (int mf = 0; mf < 2; ++mf) { const int tl = mf * 16 + fr; float ss = 0.f;
#pragma unroll
            for (int nf = 0; nf < 4; ++nf)
#pragma unroll
                for (int j = 0; j < 4; ++j) ss += ak[nf][mf][j] * ak[nf][mf][j];
#pragma unroll
            for (int j = 0; j < 8; ++j) { const float kr = Lkr[tl * 32 + fq * 8 + j]; ss += kr * kr; }
            ss += __shfl_xor(ss, 16); ss += __shfl_xor(ss, 32);
            const float rinv = frsqrt(ss * (1.0f / 96.0f) + EPS);
            const int tok = r0 + tl; bf16_t* ko = c.w<bf16_t>(WS_K) + ((size_t)(b * 4 + h) * SEQ + s0 + tl) * 96;
#pragma unroll
            for (int nf = 0; nf < 4; ++nf) { u32x2 o; o.x = cvt_pk_bf16(ak[nf][mf][0] * rinv * kg[16 * nf + 4 * fq], ak[nf][mf][1] * rinv * kg[16 * nf + 4 * fq + 1]);
                o.y = cvt_pk_bf16(ak[nf][mf][2] * rinv * kg[16 * nf + 4 * fq + 2], ak[nf][mf][3] * rinv * kg[16 * nf + 4 * fq + 3]); *(u32x2*)(ko + 16 * nf + 4 * fq) = o; }
            const f32x4 cs4 = *(const f32x4*)(rcos + (size_t)tok * 16 + 4 * fq), sn4 = *(const f32x4*)(rsin + (size_t)tok * 16 + 4 * fq);
            float o1[4], o2[4];
#pragma unroll
            for (int j = 0; j < 4; ++j) { const int i = 4 * fq + j; const float x1 = Lkr[tl * 32 + i] * rinv * kg[64 + i], x2 = Lkr[tl * 32 + 16 + i] * rinv * kg[80 + i];
                o1[j] = x1 * cs4[j] - x2 * sn4[j]; o2[j] = x1 * sn4[j] + x2 * cs4[j]; }
            { u32x2 o; o.x = cvt_pk_bf16(o1[0], o1[1]); o.y = cvt_pk_bf16(o1[2], o1[3]); *(u32x2*)(ko + 64 + 4 * fq) = o; o.x = cvt_pk_bf16(o2[0], o2[1]); o.y = cvt_pk_bf16(o2[2], o2[3]); *(u32x2*)(ko + 80 + 4 * fq) = o; }
            bf16_t* vo = c.w<bf16_t>(WS_VT) + (size_t)(b * 4 + h) * 64 * SEQ + s0 + mf * 16 + 4 * fq;
#pragma unroll
            for (int nf = 0; nf < 4; ++nf) { u32x2 o; o.x = cvt_pk_bf16(av[nf][mf][0], av[nf][mf][1]); o.y = cvt_pk_bf16(av[nf][mf][2], av[nf][mf][3]); *(u32x2*)(vo + (size_t)(16 * nf + fr) * SEQ) = o; } }
    }
    { const int t = c.tid >> 4, sub = c.tid & 15, g = sub >> 2, w = 2 << g, s = s0 + t; const float inv = 1.0f / (float)((s + 1 < w) ? (s + 1) : w);
#pragma unroll
        for (int k = 0; k < 2; ++k) { const int col = sub * 16 + k * 8; float sum[8];
#pragma unroll
            for (int j = 0; j < 8; ++j) sum[j] = 0.f;
            for (int d = 0; d < w; ++d) { const float* p = Lu + (t + 15 - d) * 256 + col;
#pragma unroll
                for (int j = 0; j < 8; ++j) sum[j] += p[j]; }
            const float* p0 = Lu + (t + 15) * 256 + col;
#pragma unroll
            for (int j = 0; j < 8; ++j) sum[j] = sum[j] * inv - p0[j];
            *(u32x4*)(Lp + t * 264 + col) = pk8(sum); } }
    float cres[16];
    { const int chn = c.tid & 255, half = c.tid >> 8; const float* dw = c.inf(I_DWW) + (size_t)l * 31 * 256 + chn; const float bias = c.inf(I_DWB)[l * 256 + chn];
        float wv[31];
#pragma unroll
        for (int j = 0; j < 31; ++j) wv[j] = dw[j * 256];
#pragma unroll
        for (int tt = 0; tt < 16; ++tt) cres[tt] = bias;
#pragma unroll
        for (int r = 0; r < 46; ++r) { const float u = Lcu[(half * 16 + r) * 256 + chn];
#pragma unroll
            for (int tt = 0; tt < 16; ++tt) { const int j = r - tt; if (j >= 0 && j < 31) cres[tt] += wv[j] * u; } } }
    __syncthreads();
    { const int g = c.wid >> 1, mf = c.wid & 1; const bf16_t* W = c.w<bf16_t>(WS_WPOOL + (size_t)(l & 1) * WSET) + g * 4096; const float* ps = c.inf(I_PSCALE) + l * 256 + g * 64;
        f32x4 acc[4];
#pragma unroll
        for (int nf = 0; nf < 4; ++nf) acc[nf] = (f32x4){0.f, 0.f, 0.f, 0.f};
#pragma unroll
        for (int ks = 0; ks < 2; ++ks) { const bf16x8 af = *(const bf16x8*)(Lp + (mf * 16 + fr) * 264 + g * 64 + ks * 32 + fq * 8);
#pragma unroll
            for (int nf = 0; nf < 4; ++nf) { const bf16x8 bfr = *(const bf16x8*)(W + (16 * nf + fr) * 64 + ks * 32 + fq * 8); acc[nf] = MFMA16(bfr, af, acc[nf]); } }
        bf16_t* yo = c.w<bf16_t>(WS_YB) + (size_t)(r0 + mf * 16 + fr) * 1024 + 256 + g * 64;
#pragma unroll
        for (int nf = 0; nf < 4; ++nf) { const int d = 16 * nf + 4 * fq; u32x2 o; o.x = cvt_pk_bf16(acc[nf][0] * ps[d], acc[nf][1] * ps[d + 1]); o.y = cvt_pk_bf16(acc[nf][2] * ps[d + 2], acc[nf][3] * ps[d + 3]); *(u32x2*)(yo + d) = o; } }
    { const int chn = c.tid & 255, half = c.tid >> 8;
#pragma unroll
        for (int tt = 0; tt < 16; ++tt) Lco[(half * 16 + tt) * 256 + chn] = cres[tt]; }
    __syncthreads();
    { const float* lg = c.inf(I_LNG) + l * 256 + c.lane * 4; const float* lb = c.inf(I_LNB) + l * 256 + c.lane * 4;
#pragma unroll
        for (int k = 0; k < 4; ++k) { const int t = c.wid * 4 + k; const f32x4 v = *(const f32x4*)(Lco + t * 256 + c.lane * 4);
            const float mean = wave_sum(v[0] + v[1] + v[2] + v[3]) * (1.0f / 256.0f); const f32x4 d = v - mean;
            const float var = wave_sum(d[0] * d[0] + d[1] * d[1] + d[2] * d[2] + d[3] * d[3]) * (1.0f / 256.0f); const float rs = frsqrt(var + EPS);
            float y[4];
#pragma unroll
            for (int j = 0; j < 4; ++j) y[j] = fsilu(d[j] * rs * lg[j] + lb[j]);
            u32x2 o; o.x = cvt_pk_bf16(y[0], y[1]); o.y = cvt_pk_bf16(y[2], y[3]); *(u32x2*)(c.w<bf16_t>(WS_YB) + (size_t)(r0 + t) * 1024 + 768 + c.lane * 4) = o; } }
    __syncthreads();
}

constexpr int CW_W13 = 32 * 16 * 16, CW_W2 = 32 * 8 * 32, CW_IN = 16 * 72, CW_OUT = 16 * 32, CW_UQ = 3 * 12, CW_UKV = 2 * 16, CW_POOL = 4 * 2;
constexpr int CW_TOTAL = 2 * CW_W13 + CW_W2 + CW_IN + CW_OUT + CW_UQ + CW_UKV + CW_POOL;
struct CvtTile { const float* src; bf16_t* dst; int ldn, ldk; };
__device__ __forceinline__ void cvt_decode(const Ctx& c, int l, int t, CvtTile& d) {
    const size_t wso = (size_t)(l & 1) * WSET; int r = t;
    if (r < 2 * CW_W13) { const int which = r / CW_W13; r %= CW_W13; const int e = r >> 8, kt = (r >> 4) & 15, nt = r & 15, n0 = nt * 32;
        d.src = c.inf(which ? I_W3 : I_W1) + ((size_t)l * 32 + e) * 1024 * 512 + (size_t)kt * 64 * 512 + n0; d.ldn = 512; d.ldk = 1024;
        d.dst = c.w<bf16_t>(WS_WUP + wso) + (size_t)e * 1024 * 1024 + (size_t)((n0 >> 7) * 256 + which * 128 + (n0 & 127)) * 1024 + kt * 64; return; } r -= 2 * CW_W13;
    if (r < CW_W2) { const int e = r >> 8, kt = (r >> 5) & 7, nt = r & 31;
        d.src = c.inf(I_W2) + ((size_t)l * 32 + e) * 512 * 1024 + (size_t)kt * 64 * 1024 + nt * 32; d.ldn = 1024; d.ldk = 512;
        d.dst = c.w<bf16_t>(WS_WDN + wso) + (size_t)e * 1024 * 512 + (size_t)(nt * 32) * 512 + kt * 64; return; } r -= CW_W2;
    if (r < CW_IN) { const int kt = r / 72, nt = r % 72; d.src = (nt < 67) ? c.inf(I_WIN) + (size_t)l * 1024 * 2144 + (size_t)kt * 64 * 2144 + nt * 32 : nullptr; d.ldn = 2144; d.ldk = 1024;
        d.dst = c.w<bf16_t>(WS_WIN + wso) + (size_t)(nt * 32) * 1024 + kt * 64; return; } r -= CW_IN;
    if (r < CW_OUT) { const int kt = r >> 5, nt = r & 31; d.src = c.inf(I_WOUT) + (size_t)l * 1024 * 1024 + (size_t)kt * 64 * 1024 + nt * 32; d.ldn = 1024; d.ldk = 1024;
        d.dst = c.w<bf16_t>(WS_WOUT + wso) + (size_t)(nt * 32) * 1024 + kt * 64; return; } r -= CW_OUT;
    if (r < CW_UQ) { const int kt = r / 12, nt = r % 12; d.src = c.inf(I_WUQ) + (size_t)l * 192 * 384 + (size_t)kt * 64 * 384 + nt * 32; d.ldn = 384; d.ldk = 192;
        d.dst = c.w<bf16_t>(WS_WUQ + wso) + (size_t)(nt * 32) * 192 + kt * 64; return; } r -= CW_UQ;
    if (r < CW_UKV) { const int kt = r >> 4, nt = r & 15; d.src = c.inf(I_WUKV) + (size_t)l * 128 * 512 + (size_t)kt * 64 * 512 + nt * 32; d.ldn = 512; d.ldk = 128;
        d.dst = c.w<bf16_t>(WS_WUKV + wso) + (size_t)(nt * 32) * 128 + kt * 64; return; } r -= CW_UKV;
    { const int g = r >> 1, nt = r & 1; d.src = c.inf(I_WPOOL) + ((size_t)l * 4 + g) * 4096 + nt * 32; d.ldn = 64; d.ldk = 64; d.dst = c.w<bf16_t>(WS_WPOOL + wso) + g * 4096 + (size_t)(nt * 32) * 64; }
}
__device__ __forceinline__ void cvt_wave(const Ctx& c, int l, int wrank, int nwaves, float* T) {
    { const float* rgw = c.inf(I_RGW) + (size_t)l * 1024 * 4; const float* rew = c.inf(I_REW) + (size_t)l * 1024 * 32; float* rwt = c.w<float>(WS_RWT + (size_t)(l & 1) * WSET);
        for (int e = wrank * 64 + c.lane; e < 36 * 1024; e += nwaves * 64) { const int g = e >> 10, k = e & 1023; rwt[e] = (g < 4) ? rgw[k * 4 + g] : rew[k * 32 + g - 4]; } }
    f32x4 v[8]; CvtTile cur; cur.src = nullptr; cur.dst = nullptr; cur.ldn = 0; cur.ldk = 0;
    auto issue = [&](const CvtTile& d) {
#pragma unroll
        for (int i = 0; i < 8; ++i) { const int e4 = c.lane + 64 * i, kk = e4 >> 3, n4 = e4 & 7; v[i] = d.src ? *(const f32x4*)(d.src + (size_t)kk * d.ldn + n4 * 4) : (f32x4){0.f, 0.f, 0.f, 0.f}; } };
    int t = wrank;
    if (t < CW_TOTAL) { cvt_decode(c, l, t, cur); issue(cur); }
    while (t < CW_TOTAL) {
#pragma unroll
        for (int i = 0; i < 8; ++i) { const int e4 = c.lane + 64 * i, kk = e4 >> 3, n4 = e4 & 7; float* p = T + kk * 33 + n4 * 4; p[0] = v[i][0]; p[1] = v[i][1]; p[2] = v[i][2]; p[3] = v[i][3]; }
        const int tn = t + nwaves; CvtTile nxt = cur; if (tn < CW_TOTAL) { cvt_decode(c, l, tn, nxt); issue(nxt); }
        __builtin_amdgcn_wave_barrier();
        { const int n = c.lane & 31, kh = c.lane >> 5; bf16_t* drow = cur.dst + (size_t)n * cur.ldk + kh * 32;
#pragma unroll
            for (int q = 0; q < 4; ++q) { float o[8];
#pragma unroll
                for (int j = 0; j < 8; ++j) o[j] = T[(kh * 32 + q * 8 + j) * 33 + n];
                *(u32x4*)(drow + q * 8) = pk8(o); } }
        __builtin_amdgcn_wave_barrier();
        t = tn; cur = nxt;
    }
}

#ifdef EMU
static inline float __builtin_amdgcn_logf(float x) { return log2f(x); }
#endif
constexpr int HGP = 68, HGV = 40;
constexpr int HG_LG = 0, HG_LK = 8704, HG_LQ = 17408, HG_LVT = 26112, HG_LEG = 31232, HG_LGG = 31488, HG_BYTES = 31744;
template <bool OUT> __device__ __forceinline__ void hgrn_mfma(const Ctx& c_, int l, int bu, int cvt_layer = NL) { const Ctx c = fresh(c_);
    if (c.wid < 4) {
        const int cu = bu * 4 + c.wid, bh = cu / NCH, chunk = cu % NCH, b = bh >> 2, h = bh & 3, tok0 = b * SEQ + chunk * 128;
        const bf16_t* Z = c.w<bf16_t>(WS_Z); const float lbd = c.w<float>(WS_LB)[l * 256 + h * 64 + c.lane];
        unsigned char* L = c.lds + c.wid * HG_BYTES; float* Lg = (float*)(L + HG_LG); float* Lk = (float*)(L + HG_LK); float* Lq = (float*)(L + HG_LQ); bf16_t* Lvt = (bf16_t*)(L + HG_LVT); float* LeG = (float*)(L + HG_LEG); float* LG = (float*)(L + HG_LGG);
        const int l31 = c.lane & 31, hi = c.lane >> 5;
        f32x16 S[2][2];
        if (OUT) { const float* s0 = c.w<float>(WS_S0) + (size_t)(bh * NCH + chunk) * 4096;
#pragma unroll
            for (int mf = 0; mf < 2; ++mf)
#pragma unroll
                for (int nf = 0; nf < 2; ++nf)
#pragma unroll
                    for (int r = 0; r < 16; ++r) S[mf][nf][r] = s0[(32 * mf + (r & 3) + 8 * (r >> 2) + 4 * hi) * 64 + 32 * nf + l31]; }
        else {
#pragma unroll
            for (int mf = 0; mf < 2; ++mf)
#pragma unroll
                for (int nf = 0; nf < 2; ++nf)
#pragma unroll
                    for (int r = 0; r < 16; ++r) S[mf][nf][r] = 0.f; }
        float gtot = 0.f; const float og0 = OUT ? c.inf(I_HOG)[l * 64 + l31] : 0.f, og1 = OUT ? c.inf(I_HOG)[l * 64 + 32 + l31] : 0.f;
        u32x4 rf[4], rq[4], rv[4];
        { const bf16_t* zn = Z + (size_t)(tok0 + (c.lane >> 3)) * ZP + h * 64 + (c.lane & 7) * 8;
#pragma unroll
            for (int i = 0; i < 4; ++i) { rf[i] = *(const u32x4*)(zn + (size_t)i * 8 * ZP + Z_HF); rv[i] = *(const u32x4*)(zn + (size_t)i * 8 * ZP + Z_HI); if (OUT) rq[i] = *(const u32x4*)(zn + (size_t)i * 8 * ZP + Z_HQ); else rq[i] = (u32x4){0u, 0u, 0u, 0u}; } }
#pragma unroll 1
        for (int sc = 0; sc < 4; ++sc) { const int tokb = tok0 + sc * 32;
            {
                const int rr = c.lane >> 3, c8 = (c.lane & 7) * 8;
#pragma unroll
                for (int i = 0; i < 4; ++i) { const int tr = i * 8 + rr; float x[8];
                    { const u32x4 v = rf[i]; x[0] = bflo(v.x); x[1] = bfhi(v.x); x[2] = bflo(v.y); x[3] = bfhi(v.y); x[4] = bflo(v.z); x[5] = bfhi(v.z); x[6] = bflo(v.w); x[7] = bfhi(v.w); }
                    *(f32x4*)(Lg + tr * HGP + c8) = (f32x4){x[0], x[1], x[2], x[3]}; *(f32x4*)(Lg + tr * HGP + c8 + 4) = (f32x4){x[4], x[5], x[6], x[7]};
                    if (OUT) { const u32x4 v = rq[i]; x[0] = fsilu(bflo(v.x)); x[1] = fsilu(bfhi(v.x)); x[2] = fsilu(bflo(v.y)); x[3] = fsilu(bfhi(v.y)); x[4] = fsilu(bflo(v.z)); x[5] = fsilu(bfhi(v.z)); x[6] = fsilu(bflo(v.w)); x[7] = fsilu(bfhi(v.w));
                        *(f32x4*)(Lq + tr * HGP + c8) = (f32x4){x[0], x[1], x[2], x[3]}; *(f32x4*)(Lq + tr * HGP + c8 + 4) = (f32x4){x[4], x[5], x[6], x[7]}; }
                    { const u32x4 v = rv[i]; const unsigned w4[4] = {v.x, v.y, v.z, v.w};
#pragma unroll
                        for (int k = 0; k < 4; ++k) { Lvt[(c8 + 2 * k) * HGV + tr] = (bf16_t)(w4[k] & 0xffffu); Lvt[(c8 + 2 * k + 1) * HGV + tr] = (bf16_t)(w4[k] >> 16); } } }
                if (sc < 3) { const bf16_t* zn = Z + (size_t)(tokb + 32 + rr) * ZP + h * 64 + c8;
#pragma unroll
                    for (int i = 0; i < 4; ++i) { rf[i] = *(const u32x4*)(zn + (size_t)i * 8 * ZP + Z_HF); rv[i] = *(const u32x4*)(zn + (size_t)i * 8 * ZP + Z_HI); if (OUT) rq[i] = *(const u32x4*)(zn + (size_t)i * 8 * ZP + Z_HQ); } }
                __builtin_amdgcn_wave_barrier();
                float run = 0.f;
#pragma unroll
                for (int t = 0; t < 32; ++t) { const float f = lbd + (1.0f - lbd) * fsigmoid(Lg[t * HGP + c.lane]); run += __builtin_amdgcn_logf(f); Lg[t * HGP + c.lane] = run; Lk[t * HGP + c.lane] = 1.0f - f; }
                LG[c.lane] = run; LeG[c.lane] = __builtin_amdgcn_exp2f(run); gtot += run;
            }
            __builtin_amdgcn_wave_barrier();
            bf16x8 vt[2][2];
#pragma unroll
            for (int nf = 0; nf < 2; ++nf)
#pragma unroll
                for (int ks = 0; ks < 2; ++ks) vt[nf][ks] = *(const bf16x8*)(Lvt + (32 * nf + l31) * HGV + 16 * ks + 8 * hi);
            f32x16 O[2];
            if (OUT) {
#pragma unroll
                for (int r = 0; r < 16; ++r) { O[0][r] = 0.f; O[1][r] = 0.f; }
                float acc[8];
#pragma unroll
                for (int m = 0; m < 8; ++m) acc[m] = 0.f;
                const int sb = (l31 & 16) + 8 * hi;
#pragma unroll 1
                for (int d4 = 0; d4 < 16; ++d4) { const f32x4 qt = *(const f32x4*)(Lq + l31 * HGP + 4 * d4), gt = *(const f32x4*)(Lg + l31 * HGP + 4 * d4);
#pragma unroll
                    for (int mg = 0; mg < 4; ++mg) {
                        f32x4 k4[2], g4[2];
#pragma unroll
                        for (int j = 0; j < 2; ++j) { const int s = sb + 2 * mg + j; k4[j] = *(const f32x4*)(Lk + s * HGP + 4 * d4); g4[j] = *(const f32x4*)(Lg + s * HGP + 4 * d4); }
                        __builtin_amdgcn_sched_barrier(0);
#pragma unroll
                        for (int j = 0; j < 2; ++j)
#pragma unroll
                            for (int e = 0; e < 4; ++e) acc[mg * 2 + j] += qt[e] * k4[j][e] * __builtin_amdgcn_exp2f(gt[e] - g4[j][e]);
                        __builtin_amdgcn_sched_barrier(0); } }
                bf16x8 af[2], afx;
                { float a8[8];
#pragma unroll
                    for (int j = 0; j < 8; ++j) a8[j] = (sb + j <= l31) ? acc[j] : 0.f;
                    const bf16x8 ad = __builtin_bit_cast(bf16x8, pk8p(a8)), az = (bf16x8){0, 0, 0, 0, 0, 0, 0, 0};
                    af[0] = (l31 < 16) ? ad : az; af[1] = (l31 < 16) ? az : ad; }
                {
                    f32x16 dx;
#pragma unroll
                    for (int r = 0; r < 16; ++r) dx[r] = 0.f;
                    const bool lowr = l31 < 16; const float* Lx = lowr ? Lk : Lq;
#pragma unroll
                    for (int kk = 0; kk < 4; ++kk) { const int d0 = 16 * kk + 8 * hi;
                        const f32x4 xa = *(const f32x4*)(Lx + l31 * HGP + d0), xb = *(const f32x4*)(Lx + l31 * HGP + d0 + 4), ga = *(const f32x4*)(Lg + l31 * HGP + d0), gb = *(const f32x4*)(Lg + l31 * HGP + d0 + 4),
                                    ma = *(const f32x4*)(Lg + 15 * HGP + d0), mb = *(const f32x4*)(Lg + 15 * HGP + d0 + 4);
                        float v8[8];
#pragma unroll
                        for (int j = 0; j < 4; ++j) { const float da = ga[j] - ma[j], db = gb[j] - mb[j];
                            v8[j] = xa[j] * __builtin_amdgcn_exp2f(lowr ? -da : da); v8[4 + j] = xb[j] * __builtin_amdgcn_exp2f(lowr ? -db : db); }
                        const bf16x8 vv = __builtin_bit_cast(bf16x8, pk8p(v8)), zz = (bf16x8){0, 0, 0, 0, 0, 0, 0, 0};
                        dx = MFMA32(lowr ? vv : zz, lowr ? zz : vv, dx); }
                    float x8[8];
#pragma unroll
                    for (int j = 0; j < 8; ++j) x8[j] = dx[j];
                    afx = __builtin_bit_cast(bf16x8, pk8(x8)); }
#pragma unroll
                for (int mf = 0; mf < 2; ++mf)
#pragma unroll
                    for (int s = 0; s < 2; ++s) { const int d0 = 32 * mf + 16 * s + 4 * hi;
                        const f32x4 qa = *(const f32x4*)(Lq + l31 * HGP + d0), qb = *(const f32x4*)(Lq + l31 * HGP + d0 + 8), ga = *(const f32x4*)(Lg + l31 * HGP + d0), gb = *(const f32x4*)(Lg + l31 * HGP + d0 + 8);
                        float q8[8];
#pragma unroll
                        for (int j = 0; j < 4; ++j) { q8[j] = qa[j] * __builtin_amdgcn_exp2f(ga[j]); q8[4 + j] = qb[j] * __builtin_amdgcn_exp2f(gb[j]); }
                        const bf16x8 qf = __builtin_bit_cast(bf16x8, pk8p(q8));
#pragma unroll
                        for (int nf = 0; nf < 2; ++nf) { float s8[8];
#pragma unroll
                            for (int j = 0; j < 8; ++j) s8[j] = S[mf][nf][8 * s + j];
                            O[nf] = MFMA32(qf, __builtin_bit_cast(bf16x8, pk8p(s8)), O[nf]); } }
#pragma unroll
                for (int nf = 0; nf < 2; ++nf) {
#pragma unroll
                    for (int ks = 0; ks < 2; ++ks) O[nf] = MFMA32(af[ks], vt[nf][ks], O[nf]);
                    const s16x4 p0 = *(const s16x4*)(Lvt + (32 * nf + l31) * HGV + 4 * hi), p1 = *(const s16x4*)(Lvt + (32 * nf + l31) * HGV + 8 + 4 * hi);
                    O[nf] = MFMA32(afx, ((bf16x8){p0[0], p0[1], p0[2], p0[3], p1[0], p1[1], p1[2], p1[3]}), O[nf]); }
            }
#pragma unroll
            for (int mf = 0; mf < 2; ++mf) {
#pragma unroll
                for (int q = 0; q < 4; ++q) { const f32x4 e4 = *(const f32x4*)(LeG + 32 * mf + 8 * q + 4 * hi);
#pragma unroll
                    for (int e = 0; e < 4; ++e) { S[mf][0][4 * q + e] *= e4[e]; S[mf][1][4 * q + e] *= e4[e]; } }
                const int d = 32 * mf + l31; const float Gd = LG[d];
#pragma unroll
                for (int ks = 0; ks < 2; ++ks) { float k8[8];
#pragma unroll
                    for (int j = 0; j < 8; ++j) { const int s = 16 * ks + 8 * hi + j; k8[j] = Lk[s * HGP + d] * __builtin_amdgcn_exp2f(Gd - Lg[s * HGP + d]); }
                    const bf16x8 kf = __builtin_bit_cast(bf16x8, pk8p(k8));
                    S[mf][0] = MFMA32(kf, vt[0][ks], S[mf][0]); S[mf][1] = MFMA32(kf, vt[1][ks], S[mf][1]); } }
            if (OUT) {
                {
                    const int rr = c.lane >> 3, c8 = (c.lane & 7) * 8; const bf16_t* zg = Z + (size_t)(tokb + rr) * ZP + Z_HG + h * 64 + c8; u32x2 gv[4];
#pragma unroll
                    for (int hf = 0; hf < 2; ++hf) {
#pragma unroll
                    for (int i = 0; i < 4; ++i) gv[i] = *(const u32x2*)(zg + (size_t)i * 8 * ZP + 4 * hf);
#pragma unroll
                    for (int i = 0; i < 4; ++i) { const u32x2 v = gv[i]; *(f32x4*)(Lq + (i * 8 + rr) * HGP + c8 + 4 * hf) = (f32x4){fsilu(bflo(v.x)), fsilu(bfhi(v.x)), fsilu(bflo(v.y)), fsilu(bfhi(v.y))}; } }
                }
                __builtin_amdgcn_wave_barrier();
#pragma unroll
                for (int r = 0; r < 16; ++r) { const int tl = (r & 3) + 8 * (r >> 2) + 4 * hi; float ss = O[0][r] * O[0][r] + O[1][r] * O[1][r];
                    ss = half_sum(ss, hi);
                    const float rinv = frsqrt(ss * (1.0f / 64.0f) + EPS); const size_t tok = (size_t)(tokb + tl);
                    const float g0 = Lq[tl * HGP + l31], g1 = Lq[tl * HGP + 32 + l31];
                    bf16_t* yo = c.w<bf16_t>(WS_YB) + tok * 1024 + 512 + h * 64;
                    yo[l31] = (bf16_t)f2bf_bits(O[0][r] * rinv * og0 * g0); yo[32 + l31] = (bf16_t)f2bf_bits(O[1][r] * rinv * og1 * g1); } }
            __builtin_amdgcn_wave_barrier();
        }
        if (!OUT) { float* sc = c.w<float>(WS_SC) + (size_t)(bh * NCH + chunk) * 4096;
#pragma unroll
            for (int mf = 0; mf < 2; ++mf)
#pragma unroll
                for (int nf = 0; nf < 2; ++nf)
#pragma unroll
                    for (int r = 0; r < 16; ++r) sc[(32 * mf + (r & 3) + 8 * (r >> 2) + 4 * hi) * 64 + 32 * nf + l31] = S[mf][nf][r];
            c.w<float>(WS_PC)[(size_t)(bh * NCH + chunk) * 64 + c.lane] = __builtin_amdgcn_exp2f(gtot); }
    } else if (OUT && cvt_layer < NL) {
        cvt_wave(c, cvt_layer, bu * 4 + (c.wid - 4), NBH * NCH, (float*)(c.lds + 4 * HG_BYTES + (c.wid - 4) * 8448));
    }
    __syncthreads();
}
__device__ __forceinline__ void hgrn_carry(const Ctx& c_, int l) { const Ctx c = fresh(c_);
    const float* SC = c.w<float>(WS_SC); const float* PC = c.w<float>(WS_PC); float* S0 = c.w<float>(WS_S0);
    for (int e = c.blk * 512 + c.tid; e < NBH * 4096; e += c.G * 512) { const int bh = e >> 12, dv = e & 4095, d = dv >> 6; float s = 0.f;
#pragma unroll 32
        for (int ch = 0; ch < NCH; ++ch) { const size_t o = (size_t)(bh * NCH + ch) * 4096 + dv; S0[o] = s; s = PC[(size_t)(bh * NCH + ch) * 64 + d] * s + SC[o]; } }
    ASMV("s_waitcnt vmcnt(0)" ::: "memory");
    __syncthreads();
    if (c.tid == 0) { __builtin_amdgcn_fence(__ATOMIC_RELEASE, "agent"); ASMV("s_waitcnt vmcnt(0)" ::: "memory");
        (void)__hip_atomic_fetch_add((unsigned*)(c.ws + WS_CTL + CTL_HG) + l * 64, 1u, __ATOMIC_RELAXED, __HIP_MEMORY_SCOPE_AGENT); }
}
__device__ __forceinline__ void hgrn_wait_carry(const Ctx& c, int l) {
    if (c.tid == 0) { unsigned* p = (unsigned*)(c.ws + WS_CTL + CTL_HG) + l * 64; unsigned sp = 0;
        while (__hip_atomic_load(p, __ATOMIC_RELAXED, __HIP_MEMORY_SCOPE_AGENT) < (unsigned)c.G) { __builtin_amdgcn_s_sleep(1); if (++sp > (1u << 22)) break; }
        __builtin_amdgcn_fence(__ATOMIC_ACQUIRE, "agent"); ASMV("s_waitcnt vmcnt(0)" ::: "memory"); }
    __syncthreads();
}
__device__ __forceinline__ void ph_mixers(const Ctx& c, int l) {
    if (c.blk & 1) for (int bu = c.blk; bu < NBH * NCH / 4; bu += c.G) hgrn_mfma<false>(c, l, bu);
    for (int u = c.blk; u < NTOK / 32; u += c.G) mix_unit(c, l, u * 32);
    if (!(c.blk & 1)) for (int bu = c.blk; bu < NBH * NCH / 4; bu += c.G) hgrn_mfma<false>(c, l, bu);
}

template <bool FIXED>
__device__ __forceinline__ void attn_unit(const Ctx& c_, int bh, int qt, float negM) { const Ctx c = fresh(c_);
    const bf16_t* Qg = c.w<bf16_t>(WS_Q) + (size_t)bh * SEQ * 96; const bf16_t* Kg = c.w<bf16_t>(WS_K) + (size_t)bh * SEQ * 96; const bf16_t* Vg = c.w<bf16_t>(WS_VT) + (size_t)bh * 64 * SEQ;
    constexpr int KROW = 104, VROW = 72, KB = 64 * KROW * 2, VB = 64 * VROW * 2;
    const int l31 = c.lane & 31, hi = c.lane >> 5, qrow = qt * 256 + c.wid * 32 + l31;
    bf16x8 qf[6];
#pragma unroll
    for (int ks = 0; ks < 6; ++ks) qf[ks] = *(const bf16x8*)(Qg + (size_t)qrow * 96 + ks * 16 + hi * 8);
    f32x16 o0, o1;
#pragma unroll
    for (int r = 0; r < 16; ++r) { o0[r] = 0.f; o1[r] = 0.f; }
    float mrun = -INFINITY, lsum = 0.f; f32x2 lsum2 = {0.f, 0.f};
    const int nkt = 4 * (qt + 1), mylast = 4 * qt + (c.wid >> 1);
    const int kr0 = c.tid / 12, kc0 = c.tid % 12, kr1 = (c.tid + 512) / 12, kc1 = (c.tid + 512) % 12, vr = c.tid >> 3, vc = c.tid & 7;
    u32x4 sk0[2], sk1[2], sv[2];
    auto gload = [&](int j) {
#pragma unroll
        for (int h = 0; h < 2; ++h) { const int kt = 2 * j + h; sk0[h] = *(const u32x4*)(Kg + (size_t)(kt * 64 + kr0) * 96 + kc0 * 8); if (c.tid < 256) sk1[h] = *(const u32x4*)(Kg + (size_t)(kt * 64 + kr1) * 96 + kc1 * 8);
                               sv[h] = *(const u32x4*)(Vg + (size_t)vr * SEQ + kt * 64 + vc * 8); } };
    auto lstore = [&](int buf) {
#pragma unroll
        for (int h = 0; h < 2; ++h) { unsigned char* kb = c.lds + (buf * 2 + h) * (KB + VB); unsigned char* vb = kb + KB;
                                 *(u32x4*)(kb + (kr0 * KROW + kc0 * 8) * 2) = sk0[h]; if (c.tid < 256) *(u32x4*)(kb + (kr1 * KROW + kc1 * 8) * 2) = sk1[h]; *(u32x4*)(vb + (vr * VROW + vc * 8) * 2) = sv[h]; } };
    gload(0); lstore(0); __syncthreads();
    auto tile = [&](const int kt, auto masked) {
            const bf16_t* kb = (const bf16_t*)(c.lds + (kt & 3) * (KB + VB)); const bf16_t* vb = (const bf16_t*)(c.lds + (kt & 3) * (KB + VB) + KB);
            f32x16 s0, s1;
#pragma unroll
            for (int r = 0; r < 16; ++r) { s0[r] = FIXED ? negM : 0.f; s1[r] = FIXED ? negM : 0.f; }
#pragma unroll
            for (int ks = 0; ks < 6; ++ks) { const bf16x8 k0 = *(const bf16x8*)(kb + l31 * KROW + ks * 16 + hi * 8), k1 = *(const bf16x8*)(kb + (32 + l31) * KROW + ks * 16 + hi * 8);
                s0 = MFMA32(k0, qf[ks], s0); s1 = MFMA32(k1, qf[ks], s1); }
            if constexpr (decltype(masked)::value) {
#pragma unroll
                for (int r = 0; r < 16; ++r) { const int key = kt * 64 + (r & 3) + 8 * (r >> 2) + 4 * hi; if (key > qrow) s0[r] = -INFINITY; if (key + 32 > qrow) s1[r] = -INFINITY; } }
            if constexpr (FIXED) {
#pragma unroll
                for (int r = 0; r < 16; ++r) { s0[r] = __builtin_amdgcn_exp2f(s0[r]); s1[r] = __builtin_amdgcn_exp2f(s1[r]); }
#pragma unroll
                for (int r = 0; r < 16; r += 2) { lsum2 += (f32x2){s0[r], s0[r + 1]}; lsum2 += (f32x2){s1[r], s1[r + 1]}; }
            } else {
            float mx = s0[0];
#pragma unroll
            for (int r = 1; r < 16; ++r) mx = fmaxf(mx, s0[r]);
#pragma unroll
            for (int r = 0; r < 16; ++r) mx = fmaxf(mx, s1[r]);
            mx = fmaxf(mx, __shfl_xor(mx, 32));
            const float mnew = fmaxf(mrun, mx), alpha = __builtin_amdgcn_exp2f(mrun - mnew); mrun = mnew;
            float ps = 0.f;
#pragma unroll
            for (int r = 0; r < 16; ++r) { s0[r] = __builtin_amdgcn_exp2f(s0[r] - mnew); s1[r] = __builtin_amdgcn_exp2f(s1[r] - mnew); ps += s0[r] + s1[r]; }
            lsum = lsum * alpha + ps;
#pragma unroll
            for (int r = 0; r < 16; ++r) { o0[r] *= alpha; o1[r] *= alpha; }
            }
#pragma unroll
            for (int kf = 0; kf < 2; ++kf)
#pragma unroll
                for (int s = 0; s < 2; ++s) { const f32x16& sx = kf ? s1 : s0; u32x4 pw; pw.x = cvt_pk_bf16(sx[8 * s], sx[8 * s + 1]); pw.y = cvt_pk_bf16(sx[8 * s + 2], sx[8 * s + 3]); pw.z = cvt_pk_bf16(sx[8 * s + 4], sx[8 * s + 5]); pw.w = cvt_pk_bf16(sx[8 * s + 6], sx[8 * s + 7]);
                    const bf16x8 pf = __builtin_bit_cast(bf16x8, pw); const int kcol = kf * 32 + 16 * s + 4 * hi;
                    const s16x4 a0 = *(const s16x4*)(vb + l31 * VROW + kcol), a1 = *(const s16x4*)(vb + l31 * VROW + kcol + 8), b0 = *(const s16x4*)(vb + (32 + l31) * VROW + kcol), b1 = *(const s16x4*)(vb + (32 + l31) * VROW + kcol + 8);
                    const bf16x8 v0 = (bf16x8){a0[0], a0[1], a0[2], a0[3], a1[0], a1[1], a1[2], a1[3]}, v1 = (bf16x8){b0[0], b0[1], b0[2], b0[3], b1[0], b1[1], b1[2], b1[3]};
                    o0 = MFMA32(v0, pf, o0); o1 = MFMA32(v1, pf, o1); }
            };
    const int nkj = nkt >> 1, jl = mylast >> 1;
    int j = 0;
    for (; j < jl; ++j) { gload(j + 1); tile(2 * j, std::false_type{}); tile(2 * j + 1, std::false_type{}); lstore((j + 1) & 1); __syncthreads(); }
    { if (mylast & 1) { tile(2 * j, std::false_type{}); tile(2 * j + 1, std::true_type{}); } else tile(2 * j, std::true_type{});
      if (j + 1 < nkj) { gload(j + 1); lstore((j + 1) & 1); }
      __syncthreads(); ++j; }
    for (; j < nkj; ++j) { if (j + 1 < nkj) { gload(j + 1); lstore((j + 1) & 1); } __syncthreads(); }
    if constexpr (FIXED) lsum = lsum2[0] + lsum2[1];
    lsum += __shfl_xor(lsum, 32); const float rl = 1.0f / lsum;
    const int b = bh >> 2, h = bh & 3; bf16_t* yo = c.w<bf16_t>(WS_YB) + (size_t)(b * SEQ + qrow) * 1024 + h * 64;
#pragma unroll
    for (int g = 0; g < 4; ++g) { const int dv = 8 * g + 4 * hi; u32x2 w0, w1;
        w0.x = cvt_pk_bf16(o0[4 * g] * rl, o0[4 * g + 1] * rl); w0.y = cvt_pk_bf16(o0[4 * g + 2] * rl, o0[4 * g + 3] * rl); *(u32x2*)(yo + dv) = w0;
        w1.x = cvt_pk_bf16(o1[4 * g] * rl, o1[4 * g + 1] * rl); w1.y = cvt_pk_bf16(o1[4 * g + 2] * rl, o1[4 * g + 3] * rl); *(u32x2*)(yo + 32 + dv) = w1; }
    __syncthreads();
}
template <bool FIXED>
__device__ __forceinline__ void attn_units(const Ctx& c, float negM) {
    { const int NU = NBH * (NQT / 2);
      if ((c.G & 7) == 0) { const int per = (NU + 7) / 8, x = c.blk & 7, G8 = c.G >> 3;
          for (int j = c.blk >> 3; j < per; j += G8) { const int pu = x * per + j; if (pu < NU) { const int bh = pu / (NQT / 2), p = pu % (NQT / 2); attn_unit<FIXED>(c, bh, NQT - 1 - p, negM); attn_unit<FIXED>(c, bh, p, negM); } } }
      else for (int pu = c.blk; pu < NU; pu += c.G) { const int bh = pu / (NQT / 2), p = pu % (NQT / 2); attn_unit<FIXED>(c, bh, NQT - 1 - p, negM); attn_unit<FIXED>(c, bh, p, negM); } }
}
__device__ __forceinline__ void ph_attn(const Ctx& c, int l) {
    hgrn_carry(c, l);
    {
        const float* qg = c.inf(I_QG) + l * 96; const float* kg = c.inf(I_KG) + l * 96;
        int ln = c.lane; LAUNDER_V(ln);
        float gq = fmaxf(fabsf(qg[ln]), fabsf(qg[32 + (ln & 63)])), gk = fmaxf(fabsf(kg[ln]), fabsf(kg[32 + (ln & 63)]));
#pragma unroll
        for (int o = 1; o < 64; o <<= 1) { gq = fmaxf(gq, __shfl_xor(gq, o)); gk = fmaxf(gk, __shfl_xor(gk, o)); }
        const float M = 9.797958971132712f * 1.44269504089f * 1.02f * gq * gk;
        if (M <= 60.0f) attn_units<true>(c, -M); else attn_units<false>(c, 0.f); }
    hgrn_wait_carry(c, l);
    for (int bu = c.blk; bu < NBH * NCH / 4; bu += c.G) hgrn_mfma<true>(c, l, bu, l + 1);
}

__device__ __forceinline__ void ph_router(const Ctx& c_, int l, int cnt_off = 0) { const Ctx c = fresh(c_);
    bf16_t* Whi = (bf16_t*)c.lds; bf16_t* Wlo = (bf16_t*)(c.lds + 73728); float* Llog = (float*)(c.lds + 147456) + c.wid * 288; float* Lcb = (float*)(c.lds + 156672);
    int* Le = (int*)(c.lds + 156672 + 256); float* Lw = (float*)(c.lds + 156672 + 256 + 1024); int* Lr = (int*)(c.lds + 156672 + 256 + 2048); int* Lcnt = (int*)(c.lds + 156672 + 256 + 3072); int* Lbase = Lcnt + 32;
    const float* rwt = c.w<float>(WS_RWT + (size_t)(l & 1) * WSET);
    const float* rgb = c.inf(I_RGB) + l * 4; const float* reb = c.inf(I_REB) + l * 32;
    const bf16_t* x = c.w<bf16_t>(WS_XB); const float* gn = c.inf(I_N2G) + l * 1024; const float* mod = c.w<float>(WS_MOD) + (size_t)l * NB * 6144; bf16_t* ha = c.w<bf16_t>(WS_HA);
    unsigned* cnt = (unsigned*)(c.ws + WS_CTL + CTL_CNT) + l * 32 + cnt_off;
    int* rowtok = c.w<int>(WS_ROWTOK); float* roww = c.w<float>(WS_ROWW);
    const int fr = c.lane & 15, fq = c.lane >> 4;
    int staged_b = -1;
    for (int u = c.blk; u < NTOK / 128; u += c.G) {
        const int b = (u * 128) / SEQ; const float* sh = mod + b * 6144 + 3072; const float* sc = sh + 1024;
        __syncthreads();
        if (b != staged_b) { staged_b = b;
            for (int q = c.tid; q < 36 * 128; q += 512) { const int n = q >> 7, ch = q & 127, k0 = ch * 8; float hi8[8], lo8[8];
#pragma unroll
                for (int j = 0; j < 8; ++j) { const float w = rwt[n * 1024 + k0 + j] * gn[k0 + j] * (1.0f + sc[k0 + j]); const float h = bf2f((bf16_t)f2bf_bits(w)); hi8[j] = h; lo8[j] = w - h; }
                const int pc = (ch ^ (n & 15)) * 8; *(u32x4*)(Whi + n * 1024 + pc) = pk8(hi8); *(u32x4*)(Wlo + n * 1024 + pc) = pk8(lo8); }
            for (int g = c.wid; g < 36; g += 8) { float s = 0.f;
#pragma unroll
                for (int i = 0; i < 4; ++i) { const f32x4 w = *(const f32x4*)(rwt + g * 1024 + i * 256 + c.lane * 4), s4 = *(const f32x4*)(sh + i * 256 + c.lane * 4); s += w[0] * s4[0] + w[1] * s4[1] + w[2] * s4[2] + w[3] * s4[3]; }
                s = wave_sum(s); if (c.lane == 0) Lcb[g] = s + (g < 4 ? rgb[g] : reb[g - 4]); } }
        if (c.tid < 32) Lcnt[c.tid] = 0;
        __syncthreads();
        const int rowb = u * 128 + c.wid * 16; const bf16_t* xr = x + (size_t)(rowb + fr) * 1024 + 8 * fq;
        f32x4 acc[3] = {{0.f, 0.f, 0.f, 0.f}, {0.f, 0.f, 0.f, 0.f}, {0.f, 0.f, 0.f, 0.f}}; float ssp = 0.f;
#pragma unroll 8
        for (int ks = 0; ks < 32; ++ks) { const u32x4 hw = *(const u32x4*)(xr + 32 * ks);
            const unsigned hws[4] = {hw.x, hw.y, hw.z, hw.w};
#pragma unroll
            for (int j = 0; j < 4; ++j) { const float a = bflo(hws[j]), b = bfhi(hws[j]); ssp += a * a + b * b; }
            const bf16x8 ah = __builtin_bit_cast(bf16x8, hw);
            const int ch = 4 * ks + fq;
#pragma unroll
            for (int nf = 0; nf < 3; ++nf) { const int n = 16 * nf + fr; bf16x8 bh = {0, 0, 0, 0, 0, 0, 0, 0}, bl = bh;
                if (nf < 2 || fr < 4) { const int pc = (ch ^ (n & 15)) * 8; bh = *(const bf16x8*)(Whi + n * 1024 + pc); bl = *(const bf16x8*)(Wlo + n * 1024 + pc); }
                acc[nf] = MFMA16(ah, bh, acc[nf]); acc[nf] = MFMA16(ah, bl, acc[nf]); } }
        ssp += __shfl_xor(ssp, 16); ssp += __shfl_xor(ssp, 32);
        const float rinv = frsqrt(ssp * (1.0f / 1024.0f) + EPS);
        float rj[4];
#pragma unroll
        for (int j = 0; j < 4; ++j) rj[j] = __shfl(rinv, fq * 4 + j);
#pragma unroll
        for (int half = 0; half < 2; ++half) {
            if ((fq >> 1) == half) {
#pragma unroll
                for (int nf = 0; nf < 3; ++nf) { const int col = 16 * nf + fr; if (col < 36) {
#pragma unroll
                    for (int j = 0; j < 4; ++j) Llog[((fq & 1) * 4 + j) * 36 + col] = acc[nf][j] * rj[j] + Lcb[col]; } } }
            __builtin_amdgcn_wave_barrier();
            if (c.lane < 8) { const float* lg = Llog + c.lane * 36; const int rl = c.wid * 16 + half * 8 + c.lane;
                int gi = 0; float gm = lg[0];
#pragma unroll
                for (int g = 1; g < 4; ++g) { const float t = lg[g]; if (t > gm) { gm = t; gi = g; } }
                float den = 0.f;
#pragma unroll
                for (int g = 0; g < 4; ++g) den += expf(lg[g] - gm);
                const float gw = 1.0f / den;
                float e1 = -INFINITY, e2 = -INFINITY; int i1 = 0, i2 = 0;
#pragma unroll
                for (int j = 0; j < 8; ++j) { const float t = lg[4 + gi * 8 + j]; if (t > e1) { e2 = e1; i2 = i1; e1 = t; i1 = j; } else if (t > e2) { e2 = t; i2 = j; } }
                const float p2 = expf(e2 - e1), w1 = gw / (1.0f + p2), w2 = gw * p2 / (1.0f + p2);
                const int ea = gi * 8 + i1, eb = gi * 8 + i2; Le[rl * 2] = ea; Le[rl * 2 + 1] = eb; Lw[rl * 2] = w1; Lw[rl * 2 + 1] = w2;
                Lr[rl * 2] = atomicAdd(&Lcnt[ea], 1); Lr[rl * 2 + 1] = atomicAdd(&Lcnt[eb], 1); }
            __builtin_amdgcn_wave_barrier();
        }
#pragma unroll 8
        for (int ks = 0; ks < 32; ++ks) { const int k0 = 32 * ks + 8 * fq; const u32x4 xw = *(const u32x4*)(xr + 32 * ks); const f32x4 xa = {bflo(xw.x), bfhi(xw.x), bflo(xw.y), bfhi(xw.y)}, xb = {bflo(xw.z), bfhi(xw.z), bflo(xw.w), bfhi(xw.w)};
            const f32x4 ga = *(const f32x4*)(gn + k0) * (*(const f32x4*)(sc + k0) + 1.0f), gb = *(const f32x4*)(gn + k0 + 4) * (*(const f32x4*)(sc + k0 + 4) + 1.0f);
            const f32x4 ha4 = xa * rinv * ga + *(const f32x4*)(sh + k0), hb4 = xb * rinv * gb + *(const f32x4*)(sh + k0 + 4);
            u32x4 o; o.x = cvt_pk_bf16(ha4[0], ha4[1]); o.y = cvt_pk_bf16(ha4[2], ha4[3]); o.z = cvt_pk_bf16(hb4[0], hb4[1]); o.w = cvt_pk_bf16(hb4[2], hb4[3]);
            *(u32x4*)(ha + (size_t)(rowb + fr) * 1024 + k0) = o; }
        __syncthreads();
        if (c.tid < 32) Lbase[c.tid] = (int)__hip_atomic_fetch_add(&cnt[c.tid], (unsigned)Lcnt[c.tid], __ATOMIC_RELAXED, __HIP_MEMORY_SCOPE_AGENT);
        __syncthreads();
        if (c.tid < 256) { const int a = u * 256 + c.tid, e = Le[c.tid], dest = e * MOE_CAP + Lbase[e] + Lr[c.tid]; rowtok[dest] = a; roww[dest] = Lw[c.tid]; }
    }
    __syncthreads();
}
constexpr int LDS_MOETAB = 131072;
__device__ __forceinline__ void moe_tables(const Ctx& c_, int l) { const Ctx c = fresh(c_);
    int* tab = (int*)(c.lds + LDS_MOETAB); unsigned* cnt = (unsigned*)(c.ws + WS_CTL + CTL_CNT) + l * 32;
    __syncthreads();
    if (c.tid < 32) tab[c.tid] = (int)__hip_atomic_load(&cnt[c.tid], __ATOMIC_RELAXED, __HIP_MEMORY_SCOPE_AGENT);
    __syncthreads();
    if (c.tid == 0) { int acc = 0; for (int e = 0; e < 32; ++e) { tab[32 + e] = acc; acc += (tab[e] + 255) >> 8; } tab[64] = acc; }
    __syncthreads();
    if (c.tid < 32) for (int t2 = tab[32 + c.tid]; t2 < tab[33 + c.tid]; ++t2) tab[72 + t2] = c.tid;
    __syncthreads();
}
__device__ __forceinline__ void ph_final(const Ctx& c_) { const Ctx c = fresh(c_);
    float* out = c.a->out; const bf16_t* y1 = c.w<bf16_t>(WS_Y1);
    const bf16_t* xb = c.w<bf16_t>(WS_XB);
    for (size_t e = (size_t)c.blk * 512 + c.tid; e < (size_t)NTOK * 128; e += (size_t)c.G * 512) { const u32x4 y = *(const u32x4*)(y1 + e * 8), xw = *(const u32x4*)(xb + e * 8);
        *(f32x4*)(out + e * 8) = (f32x4){bflo(xw.x), bfhi(xw.x), bflo(xw.y), bfhi(xw.y)} + (f32x4){bflo(y.x), bfhi(y.x), bflo(y.y), bfhi(y.y)};
        *(f32x4*)(out + e * 8 + 4) = (f32x4){bflo(xw.z), bfhi(xw.z), bflo(xw.w), bfhi(xw.w)} + (f32x4){bflo(y.z), bfhi(y.z), bflo(y.w), bfhi(y.w)}; }
}

constexpr int PH_PER_LAYER = 8, N_PHASES = 2 + PH_PER_LAYER * NL + 1;
__global__ void __launch_bounds__(512, 2) mk_fwd(Args args) {
#ifdef EMU
    unsigned char* lds = emu_lds();
#else
    extern __shared__ __attribute__((aligned(16))) unsigned char lds[];
#endif
    Ctx c; c.a = &args; c.ws = args.ws; c.lds = lds; c.tid = threadIdx.x; c.wid = __builtin_amdgcn_readfirstlane(c.tid >> 6); c.lane = c.tid & 63; c.G = gridDim.x; c.blk = blockIdx.x;
    if (c.tid == 0) *(uint4*)(lds + LDS_XB) = make_uint4(0u, 0u, 0u, 0u);
    __syncthreads();
    XcdBarrier bar; bar.bar = (unsigned*)(args.ws + WS_CTL); bar.x = 0; bar.st = (volatile LAS unsigned*)(lds + LDS_XB);
    if (args.ph_hi - args.ph_lo > 1) bar = xcd_barrier_post((unsigned*)(args.ws + WS_CTL), (volatile LAS unsigned*)(lds + LDS_XB));
    int ph = 0;
#ifndef PHMASK
#define PHMASK 0xFFFFF
#endif
#define PHASE(K, ...) do { if (ph >= args.ph_lo && ph < args.ph_hi) { if constexpr ((PHMASK >> K) & 1) { __VA_ARGS__; } if (ph + 1 < args.ph_hi) xcd_barrier(bar); } ++ph; } while (0)
    PHASE(0, ph_prologue0(c));
    PHASE(1, ph_prologue1(c));
    for (int l = 0; l < NL; ++l) {
        PHASE(2, if (l == 0) ph_cvt(c, 0); ph_normrows(c, l));
        PHASE(3, { pg8::Gemm g{c.w<bf16_t>(WS_HA), c.w<bf16_t>(WS_WIN + (size_t)(l & 1) * WSET), NTOK, ZP, 1024}; pg8::TailNarrowOrder S; S.init(NTOK, c.G, c.blk); pg8::EpiBf16 E{c.w<bf16_t>(WS_Z), ZP};
                pg8::gemm_phase<pg8::EpiBf16, pg8::TailNarrowOrder, true, true>((LAS unsigned char*)lds, g, S, E); });
        PHASE(4, ph_mixers(c, l));
        PHASE(5, ph_attn(c, l));
        PHASE(6, { pg8::Gemm g{c.w<bf16_t>(WS_YB), c.w<bf16_t>(WS_WOUT + (size_t)(l & 1) * WSET), NTOK, 1024, 1024}; pg8::StaticOrder S; S.init(NTOK, 1024, c.G, c.blk);
                pg8::EpiResid E{(l == 0) ? c.inf(I_X) : (const float*)nullptr, c.w<bf16_t>(WS_XB), c.w<bf16_t>(WS_XB), c.w<float>(WS_MOD) + (size_t)l * NB * 6144 + 2048, 6144, SEQ, c.w<bf16_t>(WS_Y1)};
                pg8::gemm_phase<pg8::EpiResid, pg8::StaticOrder, true, true>((LAS unsigned char*)lds, g, S, E); });
        PHASE(7, ph_router(c, l));
        PHASE(9, { pg8::Gemm g{c.w<bf16_t>(WS_HA), c.w<bf16_t>(WS_WUP + (size_t)(l & 1) * WSET), NR, 32 * 1024, 1024}; moe_tables(c, l); pg8::MoeOrder S{(const LAS int*)((LAS unsigned char*)lds + LDS_MOETAB), MOE_CAP, c.G, c.blk}; pg8::EpiSwiglu E{c.w<bf16_t>(WS_Q)};
                pg8::gemm_phase<pg8::EpiSwiglu, pg8::MoeOrder, true, true, true>((LAS unsigned char*)lds, g, S, E, c.w<int>(WS_ROWTOK)); });
        PHASE(10, { pg8::Gemm g{c.w<bf16_t>(WS_Q), c.w<bf16_t>(WS_WDN + (size_t)(l & 1) * WSET), NR, 32 * 1024, 512}; if (MK_SPLIT) moe_tables(c, l);        pg8::MoeOrder S{(const LAS int*)((LAS unsigned char*)lds + LDS_MOETAB), MOE_CAP, c.G, c.blk};
                pg8::EpiDown E{c.w<int>(WS_ROWTOK), c.w<float>(WS_ROWW), c.w<bf16_t>(WS_XB), c.w<bf16_t>(WS_Y1), c.w<float>(WS_MOD) + (size_t)l * NB * 6144 + 5120, 6144, SEQ};
                pg8::gemm_phase<pg8::EpiDown, pg8::MoeOrder, true, true>((LAS unsigned char*)lds, g, S, E); });
    }
    PHASE(11, ph_final(c));
#undef PHASE
}

extern "C" void kernel_launch(void* const* d_in, const int* in_sizes, int n_in, void* d_out, int out_size, void* d_ws, size_t ws_size, hipStream_t stream) {
    static int grid = 0;
    if (grid == 0) {
        if (n_in != 30 || out_size != NTOK * 1024 || ws_size < WS_END) { fprintf(stderr, "kernel_launch: shape/workspace mismatch (n_in %d out %d ws %zu need %zu)\n", n_in, out_size, ws_size, (size_t)WS_END); grid = -1; return; }
        int dev = 0, cus = 0;
        if (hipGetDevice(&dev) != hipSuccess || hipDeviceGetAttribute(&cus, hipDeviceAttributeMultiprocessorCount, dev) != hipSuccess) { grid = -1; return; }
        if (hipFuncSetAttribute((const void*)mk_fwd, hipFuncAttributeMaxDynamicSharedMemorySize, LDS_BYTES) != hipSuccess) { fprintf(stderr, "kernel_launch: hipFuncSetAttribute failed\n"); grid = -1; return; }
        int per_cu = 0; (void)hipOccupancyMaxActiveBlocksPerMultiprocessor(&per_cu, (const void*)mk_fwd, 512, LDS_BYTES);
        if (per_cu < 1) fprintf(stderr, "kernel_launch: occupancy query says %d blocks per CU\n", per_cu);
        grid = cus;
    }
    if (grid < 0) return;
    (void)hipMemsetAsync((char*)d_ws + WS_CTL, 0, CTL_BYTES, stream);
    Args a{};
    for (int i = 0; i < 30; ++i) a.in[i] = d_in[i];
    a.out = (float*)d_out; a.ws = (unsigned char*)d_ws;
#if MK_SPLIT
    for (int p = 0; p < N_PHASES; ++p) { a.ph_lo = p; a.ph_hi = p + 1;
#else
    { a.ph_lo = 0; a.ph_hi = N_PHASES;
#endif
#ifdef EMU
        EMU_LAUNCH(mk_fwd, grid, 512, LDS_BYTES, stream, a);
#else
        hipLaunchKernelGGL(mk_fwd, dim3(grid), dim3(512), LDS_BYTES, stream, a);
#endif
    }
}
```

```cpp
#include <hip/hip_runtime.h>
#include <cstdio>
#include <cstdint>
#include <type_traits>

#ifndef CFG_B
#define CFG_B 4
#endif
#ifndef CFG_S
#define CFG_S 8192
#endif
#ifndef CFG_L
#define CFG_L 4
#endif
#ifndef MK_SPLIT
#define MK_SPLIT 0
#endif

#ifdef EMU
#define ASMV(...) ((void)0)
#define LAS
#define LAUNDER_V(x) ((void)0)
#define LAUNDER_S(x) ((void)0)
#else
#define ASMV(...) asm volatile(__VA_ARGS__)
#define LAS __attribute__((address_space(3)))
#define LAUNDER_V(x) asm volatile("" : "+v"(x))
#define LAUNDER_S(x) asm volatile("" : "+s"(x))
#endif

typedef unsigned short bf16_t;
typedef short bf16x8 __attribute__((ext_vector_type(8)));
typedef short s16x4 __attribute__((ext_vector_type(4)));
typedef float f32x2 __attribute__((ext_vector_type(2)));
typedef float f32x4 __attribute__((ext_vector_type(4)));
typedef float f32x16 __attribute__((ext_vector_type(16)));
typedef unsigned u32x4 __attribute__((ext_vector_type(4)));
typedef unsigned u32x2 __attribute__((ext_vector_type(2)));

__device__ __forceinline__ float bf2f(bf16_t h) { return __builtin_bit_cast(float, (unsigned)h << 16); }
__device__ __forceinline__ float bflo(unsigned w) { return __builtin_bit_cast(float, w << 16); }
__device__ __forceinline__ float bfhi(unsigned w) { return __builtin_bit_cast(float, w & 0xffff0000u); }
__device__ __forceinline__ unsigned f2bf_bits(float f) { unsigned u = __builtin_bit_cast(unsigned, f); u += 0x7fffu + ((u >> 16) & 1u); return u >> 16; }
#ifdef EMU
__device__ __forceinline__ unsigned cvt_pk_bf16(float lo, float hi) { return f2bf_bits(lo) | (f2bf_bits(hi) << 16); }
__device__ __forceinline__ unsigned cvt_pk_bf16_pinned(float lo, float hi) { return f2bf_bits(lo) | (f2bf_bits(hi) << 16); }
#else
typedef __bf16 bf16v2_t __attribute__((ext_vector_type(2)));
typedef float f32v2_t __attribute__((ext_vector_type(2)));
__device__ __forceinline__ unsigned cvt_pk_bf16(float lo, float hi) { const bf16v2_t r = __builtin_convertvector((f32v2_t){lo, hi}, bf16v2_t); return __builtin_bit_cast(unsigned, r); }
__device__ __forceinline__ unsigned cvt_pk_bf16_pinned(float lo, float hi) { unsigned r; asm volatile("v_cvt_pk_bf16_f32 %0, %1, %2\n\ts_nop 1" : "=v"(r) : "v"(lo), "v"(hi)); return r; }
#endif
__device__ __forceinline__ float fast_exp(float x) { return __builtin_amdgcn_exp2f(x * 1.44269504089f); }
__device__ __forceinline__ float fsigmoid(float x) { return __builtin_amdgcn_rcpf(1.0f + fast_exp(-x)); }
__device__ __forceinline__ float fsilu(float x) { return x * fsigmoid(x); }
__device__ __forceinline__ float frsqrt(float x) { return __builtin_amdgcn_rsqf(x); }
#ifdef EMU
__device__ __forceinline__ float wave_sum(float v) {
#pragma unroll
    for (int m = 32; m >= 1; m >>= 1) v += __shfl_xor(v, m);
    return v;
}
#else
template <int CTRL, int ROW_MASK> __device__ __forceinline__ float dpp_t(float v) { return __builtin_bit_cast(float, __builtin_amdgcn_update_dpp(0, __builtin_bit_cast(int, v), CTRL, ROW_MASK, 0xF, false)); }
#define dpp_f(v, ctrl, rm) dpp_t<ctrl, rm>(v)
__device__ __forceinline__ float wave_sum(float v) {
    v += dpp_f(v, 0xB1, 0xF);
    v += dpp_f(v, 0x4E, 0xF);
    v += dpp_f(v, 0x141, 0xF);
    v += dpp_f(v, 0x140, 0xF);
    v += dpp_f(v, 0x142, 0xA);
    v += dpp_f(v, 0x143, 0xC);
    return __builtin_bit_cast(float, __builtin_amdgcn_readlane(__builtin_bit_cast(int, v), 63));
}
__device__ __forceinline__ float half_sum(float v, int hi) {
    v += dpp_f(v, 0xB1, 0xF); v += dpp_f(v, 0x4E, 0xF); v += dpp_f(v, 0x141, 0xF); v += dpp_f(v, 0x140, 0xF);
    v += dpp_f(v, 0x142, 0xA);
    const float a = __builtin_bit_cast(float, __builtin_amdgcn_readlane(__builtin_bit_cast(int, v), 31)), b = __builtin_bit_cast(float, __builtin_amdgcn_readlane(__builtin_bit_cast(int, v), 63));
    return hi ? b : a;
}
#endif
#ifdef EMU
__device__ __forceinline__ float half_sum(float v, int) {
#pragma unroll
    for (int m = 1; m < 32; m <<= 1) v += __shfl_xor(v, m);
    return v;
}
#endif

namespace pg8 {
#define PG8_LAS LAS
constexpr int BM = 256, BK = 64, HALF = 128, HTB = HALF * BK * 2  , STAGE_BYTES = 8 * HTB, NXCD = 8, WGM = 8;

__host__ __device__ __forceinline__ int lds_byte(int r, int c) { const int st = (r >> 4) * 2 + (c >> 5), rr = r & 15, cc = c & 31, ob = rr * 64 + cc * 2; return st * 1024 + (ob ^ (((ob >> 9) & 1) << 5)); }
__host__ __device__ __forceinline__ void stage_rc(int b, int& R, int& C) { const int st = b / 1024, sb = b % 1024, swz = sb ^ (((sb >> 9) & 1) << 5); R = (st >> 1) * 16 + swz / 64; C = (st & 1) * 32 + (swz % 64) / 2; }
__host__ __device__ __forceinline__ int perm32(int rho) { const int n = rho >> 4, i = rho & 15; return 8 * (i >> 2) + 4 * n + (i & 3); }

struct Unit { int pm, pn, narrow, rbase, nvalid; };
struct Gemm { const bf16_t* A; const bf16_t* Bt; int M, N, K; };

struct StaticOrder {
    static constexpr bool HAS_NARROW = false;
    int nM, nN, nwg, G, c;
    __host__ __device__ void init(int M, int N, int G_, int c_) { nM = M / BM; nN = N / BM; nwg = nM * nN; G = G_; c = c_; }
    __host__ __device__ bool next(int i, Unit& u) const {
        const long L = (long)i * G + c; if (L >= nwg) return false;
        int wgid = (int)L; { const int q = nwg / NXCD, r = nwg % NXCD, xcd = wgid % NXCD, off = wgid / NXCD; wgid = (xcd < r ? xcd * (q + 1) : r * (q + 1) + (xcd - r) * q) + off; }
        const int nig = WGM * nN, gid = wgid / nig, fm = gid * WGM, gsz = (nM - fm) < WGM ? (nM - fm) : WGM;
        u.pm = fm + ((wgid % nig) % gsz); u.pn = (wgid % nig) / gsz; return true;
    }
    __device__ __forceinline__ void a_ready(const Unit&) const {}
    __device__ __forceinline__ void done(const Unit&) const {}
};
struct TailNarrowOrder {
    static constexpr bool HAS_NARROW = true;
    StaticOrder full; int nM, G, c;
    __host__ __device__ void init(int M, int G_, int c_) { nM = M / BM; G = G_; c = c_; full.init(M, 8 * BM, G_, c_); }
    __host__ __device__ bool next(int i, Unit& u) const { const long L = (long)i * G + c;
        if (L < full.nwg) { const bool ok = full.next(i, u); u.narrow = 0; return ok; }
        if (L >= full.nwg + nM) return false;
        u.pm = (int)(L - full.nwg); u.pn = 8; u.narrow = 1; return true; }
    __device__ __forceinline__ void a_ready(const Unit&) const {}
    __device__ __forceinline__ void done(const Unit&) const {}
};
template <class Epi, class Sched, bool ALIGN_EPI = false, bool SP2 = false, bool GATHER = false>
__device__ __forceinline__ void gemm_phase(PG8_LAS unsigned char* lds, const Gemm g, const Sched& S, const Epi& E, const int* rowmap = nullptr) {
    int tid = threadIdx.x; LAUNDER_V(tid); const int wid = __builtin_amdgcn_readfirstlane(tid >> 6), lane = tid & 63, wr = wid >> 2, wc = wid & 3, fr = lane & 15, fq = lane >> 4;
    const int K = g.K, nt = K / BK;
    unsigned voffA[2], voffB[2]; int RA[2], CA[2];
#pragma unroll
    for (int i = 0; i < 2; ++i) { int R, C; stage_rc(tid * 16 + i * 8192, R, C); const int Rb = Epi::PERM ? ((R & ~31) + perm32(R & 31)) : R;
        voffA[i] = (unsigned)(R * K + C) * 2u; voffB[i] = (unsigned)(Rb * K + C) * 2u; RA[i] = R; CA[i] = C; }
    const size_t kstep = (size_t)(BK * 2);
    const size_t hstep = (size_t)HALF * K * 2;
    const size_t tstep = 2 * hstep;
    const size_t hA = GATHER ? (size_t)0 : hstep;
    unsigned vA0[2], vA1[2], nA0[2], nA1[2];
    auto rows_of = [&](const Unit& u, unsigned (&o0)[2], unsigned (&o1)[2]) {
#pragma unroll
        for (int i = 0; i < 2; ++i) { if constexpr (GATHER) { int t0 = (RA[i] < u.nvalid) ? rowmap[u.rbase + RA[i]] : -1, t1 = (HALF + RA[i] < u.nvalid) ? rowmap[u.rbase + HALF + RA[i]] : -1; t0 = t0 < 0 ? 0 : (t0 >> 1); t1 = t1 < 0 ? 0 : (t1 >> 1);
                o0[i] = (unsigned)(t0 * K + CA[i]) * 2u; o1[i] = (unsigned)(t1 * K + CA[i]) * 2u; } else { o0[i] = voffA[i]; o1[i] = voffA[i]; } } };
    const unsigned ldsw = (unsigned)wid * 1024u;
    const int aoff = lds_byte(wr * 64 + fr, fq * 8), boff = lds_byte(wc * 32 + fr, fq * 8);
#define PG8_SA(b, h) (((b) * 2 + (h)) * HTB)
#define PG8_SB(b, h) ((4 + (b) * 2 + (h)) * HTB)
#define PG8_STAGE(bufoff, gbase, voff) do { _Pragma("unroll") for (int _i = 0; _i < 2; ++_i) \
        __builtin_amdgcn_global_load_lds((const unsigned*)((const char*)(gbase) + (voff)[_i]), (PG8_LAS unsigned*)(lds + (bufoff) + ldsw + _i * 8192), 16, 0, 0); } while (0)
#define PG8_LDA(dst, b, h) do { _Pragma("unroll") for (int m = 0; m < 4; ++m) _Pragma("unroll") for (int k = 0; k < 2; ++k) dst[m][k] = *(const PG8_LAS bf16x8*)(lds + PG8_SA(b, h) + aoff + m * 2048 + k * 1024); } while (0)
#define PG8_LDB(dst, b, h) do { _Pragma("unroll") for (int n = 0; n < 2; ++n) _Pragma("unroll") for (int k = 0; k < 2; ++k) dst[n][k] = *(const PG8_LAS bf16x8*)(lds + PG8_SB(b, h) + boff + n * 2048 + k * 1024); } while (0)
#define PG8_MMA(ai, bj, At, Bt) do { __builtin_amdgcn_s_setprio(1); _Pragma("unroll") for (int m = 0; m < 4; ++m) _Pragma("unroll") for (int n = 0; n < 2; ++n) _Pragma("unroll") for (int k = 0; k < 2; ++k) \
        acc[ai][bj][m][n] = __builtin_amdgcn_mfma_f32_16x16x32_bf16(Bt[n][k], At[m][k], acc[ai][bj][m][n], 0, 0, 0); __builtin_amdgcn_s_setprio(0); } while (0)
#define PG8_WAIT_V(n) ASMV("s_waitcnt vmcnt(" #n ")" ::: "memory")
#define PG8_WAIT_L(n) ASMV("s_waitcnt lgkmcnt(" #n ")" ::: "memory")
#define PG8_BAR __builtin_amdgcn_s_barrier()
#define PG8_SCHED __builtin_amdgcn_sched_barrier(0)
    Unit cur, nxt; int ui = 0;
    if (!S.next(0, cur)) return;
    f32x4 acc[2][2][4][2];
#pragma unroll
    for (int a = 0; a < 2; ++a)
#pragma unroll
        for (int b = 0; b < 2; ++b)
#pragma unroll
            for (int m = 0; m < 4; ++m)
#pragma unroll
                for (int n = 0; n < 2; ++n) acc[a][b][m][n] = (f32x4){0.f, 0.f, 0.f, 0.f};
    bf16x8 At[4][2], B0[2][2], B1[2][2];
    const char* cA = GATHER ? (const char*)g.A : (const char*)g.A + (size_t)cur.pm * tstep; rows_of(cur, vA0, vA1); const char* cB = (const char*)g.Bt + (size_t)cur.pn * tstep;
    typename Epi::Pre pre; E.prefetch(pre, cur, wr, fr);
    S.a_ready(cur);
    if constexpr (SP2) {
        PG8_STAGE(PG8_SB(0, 0), cB, voffB); PG8_STAGE(PG8_SB(0, 1), cB + hstep, voffB); PG8_STAGE(PG8_SA(0, 0), cA, vA0); PG8_STAGE(PG8_SA(0, 1), cA + hA, vA1);
        if (wr == 1) PG8_BAR;
        PG8_WAIT_V(2); PG8_BAR;
        PG8_STAGE(PG8_SB(1, 0), cB + kstep, voffB); PG8_STAGE(PG8_SA(1, 0), cA + kstep, vA0); PG8_STAGE(PG8_SB(1, 1), cB + hstep + kstep, voffB);
        PG8_WAIT_V(6); PG8_BAR;
    } else {
        PG8_STAGE(PG8_SB(0, 0), cB, voffB); PG8_STAGE(PG8_SA(0, 0), cA, vA0); PG8_STAGE(PG8_SB(0, 1), cB + hstep, voffB); PG8_STAGE(PG8_SA(0, 1), cA + hA, vA1);
        if (wr == 1) PG8_BAR;
        PG8_WAIT_V(4); PG8_BAR;
        PG8_STAGE(PG8_SB(1, 0), cB + kstep, voffB); PG8_STAGE(PG8_SA(1, 0), cA + kstep, vA0); PG8_STAGE(PG8_SB(1, 1), cB + hstep + kstep, voffB);
        PG8_WAIT_V(6); PG8_BAR;
    }
    for (;;) {
        const bool has_next = S.next(ui + 1, nxt);
        const char* nA = GATHER ? (const char*)g.A : (has_next ? (const char*)g.A + (size_t)nxt.pm * tstep : cA);
        if (has_next) rows_of(nxt, nA0, nA1); else { nA0[0] = vA0[0]; nA0[1] = vA0[1]; nA1[0] = vA1[0]; nA1[1] = vA1[1]; } const char* nB = has_next ? (const char*)g.Bt + (size_t)nxt.pn * tstep : cB;
        for (int t = 0; t < nt; t += 2) {
            const bool last = (t == nt - 2);
            unsigned sA0[2], sA1[2];
#pragma unroll
            for (int i = 0; i < 2; ++i) { sA0[i] = last ? nA0[i] : vA0[i]; sA1[i] = last ? nA1[i] : vA1[i]; }
            const char* a1 = cA + (size_t)(t + 1) * kstep;
            const char* a2 = last ? nA : cA + (size_t)(t + 2) * kstep; const char* b2 = last ? nB : cB + (size_t)(t + 2) * kstep;
            const char* a3 = a2 + kstep; const char* b3 = b2 + kstep;
            if (last && has_next) S.a_ready(nxt);
            if constexpr (SP2) {
            PG8_LDB(B0, 0, 0); PG8_LDB(B1, 0, 1); PG8_SCHED; PG8_LDA(At, 0, 0); PG8_STAGE(PG8_SA(1, 1), a1 + hA, vA1);
            PG8_WAIT_V(8); PG8_WAIT_L(0); PG8_BAR; PG8_MMA(0, 0, At, B0); if (!Sched::HAS_NARROW || !cur.narrow) PG8_MMA(0, 1, At, B1); PG8_BAR; PG8_SCHED;
            PG8_LDA(At, 0, 1); PG8_STAGE(PG8_SB(0, 0), b2, voffB); PG8_STAGE(PG8_SB(0, 1), b2 + hstep, voffB); PG8_STAGE(PG8_SA(0, 0), a2, sA0);
            PG8_WAIT_V(8); PG8_WAIT_L(0); PG8_BAR; PG8_MMA(1, 0, At, B0); if (!Sched::HAS_NARROW || !cur.narrow) PG8_MMA(1, 1, At, B1); PG8_BAR; PG8_SCHED;
            PG8_LDB(B0, 1, 0); PG8_LDB(B1, 1, 1); PG8_SCHED; PG8_LDA(At, 1, 0); PG8_STAGE(PG8_SA(0, 1), a2 + hA, sA1);
            PG8_WAIT_V(8); PG8_WAIT_L(0); PG8_BAR; PG8_MMA(0, 0, At, B0); if (!Sched::HAS_NARROW || !cur.narrow) PG8_MMA(0, 1, At, B1); PG8_BAR; PG8_SCHED;
            PG8_LDA(At, 1, 1); PG8_STAGE(PG8_SB(1, 0), b3, voffB); PG8_STAGE(PG8_SB(1, 1), b3 + hstep, voffB); PG8_STAGE(PG8_SA(1, 0), a3, sA0);
            PG8_WAIT_V(8); PG8_WAIT_L(0); PG8_BAR; PG8_MMA(1, 0, At, B0); if (!Sched::HAS_NARROW || !cur.narrow) PG8_MMA(1, 1, At, B1); PG8_BAR; PG8_SCHED;
            } else {
            PG8_LDB(B0, 0, 0); PG8_SCHED; PG8_LDA(At, 0, 0); PG8_STAGE(PG8_SA(1, 1), a1 + hA, vA1);
            PG8_WAIT_L(8); PG8_BAR; PG8_WAIT_L(0); PG8_MMA(0, 0, At, B0); PG8_BAR; PG8_SCHED;
            PG8_LDB(B1, 0, 1); PG8_STAGE(PG8_SB(0, 0), b2, voffB);
            PG8_BAR; PG8_WAIT_L(0); if (!Sched::HAS_NARROW || !cur.narrow) PG8_MMA(0, 1, At, B1); PG8_BAR;
            PG8_LDA(At, 0, 1); PG8_STAGE(PG8_SA(0, 0), a2, sA0);
            PG8_BAR; PG8_WAIT_L(0); PG8_MMA(1, 0, At, B0); PG8_BAR; PG8_SCHED;
            PG8_STAGE(PG8_SB(0, 1), b2 + hstep, voffB);
            PG8_WAIT_V(6); PG8_BAR; if (!Sched::HAS_NARROW || !cur.narrow) PG8_MMA(1, 1, At, B1); PG8_BAR;
            PG8_LDB(B0, 1, 0); PG8_SCHED; PG8_LDA(At, 1, 0); PG8_STAGE(PG8_SA(0, 1), a2 + hA, sA1);
            PG8_WAIT_L(8); PG8_BAR; PG8_WAIT_L(0); PG8_MMA(0, 0, At, B0); PG8_BAR; PG8_SCHED;
            PG8_LDB(B1, 1, 1); PG8_STAGE(PG8_SB(1, 0), b3, voffB);
            PG8_BAR; PG8_WAIT_L(0); if (!Sched::HAS_NARROW || !cur.narrow) PG8_MMA(0, 1, At, B1); PG8_BAR;
            PG8_LDA(At, 1, 1); PG8_STAGE(PG8_SA(1, 0), a3, sA0);
            PG8_BAR; PG8_WAIT_L(0); PG8_MMA(1, 0, At, B0); PG8_BAR; PG8_SCHED;
            PG8_STAGE(PG8_SB(1, 1), b3 + hstep, voffB);
            PG8_WAIT_V(6); PG8_BAR; if (!Sched::HAS_NARROW || !cur.narrow) PG8_MMA(1, 1, At, B1); PG8_BAR;
            }
        }
        if constexpr (ALIGN_EPI) { if (wr == 0) PG8_BAR; }
        if constexpr (!Epi::AFTER_DRAIN) { E(acc, cur, wr, wc, fr, fq, pre); S.done(cur); }
        if (!has_next) break;
#pragma unroll
        for (int a = 0; a < 2; ++a)
#pragma unroll
            for (int b = 0; b < 2; ++b)
#pragma unroll
                for (int m = 0; m < 4; ++m)
#pragma unroll
                    for (int n = 0; n < 2; ++n) acc[a][b][m][n] = (f32x4){0.f, 0.f, 0.f, 0.f};
        cur = nxt; cA = nA; cB = nB; ++ui; vA0[0] = nA0[0]; vA0[1] = nA0[1]; vA1[0] = nA1[0]; vA1[1] = nA1[1];
        E.prefetch(pre, cur, wr, fr);
        if constexpr (ALIGN_EPI) { if (wr == 1) PG8_BAR; }
    }
    PG8_WAIT_V(0);
    if constexpr (!ALIGN_EPI) { if (wr == 0) PG8_BAR; }
    PG8_BAR;
    if constexpr (Epi::AFTER_DRAIN) { E.fused(acc, cur, wr, wc, fr, fq, lds, wid, lane); S.done(cur); }
#undef PG8_SA
#undef PG8_SB
#undef PG8_STAGE
#undef PG8_LDA
#undef PG8_LDB
#undef PG8_MMA
#undef PG8_WAIT_V
#undef PG8_WAIT_L
#undef PG8_BAR
#undef PG8_SCHED
}

struct EpiBf16 {
    static constexpr bool PERM = true, AFTER_DRAIN = false;
    bf16_t* O; int ldc;
    struct Pre {}; __device__ __forceinline__ void prefetch(Pre&, const Unit&, int, int) const {}
    __device__ __forceinline__ void operator()(const f32x4 (&acc)[2][2][4][2], const Unit& u, int wr, int wc, int fr, int fq, const Pre&) const {
        const int row0 = u.pm * BM + wr * 64 + fr, col0 = u.pn * BM + wc * 32 + 8 * fq;
#pragma unroll
        for (int ai = 0; ai < 2; ++ai)
#pragma unroll
            for (int m = 0; m < 4; ++m) { bf16_t* rowp = O + (size_t)(row0 + ai * HALF + m * 16) * ldc + col0;
#pragma unroll
                for (int bj = 0; bj < 2; ++bj) { const f32x4 v0 = acc[ai][bj][m][0], v1 = acc[ai][bj][m][1];
                    u32x4 w; w.x = cvt_pk_bf16(v0[0], v0[1]); w.y = cvt_pk_bf16(v0[2], v0[3]); w.z = cvt_pk_bf16(v1[0], v1[1]); w.w = cvt_pk_bf16(v1[2], v1[3]);
                    *(u32x4*)(rowp + bj * HALF) = w; } }
    }
};
struct EpiResid {
    static constexpr bool PERM = true, AFTER_DRAIN = false;
    const float* xin; const bf16_t* xinb; bf16_t* xout; const float* gate; int gstride; int seq; const bf16_t* y1;
    struct Pre {}; __device__ __forceinline__ void prefetch(Pre&, const Unit&, int, int) const {}
    __device__ __forceinline__ void operator()(const f32x4 (&acc)[2][2][4][2], const Unit& u, int wr, int wc, int fr, int fq, const Pre&) const {
        const int row0 = u.pm * BM + wr * 64 + fr, col0 = u.pn * BM + wc * 32 + 8 * fq;
#pragma unroll
        for (int ai = 0; ai < 2; ++ai)
#pragma unroll
            for (int m = 0; m < 4; ++m) { const int row = row0 + ai * HALF + m * 16; const float* gp = gate + (size_t)(row / seq) * gstride;
#pragma unroll
                for (int bj = 0; bj < 2; ++bj) { const int c = col0 + bj * HALF; const size_t o = (size_t)row * 1024 + c;
                    const f32x4 g0 = *(const f32x4*)(gp + c), g1 = *(const f32x4*)(gp + c + 4);
                    f32x4 x0, x1;
                    if (xin) { x0 = *(const f32x4*)(xin + o); x1 = *(const f32x4*)(xin + o + 4); }
                    else { const u32x4 xw = *(const u32x4*)(xinb + o), y = *(const u32x4*)(y1 + o);
                        x0 = (f32x4){bflo(xw.x), bfhi(xw.x), bflo(xw.y), bfhi(xw.y)} + (f32x4){bflo(y.x), bfhi(y.x), bflo(y.y), bfhi(y.y)};
                        x1 = (f32x4){bflo(xw.z), bfhi(xw.z), bflo(xw.w), bfhi(xw.w)} + (f32x4){bflo(y.z), bfhi(y.z), bflo(y.w), bfhi(y.w)}; }
                    x0 += g0 * acc[ai][bj][m][0]; x1 += g1 * acc[ai][bj][m][1];
                    u32x4 w; w.x = cvt_pk_bf16(x0[0], x0[1]); w.y = cvt_pk_bf16(x0[2], x0[3]); w.z = cvt_pk_bf16(x1[0], x1[1]); w.w = cvt_pk_bf16(x1[2], x1[3]);
                    *(u32x4*)(xout + o) = w; } }
    }
};
struct EpiSwiglu {
    static constexpr bool PERM = true, AFTER_DRAIN = false;
    bf16_t* HB;
    struct Pre {}; __device__ __forceinline__ void prefetch(Pre&, const Unit&, int, int) const {}
    __device__ __forceinline__ void operator()(const f32x4 (&acc)[2][2][4][2], const Unit& u, int wr, int wc, int fr, int fq, const Pre&) const {
        const int row0 = u.pm * BM + wr * 64 + fr, col0 = (u.pn & 3) * 128 + wc * 32 + 8 * fq;
#pragma unroll
        for (int ai = 0; ai < 2; ++ai)
#pragma unroll
            for (int m = 0; m < 4; ++m) { bf16_t* p = HB + (size_t)(row0 + ai * HALF + m * 16) * 512 + col0;
                float h[8];
#pragma unroll
                for (int n = 0; n < 2; ++n)
#pragma unroll
                    for (int k = 0; k < 4; ++k) h[n * 4 + k] = fsilu(acc[ai][0][m][n][k]) * acc[ai][1][m][n][k];
                u32x4 w; w.x = cvt_pk_bf16(h[0], h[1]); w.y = cvt_pk_bf16(h[2], h[3]); w.z = cvt_pk_bf16(h[4], h[5]); w.w = cvt_pk_bf16(h[6], h[7]);
                *(u32x4*)p = w; }
    }
};
struct EpiDown {
    static constexpr bool PERM = true, AFTER_DRAIN = false;
    const int* row_tok; const float* row_w; bf16_t* x; bf16_t* y1; const float* gate; int gstride; int seq;
    struct Pre { int ts[8]; };
    __device__ __forceinline__ void prefetch(Pre& p, const Unit& u, int wr, int fr) const {
#pragma unroll
        for (int ai = 0; ai < 2; ++ai)
#pragma unroll
            for (int m = 0; m < 4; ++m) { const int lr = wr * 64 + fr + ai * HALF + m * 16; p.ts[ai * 4 + m] = (lr < u.nvalid) ? row_tok[u.rbase + lr] : -1; } }
    __device__ __forceinline__ void operator()(const f32x4 (&acc)[2][2][4][2], const Unit& u, int wr, int wc, int fr, int fq, const Pre& pre) const {
        const int col0 = (u.pn & 3) * BM + wc * 32 + 8 * fq;
#pragma unroll
        for (int ai = 0; ai < 2; ++ai)
#pragma unroll
            for (int m = 0; m < 4; ++m) { const int ts = pre.ts[ai * 4 + m];
                if (ts >= 0) { const int tok = ts >> 1; const float w = row_w[u.rbase + wr * 64 + fr + ai * HALF + m * 16]; const float* gp = gate + (size_t)(tok / seq) * gstride;
#pragma unroll
                    for (int bj = 0; bj < 2; ++bj) { const int c = col0 + bj * HALF; const size_t o = (size_t)tok * 1024 + c;
                        const f32x4 v0 = acc[ai][bj][m][0] * (*(const f32x4*)(gp + c)) * w, v1 = acc[ai][bj][m][1] * (*(const f32x4*)(gp + c + 4)) * w;
                        if (ts & 1) { u32x4 q; q.x = cvt_pk_bf16(v0[0], v0[1]); q.y = cvt_pk_bf16(v0[2], v0[3]); q.z = cvt_pk_bf16(v1[0], v1[1]); q.w = cvt_pk_bf16(v1[2], v1[3]); *(u32x4*)(y1 + o) = q; }
                        else { const u32x4 xw = *(const u32x4*)(x + o); const f32x4 s0 = (f32x4){bflo(xw.x), bfhi(xw.x), bflo(xw.y), bfhi(xw.y)} + v0, s1 = (f32x4){bflo(xw.z), bfhi(xw.z), bflo(xw.w), bfhi(xw.w)} + v1;
                            u32x4 q; q.x = cvt_pk_bf16(s0[0], s0[1]); q.y = cvt_pk_bf16(s0[2], s0[3]); q.z = cvt_pk_bf16(s1[0], s1[1]); q.w = cvt_pk_bf16(s1[2], s1[3]); *(u32x4*)(x + o) = q; } } } }
    }
};
struct MoeOrder {
    static constexpr bool HAS_NARROW = false;
    const PG8_LAS int* tab; int cap, G, c;
    __device__ __forceinline__ bool next(int i, Unit& u) const { const int v = ((G & 7) == 0) ? (c & 7) * (G >> 3) + (c >> 3) : c; const int L = i * G + v, nt = tab[64]; if (L >= nt * 4) return false;
        const int pm = L >> 2, e = tab[72 + pm], j = pm - tab[32 + e], nv = tab[e] - j * BM; u.pm = pm; u.pn = e * 4 + (L & 3); u.rbase = e * cap + j * BM; u.nvalid = nv > BM ? BM : nv; return true; }
    __device__ __forceinline__ void a_ready(const Unit&) const {}
    __device__ __forceinline__ void done(const Unit&) const {}
};
}

constexpr int NB = CFG_B, SEQ = CFG_S, NL = CFG_L, NTOK = NB * SEQ, DM = 1024, ZP = 2304;
constexpr int NBH = NB * 4, NCH = SEQ / 128, NQT = SEQ / 256;
constexpr int NR = 2 * NTOK + 32 * 256;
constexpr int Z_CQ = 0, Z_CKV = 192, Z_KR = 320, Z_POOL = 352, Z_HQ = 608, Z_HF = 864, Z_HI = 1120, Z_HG = 1376, Z_CA = 1632, Z_CG = 1888;
constexpr float EPS = 1e-6f;
static_assert(SEQ % 256 == 0 && NTOK % 256 == 0 && (NQT % 2) == 0, "shape");
constexpr size_t al256(size_t x) { return (x + 255) & ~(size_t)255; }
constexpr size_t cmax(size_t a, size_t b) { return a > b ? a : b; }
constexpr size_t WS_CTL = 0, CTL_BYTES = 65536;
constexpr size_t CTL_CNT = 16384;
constexpr size_t CTL_HG = 32768;
constexpr size_t WS_MODP = WS_CTL + CTL_BYTES;
constexpr size_t WS_MOD = WS_MODP + al256((size_t)16 * NL * NB * 6144 * 4);
constexpr size_t WS_LB = WS_MOD + al256((size_t)NL * NB * 6144 * 4);
constexpr size_t WS_ROPE = WS_LB + al256((size_t)NL * 256 * 4);
constexpr size_t WS_WIN = WS_ROPE + al256((size_t)NTOK * 32 * 4);
constexpr size_t WS_WOUT = WS_WIN + (size_t)ZP * 1024 * 2;
constexpr size_t WS_WUQ = WS_WOUT + (size_t)1024 * 1024 * 2;
constexpr size_t WS_WUKV = WS_WUQ + al256((size_t)384 * 192 * 2);
constexpr size_t WS_WPOOL = WS_WUKV + al256((size_t)512 * 128 * 2);
constexpr size_t WS_WUP = WS_WPOOL + al256((size_t)4 * 64 * 64 * 2);
constexpr size_t WS_WDN = WS_WUP + (size_t)32 * 1024 * 1024 * 2;
constexpr size_t WS_RWT = WS_WDN + (size_t)32 * 1024 * 512 * 2;
constexpr size_t WSET = WS_RWT + 36 * 1024 * 4 - WS_WIN;
constexpr size_t WS_HA = WS_WIN + 2 * WSET;
constexpr size_t WS_Z = WS_HA + (size_t)NTOK * 1024 * 2;
constexpr size_t Z_BYTES = cmax((size_t)NTOK * ZP * 2, (size_t)NR * 1024 * 2);
constexpr size_t WS_Q = WS_Z + Z_BYTES;
constexpr size_t WS_K = WS_Q + (size_t)NTOK * 4 * 96 * 2;
constexpr size_t WS_VT = WS_K + (size_t)NTOK * 4 * 96 * 2;
constexpr size_t WS_YB = WS_VT + (size_t)NTOK * 4 * 64 * 2;
constexpr size_t R2_BYTES = cmax(WS_YB + (size_t)NTOK * 1024 * 2 - WS_Q, (size_t)NR * 512 * 2);
constexpr size_t WS_Y1 = WS_Q + R2_BYTES;
constexpr size_t WS_SC = WS_Y1 + (size_t)NTOK * 1024 * 2;
constexpr size_t WS_PC = WS_SC + (size_t)NBH * NCH * 4096 * 4;
constexpr size_t WS_S0 = WS_PC + al256((size_t)NBH * NCH * 64 * 4);
constexpr size_t WS_ASGE = WS_S0 + (size_t)NBH * NCH * 4096 * 4;
constexpr size_t WS_ASGR = WS_ASGE + (size_t)NTOK * 8;
constexpr size_t WS_ASGW = WS_ASGR + (size_t)NTOK * 8;
constexpr int MOE_CAP = NTOK;
constexpr size_t WS_ROWTOK = WS_ASGW + (size_t)NTOK * 8;
constexpr size_t WS_ROWW = WS_ROWTOK + (size_t)32 * MOE_CAP * 4;
constexpr size_t WS_TILE = WS_ROWW + (size_t)32 * MOE_CAP * 4;
constexpr size_t WS_XB = WS_TILE + al256((size_t)(NR / 256 + 16) * 4);
constexpr size_t WS_END = WS_XB + (size_t)NTOK * 1024 * 2;
constexpr int LDS_BYTES = 160 * 1024;
constexpr int LDS_XB = LDS_BYTES - 16;

#define XB_TMO      128
#define XB_XCNT(j)  (256  + 64 * (j))
#define XB_XSUB(j)  (1280 + 64 * (j))
#define XB_XGEN(j)  (2304 + 64 * (j))
#define XB_TOP      3328
#define XB_TOPGEN   3392
#define XCD_BAR_WORDS 3456
#define XB_SPIN_CAP (1u << 18)
__device__ __forceinline__ unsigned xb_ld(unsigned* p)              { return __hip_atomic_load(p, __ATOMIC_RELAXED, __HIP_MEMORY_SCOPE_AGENT); }
__device__ __forceinline__ unsigned xb_add(unsigned* p, unsigned v) { return __hip_atomic_fetch_add(p, v, __ATOMIC_RELAXED, __HIP_MEMORY_SCOPE_AGENT); }
__device__ __forceinline__ unsigned xb_xcc_id() { return (unsigned)__builtin_amdgcn_s_getreg((3 << 11) | 20) & 0xFu; }
#define XB_SPIN(cond, bar) do { unsigned _sp = 0; while (cond) { __builtin_amdgcn_s_sleep(1); \
    if ((++_sp & 255u) == 0u) { if (xb_ld(&(bar)[XB_TMO])) break; if (_sp > XB_SPIN_CAP) { atomicAdd(&(bar)[XB_TMO], 1u); break; } } } } while (0)
struct XcdBarrier { unsigned* bar; unsigned x; volatile LAS unsigned* st; };
__device__ __forceinline__ XcdBarrier xcd_barrier_post(unsigned* bar, volatile LAS unsigned* st) {
    XcdBarrier b; b.bar = bar; b.x = xb_xcc_id(); b.st = st;
    if (threadIdx.x == 0) (void)xb_add(&bar[XB_XCNT(b.x)], 1u);
    return b;
}
__device__ __forceinline__ void xcd_barrier_complete(unsigned* bar, unsigned x, unsigned& nloc, unsigned& nx) {
    const unsigned G = gridDim.x * gridDim.y * gridDim.z;
    unsigned sum, cnt, mine, sp = 0u;
    for (;;) {
        sum = 0u; cnt = 0u; mine = 0u;
#pragma unroll
        for (unsigned j = 0; j < 16; ++j) { const unsigned c = xb_ld(&bar[XB_XCNT(j)]); sum += c; cnt += (c > 0u) ? 1u : 0u; mine = (j == x) ? c : mine; }
        if (sum == G) break;
        __builtin_amdgcn_s_sleep(1);
        if ((++sp & 255u) == 0u) { if (xb_ld(&bar[XB_TMO])) break; if (sp > XB_SPIN_CAP) { atomicAdd(&bar[XB_TMO], 1u); break; } }
    }
    nloc = mine > 0u ? mine : 1u; nx = cnt > 0u ? cnt : 1u;
}
__device__ __forceinline__ void xcd_barrier(const XcdBarrier& b) {
    ASMV("s_waitcnt vmcnt(0)" ::: "memory");
    __syncthreads();
    if (threadIdx.x == 0) {
        unsigned* bar = b.bar;
        __builtin_amdgcn_s_waitcnt(0);
        unsigned nloc = b.st[0], nx = b.st[1];
        if (nloc == 0u) { xcd_barrier_complete(bar, b.x, nloc, nx); b.st[0] = nloc; b.st[1] = nx; }
        const unsigned old = xb_add(&bar[XB_XSUB(b.x)], 1u);
        const unsigned gen = old / nloc;
        if (old + 1u == (gen + 1u) * nloc) {
            __builtin_amdgcn_fence(__ATOMIC_RELEASE, "agent");
            ASMV("s_waitcnt vmcnt(0)" ::: "memory");
            const unsigned og = xb_add(&bar[XB_TOP], 1u);
            const unsigned tg = og / nx;
            if (og + 1u == (tg + 1u) * nx) xb_add(&bar[XB_TOPGEN], 1u);
            else XB_SPIN(xb_ld(&bar[XB_TOPGEN]) == tg, bar);
            __builtin_amdgcn_fence(__ATOMIC_ACQUIRE, "agent");
            xb_add(&bar[XB_XGEN(b.x)], 1u);
            ASMV("s_waitcnt vmcnt(0)" ::: "memory");
        } else {
            XB_SPIN(xb_ld(&bar[XB_XGEN(b.x)]) == gen, bar);
            __builtin_amdgcn_fence(__ATOMIC_ACQUIRE, "agent");
            ASMV("s_waitcnt vmcnt(0)" ::: "memory");
        }
    }
    __syncthreads();
}

struct Args { const void* in[30]; float* out; unsigned char* ws; int ph_lo, ph_hi; };
enum { I_X = 0, I_C, I_POS, I_WADA, I_BADA, I_N1G, I_N2G, I_WIN, I_QAG, I_WUQ, I_KVAG, I_WUKV, I_QG, I_KG, I_WPOOL, I_PSCALE, I_LBL, I_HOG, I_DWW, I_DWB, I_LNG, I_LNB,
       I_WOUT, I_RGW, I_RGB, I_REW, I_REB, I_W1, I_W3, I_W2 };
struct Ctx {
    const Args* a; unsigned char* ws; unsigned char* lds; int tid, wid, lane, G, blk;
    __device__ __forceinline__ const float* inf(int i) const { return (const float*)a->in[i]; }
    template <class T> __device__ __forceinline__ T* w(size_t off) const { return (T*)(ws + off); }
};

__device__ __forceinline__ Ctx fresh(const Ctx& c0) { Ctx c = c0; LAUNDER_V(c.tid); LAUNDER_V(c.lane); LAUNDER_S(c.wid); return c; }
__device__ __forceinline__ void ph_prologue0(const Ctx& c_) { const Ctx c = fresh(c_);
    const float* cc = c.inf(I_C); const float* wada = c.inf(I_WADA); float* modp = c.w<float>(WS_MODP);
    for (int u = c.blk; u < NL * 16 * 12; u += c.G) {
        const int l = u / 192, r = u % 192, ic = r / 12, jb = r % 12, j = jb * 512 + c.tid;
        float* Ls = (float*)c.lds;
        __syncthreads();
        if (c.tid < NB * 64) Ls[c.tid] = fsilu(cc[(c.tid >> 6) * 1024 + ic * 64 + (c.tid & 63)]);
        __syncthreads();
        float acc[NB];
#pragma unroll
        for (int b = 0; b < NB; ++b) acc[b] = 0.f;
        const float* wp = wada + ((size_t)l * 1024 + ic * 64) * 6144 + j;
#pragma unroll
        for (int i0 = 0; i0 < 64; i0 += 16) { float wv[16];
#pragma unroll
            for (int i = 0; i < 16; ++i) wv[i] = wp[(size_t)(i0 + i) * 6144];
#pragma unroll
            for (int i = 0; i < 16; ++i)
#pragma unroll
                for (int b = 0; b < NB; ++b) acc[b] += Ls[b * 64 + i0 + i] * wv[i]; }
#pragma unroll
        for (int b = 0; b < NB; ++b) modp[(((size_t)ic * NL + l) * NB + b) * 6144 + j] = acc[b];
    }
    const int* pos = (const int*)c.a->in[I_POS]; float* rc = c.w<float>(WS_ROPE); float* rs = rc + (size_t)NTOK * 16;
    for (int e = c.blk * 512 + c.tid; e < NTOK * 16; e += c.G * 512) { const int t = e >> 4, i = e & 15;
        const float inv = exp2f(-(float)i * (13.287712379549449f / 16.0f));
        const float ang = (float)pos[t] * inv; rc[e] = cosf(ang); rs[e] = sinf(ang); }
    if (c.blk == 0 && c.tid < 256) { const float* lg = c.inf(I_LBL); float* lb = c.w<float>(WS_LB); float mx = -1e30f;
        for (int l = 0; l < NL; ++l) mx = fmaxf(mx, lg[l * 256 + c.tid]);
        float den = 0.f; for (int l = 0; l < NL; ++l) den += expf(lg[l * 256 + c.tid] - mx);
        float cum = 0.f, first = 0.f; for (int l = 0; l < NL; ++l) { cum += expf(lg[l * 256 + c.tid] - mx) / den; if (l == 0) first = cum; lb[l * 256 + c.tid] = cum - first; } }
}
__device__ __forceinline__ void ph_prologue1(const Ctx& c_) { const Ctx c = fresh(c_);
    const float* modp = c.w<float>(WS_MODP); float* mod = c.w<float>(WS_MOD); const float* bada = c.inf(I_BADA);
    for (int e = c.blk * 512 + c.tid; e < NL * NB * 6144; e += c.G * 512) { const int j = e % 6144, l = e / (NB * 6144);
        float s = bada[l * 6144 + j];
#pragma unroll
        for (int ic = 0; ic < 16; ++ic) s += modp[(size_t)ic * NL * NB * 6144 + e];
        mod[e] = s; }
}

__device__ __forceinline__ void ld8bf(const bf16_t* p, float (&o)[8]) { const u32x4 v = *(const u32x4*)p; o[0] = bflo(v.x); o[1] = bfhi(v.x); o[2] = bflo(v.y); o[3] = bfhi(v.y); o[4] = bflo(v.z); o[5] = bfhi(v.z); o[6] = bflo(v.w); o[7] = bfhi(v.w); }
__device__ __forceinline__ u32x4 pk8(const float (&o)[8]) { u32x4 w; w.x = cvt_pk_bf16(o[0], o[1]); w.y = cvt_pk_bf16(o[2], o[3]); w.z = cvt_pk_bf16(o[4], o[5]); w.w = cvt_pk_bf16(o[6], o[7]); return w; }
__device__ __forceinline__ u32x4 pk8p(const float (&o)[8]) { u32x4 w; w.x = cvt_pk_bf16_pinned(o[0], o[1]); w.y = cvt_pk_bf16_pinned(o[2], o[3]); w.z = cvt_pk_bf16_pinned(o[4], o[5]); w.w = cvt_pk_bf16_pinned(o[6], o[7]); return w; }
__device__ __forceinline__ void cvt_tile(const Ctx& c, const float* src, int ldn, int nlim, int k0, int n0, bf16_t* dst, int ldk, int drow0) {
    float* T = (float*)c.lds;
#pragma unroll
    for (int i = 0; i < 8; ++i) { const int e = c.tid + 512 * i, kk = e >> 6, nn = e & 63; T[kk * 65 + nn] = (n0 + nn < nlim) ? src[(size_t)(k0 + kk) * ldn + n0 + nn] : 0.f; }
    __syncthreads();
#pragma unroll
    for (int i = 0; i < 4; ++i) { const int e = c.tid + 512 * i, nn = e >> 5, k2 = e & 31;
        *(unsigned*)(dst + (size_t)(drow0 + nn) * ldk + k0 + 2 * k2) = cvt_pk_bf16(T[(2 * k2) * 65 + nn], T[(2 * k2 + 1) * 65 + nn]); }
    __syncthreads();
}
__device__ __forceinline__ void cvt_big(const Ctx& c, const float* src, int ldn, int nlim, int k0, int n0, bf16_t* dst, int ldk, int mode) {
    float* T = (float*)c.lds;
    f32x4 v[8];
#pragma unroll
    for (int i = 0; i < 8; ++i) { const int e4 = c.tid + 512 * i, kk = e4 >> 6, n4 = e4 & 63; v[i] = (n0 + n4 * 4 < nlim) ? *(const f32x4*)(src + (size_t)(k0 + kk) * ldn + n0 + n4 * 4) : (f32x4){0.f, 0.f, 0.f, 0.f}; }
#pragma unroll
    for (int i = 0; i < 8; ++i) { const int e4 = c.tid + 512 * i, kk = e4 >> 6, n4 = e4 & 63; float* p = T + kk * 261 + n4 * 4; p[0] = v[i][0]; p[1] = v[i][1]; p[2] = v[i][2]; p[3] = v[i][3]; }
    __syncthreads();
#pragma unroll
    for (int i = 0; i < 4; ++i) { const int e = c.tid + 512 * i, k8 = e & 7, nn = e >> 3, n = n0 + nn; float o[8];
#pragma unroll
        for (int j = 0; j < 8; ++j) o[j] = T[(8 * k8 + j) * 261 + nn];
        const int row = (mode == 0) ? n : ((n >> 7) * 256 + (mode - 1) * 128 + (n & 127));
        *(u32x4*)(dst + (size_t)row * ldk + k0 + 8 * k8) = pk8(o); }
    __syncthreads();
}
constexpr int CT_IN = 16 * 9, CT_OUT = 16 * 4, CT_W13 = 32 * 16 * 2, CT_W2 = 32 * 8 * 4, CT_UQ = 3 * 6, CT_UKV = 2 * 8, CT_POOL = 4;
constexpr int CT_TOTAL = CT_IN + CT_OUT + 2 * CT_W13 + CT_W2 + CT_UQ + CT_UKV + CT_POOL;
__device__ __forceinline__ void ph_cvt(const Ctx& c_, int l) { const Ctx c = fresh(c_);
    { const float* rgw = c.inf(I_RGW) + (size_t)l * 1024 * 4; const float* rew = c.inf(I_REW) + (size_t)l * 1024 * 32; float* rwt = c.w<float>(WS_RWT + (size_t)(l & 1) * WSET);
        for (int e = c.blk * 512 + c.tid; e < 36 * 1024; e += c.G * 512) { const int g = e >> 10, k = e & 1023; rwt[e] = (g < 4) ? rgw[k * 4 + g] : rew[k * 32 + g - 4]; } }
    for (int t = c.blk; t < CT_TOTAL; t += c.G) {
        int r = t;
        if (r < 2 * CT_W13) { const int which = r / CT_W13; r %= CT_W13; const int e = r / 32, kt = (r % 32) / 2, nt = r % 2;
            cvt_big(c, c.inf(which ? I_W3 : I_W1) + ((size_t)l * 32 + e) * 1024 * 512, 512, 512, kt * 64, nt * 256, c.w<bf16_t>(WS_WUP + (size_t)(l & 1) * WSET) + (size_t)e * 1024 * 1024, 1024, 1 + which); continue; } r -= 2 * CT_W13;
        if (r < CT_W2) { const int e = r / 32, kt = (r % 32) / 4, nt = r % 4;
            cvt_big(c, c.inf(I_W2) + ((size_t)l * 32 + e) * 512 * 1024, 1024, 1024, kt * 64, nt * 256, c.w<bf16_t>(WS_WDN + (size_t)(l & 1) * WSET) + (size_t)e * 1024 * 512, 512, 0); continue; } r -= CT_W2;
        if (r < CT_IN) { const int kt = r / 9, nt = r % 9; cvt_big(c, c.inf(I_WIN) + (size_t)l * 1024 * 2144, 2144, 2144, kt * 64, nt * 256, c.w<bf16_t>(WS_WIN + (size_t)(l & 1) * WSET), 1024, 0); continue; } r -= CT_IN;
        if (r < CT_OUT) { const int kt = r / 4, nt = r % 4; cvt_big(c, c.inf(I_WOUT) + (size_t)l * 1024 * 1024, 1024, 1024, kt * 64, nt * 256, c.w<bf16_t>(WS_WOUT + (size_t)(l & 1) * WSET), 1024, 0); continue; } r -= CT_OUT;
        if (r < CT_UQ) { const int kt = r / 6, nt = r % 6; cvt_tile(c, c.inf(I_WUQ) + (size_t)l * 192 * 384, 384, 384, kt * 64, nt * 64, c.w<bf16_t>(WS_WUQ + (size_t)(l & 1) * WSET), 192, nt * 64); continue; } r -= CT_UQ;
        if (r < CT_UKV) { const int kt = r / 8, nt = r % 8; cvt_tile(c, c.inf(I_WUKV) + (size_t)l * 128 * 512, 512, 512, kt * 64, nt * 64, c.w<bf16_t>(WS_WUKV + (size_t)(l & 1) * WSET), 128, nt * 64); continue; } r -= CT_UKV;
        cvt_tile(c, c.inf(I_WPOOL) + ((size_t)l * 4 + r) * 4096, 64, 64, 0, 0, c.w<bf16_t>(WS_WPOOL + (size_t)(l & 1) * WSET) + r * 4096, 64, 0);
    }
}
__device__ __forceinline__ void ph_normrows(const Ctx& c_, int l) { const Ctx c = fresh(c_);
    const float* xin = c.inf(I_X); const bf16_t* xb = c.w<bf16_t>(WS_XB); const bf16_t* y1 = c.w<bf16_t>(WS_Y1);
    const float* gn = c.inf(I_N1G) + l * 1024; const float* mod = c.w<float>(WS_MOD) + (size_t)l * NB * 6144; bf16_t* ha = c.w<bf16_t>(WS_HA);
    constexpr int RQ = 4;
    for (int row0 = c.blk * 8 + c.wid; row0 < NTOK; row0 += c.G * 8 * RQ) {
        f32x4 v[RQ][2][2]; float ss[RQ];
        if (l == 0) {
#pragma unroll
            for (int q = 0; q < RQ; ++q) { const int row = row0 + q * c.G * 8;
                if (row < NTOK) {
#pragma unroll
                    for (int i = 0; i < 2; ++i) { const float* p = xin + (size_t)row * 1024 + i * 512 + c.lane * 8; v[q][i][0] = *(const f32x4*)p; v[q][i][1] = *(const f32x4*)(p + 4); } } }
        } else {
            u32x4 xw[RQ][2], yw[RQ][2];
#pragma unroll
            for (int q = 0; q < RQ; ++q) { const int row = row0 + q * c.G * 8;
                if (row < NTOK) {
#pragma unroll
                    for (int i = 0; i < 2; ++i) { const size_t o = (size_t)row * 1024 + i * 512 + c.lane * 8; xw[q][i] = *(const u32x4*)(xb + o); yw[q][i] = *(const u32x4*)(y1 + o); } } }
#pragma unroll
            for (int q = 0; q < RQ; ++q)
#pragma unroll
                for (int i = 0; i < 2; ++i) { const u32x4 a = xw[q][i], b = yw[q][i];
                    v[q][i][0] = (f32x4){bflo(a.x), bfhi(a.x), bflo(a.y), bfhi(a.y)} + (f32x4){bflo(b.x), bfhi(b.x), bflo(b.y), bfhi(b.y)};
                    v[q][i][1] = (f32x4){bflo(a.z), bfhi(a.z), bflo(a.w), bfhi(a.w)} + (f32x4){bflo(b.z), bfhi(b.z), bflo(b.w), bfhi(b.w)}; }
        }
#pragma unroll
        for (int q = 0; q < RQ; ++q) { float s = 0.f;
#pragma unroll
            for (int i = 0; i < 2; ++i)
#pragma unroll
                for (int h = 0; h < 2; ++h) { const f32x4 w = v[q][i][h]; s += w[0] * w[0] + w[1] * w[1] + w[2] * w[2] + w[3] * w[3]; }
            ss[q] = (row0 + q * c.G * 8 < NTOK) ? s : 0.f; }
#pragma unroll
        for (int q = 0; q < RQ; ++q) ss[q] = wave_sum(ss[q]);
#pragma unroll
        for (int q = 0; q < RQ; ++q) { const int row = row0 + q * c.G * 8;
            if (row < NTOK) { const int b = row / SEQ; const float* sh = mod + b * 6144; const float* sc = sh + 1024; const float rinv = frsqrt(ss[q] * (1.0f / 1024.0f) + EPS);
#pragma unroll
                for (int i = 0; i < 2; ++i) { const int col = i * 512 + c.lane * 8; float o8[8];
#pragma unroll
                    for (int h = 0; h < 2; ++h) { const f32x4 g = *(const f32x4*)(gn + col + 4 * h), s1 = *(const f32x4*)(sc + col + 4 * h), s0 = *(const f32x4*)(sh + col + 4 * h);
                        const f32x4 hv = v[q][i][h] * rinv * g * (s1 + 1.0f) + s0; o8[4 * h] = hv[0]; o8[4 * h + 1] = hv[1]; o8[4 * h + 2] = hv[2]; o8[4 * h + 3] = hv[3]; }
                    *(u32x4*)(ha + (size_t)row * 1024 + col) = pk8(o8); } } }
    }
}

#define MFMA16(a, b, c) __builtin_amdgcn_mfma_f32_16x16x32_bf16((a), (b), (c), 0, 0, 0)
#define MFMA32(a, b, c) __builtin_amdgcn_mfma_f32_32x32x16_bf16((a), (b), (c), 0, 0, 0)

__device__ __forceinline__ void mix_unit(const Ctx& c_, int l, int r0) { const Ctx c = fresh(c_);
    const bf16_t* Z = c.w<bf16_t>(WS_Z); bf16_t* Aq = (bf16_t*)c.lds; bf16_t* Akv = (bf16_t*)(c.lds + 12800); float* Lkr = (float*)(c.lds + 21504);
    float* Lu = (float*)(c.lds + 25600); bf16_t* Lp = (bf16_t*)(c.lds + 73728); float* Lcu = (float*)(c.lds + 90624); float* Lco = (float*)c.lds;
    const int s0 = r0 % SEQ, b = r0 / SEQ, fr = c.lane & 15, fq = c.lane >> 4;
    {   const int t = c.tid >> 4, sub = c.tid & 15; const bf16_t* zr = Z + (size_t)(r0 + t) * ZP;
        const u32x4 zero4 = {0u, 0u, 0u, 0u};
        const u32x4 ra0 = *(const u32x4*)(zr + Z_CQ + sub * 8), ra1 = (sub < 8) ? *(const u32x4*)(zr + Z_CQ + 128 + sub * 8) : zero4, rk0 = *(const u32x4*)(zr + Z_CKV + sub * 8), rkr = (sub < 4) ? *(const u32x4*)(zr + Z_KR + sub * 8) : zero4;
        u32x4 rp[3], rca[4], rcg[4];
#pragma unroll
        for (int i = 0; i < 3; ++i) { const int ch = c.tid + 512 * i, row = ch >> 5, c8 = ch & 31; rp[i] = (ch < 47 * 32 && s0 - 15 + row >= 0) ? *(const u32x4*)(Z + (size_t)(r0 - 15 + row) * ZP + Z_POOL + c8 * 8) : zero4; }
#pragma unroll
        for (int i = 0; i < 4; ++i) { const int ch = c.tid + 512 * i, row = ch >> 5, c8 = ch & 31; const bool ok = (ch < 62 * 32 && s0 - 30 + row >= 0);
            rca[i] = ok ? *(const u32x4*)(Z + (size_t)(r0 - 30 + row) * ZP + Z_CA + c8 * 8) : zero4; rcg[i] = ok ? *(const u32x4*)(Z + (size_t)(r0 - 30 + row) * ZP + Z_CG + c8 * 8) : zero4; }
        auto un8 = [](const u32x4 v, float (&o)[8]) { o[0] = bflo(v.x); o[1] = bfhi(v.x); o[2] = bflo(v.y); o[3] = bfhi(v.y); o[4] = bflo(v.z); o[5] = bfhi(v.z); o[6] = bflo(v.w); o[7] = bfhi(v.w); };
        const float* qag = c.inf(I_QAG) + l * 192; const float* kvag = c.inf(I_KVAG) + l * 128;
        float a0[8], a1[8], k0[8]; float ssq = 0.f, ssk = 0.f; un8(ra0, a0); un8(ra1, a1); un8(rk0, k0);
#pragma unroll
        for (int j = 0; j < 8; ++j) { ssq += a0[j] * a0[j] + a1[j] * a1[j]; ssk += k0[j] * k0[j]; }
#pragma unroll
        for (int m = 1; m < 16; m <<= 1) { ssq += __shfl_xor(ssq, m); ssk += __shfl_xor(ssk, m); }
        const float rq = frsqrt(ssq * (1.0f / 192.0f) + EPS), rk = frsqrt(ssk * (1.0f / 128.0f) + EPS);
#pragma unroll
        for (int j = 0; j < 8; ++j) a0[j] *= rq * qag[sub * 8 + j];
        *(u32x4*)(Aq + t * 200 + sub * 8) = pk8(a0);
        if (sub < 8) {
#pragma unroll
            for (int j = 0; j < 8; ++j) a1[j] *= rq * qag[128 + sub * 8 + j];
            *(u32x4*)(Aq + t * 200 + 128 + sub * 8) = pk8(a1); }
#pragma unroll
        for (int j = 0; j < 8; ++j) k0[j] *= rk * kvag[sub * 8 + j];
        *(u32x4*)(Akv + t * 136 + sub * 8) = pk8(k0);
        if (sub < 4) { float kr[8]; un8(rkr, kr);
#pragma unroll
            for (int j = 0; j < 8; ++j) Lkr[t * 32 + sub * 8 + j] = kr[j]; }
#pragma unroll
        for (int i = 0; i < 3; ++i) { const int ch = c.tid + 512 * i, row = ch >> 5, c8 = ch & 31; if (ch < 47 * 32) { float v[8]; un8(rp[i], v);
            *(f32x4*)(Lu + row * 256 + c8 * 8) = (f32x4){v[0], v[1], v[2], v[3]}; *(f32x4*)(Lu + row * 256 + c8 * 8 + 4) = (f32x4){v[4], v[5], v[6], v[7]}; } }
#pragma unroll
        for (int i = 0; i < 4; ++i) { const int ch = c.tid + 512 * i, row = ch >> 5, c8 = ch & 31; if (ch < 62 * 32) { float a[8], g[8]; un8(rca[i], a); un8(rcg[i], g);
#pragma unroll
            for (int j = 0; j < 8; ++j) a[j] *= fsigmoid(g[j]);
            *(f32x4*)(Lcu + row * 256 + c8 * 8) = (f32x4){a[0], a[1], a[2], a[3]}; *(f32x4*)(Lcu + row * 256 + c8 * 8 + 4) = (f32x4){a[4], a[5], a[6], a[7]}; } }
    }
    __syncthreads();
    const float* rcos = c.w<float>(WS_ROPE); const float* rsin = rcos + (size_t)NTOK * 16;
    if (c.wid < 4) {
        const int h = c.wid; const bf16_t* W = c.w<bf16_t>(WS_WUQ + (size_t)(l & 1) * WSET) + (size_t)(96 * h) * 192; const float* qg = c.inf(I_QG) + l * 96;
        f32x4 acc[6][2];
#pragma unroll
        for (int nf = 0; nf < 6; ++nf) { acc[nf][0] = (f32x4){0.f, 0.f, 0.f, 0.f}; acc[nf][1] = acc[nf][0]; }
#pragma unroll
        for (int ks = 0; ks < 6; ++ks) { bf16x8 af[2];
#pragma unroll
            for (int mf = 0; mf < 2; ++mf) af[mf] = *(const bf16x8*)(Aq + (mf * 16 + fr) * 200 + ks * 32 + fq * 8);
#pragma unroll
            for (int nf = 0; nf < 6; ++nf) { const bf16x8 bfr = *(const bf16x8*)(W + (size_t)(16 * nf + fr) * 192 + ks * 32 + fq * 8);
                acc[nf][0] = MFMA16(bfr, af[0], acc[nf][0]); acc[nf][1] = MFMA16(bfr, af[1], acc[nf][1]); } }
#pragma unroll
        for (int mf = 0; mf < 2; ++mf) { float ss = 0.f;
#pragma unroll
            for (int nf = 0; nf < 6; ++nf)
#pragma unroll
                for (int j = 0; j < 4; ++j) ss += acc[nf][mf][j] * acc[nf][mf][j];
            ss += __shfl_xor(ss, 16); ss += __shfl_xor(ss, 32);
            const float rinv = frsqrt(ss * (1.0f / 96.0f) + EPS) * (0.10206207261596575f * 1.44269504089f);
            const int tok = r0 + mf * 16 + fr; bf16_t* qo = c.w<bf16_t>(WS_Q) + ((size_t)(b * 4 + h) * SEQ + s0 + mf * 16 + fr) * 96;
            float v[6][4];
#pragma unroll
            for (int nf = 0; nf < 6; ++nf)
#pragma unroll
                for (int j = 0; j < 4; ++j) v[nf][j] = acc[nf][mf][j] * rinv * qg[16 * nf + 4 * fq + j];
            const f32x4 cs4 = *(const f32x4*)(rcos + (size_t)tok * 16 + 4 * fq), sn4 = *(const f32x4*)(rsin + (size_t)tok * 16 + 4 * fq);
#pragma unroll
            for (int j = 0; j < 4; ++j) { const float x1 = v[4][j], x2 = v[5][j]; v[4][j] = x1 * cs4[j] - x2 * sn4[j]; v[5][j] = x1 * sn4[j] + x2 * cs4[j]; }
#pragma unroll
            for (int nf = 0; nf < 6; ++nf) { u32x2 o; o.x = cvt_pk_bf16(v[nf][0], v[nf][1]); o.y = cvt_pk_bf16(v[nf][2], v[nf][3]); *(u32x2*)(qo + 16 * nf + 4 * fq) = o; } }
    } else {
        const int h = c.wid - 4; const bf16_t* W = c.w<bf16_t>(WS_WUKV + (size_t)(l & 1) * WSET) + (size_t)(128 * h) * 128; const float* kg = c.inf(I_KG) + l * 96;
        f32x4 ak[4][2], av[4][2];
#pragma unroll
        for (int nf = 0; nf < 4; ++nf) { ak[nf][0] = (f32x4){0.f, 0.f, 0.f, 0.f}; ak[nf][1] = ak[nf][0]; av[nf][0] = ak[nf][0]; av[nf][1] = ak[nf][0]; }
#pragma unroll
        for (int ks = 0; ks < 4; ++ks) { bf16x8 af[2];
#pragma unroll
            for (int mf = 0; mf < 2; ++mf) af[mf] = *(const bf16x8*)(Akv + (mf * 16 + fr) * 136 + ks * 32 + fq * 8);
#pragma unroll
            for (int nf = 0; nf < 4; ++nf) { const bf16x8 bk = *(const bf16x8*)(W + (size_t)(16 * nf + fr) * 128 + ks * 32 + fq * 8), bv = *(const bf16x8*)(W + (size_t)(64 + 16 * nf + fr) * 128 + ks * 32 + fq * 8);
                ak[nf][0] = MFMA16(bk, af[0], ak[nf][0]); ak[nf][1] = MFMA16(bk, af[1], ak[nf][1]);
                av[nf][0] = MFMA16(af[0], bv, av[nf][0]); av[nf][1] = MFMA16(af[1], bv, av[nf][1]); } }
#pragma unroll
        for (int mf = 0; mf < 2; ++mf) { const int tl = mf * 16 + fr; float ss = 0.f;
#pragma unroll
            for (int nf = 0; nf < 4; ++nf)
#pragma unroll
                for (int j = 0; j < 4; ++j) ss += ak[nf][mf][j] * ak[nf][mf][j];
#pragma unroll
            for (int j = 0; j < 8; ++j) { const float kr = Lkr[tl * 32 + fq * 8 + j]; ss += kr * kr; }
            ss += __shfl_xor(ss, 16); ss += __shfl_xor(ss, 32);
            const float rinv = frsqrt(ss * (1.0f / 96.0f) + EPS);
            const int tok = r0 + tl; bf16_t* ko = c.w<bf16_t>(WS_K) + ((size_t)(b * 4 + h) * SEQ + s0 + tl) * 96;
#pragma unroll
            for (int nf = 0; nf < 4; ++nf) { u32x2 o; o.x = cvt_pk_bf16(ak[nf][mf][0] * rinv * kg[16 * nf + 4 * fq], ak[nf][mf][1] * rinv * kg[16 * nf + 4 * fq + 1]);
                o.y = cvt_pk_bf16(ak[nf][mf][2] * rinv * kg[16 * nf + 4 * fq + 2], ak[nf][mf][3] * rinv * kg[16 * nf + 4 * fq + 3]); *(u32x2*)(ko + 16 * nf + 4 * fq) = o; }
            const f32x4 cs4 = *(const f32x4*)(rcos + (size_t)tok * 16 + 4 * fq), sn4 = *(const f32x4*)(rsin + (size_t)tok * 16 + 4 * fq);
            float o1[4], o2[4];
#pragma unroll
            for (int j = 0; j < 4; ++j) { const int i = 4 * fq + j; const float x1 = Lkr[tl * 32 + i] * rinv * kg[64 + i], x2 = Lkr[tl * 32 + 16 + i] * rinv * kg[80 + i];
                o1[j] = x1 * cs4[j] - x2 * sn4[j]; o2[j] = x1 * sn4[j] + x2 * cs4[j]; }
            { u32x2 o; o.x = cvt_pk_bf16(o1[0], o1[1]); o.y = cvt_pk_bf16(o1[2], o1[3]); *(u32x2*)(ko + 64 + 4 * fq) = o; o.x = cvt_pk_bf16(o2[0], o2[1]); o.y = cvt_pk_bf16(o2[2], o2[3]); *(u32x2*)(ko + 80 + 4 * fq) = o; }
            bf16_t* vo = c.w<bf16_t>(WS_VT) + (size_t)(b * 4 + h) * 64 * SEQ + s0 + mf * 16 + 4 * fq;
#pragma unroll
            for (int nf = 0; nf < 4; ++nf) { u32x2 o; o.x = cvt_pk_bf16(av[nf][mf][0], av[nf][mf][1]); o.y = cvt_pk_bf16(av[nf][mf][2], av[nf][mf][3]); *(u32x2*)(vo + (size_t)(16 * nf + fr) * SEQ) = o; } }
    }
    { const int t = c.tid >> 4, sub = c.tid & 15, g = sub >> 2, w = 2 << g, s = s0 + t; const float inv = 1.0f / (float)((s + 1 < w) ? (s + 1) : w);
#pragma unroll
        for (int k = 0; k < 2; ++k) { const int col = sub * 16 + k * 8; float sum[8];
#pragma unroll
            for (int j = 0; j < 8; ++j) sum[j] = 0.f;
            for (int d = 0; d < w; ++d) { const float* p = Lu + (t + 15 - d) * 256 + col;
#pragma unroll
                for (int j = 0; j < 8; ++j) sum[j] += p[j]; }
            const float* p0 = Lu + (t + 15) * 256 + col;
#pragma unroll
            for (int j = 0; j < 8; ++j) sum[j] = sum[j] * inv - p0[j];
            *(u32x4*)(Lp + t * 264 + col) = pk8(sum); } }
    float cres[16];
    { const int chn = c.tid & 255, half = c.tid >> 8; const float* dw = c.inf(I_DWW) + (size_t)l * 31 * 256 + chn; const float bias = c.inf(I_DWB)[l * 256 + chn];
        float wv[31];
#pragma unroll
        for (int j = 0; j < 31; ++j) wv[j] = dw[j * 256];
#pragma unroll
        for (int tt = 0; tt < 16; ++tt) cres[tt] = bias;
#pragma unroll
        for (int r = 0; r < 46; ++r) { const float u = Lcu[(half * 16 + r) * 256 + chn];
#pragma unroll
            for (int tt = 0; tt < 16; ++tt) { const int j = r - tt; if (j >= 0 && j < 31) cres[tt] += wv[j] * u; } } }
    __syncthreads();
    { const int g = c.wid >> 1, mf = c.wid & 1; const bf16_t* W = c.w<bf16_t>(WS_WPOOL + (size_t)(l & 1) * WSET) + g * 4096; const float* ps = c.inf(I_PSCALE) + l * 256 + g * 64;
        f32x4 acc[4];
#pragma unroll
        for (int nf = 0; nf < 4; ++nf) acc[nf] = (f32x4){0.f, 0.f, 0.f, 0.f};
#pragma unroll
        for (int ks = 0; ks < 2; ++ks) { const bf16x8 af = *(const bf16x8*)(Lp + (mf * 16 + fr) * 264 + g * 64 + ks * 32 + fq * 8);
#pragma unroll
            for (int nf = 0; nf < 4; ++nf) { const bf16x8 bfr = *(const bf16x8*)(W + (16 * nf + fr) * 64 + ks * 32 + fq * 8); acc[nf] = MFMA16(bfr, af, acc[nf]); } }
        bf16_t* yo = c.w<bf16_t>(WS_YB) + (size_t)(r0 + mf * 16 + fr) * 1024 + 256 + g * 64;
#pragma unroll
        for (int nf = 0; nf < 4; ++nf) { const int d = 16 * nf + 4 * fq; u32x2 o; o.x = cvt_pk_bf16(acc[nf][0] * ps[d], acc[nf][1] * ps[d + 1]); o.y = cvt_pk_bf16(acc[nf][2] * ps[d + 2], acc[nf][3] * ps[d + 3]); *(u32x2*)(yo + d) = o; } }
    { const int chn = c.tid & 255, half = c.tid >> 8;
#pragma unroll
        for (int tt = 0; tt < 16; ++tt) Lco[(half * 16 + tt) * 256 + chn] = cres[tt]; }
    __syncthreads();
    { const float* lg = c.inf(I_LNG) + l * 256 + c.lane * 4; const float* lb = c.inf(I_LNB) + l * 256 + c.lane * 4;
#pragma unroll
        for (int k = 0; k < 4; ++k) { const int t = c.wid * 4 + k; const f32x4 v = *(const f32x4*)(Lco + t * 256 + c.lane * 4);
            const float mean = wave_sum(v[0] + v[1] + v[2] + v[3]) * (1.0f / 256.0f); const f32x4 d = v - mean;
            const float var = wave_sum(d[0] * d[0] + d[1] * d[1] + d[2] * d[2] + d[3] * d[3]) * (1.0f / 256.0f); const float rs = frsqrt(var + EPS);
            float y[4];
#pragma unroll
            for (int j = 0; j < 4; ++j) y[j] = fsilu(d[j] * rs * lg[j] + lb[j]);
            u32x2 o; o.x = cvt_pk_bf16(y[0], y[1]); o.y = cvt_pk_bf16(y[2], y[3]); *(u32x2*)(c.w<bf16_t>(WS_YB) + (size_t)(r0 + t) * 1024 + 768 + c.lane * 4) = o; } }
    __syncthreads();
}

constexpr int CW_W13 = 32 * 16 * 16, CW_W2 = 32 * 8 * 32, CW_IN = 16 * 72, CW_OUT = 16 * 32, CW_UQ = 3 * 12, CW_UKV = 2 * 16, CW_POOL = 4 * 2;
constexpr int CW_TOTAL = 2 * CW_W13 + CW_W2 + CW_IN + CW_OUT + CW_UQ + CW_UKV + CW_POOL;
struct CvtTile { const float* src; bf16_t* dst; int ldn, ldk; };
__device__ __forceinline__ void cvt_decode(const Ctx& c, int l, int t, CvtTile& d) {
    const size_t wso = (size_t)(l & 1) * WSET; int r = t;
    if (r < 2 * CW_W13) { const int which = r / CW_W13; r %= CW_W13; const int e = r >> 8, kt = (r >> 4) & 15, nt = r & 15, n0 = nt * 32;
        d.src = c.inf(which ? I_W3 : I_W1) + ((size_t)l * 32 + e) * 1024 * 512 + (size_t)kt * 64 * 512 + n0; d.ldn = 512; d.ldk = 1024;
        d.dst = c.w<bf16_t>(WS_WUP + wso) + (size_t)e * 1024 * 1024 + (size_t)((n0 >> 7) * 256 + which * 128 + (n0 & 127)) * 1024 + kt * 64; return; } r -= 2 * CW_W13;
    if (r < CW_W2) { const int e = r >> 8, kt = (r >> 5) & 7, nt = r & 31;
        d.src = c.inf(I_W2) + ((size_t)l * 32 + e) * 512 * 1024 + (size_t)kt * 64 * 1024 + nt * 32; d.ldn = 1024; d.ldk = 512;
        d.dst = c.w<bf16_t>(WS_WDN + wso) + (size_t)e * 1024 * 512 + (size_t)(nt * 32) * 512 + kt * 64; return; } r -= CW_W2;
    if (r < CW_IN) { const int kt = r / 72, nt = r % 72; d.src = (nt < 67) ? c.inf(I_WIN) + (size_t)l * 1024 * 2144 + (size_t)kt * 64 * 2144 + nt * 32 : nullptr; d.ldn = 2144; d.ldk = 1024;
        d.dst = c.w<bf16_t>(WS_WIN + wso) + (size_t)(nt * 32) * 1024 + kt * 64; return; } r -= CW_IN;
    if (r < CW_OUT) { const int kt = r >> 5, nt = r & 31; d.src = c.inf(I_WOUT) + (size_t)l * 1024 * 1024 + (size_t)kt * 64 * 1024 + nt * 32; d.ldn = 1024; d.ldk = 1024;
        d.dst = c.w<bf16_t>(WS_WOUT + wso) + (size_t)(nt * 32) * 1024 + kt * 64; return; } r -= CW_OUT;
    if (r < CW_UQ) { const int kt = r / 12, nt = r % 12; d.src = c.inf(I_WUQ) + (size_t)l * 192 * 384 + (size_t)kt * 64 * 384 + nt * 32; d.ldn = 384; d.ldk = 192;
        d.dst = c.w<bf16_t>(WS_WUQ + wso) + (size_t)(nt * 32) * 192 + kt * 64; return; } r -= CW_UQ;
    if (r < CW_UKV) { const int kt = r >> 4, nt = r & 15; d.src = c.inf(I_WUKV) + (size_t)l * 128 * 512 + (size_t)kt * 64 * 512 + nt * 32; d.ldn = 512; d.ldk = 128;
        d.dst = c.w<bf16_t>(WS_WUKV + wso) + (size_t)(nt * 32) * 128 + kt * 64; return; } r -= CW_UKV;
    { const int g = r >> 1, nt = r & 1; d.src = c.inf(I_WPOOL) + ((size_t)l * 4 + g) * 4096 + nt * 32; d.ldn = 64; d.ldk = 64; d.dst = c.w<bf16_t>(WS_WPOOL + wso) + g * 4096 + (size_t)(nt * 32) * 64; }
}
__device__ __forceinline__ void cvt_wave(const Ctx& c, int l, int wrank, int nwaves, float* T) {
    { const float* rgw = c.inf(I_RGW) + (size_t)l * 1024 * 4; const float* rew = c.inf(I_REW) + (size_t)l * 1024 * 32; float* rwt = c.w<float>(WS_RWT + (size_t)(l & 1) * WSET);
        for (int e = wrank * 64 + c.lane; e < 36 * 1024; e += nwaves * 64) { const int g = e >> 10, k = e & 1023; rwt[e] = (g < 4) ? rgw[k * 4 + g] : rew[k * 32 + g - 4]; } }
    f32x4 v[8]; CvtTile cur; cur.src = nullptr; cur.dst = nullptr; cur.ldn = 0; cur.ldk = 0;
    auto issue = [&](const CvtTile& d) {
#pragma unroll
        for (int i = 0; i < 8; ++i) { const int e4 = c.lane + 64 * i, kk = e4 >> 3, n4 = e4 & 7; v[i] = d.src ? *(const f32x4*)(d.src + (size_t)kk * d.ldn + n4 * 4) : (f32x4){0.f, 0.f, 0.f, 0.f}; } };
    int t = wrank;
    if (t < CW_TOTAL) { cvt_decode(c, l, t, cur); issue(cur); }
    while (t < CW_TOTAL) {
#pragma unroll
        for (int i = 0; i < 8; ++i) { const int e4 = c.lane + 64 * i, kk = e4 >> 3, n4 = e4 & 7; float* p = T + kk * 33 + n4 * 4; p[0] = v[i][0]; p[1] = v[i][1]; p[2] = v[i][2]; p[3] = v[i][3]; }
        const int tn = t + nwaves; CvtTile nxt = cur; if (tn < CW_TOTAL) { cvt_decode(c, l, tn, nxt); issue(nxt); }
        __builtin_amdgcn_wave_barrier();
        { const int n = c.lane & 31, kh = c.lane >> 5; bf16_t* drow = cur.dst + (size_t)n * cur.ldk + kh * 32;
#pragma unroll
            for (int q = 0; q < 4; ++q) { float o[8];
#pragma unroll
                for (int j = 0; j < 8; ++j) o[j] = T[(kh * 32 + q * 8 + j) * 33 + n];
                *(u32x4*)(drow + q * 8) = pk8(o); } }
        __builtin_amdgcn_wave_barrier();
        t = tn; cur = nxt;
    }
}

#ifdef EMU
static inline float __builtin_amdgcn_logf(float x) { return log2f(x); }
#endif
constexpr int HGP = 68, HGV = 40;
constexpr int HG_LG = 0, HG_LK = 8704, HG_LQ = 17408, HG_LVT = 26112, HG_LEG = 31232, HG_LGG = 31488, HG_BYTES = 31744;
template <bool OUT> __device__ __forceinline__ void hgrn_mfma(const Ctx& c_, int l, int bu, int cvt_layer = NL) { const Ctx c = fresh(c_);
    if (c.wid < 4) {
        const int cu = bu * 4 + c.wid, bh = cu / NCH, chunk = cu % NCH, b = bh >> 2, h = bh & 3, tok0 = b * SEQ + chunk * 128;
        const bf16_t* Z = c.w<bf16_t>(WS_Z); const float lbd = c.w<float>(WS_LB)[l * 256 + h * 64 + c.lane];
        unsigned char* L = c.lds + c.wid * HG_BYTES; float* Lg = (float*)(L + HG_LG); float* Lk = (float*)(L + HG_LK); float* Lq = (float*)(L + HG_LQ); bf16_t* Lvt = (bf16_t*)(L + HG_LVT); float* LeG = (float*)(L + HG_LEG); float* LG = (float*)(L + HG_LGG);
        const int l31 = c.lane & 31, hi = c.lane >> 5;
        f32x16 S[2][2];
        if (OUT) { const float* s0 = c.w<float>(WS_S0) + (size_t)(bh * NCH + chunk) * 4096;
#pragma unroll
            for (int mf = 0; mf < 2; ++mf)
#pragma unroll
                for (int nf = 0; nf < 2; ++nf)
#pragma unroll
                    for (int r = 0; r < 16; ++r) S[mf][nf][r] = s0[(32 * mf + (r & 3) + 8 * (r >> 2) + 4 * hi) * 64 + 32 * nf + l31]; }
        else {
#pragma unroll
            for (int mf = 0; mf < 2; ++mf)
#pragma unroll
                for (int nf = 0; nf < 2; ++nf)
#pragma unroll
                    for (int r = 0; r < 16; ++r) S[mf][nf][r] = 0.f; }
        float gtot = 0.f; const float og0 = OUT ? c.inf(I_HOG)[l * 64 + l31] : 0.f, og1 = OUT ? c.inf(I_HOG)[l * 64 + 32 + l31] : 0.f;
        u32x4 rf[4], rq[4], rv[4];
        { const bf16_t* zn = Z + (size_t)(tok0 + (c.lane >> 3)) * ZP + h * 64 + (c.lane & 7) * 8;
#pragma unroll
            for (int i = 0; i < 4; ++i) { rf[i] = *(const u32x4*)(zn + (size_t)i * 8 * ZP + Z_HF); rv[i] = *(const u32x4*)(zn + (size_t)i * 8 * ZP + Z_HI); if (OUT) rq[i] = *(const u32x4*)(zn + (size_t)i * 8 * ZP + Z_HQ); else rq[i] = (u32x4){0u, 0u, 0u, 0u}; } }
#pragma unroll 1
        for (int sc = 0; sc < 4; ++sc) { const int tokb = tok0 + sc * 32;
            {
                const int rr = c.lane >> 3, c8 = (c.lane & 7) * 8;
#pragma unroll
                for (int i = 0; i < 4; ++i) { const int tr = i * 8 + rr; float x[8];
                    { const u32x4 v = rf[i]; x[0] = bflo(v.x); x[1] = bfhi(v.x); x[2] = bflo(v.y); x[3] = bfhi(v.y); x[4] = bflo(v.z); x[5] = bfhi(v.z); x[6] = bflo(v.w); x[7] = bfhi(v.w); }
                    *(f32x4*)(Lg + tr * HGP + c8) = (f32x4){x[0], x[1], x[2], x[3]}; *(f32x4*)(Lg + tr * HGP + c8 + 4) = (f32x4){x[4], x[5], x[6], x[7]};
                    if (OUT) { const u32x4 v = rq[i]; x[0] = fsilu(bflo(v.x)); x[1] = fsilu(bfhi(v.x)); x[2] = fsilu(bflo(v.y)); x[3] = fsilu(bfhi(v.y)); x[4] = fsilu(bflo(v.z)); x[5] = fsilu(bfhi(v.z)); x[6] = fsilu(bflo(v.w)); x[7] = fsilu(bfhi(v.w));
                        *(f32x4*)(Lq + tr * HGP + c8) = (f32x4){x[0], x[1], x[2], x[3]}; *(f32x4*)(Lq + tr * HGP + c8 + 4) = (f32x4){x[4], x[5], x[6], x[7]}; }
                    { const u32x4 v = rv[i]; const unsigned w4[4] = {v.x, v.y, v.z, v.w};
#pragma unroll
                        for (int k = 0; k < 4; ++k) { Lvt[(c8 + 2 * k) * HGV + tr] = (bf16_t)(w4[k] & 0xffffu); Lvt[(c8 + 2 * k + 1) * HGV + tr] = (bf16_t)(w4[k] >> 16); } } }
                if (sc < 3) { const bf16_t* zn = Z + (size_t)(tokb + 32 + rr) * ZP + h * 64 + c8;
#pragma unroll
                    for (int i = 0; i < 4; ++i) { rf[i] = *(const u32x4*)(zn + (size_t)i * 8 * ZP + Z_HF); rv[i] = *(const u32x4*)(zn + (size_t)i * 8 * ZP + Z_HI); if (OUT) rq[i] = *(const u32x4*)(zn + (size_t)i * 8 * ZP + Z_HQ); } }
                __builtin_amdgcn_wave_barrier();
                float run = 0.f;
#pragma unroll
                for (int t = 0; t < 32; ++t) { const float f = lbd + (1.0f - lbd) * fsigmoid(Lg[t * HGP + c.lane]); run += __builtin_amdgcn_logf(f); Lg[t * HGP + c.lane] = run; Lk[t * HGP + c.lane] = 1.0f - f; }
                LG[c.lane] = run; LeG[c.lane] = __builtin_amdgcn_exp2f(run); gtot += run;
            }
            __builtin_amdgcn_wave_barrier();
            bf16x8 vt[2][2];
#pragma unroll
            for (int nf = 0; nf < 2; ++nf)
#pragma unroll
                for (int ks = 0; ks < 2; ++ks) vt[nf][ks] = *(const bf16x8*)(Lvt + (32 * nf + l31) * HGV + 16 * ks + 8 * hi);
            f32x16 O[2];
            if (OUT) {
#pragma unroll
                for (int r = 0; r < 16; ++r) { O[0][r] = 0.f; O[1][r] = 0.f; }
                float acc[8];
#pragma unroll
                for (int m = 0; m < 8; ++m) acc[m] = 0.f;
                const int sb = (l31 & 16) + 8 * hi;
#pragma unroll 1
                for (int d4 = 0; d4 < 16; ++d4) { const f32x4 qt = *(const f32x4*)(Lq + l31 * HGP + 4 * d4), gt = *(const f32x4*)(Lg + l31 * HGP + 4 * d4);
#pragma unroll
                    for (int mg = 0; mg < 4; ++mg) {
                        f32x4 k4[2], g4[2];
#pragma unroll
                        for (int j = 0; j < 2; ++j) { const int s = sb + 2 * mg + j; k4[j] = *(const f32x4*)(Lk + s * HGP + 4 * d4); g4[j] = *(const f32x4*)(Lg + s * HGP + 4 * d4); }
                        __builtin_amdgcn_sched_barrier(0);
#pragma unroll
                        for (int j = 0; j < 2; ++j)
#pragma unroll
                            for (int e = 0; e < 4; ++e) acc[mg * 2 + j] += qt[e] * k4[j][e] * __builtin_amdgcn_exp2f(gt[e] - g4[j][e]);
                        __builtin_amdgcn_sched_barrier(0); } }
                bf16x8 af[2], afx;
                { float a8[8];
#pragma unroll
                    for (int j = 0; j < 8; ++j) a8[j] = (sb + j <= l31) ? acc[j] : 0.f;
                    const bf16x8 ad = __builtin_bit_cast(bf16x8, pk8p(a8)), az = (bf16x8){0, 0, 0, 0, 0, 0, 0, 0};
                    af[0] = (l31 < 16) ? ad : az; af[1] = (l31 < 16) ? az : ad; }
                {
                    f32x16 dx;
#pragma unroll
                    for (int r = 0; r < 16; ++r) dx[r] = 0.f;
                    const bool lowr = l31 < 16; const float* Lx = lowr ? Lk : Lq;
#pragma unroll
                    for (int kk = 0; kk < 4; ++kk) { const int d0 = 16 * kk + 8 * hi;
                        const f32x4 xa = *(const f32x4*)(Lx + l31 * HGP + d0), xb = *(const f32x4*)(Lx + l31 * HGP + d0 + 4), ga = *(const f32x4*)(Lg + l31 * HGP + d0), gb = *(const f32x4*)(Lg + l31 * HGP + d0 + 4),
                                    ma = *(const f32x4*)(Lg + 15 * HGP + d0), mb = *(const f32x4*)(Lg + 15 * HGP + d0 + 4);
                        float v8[8];
#pragma unroll
                        for (int j = 0; j < 4; ++j) { const float da = ga[j] - ma[j], db = gb[j] - mb[j];
                            v8[j] = xa[j] * __builtin_amdgcn_exp2f(lowr ? -da : da); v8[4 + j] = xb[j] * __builtin_amdgcn_exp2f(lowr ? -db : db); }
                        const bf16x8 vv = __builtin_bit_cast(bf16x8, pk8p(v8)), zz = (bf16x8){0, 0, 0, 0, 0, 0, 0, 0};
                        dx = MFMA32(lowr ? vv : zz, lowr ? zz : vv, dx); }
                    float x8[8];
#pragma unroll
                    for (int j = 0; j < 8; ++j) x8[j] = dx[j];
                    afx = __builtin_bit_cast(bf16x8, pk8(x8)); }
#pragma unroll
                for (int mf = 0; mf < 2; ++mf)
#pragma unroll
                    for (int s = 0; s < 2; ++s) { const int d0 = 32 * mf + 16 * s + 4 * hi;
                        const f32x4 qa = *(const f32x4*)(Lq + l31 * HGP + d0), qb = *(const f32x4*)(Lq + l31 * HGP + d0 + 8), ga = *(const f32x4*)(Lg + l31 * HGP + d0), gb = *(const f32x4*)(Lg + l31 * HGP + d0 + 8);
                        float q8[8];
#pragma unroll
                        for (int j = 0; j < 4; ++j) { q8[j] = qa[j] * __builtin_amdgcn_exp2f(ga[j]); q8[4 + j] = qb[j] * __builtin_amdgcn_exp2f(gb[j]); }
                        const bf16x8 qf = __builtin_bit_cast(bf16x8, pk8p(q8));
#pragma unroll
                        for (int nf = 0; nf < 2; ++nf) { float s8[8];
#pragma unroll
                            for (int j = 0; j < 8; ++j) s8[j] = S[mf][nf][8 * s + j];
                            O[nf] = MFMA32(qf, __builtin_bit_cast(bf16x8, pk8p(s8)), O[nf]); } }
#pragma unroll
                for (int nf = 0; nf < 2; ++nf) {
#pragma unroll
                    for (int ks = 0; ks < 2; ++ks) O[nf] = MFMA32(af[ks], vt[nf][ks], O[nf]);
                    const s16x4 p0 = *(const s16x4*)(Lvt + (32 * nf + l31) * HGV + 4 * hi), p1 = *(const s16x4*)(Lvt + (32 * nf + l31) * HGV + 8 + 4 * hi);
                    O[nf] = MFMA32(afx, ((bf16x8){p0[0], p0[1], p0[2], p0[3], p1[0], p1[1], p1[2], p1[3]}), O[nf]); }
            }
#pragma unroll
            for (int mf = 0; mf < 2; ++mf) {
#pragma unroll
                for (int q = 0; q < 4; ++q) { const f32x4 e4 = *(const f32x4*)(LeG + 32 * mf + 8 * q + 4 * hi);
#pragma unroll
                    for (int e = 0; e < 4; ++e) { S[mf][0][4 * q + e] *= e4[e]; S[mf][1][4 * q + e] *= e4[e]; } }
                const int d = 32 * mf + l31; const float Gd = LG[d];
#pragma unroll
                for (int ks = 0; ks < 2; ++ks) { float k8[8];
#pragma unroll
                    for (int j = 0; j < 8; ++j) { const int s = 16 * ks + 8 * hi + j; k8[j] = Lk[s * HGP + d] * __builtin_amdgcn_exp2f(Gd - Lg[s * HGP + d]); }
                    const bf16x8 kf = __builtin_bit_cast(bf16x8, pk8p(k8));
                    S[mf][0] = MFMA32(kf, vt[0][ks], S[mf][0]); S[mf][1] = MFMA32(kf, vt[1][ks], S[mf][1]); } }
            if (OUT) {
                {
                    const int rr = c.lane >> 3, c8 = (c.lane & 7) * 8; const bf16_t* zg = Z + (size_t)(tokb + rr) * ZP + Z_HG + h * 64 + c8; u32x2 gv[4];
#pragma unroll
                    for (int hf = 0; hf < 2; ++hf) {
#pragma unroll
                    for (int i = 0; i < 4; ++i) gv[i] = *(const u32x2*)(zg + (size_t)i * 8 * ZP + 4 * hf);
#pragma unroll
                    for (int i = 0; i < 4; ++i) { const u32x2 v = gv[i]; *(f32x4*)(Lq + (i * 8 + rr) * HGP + c8 + 4 * hf) = (f32x4){fsilu(bflo(v.x)), fsilu(bfhi(v.x)), fsilu(bflo(v.y)), fsilu(bfhi(v.y))}; } }
                }
                __builtin_amdgcn_wave_barrier();
#pragma unroll
                for (int r = 0; r < 16; ++r) { const int tl = (r & 3) + 8 * (r >> 2) + 4 * hi; float ss = O[0][r] * O[0][r] + O[1][r] * O[1][r];
                    ss = half_sum(ss, hi);
                    const float rinv = frsqrt(ss * (1.0f / 64.0f) + EPS); const size_t tok = (size_t)(tokb + tl);
                    const float g0 = Lq[tl * HGP + l31], g1 = Lq[tl * HGP + 32 + l31];
                    bf16_t* yo = c.w<bf16_t>(WS_YB) + tok * 1024 + 512 + h * 64;
                    yo[l31] = (bf16_t)f2bf_bits(O[0][r] * rinv * og0 * g0); yo[32 + l31] = (bf16_t)f2bf_bits(O[1][r] * rinv * og1 * g1); } }
            __builtin_amdgcn_wave_barrier();
        }
        if (!OUT) { float* sc = c.w<float>(WS_SC) + (size_t)(bh * NCH + chunk) * 4096;
#pragma unroll
            for (int mf = 0; mf < 2; ++mf)
#pragma unroll
                for (int nf = 0; nf < 2; ++nf)
#pragma unroll
                    for (int r = 0; r < 16; ++r) sc[(32 * mf + (r & 3) + 8 * (r >> 2) + 4 * hi) * 64 + 32 * nf + l31] = S[mf][nf][r];
            c.w<float>(WS_PC)[(size_t)(bh * NCH + chunk) * 64 + c.lane] = __builtin_amdgcn_exp2f(gtot); }
    } else if (OUT && cvt_layer < NL) {
        cvt_wave(c, cvt_layer, bu * 4 + (c.wid - 4), NBH * NCH, (float*)(c.lds + 4 * HG_BYTES + (c.wid - 4) * 8448));
    }
    __syncthreads();
}
__device__ __forceinline__ void hgrn_carry(const Ctx& c_, int l) { const Ctx c = fresh(c_);
    const float* SC = c.w<float>(WS_SC); const float* PC = c.w<float>(WS_PC); float* S0 = c.w<float>(WS_S0);
    for (int e = c.blk * 512 + c.tid; e < NBH * 4096; e += c.G * 512) { const int bh = e >> 12, dv = e & 4095, d = dv >> 6; float s = 0.f;
#pragma unroll 32
        for (int ch = 0; ch < NCH; ++ch) { const size_t o = (size_t)(bh * NCH + ch) * 4096 + dv; S0[o] = s; s = PC[(size_t)(bh * NCH + ch) * 64 + d] * s + SC[o]; } }
    ASMV("s_waitcnt vmcnt(0)" ::: "memory");
    __syncthreads();
    if (c.tid == 0) { __builtin_amdgcn_fence(__ATOMIC_RELEASE, "agent"); ASMV("s_waitcnt vmcnt(0)" ::: "memory");
        (void)__hip_atomic_fetch_add((unsigned*)(c.ws + WS_CTL + CTL_HG) + l * 64, 1u, __ATOMIC_RELAXED, __HIP_MEMORY_SCOPE_AGENT); }
}
__device__ __forceinline__ void hgrn_wait_carry(const Ctx& c, int l) {
    if (c.tid == 0) { unsigned* p = (unsigned*)(c.ws + WS_CTL + CTL_HG) + l * 64; unsigned sp = 0;
        while (__hip_atomic_load(p, __ATOMIC_RELAXED, __HIP_MEMORY_SCOPE_AGENT) < (unsigned)c.G) { __builtin_amdgcn_s_sleep(1); if (++sp > (1u << 22)) break; }
        __builtin_amdgcn_fence(__ATOMIC_ACQUIRE, "agent"); ASMV("s_waitcnt vmcnt(0)" ::: "memory"); }
    __syncthreads();
}
__device__ __forceinline__ void ph_mixers(const Ctx& c, int l) {
    if (c.blk & 1) for (int bu = c.blk; bu < NBH * NCH / 4; bu += c.G) hgrn_mfma<false>(c, l, bu);
    for (int u = c.blk; u < NTOK / 32; u += c.G) mix_unit(c, l, u * 32);
    if (!(c.blk & 1)) for (int bu = c.blk; bu < NBH * NCH / 4; bu += c.G) hgrn_mfma<false>(c, l, bu);
}

template <bool FIXED>
__device__ __forceinline__ void attn_unit(const Ctx& c_, int bh, int qt, float negM) { const Ctx c = fresh(c_);
    const bf16_t* Qg = c.w<bf16_t>(WS_Q) + (size_t)bh * SEQ * 96; const bf16_t* Kg = c.w<bf16_t>(WS_K) + (size_t)bh * SEQ * 96; const bf16_t* Vg = c.w<bf16_t>(WS_VT) + (size_t)bh * 64 * SEQ;
    constexpr int KROW = 104, VROW = 72, KB = 64 * KROW * 2, VB = 64 * VROW * 2;
    const int l31 = c.lane & 31, hi = c.lane >> 5, qrow = qt * 256 + c.wid * 32 + l31;
    bf16x8 qf[6];
#pragma unroll
    for (int ks = 0; ks < 6; ++ks) qf[ks] = *(const bf16x8*)(Qg + (size_t)qrow * 96 + ks * 16 + hi * 8);
    f32x16 o0, o1;
#pragma unroll
    for (int r = 0; r < 16; ++r) { o0[r] = 0.f; o1[r] = 0.f; }
    float mrun = -INFINITY, lsum = 0.f; f32x2 lsum2 = {0.f, 0.f};
    const int nkt = 4 * (qt + 1), mylast = 4 * qt + (c.wid >> 1);
    const int kr0 = c.tid / 12, kc0 = c.tid % 12, kr1 = (c.tid + 512) / 12, kc1 = (c.tid + 512) % 12, vr = c.tid >> 3, vc = c.tid & 7;
    u32x4 sk0[2], sk1[2], sv[2];
    auto gload = [&](int j) {
#pragma unroll
        for (int h = 0; h < 2; ++h) { const int kt = 2 * j + h; sk0[h] = *(const u32x4*)(Kg + (size_t)(kt * 64 + kr0) * 96 + kc0 * 8); if (c.tid < 256) sk1[h] = *(const u32x4*)(Kg + (size_t)(kt * 64 + kr1) * 96 + kc1 * 8);
                               sv[h] = *(const u32x4*)(Vg + (size_t)vr * SEQ + kt * 64 + vc * 8); } };
    auto lstore = [&](int buf) {
#pragma unroll
        for (int h = 0; h < 2; ++h) { unsigned char* kb = c.lds + (buf * 2 + h) * (KB + VB); unsigned char* vb = kb + KB;
                                 *(u32x4*)(kb + (kr0 * KROW + kc0 * 8) * 2) = sk0[h]; if (c.tid < 256) *(u32x4*)(kb + (kr1 * KROW + kc1 * 8) * 2) = sk1[h]; *(u32x4*)(vb + (vr * VROW + vc * 8) * 2) = sv[h]; } };
    gload(0); lstore(0); __syncthreads();
    auto tile = [&](const int kt, auto masked) {
            const bf16_t* kb = (const bf16_t*)(c.lds + (kt & 3) * (KB + VB)); const bf16_t* vb = (const bf16_t*)(c.lds + (kt & 3) * (KB + VB) + KB);
            f32x16 s0, s1;
#pragma unroll
            for (int r = 0; r < 16; ++r) { s0[r] = FIXED ? negM : 0.f; s1[r] = FIXED ? negM : 0.f; }
#pragma unroll
            for (int ks = 0; ks < 6; ++ks) { const bf16x8 k0 = *(const bf16x8*)(kb + l31 * KROW + ks * 16 + hi * 8), k1 = *(const bf16x8*)(kb + (32 + l31) * KROW + ks * 16 + hi * 8);
                s0 = MFMA32(k0, qf[ks], s0); s1 = MFMA32(k1, qf[ks], s1); }
            if constexpr (decltype(masked)::value) {
#pragma unroll
                for (int r = 0; r < 16; ++r) { const int key = kt * 64 + (r & 3) + 8 * (r >> 2) + 4 * hi; if (key > qrow) s0[r] = -INFINITY; if (key + 32 > qrow) s1[r] = -INFINITY; } }
            if constexpr (FIXED) {
#pragma unroll
                for (int r = 0; r < 16; ++r) { s0[r] = __builtin_amdgcn_exp2f(s0[r]); s1[r] = __builtin_amdgcn_exp2f(s1[r]); }
#pragma unroll
                for (int r = 0; r < 16; r += 2) { lsum2 += (f32x2){s0[r], s0[r + 1]}; lsum2 += (f32x2){s1[r], s1[r + 1]}; }
            } else {
            float mx = s0[0];
#pragma unroll
            for (int r = 1; r < 16; ++r) mx = fmaxf(mx, s0[r]);
#pragma unroll
            for (int r = 0; r < 16; ++r) mx = fmaxf(mx, s1[r]);
            mx = fmaxf(mx, __shfl_xor(mx, 32));
            const float mnew = fmaxf(mrun, mx), alpha = __builtin_amdgcn_exp2f(mrun - mnew); mrun = mnew;
            float ps = 0.f;
#pragma unroll
            for (int r = 0; r < 16; ++r) { s0[r] = __builtin_amdgcn_exp2f(s0[r] - mnew); s1[r] = __builtin_amdgcn_exp2f(s1[r] - mnew); ps += s0[r] + s1[r]; }
            lsum = lsum * alpha + ps;
#pragma unroll
            for (int r = 0; r < 16; ++r) { o0[r] *= alpha; o1[r] *= alpha; }
            }
#pragma unroll
            for (int kf = 0; kf < 2; ++kf)
#pragma unroll
                for (int s = 0; s < 2; ++s) { const f32x16& sx = kf ? s1 : s0; u32x4 pw; pw.x = cvt_pk_bf16(sx[8 * s], sx[8 * s + 1]); pw.y = cvt_pk_bf16(sx[8 * s + 2], sx[8 * s + 3]); pw.z = cvt_pk_bf16(sx[8 * s + 4], sx[8 * s + 5]); pw.w = cvt_pk_bf16(sx[8 * s + 6], sx[8 * s + 7]);
                    const bf16x8 pf = __builtin_bit_cast(bf16x8, pw); const int kcol = kf * 32 + 16 * s + 4 * hi;
                    const s16x4 a0 = *(const s16x4*)(vb + l31 * VROW + kcol), a1 = *(const s16x4*)(vb + l31 * VROW + kcol + 8), b0 = *(const s16x4*)(vb + (32 + l31) * VROW + kcol), b1 = *(const s16x4*)(vb + (32 + l31) * VROW + kcol + 8);
                    const bf16x8 v0 = (bf16x8){a0[0], a0[1], a0[2], a0[3], a1[0], a1[1], a1[2], a1[3]}, v1 = (bf16x8){b0[0], b0[1], b0[2], b0[3], b1[0], b1[1], b1[2], b1[3]};
                    o0 = MFMA32(v0, pf, o0); o1 = MFMA32(v1, pf, o1); }
            };
    const int nkj = nkt >> 1, jl = mylast >> 1;
    int j = 0;
    for (; j < jl; ++j) { gload(j + 1); tile(2 * j, std::false_type{}); tile(2 * j + 1, std::false_type{}); lstore((j + 1) & 1); __syncthreads(); }
    { if (mylast & 1) { tile(2 * j, std::false_type{}); tile(2 * j + 1, std::true_type{}); } else tile(2 * j, std::true_type{});
      if (j + 1 < nkj) { gload(j + 1); lstore((j + 1) & 1); }
      __syncthreads(); ++j; }
    for (; j < nkj; ++j) { if (j + 1 < nkj) { gload(j + 1); lstore((j + 1) & 1); } __syncthreads(); }
    if constexpr (FIXED) lsum = lsum2[0] + lsum2[1];
    lsum += __shfl_xor(lsum, 32); const float rl = 1.0f / lsum;
    const int b = bh >> 2, h = bh & 3; bf16_t* yo = c.w<bf16_t>(WS_YB) + (size_t)(b * SEQ + qrow) * 1024 + h * 64;
#pragma unroll
    for (int g = 0; g < 4; ++g) { const int dv = 8 * g + 4 * hi; u32x2 w0, w1;
        w0.x = cvt_pk_bf16(o0[4 * g] * rl, o0[4 * g + 1] * rl); w0.y = cvt_pk_bf16(o0[4 * g + 2] * rl, o0[4 * g + 3] * rl); *(u32x2*)(yo + dv) = w0;
        w1.x = cvt_pk_bf16(o1[4 * g] * rl, o1[4 * g + 1] * rl); w1.y = cvt_pk_bf16(o1[4 * g + 2] * rl, o1[4 * g + 3] * rl); *(u32x2*)(yo + 32 + dv) = w1; }
    __syncthreads();
}
template <bool FIXED>
__device__ __forceinline__ void attn_units(const Ctx& c, float negM) {
    { const int NU = NBH * (NQT / 2);
      if ((c.G & 7) == 0) { const int per = (NU + 7) / 8, x = c.blk & 7, G8 = c.G >> 3;
          for (int j = c.blk >> 3; j < per; j += G8) { const int pu = x * per + j; if (pu < NU) { const int bh = pu / (NQT / 2), p = pu % (NQT / 2); attn_unit<FIXED>(c, bh, NQT - 1 - p, negM); attn_unit<FIXED>(c, bh, p, negM); } } }
      else for (int pu = c.blk; pu < NU; pu += c.G) { const int bh = pu / (NQT / 2), p = pu % (NQT / 2); attn_unit<FIXED>(c, bh, NQT - 1 - p, negM); attn_unit<FIXED>(c, bh, p, negM); } }
}
__device__ __forceinline__ void ph_attn(const Ctx& c, int l) {
    hgrn_carry(c, l);
    {
        const float* qg = c.inf(I_QG) + l * 96; const float* kg = c.inf(I_KG) + l * 96;
        int ln = c.lane; LAUNDER_V(ln);
        float gq = fmaxf(fabsf(qg[ln]), fabsf(qg[32 + (ln & 63)])), gk = fmaxf(fabsf(kg[ln]), fabsf(kg[32 + (ln & 63)]));
#pragma unroll
        for (int o = 1; o < 64; o <<= 1) { gq = fmaxf(gq, __shfl_xor(gq, o)); gk = fmaxf(gk, __shfl_xor(gk, o)); }
        const float M = 9.797958971132712f * 1.44269504089f * 1.02f * gq * gk;
        if (M <= 60.0f) attn_units<true>(c, -M); else attn_units<false>(c, 0.f); }
    hgrn_wait_carry(c, l);
    for (int bu = c.blk; bu < NBH * NCH / 4; bu += c.G) hgrn_mfma<true>(c, l, bu, l + 1);
}

__device__ __forceinline__ void ph_router(const Ctx& c_, int l, int cnt_off = 0) { const Ctx c = fresh(c_);
    bf16_t* Whi = (bf16_t*)c.lds; bf16_t* Wlo = (bf16_t*)(c.lds + 73728); float* Llog = (float*)(c.lds + 147456) + c.wid * 288; float* Lcb = (float*)(c.lds + 156672);
    int* Le = (int*)(c.lds + 156672 + 256); float* Lw = (float*)(c.lds + 156672 + 256 + 1024); int* Lr = (int*)(c.lds + 156672 + 256 + 2048); int* Lcnt = (int*)(c.lds + 156672 + 256 + 3072); int* Lbase = Lcnt + 32;
    const float* rwt = c.w<float>(WS_RWT + (size_t)(l & 1) * WSET);
    const float* rgb = c.inf(I_RGB) + l * 4; const float* reb = c.inf(I_REB) + l * 32;
    const bf16_t* x = c.w<bf16_t>(WS_XB); const float* gn = c.inf(I_N2G) + l * 1024; const float* mod = c.w<float>(WS_MOD) + (size_t)l * NB * 6144; bf16_t* ha = c.w<bf16_t>(WS_HA);
    unsigned* cnt = (unsigned*)(c.ws + WS_CTL + CTL_CNT) + l * 32 + cnt_off;
    int* rowtok = c.w<int>(WS_ROWTOK); float* roww = c.w<float>(WS_ROWW);
    const int fr = c.lane & 15, fq = c.lane >> 4;
    int staged_b = -1;
    for (int u = c.blk; u < NTOK / 128; u += c.G) {
        const int b = (u * 128) / SEQ; const float* sh = mod + b * 6144 + 3072; const float* sc = sh + 1024;
        __syncthreads();
        if (b != staged_b) { staged_b = b;
            for (int q = c.tid; q < 36 * 128; q += 512) { const int n = q >> 7, ch = q & 127, k0 = ch * 8; float hi8[8], lo8[8];
#pragma unroll
                for (int j = 0; j < 8; ++j) { const float w = rwt[n * 1024 + k0 + j] * gn[k0 + j] * (1.0f + sc[k0 + j]); const float h = bf2f((bf16_t)f2bf_bits(w)); hi8[j] = h; lo8[j] = w - h; }
                const int pc = (ch ^ (n & 15)) * 8; *(u32x4*)(Whi + n * 1024 + pc) = pk8(hi8); *(u32x4*)(Wlo + n * 1024 + pc) = pk8(lo8); }
            for (int g = c.wid; g < 36; g += 8) { float s = 0.f;
#pragma unroll
                for (int i = 0; i < 4; ++i) { const f32x4 w = *(const f32x4*)(rwt + g * 1024 + i * 256 + c.lane * 4), s4 = *(const f32x4*)(sh + i * 256 + c.lane * 4); s += w[0] * s4[0] + w[1] * s4[1] + w[2] * s4[2] + w[3] * s4[3]; }
                s = wave_sum(s); if (c.lane == 0) Lcb[g] = s + (g < 4 ? rgb[g] : reb[g - 4]); } }
        if (c.tid < 32) Lcnt[c.tid] = 0;
        __syncthreads();
        const int rowb = u * 128 + c.wid * 16; const bf16_t* xr = x + (size_t)(rowb + fr) * 1024 + 8 * fq;
        f32x4 acc[3] = {{0.f, 0.f, 0.f, 0.f}, {0.f, 0.f, 0.f, 0.f}, {0.f, 0.f, 0.f, 0.f}}; float ssp = 0.f;
#pragma unroll 8
        for (int ks = 0; ks < 32; ++ks) { const u32x4 hw = *(const u32x4*)(xr + 32 * ks);
            const unsigned hws[4] = {hw.x, hw.y, hw.z, hw.w};
#pragma unroll
            for (int j = 0; j < 4; ++j) { const float a = bflo(hws[j]), b = bfhi(hws[j]); ssp += a * a + b * b; }
            const bf16x8 ah = __builtin_bit_cast(bf16x8, hw);
            const int ch = 4 * ks + fq;
#pragma unroll
            for (int nf = 0; nf < 3; ++nf) { const int n = 16 * nf + fr; bf16x8 bh = {0, 0, 0, 0, 0, 0, 0, 0}, bl = bh;
                if (nf < 2 || fr < 4) { const int pc = (ch ^ (n & 15)) * 8; bh = *(const bf16x8*)(Whi + n * 1024 + pc); bl = *(const bf16x8*)(Wlo + n * 1024 + pc); }
                acc[nf] = MFMA16(ah, bh, acc[nf]); acc[nf] = MFMA16(ah, bl, acc[nf]); } }
        ssp += __shfl_xor(ssp, 16); ssp += __shfl_xor(ssp, 32);
        const float rinv = frsqrt(ssp * (1.0f / 1024.0f) + EPS);
        float rj[4];
#pragma unroll
        for (int j = 0; j < 4; ++j) rj[j] = __shfl(rinv, fq * 4 + j);
#pragma unroll
        for (int half = 0; half < 2; ++half) {
            if ((fq >> 1) == half) {
#pragma unroll
                for (int nf = 0; nf < 3; ++nf) { const int col = 16 * nf + fr; if (col < 36) {
#pragma unroll
                    for (int j = 0; j < 4; ++j) Llog[((fq & 1) * 4 + j) * 36 + col] = acc[nf][j] * rj[j] + Lcb[col]; } } }
            __builtin_amdgcn_wave_barrier();
            if (c.lane < 8) { const float* lg = Llog + c.lane * 36; const int rl = c.wid * 16 + half * 8 + c.lane;
                int gi = 0; float gm = lg[0];
#pragma unroll
                for (int g = 1; g < 4; ++g) { const float t = lg[g]; if (t > gm) { gm = t; gi = g; } }
                float den = 0.f;
#pragma unroll
                for (int g = 0; g < 4; ++g) den += expf(lg[g] - gm);
                const float gw = 1.0f / den;
                float e1 = -INFINITY, e2 = -INFINITY; int i1 = 0, i2 = 0;
#pragma unroll
                for (int j = 0; j < 8; ++j) { const float t = lg[4 + gi * 8 + j]; if (t > e1) { e2 = e1; i2 = i1; e1 = t; i1 = j; } else if (t > e2) { e2 = t; i2 = j; } }
                const float p2 = expf(e2 - e1), w1 = gw / (1.0f + p2), w2 = gw * p2 / (1.0f + p2);
                const int ea = gi * 8 + i1, eb = gi * 8 + i2; Le[rl * 2] = ea; Le[rl * 2 + 1] = eb; Lw[rl * 2] = w1; Lw[rl * 2 + 1] = w2;
                Lr[rl * 2] = atomicAdd(&Lcnt[ea], 1); Lr[rl * 2 + 1] = atomicAdd(&Lcnt[eb], 1); }
            __builtin_amdgcn_wave_barrier();
        }
#pragma unroll 8
        for (int ks = 0; ks < 32; ++ks) { const int k0 = 32 * ks + 8 * fq; const u32x4 xw = *(const u32x4*)(xr + 32 * ks); const f32x4 xa = {bflo(xw.x), bfhi(xw.x), bflo(xw.y), bfhi(xw.y)}, xb = {bflo(xw.z), bfhi(xw.z), bflo(xw.w), bfhi(xw.w)};
            const f32x4 ga = *(const f32x4*)(gn + k0) * (*(const f32x4*)(sc + k0) + 1.0f), gb = *(const f32x4*)(gn + k0 + 4) * (*(const f32x4*)(sc + k0 + 4) + 1.0f);
            const f32x4 ha4 = xa * rinv * ga + *(const f32x4*)(sh + k0), hb4 = xb * rinv * gb + *(const f32x4*)(sh + k0 + 4);
            u32x4 o; o.x = cvt_pk_bf16(ha4[0], ha4[1]); o.y = cvt_pk_bf16(ha4[2], ha4[3]); o.z = cvt_pk_bf16(hb4[0], hb4[1]); o.w = cvt_pk_bf16(hb4[2], hb4[3]);
            *(u32x4*)(ha + (size_t)(rowb + fr) * 1024 + k0) = o; }
        __syncthreads();
        if (c.tid < 32) Lbase[c.tid] = (int)__hip_atomic_fetch_add(&cnt[c.tid], (unsigned)Lcnt[c.tid], __ATOMIC_RELAXED, __HIP_MEMORY_SCOPE_AGENT);
        __syncthreads();
        if (c.tid < 256) { const int a = u * 256 + c.tid, e = Le[c.tid], dest = e * MOE_CAP + Lbase[e] + Lr[c.tid]; rowtok[dest] = a; roww[dest] = Lw[c.tid]; }
    }
    __syncthreads();
}
constexpr int LDS_MOETAB = 131072;
__device__ __forceinline__ void moe_tables(const Ctx& c_, int l) { const Ctx c = fresh(c_);
    int* tab = (int*)(c.lds + LDS_MOETAB); unsigned* cnt = (unsigned*)(c.ws + WS_CTL + CTL_CNT) + l * 32;
    __syncthreads();
    if (c.tid < 32) tab[c.tid] = (int)__hip_atomic_load(&cnt[c.tid], __ATOMIC_RELAXED, __HIP_MEMORY_SCOPE_AGENT);
    __syncthreads();
    if (c.tid == 0) { int acc = 0; for (int e = 0; e < 32; ++e) { tab[32 + e] = acc; acc += (tab[e] + 255) >> 8; } tab[64] = acc; }
    __syncthreads();
    if (c.tid < 32) for (int t2 = tab[32 + c.tid]; t2 < tab[33 + c.tid]; ++t2) tab[72 + t2] = c.tid;
    __syncthreads();
}
__device__ __forceinline__ void ph_final(const Ctx& c_) { const Ctx c = fresh(c_);
    float* out = c.a->out; const bf16_t* y1 = c.w<bf16_t>(WS_Y1);
    const bf16_t* xb = c.w<bf16_t>(WS_XB);
    for (size_t e = (size_t)c.blk * 512 + c.tid; e < (size_t)NTOK * 128; e += (size_t)c.G * 512) { const u32x4 y = *(const u32x4*)(y1 + e * 8), xw = *(const u32x4*)(xb + e * 8);
        *(f32x4*)(out + e * 8) = (f32x4){bflo(xw.x), bfhi(xw.x), bflo(xw.y), bfhi(xw.y)} + (f32x4){bflo(y.x), bfhi(y.x), bflo(y.y), bfhi(y.y)};
        *(f32x4*)(out + e * 8 + 4) = (f32x4){bflo(xw.z), bfhi(xw.z), bflo(xw.w), bfhi(xw.w)} + (f32x4){bflo(y.z), bfhi(y.z), bflo(y.w), bfhi(y.w)}; }
}

constexpr int PH_PER_LAYER = 8, N_PHASES = 2 + PH_PER_LAYER * NL + 1;
__global__ void __launch_bounds__(512, 2) mk_fwd(Args args) {
#ifdef EMU
    unsigned char* lds = emu_lds();
#else
    extern __shared__ __attribute__((aligned(16))) unsigned char lds[];
#endif
    Ctx c; c.a = &args; c.ws = args.ws; c.lds = lds; c.tid = threadIdx.x; c.wid = __builtin_amdgcn_readfirstlane(c.tid >> 6); c.lane = c.tid & 63; c.G = gridDim.x; c.blk = blockIdx.x;
    if (c.tid == 0) *(uint4*)(lds + LDS_XB) = make_uint4(0u, 0u, 0u, 0u);
    __syncthreads();
    XcdBarrier bar; bar.bar = (unsigned*)(args.ws + WS_CTL); bar.x = 0; bar.st = (volatile LAS unsigned*)(lds + LDS_XB);
    if (args.ph_hi - args.ph_lo > 1) bar = xcd_barrier_post((unsigned*)(args.ws + WS_CTL), (volatile LAS unsigned*)(lds + LDS_XB));
    int ph = 0;
#ifndef PHMASK
#define PHMASK 0xFFFFF
#endif
#define PHASE(K, ...) do { if (ph >= args.ph_lo && ph < args.ph_hi) { if constexpr ((PHMASK >> K) & 1) { __VA_ARGS__; } if (ph + 1 < args.ph_hi) xcd_barrier(bar); } ++ph; } while (0)
    PHASE(0, ph_prologue0(c));
    PHASE(1, ph_prologue1(c));
    for (int l = 0; l < NL; ++l) {
        PHASE(2, if (l == 0) ph_cvt(c, 0); ph_normrows(c, l));
        PHASE(3, { pg8::Gemm g{c.w<bf16_t>(WS_HA), c.w<bf16_t>(WS_WIN + (size_t)(l & 1) * WSET), NTOK, ZP, 1024}; pg8::TailNarrowOrder S; S.init(NTOK, c.G, c.blk); pg8::EpiBf16 E{c.w<bf16_t>(WS_Z), ZP};
                pg8::gemm_phase<pg8::EpiBf16, pg8::TailNarrowOrder, true, true>((LAS unsigned char*)lds, g, S, E); });
        PHASE(4, ph_mixers(c, l));
        PHASE(5, ph_attn(c, l));
        PHASE(6, { pg8::Gemm g{c.w<bf16_t>(WS_YB), c.w<bf16_t>(WS_WOUT + (size_t)(l & 1) * WSET), NTOK, 1024, 1024}; pg8::StaticOrder S; S.init(NTOK, 1024, c.G, c.blk);
                pg8::EpiResid E{(l == 0) ? c.inf(I_X) : (const float*)nullptr, c.w<bf16_t>(WS_XB), c.w<bf16_t>(WS_XB), c.w<float>(WS_MOD) + (size_t)l * NB * 6144 + 2048, 6144, SEQ, c.w<bf16_t>(WS_Y1)};
                pg8::gemm_phase<pg8::EpiResid, pg8::StaticOrder, true, true>((LAS unsigned char*)lds, g, S, E); });
        PHASE(7, ph_router(c, l));
        PHASE(9, { pg8::Gemm g{c.w<bf16_t>(WS_HA), c.w<bf16_t>(WS_WUP + (size_t)(l & 1) * WSET), NR, 32 * 1024, 1024}; moe_tables(c, l); pg8::MoeOrder S{(const LAS int*)((LAS unsigned char*)lds + LDS_MOETAB), MOE_CAP, c.G, c.blk}; pg8::EpiSwiglu E{c.w<bf16_t>(WS_Q)};
                pg8::gemm_phase<pg8::EpiSwiglu, pg8::MoeOrder, true, true, true>((LAS unsigned char*)lds, g, S, E, c.w<int>(WS_ROWTOK)); });
        PHASE(10, { pg8::Gemm g{c.w<bf16_t>(WS_Q), c.w<bf16_t>(WS_WDN + (size_t)(l & 1) * WSET), NR, 32 * 1024, 512}; if (MK_SPLIT) moe_tables(c, l);        pg8::MoeOrder S{(const LAS int*)((LAS unsigned char*)lds + LDS_MOETAB), MOE_CAP, c.G, c.blk};
                pg8::EpiDown E{c.w<int>(WS_ROWTOK), c.w<float>(WS_ROWW), c.w<bf16_t>(WS_XB), c.w<bf16_t>(WS_Y1), c.w<float>(WS_MOD) + (size_t)l * NB * 6144 + 5120, 6144, SEQ};
                pg8::gemm_phase<pg8::EpiDown, pg8::MoeOrder, true, true>((LAS unsigned char*)lds, g, S, E); });
    }
    PHASE(11, ph_final(c));
#undef PHASE
}

extern "C" void kernel_launch(void* const* d_in, const int* in_sizes, int n_in, void* d_out, int out_size, void* d_ws, size_t ws_size, hipStream_t stream) {
    static int grid = 0;
    if (grid == 0) {
        if (n_in != 30 || out_size != NTOK * 1024 || ws_size < WS_END) { fprintf(stderr, "kernel_launch: shape/workspace mismatch (n_in %d out %d ws %zu need %zu)\n", n_in, out_size, ws_size, (size_t)WS_END); grid = -1; return; }
        int dev = 0, cus = 0;
        if (hipGetDevice(&dev) != hipSuccess || hipDeviceGetAttribute(&cus, hipDeviceAttributeMultiprocessorCount, dev) != hipSuccess) { grid = -1; return; }
        if (hipFuncSetAttribute((const void*)mk_fwd, hipFuncAttributeMaxDynamicSharedMemorySize, LDS_BYTES) != hipSuccess) { fprintf(stderr, "kernel_launch: hipFuncSetAttribute failed\n"); grid = -1; return; }
        int per_cu = 0; (void)hipOccupancyMaxActiveBlocksPerMultiprocessor(&per_cu, (const void*)mk_fwd, 512, LDS_BYTES);
        if (per_cu < 1) fprintf(stderr, "kernel_launch: occupancy query says %d blocks per CU\n", per_cu);
        grid = cus;
    }
    if (grid < 0) return;
    (void)hipMemsetAsync((char*)d_ws + WS_CTL, 0, CTL_BYTES, stream);
    Args a{};
    for (int i = 0; i < 30; ++i) a.in[i] = d_in[i];
    a.out = (float*)d_out; a.ws = (unsigned char*)d_ws;
#if MK_SPLIT
    for (int p = 0; p < N_PHASES; ++p) { a.ph_lo = p; a.ph_hi = p + 1;
#else
    { a.ph_lo = 0; a.ph_hi = N_PHASES;
#endif
#ifdef EMU
        EMU_LAUNCH(mk_fwd, grid, 512, LDS_BYTES, stream, a);
#else
        hipLaunchKernelGGL(mk_fwd, dim3(grid), dim3(512), LDS_BYTES, stream, a);
#endif
    }
}
```

```cpp
#include <hip/hip_runtime.h>
#include <cstdio>
#include <cstdint>
#include <type_traits>

#ifndef CFG_B
#define CFG_B 4
#endif
#ifndef CFG_S
#define CFG_S 8192
#endif
#ifndef CFG_L
#define CFG_L 4
#endif
#ifndef MK_SPLIT
#define MK_SPLIT 0
#endif

#ifdef EMU
#define ASMV(...) ((void)0)
#define LAS
#define LAUNDER_V(x) ((void)0)
#define LAUNDER_S(x) ((void)0)
#else
#define ASMV(...) asm volatile(__VA_ARGS__)
#define LAS __attribute__((address_space(3)))
#define LAUNDER_V(x) asm volatile("" : "+v"(x))
#define LAUNDER_S(x) asm volatile("" : "+s"(x))
#endif

typedef unsigned short bf16_t;
typedef short bf16x8 __attribute__((ext_vector_type(8)));
typedef short s16x4 __attribute__((ext_vector_type(4)));
typedef float f32x2 __attribute__((ext_vector_type(2)));
typedef float f32x4 __attribute__((ext_vector_type(4)));
typedef float f32x16 __attribute__((ext_vector_type(16)));
typedef unsigned u32x4 __attribute__((ext_vector_type(4)));
typedef unsigned u32x2 __attribute__((ext_vector_type(2)));

__device__ __forceinline__ float bf2f(bf16_t h) { return __builtin_bit_cast(float, (unsigned)h << 16); }
__device__ __forceinline__ float bflo(unsigned w) { return __builtin_bit_cast(float, w << 16); }
__device__ __forceinline__ float bfhi(unsigned w) { return __builtin_bit_cast(float, w & 0xffff0000u); }
__device__ __forceinline__ unsigned f2bf_bits(float f) { unsigned u = __builtin_bit_cast(unsigned, f); u += 0x7fffu + ((u >> 16) & 1u); return u >> 16; }
#ifdef EMU
__device__ __forceinline__ unsigned cvt_pk_bf16(float lo, float hi) { return f2bf_bits(lo) | (f2bf_bits(hi) << 16); }
__device__ __forceinline__ unsigned cvt_pk_bf16_pinned(float lo, float hi) { return f2bf_bits(lo) | (f2bf_bits(hi) << 16); }
#else
typedef __bf16 bf16v2_t __attribute__((ext_vector_type(2)));
typedef float f32v2_t __attribute__((ext_vector_type(2)));
__device__ __forceinline__ unsigned cvt_pk_bf16(float lo, float hi) { const bf16v2_t r = __builtin_convertvector((f32v2_t){lo, hi}, bf16v2_t); return __builtin_bit_cast(unsigned, r); }
__device__ __forceinline__ unsigned cvt_pk_bf16_pinned(float lo, float hi) { unsigned r; asm volatile("v_cvt_pk_bf16_f32 %0, %1, %2\n\ts_nop 1" : "=v"(r) : "v"(lo), "v"(hi)); return r; }
#endif
__device__ __forceinline__ float fast_exp(float x) { return __builtin_amdgcn_exp2f(x * 1.44269504089f); }
__device__ __forceinline__ float fsigmoid(float x) { return __builtin_amdgcn_rcpf(1.0f + fast_exp(-x)); }
__device__ __forceinline__ float fsilu(float x) { return x * fsigmoid(x); }
__device__ __forceinline__ float frsqrt(float x) { return __builtin_amdgcn_rsqf(x); }
#ifdef EMU
__device__ __forceinline__ float wave_sum(float v) {
#pragma unroll
    for (int m = 32; m >= 1; m >>= 1) v += __shfl_xor(v, m);
    return v;
}
#else
template <int CTRL, int ROW_MASK> __device__ __forceinline__ float dpp_t(float v) { return __builtin_bit_cast(float, __builtin_amdgcn_update_dpp(0, __builtin_bit_cast(int, v), CTRL, ROW_MASK, 0xF, false)); }
#define dpp_f(v, ctrl, rm) dpp_t<ctrl, rm>(v)
__device__ __forceinline__ float wave_sum(float v) {
    v += dpp_f(v, 0xB1, 0xF);
    v += dpp_f(v, 0x4E, 0xF);
    v += dpp_f(v, 0x141, 0xF);
    v += dpp_f(v, 0x140, 0xF);
    v += dpp_f(v, 0x142, 0xA);
    v += dpp_f(v, 0x143, 0xC);
    return __builtin_bit_cast(float, __builtin_amdgcn_readlane(__builtin_bit_cast(int, v), 63));
}
__device__ __forceinline__ float half_sum(float v, int hi) {
    v += dpp_f(v, 0xB1, 0xF); v += dpp_f(v, 0x4E, 0xF); v += dpp_f(v, 0x141, 0xF); v += dpp_f(v, 0x140, 0xF);
    v += dpp_f(v, 0x142, 0xA);
    const float a = __builtin_bit_cast(float, __builtin_amdgcn_readlane(__builtin_bit_cast(int, v), 31)), b = __builtin_bit_cast(float, __builtin_amdgcn_readlane(__builtin_bit_cast(int, v), 63));
    return hi ? b : a;
}
#endif
#ifdef EMU
__device__ __forceinline__ float half_sum(float v, int) {
#pragma unroll
    for (int m = 1; m < 32; m <<= 1) v += __shfl_xor(v, m);
    return v;
}
#endif

namespace pg8 {
#define PG8_LAS LAS
constexpr int BM = 256, BK = 64, HALF = 128, HTB = HALF * BK * 2  , STAGE_BYTES = 8 * HTB, NXCD = 8, WGM = 8;

__host__ __device__ __forceinline__ int lds_byte(int r, int c) { const int st = (r >> 4) * 2 + (c >> 5), rr = r & 15, cc = c & 31, ob = rr * 64 + cc * 2; return st * 1024 + (ob ^ (((ob >> 9) & 1) << 5)); }
__host__ __device__ __forceinline__ void stage_rc(int b, int& R, int& C) { const int st = b / 1024, sb = b % 1024, swz = sb ^ (((sb >> 9) & 1) << 5); R = (st >> 1) * 16 + swz / 64; C = (st & 1) * 32 + (swz % 64) / 2; }
__host__ __device__ __forceinline__ int perm32(int rho) { const int n = rho >> 4, i = rho & 15; return 8 * (i >> 2) + 4 * n + (i & 3); }

struct Unit { int pm, pn, narrow, rbase, nvalid; };
struct Gemm { const bf16_t* A; const bf16_t* Bt; int M, N, K; };

struct StaticOrder {
    static constexpr bool HAS_NARROW = false;
    int nM, nN, nwg, G, c;
    __host__ __device__ void init(int M, int N, int G_, int c_) { nM = M / BM; nN = N / BM; nwg = nM * nN; G = G_; c = c_; }
    __host__ __device__ bool next(int i, Unit& u) const {
        const long L = (long)i * G + c; if (L >= nwg) return false;
        int wgid = (int)L; { const int q = nwg / NXCD, r = nwg % NXCD, xcd = wgid % NXCD, off = wgid / NXCD; wgid = (xcd < r ? xcd * (q + 1) : r * (q + 1) + (xcd - r) * q) + off; }
        const int nig = WGM * nN, gid = wgid / nig, fm = gid * WGM, gsz = (nM - fm) < WGM ? (nM - fm) : WGM;
        u.pm = fm + ((wgid % nig) % gsz); u.pn = (wgid % nig) / gsz; return true;
    }
    __device__ __forceinline__ void a_ready(const Unit&) const {}
    __device__ __forceinline__ void done(const Unit&) const {}
};
struct TailNarrowOrder {
    static constexpr bool HAS_NARROW = true;
    StaticOrder full; int nM, G, c;
    __host__ __device__ void init(int M, int G_, int c_) { nM = M / BM; G = G_; c = c_; full.init(M, 8 * BM, G_, c_); }
    __host__ __device__ bool next(int i, Unit& u) const { const long L = (long)i * G + c;
        if (L < full.nwg) { const bool ok = full.next(i, u); u.narrow = 0; return ok; }
        if (L >= full.nwg + nM) return false;
        u.pm = (int)(L - full.nwg); u.pn = 8; u.narrow = 1; return true; }
    __device__ __forceinline__ void a_ready(const Unit&) const {}
    __device__ __forceinline__ void done(const Unit&) const {}
};
template <class Epi, class Sched, bool ALIGN_EPI = false, bool SP2 = false, bool GATHER = false>
__device__ __forceinline__ void gemm_phase(PG8_LAS unsigned char* lds, const Gemm g, const Sched& S, const Epi& E, const int* rowmap = nullptr) {
    int tid = threadIdx.x; LAUNDER_V(tid); const int wid = __builtin_amdgcn_readfirstlane(tid >> 6), lane = tid & 63, wr = wid >> 2, wc = wid & 3, fr = lane & 15, fq = lane >> 4;
    const int K = g.K, nt = K / BK;
    unsigned voffA[2], voffB[2]; int RA[2], CA[2];
#pragma unroll
    for (int i = 0; i < 2; ++i) { int R, C; stage_rc(tid * 16 + i * 8192, R, C); const int Rb = Epi::PERM ? ((R & ~31) + perm32(R & 31)) : R;
        voffA[i] = (unsigned)(R * K + C) * 2u; voffB[i] = (unsigned)(Rb * K + C) * 2u; RA[i] = R; CA[i] = C; }
    const size_t kstep = (size_t)(BK * 2);
    const size_t hstep = (size_t)HALF * K * 2;
    const size_t tstep = 2 * hstep;
    const size_t hA = GATHER ? (size_t)0 : hstep;
    unsigned vA0[2], vA1[2], nA0[2], nA1[2];
    auto rows_of = [&](const Unit& u, unsigned (&o0)[2], unsigned (&o1)[2]) {
#pragma unroll
        for (int i = 0; i < 2; ++i) { if constexpr (GATHER) { int t0 = (RA[i] < u.nvalid) ? rowmap[u.rbase + RA[i]] : -1, t1 = (HALF + RA[i] < u.nvalid) ? rowmap[u.rbase + HALF + RA[i]] : -1; t0 = t0 < 0 ? 0 : (t0 >> 1); t1 = t1 < 0 ? 0 : (t1 >> 1);
                o0[i] = (unsigned)(t0 * K + CA[i]) * 2u; o1[i] = (unsigned)(t1 * K + CA[i]) * 2u; } else { o0[i] = voffA[i]; o1[i] = voffA[i]; } } };
    const unsigned ldsw = (unsigned)wid * 1024u;
    const int aoff = lds_byte(wr * 64 + fr, fq * 8), boff = lds_byte(wc * 32 + fr, fq * 8);
#define PG8_SA(b, h) (((b) * 2 + (h)) * HTB)
#define PG8_SB(b, h) ((4 + (b) * 2 + (h)) * HTB)
#define PG8_STAGE(bufoff, gbase, voff) do { _Pragma("unroll") for (int _i = 0; _i < 2; ++_i) \
        __builtin_amdgcn_global_load_lds((const unsigned*)((const char*)(gbase) + (voff)[_i]), (PG8_LAS unsigned*)(lds + (bufoff) + ldsw + _i * 8192), 16, 0, 0); } while (0)
#define PG8_LDA(dst, b, h) do { _Pragma("unroll") for (int m = 0; m < 4; ++m) _Pragma("unroll") for (int k = 0; k < 2; ++k) dst[m][k] = *(const PG8_LAS bf16x8*)(lds + PG8_SA(b, h) + aoff + m * 2048 + k * 1024); } while (0)
#define PG8_LDB(dst, b, h) do { _Pragma("unroll") for (int n = 0; n < 2; ++n) _Pragma("unroll") for (int k = 0; k < 2; ++k) dst[n][k] = *(const PG8_LAS bf16x8*)(lds + PG8_SB(b, h) + boff + n * 2048 + k * 1024); } while (0)
#define PG8_MMA(ai, bj, At, Bt) do { __builtin_amdgcn_s_setprio(1); _Pragma("unroll") for (int m = 0; m < 4; ++m) _Pragma("unroll") for (int n = 0; n < 2; ++n) _Pragma("unroll") for (int k = 0; k < 2; ++k) \
        acc[ai][bj][m][n] = __builtin_amdgcn_mfma_f32_16x16x32_bf16(Bt[n][k], At[m][k], acc[ai][bj][m][n], 0, 0, 0); __builtin_amdgcn_s_setprio(0); } while (0)
#define PG8_WAIT_V(n) ASMV("s_waitcnt vmcnt(" #n ")" ::: "memory")
#define PG8_WAIT_L(n) ASMV("s_waitcnt lgkmcnt(" #n ")" ::: "memory")
#define PG8_BAR __builtin_amdgcn_s_barrier()
#define PG8_SCHED __builtin_amdgcn_sched_barrier(0)
    Unit cur, nxt; int ui = 0;
    if (!S.next(0, cur)) return;
    f32x4 acc[2][2][4][2];
#pragma unroll
    for (int a = 0; a < 2; ++a)
#pragma unroll
        for (int b = 0; b < 2; ++b)
#pragma unroll
            for (int m = 0; m < 4; ++m)
#pragma unroll
                for (int n = 0; n < 2; ++n) acc[a][b][m][n] = (f32x4){0.f, 0.f, 0.f, 0.f};
    bf16x8 At[4][2], B0[2][2], B1[2][2];
    const char* cA = GATHER ? (const char*)g.A : (const char*)g.A + (size_t)cur.pm * tstep; rows_of(cur, vA0, vA1); const char* cB = (const char*)g.Bt + (size_t)cur.pn * tstep;
    typename Epi::Pre pre; E.prefetch(pre, cur, wr, fr);
    S.a_ready(cur);
    if constexpr (SP2) {
        PG8_STAGE(PG8_SB(0, 0), cB, voffB); PG8_STAGE(PG8_SB(0, 1), cB + hstep, voffB); PG8_STAGE(PG8_SA(0, 0), cA, vA0); PG8_STAGE(PG8_SA(0, 1), cA + hA, vA1);
        if (wr == 1) PG8_BAR;
        PG8_WAIT_V(2); PG8_BAR;
        PG8_STAGE(PG8_SB(1, 0), cB + kstep, voffB); PG8_STAGE(PG8_SA(1, 0), cA + kstep, vA0); PG8_STAGE(PG8_SB(1, 1), cB + hstep + kstep, voffB);
        PG8_WAIT_V(6); PG8_BAR;
    } else {
        PG8_STAGE(PG8_SB(0, 0), cB, voffB); PG8_STAGE(PG8_SA(0, 0), cA, vA0); PG8_STAGE(PG8_SB(0, 1), cB + hstep, voffB); PG8_STAGE(PG8_SA(0, 1), cA + hA, vA1);
        if (wr == 1) PG8_BAR;
        PG8_WAIT_V(4); PG8_BAR;
        PG8_STAGE(PG8_SB(1, 0), cB + kstep, voffB); PG8_STAGE(PG8_SA(1, 0), cA + kstep, vA0); PG8_STAGE(PG8_SB(1, 1), cB + hstep + kstep, voffB);
        PG8_WAIT_V(6); PG8_BAR;
    }
    for (;;) {
        const bool has_next = S.next(ui + 1, nxt);
        const char* nA = GATHER ? (const char*)g.A : (has_next ? (const char*)g.A + (size_t)nxt.pm * tstep : cA);
        if (has_next) rows_of(nxt, nA0, nA1); else { nA0[0] = vA0[0]; nA0[1] = vA0[1]; nA1[0] = vA1[0]; nA1[1] = vA1[1]; } const char* nB = has_next ? (const char*)g.Bt + (size_t)nxt.pn * tstep : cB;
        for (int t = 0; t < nt; t += 2) {
            const bool last = (t == nt - 2);
            unsigned sA0[2], sA1[2];
#pragma unroll
            for (int i = 0; i < 2; ++i) { sA0[i] = last ? nA0[i] : vA0[i]; sA1[i] = last ? nA1[i] : vA1[i]; }
            const char* a1 = cA + (size_t)(t + 1) * kstep;
            const char* a2 = last ? nA : cA + (size_t)(t + 2) * kstep; const char* b2 = last ? nB : cB + (size_t)(t + 2) * kstep;
            const char* a3 = a2 + kstep; const char* b3 = b2 + kstep;
            if (last && has_next) S.a_ready(nxt);
            if constexpr (SP2) {
            PG8_LDB(B0, 0, 0); PG8_LDB(B1, 0, 1); PG8_SCHED; PG8_LDA(At, 0, 0); PG8_STAGE(PG8_SA(1, 1), a1 + hA, vA1);
            PG8_WAIT_V(8); PG8_WAIT_L(0); PG8_BAR; PG8_MMA(0, 0, At, B0); if (!Sched::HAS_NARROW || !cur.narrow) PG8_MMA(0, 1, At, B1); PG8_BAR; PG8_SCHED;
            PG8_LDA(At, 0, 1); PG8_STAGE(PG8_SB(0, 0), b2, voffB); PG8_STAGE(PG8_SB(0, 1), b2 + hstep, voffB); PG8_STAGE(PG8_SA(0, 0), a2, sA0);
            PG8_WAIT_V(8); PG8_WAIT_L(0); PG8_BAR; PG8_MMA(1, 0, At, B0); if (!Sched::HAS_NARROW || !cur.narrow) PG8_MMA(1, 1, At, B1); PG8_BAR; PG8_SCHED;
            PG8_LDB(B0, 1, 0); PG8_LDB(B1, 1, 1); PG8_SCHED; PG8_LDA(At, 1, 0); PG8_STAGE(PG8_SA(0, 1), a2 + hA, sA1);
            PG8_WAIT_V(8); PG8_WAIT_L(0); PG8_BAR; PG8_MMA(0, 0, At, B0); if (!Sched::HAS_NARROW || !cur.narrow) PG8_MMA(0, 1, At, B1); PG8_BAR; PG8_SCHED;
            PG8_LDA(At, 1, 1); PG8_STAGE(PG8_SB(1, 0), b3, voffB); PG8_STAGE(PG8_SB(1, 1), b3 + hstep, voffB); PG8_STAGE(PG8_SA(1, 0), a3, sA0);
            PG8_WAIT_V(8); PG8_WAIT_L(0); PG8_BAR; PG8_MMA(1, 0, At, B0); if (!Sched::HAS_NARROW || !cur.narrow) PG8_MMA(1, 1, At, B1); PG8_BAR; PG8_SCHED;
            } else {
            PG8_LDB(B0, 0, 0); PG8_SCHED; PG8_LDA(At, 0, 0); PG8_STAGE(PG8_SA(1, 1), a1 + hA, vA1);
            PG8_WAIT_L(8); PG8_BAR; PG8_WAIT_L(0); PG8_MMA(0, 0, At, B0); PG8_BAR; PG8_SCHED;
            PG8_LDB(B1, 0, 1); PG8_STAGE(PG8_SB(0, 0), b2, voffB);
            PG8_BAR; PG8_WAIT_L(0); if (!Sched::HAS_NARROW || !cur.narrow) PG8_MMA(0, 1, At, B1); PG8_BAR;
            PG8_LDA(At, 0, 1); PG8_STAGE(PG8_SA(0, 0), a2, sA0);
            PG8_BAR; PG8_WAIT_L(0); PG8_MMA(1, 0, At, B0); PG8_BAR; PG8_SCHED;
            PG8_STAGE(PG8_SB(0, 1), b2 + hstep, voffB);
            PG8_WAIT_V(6); PG8_BAR; if (!Sched::HAS_NARROW || !cur.narrow) PG8_MMA(1, 1, At, B1); PG8_BAR;
            PG8_LDB(B0, 1, 0); PG8_SCHED; PG8_LDA(At, 1, 0); PG8_STAGE(PG8_SA(0, 1), a2 + hA, sA1);
            PG8_WAIT_L(8); PG8_BAR; PG8_WAIT_L(0); PG8_MMA(0, 0, At, B0); PG8_BAR; PG8_SCHED;
            PG8_LDB(B1, 1, 1); PG8_STAGE(PG8_SB(1, 0), b3, voffB);
            PG8_BAR; PG8_WAIT_L(0); if (!Sched::HAS_NARROW || !cur.narrow) PG8_MMA(0, 1, At, B1); PG8_BAR;
            PG8_LDA(At, 1, 1); PG8_STAGE(PG8_SA(1, 0), a3, sA0);
            PG8_BAR; PG8_WAIT_L(0); PG8_MMA(1, 0, At, B0); PG8_BAR; PG8_SCHED;
            PG8_STAGE(PG8_SB(1, 1), b3 + hstep, voffB);
            PG8_WAIT_V(6); PG8_BAR; if (!Sched::HAS_NARROW || !cur.narrow) PG8_MMA(1, 1, At, B1); PG8_BAR;
            }
        }
        if constexpr (ALIGN_EPI) { if (wr == 0) PG8_BAR; }
        if constexpr (!Epi::AFTER_DRAIN) { E(acc, cur, wr, wc, fr, fq, pre); S.done(cur); }
        if (!has_next) break;
#pragma unroll
        for (int a = 0; a < 2; ++a)
#pragma unroll
            for (int b = 0; b < 2; ++b)
#pragma unroll
                for (int m = 0; m < 4; ++m)
#pragma unroll
                    for (int n = 0; n < 2; ++n) acc[a][b][m][n] = (f32x4){0.f, 0.f, 0.f, 0.f};
        cur = nxt; cA = nA; cB = nB; ++ui; vA0[0] = nA0[0]; vA0[1] = nA0[1]; vA1[0] = nA1[0]; vA1[1] = nA1[1];
        E.prefetch(pre, cur, wr, fr);
        if constexpr (ALIGN_EPI) { if (wr == 1) PG8_BAR; }
    }
    PG8_WAIT_V(0);
    if constexpr (!ALIGN_EPI) { if (wr == 0) PG8_BAR; }
    PG8_BAR;
    if constexpr (Epi::AFTER_DRAIN) { E.fused(acc, cur, wr, wc, fr, fq, lds, wid, lane); S.done(cur); }
#undef PG8_SA
#undef PG8_SB
#undef PG8_STAGE
#undef PG8_LDA
#undef PG8_LDB
#undef PG8_MMA
#undef PG8_WAIT_V
#undef PG8_WAIT_L
#undef PG8_BAR
#undef PG8_SCHED
}

struct EpiBf16 {
    static constexpr bool PERM = true, AFTER_DRAIN = false;
    bf16_t* O; int ldc;
    struct Pre {}; __device__ __forceinline__ void prefetch(Pre&, const Unit&, int, int) const {}
    __device__ __forceinline__ void operator()(const f32x4 (&acc)[2][2][4][2], const Unit& u, int wr, int wc, int fr, int fq, const Pre&) const {
        const int row0 = u.pm * BM + wr * 64 + fr, col0 = u.pn * BM + wc * 32 + 8 * fq;
#pragma unroll
        for (int ai = 0; ai < 2; ++ai)
#pragma unroll
            for (int m = 0; m < 4; ++m) { bf16_t* rowp = O + (size_t)(row0 + ai * HALF + m * 16) * ldc + col0;
#pragma unroll
                for (int bj = 0; bj < 2; ++bj) { const f32x4 v0 = acc[ai][bj][m][0], v1 = acc[ai][bj][m][1];
                    u32x4 w; w.x = cvt_pk_bf16(v0[0], v0[1]); w.y = cvt_pk_bf16(v0[2], v0[3]); w.z = cvt_pk_bf16(v1[0], v1[1]); w.w = cvt_pk_bf16(v1[2], v1[3]);
                    *(u32x4*)(rowp + bj * HALF) = w; } }
    }
};
struct EpiResid {
    static constexpr bool PERM = true, AFTER_DRAIN = false;
    const float* xin; const bf16_t* xinb; bf16_t* xout; const float* gate; int gstride; int seq; const bf16_t* y1;
    struct Pre {}; __device__ __forceinline__ void prefetch(Pre&, const Unit&, int, int) const {}
    __device__ __forceinline__ void operator()(const f32x4 (&acc)[2][2][4][2], const Unit& u, int wr, int wc, int fr, int fq, const Pre&) const {
        const int row0 = u.pm * BM + wr * 64 + fr, col0 = u.pn * BM + wc * 32 + 8 * fq;
#pragma unroll
        for (int ai = 0; ai < 2; ++ai)
#pragma unroll
            for (int m = 0; m < 4; ++m) { const int row = row0 + ai * HALF + m * 16; const float* gp = gate + (size_t)(row / seq) * gstride;
#pragma unroll
                for (int bj = 0; bj < 2; ++bj) { const int c = col0 + bj * HALF; const size_t o = (size_t)row * 1024 + c;
                    const f32x4 g0 = *(const f32x4*)(gp + c), g1 = *(const f32x4*)(gp + c + 4);
                    f32x4 x0, x1;
                    if (xin) { x0 = *(const f32x4*)(xin + o); x1 = *(const f32x4*)(xin + o + 4); }
                    else { const u32x4 xw = *(const u32x4*)(xinb + o), y = *(const u32x4*)(y1 + o);
                        x0 = (f32x4){bflo(xw.x), bfhi(xw.x), bflo(xw.y), bfhi(xw.y)} + (f32x4){bflo(y.x), bfhi(y.x), bflo(y.y), bfhi(y.y)};
                        x1 = (f32x4){bflo(xw.z), bfhi(xw.z), bflo(xw.w), bfhi(xw.w)} + (f32x4){bflo(y.z), bfhi(y.z), bflo(y.w), bfhi(y.w)}; }
                    x0 += g0 * acc[ai][bj][m][0]; x1 += g1 * acc[ai][bj][m][1];
                    u32x4 w; w.x = cvt_pk_bf16(x0[0], x0[1]); w.y = cvt_pk_bf16(x0[2], x0[3]); w.z = cvt_pk_bf16(x1[0], x1[1]); w.w = cvt_pk_bf16(x1[2], x1[3]);
                    *(u32x4*)(xout + o) = w; } }
    }
};
struct EpiSwiglu {
    static constexpr bool PERM = true, AFTER_DRAIN = false;
    bf16_t* HB;
    struct Pre {}; __device__ __forceinline__ void prefetch(Pre&, const Unit&, int, int) const {}
    __device__ __forceinline__ void operator()(const f32x4 (&acc)[2][2][4][2], const Unit& u, int wr, int wc, int fr, int fq, const Pre&) const {
        const int row0 = u.pm * BM + wr * 64 + fr, col0 = (u.pn & 3) * 128 + wc * 32 + 8 * fq;
#pragma unroll
        for (int ai = 0; ai < 2; ++ai)
#pragma unroll
            for (int m = 0; m < 4; ++m) { bf16_t* p = HB + (size_t)(row0 + ai * HALF + m * 16) * 512 + col0;
                float h[8];
#pragma unroll
                for (int n = 0; n < 2; ++n)
#pragma unroll
                    for (int k = 0; k < 4; ++k) h[n * 4 + k] = fsilu(acc[ai][0][m][n][k]) * acc[ai][1][m][n][k];
                u32x4 w; w.x = cvt_pk_bf16(h[0], h[1]); w.y = cvt_pk_bf16(h[2], h[3]); w.z = cvt_pk_bf16(h[4], h[5]); w.w = cvt_pk_bf16(h[6], h[7]);
                *(u32x4*)p = w; }
    }
};
struct EpiDown {
    static constexpr bool PERM = true, AFTER_DRAIN = false;
    const int* row_tok; const float* row_w; bf16_t* x; bf16_t* y1; const float* gate; int gstride; int seq;
    struct Pre { int ts[8]; };
    __device__ __forceinline__ void prefetch(Pre& p, const Unit& u, int wr, int fr) const {
#pragma unroll
        for (int ai = 0; ai < 2; ++ai)
#pragma unroll
            for (int m = 0; m < 4; ++m) { const int lr = wr * 64 + fr + ai * HALF + m * 16; p.ts[ai * 4 + m] = (lr < u.nvalid) ? row_tok[u.rbase + lr] : -1; } }
    __device__ __forceinline__ void operator()(const f32x4 (&acc)[2][2][4][2], const Unit& u, int wr, int wc, int fr, int fq, const Pre& pre) const {
        const int col0 = (u.pn & 3) * BM + wc * 32 + 8 * fq;
#pragma unroll
        for (int ai = 0; ai < 2; ++ai)
#pragma unroll
            for (int m = 0; m < 4; ++m) { const int ts = pre.ts[ai * 4 + m];
                if (ts >= 0) { const int tok = ts >> 1; const float w = row_w[u.rbase + wr * 64 + fr + ai * HALF + m * 16]; const float* gp = gate + (size_t)(tok / seq) * gstride;
#pragma unroll
                    for (int bj = 0; bj < 2; ++bj) { const int c = col0 + bj * HALF; const size_t o = (size_t)tok * 1024 + c;
                        const f32x4 v0 = acc[ai][bj][m][0] * (*(const f32x4*)(gp + c)) * w, v1 = acc[ai][bj][m][1] * (*(const f32x4*)(gp + c + 4)) * w;
                        if (ts & 1) { u32x4 q; q.x = cvt_pk_bf16(v0[0], v0[1]); q.y = cvt_pk_bf16(v0[2], v0[3]); q.z = cvt_pk_bf16(v1[0], v1[1]); q.w = cvt_pk_bf16(v1[2], v1[3]); *(u32x4*)(y1 + o) = q; }
                        else { const u32x4 xw = *(const u32x4*)(x + o); const f32x4 s0 = (f32x4){bflo(xw.x), bfhi(xw.x), bflo(xw.y), bfhi(xw.y)} + v0, s1 = (f32x4){bflo(xw.z), bfhi(xw.z), bflo(xw.w), bfhi(xw.w)} + v1;
                            u32x4 q; q.x = cvt_pk_bf16(s0[0], s0[1]); q.y = cvt_pk_bf16(s0[2], s0[3]); q.z = cvt_pk_bf16(s1[0], s1[1]); q.w = cvt_pk_bf16(s1[2], s1[3]); *(u32x4*)(x + o) = q; } } } }
    }
};
struct MoeOrder {
    static constexpr bool HAS_NARROW = false;
    const PG8_LAS int* tab; int cap, G, c;
    __device__ __forceinline__ bool next(int i, Unit& u) const { const int v = ((G & 7) == 0) ? (c & 7) * (G >> 3) + (c >> 3) : c; const int L = i * G + v, nt = tab[64]; if (L >= nt * 4) return false;
        const int pm = L >> 2, e = tab[72 + pm], j = pm - tab[32 + e], nv = tab[e] - j * BM; u.pm = pm; u.pn = e * 4 + (L & 3); u.rbase = e * cap + j * BM; u.nvalid = nv > BM ? BM : nv; return true; }
    __device__ __forceinline__ void a_ready(const Unit&) const {}
    __device__ __forceinline__ void done(const Unit&) const {}
};
}

constexpr int NB = CFG_B, SEQ = CFG_S, NL = CFG_L, NTOK = NB * SEQ, DM = 1024, ZP = 2304;
constexpr int NBH = NB * 4, NCH = SEQ / 128, NQT = SEQ / 256;
constexpr int NR = 2 * NTOK + 32 * 256;
constexpr int Z_CQ = 0, Z_CKV = 192, Z_KR = 320, Z_POOL = 352, Z_HQ = 608, Z_HF = 864, Z_HI = 1120, Z_HG = 1376, Z_CA = 1632, Z_CG = 1888;
constexpr float EPS = 1e-6f;
static_assert(SEQ % 256 == 0 && NTOK % 256 == 0 && (NQT % 2) == 0, "shape");
constexpr size_t al256(size_t x) { return (x + 255) & ~(size_t)255; }
constexpr size_t cmax(size_t a, size_t b) { return a > b ? a : b; }
constexpr size_t WS_CTL = 0, CTL_BYTES = 65536;
constexpr size_t CTL_CNT = 16384;
constexpr size_t CTL_HG = 32768;
constexpr size_t WS_MODP = WS_CTL + CTL_BYTES;
constexpr size_t WS_MOD = WS_MODP + al256((size_t)16 * NL * NB * 6144 * 4);
constexpr size_t WS_LB = WS_MOD + al256((size_t)NL * NB * 6144 * 4);
constexpr size_t WS_ROPE = WS_LB + al256((size_t)NL * 256 * 4);
constexpr size_t WS_WIN = WS_ROPE + al256((size_t)NTOK * 32 * 4);
constexpr size_t WS_WOUT = WS_WIN + (size_t)ZP * 1024 * 2;
constexpr size_t WS_WUQ = WS_WOUT + (size_t)1024 * 1024 * 2;
constexpr size_t WS_WUKV = WS_WUQ + al256((size_t)384 * 192 * 2);
constexpr size_t WS_WPOOL = WS_WUKV + al256((size_t)512 * 128 * 2);
constexpr size_t WS_WUP = WS_WPOOL + al256((size_t)4 * 64 * 64 * 2);
constexpr size_t WS_WDN = WS_WUP + (size_t)32 * 1024 * 1024 * 2;
constexpr size_t WS_RWT = WS_WDN + (size_t)32 * 1024 * 512 * 2;
constexpr size_t WSET = WS_RWT + 36 * 1024 * 4 - WS_WIN;
constexpr size_t WS_HA = WS_WIN + 2 * WSET;
constexpr size_t WS_Z = WS_HA + (size_t)NTOK * 1024 * 2;
constexpr size_t Z_BYTES = cmax((size_t)NTOK * ZP * 2, (size_t)NR * 1024 * 2);
constexpr size_t WS_Q = WS_Z + Z_BYTES;
constexpr size_t WS_K = WS_Q + (size_t)NTOK * 4 * 96 * 2;
constexpr size_t WS_VT = WS_K + (size_t)NTOK * 4 * 96 * 2;
constexpr size_t WS_YB = WS_VT + (size_t)NTOK * 4 * 64 * 2;
constexpr size_t R2_BYTES = cmax(WS_YB + (size_t)NTOK * 1024 * 2 - WS_Q, (size_t)NR * 512 * 2);
constexpr size_t WS_Y1 = WS_Q + R2_BYTES;
constexpr size_t WS_SC = WS_Y1 + (size_t)NTOK * 1024 * 2;
constexpr size_t WS_PC = WS_SC + (size_t)NBH * NCH * 4096 * 4;
constexpr size_t WS_S0 = WS_PC + al256((size_t)NBH * NCH * 64 * 4);
constexpr size_t WS_ASGE = WS_S0 + (size_t)NBH * NCH * 4096 * 4;
constexpr size_t WS_ASGR = WS_ASGE + (size_t)NTOK * 8;
constexpr size_t WS_ASGW = WS_ASGR + (size_t)NTOK * 8;
constexpr int MOE_CAP = NTOK;
constexpr size_t WS_ROWTOK = WS_ASGW + (size_t)NTOK * 8;
constexpr size_t WS_ROWW = WS_ROWTOK + (size_t)32 * MOE_CAP * 4;
constexpr size_t WS_TILE = WS_ROWW + (size_t)32 * MOE_CAP * 4;
constexpr size_t WS_XB = WS_TILE + al256((size_t)(NR / 256 + 16) * 4);
constexpr size_t WS_END = WS_XB + (size_t)NTOK * 1024 * 2;
constexpr int LDS_BYTES = 160 * 1024;
constexpr int LDS_XB = LDS_BYTES - 16;

#define XB_TMO      128
#define XB_XCNT(j)  (256  + 64 * (j))
#define XB_XSUB(j)  (1280 + 64 * (j))
#define XB_XGEN(j)  (2304 + 64 * (j))
#define XB_TOP      3328
#define XB_TOPGEN   3392
#define XCD_BAR_WORDS 3456
#define XB_SPIN_CAP (1u << 18)
__device__ __forceinline__ unsigned xb_ld(unsigned* p)              { return __hip_atomic_load(p, __ATOMIC_RELAXED, __HIP_MEMORY_SCOPE_AGENT); }
__device__ __forceinline__ unsigned xb_add(unsigned* p, unsigned v) { return __hip_atomic_fetch_add(p, v, __ATOMIC_RELAXED, __HIP_MEMORY_SCOPE_AGENT); }
__device__ __forceinline__ unsigned xb_xcc_id() { return (unsigned)__builtin_amdgcn_s_getreg((3 << 11) | 20) & 0xFu; }
#define XB_SPIN(cond, bar) do { unsigned _sp = 0; while (cond) { __builtin_amdgcn_s_sleep(1); \
    if ((++_sp & 255u) == 0u) { if (xb_ld(&(bar)[XB_TMO])) break; if (_sp > XB_SPIN_CAP) { atomicAdd(&(bar)[XB_TMO], 1u); break; } } } } while (0)
struct XcdBarrier { unsigned* bar; unsigned x; volatile LAS unsigned* st; };
__device__ __forceinline__ XcdBarrier xcd_barrier_post(unsigned* bar, volatile LAS unsigned* st) {
    XcdBarrier b; b.bar = bar; b.x = xb_xcc_id(); b.st = st;
    if (threadIdx.x == 0) (void)xb_add(&bar[XB_XCNT(b.x)], 1u);
    return b;
}
__device__ __forceinline__ void xcd_barrier_complete(unsigned* bar, unsigned x, unsigned& nloc, unsigned& nx) {
    const unsigned G = gridDim.x * gridDim.y * gridDim.z;
    unsigned sum, cnt, mine, sp = 0u;
    for (;;) {
        sum = 0u; cnt = 0u; mine = 0u;
#pragma unroll
        for (unsigned j = 0; j < 16; ++j) { const unsigned c = xb_ld(&bar[XB_XCNT(j)]); sum += c; cnt += (c > 0u) ? 1u : 0u; mine = (j == x) ? c : mine; }
        if (sum == G) break;
        __builtin_amdgcn_s_sleep(1);
        if ((++sp & 255u) == 0u) { if (xb_ld(&bar[XB_TMO])) break; if (sp > XB_SPIN_CAP) { atomicAdd(&bar[XB_TMO], 1u); break; } }
    }
    nloc = mine > 0u ? mine : 1u; nx = cnt > 0u ? cnt : 1u;
}
__device__ __forceinline__ void xcd_barrier(const XcdBarrier& b) {
    ASMV("s_waitcnt vmcnt(0)" ::: "memory");
    __syncthreads();
    if (threadIdx.x == 0) {
        unsigned* bar = b.bar;
        __builtin_amdgcn_s_waitcnt(0);
        unsigned nloc = b.st[0], nx = b.st[1];
        if (nloc == 0u) { xcd_barrier_complete(bar, b.x, nloc, nx); b.st[0] = nloc; b.st[1] = nx; }
        const unsigned old = xb_add(&bar[XB_XSUB(b.x)], 1u);
        const unsigned gen = old / nloc;
        if (old + 1u == (gen + 1u) * nloc) {
            __builtin_amdgcn_fence(__ATOMIC_RELEASE, "agent");
            ASMV("s_waitcnt vmcnt(0)" ::: "memory");
            const unsigned og = xb_add(&bar[XB_TOP], 1u);
            const unsigned tg = og / nx;
            if (og + 1u == (tg + 1u) * nx) xb_add(&bar[XB_TOPGEN], 1u);
            else XB_SPIN(xb_ld(&bar[XB_TOPGEN]) == tg, bar);
            __builtin_amdgcn_fence(__ATOMIC_ACQUIRE, "agent");
            xb_add(&bar[XB_XGEN(b.x)], 1u);
            ASMV("s_waitcnt vmcnt(0)" ::: "memory");
        } else {
            XB_SPIN(xb_ld(&bar[XB_XGEN(b.x)]) == gen, bar);
            __builtin_amdgcn_fence(__ATOMIC_ACQUIRE, "agent");
            ASMV("s_waitcnt vmcnt(0)" ::: "memory");
        }
    }
    __syncthreads();
}

struct Args { const void* in[30]; float* out; unsigned char* ws; int ph_lo, ph_hi; };
enum { I_X = 0, I_C, I_POS, I_WADA, I_BADA, I_N1G, I_N2G, I_WIN, I_QAG, I_WUQ, I_KVAG, I_WUKV, I_QG, I_KG, I_WPOOL, I_PSCALE, I_LBL, I_HOG, I_DWW, I_DWB, I_LNG, I_LNB,
       I_WOUT, I_RGW, I_RGB, I_REW, I_REB, I_W1, I_W3, I_W2 };
struct Ctx {
    const Args* a; unsigned char* ws; unsigned char* lds; int tid, wid, lane, G, blk;
    __device__ __forceinline__ const float* inf(int i) const { return (const float*)a->in[i]; }
    template <class T> __device__ __forceinline__ T* w(size_t off) const { return (T*)(ws + off); }
};

__device__ __forceinline__ Ctx fresh(const Ctx& c0) { Ctx c = c0; LAUNDER_V(c.tid); LAUNDER_V(c.lane); LAUNDER_S(c.wid); return c; }
__device__ __forceinline__ void ph_prologue0(const Ctx& c_) { const Ctx c = fresh(c_);
    const float* cc = c.inf(I_C); const float* wada = c.inf(I_WADA); float* modp = c.w<float>(WS_MODP);
    for (int u = c.blk; u < NL * 16 * 12; u += c.G) {
        const int l = u / 192, r = u % 192, ic = r / 12, jb = r % 12, j = jb * 512 + c.tid;
        float* Ls = (float*)c.lds;
        __syncthreads();
        if (c.tid < NB * 64) Ls[c.tid] = fsilu(cc[(c.tid >> 6) * 1024 + ic * 64 + (c.tid & 63)]);
        __syncthreads();
        float acc[NB];
#pragma unroll
        for (int b = 0; b < NB; ++b) acc[b] = 0.f;
        const float* wp = wada + ((size_t)l * 1024 + ic * 64) * 6144 + j;
#pragma unroll
        for (int i0 = 0; i0 < 64; i0 += 16) { float wv[16];
#pragma unroll
            for (int i = 0; i < 16; ++i) wv[i] = wp[(size_t)(i0 + i) * 6144];
#pragma unroll
            for (int i = 0; i < 16; ++i)
#pragma unroll
                for (int b = 0; b < NB; ++b) acc[b] += Ls[b * 64 + i0 + i] * wv[i]; }
#pragma unroll
        for (int b = 0; b < NB; ++b) modp[(((size_t)ic * NL + l) * NB + b) * 6144 + j] = acc[b];
    }
    const int* pos = (const int*)c.a->in[I_POS]; float* rc = c.w<float>(WS_ROPE); float* rs = rc + (size_t)NTOK * 16;
    for (int e = c.blk * 512 + c.tid; e < NTOK * 16; e += c.G * 512) { const int t = e >> 4, i = e & 15;
        const float inv = exp2f(-(float)i * (13.287712379549449f / 16.0f));
        const float ang = (float)pos[t] * inv; rc[e] = cosf(ang); rs[e] = sinf(ang); }
    if (c.blk == 0 && c.tid < 256) { const float* lg = c.inf(I_LBL); float* lb = c.w<float>(WS_LB); float mx = -1e30f;
        for (int l = 0; l < NL; ++l) mx = fmaxf(mx, lg[l * 256 + c.tid]);
        float den = 0.f; for (int l = 0; l < NL; ++l) den += expf(lg[l * 256 + c.tid] - mx);
        float cum = 0.f, first = 0.f; for (int l = 0; l < NL; ++l) { cum += expf(lg[l * 256 + c.tid] - mx) / den; if (l == 0) first = cum; lb[l * 256 + c.tid] = cum - first; } }
}
__device__ __forceinline__ void ph_prologue1(const Ctx& c_) { const Ctx c = fresh(c_);
    const float* modp = c.w<float>(WS_MODP); float* mod = c.w<float>(WS_MOD); const float* bada = c.inf(I_BADA);
    for (int e = c.blk * 512 + c.tid; e < NL * NB * 6144; e += c.G * 512) { const int j = e % 6144, l = e / (NB * 6144);
        float s = bada[l * 6144 + j];
#pragma unroll
        for (int ic = 0; ic < 16; ++ic) s += modp[(size_t)ic * NL * NB * 6144 + e];
        mod[e] = s; }
}

__device__ __forceinline__ void ld8bf(const bf16_t* p, float (&o)[8]) { const u32x4 v = *(const u32x4*)p; o[0] = bflo(v.x); o[1] = bfhi(v.x); o[2] = bflo(v.y); o[3] = bfhi(v.y); o[4] = bflo(v.z); o[5] = bfhi(v.z); o[6] = bflo(v.w); o[7] = bfhi(v.w); }
__device__ __forceinline__ u32x4 pk8(const float (&o)[8]) { u32x4 w; w.x = cvt_pk_bf16(o[0], o[1]); w.y = cvt_pk_bf16(o[2], o[3]); w.z = cvt_pk_bf16(o[4], o[5]); w.w = cvt_pk_bf16(o[6], o[7]); return w; }
__device__ __forceinline__ u32x4 pk8p(const float (&o)[8]) { u32x4 w; w.x = cvt_pk_bf16_pinned(o[0], o[1]); w.y = cvt_pk_bf16_pinned(o[2], o[3]); w.z = cvt_pk_bf16_pinned(o[4], o[5]); w.w = cvt_pk_bf16_pinned(o[6], o[7]); return w; }
__device__ __forceinline__ void cvt_tile(const Ctx& c, const float* src, int ldn, int nlim, int k0, int n0, bf16_t* dst, int ldk, int drow0) {
    float* T = (float*)c.lds;
#pragma unroll
    for (int i = 0; i < 8; ++i) { const int e = c.tid + 512 * i, kk = e >> 6, nn = e & 63; T[kk * 65 + nn] = (n0 + nn < nlim) ? src[(size_t)(k0 + kk) * ldn + n0 + nn] : 0.f; }
    __syncthreads();
#pragma unroll
    for (int i = 0; i < 4; ++i) { const int e = c.tid + 512 * i, nn = e >> 5, k2 = e & 31;
        *(unsigned*)(dst + (size_t)(drow0 + nn) * ldk + k0 + 2 * k2) = cvt_pk_bf16(T[(2 * k2) * 65 + nn], T[(2 * k2 + 1) * 65 + nn]); }
    __syncthreads();
}
__device__ __forceinline__ void cvt_big(const Ctx& c, const float* src, int ldn, int nlim, int k0, int n0, bf16_t* dst, int ldk, int mode) {
    float* T = (float*)c.lds;
    f32x4 v[8];
#pragma unroll
    for (int i = 0; i < 8; ++i) { const int e4 = c.tid + 512 * i, kk = e4 >> 6, n4 = e4 & 63; v[i] = (n0 + n4 * 4 < nlim) ? *(const f32x4*)(src + (size_t)(k0 + kk) * ldn + n0 + n4 * 4) : (f32x4){0.f, 0.f, 0.f, 0.f}; }
#pragma unroll
    for (int i = 0; i < 8; ++i) { const int e4 = c.tid + 512 * i, kk = e4 >> 6, n4 = e4 & 63; float* p = T + kk * 261 + n4 * 4; p[0] = v[i][0]; p[1] = v[i][1]; p[2] = v[i][2]; p[3] = v[i][3]; }
    __syncthreads();
#pragma unroll
    for (int i = 0; i < 4; ++i) { const int e = c.tid + 512 * i, k8 = e & 7, nn = e >> 3, n = n0 + nn; float o[8];
#pragma unroll
        for (int j = 0; j < 8; ++j) o[j] = T[(8 * k8 + j) * 261 + nn];
        const int row = (mode == 0) ? n : ((n >> 7) * 256 + (mode - 1) * 128 + (n & 127));
        *(u32x4*)(dst + (size_t)row * ldk + k0 + 8 * k8) = pk8(o); }
    __syncthreads();
}
constexpr int CT_IN = 16 * 9, CT_OUT = 16 * 4, CT_W13 = 32 * 16 * 2, CT_W2 = 32 * 8 * 4, CT_UQ = 3 * 6, CT_UKV = 2 * 8, CT_POOL = 4;
constexpr int CT_TOTAL = CT_IN + CT_OUT + 2 * CT_W13 + CT_W2 + CT_UQ + CT_UKV + CT_POOL;
__device__ __forceinline__ void ph_cvt(const Ctx& c_, int l) { const Ctx c = fresh(c_);
    { const float* rgw = c.inf(I_RGW) + (size_t)l * 1024 * 4; const float* rew = c.inf(I_REW) + (size_t)l * 1024 * 32; float* rwt = c.w<float>(WS_RWT + (size_t)(l & 1) * WSET);
        for (int e = c.blk * 512 + c.tid; e < 36 * 1024; e += c.G * 512) { const int g = e >> 10, k = e & 1023; rwt[e] = (g < 4) ? rgw[k * 4 + g] : rew[k * 32 + g - 4]; } }
    for (int t = c.blk; t < CT_TOTAL; t += c.G) {
        int r = t;
        if (r < 2 * CT_W13) { const int which = r / CT_W13; r %= CT_W13; const int e = r / 32, kt = (r % 32) / 2, nt = r % 2;
            cvt_big(c, c.inf(which ? I_W3 : I_W1) + ((size_t)l * 32 + e) * 1024 * 512, 512, 512, kt * 64, nt * 256, c.w<bf16_t>(WS_WUP + (size_t)(l & 1) * WSET) + (size_t)e * 1024 * 1024, 1024, 1 + which); continue; } r -= 2 * CT_W13;
        if (r < CT_W2) { const int e = r / 32, kt = (r % 32) / 4, nt = r % 4;
            cvt_big(c, c.inf(I_W2) + ((size_t)l * 32 + e) * 512 * 1024, 1024, 1024, kt * 64, nt * 256, c.w<bf16_t>(WS_WDN + (size_t)(l & 1) * WSET) + (size_t)e * 1024 * 512, 512, 0); continue; } r -= CT_W2;
        if (r < CT_IN) { const int kt = r / 9, nt = r % 9; cvt_big(c, c.inf(I_WIN) + (size_t)l * 1024 * 2144, 2144, 2144, kt * 64, nt * 256, c.w<bf16_t>(WS_WIN + (size_t)(l & 1) * WSET), 1024, 0); continue; } r -= CT_IN;
        if (r < CT_OUT) { const int kt = r / 4, nt = r % 4; cvt_big(c, c.inf(I_WOUT) + (size_t)l * 1024 * 1024, 1024, 1024, kt * 64, nt * 256, c.w<bf16_t>(WS_WOUT + (size_t)(l & 1) * WSET), 1024, 0); continue; } r -= CT_OUT;
        if (r < CT_UQ) { const int kt = r / 6, nt = r % 6; cvt_tile(c, c.inf(I_WUQ) + (size_t)l * 192 * 384, 384, 384, kt * 64, nt * 64, c.w<bf16_t>(WS_WUQ + (size_t)(l & 1) * WSET), 192, nt * 64); continue; } r -= CT_UQ;
        if (r < CT_UKV) { const int kt = r / 8, nt = r % 8; cvt_tile(c, c.inf(I_WUKV) + (size_t)l * 128 * 512, 512, 512, kt * 64, nt * 64, c.w<bf16_t>(WS_WUKV + (size_t)(l & 1) * WSET), 128, nt * 64); continue; } r -= CT_UKV;
        cvt_tile(c, c.inf(I_WPOOL) + ((size_t)l * 4 + r) * 4096, 64, 64, 0, 0, c.w<bf16_t>(WS_WPOOL + (size_t)(l & 1) * WSET) + r * 4096, 64, 0);
    }
}
__device__ __forceinline__ void ph_normrows(const Ctx& c_, int l) { const Ctx c = fresh(c_);
    const float* xin = c.inf(I_X); const bf16_t* xb = c.w<bf16_t>(WS_XB); const bf16_t* y1 = c.w<bf16_t>(WS_Y1);
    const float* gn = c.inf(I_N1G) + l * 1024; const float* mod = c.w<float>(WS_MOD) + (size_t)l * NB * 6144; bf16_t* ha = c.w<bf16_t>(WS_HA);
    constexpr int RQ = 4;
    for (int row0 = c.blk * 8 + c.wid; row0 < NTOK; row0 += c.G * 8 * RQ) {
        f32x4 v[RQ][2][2]; float ss[RQ];
        if (l == 0) {
#pragma unroll
            for (int q = 0; q < RQ; ++q) { const int row = row0 + q * c.G * 8;
                if (row < NTOK) {
#pragma unroll
                    for (int i = 0; i < 2; ++i) { const float* p = xin + (size_t)row * 1024 + i * 512 + c.lane * 8; v[q][i][0] = *(const f32x4*)p; v[q][i][1] = *(const f32x4*)(p + 4); } } }
        } else {
            u32x4 xw[RQ][2], yw[RQ][2];
#pragma unroll
            for (int q = 0; q < RQ; ++q) { const int row = row0 + q * c.G * 8;
                if (row < NTOK) {
#pragma unroll
                    for (int i = 0; i < 2; ++i) { const size_t o = (size_t)row * 1024 + i * 512 + c.lane * 8; xw[q][i] = *(const u32x4*)(xb + o); yw[q][i] = *(const u32x4*)(y1 + o); } } }
#pragma unroll
            for (int q = 0; q < RQ; ++q)
#pragma unroll
                for (int i = 0; i < 2; ++i) { const u32x4 a = xw[q][i], b = yw[q][i];
                    v[q][i][0] = (f32x4){bflo(a.x), bfhi(a.x), bflo(a.y), bfhi(a.y)} + (f32x4){bflo(b.x), bfhi(b.x), bflo(b.y), bfhi(b.y)};
                    v[q][i][1] = (f32x4){bflo(a.z), bfhi(a.z), bflo(a.w), bfhi(a.w)} + (f32x4){bflo(b.z), bfhi(b.z), bflo(b.w), bfhi(b.w)}; }
        }
#pragma unroll
        for (int q = 0; q < RQ; ++q) { float s = 0.f;
#pragma unroll
            for (int i = 0; i < 2; ++i)
#pragma unroll
                for (int h = 0; h < 2; ++h) { const f32x4 w = v[q][i][h]; s += w[0] * w[0] + w[1] * w[1] + w[2] * w[2] + w[3] * w[3]; }
            ss[q] = (row0 + q * c.G * 8 < NTOK) ? s : 0.f; }
#pragma unroll
        for (int q = 0; q < RQ; ++q) ss[q] = wave_sum(ss[q]);
#pragma unroll
        for (int q = 0; q < RQ; ++q) { const int row = row0 + q * c.G * 8;
            if (row < NTOK) { const int b = row / SEQ; const float* sh = mod + b * 6144; const float* sc = sh + 1024; const float rinv = frsqrt(ss[q] * (1.0f / 1024.0f) + EPS);
#pragma unroll
                for (int i = 0; i < 2; ++i) { const int col = i * 512 + c.lane * 8; float o8[8];
#pragma unroll
                    for (int h = 0; h < 2; ++h) { const f32x4 g = *(const f32x4*)(gn + col + 4 * h), s1 = *(const f32x4*)(sc + col + 4 * h), s0 = *(const f32x4*)(sh + col + 4 * h);
                        const f32x4 hv = v[q][i][h] * rinv * g * (s1 + 1.0f) + s0; o8[4 * h] = hv[0]; o8[4 * h + 1] = hv[1]; o8[4 * h + 2] = hv[2]; o8[4 * h + 3] = hv[3]; }
                    *(u32x4*)(ha + (size_t)row * 1024 + col) = pk8(o8); } } }
    }
}

#define MFMA16(a, b, c) __builtin_amdgcn_mfma_f32_16x16x32_bf16((a), (b), (c), 0, 0, 0)
#define MFMA32(a, b, c) __builtin_amdgcn_mfma_f32_32x32x16_bf16((a), (b), (c), 0, 0, 0)

__device__ __forceinline__ void mix_unit(const Ctx& c_, int l, int r0) { const Ctx c = fresh(c_);
    const bf16_t* Z = c.w<bf16_t>(WS_Z); bf16_t* Aq = (bf16_t*)c.lds; bf16_t* Akv = (bf16_t*)(c.lds + 12800); float* Lkr = (float*)(c.lds + 21504);
    float* Lu = (float*)(c.lds + 25600); bf16_t* Lp = (bf16_t*)(c.lds + 73728); float* Lcu = (float*)(c.lds + 90624); float* Lco = (float*)c.lds;
    const int s0 = r0 % SEQ, b = r0 / SEQ, fr = c.lane & 15, fq = c.lane >> 4;
    {   const int t = c.tid >> 4, sub = c.tid & 15; const bf16_t* zr = Z + (size_t)(r0 + t) * ZP;
        const u32x4 zero4 = {0u, 0u, 0u, 0u};
        const u32x4 ra0 = *(const u32x4*)(zr + Z_CQ + sub * 8), ra1 = (sub < 8) ? *(const u32x4*)(zr + Z_CQ + 128 + sub * 8) : zero4, rk0 = *(const u32x4*)(zr + Z_CKV + sub * 8), rkr = (sub < 4) ? *(const u32x4*)(zr + Z_KR + sub * 8) : zero4;
        u32x4 rp[3], rca[4], rcg[4];
#pragma unroll
        for (int i = 0; i < 3; ++i) { const int ch = c.tid + 512 * i, row = ch >> 5, c8 = ch & 31; rp[i] = (ch < 47 * 32 && s0 - 15 + row >= 0) ? *(const u32x4*)(Z + (size_t)(r0 - 15 + row) * ZP + Z_POOL + c8 * 8) : zero4; }
#pragma unroll
        for (int i = 0; i < 4; ++i) { const int ch = c.tid + 512 * i, row = ch >> 5, c8 = ch & 31; const bool ok = (ch < 62 * 32 && s0 - 30 + row >= 0);
            rca[i] = ok ? *(const u32x4*)(Z + (size_t)(r0 - 30 + row) * ZP + Z_CA + c8 * 8) : zero4; rcg[i] = ok ? *(const u32x4*)(Z + (size_t)(r0 - 30 + row) * ZP + Z_CG + c8 * 8) : zero4; }
        auto un8 = [](const u32x4 v, float (&o)[8]) { o[0] = bflo(v.x); o[1] = bfhi(v.x); o[2] = bflo(v.y); o[3] = bfhi(v.y); o[4] = bflo(v.z); o[5] = bfhi(v.z); o[6] = bflo(v.w); o[7] = bfhi(v.w); };
        const float* qag = c.inf(I_QAG) + l * 192; const float* kvag = c.inf(I_KVAG) + l * 128;
        float a0[8], a1[8], k0[8]; float ssq = 0.f, ssk = 0.f; un8(ra0, a0); un8(ra1, a1); un8(rk0, k0);
#pragma unroll
        for (int j = 0; j < 8; ++j) { ssq += a0[j] * a0[j] + a1[j] * a1[j]; ssk += k0[j] * k0[j]; }
#pragma unroll
        for (int m = 1; m < 16; m <<= 1) { ssq += __shfl_xor(ssq, m); ssk += __shfl_xor(ssk, m); }
        const float rq = frsqrt(ssq * (1.0f / 192.0f) + EPS), rk = frsqrt(ssk * (1.0f / 128.0f) + EPS);
#pragma unroll
        for (int j = 0; j < 8; ++j) a0[j] *= rq * qag[sub * 8 + j];
        *(u32x4*)(Aq + t * 200 + sub * 8) = pk8(a0);
        if (sub < 8) {
#pragma unroll
            for (int j = 0; j < 8; ++j) a1[j] *= rq * qag[128 + sub * 8 + j];
            *(u32x4*)(Aq + t * 200 + 128 + sub * 8) = pk8(a1); }
#pragma unroll
        for (int j = 0; j < 8; ++j) k0[j] *= rk * kvag[sub * 8 + j];
        *(u32x4*)(Akv + t * 136 + sub * 8) = pk8(k0);
        if (sub < 4) { float kr[8]; un8(rkr, kr);
#pragma unroll
            for (int j = 0; j < 8; ++j) Lkr[t * 32 + sub * 8 + j] = kr[j]; }
#pragma unroll
        for (int i = 0; i < 3; ++i) { const int ch = c.tid + 512 * i, row = ch >> 5, c8 = ch & 31; if (ch < 47 * 32) { float v[8]; un8(rp[i], v);
            *(f32x4*)(Lu + row * 256 + c8 * 8) = (f32x4){v[0], v[1], v[2], v[3]}; *(f32x4*)(Lu + row * 256 + c8 * 8 + 4) = (f32x4){v[4], v[5], v[6], v[7]}; } }
#pragma unroll
        for (int i = 0; i < 4; ++i) { const int ch = c.tid + 512 * i, row = ch >> 5, c8 = ch & 31; if (ch < 62 * 32) { float a[8], g[8]; un8(rca[i], a); un8(rcg[i], g);
#pragma unroll
            for (int j = 0; j < 8; ++j) a[j] *= fsigmoid(g[j]);
            *(f32x4*)(Lcu + row * 256 + c8 * 8) = (f32x4){a[0], a[1], a[2], a[3]}; *(f32x4*)(Lcu + row * 256 + c8 * 8 + 4) = (f32x4){a[4], a[5], a[6], a[7]}; } }
    }
    __syncthreads();
    const float* rcos = c.w<float>(WS_ROPE); const float* rsin = rcos + (size_t)NTOK * 16;
    if (c.wid < 4) {
        const int h = c.wid; const bf16_t* W = c.w<bf16_t>(WS_WUQ + (size_t)(l & 1) * WSET) + (size_t)(96 * h) * 192; const float* qg = c.inf(I_QG) + l * 96;
        f32x4 acc[6][2];
#pragma unroll
        for (int nf = 0; nf < 6; ++nf) { acc[nf][0] = (f32x4){0.f, 0.f, 0.f, 0.f}; acc[nf][1] = acc[nf][0]; }
#pragma unroll
        for (int ks = 0; ks < 6; ++ks) { bf16x8 af[2];
#pragma unroll
            for (int mf = 0; mf < 2; ++mf) af[mf] = *(const bf16x8*)(Aq + (mf * 16 + fr) * 200 + ks * 32 + fq * 8);
#pragma unroll
            for (int nf = 0; nf < 6; ++nf) { const bf16x8 bfr = *(const bf16x8*)(W + (size_t)(16 * nf + fr) * 192 + ks * 32 + fq * 8);
                acc[nf][0] = MFMA16(bfr, af[0], acc[nf][0]); acc[nf][1] = MFMA16(bfr, af[1], acc[nf][1]); } }
#pragma unroll
        for (int mf = 0; mf < 2; ++mf) { float ss = 0.f;
#pragma unroll
            for (int nf = 0; nf < 6; ++nf)
#pragma unroll
                for (int j = 0; j < 4; ++j) ss += acc[nf][mf][j] * acc[nf][mf][j];
            ss += __shfl_xor(ss, 16); ss += __shfl_xor(ss, 32);
            const float rinv = frsqrt(ss * (1.0f / 96.0f) + EPS) * (0.10206207261596575f * 1.44269504089f);
            const int tok = r0 + mf * 16 + fr; bf16_t* qo = c.w<bf16_t>(WS_Q) + ((size_t)(b * 4 + h) * SEQ + s0 + mf * 16 + fr) * 96;
            float v[6][4];
#pragma unroll
            for (int nf = 0; nf < 6; ++nf)
#pragma unroll
                for (int j = 0; j < 4; ++j) v[nf][j] = acc[nf][mf][j] * rinv * qg[16 * nf + 4 * fq + j];
            const f32x4 cs4 = *(const f32x4*)(rcos + (size_t)tok * 16 + 4 * fq), sn4 = *(const f32x4*)(rsin + (size_t)tok * 16 + 4 * fq);
#pragma unroll
            for (int j = 0; j < 4; ++j) { const float x1 = v[4][j], x2 = v[5][j]; v[4][j] = x1 * cs4[j] - x2 * sn4[j]; v[5][j] = x1 * sn4[j] + x2 * cs4[j]; }
#pragma unroll
            for (int nf = 0; nf < 6; ++nf) { u32x2 o; o.x = cvt_pk_bf16(v[nf][0], v[nf][1]); o.y = cvt_pk_bf16(v[nf][2], v[nf][3]); *(u32x2*)(qo + 16 * nf + 4 * fq) = o; } }
    } else {
        const int h = c.wid - 4; const bf16_t* W = c.w<bf16_t>(WS_WUKV + (size_t)(l & 1) * WSET) + (size_t)(128 * h) * 128; const float* kg = c.inf(I_KG) + l * 96;
        f32x4 ak[4][2], av[4][2];
#pragma unroll
        for (int nf = 0; nf < 4; ++nf) { ak[nf][0] = (f32x4){0.f, 0.f, 0.f, 0.f}; ak[nf][1] = ak[nf][0]; av[nf][0] = ak[nf][0]; av[nf][1] = ak[nf][0]; }
#pragma unroll
        for (int ks = 0; ks < 4; ++ks) { bf16x8 af[2];
#pragma unroll
            for (int mf = 0; mf < 2; ++mf) af[mf] = *(const bf16x8*)(Akv + (mf * 16 + fr) * 136 + ks * 32 + fq * 8);
#pragma unroll
            for (int nf = 0; nf < 4; ++nf) { const bf16x8 bk = *(const bf16x8*)(W + (size_t)(16 * nf + fr) * 128 + ks * 32 + fq * 8), bv = *(const bf16x8*)(W + (size_t)(64 + 16 * nf + fr) * 128 + ks * 32 + fq * 8);
                ak[nf][0] = MFMA16(bk, af[0], ak[nf][0]); ak[nf][1] = MFMA16(bk, af[1], ak[nf][1]);
                av[nf][0] = MFMA16(af[0], bv, av[nf][0]); av[nf][1] = MFMA16(af[1], bv, av[nf][1]); } }
#pragma unroll
        for (int mf = 0; mf < 2; ++mf) { const int tl = mf * 16 + fr; float ss = 0.f;
#pragma unroll
            for (int nf = 0; nf < 4; ++nf)
#pragma unroll
                for (int j = 0; j < 4; ++j) ss += ak[nf][mf][j] * ak[nf][mf][j];
#pragma unroll
            for (int j = 0; j < 8; ++j) { const float kr = Lkr[tl * 32 + fq * 8 + j]; ss += kr * kr; }
            ss += __shfl_xor(ss, 16); ss += __shfl_xor(ss, 32);
            const float rinv = frsqrt(ss * (1.0f / 96.0f) + EPS);
            const int tok = r0 + tl; bf16_t* ko = c.w<bf16_t>(WS_K) + ((size_t)(b * 4 + h) * SEQ + s0 + tl) * 96;
#pragma unroll
            for (int nf = 0; nf < 4; ++nf) { u32x2 o; o.x = cvt_pk_bf16(ak[nf][mf][0] * rinv * kg[16 * nf + 4 * fq], ak[nf][mf][1] * rinv * kg[16 * nf + 4 * fq + 1]);
                o.y = cvt_pk_bf16(ak[nf][mf][2] * rinv * kg[16 * nf + 4 * fq + 2], ak[nf][mf][3] * rinv * kg[16 * nf + 4 * fq + 3]); *(u32x2*)(ko + 16 * nf + 4 * fq) = o; }
            const f32x4 cs4 = *(const f32x4*)(rcos + (size_t)tok * 16 + 4 * fq), sn4 = *(const f32x4*)(rsin + (size_t)tok * 16 + 4 * fq);
            float o1[4], o2[4];
#pragma unroll
            for (int j = 0; j < 4; ++j) { const int i = 4 * fq + j; const float x1 = Lkr[tl * 32 + i] * rinv * kg[64 + i], x2 = Lkr[tl * 32 + 16 + i] * rinv * kg[80 + i];
                o1[j] = x1 * cs4[j] - x2 * sn4[j]; o2[j] = x1 * sn4[j] + x2 * cs4[j]; }
            { u32x2 o; o.x = cvt_pk_bf16(o1[0], o1[1]); o.y = cvt_pk_bf16(o1[2], o1[3]); *(u32x2*)(ko + 64 + 4 * fq) = o; o.x = cvt_pk_bf16(o2[0], o2[1]); o.y = cvt_pk_bf16(o2[2], o2[3]); *(u32x2*)(ko + 80 + 4 * fq) = o; }
            bf16_t* vo = c.w<bf16_t>(WS_VT) + (size_t)(b * 4 + h) * 64 * SEQ + s0 + mf * 16 + 4 * fq;
#pragma unroll
            for (int nf = 0; nf < 4; ++nf) { u32x2 o; o.x = cvt_pk_bf16(av[nf][mf][0], av[nf][mf][1]); o.y = cvt_pk_bf16(av[nf][mf][2], av[nf][mf][3]); *(u32x2*)(vo + (size_t)(16 * nf + fr) * SEQ) = o; } }
    }
    { const int t = c.tid >> 4, sub = c.tid & 15, g = sub >> 2, w = 2 << g, s = s0 + t; const float inv = 1.0f / (float)((s + 1 < w) ? (s + 1) : w);
#pragma unroll
        for (int k = 0; k < 2; ++k) { const int col = sub * 16 + k * 8; float sum[8];
#pragma unroll
            for (int j = 0; j < 8; ++j) sum[j] = 0.f;
            for (int d = 0; d < w; ++d) { const float* p = Lu + (t + 15 - d) * 256 + col;
#pragma unroll
                for (int j = 0; j < 8; ++j) sum[j] += p[j]; }
            const float* p0 = Lu + (t + 15) * 256 + col;
#pragma unroll
            for (int j = 0; j < 8; ++j) sum[j] = sum[j] * inv - p0[j];
            *(u32x4*)(Lp + t * 264 + col) = pk8(sum); } }
    float cres[16];
    { const int chn = c.tid & 255, half = c.tid >> 8; const float* dw = c.inf(I_DWW) + (size_t)l * 31 * 256 + chn; const float bias = c.inf(I_DWB)[l * 256 + chn];
        float wv[31];
#pragma unroll
        for (int j = 0; j < 31; ++j) wv[j] = dw[j * 256];
#pragma unroll
        for (int tt = 0; tt < 16; ++tt) cres[tt] = bias;
#pragma unroll
        for (int r = 0; r < 46; ++r) { const float u = Lcu[(half * 16 + r) * 256 + chn];
#pragma unroll
            for (int tt = 0; tt < 16; ++tt) { const int j = r - tt; if (j >= 0 && j < 31) cres[tt] += wv[j] * u; } } }
    __syncthreads();
    { const int g = c.wid >> 1, mf = c.wid & 1; const bf16_t* W = c.w<bf16_t>(WS_WPOOL + (size_t)(l & 1) * WSET) + g * 4096; const float* ps = c.inf(I_PSCALE) + l * 256 + g * 64;
        f32x4 acc[4];
#pragma unroll
        for (int nf = 0; nf < 4; ++nf) acc[nf] = (f32x4){0.f, 0.f, 0.f, 0.f};
#pragma unroll
        for (int ks = 0; ks < 2; ++ks) { const bf16x8 af = *(const bf16x8*)(Lp + (mf * 16 + fr) * 264 + g * 64 + ks * 32 + fq * 8);
#pragma unroll
            for (int nf = 0; nf < 4; ++nf) { const bf16x8 bfr = *(const bf16x8*)(W + (16 * nf + fr) * 64 + ks * 32 + fq * 8); acc[nf] = MFMA16(bfr, af, acc[nf]); } }
        bf16_t* yo = c.w<bf16_t>(WS_YB) + (size_t)(r0 + mf * 16 + fr) * 1024 + 256 + g * 64;
#pragma unroll
        for (int nf = 0; nf < 4; ++nf) { const int d = 16 * nf + 4 * fq; u32x2 o; o.x = cvt_pk_bf16(acc[nf][0] * ps[d], acc[nf][1] * ps[d + 1]); o.y = cvt_pk_bf16(acc[nf][2] * ps[d + 2], acc[nf][3] * ps[d + 3]); *(u32x2*)(yo + d) = o; } }
    { const int chn = c.tid & 255, half = c.tid >> 8;
#pragma unroll
        for (int tt = 0; tt < 16; ++tt) Lco[(half * 16 + tt) * 256 + chn] = cres[tt]; }
    __syncthreads();
    { const float* lg = c.inf(I_LNG) + l * 256 + c.lane * 4; const float* lb = c.inf(I_LNB) + l * 256 + c.lane * 4;
#pragma unroll
        for (int k = 0; k < 4; ++k) { const int t = c.wid * 4 + k; const f32x4 v = *(const f32x4*)(Lco + t * 256 + c.lane * 4);
            const float mean = wave_sum(v[0] + v[1] + v[2] + v[3]) * (1.0f / 256.0f); const f32x4 d = v - mean;
            const float var = wave_sum(d[0] * d[0] + d[1] * d[1] + d[2] * d[2] + d[3] * d[3]) * (1.0f / 256.0f); const float rs = frsqrt(var + EPS);
            float y[4];
#pragma unroll
            for (int j = 0; j < 4; ++j) y[j] = fsilu(d[j] * rs * lg[j] + lb[j]);
            u32x2 o; o.x = cvt_pk_bf16(y[0], y[1]); o.y = cvt_pk_bf16(y[2], y[3]); *(u32x2*)(c.w<bf16_t>(WS_YB) + (size_t)(r0 + t) * 1024 + 768 + c.lane * 4) = o; } }
    __syncthreads();
}

constexpr int CW_W13 = 32 * 16 * 16, CW_W2 = 32 * 8 * 32, CW_IN = 16 * 72, CW_OUT = 16 * 32, CW_UQ = 3 * 12, CW_UKV = 2 * 16, CW_POOL = 4 * 2;
constexpr int CW_TOTAL = 2 * CW_W13 + CW_W2 + CW_IN + CW_OUT + CW_UQ + CW_UKV + CW_POOL;
struct CvtTile { const float* src; bf16_t* dst; int ldn, ldk; };
__device__ __forceinline__ void cvt_decode(const Ctx& c, int l, int t, CvtTile& d) {
    const size_t wso = (size_t)(l & 1) * WSET; int r = t;
    if (r < 2 * CW_W13) { const int which = r / CW_W13; r %= CW_W13; const int e = r >> 8, kt = (r >> 4) & 15, nt = r & 15, n0 = nt * 32;
        d.src = c.inf(which ? I_W3 : I_W1) + ((size_t)l * 32 + e) * 1024 * 512 + (size_t)kt * 64 * 512 + n0; d.ldn = 512; d.ldk = 1024;
        d.dst = c.w<bf16_t>(WS_WUP + wso) + (size_t)e * 1024 * 1024 + (size_t)((n0 >> 7) * 256 + which * 128 + (n0 & 127)) * 1024 + kt * 64; return; } r -= 2 * CW_W13;
    if (r < CW_W2) { const int e = r >> 8, kt = (r >> 5) & 7, nt = r & 31;
        d.src = c.inf(I_W2) + ((size_t)l * 32 + e) * 512 * 1024 + (size_t)kt * 64 * 1024 + nt * 32; d.ldn = 1024; d.ldk = 512;
        d.dst = c.w<bf16_t>(WS_WDN + wso) + (size_t)e * 1024 * 512 + (size_t)(nt * 32) * 512 + kt * 64; return; } r -= CW_W2;
    if (r < CW_IN) { const int kt = r / 72, nt = r % 72; d.src = (nt < 67) ? c.inf(I_WIN) + (size_t)l * 1024 * 2144 + (size_t)kt * 64 * 2144 + nt * 32 : nullptr; d.ldn = 2144; d.ldk = 1024;
        d.dst = c.w<bf16_t>(WS_WIN + wso) + (size_t)(nt * 32) * 1024 + kt * 64; return; } r -= CW_IN;
    if (r < CW_OUT) { const int kt = r >> 5, nt = r & 31; d.src = c.inf(I_WOUT) + (size_t)l * 1024 * 1024 + (size_t)kt * 64 * 1024 + nt * 32; d.ldn = 1024; d.ldk = 1024;
        d.dst = c.w<bf16_t>(WS_WOUT + wso) + (size_t)(nt * 32) * 1024 + kt * 64; return; } r -= CW_OUT;
    if (r < CW_UQ) { const int kt = r / 12, nt = r % 12; d.src = c.inf(I_WUQ) + (size_t)l * 192 * 384 + (size_t)kt * 64 * 384 + nt * 32; d.ldn = 384; d.ldk = 192;
        d.dst = c.w<bf16_t>(WS_WUQ + wso) + (size_t)(nt * 32) * 192 + kt * 64; return; } r -= CW_UQ;
    if (r < CW_UKV) { const int kt = r >> 4, nt = r & 15; d.src = c.inf(I_WUKV) + (size_t)l * 128 * 512 + (size_t)kt * 64 * 512 + nt * 32; d.ldn = 512; d.ldk = 128;
        d.dst = c.w<bf16_t>(WS_WUKV + wso) + (size_t)(nt * 32) * 128 + kt * 64; return; } r -= CW_UKV;
    { const int g = r >> 1, nt = r & 1; d.src = c.inf(I_WPOOL) + ((size_t)l * 4 + g) * 4096 + nt * 32; d.ldn = 64; d.ldk = 64; d.dst = c.w<bf16_t>(WS_WPOOL + wso) + g * 4096 + (size_t)(nt * 32) * 64; }
}
__device__ __forceinline__ void cvt_wave(const Ctx& c, int l, int wrank, int nwaves, float* T) {
    { const float* rgw = c.inf(I_RGW) + (size_t)l * 1024 * 4; const float* rew = c.inf(I_REW) + (size_t)l * 1024 * 32; float* rwt = c.w<float>(WS_RWT + (size_t)(l & 1) * WSET);
        for (int e = wrank * 64 + c.lane; e < 36 * 1024; e += nwaves * 64) { const int g = e >> 10, k = e & 1023; rwt[e] = (g < 4) ? rgw[k * 4 + g] : rew[k * 32 + g - 4]; } }
    f32x4 v[8]; CvtTile cur; cur.src = nullptr; cur.dst = nullptr; cur.ldn = 0; cur.ldk = 0;
    auto issue = [&](const CvtTile& d) {
#pragma unroll
        for (int i = 0; i < 8; ++i) { const int e4 = c.lane + 64 * i, kk = e4 >> 3, n4 = e4 & 7; v[i] = d.src ? *(const f32x4*)(d.src + (size_t)kk * d.ldn + n4 * 4) : (f32x4){0.f, 0.f, 0.f, 0.f}; } };
    int t = wrank;
    if (t < CW_TOTAL) { cvt_decode(c, l, t, cur); issue(cur); }
    while (t < CW_TOTAL) {
#pragma unroll
        for (int i = 0; i < 8; ++i) { const int e4 = c.lane + 64 * i, kk = e4 >> 3, n4 = e4 & 7; float* p = T + kk * 33 + n4 * 4; p[0] = v[i][0]; p[1] = v[i][1]; p[2] = v[i][2]; p[3] = v[i][3]; }
        const int tn = t + nwaves; CvtTile nxt = cur; if (tn < CW_TOTAL) { cvt_decode(c, l, tn, nxt); issue(nxt); }
        __builtin_amdgcn_wave_barrier();
        { const int r = c.lane >> 3, p8 = c.lane & 7;
#pragma unroll
            for (int q = 0; q < 4; ++q) { const int n = q * 8 + r; float o[8];
#pragma unroll
                for (int j = 0; j < 8; ++j) o[j] = T[(p8 * 8 + j) * 33 + n];
                *(u32x4*)(cur.dst + (size_t)n * cur.ldk + p8 * 8) = pk8(o); } }
        __builtin_amdgcn_wave_barrier();
        t = tn; cur = nxt;
    }
}

#ifdef EMU
static inline float __builtin_amdgcn_logf(float x) { return log2f(x); }
#endif
constexpr int HGP = 68, HGV = 40;
constexpr int HG_LG = 0, HG_LK = 8704, HG_LQ = 17408, HG_LVT = 26112, HG_LEG = 31232, HG_LGG = 31488, HG_BYTES = 31744;
template <bool OUT> __device__ __forceinline__ void hgrn_mfma(const Ctx& c_, int l, int bu, int cvt_layer = NL) { const Ctx c = fresh(c_);
    if (c.wid < 4) {
        const int cu = bu * 4 + c.wid, bh = cu / NCH, chunk = cu % NCH, b = bh >> 2, h = bh & 3, tok0 = b * SEQ + chunk * 128;
        const bf16_t* Z = c.w<bf16_t>(WS_Z); const float lbd = c.w<float>(WS_LB)[l * 256 + h * 64 + c.lane];
        unsigned char* L = c.lds + c.wid * HG_BYTES; float* Lg = (float*)(L + HG_LG); float* Lk = (float*)(L + HG_LK); float* Lq = (float*)(L + HG_LQ); bf16_t* Lvt = (bf16_t*)(L + HG_LVT); float* LeG = (float*)(L + HG_LEG); float* LG = (float*)(L + HG_LGG);
        const int l31 = c.lane & 31, hi = c.lane >> 5;
        f32x16 S[2][2];
        if (OUT) { const float* s0 = c.w<float>(WS_S0) + (size_t)(bh * NCH + chunk) * 4096;
#pragma unroll
            for (int mf = 0; mf < 2; ++mf)
#pragma unroll
                for (int nf = 0; nf < 2; ++nf)
#pragma unroll
                    for (int r = 0; r < 16; ++r) S[mf][nf][r] = s0[(32 * mf + (r & 3) + 8 * (r >> 2) + 4 * hi) * 64 + 32 * nf + l31]; }
        else {
#pragma unroll
            for (int mf = 0; mf < 2; ++mf)
#pragma unroll
                for (int nf = 0; nf < 2; ++nf)
#pragma unroll
                    for (int r = 0; r < 16; ++r) S[mf][nf][r] = 0.f; }
        float gtot = 0.f; const float og0 = OUT ? c.inf(I_HOG)[l * 64 + l31] : 0.f, og1 = OUT ? c.inf(I_HOG)[l * 64 + 32 + l31] : 0.f;
        u32x4 rf[4], rq[4], rv[4];
        { const bf16_t* zn = Z + (size_t)(tok0 + (c.lane >> 3)) * ZP + h * 64 + (c.lane & 7) * 8;
#pragma unroll
            for (int i = 0; i < 4; ++i) { rf[i] = *(const u32x4*)(zn + (size_t)i * 8 * ZP + Z_HF); rv[i] = *(const u32x4*)(zn + (size_t)i * 8 * ZP + Z_HI); if (OUT) rq[i] = *(const u32x4*)(zn + (size_t)i * 8 * ZP + Z_HQ); else rq[i] = (u32x4){0u, 0u, 0u, 0u}; } }
#pragma unroll 1
        for (int sc = 0; sc < 4; ++sc) { const int tokb = tok0 + sc * 32;
            {
                const int rr = c.lane >> 3, c8 = (c.lane & 7) * 8;
#pragma unroll
                for (int i = 0; i < 4; ++i) { const int tr = i * 8 + rr; float x[8];
                    { const u32x4 v = rf[i]; x[0] = bflo(v.x); x[1] = bfhi(v.x); x[2] = bflo(v.y); x[3] = bfhi(v.y); x[4] = bflo(v.z); x[5] = bfhi(v.z); x[6] = bflo(v.w); x[7] = bfhi(v.w); }
                    *(f32x4*)(Lg + tr * HGP + c8) = (f32x4){x[0], x[1], x[2], x[3]}; *(f32x4*)(Lg + tr * HGP + c8 + 4) = (f32x4){x[4], x[5], x[6], x[7]};
                    if (OUT) { const u32x4 v = rq[i]; x[0] = fsilu(bflo(v.x)); x[1] = fsilu(bfhi(v.x)); x[2] = fsilu(bflo(v.y)); x[3] = fsilu(bfhi(v.y)); x[4] = fsilu(bflo(v.z)); x[5] = fsilu(bfhi(v.z)); x[6] = fsilu(bflo(v.w)); x[7] = fsilu(bfhi(v.w));
                        *(f32x4*)(Lq + tr * HGP + c8) = (f32x4){x[0], x[1], x[2], x[3]}; *(f32x4*)(Lq + tr * HGP + c8 + 4) = (f32x4){x[4], x[5], x[6], x[7]}; }
                    { const u32x4 v = rv[i]; const unsigned w4[4] = {v.x, v.y, v.z, v.w};
#pragma unroll
                        for (int k = 0; k < 4; ++k) { Lvt[(c8 + 2 * k) * HGV + tr] = (bf16_t)(w4[k] & 0xffffu); Lvt[(c8 + 2 * k + 1) * HGV + tr] = (bf16_t)(w4[k] >> 16); } } }
                if (sc < 3) { const bf16_t* zn = Z + (size_t)(tokb + 32 + rr) * ZP + h * 64 + c8;
#pragma unroll
                    for (int i = 0; i < 4; ++i) { rf[i] = *(const u32x4*)(zn + (size_t)i * 8 * ZP + Z_HF); rv[i] = *(const u32x4*)(zn + (size_t)i * 8 * ZP + Z_HI); if (OUT) rq[i] = *(const u32x4*)(zn + (size_t)i * 8 * ZP + Z_HQ); } }
                __builtin_amdgcn_wave_barrier();
                float run = 0.f;
#pragma unroll
                for (int t = 0; t < 32; ++t) { const float f = lbd + (1.0f - lbd) * fsigmoid(Lg[t * HGP + c.lane]); run += __builtin_amdgcn_logf(f); Lg[t * HGP + c.lane] = run; Lk[t * HGP + c.lane] = 1.0f - f; }
                LG[c.lane] = run; LeG[c.lane] = __builtin_amdgcn_exp2f(run); gtot += run;
            }
            __builtin_amdgcn_wave_barrier();
            bf16x8 vt[2][2];
#pragma unroll
            for (int nf = 0; nf < 2; ++nf)
#pragma unroll
                for (int ks = 0; ks < 2; ++ks) vt[nf][ks] = *(const bf16x8*)(Lvt + (32 * nf + l31) * HGV + 16 * ks + 8 * hi);
            f32x16 O[2];
            if (OUT) {
#pragma unroll
                for (int r = 0; r < 16; ++r) { O[0][r] = 0.f; O[1][r] = 0.f; }
                float acc[8];
#pragma unroll
                for (int m = 0; m < 8; ++m) acc[m] = 0.f;
                const int sb = (l31 & 16) + 8 * hi;
#pragma unroll 1
                for (int d4 = 0; d4 < 16; ++d4) { const f32x4 qt = *(const f32x4*)(Lq + l31 * HGP + 4 * d4), gt = *(const f32x4*)(Lg + l31 * HGP + 4 * d4);
#pragma unroll
                    for (int mg = 0; mg < 4; ++mg) {
                        f32x4 k4[2], g4[2];
#pragma unroll
                        for (int j = 0; j < 2; ++j) { const int s = sb + 2 * mg + j; k4[j] = *(const f32x4*)(Lk + s * HGP + 4 * d4); g4[j] = *(const f32x4*)(Lg + s * HGP + 4 * d4); }
                        __builtin_amdgcn_sched_barrier(0);
#pragma unroll
                        for (int j = 0; j < 2; ++j)
#pragma unroll
                            for (int e = 0; e < 4; ++e) acc[mg * 2 + j] += qt[e] * k4[j][e] * __builtin_amdgcn_exp2f(gt[e] - g4[j][e]);
                        __builtin_amdgcn_sched_barrier(0); } }
                bf16x8 af[2], afx;
                { float a8[8];
#pragma unroll
                    for (int j = 0; j < 8; ++j) a8[j] = (sb + j <= l31) ? acc[j] : 0.f;
                    const bf16x8 ad = __builtin_bit_cast(bf16x8, pk8p(a8)), az = (bf16x8){0, 0, 0, 0, 0, 0, 0, 0};
                    af[0] = (l31 < 16) ? ad : az; af[1] = (l31 < 16) ? az : ad; }
                {
                    f32x16 dx;
#pragma unroll
                    for (int r = 0; r < 16; ++r) dx[r] = 0.f;
                    const bool lowr = l31 < 16; const float* Lx = lowr ? Lk : Lq;
#pragma unroll
                    for (int kk = 0; kk < 4; ++kk) { const int d0 = 16 * kk + 8 * hi;
                        const f32x4 xa = *(const f32x4*)(Lx + l31 * HGP + d0), xb = *(const f32x4*)(Lx + l31 * HGP + d0 + 4), ga = *(const f32x4*)(Lg + l31 * HGP + d0), gb = *(const f32x4*)(Lg + l31 * HGP + d0 + 4),
                                    ma = *(const f32x4*)(Lg + 15 * HGP + d0), mb = *(const f32x4*)(Lg + 15 * HGP + d0 + 4);
                        float v8[8];
#pragma unroll
                        for (int j = 0; j < 4; ++j) { const float da = ga[j] - ma[j], db = gb[j] - mb[j];
                            v8[j] = xa[j] * __builtin_amdgcn_exp2f(lowr ? -da : da); v8[4 + j] = xb[j] * __builtin_amdgcn_exp2f(lowr ? -db : db); }
                        const bf16x8 vv = __builtin_bit_cast(bf16x8, pk8p(v8)), zz = (bf16x8){0, 0, 0, 0, 0, 0, 0, 0};
                        dx = MFMA32(lowr ? vv : zz, lowr ? zz : vv, dx); }
                    float x8[8];
#pragma unroll
                    for (int j = 0; j < 8; ++j) x8[j] = dx[j];
                    afx = __builtin_bit_cast(bf16x8, pk8(x8)); }
#pragma unroll
                for (int mf = 0; mf < 2; ++mf)
#pragma unroll
                    for (int s = 0; s < 2; ++s) { const int d0 = 32 * mf + 16 * s + 4 * hi;
                        const f32x4 qa = *(const f32x4*)(Lq + l31 * HGP + d0), qb = *(const f32x4*)(Lq + l31 * HGP + d0 + 8), ga = *(const f32x4*)(Lg + l31 * HGP + d0), gb = *(const f32x4*)(Lg + l31 * HGP + d0 + 8);
                        float q8[8];
#pragma unroll
                        for (int j = 0; j < 4; ++j) { q8[j] = qa[j] * __builtin_amdgcn_exp2f(ga[j]); q8[4 + j] = qb[j] * __builtin_amdgcn_exp2f(gb[j]); }
                        const bf16x8 qf = __builtin_bit_cast(bf16x8, pk8p(q8));
#pragma unroll
                        for (int nf = 0; nf < 2; ++nf) { float s8[8];
#pragma unroll
                            for (int j = 0; j < 8; ++j) s8[j] = S[mf][nf][8 * s + j];
                            O[nf] = MFMA32(qf, __builtin_bit_cast(bf16x8, pk8p(s8)), O[nf]); } }
#pragma unroll
                for (int nf = 0; nf < 2; ++nf) {
#pragma unroll
                    for (int ks = 0; ks < 2; ++ks) O[nf] = MFMA32(af[ks], vt[nf][ks], O[nf]);
                    const s16x4 p0 = *(const s16x4*)(Lvt + (32 * nf + l31) * HGV + 4 * hi), p1 = *(const s16x4*)(Lvt + (32 * nf + l31) * HGV + 8 + 4 * hi);
                    O[nf] = MFMA32(afx, ((bf16x8){p0[0], p0[1], p0[2], p0[3], p1[0], p1[1], p1[2], p1[3]}), O[nf]); }
            }
#pragma unroll
            for (int mf = 0; mf < 2; ++mf) {
#pragma unroll
                for (int q = 0; q < 4; ++q) { const f32x4 e4 = *(const f32x4*)(LeG + 32 * mf + 8 * q + 4 * hi);
#pragma unroll
                    for (int e = 0; e < 4; ++e) { S[mf][0][4 * q + e] *= e4[e]; S[mf][1][4 * q + e] *= e4[e]; } }
                const int d = 32 * mf + l31; const float Gd = LG[d];
#pragma unroll
                for (int ks = 0; ks < 2; ++ks) { float k8[8];
#pragma unroll
                    for (int j = 0; j < 8; ++j) { const int s = 16 * ks + 8 * hi + j; k8[j] = Lk[s * HGP + d] * __builtin_amdgcn_exp2f(Gd - Lg[s * HGP + d]); }
                    const bf16x8 kf = __builtin_bit_cast(bf16x8, pk8p(k8));
                    S[mf][0] = MFMA32(kf, vt[0][ks], S[mf][0]); S[mf][1] = MFMA32(kf, vt[1][ks], S[mf][1]); } }
            if (OUT) {
                {
                    const int rr = c.lane >> 3, c8 = (c.lane & 7) * 8; const bf16_t* zg = Z + (size_t)(tokb + rr) * ZP + Z_HG + h * 64 + c8; u32x2 gv[4];
#pragma unroll
                    for (int hf = 0; hf < 2; ++hf) {
#pragma unroll
                    for (int i = 0; i < 4; ++i) gv[i] = *(const u32x2*)(zg + (size_t)i * 8 * ZP + 4 * hf);
#pragma unroll
                    for (int i = 0; i < 4; ++i) { const u32x2 v = gv[i]; *(f32x4*)(Lq + (i * 8 + rr) * HGP + c8 + 4 * hf) = (f32x4){fsilu(bflo(v.x)), fsilu(bfhi(v.x)), fsilu(bflo(v.y)), fsilu(bfhi(v.y))}; } }
                }
                __builtin_amdgcn_wave_barrier();
#pragma unroll
                for (int r = 0; r < 16; ++r) { const int tl = (r & 3) + 8 * (r >> 2) + 4 * hi; float ss = O[0][r] * O[0][r] + O[1][r] * O[1][r];
                    ss = half_sum(ss, hi);
                    const float rinv = frsqrt(ss * (1.0f / 64.0f) + EPS); const size_t tok = (size_t)(tokb + tl);
                    const float g0 = Lq[tl * HGP + l31], g1 = Lq[tl * HGP + 32 + l31];
                    bf16_t* yo = c.w<bf16_t>(WS_YB) + tok * 1024 + 512 + h * 64;
                    yo[l31] = (bf16_t)f2bf_bits(O[0][r] * rinv * og0 * g0); yo[32 + l31] = (bf16_t)f2bf_bits(O[1][r] * rinv * og1 * g1); } }
            __builtin_amdgcn_wave_barrier();
        }
        if (!OUT) { float* sc = c.w<float>(WS_SC) + (size_t)(bh * NCH + chunk) * 4096;
#pragma unroll
            for (int mf = 0; mf < 2; ++mf)
#pragma unroll
                for (int nf = 0; nf < 2; ++nf)
#pragma unroll
                    for (int r = 0; r < 16; ++r) sc[(32 * mf + (r & 3) + 8 * (r >> 2) + 4 * hi) * 64 + 32 * nf + l31] = S[mf][nf][r];
            c.w<float>(WS_PC)[(size_t)(bh * NCH + chunk) * 64 + c.lane] = __builtin_amdgcn_exp2f(gtot); }
    } else if (OUT && cvt_layer < NL) {
        cvt_wave(c, cvt_layer, bu * 4 + (c.wid - 4), NBH * NCH, (float*)(c.lds + 4 * HG_BYTES + (c.wid - 4) * 8448));
    }
    __syncthreads();
}
__device__ __forceinline__ void hgrn_carry(const Ctx& c_, int l) { const Ctx c = fresh(c_);
    const float* SC = c.w<float>(WS_SC); const float* PC = c.w<float>(WS_PC); float* S0 = c.w<float>(WS_S0);
    for (int e = c.blk * 512 + c.tid; e < NBH * 4096; e += c.G * 512) { const int bh = e >> 12, dv = e & 4095, d = dv >> 6; float s = 0.f;
#pragma unroll 32
        for (int ch = 0; ch < NCH; ++ch) { const size_t o = (size_t)(bh * NCH + ch) * 4096 + dv; S0[o] = s; s = PC[(size_t)(bh * NCH + ch) * 64 + d] * s + SC[o]; } }
    ASMV("s_waitcnt vmcnt(0)" ::: "memory");
    __syncthreads();
    if (c.tid == 0) { __builtin_amdgcn_fence(__ATOMIC_RELEASE, "agent"); ASMV("s_waitcnt vmcnt(0)" ::: "memory");
        (void)__hip_atomic_fetch_add((unsigned*)(c.ws + WS_CTL + CTL_HG) + l * 64, 1u, __ATOMIC_RELAXED, __HIP_MEMORY_SCOPE_AGENT); }
}
__device__ __forceinline__ void hgrn_wait_carry(const Ctx& c, int l) {
    if (c.tid == 0) { unsigned* p = (unsigned*)(c.ws + WS_CTL + CTL_HG) + l * 64; unsigned sp = 0;
        while (__hip_atomic_load(p, __ATOMIC_RELAXED, __HIP_MEMORY_SCOPE_AGENT) < (unsigned)c.G) { __builtin_amdgcn_s_sleep(1); if (++sp > (1u << 22)) break; }
        __builtin_amdgcn_fence(__ATOMIC_ACQUIRE, "agent"); ASMV("s_waitcnt vmcnt(0)" ::: "memory"); }
    __syncthreads();
}
__device__ __forceinline__ void ph_mixers(const Ctx& c, int l) {
    if (c.blk & 1) for (int bu = c.blk; bu < NBH * NCH / 4; bu += c.G) hgrn_mfma<false>(c, l, bu);
    for (int u = c.blk; u < NTOK / 32; u += c.G) mix_unit(c, l, u * 32);
    if (!(c.blk & 1)) for (int bu = c.blk; bu < NBH * NCH / 4; bu += c.G) hgrn_mfma<false>(c, l, bu);
}

template <bool FIXED>
__device__ __forceinline__ void attn_unit(const Ctx& c_, int bh, int qt, float negM) { const Ctx c = fresh(c_);
    const bf16_t* Qg = c.w<bf16_t>(WS_Q) + (size_t)bh * SEQ * 96; const bf16_t* Kg = c.w<bf16_t>(WS_K) + (size_t)bh * SEQ * 96; const bf16_t* Vg = c.w<bf16_t>(WS_VT) + (size_t)bh * 64 * SEQ;
    constexpr int KROW = 104, VROW = 72, KB = 64 * KROW * 2, VB = 64 * VROW * 2;
    const int l31 = c.lane & 31, hi = c.lane >> 5, qrow = qt * 256 + c.wid * 32 + l31;
    bf16x8 qf[6];
#pragma unroll
    for (int ks = 0; ks < 6; ++ks) qf[ks] = *(const bf16x8*)(Qg + (size_t)qrow * 96 + ks * 16 + hi * 8);
    f32x16 o0, o1;
#pragma unroll
    for (int r = 0; r < 16; ++r) { o0[r] = 0.f; o1[r] = 0.f; }
    float mrun = -INFINITY, lsum = 0.f; f32x2 lsum2 = {0.f, 0.f};
    const int nkt = 4 * (qt + 1), mylast = 4 * qt + (c.wid >> 1);
    const int kr0 = c.tid / 12, kc0 = c.tid % 12, kr1 = (c.tid + 512) / 12, kc1 = (c.tid + 512) % 12, vr = c.tid >> 3, vc = c.tid & 7;
    u32x4 sk0[2], sk1[2], sv[2];
    auto gload = [&](int j) {
#pragma unroll
        for (int h = 0; h < 2; ++h) { const int kt = 2 * j + h; sk0[h] = *(const u32x4*)(Kg + (size_t)(kt * 64 + kr0) * 96 + kc0 * 8); if (c.tid < 256) sk1[h] = *(const u32x4*)(Kg + (size_t)(kt * 64 + kr1) * 96 + kc1 * 8);
                               sv[h] = *(const u32x4*)(Vg + (size_t)vr * SEQ + kt * 64 + vc * 8); } };
    auto lstore = [&](int buf) {
#pragma unroll
        for (int h = 0; h < 2; ++h) { unsigned char* kb = c.lds + (buf * 2 + h) * (KB + VB); unsigned char* vb = kb + KB;
                                 *(u32x4*)(kb + (kr0 * KROW + kc0 * 8) * 2) = sk0[h]; if (c.tid < 256) *(u32x4*)(kb + (kr1 * KROW + kc1 * 8) * 2) = sk1[h]; *(u32x4*)(vb + (vr * VROW + vc * 8) * 2) = sv[h]; } };
    gload(0); lstore(0); __syncthreads();
    auto tile = [&](const int kt, auto masked) {
            const bf16_t* kb = (const bf16_t*)(c.lds + (kt & 3) * (KB + VB)); const bf16_t* vb = (const bf16_t*)(c.lds + (kt & 3) * (KB + VB) + KB);
            f32x16 s0, s1;
#pragma unroll
            for (int r = 0; r < 16; ++r) { s0[r] = FIXED ? negM : 0.f; s1[r] = FIXED ? negM : 0.f; }
#pragma unroll
            for (int ks = 0; ks < 6; ++ks) { const bf16x8 k0 = *(const bf16x8*)(kb + l31 * KROW + ks * 16 + hi * 8), k1 = *(const bf16x8*)(kb + (32 + l31) * KROW + ks * 16 + hi * 8);
                s0 = MFMA32(k0, qf[ks], s0); s1 = MFMA32(k1, qf[ks], s1); }
            if constexpr (decltype(masked)::value) {
#pragma unroll
                for (int r = 0; r < 16; ++r) { const int key = kt * 64 + (r & 3) + 8 * (r >> 2) + 4 * hi; if (key > qrow) s0[r] = -INFINITY; if (key + 32 > qrow) s1[r] = -INFINITY; } }
            if constexpr (FIXED) {
#pragma unroll
                for (int r = 0; r < 16; ++r) { s0[r] = __builtin_amdgcn_exp2f(s0[r]); s1[r] = __builtin_amdgcn_exp2f(s1[r]); }
#pragma unroll
                for (int r = 0; r < 16; r += 2) { lsum2 += (f32x2){s0[r], s0[r + 1]}; lsum2 += (f32x2){s1[r], s1[r + 1]}; }
            } else {
            float mx = s0[0];
#pragma unroll
            for (int r = 1; r < 16; ++r) mx = fmaxf(mx, s0[r]);
#pragma unroll
            for (int r = 0; r < 16; ++r) mx = fmaxf(mx, s1[r]);
            mx = fmaxf(mx, __shfl_xor(mx, 32));
            const float mnew = fmaxf(mrun, mx), alpha = __builtin_amdgcn_exp2f(mrun - mnew); mrun = mnew;
            float ps = 0.f;
#pragma unroll
            for (int r = 0; r < 16; ++r) { s0[r] = __builtin_amdgcn_exp2f(s0[r] - mnew); s1[r] = __builtin_amdgcn_exp2f(s1[r] - mnew); ps += s0[r] + s1[r]; }
            lsum = lsum * alpha + ps;
#pragma unroll
            for (int r = 0; r < 16; ++r) { o0[r] *= alpha; o1[r] *= alpha; }
            }
#pragma unroll
            for (int kf = 0; kf < 2; ++kf)
#pragma unroll
                for (int s = 0; s < 2; ++s) { const f32x16& sx = kf ? s1 : s0; u32x4 pw; pw.x = cvt_pk_bf16(sx[8 * s], sx[8 * s + 1]); pw.y = cvt_pk_bf16(sx[8 * s + 2], sx[8 * s + 3]); pw.z = cvt_pk_bf16(sx[8 * s + 4], sx[8 * s + 5]); pw.w = cvt_pk_bf16(sx[8 * s + 6], sx[8 * s + 7]);
                    const bf16x8 pf = __builtin_bit_cast(bf16x8, pw); const int kcol = kf * 32 + 16 * s + 4 * hi;
                    const s16x4 a0 = *(const s16x4*)(vb + l31 * VROW + kcol), a1 = *(const s16x4*)(vb + l31 * VROW + kcol + 8), b0 = *(const s16x4*)(vb + (32 + l31) * VROW + kcol), b1 = *(const s16x4*)(vb + (32 + l31) * VROW + kcol + 8);
                    const bf16x8 v0 = (bf16x8){a0[0], a0[1], a0[2], a0[3], a1[0], a1[1], a1[2], a1[3]}, v1 = (bf16x8){b0[0], b0[1], b0[2], b0[3], b1[0], b1[1], b1[2], b1[3]};
                    o0 = MFMA32(v0, pf, o0); o1 = MFMA32(v1, pf, o1); }
            };
    const int nkj = nkt >> 1, jl = mylast >> 1;
    int j = 0;
    for (; j < jl; ++j) { gload(j + 1); tile(2 * j, std::false_type{}); tile(2 * j + 1, std::false_type{}); lstore((j + 1) & 1); __syncthreads(); }
    { if (mylast & 1) { tile(2 * j, std::false_type{}); tile(2 * j + 1, std::true_type{}); } else tile(2 * j, std::true_type{});
      if (j + 1 < nkj) { gload(j + 1); lstore((j + 1) & 1); }
      __syncthreads(); ++j; }
    for (; j < nkj; ++j) { if (j + 1 < nkj) { gload(j + 1); lstore((j + 1) & 1); } __syncthreads(); }
    if constexpr (FIXED) lsum = lsum2[0] + lsum2[1];
    lsum += __shfl_xor(lsum, 32); const float rl = 1.0f / lsum;
    const int b = bh >> 2, h = bh & 3; bf16_t* yo = c.w<bf16_t>(WS_YB) + (size_t)(b * SEQ + qrow) * 1024 + h * 64;
#pragma unroll
    for (int g = 0; g < 4; ++g) { const int dv = 8 * g + 4 * hi; u32x2 w0, w1;
        w0.x = cvt_pk_bf16(o0[4 * g] * rl, o0[4 * g + 1] * rl); w0.y = cvt_pk_bf16(o0[4 * g + 2] * rl, o0[4 * g + 3] * rl); *(u32x2*)(yo + dv) = w0;
        w1.x = cvt_pk_bf16(o1[4 * g] * rl, o1[4 * g + 1] * rl); w1.y = cvt_pk_bf16(o1[4 * g + 2] * rl, o1[4 * g + 3] * rl); *(u32x2*)(yo + 32 + dv) = w1; }
    __syncthreads();
}
template <bool FIXED>
__device__ __forceinline__ void attn_units(const Ctx& c, float negM) {
    { const int NU = NBH * (NQT / 2);
      if ((c.G & 7) == 0) { const int per = (NU + 7) / 8, x = c.blk & 7, G8 = c.G >> 3;
          for (int j = c.blk >> 3; j < per; j += G8) { const int pu = x * per + j; if (pu < NU) { const int bh = pu / (NQT / 2), p = pu % (NQT / 2); attn_unit<FIXED>(c, bh, NQT - 1 - p, negM); attn_unit<FIXED>(c, bh, p, negM); } } }
      else for (int pu = c.blk; pu < NU; pu += c.G) { const int bh = pu / (NQT / 2), p = pu % (NQT / 2); attn_unit<FIXED>(c, bh, NQT - 1 - p, negM); attn_unit<FIXED>(c, bh, p, negM); } }
}
__device__ __forceinline__ void ph_attn(const Ctx& c, int l) {
    hgrn_carry(c, l);
    {
        const float* qg = c.inf(I_QG) + l * 96; const float* kg = c.inf(I_KG) + l * 96;
        int ln = c.lane; LAUNDER_V(ln);
        float gq = fmaxf(fabsf(qg[ln]), fabsf(qg[32 + (ln & 63)])), gk = fmaxf(fabsf(kg[ln]), fabsf(kg[32 + (ln & 63)]));
#pragma unroll
        for (int o = 1; o < 64; o <<= 1) { gq = fmaxf(gq, __shfl_xor(gq, o)); gk = fmaxf(gk, __shfl_xor(gk, o)); }
        const float M = 9.797958971132712f * 1.44269504089f * 1.02f * gq * gk;
        if (M <= 60.0f) attn_units<true>(c, -M); else attn_units<false>(c, 0.f); }
    hgrn_wait_carry(c, l);
    for (int bu = c.blk; bu < NBH * NCH / 4; bu += c.G) hgrn_mfma<true>(c, l, bu, l + 1);
}

__device__ __forceinline__ void ph_router(const Ctx& c_, int l, int cnt_off = 0) { const Ctx c = fresh(c_);
    bf16_t* Whi = (bf16_t*)c.lds; bf16_t* Wlo = (bf16_t*)(c.lds + 73728); float* Llog = (float*)(c.lds + 147456) + c.wid * 288; float* Lcb = (float*)(c.lds + 156672);
    int* Le = (int*)(c.lds + 156672 + 256); float* Lw = (float*)(c.lds + 156672 + 256 + 1024); int* Lr = (int*)(c.lds + 156672 + 256 + 2048); int* Lcnt = (int*)(c.lds + 156672 + 256 + 3072); int* Lbase = Lcnt + 32;
    const float* rwt = c.w<float>(WS_RWT + (size_t)(l & 1) * WSET);
    const float* rgb = c.inf(I_RGB) + l * 4; const float* reb = c.inf(I_REB) + l * 32;
    const bf16_t* x = c.w<bf16_t>(WS_XB); const float* gn = c.inf(I_N2G) + l * 1024; const float* mod = c.w<float>(WS_MOD) + (size_t)l * NB * 6144; bf16_t* ha = c.w<bf16_t>(WS_HA);
    unsigned* cnt = (unsigned*)(c.ws + WS_CTL + CTL_CNT) + l * 32 + cnt_off;
    int* rowtok = c.w<int>(WS_ROWTOK); float* roww = c.w<float>(WS_ROWW);
    const int fr = c.lane & 15, fq = c.lane >> 4;
    int staged_b = -1;
    for (int u = c.blk; u < NTOK / 128; u += c.G) {
        const int b = (u * 128) / SEQ; const float* sh = mod + b * 6144 + 3072; const float* sc = sh + 1024;
        __syncthreads();
        if (b != staged_b) { staged_b = b;
            for (int q = c.tid; q < 36 * 128; q += 512) { const int n = q >> 7, ch = q & 127, k0 = ch * 8; float hi8[8], lo8[8];
#pragma unroll
                for (int j = 0; j < 8; ++j) { const float w = rwt[n * 1024 + k0 + j] * gn[k0 + j] * (1.0f + sc[k0 + j]); const float h = bf2f((bf16_t)f2bf_bits(w)); hi8[j] = h; lo8[j] = w - h; }
                const int pc = (ch ^ (n & 15)) * 8; *(u32x4*)(Whi + n * 1024 + pc) = pk8(hi8); *(u32x4*)(Wlo + n * 1024 + pc) = pk8(lo8); }
            for (int g = c.wid; g < 36; g += 8) { float s = 0.f;
#pragma unroll
                for (int i = 0; i < 4; ++i) { const f32x4 w = *(const f32x4*)(rwt + g * 1024 + i * 256 + c.lane * 4), s4 = *(const f32x4*)(sh + i * 256 + c.lane * 4); s += w[0] * s4[0] + w[1] * s4[1] + w[2] * s4[2] + w[3] * s4[3]; }
                s = wave_sum(s); if (c.lane == 0) Lcb[g] = s + (g < 4 ? rgb[g] : reb[g - 4]); } }
        if (c.tid < 32) Lcnt[c.tid] = 0;
        __syncthreads();
        const int rowb = u * 128 + c.wid * 16; const bf16_t* xr = x + (size_t)(rowb + fr) * 1024 + 8 * fq;
        f32x4 acc[3] = {{0.f, 0.f, 0.f, 0.f}, {0.f, 0.f, 0.f, 0.f}, {0.f, 0.f, 0.f, 0.f}}; float ssp = 0.f;
#pragma unroll 8
        for (int ks = 0; ks < 32; ++ks) { const u32x4 hw = *(const u32x4*)(xr + 32 * ks);
            const unsigned hws[4] = {hw.x, hw.y, hw.z, hw.w};
#pragma unroll
            for (int j = 0; j < 4; ++j) { const float a = bflo(hws[j]), b = bfhi(hws[j]); ssp += a * a + b * b; }
            const bf16x8 ah = __builtin_bit_cast(bf16x8, hw);
            const int ch = 4 * ks + fq;
#pragma unroll
            for (int nf = 0; nf < 3; ++nf) { const int n = 16 * nf + fr; bf16x8 bh = {0, 0, 0, 0, 0, 0, 0, 0}, bl = bh;
                if (nf < 2 || fr < 4) { const int pc = (ch ^ (n & 15)) * 8; bh = *(const bf16x8*)(Whi + n * 1024 + pc); bl = *(const bf16x8*)(Wlo + n * 1024 + pc); }
                acc[nf] = MFMA16(ah, bh, acc[nf]); acc[nf] = MFMA16(ah, bl, acc[nf]); } }
        ssp += __shfl_xor(ssp, 16); ssp += __shfl_xor(ssp, 32);
        const float rinv = frsqrt(ssp * (1.0f / 1024.0f) + EPS);
        float rj[4];
#pragma unroll
        for (int j = 0; j < 4; ++j) rj[j] = __shfl(rinv, fq * 4 + j);
#pragma unroll
        for (int half = 0; half < 2; ++half) {
            if ((fq >> 1) == half) {
#pragma unroll
                for (int nf = 0; nf < 3; ++nf) { const int col = 16 * nf + fr; if (col < 36) {
#pragma unroll
                    for (int j = 0; j < 4; ++j) Llog[((fq & 1) * 4 + j) * 36 + col] = acc[nf][j] * rj[j] + Lcb[col]; } } }
            __builtin_amdgcn_wave_barrier();
            if (c.lane < 8) { const float* lg = Llog + c.lane * 36; const int rl = c.wid * 16 + half * 8 + c.lane;
                int gi = 0; float gm = lg[0];
#pragma unroll
                for (int g = 1; g < 4; ++g) { const float t = lg[g]; if (t > gm) { gm = t; gi = g; } }
                float den = 0.f;
#pragma unroll
                for (int g = 0; g < 4; ++g) den += expf(lg[g] - gm);
                const float gw = 1.0f / den;
                float e1 = -INFINITY, e2 = -INFINITY; int i1 = 0, i2 = 0;
#pragma unroll
                for (int j = 0; j < 8; ++j) { const float t = lg[4 + gi * 8 + j]; if (t > e1) { e2 = e1; i2 = i1; e1 = t; i1 = j; } else if (t > e2) { e2 = t; i2 = j; } }
                const float p2 = expf(e2 - e1), w1 = gw / (1.0f + p2), w2 = gw * p2 / (1.0f + p2);
                const int ea = gi * 8 + i1, eb = gi * 8 + i2; Le[rl * 2] = ea; Le[rl * 2 + 1] = eb; Lw[rl * 2] = w1; Lw[rl * 2 + 1] = w2;
                Lr[rl * 2] = atomicAdd(&Lcnt[ea], 1); Lr[rl * 2 + 1] = atomicAdd(&Lcnt[eb], 1); }
            __builtin_amdgcn_wave_barrier();
        }
#pragma unroll 8
        for (int ks = 0; ks < 32; ++ks) { const int k0 = 32 * ks + 8 * fq; const u32x4 xw = *(const u32x4*)(xr + 32 * ks); const f32x4 xa = {bflo(xw.x), bfhi(xw.x), bflo(xw.y), bfhi(xw.y)}, xb = {bflo(xw.z), bfhi(xw.z), bflo(xw.w), bfhi(xw.w)};
            const f32x4 ga = *(const f32x4*)(gn + k0) * (*(const f32x4*)(sc + k0) + 1.0f), gb = *(const f32x4*)(gn + k0 + 4) * (*(const f32x4*)(sc + k0 + 4) + 1.0f);
            const f32x4 ha4 = xa * rinv * ga + *(const f32x4*)(sh + k0), hb4 = xb * rinv * gb + *(const f32x4*)(sh + k0 + 4);
            u32x4 o; o.x = cvt_pk_bf16(ha4[0], ha4[1]); o.y = cvt_pk_bf16(ha4[2], ha4[3]); o.z = cvt_pk_bf16(hb4[0], hb4[1]); o.w = cvt_pk_bf16(hb4[2], hb4[3]);
            *(u32x4*)(ha + (size_t)(rowb + fr) * 1024 + k0) = o; }
        __syncthreads();
        if (c.tid < 32) Lbase[c.tid] = (int)__hip_atomic_fetch_add(&cnt[c.tid], (unsigned)Lcnt[c.tid], __ATOMIC_RELAXED, __HIP_MEMORY_SCOPE_AGENT);
        __syncthreads();
        if (c.tid < 256) { const int a = u * 256 + c.tid, e = Le[c.tid], dest = e * MOE_CAP + Lbase[e] + Lr[c.tid]; rowtok[dest] = a; roww[dest] = Lw[c.tid]; }
    }
    __syncthreads();
}
constexpr int LDS_MOETAB = 131072;
__device__ __forceinline__ void moe_tables(const Ctx& c_, int l) { const Ctx c = fresh(c_);
    int* tab = (int*)(c.lds + LDS_MOETAB); unsigned* cnt = (unsigned*)(c.ws + WS_CTL + CTL_CNT) + l * 32;
    __syncthreads();
    if (c.tid < 32) tab[c.tid] = (int)__hip_atomic_load(&cnt[c.tid], __ATOMIC_RELAXED, __HIP_MEMORY_SCOPE_AGENT);
    __syncthreads();
    if (c.tid == 0) { int acc = 0; for (int e = 0; e < 32; ++e) { tab[32 + e] = acc; acc += (tab[e] + 255) >> 8; } tab[64] = acc; }
    __syncthreads();
    if (c.tid < 32) for (int t2 = tab[32 + c.tid]; t2 < tab[33 + c.tid]; ++t2) tab[72 + t2] = c.tid;
    __syncthreads();
}
__device__ __forceinline__ void ph_final(const Ctx& c_) { const Ctx c = fresh(c_);
    float* out = c.a->out; const bf16_t* y1 = c.w<bf16_t>(WS_Y1);
    const bf16_t* xb = c.w<bf16_t>(WS_XB);
    for (size_t e = (size_t)c.blk * 512 + c.tid; e < (size_t)NTOK * 128; e += (size_t)c.G * 512) { const u32x4 y = *(const u32x4*)(y1 + e * 8), xw = *(const u32x4*)(xb + e * 8);
        *(f32x4*)(out + e * 8) = (f32x4){bflo(xw.x), bfhi(xw.x), bflo(xw.y), bfhi(xw.y)} + (f32x4){bflo(y.x), bfhi(y.x), bflo(y.y), bfhi(y.y)};
        *(f32x4*)(out + e * 8 + 4) = (f32x4){bflo(xw.z), bfhi(xw.z), bflo(xw.w), bfhi(xw.w)} + (f32x4){bflo(y.z), bfhi(y.z), bflo(y.w), bfhi(y.w)}; }
}

constexpr int PH_PER_LAYER = 8, N_PHASES = 2 + PH_PER_LAYER * NL + 1;
__global__ void __launch_bounds__(512, 2) mk_fwd(Args args) {
#ifdef EMU
    unsigned char* lds = emu_lds();
#else
    extern __shared__ __attribute__((aligned(16))) unsigned char lds[];
#endif
    Ctx c; c.a = &args; c.ws = args.ws; c.lds = lds; c.tid = threadIdx.x; c.wid = __builtin_amdgcn_readfirstlane(c.tid >> 6); c.lane = c.tid & 63; c.G = gridDim.x; c.blk = blockIdx.x;
    if (c.tid == 0) *(uint4*)(lds + LDS_XB) = make_uint4(0u, 0u, 0u, 0u);
    __syncthreads();
    XcdBarrier bar; bar.bar = (unsigned*)(args.ws + WS_CTL); bar.x = 0; bar.st = (volatile LAS unsigned*)(lds + LDS_XB);
    if (args.ph_hi - args.ph_lo > 1) bar = xcd_barrier_post((unsigned*)(args.ws + WS_CTL), (volatile LAS unsigned*)(lds + LDS_XB));
    int ph = 0;
#ifndef PHMASK
#define PHMASK 0xFFFFF
#endif
#define PHASE(K, ...) do { if (ph >= args.ph_lo && ph < args.ph_hi) { if constexpr ((PHMASK >> K) & 1) { __VA_ARGS__; } if (ph + 1 < args.ph_hi) xcd_barrier(bar); } ++ph; } while (0)
    PHASE(0, ph_prologue0(c));
    PHASE(1, ph_prologue1(c));
    for (int l = 0; l < NL; ++l) {
        PHASE(2, if (l == 0) ph_cvt(c, 0); ph_normrows(c, l));
        PHASE(3, { pg8::Gemm g{c.w<bf16_t>(WS_HA), c.w<bf16_t>(WS_WIN + (size_t)(l & 1) * WSET), NTOK, ZP, 1024}; pg8::TailNarrowOrder S; S.init(NTOK, c.G, c.blk); pg8::EpiBf16 E{c.w<bf16_t>(WS_Z), ZP};
                pg8::gemm_phase<pg8::EpiBf16, pg8::TailNarrowOrder, true, true>((LAS unsigned char*)lds, g, S, E); });
        PHASE(4, ph_mixers(c, l));
        PHASE(5, ph_attn(c, l));
        PHASE(6, { pg8::Gemm g{c.w<bf16_t>(WS_YB), c.w<bf16_t>(WS_WOUT + (size_t)(l & 1) * WSET), NTOK, 1024, 1024}; pg8::StaticOrder S; S.init(NTOK, 1024, c.G, c.blk);
                pg8::EpiResid E{(l == 0) ? c.inf(I_X) : (const float*)nullptr, c.w<bf16_t>(WS_XB), c.w<bf16_t>(WS_XB), c.w<float>(WS_MOD) + (size_t)l * NB * 6144 + 2048, 6144, SEQ, c.w<bf16_t>(WS_Y1)};
                pg8::gemm_phase<pg8::EpiResid, pg8::StaticOrder, true, true>((LAS unsigned char*)lds, g, S, E); });
        PHASE(7, ph_router(c, l));
        PHASE(9, { pg8::Gemm g{c.w<bf16_t>(WS_HA), c.w<bf16_t>(WS_WUP + (size_t)(l & 1) * WSET), NR, 32 * 1024, 1024}; moe_tables(c, l); pg8::MoeOrder S{(const LAS int*)((LAS unsigned char*)lds + LDS_MOETAB), MOE_CAP, c.G, c.blk}; pg8::EpiSwiglu E{c.w<bf16_t>(WS_Q)};
                pg8::gemm_phase<pg8::EpiSwiglu, pg8::MoeOrder, true, true, true>((LAS unsigned char*)lds, g, S, E, c.w<int>(WS_ROWTOK)); });
        PHASE(10, { pg8::Gemm g{c.w<bf16_t>(WS_Q), c.w<bf16_t>(WS_WDN + (size_t)(l & 1) * WSET), NR, 32 * 1024, 512}; if (MK_SPLIT) moe_tables(c, l);        pg8::MoeOrder S{(const LAS int*)((LAS unsigned char*)lds + LDS_MOETAB), MOE_CAP, c.G, c.blk};
                pg8::EpiDown E{c.w<int>(WS_ROWTOK), c.w<float>(WS_ROWW), c.w<bf16_t>(WS_XB), c.w<bf16_t>(WS_Y1), c.w<float>(WS_MOD) + (size_t)l * NB * 6144 + 5120, 6144, SEQ};
                pg8::gemm_phase<pg8::EpiDown, pg8::MoeOrder, true, true>((LAS unsigned char*)lds, g, S, E); });
    }
    PHASE(11, ph_final(c));
#undef PHASE
}

extern "C" void kernel_launch(void* const* d_in, const int* in_sizes, int n_in, void* d_out, int out_size, void* d_ws, size_t ws_size, hipStream_t stream) {
    static int grid = 0;
    if (grid == 0) {
        if (n_in != 30 || out_size != NTOK * 1024 || ws_size < WS_END) { fprintf(stderr, "kernel_launch: shape/workspace mismatch (n_in %d out %d ws %zu need %zu)\n", n_in, out_size, ws_size, (size_t)WS_END); grid = -1; return; }
        int dev = 0, cus = 0;
        if (hipGetDevice(&dev) != hipSuccess || hipDeviceGetAttribute(&cus, hipDeviceAttributeMultiprocessorCount, dev) != hipSuccess) { grid = -1; return; }
        if (hipFuncSetAttribute((const void*)mk_fwd, hipFuncAttributeMaxDynamicSharedMemorySize, LDS_BYTES) != hipSuccess) { fprintf(stderr, "kernel_launch: hipFuncSetAttribute failed\n"); grid = -1; return; }
        int per_cu = 0; (void)hipOccupancyMaxActiveBlocksPerMultiprocessor(&per_cu, (const void*)mk_fwd, 512, LDS_BYTES);
        if (per_cu < 1) fprintf(stderr, "kernel_launch: occupancy query says %d blocks per CU\n", per_cu);
        grid = cus;
    }
    if (grid < 0) return;
    (void)hipMemsetAsync((char*)d_ws + WS_CTL, 0, CTL_BYTES, stream);
    Args a{};
    for (int i = 0; i < 30; ++i) a.in[i] = d_in[i];
    a.out = (float*)d_out; a.ws = (unsigned char*)d_ws;
#if MK_SPLIT
    for (int p = 0; p < N_PHASES; ++p) { a.ph_lo = p; a.ph_hi = p + 1;
#else
    { a.ph_lo = 0; a.ph_hi = N_PHASES;
#endif
#ifdef EMU
        EMU_LAUNCH(mk_fwd, grid, 512, LDS_BYTES, stream, a);
#else
        hipLaunchKernelGGL(mk_fwd, dim3(grid), dim3(512), LDS_BYTES, stream, a);
#endif
    }
}
```
